# Optimizing an MI355X kernel written in HIP

```python
import math
import jax, jax.numpy as jnp
from jax import lax
import numpy as np

D_MODEL = 2048
BATCH = 4
SEQ = 2048
DEPTH = 2

MEM_LEN = 256
NORM_EPS = 1e-6

RET_HEADS = 8
RET_DK = 128
RET_DV = 128
RET_CHUNK = 128
GDN_HEADS = 8
GDN_DK = 128
GDN_DV = 128
GDN_CONV = 4
GDN_CHUNK = 64
DIFF_HEADS = 4
DIFF_DK = 128
DIFF_DV = 256
Q_BLOCK = 128
MEM_HEADS = 4
MEM_DH = 128
D_FF = 5632
N_EXPERTS = 8
TOP_K = 2
EXPERT_FF = 7168

RET_QK = RET_HEADS * RET_DK
RET_V = RET_HEADS * RET_DV
GDN_QK = GDN_HEADS * GDN_DK
GDN_V = GDN_HEADS * GDN_DV
GDN_QKV = 2 * GDN_QK + GDN_V
DIFF_QK = DIFF_HEADS * 2 * DIFF_DK
DIFF_V = DIFF_HEADS * DIFF_DV
BRANCH_W = RET_V + GDN_V + DIFF_V
IN_SIZES = (RET_QK, RET_QK, RET_V, RET_V,
            GDN_QKV, GDN_V, GDN_HEADS, GDN_HEADS,
            DIFF_QK, DIFF_QK, DIFF_V,
            3 * D_MODEL)
IN_WIDTH = sum(IN_SIZES)
N_DENSE = (DEPTH + 1) // 2
N_MOE = DEPTH // 2

kernel_name = "hybrid_retention_gdn_diffattn_moe"


def rms_norm(x, w, eps=NORM_EPS):
    xf = x.astype(jnp.float32)
    y = xf * lax.rsqrt(jnp.mean(xf * xf, axis=-1, keepdims=True) + eps)
    return (y * w.astype(jnp.float32)).astype(x.dtype)


def head_layer_norm(o, eps=NORM_EPS):
    mu = jnp.mean(o, axis=-1, keepdims=True)
    var = jnp.mean(jnp.square(o - mu), axis=-1, keepdims=True)
    return (o - mu) * lax.rsqrt(var + eps)


def l2_normalize(t, eps=1e-6):
    return t * lax.rsqrt(jnp.sum(t * t, axis=-1, keepdims=True) + eps)


def split_heads(t, h):
    b, s, _ = t.shape
    return t.reshape(b, s, h, -1).transpose(0, 2, 1, 3)


def merge_heads(t):
    b, h, s, d = t.shape
    return t.transpose(0, 2, 1, 3).reshape(b, s, h * d)


def split_points(sizes):
    pts, acc = [], 0
    for sz in sizes[:-1]:
        acc += sz
        pts.append(acc)
    return pts


def retention(q, k, v):
    b, h, s, dk = q.shape
    dv = v.shape[-1]
    c = RET_CHUNK
    n = s // c
    log_g = jnp.log(1.0 - 2.0 ** (-5.0 - jnp.arange(h, dtype=jnp.float32)))
    k = k * dk ** -0.5
    qc = q.reshape(b, h, n, c, dk)
    kc = k.reshape(b, h, n, c, dk)
    vc = v.reshape(b, h, n, c, dv)
    pos = jnp.arange(c, dtype=jnp.float32)
    diff = pos[:, None] - pos[None, :]
    causal = diff >= 0
    decay_mask = jnp.where(causal, jnp.exp(log_g[:, None, None] * jnp.where(causal, diff, 0.0)), 0.0)
    inner = jnp.einsum('bhnik,bhnjk->bhnij', qc, kc) * decay_mask[None, :, None]
    o_inner = jnp.einsum('bhnij,bhnjv->bhniv', inner, vc)
    to_end = jnp.exp(log_g[:, None] * (c - 1.0 - pos)[None, :])
    kv = jnp.einsum('bhnjk,bhnjv->nbhkv', kc * to_end[None, :, None, :, None], vc)
    chunk_decay = jnp.exp(log_g * c)[None, :, None, None]

    def step(state, kv_n):
        return chunk_decay * state + kv_n, state

    _, prev = lax.scan(step, jnp.zeros((b, h, dk, dv), jnp.float32), kv)
    from_start = jnp.exp(log_g[:, None] * (pos + 1.0)[None, :])
    o_cross = jnp.einsum('bhnik,nbhkv->bhniv', qc, prev) * from_start[None, :, None, :, None]
    return (o_inner + o_cross).reshape(b, h, s, dv)


def causal_depthwise_conv(x, w):
    kw, ch = w.shape
    return lax.conv_general_dilated(x, w[:, None, :], window_strides=(1,), padding=[(kw - 1, 0)],
                                    dimension_numbers=('NWC', 'WIO', 'NWC'), feature_group_count=ch)


def gated_delta_rule(q, k, v, g, beta):
    b, h, s, dk = q.shape
    dv = v.shape[-1]
    c = GDN_CHUNK
    n = s // c
    q = q * dk ** -0.5
    qc = q.reshape(b, h, n, c, dk)
    kc = k.reshape(b, h, n, c, dk)
    vc = v.reshape(b, h, n, c, dv)
    bc = beta.reshape(b, h, n, c)
    G = jnp.cumsum(g.reshape(b, h, n, c), axis=-1)
    idx = jnp.arange(c)
    lower_incl = idx[:, None] >= idx[None, :]
    strict = idx[:, None] > idx[None, :]
    seg = G[..., :, None] - G[..., None, :]
    L = jnp.where(lower_incl, jnp.exp(jnp.where(lower_incl, seg, 0.0)), 0.0)
    A = jnp.where(strict, jnp.einsum('bhnik,bhnjk->bhnij', kc, kc) * L * bc[..., :, None], 0.0)
    M = jnp.eye(c, dtype=jnp.float32) + A
    rhs = jnp.concatenate([kc * (bc * jnp.exp(G))[..., None], vc * bc[..., None]], axis=-1)
    sol = lax.linalg.triangular_solve(M, rhs, left_side=True, lower=True, unit_diagonal=True)
    w_c, u_c = sol[..., :dk], sol[..., dk:]
    q_dec = qc * jnp.exp(G)[..., None]
    a_qk = jnp.einsum('bhnik,bhnjk->bhnij', qc, kc) * L
    g_last = G[..., -1]
    k_tail = kc * jnp.exp(g_last[..., None] - G)[..., None]
    xs = (jnp.moveaxis(q_dec, 2, 0), jnp.moveaxis(a_qk, 2, 0), jnp.moveaxis(w_c, 2, 0),
          jnp.moveaxis(u_c, 2, 0), jnp.moveaxis(k_tail, 2, 0), jnp.moveaxis(g_last, 2, 0))

    def step(S, inp):
        dq, aqk, wn, un, kt, gl = inp
        v_new = un - jnp.einsum('bhck,bhkv->bhcv', wn, S)
        o = jnp.einsum('bhck,bhkv->bhcv', dq, S) + jnp.einsum('bhij,bhjv->bhiv', aqk, v_new)
        S = S * jnp.exp(gl)[..., None, None] + jnp.einsum('bhck,bhcv->bhkv', kt, v_new)
        return S, o

    _, o = lax.scan(step, jnp.zeros((b, h, dk, dv), jnp.float32), xs)
    return jnp.moveaxis(o, 0, 2).reshape(b, h, s, dv)


def alibi_slopes(n):
    return 2.0 ** (-8.0 * (jnp.arange(n, dtype=jnp.float32) + 1.0) / n)


def diff_attention(q, k, v, lam):
    b, h, _, s, dk = q.shape
    scale = dk ** -0.5
    slopes = alibi_slopes(h)[:, None, None, None]
    outs = []
    for i in range(s // Q_BLOCK):
        lo, hi = i * Q_BLOCK, (i + 1) * Q_BLOCK
        dist = (jnp.arange(lo, hi)[:, None] - jnp.arange(hi)[None, :]).astype(jnp.float32)
        sc = jnp.einsum('bhmqd,bhmkd->bhmqk', q[:, :, :, lo:hi], k[:, :, :, :hi]) * scale - slopes * dist
        sc = jnp.where(dist >= 0, sc, -jnp.inf)
        p = jax.nn.softmax(sc, axis=-1)
        a = p[:, :, 0] - lam * p[:, :, 1]
        outs.append(jnp.einsum('bhqk,bhkv->bhqv', a, v[:, :, :hi]))
    return jnp.concatenate(outs, axis=2)


def hybrid_mixer(xn, w_in, conv_w, a_log, dt_bias, gdn_norm_w, lam_vecs, diff_norm_w, w_branch, w_out, lambda_init):
    b, s, _ = xn.shape
    proj = (xn @ w_in).astype(jnp.float32)
    (rq, rk, rv, rg, bqkv, bz, bb, ba, cq, ck, cv, gates) = jnp.split(proj, split_points(IN_SIZES), axis=-1)

    o_a = retention(split_heads(rq, RET_HEADS), split_heads(rk, RET_HEADS), split_heads(rv, RET_HEADS))
    o_a = merge_heads(head_layer_norm(o_a)) * jax.nn.silu(rg)

    qkv = jax.nn.silu(causal_depthwise_conv(bqkv, conv_w.astype(jnp.float32)))
    bq, bk, bv = jnp.split(qkv, [GDN_QK, 2 * GDN_QK], axis=-1)
    beta = jax.nn.sigmoid(bb).transpose(0, 2, 1)
    g = (-jnp.exp(a_log.astype(jnp.float32)) * jax.nn.softplus(ba + dt_bias.astype(jnp.float32))).transpose(0, 2, 1)
    o_b = gated_delta_rule(l2_normalize(split_heads(bq, GDN_HEADS)), l2_normalize(split_heads(bk, GDN_HEADS)),
                           split_heads(bv, GDN_HEADS), g, beta)
    o_b = merge_heads(rms_norm(o_b, gdn_norm_w)) * jax.nn.silu(bz)

    q2 = cq.reshape(b, s, DIFF_HEADS, 2, DIFF_DK).transpose(0, 2, 3, 1, 4)
    k2 = ck.reshape(b, s, DIFF_HEADS, 2, DIFF_DK).transpose(0, 2, 3, 1, 4)
    lv = lam_vecs.astype(jnp.float32)
    lam = jnp.exp(jnp.sum(lv[0] * lv[1])) - jnp.exp(jnp.sum(lv[2] * lv[3])) + lambda_init
    o_c = diff_attention(q2, k2, split_heads(cv, DIFF_HEADS), lam)
    o_c = merge_heads(rms_norm(o_c, diff_norm_w) * (1.0 - lambda_init))

    ga, gb, gc = jnp.split(jax.nn.sigmoid(gates), 3, axis=-1)
    wa, wb, wc = jnp.split(w_branch, [RET_V, RET_V + GDN_V], axis=0)
    merged = ga * (o_a @ wa) + gb * (o_b @ wb) + gc * (o_c @ wc)
    return (merged @ w_out).astype(xn.dtype)


def memory_cross_attention(xn, mem_n, w_q, w_kv, w_o):
    q = split_heads(xn @ w_q, MEM_HEADS)
    k, v = jnp.split(mem_n @ w_kv, 2, axis=-1)
    k, v = split_heads(k, MEM_HEADS), split_heads(v, MEM_HEADS)
    sc = jnp.einsum('bhqd,bhkd->bhqk', q, k).astype(jnp.float32) * MEM_DH ** -0.5
    p = jax.nn.softmax(sc, axis=-1)
    o = jnp.einsum('bhqk,bhkd->bhqd', p, v.astype(jnp.float32))
    return (merge_heads(o) @ w_o).astype(xn.dtype)


def swiglu(x, w_gu, w_down):
    a, u = jnp.split(x @ w_gu, 2, axis=-1)
    return (jax.nn.silu(a) * u) @ w_down


def moe_swiglu(x, w_router, w_gu, w_down):
    b, s, d = x.shape
    xf = x.reshape(b * s, d)
    logits = (xf @ w_router).astype(jnp.float32)
    top_val, top_idx = lax.top_k(logits, TOP_K)
    top_w = jax.nn.softmax(top_val, axis=-1)
    combine = jnp.sum(jax.nn.one_hot(top_idx, N_EXPERTS, dtype=jnp.float32) * top_w[..., None], axis=1)
    out = jnp.zeros((b * s, d), jnp.float32)
    for e in range(N_EXPERTS):
        out = out + combine[:, e:e + 1] * swiglu(xf, w_gu[e], w_down[e])
    return out.reshape(b, s, d).astype(x.dtype)


def _normal(key, shape, fan_in):
    return jax.random.normal(key, shape, jnp.float32) * fan_in ** -0.5


def _gain(key, shape):
    return 1.0 + 0.02 * jax.random.normal(key, shape, jnp.float32)


def setup_inputs(seed: int = 0) -> dict:
    key = jax.random.key(seed)
    ks = jax.random.split(key, 26)
    dt = jnp.exp(jax.random.uniform(ks[5], (DEPTH, GDN_HEADS), jnp.float32, math.log(1e-3), math.log(1e-1)))
    return {
        "x": jax.random.normal(ks[0], (BATCH, SEQ, D_MODEL), jnp.float32),
        "mem": jax.random.normal(ks[1], (BATCH, MEM_LEN, D_MODEL), jnp.float32),
        "w_in": _normal(ks[2], (DEPTH, D_MODEL, IN_WIDTH), D_MODEL),
        "conv_w": _normal(ks[3], (DEPTH, GDN_CONV, GDN_QKV), GDN_CONV),
        "gdn_a_log": jnp.log(jax.random.uniform(ks[4], (DEPTH, GDN_HEADS), jnp.float32, 1.0, 16.0)),
        "gdn_dt_bias": dt + jnp.log(-jnp.expm1(-dt)),
        "gdn_norm_w": _gain(ks[6], (DEPTH, GDN_DV)),
        "diff_lambda": 0.1 * jax.random.normal(ks[7], (DEPTH, 4, DIFF_DK), jnp.float32),
        "diff_norm_w": _gain(ks[8], (DEPTH, DIFF_DV)),
        "w_branch": _normal(ks[9], (DEPTH, BRANCH_W, D_MODEL), RET_V),
        "w_out": _normal(ks[10], (DEPTH, D_MODEL, D_MODEL), D_MODEL),
        "mix_norm_w": _gain(ks[11], (DEPTH, D_MODEL)),
        "mem_norm_w": _gain(ks[12], (DEPTH, D_MODEL)),
        "cross_norm_w": _gain(ks[13], (DEPTH, D_MODEL)),
        "cross_w_q": _normal(ks[14], (DEPTH, D_MODEL, MEM_HEADS * MEM_DH), D_MODEL),
        "cross_w_kv": _normal(ks[15], (DEPTH, D_MODEL, 2 * MEM_HEADS * MEM_DH), D_MODEL),
        "cross_w_o": _normal(ks[16], (DEPTH, MEM_HEADS * MEM_DH, D_MODEL), MEM_HEADS * MEM_DH),
        "ffn_norm_w": _gain(ks[17], (DEPTH, D_MODEL)),
        "dense_w_gu": _normal(ks[18], (N_DENSE, D_MODEL, 2 * D_FF), D_MODEL),
        "dense_w_down": _normal(ks[19], (N_DENSE, D_FF, D_MODEL), D_FF),
        "router_w": _normal(ks[20], (N_MOE, D_MODEL, N_EXPERTS), D_MODEL),
        "expert_w_gu": _normal(ks[21], (N_MOE, N_EXPERTS, D_MODEL, 2 * EXPERT_FF), D_MODEL),
        "expert_w_down": _normal(ks[22], (N_MOE, N_EXPERTS, EXPERT_FF, D_MODEL), EXPERT_FF),
        "final_norm_w": _gain(ks[23], (D_MODEL,)),
    }


def reference(x, mem, w_in, conv_w, gdn_a_log, gdn_dt_bias, gdn_norm_w, diff_lambda, diff_norm_w,
              w_branch, w_out, mix_norm_w, mem_norm_w, cross_norm_w, cross_w_q, cross_w_kv, cross_w_o,
              ffn_norm_w, dense_w_gu, dense_w_down, router_w, expert_w_gu, expert_w_down, final_norm_w):
    for l in range(DEPTH):
        lambda_init = 0.8 - 0.6 * math.exp(-0.3 * l)
        h = rms_norm(x, mix_norm_w[l])
        x = x + hybrid_mixer(h, w_in[l], conv_w[l], gdn_a_log[l], gdn_dt_bias[l], gdn_norm_w[l],
                             diff_lambda[l], diff_norm_w[l], w_branch[l], w_out[l], lambda_init).astype(x.dtype)
        h = rms_norm(x, cross_norm_w[l])
        m = rms_norm(mem, mem_norm_w[l])
        x = x + memory_cross_attention(h, m, cross_w_q[l], cross_w_kv[l], cross_w_o[l]).astype(x.dtype)
        h = rms_norm(x, ffn_norm_w[l])
        if l % 2 == 0:
            x = x + swiglu(h, dense_w_gu[l // 2], dense_w_down[l // 2]).astype(x.dtype)
        else:
            x = x + moe_swiglu(h, router_w[l // 2], expert_w_gu[l // 2], expert_w_down[l // 2]).astype(x.dtype)
    return rms_norm(x, final_norm_w)
```

```cpp
#include <hip/hip_runtime.h>
#include <cstdio>
#include <cstdint>
#define MK_ONE_LAUNCH 0
namespace pg8 {
#define PG8_LAS __attribute__((address_space(3)))
typedef unsigned short bf16_t;
typedef short bf16x8 __attribute__((ext_vector_type(8)));
typedef float f32x4 __attribute__((ext_vector_type(4)));
typedef unsigned u32x4 __attribute__((ext_vector_type(4)));
constexpr int BM = 256, BK = 64, HALF = 128, HTB = HALF * BK * 2  , STAGE_BYTES = 8 * HTB, NXCD = 8, WGM = 8;

__host__ __device__ __forceinline__ int lds_byte(int r, int c) { const int st = (r >> 4) * 2 + (c >> 5), rr = r & 15, cc = c & 31, ob = rr * 64 + cc * 2; return st * 1024 + (ob ^ (((ob >> 9) & 1) << 5)); }
__host__ __device__ __forceinline__ void stage_rc(int b, int& R, int& C) { const int st = b / 1024, sb = b % 1024, swz = sb ^ (((sb >> 9) & 1) << 5); R = (st >> 1) * 16 + swz / 64; C = (st & 1) * 32 + (swz % 64) / 2; }
__host__ __device__ __forceinline__ int perm32(int rho) { const int n = rho >> 4, i = rho & 15; return 8 * (i >> 2) + 4 * n + (i & 3); }

struct Unit { int pm, pn; };
struct Gemm { const bf16_t* A; const bf16_t* Bt; int M, N, K; };

struct StaticOrder {
    int nM, nN, nwg, G, c;
    __host__ __device__ void init(int M, int N, int G_, int c_) { nM = M / BM; nN = N / BM; nwg = nM * nN; G = G_; c = c_; }
    __host__ __device__ bool next(int i, Unit& u) const {
        const long L = (long)i * G + c; if (L >= nwg) return false;
        int wgid = (int)L; { const int q = nwg / NXCD, r = nwg % NXCD, xcd = wgid % NXCD, off = wgid / NXCD; wgid = (xcd < r ? xcd * (q + 1) : r * (q + 1) + (xcd - r) * q) + off; }
        const int nig = WGM * nN, gid = wgid / nig, fm = gid * WGM, gsz = (nM - fm) < WGM ? (nM - fm) : WGM;
        u.pm = fm + ((wgid % nig) % gsz); u.pn = (wgid % nig) / gsz; return true;
    }
    __device__ __forceinline__ void a_ready(const Unit&) const {}
    __device__ __forceinline__ void done(const Unit&) const {}
};

__device__ __forceinline__ unsigned cvt_pk_bf16(float lo, float hi) { unsigned r; asm volatile("v_cvt_pk_bf16_f32 %0, %1, %2" : "=v"(r) : "v"(lo), "v"(hi)); return r; }
typedef float f32x2 __attribute__((ext_vector_type(2)));
__device__ __forceinline__ float fsilu(float v) { return v / (1.0f + __expf(-v)); }
__device__ __forceinline__ float fsigm(float v) { return 1.0f / (1.0f + __expf(-v)); }
__device__ __forceinline__ void st8bf(bf16_t* p, f32x4 v0, f32x4 v1) { u32x4 w; w.x = cvt_pk_bf16(v0[0], v0[1]); w.y = cvt_pk_bf16(v0[2], v0[3]); w.z = cvt_pk_bf16(v1[0], v1[1]); w.w = cvt_pk_bf16(v1[2], v1[3]); *(u32x4*)p = w; }
__device__ __forceinline__ bf16_t f2bf1(float f) { unsigned u = __builtin_bit_cast(unsigned, f); return (bf16_t)((u + 0x7fffu + ((u >> 16) & 1u)) >> 16); }

struct EpiIn {
    static constexpr bool PERM = true, AFTER_DRAIN = false;
    bf16_t *RQ, *RK, *RV, *RG, *BQKV, *BZ, *CQ, *CK, *CVT, *GATES; float* BBA;
    __device__ __forceinline__ void operator()(const f32x4 (&acc)[2][2][4][2], const Unit& u, int wr, int wc, int fr, int fq) const {
        const int pn = u.pn, b = u.pm >> 3;
        const int rowt = u.pm * BM + wr * 64 + fr;
        const int cin = wc * 32 + 8 * fq;
        if (pn < 12 || (pn >= 32 && pn < 40)) {
            auto heads = [&](bf16_t* base, int hb, float sc) __attribute__((always_inline)) {
#pragma unroll
                for (int ai = 0; ai < 2; ++ai)
#pragma unroll
                    for (int m = 0; m < 4; ++m) { const int s = (rowt + ai * HALF + m * 16) - b * 2048;
#pragma unroll
                        for (int bj = 0; bj < 2; ++bj) st8bf(base + ((size_t)((b * 8 + hb + bj) * 2048 + s)) * 128 + cin, acc[ai][bj][m][0] * sc, acc[ai][bj][m][1] * sc); } };
            if (pn < 4) heads(RQ, pn * 2, 1.f); else if (pn < 8) heads(RK, (pn - 4) * 2, 0.08838834764831845f); else if (pn < 12) heads(RV, (pn - 8) * 2, 1.f);
            else if (pn < 36) heads(CQ, (pn - 32) * 2, 1.f); else heads(CK, (pn - 36) * 2, 1.f);
        } else if (pn >= 40 && pn < 44) {
            const int h = pn - 40;
#pragma unroll
            for (int ai = 0; ai < 2; ++ai)
#pragma unroll
                for (int m = 0; m < 4; ++m) { const int s = (rowt + ai * HALF + m * 16) - b * 2048;
#pragma unroll
                    for (int bj = 0; bj < 2; ++bj)
#pragma unroll
                        for (int n = 0; n < 2; ++n)
#pragma unroll
                            for (int e = 0; e < 4; ++e) CVT[((size_t)((b * 4 + h) * 256 + bj * HALF + cin + 4 * n + e)) * 2048 + s] = f2bf1(acc[ai][bj][m][n][e]); }
        } else if (pn == 68) {
            if (wc == 0 && fq < 2) {
#pragma unroll
                for (int ai = 0; ai < 2; ++ai)
#pragma unroll
                    for (int m = 0; m < 4; ++m) { float* p = BBA + (size_t)(rowt + ai * HALF + m * 16) * 16 + 8 * fq; *(f32x4*)p = acc[ai][0][m][0]; *(f32x4*)(p + 4) = acc[ai][0][m][1]; }
            }
        } else {
            auto rows = [&](bf16_t* base, int ldc, int c0, int act) __attribute__((always_inline)) {
#pragma unroll
                for (int ai = 0; ai < 2; ++ai)
#pragma unroll
                    for (int m = 0; m < 4; ++m) { bf16_t* rowp = base + (size_t)(rowt + ai * HALF + m * 16) * ldc + c0 + cin;
#pragma unroll
                        for (int bj = 0; bj < 2; ++bj) { f32x4 v0 = acc[ai][bj][m][0], v1 = acc[ai][bj][m][1];
                            if (act == 1) {
#pragma unroll
                                for (int e = 0; e < 4; ++e) { v0[e] = fsilu(v0[e]); v1[e] = fsilu(v1[e]); } }
                            else if (act == 2) {
#pragma unroll
                                for (int e = 0; e < 4; ++e) { v0[e] = fsigm(v0[e]); v1[e] = fsigm(v1[e]); } }
                            st8bf(rowp + bj * HALF, v0, v1); } } };
            if (pn < 16) rows(RG, 1024, (pn - 12) * 256, 1); else if (pn < 28) rows(BQKV, 3072, (pn - 16) * 256, 0);
            else if (pn < 32) rows(BZ, 1024, (pn - 28) * 256, 1); else rows(GATES, 6144, (pn - 44) * 256, 2);
        }
    }
};

struct EpiHeads {
    static constexpr bool PERM = true, AFTER_DRAIN = false;
    bf16_t* O; bf16_t* VT; int NH, rpb_shift  , vt_from_pn;
    __device__ __forceinline__ void operator()(const f32x4 (&acc)[2][2][4][2], const Unit& u, int wr, int wc, int fr, int fq) const {
        const int rowt = u.pm * BM + wr * 64 + fr, cin = wc * 32 + 8 * fq, rpb = 1 << rpb_shift;
        if (u.pn < vt_from_pn) {
#pragma unroll
            for (int ai = 0; ai < 2; ++ai)
#pragma unroll
                for (int m = 0; m < 4; ++m) { const int row = rowt + ai * HALF + m * 16, b = row >> rpb_shift, s = row & (rpb - 1);
#pragma unroll
                    for (int bj = 0; bj < 2; ++bj) st8bf(O + ((size_t)((b * NH + u.pn * 2 + bj) * rpb + s)) * 128 + cin, acc[ai][bj][m][0], acc[ai][bj][m][1]); }
        } else {
            const int hb = (u.pn - vt_from_pn) * 2;
#pragma unroll
            for (int ai = 0; ai < 2; ++ai)
#pragma unroll
                for (int m = 0; m < 4; ++m) { const int row = rowt + ai * HALF + m * 16, b = row >> rpb_shift, s = row & (rpb - 1);
#pragma unroll
                    for (int bj = 0; bj < 2; ++bj)
#pragma unroll
                        for (int n = 0; n < 2; ++n)
#pragma unroll
                            for (int e = 0; e < 4; ++e) VT[((size_t)((b * NH + hb + bj) * 128 + cin + 4 * n + e)) * rpb + s] = f2bf1(acc[ai][bj][m][n][e]); }
        }
    }
};

struct EpiResid {
    static constexpr bool PERM = false, AFTER_DRAIN = false;
    const float* in; float* out; int ldc;
    __device__ __forceinline__ void operator()(const f32x4 (&acc)[2][2][4][2], const Unit& u, int wr, int wc, int fr, int fq) const {
        const int row0 = u.pm * BM + wr * 64 + fr, col0 = u.pn * BM + wc * 32 + 4 * fq;
#pragma unroll
        for (int ai = 0; ai < 2; ++ai)
#pragma unroll
            for (int m = 0; m < 4; ++m) { const size_t off = (size_t)(row0 + ai * HALF + m * 16) * ldc + col0;
#pragma unroll
                for (int bj = 0; bj < 2; ++bj)
#pragma unroll
                    for (int n = 0; n < 2; ++n) { const f32x4 x = *(const f32x4*)(in + off + bj * HALF + n * 16); *(f32x4*)(out + off + bj * HALF + n * 16) = x + acc[ai][bj][m][n]; } }
    }
};

struct EpiBranch {
    static constexpr bool PERM = false, AFTER_DRAIN = false;
    float* M; bf16_t* OUT; const bf16_t* GATES; int seg;
    __device__ __forceinline__ void operator()(const f32x4 (&acc)[2][2][4][2], const Unit& u, int wr, int wc, int fr, int fq) const {
        typedef unsigned u32x2 __attribute__((ext_vector_type(2)));
        const int row0 = u.pm * BM + wr * 64 + fr, col0 = u.pn * BM + wc * 32 + 4 * fq;
#pragma unroll
        for (int ai = 0; ai < 2; ++ai)
#pragma unroll
            for (int m = 0; m < 4; ++m) { const int row = row0 + ai * HALF + m * 16;
#pragma unroll
                for (int bj = 0; bj < 2; ++bj)
#pragma unroll
                    for (int n = 0; n < 2; ++n) { const int col = col0 + bj * HALF + n * 16; const size_t off = (size_t)row * 2048 + col;
                        const u32x2 gw = *(const u32x2*)(GATES + (size_t)row * 6144 + seg * 2048 + col);
                        f32x4 g; g[0] = __uint_as_float(gw.x << 16); g[1] = __uint_as_float(gw.x & 0xffff0000u); g[2] = __uint_as_float(gw.y << 16); g[3] = __uint_as_float(gw.y & 0xffff0000u);
                        f32x4 v = g * acc[ai][bj][m][n];
                        if (seg > 0) v = v + *(const f32x4*)(M + off);
                        if (seg < 2) *(f32x4*)(M + off) = v;
                        else { u32x2 w; w.x = cvt_pk_bf16(v[0], v[1]); w.y = cvt_pk_bf16(v[2], v[3]); *(u32x2*)(OUT + off) = w; } } }
    }
};

struct EpiSwiglu {
    static constexpr bool PERM = true, AFTER_DRAIN = false;
    bf16_t* O; int ldc, npn;
    __device__ __forceinline__ void operator()(const f32x4 (&acc)[2][2][4][2], const Unit& u, int wr, int wc, int fr, int fq) const {
        const int row0 = u.pm * BM + wr * 64 + fr, col0 = (u.pn % npn) * HALF + wc * 32 + 8 * fq;
#pragma unroll
        for (int ai = 0; ai < 2; ++ai)
#pragma unroll
            for (int m = 0; m < 4; ++m) { f32x4 v0, v1;
#pragma unroll
                for (int e = 0; e < 4; ++e) { v0[e] = fsilu(acc[ai][0][m][0][e]) * acc[ai][1][m][0][e]; v1[e] = fsilu(acc[ai][0][m][1][e]) * acc[ai][1][m][1][e]; }
                st8bf(O + (size_t)(row0 + ai * HALF + m * 16) * ldc + col0, v0, v1); }
    }
};

struct EpiStoreF32 {
    static constexpr bool PERM = false, AFTER_DRAIN = false;
    float* Y; int ldc, npn;
    __device__ __forceinline__ void operator()(const f32x4 (&acc)[2][2][4][2], const Unit& u, int wr, int wc, int fr, int fq) const {
        const int row0 = u.pm * BM + wr * 64 + fr, col0 = (u.pn % npn) * BM + wc * 32 + 4 * fq;
#pragma unroll
        for (int ai = 0; ai < 2; ++ai)
#pragma unroll
            for (int m = 0; m < 4; ++m) { float* rowp = Y + (size_t)(row0 + ai * HALF + m * 16) * ldc + col0;
#pragma unroll
                for (int bj = 0; bj < 2; ++bj)
#pragma unroll
                    for (int n = 0; n < 2; ++n) *(f32x4*)(rowp + bj * HALF + n * 16) = acc[ai][bj][m][n]; }
    }
};

struct MoeOrder {
    const PG8_LAS int* T; int npn, G, c;
    __device__ __forceinline__ bool next(int i, Unit& u) const {
        const int total = T[25]; const long L = (long)i * G + c; if (L >= total) return false;
        int wgid = (int)L; { const int q = total / NXCD, r = total % NXCD, xcd = wgid % NXCD, off = wgid / NXCD; wgid = (xcd < r ? xcd * (q + 1) : r * (q + 1) + (xcd - r) * q) + off; }
        int e = 0;
#pragma unroll
        for (int k = 1; k < 8; ++k) if (wgid >= T[16 + k]) e = k;
        const int loc = wgid - T[16 + e], ne = T[e];
        u.pm = T[8 + e] + loc % ne; u.pn = e * npn + loc / ne; return true;
    }
    __device__ __forceinline__ void a_ready(const Unit&) const {}
    __device__ __forceinline__ void done(const Unit&) const {}
};
template <class Epi, class Sched, bool ALIGN_EPI = false, bool SP2 = false>
__device__ __forceinline__ void gemm_phase(PG8_LAS unsigned char* lds, const Gemm g, const Sched& S, const Epi& E) {
    int tid_ = threadIdx.x; asm volatile("" : "+v"(tid_)); const int tid = tid_, wid = __builtin_amdgcn_readfirstlane(tid >> 6), lane = tid & 63, wr = wid >> 2, wc = wid & 3, fr = lane & 15, fq = lane >> 4;
    const int K = g.K, nt = K / BK;
    unsigned voffA[2], voffB[2];
#pragma unroll
    for (int i = 0; i < 2; ++i) { int R, C; stage_rc(tid * 16 + i * 8192, R, C); const int Rb = Epi::PERM ? ((R & ~31) + perm32(R & 31)) : R;
        voffA[i] = (unsigned)(R * K + C) * 2u; voffB[i] = (unsigned)(Rb * K + C) * 2u; }
    const size_t kstep = (size_t)(BK * 2);
    const size_t hstep = (size_t)HALF * K * 2;
    const size_t tstep = 2 * hstep;
    const unsigned ldsw = (unsigned)wid * 1024u;
    const int aoff = lds_byte(wr * 64 + fr, fq * 8), boff = lds_byte(wc * 32 + fr, fq * 8);
#define PG8_SA(b, h) (((b) * 2 + (h)) * HTB)
#define PG8_SB(b, h) ((4 + (b) * 2 + (h)) * HTB)
#define PG8_STAGE(bufoff, gbase, voff) do { _Pragma("unroll") for (int _i = 0; _i < 2; ++_i) \
        __builtin_amdgcn_global_load_lds((const unsigned*)((const char*)(gbase) + (voff)[_i]), (PG8_LAS unsigned*)(lds + (bufoff) + ldsw + _i * 8192), 16, 0, 0); } while (0)
#define PG8_LDA(dst, b, h) do { _Pragma("unroll") for (int m = 0; m < 4; ++m) _Pragma("unroll") for (int k = 0; k < 2; ++k) dst[m][k] = *(const PG8_LAS bf16x8*)(lds + PG8_SA(b, h) + aoff + m * 2048 + k * 1024); } while (0)
#define PG8_LDB(dst, b, h) do { _Pragma("unroll") for (int n = 0; n < 2; ++n) _Pragma("unroll") for (int k = 0; k < 2; ++k) dst[n][k] = *(const PG8_LAS bf16x8*)(lds + PG8_SB(b, h) + boff + n * 2048 + k * 1024); } while (0)
#define PG8_MMA(ai, bj, At, Bt) do { __builtin_amdgcn_s_setprio(1); _Pragma("unroll") for (int m = 0; m < 4; ++m) _Pragma("unroll") for (int n = 0; n < 2; ++n) _Pragma("unroll") for (int k = 0; k < 2; ++k) \
        acc[ai][bj][m][n] = __builtin_amdgcn_mfma_f32_16x16x32_bf16(Bt[n][k], At[m][k], acc[ai][bj][m][n], 0, 0, 0); __builtin_amdgcn_s_setprio(0); } while (0)
#define PG8_WAIT_V(n) asm volatile("s_waitcnt vmcnt(" #n ")" ::: "memory")
#define PG8_WAIT_L(n) asm volatile("s_waitcnt lgkmcnt(" #n ")" ::: "memory")
#define PG8_BAR __builtin_amdgcn_s_barrier()
#define PG8_SCHED __builtin_amdgcn_sched_barrier(0)
    Unit cur, nxt; int ui = 0;
    if (!S.next(0, cur)) return;
    f32x4 acc[2][2][4][2];
#pragma unroll
    for (int a = 0; a < 2; ++a)
#pragma unroll
        for (int b = 0; b < 2; ++b)
#pragma unroll
            for (int m = 0; m < 4; ++m)
#pragma unroll
                for (int n = 0; n < 2; ++n) acc[a][b][m][n] = (f32x4){0.f, 0.f, 0.f, 0.f};
    bf16x8 At[4][2], B0[2][2], B1[2][2];
    const char* cA = (const char*)g.A + (size_t)cur.pm * tstep; const char* cB = (const char*)g.Bt + (size_t)cur.pn * tstep;
    S.a_ready(cur);
    if constexpr (SP2) {
        PG8_STAGE(PG8_SB(0, 0), cB, voffB); PG8_STAGE(PG8_SB(0, 1), cB + hstep, voffB); PG8_STAGE(PG8_SA(0, 0), cA, voffA); PG8_STAGE(PG8_SA(0, 1), cA + hstep, voffA);
        if (wr == 1) PG8_BAR;
        PG8_WAIT_V(2); PG8_BAR;
        PG8_STAGE(PG8_SB(1, 0), cB + kstep, voffB); PG8_STAGE(PG8_SA(1, 0), cA + kstep, voffA); PG8_STAGE(PG8_SB(1, 1), cB + hstep + kstep, voffB);
        PG8_WAIT_V(6); PG8_BAR;
    } else {
        PG8_STAGE(PG8_SB(0, 0), cB, voffB); PG8_STAGE(PG8_SA(0, 0), cA, voffA); PG8_STAGE(PG8_SB(0, 1), cB + hstep, voffB); PG8_STAGE(PG8_SA(0, 1), cA + hstep, voffA);
        if (wr == 1) PG8_BAR;
        PG8_WAIT_V(4); PG8_BAR;
        PG8_STAGE(PG8_SB(1, 0), cB + kstep, voffB); PG8_STAGE(PG8_SA(1, 0), cA + kstep, voffA); PG8_STAGE(PG8_SB(1, 1), cB + hstep + kstep, voffB);
        PG8_WAIT_V(6); PG8_BAR;
    }
    for (;;) {
        const bool has_next = S.next(ui + 1, nxt);
        const char* nA = has_next ? (const char*)g.A + (size_t)nxt.pm * tstep : cA; const char* nB = has_next ? (const char*)g.Bt + (size_t)nxt.pn * tstep : cB;
        for (int t = 0; t < nt; t += 2) {
            const bool last = (t == nt - 2);
            const char* a1 = cA + (size_t)(t + 1) * kstep;
            const char* a2 = last ? nA : cA + (size_t)(t + 2) * kstep; const char* b2 = last ? nB : cB + (size_t)(t + 2) * kstep;
            const char* a3 = a2 + kstep; const char* b3 = b2 + kstep;
            if (last && has_next) S.a_ready(nxt);
            if constexpr (SP2) {
            PG8_LDB(B0, 0, 0); PG8_LDB(B1, 0, 1); PG8_SCHED; PG8_LDA(At, 0, 0); PG8_STAGE(PG8_SA(1, 1), a1 + hstep, voffA);
            PG8_WAIT_V(8); PG8_WAIT_L(0); PG8_BAR; PG8_MMA(0, 0, At, B0); PG8_MMA(0, 1, At, B1); PG8_BAR; PG8_SCHED;
            PG8_LDA(At, 0, 1); PG8_STAGE(PG8_SB(0, 0), b2, voffB); PG8_STAGE(PG8_SB(0, 1), b2 + hstep, voffB); PG8_STAGE(PG8_SA(0, 0), a2, voffA);
            PG8_WAIT_V(8); PG8_WAIT_L(0); PG8_BAR; PG8_MMA(1, 0, At, B0); PG8_MMA(1, 1, At, B1); PG8_BAR; PG8_SCHED;
            PG8_LDB(B0, 1, 0); PG8_LDB(B1, 1, 1); PG8_SCHED; PG8_LDA(At, 1, 0); PG8_STAGE(PG8_SA(0, 1), a2 + hstep, voffA);
            PG8_WAIT_V(8); PG8_WAIT_L(0); PG8_BAR; PG8_MMA(0, 0, At, B0); PG8_MMA(0, 1, At, B1); PG8_BAR; PG8_SCHED;
            PG8_LDA(At, 1, 1); PG8_STAGE(PG8_SB(1, 0), b3, voffB); PG8_STAGE(PG8_SB(1, 1), b3 + hstep, voffB); PG8_STAGE(PG8_SA(1, 0), a3, voffA);
            PG8_WAIT_V(8); PG8_WAIT_L(0); PG8_BAR; PG8_MMA(1, 0, At, B0); PG8_MMA(1, 1, At, B1); PG8_BAR; PG8_SCHED;
            } else {
            PG8_LDB(B0, 0, 0); PG8_SCHED; PG8_LDA(At, 0, 0); PG8_STAGE(PG8_SA(1, 1), a1 + hstep, voffA);
            PG8_WAIT_L(8); PG8_BAR; PG8_WAIT_L(0); PG8_MMA(0, 0, At, B0); PG8_BAR; PG8_SCHED;
            PG8_LDB(B1, 0, 1); PG8_STAGE(PG8_SB(0, 0), b2, voffB);
            PG8_BAR; PG8_WAIT_L(0); PG8_MMA(0, 1, At, B1); PG8_BAR;
            PG8_LDA(At, 0, 1); PG8_STAGE(PG8_SA(0, 0), a2, voffA);
            PG8_BAR; PG8_WAIT_L(0); PG8_MMA(1, 0, At, B0); PG8_BAR; PG8_SCHED;
            PG8_STAGE(PG8_SB(0, 1), b2 + hstep, voffB);
            PG8_WAIT_V(6); PG8_BAR; PG8_MMA(1, 1, At, B1); PG8_BAR;
            PG8_LDB(B0, 1, 0); PG8_SCHED; PG8_LDA(At, 1, 0); PG8_STAGE(PG8_SA(0, 1), a2 + hstep, voffA);
            PG8_WAIT_L(8); PG8_BAR; PG8_WAIT_L(0); PG8_MMA(0, 0, At, B0); PG8_BAR; PG8_SCHED;
            PG8_LDB(B1, 1, 1); PG8_STAGE(PG8_SB(1, 0), b3, voffB);
            PG8_BAR; PG8_WAIT_L(0); PG8_MMA(0, 1, At, B1); PG8_BAR;
            PG8_LDA(At, 1, 1); PG8_STAGE(PG8_SA(1, 0), a3, voffA);
            PG8_BAR; PG8_WAIT_L(0); PG8_MMA(1, 0, At, B0); PG8_BAR; PG8_SCHED;
            PG8_STAGE(PG8_SB(1, 1), b3 + hstep, voffB);
            PG8_WAIT_V(6); PG8_BAR; PG8_MMA(1, 1, At, B1); PG8_BAR;
            }
        }
        if constexpr (ALIGN_EPI) { if (wr == 0) PG8_BAR; }
        if constexpr (!Epi::AFTER_DRAIN) { E(acc, cur, wr, wc, fr, fq); S.done(cur); }
        if (!has_next) break;
#pragma unroll
        for (int a = 0; a < 2; ++a)
#pragma unroll
            for (int b = 0; b < 2; ++b)
#pragma unroll
                for (int m = 0; m < 4; ++m)
#pragma unroll
                    for (int n = 0; n < 2; ++n) acc[a][b][m][n] = (f32x4){0.f, 0.f, 0.f, 0.f};
        cur = nxt; cA = nA; cB = nB; ++ui;
        if constexpr (ALIGN_EPI) { if (wr == 1) PG8_BAR; }
    }
    PG8_WAIT_V(0);
    if constexpr (!ALIGN_EPI) { if (wr == 0) PG8_BAR; }
    PG8_BAR;
    if constexpr (Epi::AFTER_DRAIN) { E.fused(acc, cur, wr, wc, fr, fq, lds, wid, lane); S.done(cur); }
#undef PG8_SA
#undef PG8_SB
#undef PG8_STAGE
#undef PG8_LDA
#undef PG8_LDB
#undef PG8_MMA
#undef PG8_WAIT_V
#undef PG8_WAIT_L
#undef PG8_BAR
#undef PG8_SCHED
}
}
#ifndef MK_ONE_LAUNCH
#define MK_ONE_LAUNCH 0
#endif
constexpr int NWAVES = 8;
constexpr int NB = 4, SEQ = 2048, T = NB * SEQ, D = 2048, MEML = 256, MEMR = NB * MEML;
constexpr int NINP = 17664;
constexpr int DFF = 5632, EFF = 7168, NEXP = 8, MAXSLOT = 18432;
constexpr float EPS = 1e-6f;
constexpr int NPL = 15, NPH = 2 + 2 * NPL;

constexpr size_t MiB = 1u << 20;
constexpr size_t WS_CTL = 0, CTL_BYTES = 1 * MiB;
constexpr size_t WS_WIN = WS_CTL + CTL_BYTES;
constexpr size_t WS_WBR = WS_WIN + 2 * 69 * MiB;
constexpr size_t WS_WOUT = WS_WBR + 2 * 12 * MiB;
constexpr size_t WS_WQ = WS_WOUT + 2 * 8 * MiB;
constexpr size_t WS_WKV = WS_WQ + 2 * 2 * MiB;
constexpr size_t WS_WO = WS_WKV + 2 * 4 * MiB;
constexpr size_t WS_WGU = WS_WO + 2 * 2 * MiB;
constexpr size_t WS_WDN = WS_WGU + 44 * MiB;
constexpr size_t WS_WEGU = WS_WDN + 22 * MiB;
constexpr size_t WS_WEDN = WS_WEGU + 448 * MiB;
constexpr size_t WS_XRES = WS_WEDN + 224 * MiB;
constexpr size_t WS_H = WS_XRES + 64 * MiB;
constexpr size_t WS_RQ = WS_H + 32 * MiB, WS_RK = WS_RQ + 16 * MiB, WS_RV = WS_RK + 16 * MiB, WS_RG = WS_RV + 16 * MiB;
constexpr size_t WS_BQKV = WS_RG + 16 * MiB;
constexpr size_t WS_BZ = WS_BQKV + 48 * MiB;
constexpr size_t WS_BBA = WS_BZ + 16 * MiB;
constexpr size_t WS_CQ = WS_BBA + 1 * MiB, WS_CK = WS_CQ + 16 * MiB, WS_CVT = WS_CK + 16 * MiB;
constexpr size_t WS_GATES = WS_CVT + 16 * MiB;
constexpr size_t WS_GQ = WS_GATES + 96 * MiB, WS_GK = WS_GQ + 16 * MiB, WS_GV = WS_GK + 16 * MiB;
constexpr size_t WS_GG = WS_GV + 16 * MiB, WS_GB = WS_GG + 1 * MiB;
constexpr size_t WS_OA = WS_GB + 1 * MiB, WS_OB = WS_OA + 32 * MiB;
constexpr size_t WS_O12 = WS_OB + 32 * MiB;
constexpr size_t WS_OCAT = WS_O12 + 64 * MiB;
constexpr size_t WS_MERGE = WS_OCAT + 48 * MiB;
constexpr size_t WS_MERGEB = WS_MERGE + 64 * MiB;
constexpr size_t WS_MEMN = WS_MERGEB + 32 * MiB;
constexpr size_t WS_KX = WS_MEMN + 8 * MiB;
constexpr size_t WS_VXT = WS_KX + 2 * MiB;
constexpr size_t WS_QX = WS_VXT + 2 * MiB;
constexpr size_t WS_OX = WS_QX + 8 * MiB;
constexpr size_t WS_ACT = WS_OX + 8 * MiB;
constexpr size_t WS_HG = WS_ACT + 88 * MiB;
constexpr size_t WS_EACT = WS_HG + 72 * MiB;
constexpr size_t WS_Y = WS_EACT + 252 * MiB;
constexpr size_t WS_ROUTE = WS_Y + 144 * MiB;
constexpr size_t WS_END = WS_ROUTE + 1 * MiB;
constexpr int CW_CNT = 64;
constexpr int CW_BAR = 4096;

constexpr int RING_BYTES = 131072, MISC_OFF = RING_BYTES + 320, LDS_BYTES = 147456;

#define GAS __attribute__((address_space(1)))
#define LAS __attribute__((address_space(3)))
#define DI __device__ __forceinline__
typedef unsigned short bf16;
typedef unsigned v4u __attribute__((ext_vector_type(4)));
typedef unsigned v2u __attribute__((ext_vector_type(2)));
typedef float f32x4 __attribute__((ext_vector_type(4)));
typedef short bf16x8 __attribute__((ext_vector_type(8)));
typedef short s16x4 __attribute__((ext_vector_type(4)));
DI float bf2f(unsigned v) { return __uint_as_float(v << 16); }
DI unsigned f2bf(float f) { unsigned u = __builtin_bit_cast(unsigned, f); return (u + 0x7fffu + ((u >> 16) & 1u)) >> 16; }
DI unsigned pk2(float lo, float hi) { return f2bf(lo) | (f2bf(hi) << 16); }
DI float wave_sum(float v) {
#pragma unroll
    for (int o = 1; o < 64; o <<= 1) v += __shfl_xor(v, o);
    return v;
}

#define XB_TMO      128
#define XB_XCNT(j)  (256  + 64 * (j))
#define XB_XSUB(j)  (1280 + 64 * (j))
#define XB_XGEN(j)  (2304 + 64 * (j))
#define XB_TOP      3328
#define XB_TOPGEN   3392
#define XCD_BAR_WORDS 3456
#define XB_SPIN_CAP (1u << 18)

__device__ __forceinline__ unsigned xb_ld(unsigned* p)              { return __hip_atomic_load(p, __ATOMIC_RELAXED, __HIP_MEMORY_SCOPE_AGENT); }
__device__ __forceinline__ unsigned xb_add(unsigned* p, unsigned v) { return __hip_atomic_fetch_add(p, v, __ATOMIC_RELAXED, __HIP_MEMORY_SCOPE_AGENT); }
__device__ __forceinline__ unsigned xb_xcc_id() { return (unsigned)__builtin_amdgcn_s_getreg((3 << 11) | 20) & 0xFu; }
#define XB_SPIN(cond, bar) do { unsigned _sp = 0; while (cond) { __builtin_amdgcn_s_sleep(1); \
    if ((++_sp & 255u) == 0u) { if (xb_ld(&(bar)[XB_TMO])) break; if (_sp > XB_SPIN_CAP) { atomicAdd(&(bar)[XB_TMO], 1u); break; } } } } while (0)

struct XcdBarrier {
    unsigned* bar; unsigned x;
    volatile LAS unsigned* st;
};

__device__ __forceinline__ XcdBarrier xcd_barrier_post(unsigned* bar, volatile LAS unsigned* st) {
    XcdBarrier b; b.bar = bar; b.x = xb_xcc_id(); b.st = st;
    if (threadIdx.x == 0) (void)xb_add(&bar[XB_XCNT(b.x)], 1u);
    return b;
}
__device__ __forceinline__ void xcd_barrier_complete(unsigned* bar, unsigned x, unsigned& nloc, unsigned& nx) {
    const unsigned G = gridDim.x * gridDim.y * gridDim.z;
    unsigned sum, cnt, mine, sp = 0u;
    for (;;) {
        sum = 0u; cnt = 0u; mine = 0u;
#pragma unroll
        for (unsigned j = 0; j < 16; ++j) { const unsigned c = xb_ld(&bar[XB_XCNT(j)]); sum += c; cnt += (c > 0u) ? 1u : 0u; mine = (j == x) ? c : mine; }
        if (sum == G) break;
        __builtin_amdgcn_s_sleep(1);
        if ((++sp & 255u) == 0u) { if (xb_ld(&bar[XB_TMO])) break; if (sp > XB_SPIN_CAP) { atomicAdd(&bar[XB_TMO], 1u); break; } }
    }
    nloc = mine > 0u ? mine : 1u; nx = cnt > 0u ? cnt : 1u;
}

__device__ __forceinline__ void xcd_barrier(const XcdBarrier& b) {
    asm volatile("s_waitcnt vmcnt(0)" ::: "memory");
    __syncthreads();
    if (threadIdx.x == 0) {
        unsigned* bar = b.bar;
        __builtin_amdgcn_s_waitcnt(0);
        unsigned nloc = b.st[0], nx = b.st[1];
        if (nloc == 0u) { xcd_barrier_complete(bar, b.x, nloc, nx); b.st[0] = nloc; b.st[1] = nx; }
        const unsigned old = xb_add(&bar[XB_XSUB(b.x)], 1u);
        const unsigned gen = old / nloc;
        if (old + 1u == (gen + 1u) * nloc) {
            __builtin_amdgcn_fence(__ATOMIC_RELEASE, "agent");
            asm volatile("s_waitcnt vmcnt(0)" ::: "memory");
            const unsigned og = xb_add(&bar[XB_TOP], 1u);
            const unsigned tg = og / nx;
            if (og + 1u == (tg + 1u) * nx) xb_add(&bar[XB_TOPGEN], 1u);
            else XB_SPIN(xb_ld(&bar[XB_TOPGEN]) == tg, bar);
            __builtin_amdgcn_fence(__ATOMIC_ACQUIRE, "agent");
            xb_add(&bar[XB_XGEN(b.x)], 1u);
            asm volatile("s_waitcnt vmcnt(0)" ::: "memory");
        } else {
            XB_SPIN(xb_ld(&bar[XB_XGEN(b.x)]) == gen, bar);
            __builtin_amdgcn_fence(__ATOMIC_ACQUIRE, "agent");
            asm volatile("s_waitcnt vmcnt(0)" ::: "memory");
        }
    }
    __syncthreads();
}

struct Args { const void* in[24]; float* out; unsigned char* ws; int ph_lo, ph_hi; };

struct Frame {
    LAS unsigned char* lds;
    int tid, lane, wave, G, vcu, gw, NGW;
};

DI void conv_job(const Frame& F, const float* W, int K, int Nsrc, bf16* WT, int Ndst, int mode, int Fgu) {
    LAS unsigned* scr = (LAS unsigned*)(F.lds + F.wave * 8704);
    const int nkb = K / 64, nnb = Ndst / 64, items = nkb * nnb, lane = F.lane;
    for (int it = F.gw; it < items; it += F.NGW) {
        const int nb = it / nkb, kb = it % nkb, k0 = kb * 64, n0 = nb * 64, n = n0 + lane;
        int ns;
        if (mode == 0) ns = n;
        else if (mode == 1) ns = n < 8192 ? n : (n < 17408 ? n + 16 : (n < 17424 ? n - 17408 + 8192 : -1));
        else { const int pn = n >> 8, half = (n >> 7) & 1, j = n & 127; ns = half * Fgu + 128 * pn + j; }
        const float* src = W + (size_t)k0 * Nsrc + (ns < 0 ? 0 : ns);
#pragma unroll 8
        for (int i = 0; i < 32; ++i) { float a = src[(size_t)(2 * i) * Nsrc], b = src[(size_t)(2 * i + 1) * Nsrc]; if (ns < 0) { a = 0.f; b = 0.f; } scr[lane * 33 + i] = pk2(a, b); }
        asm volatile("s_waitcnt lgkmcnt(0)" ::: "memory");
#pragma unroll
        for (int j = 0; j < 8; ++j) { const int nn = (lane >> 3) + 8 * j, kq = lane & 7; v4u o; const LAS unsigned* s = scr + nn * 33 + 4 * kq; o.x = s[0]; o.y = s[1]; o.z = s[2]; o.w = s[3];
            *(v4u*)(WT + (size_t)(n0 + nn) * K + k0 + 8 * kq) = o; }
        asm volatile("s_waitcnt lgkmcnt(0)" ::: "memory");
    }
}

DI void rms_row(const float* xrow, const float* w, bf16* orow, int lane) {
    f32x4 v[8]; float ss = 0.f;
#pragma unroll
    for (int j = 0; j < 8; ++j) { v[j] = *(const f32x4*)(xrow + 4 * (lane + 64 * j)); ss += (v[j][0] * v[j][0] + v[j][1] * v[j][1]) + (v[j][2] * v[j][2] + v[j][3] * v[j][3]); }
    const float rstd = rsqrtf(wave_sum(ss) * (1.f / D) + EPS);
#pragma unroll
    for (int j = 0; j < 8; ++j) { const f32x4 ww = *(const f32x4*)(w + 4 * (lane + 64 * j)); v2u o; o.x = pk2(v[j][0] * rstd * ww[0], v[j][1] * rstd * ww[1]); o.y = pk2(v[j][2] * rstd * ww[2], v[j][3] * rstd * ww[3]);
        *(v2u*)(orow + 4 * (lane + 64 * j)) = o; }
}

template <bool GDN>
DI void seq_mixer(const Frame& F, int bh, const bf16* Q, const bf16* K, const bf16* V, const float* Gg, const float* Gb, float* OUT, float gamma) {
    LAS float* qs = (LAS float*)F.lds; LAS float* ks = qs + 32 * 128; LAS float* vs = ks + 32 * 128; LAS float* red = vs + 32 * 128; LAS float* gs = red + 2 * 4 * 128; LAS float* bs = gs + 32;
    const int tid = F.tid, v = tid & 127, kg = tid >> 7, b = bh >> 3, h = bh & 7;
    const size_t hb = (size_t)bh * SEQ * 128;
    float Sr[32];
#pragma unroll
    for (int i = 0; i < 32; ++i) Sr[i] = 0.f;
    for (int c0 = 0; c0 < SEQ; c0 += 32) {
        __syncthreads();
#pragma unroll
        for (int j = 0; j < 4; ++j) { const int idx = tid + 512 * j, tok = idx >> 6, d = (idx & 63) * 2; const size_t go = hb + (size_t)(c0 + tok) * 128 + d;
            const unsigned a = *(const unsigned*)(Q + go), bb = *(const unsigned*)(K + go), cc = *(const unsigned*)(V + go);
            qs[tok * 128 + d] = bf2f(a & 0xffffu); qs[tok * 128 + d + 1] = __uint_as_float(a & 0xffff0000u);
            ks[tok * 128 + d] = bf2f(bb & 0xffffu); ks[tok * 128 + d + 1] = __uint_as_float(bb & 0xffff0000u);
            vs[tok * 128 + d] = bf2f(cc & 0xffffu); vs[tok * 128 + d + 1] = __uint_as_float(cc & 0xffff0000u); }
        if (GDN && tid < 32) { gs[tid] = Gg[(size_t)bh * SEQ + c0 + tid]; bs[tid] = Gb[(size_t)bh * SEQ + c0 + tid]; }
        __syncthreads();
        for (int tt = 0; tt < 32; ++tt) {
            const LAS float* kt = ks + tt * 128 + kg * 32; const LAS float* qt = qs + tt * 128 + kg * 32;
            float po = 0.f;
            if (GDN) {
                const float a = __expf(gs[tt]); float p = 0.f;
#pragma unroll
                for (int i = 0; i < 32; ++i) { Sr[i] *= a; p += Sr[i] * kt[i]; }
                red[kg * 128 + v] = p; __syncthreads();
                const float kv = (red[v] + red[128 + v]) + (red[256 + v] + red[384 + v]);
                const float delta = bs[tt] * (vs[tt * 128 + v] - kv);
#pragma unroll
                for (int i = 0; i < 32; ++i) { Sr[i] += kt[i] * delta; po += Sr[i] * qt[i]; }
                red[512 + kg * 128 + v] = po; __syncthreads();
                if (kg == 0) OUT[((size_t)(b * SEQ + c0 + tt)) * 1024 + h * 128 + v] = (red[512 + v] + red[640 + v]) + (red[768 + v] + red[896 + v]);
            } else {
                const float vv = vs[tt * 128 + v]; LAS float* r = red + (tt & 1) * 512;
#pragma unroll
                for (int i = 0; i < 32; ++i) { Sr[i] = gamma * Sr[i] + kt[i] * vv; po += Sr[i] * qt[i]; }
                r[kg * 128 + v] = po; __syncthreads();
                if (kg == 0) OUT[((size_t)(b * SEQ + c0 + tt)) * 1024 + h * 128 + v] = (r[v] + r[128 + v]) + (r[256 + v] + r[384 + v]);
            }
        }
    }
    __syncthreads();
}

template <int DV, bool CAUSAL, bool OUT_BF16>
DI void flash_item(const Frame& F, const bf16* Q, const bf16* Kh, const bf16* VT, int vpitch, int q0, int nkeys, float slope, float* OUTF, bf16* OUTB, int opitch) {
    constexpr int KP = 272, VP = 144;
    LAS unsigned char* Kl = F.lds; LAS unsigned char* Vl = F.lds + 64 * KP;
    int tid_ = F.tid; asm volatile("" : "+v"(tid_));
    const int tid = tid_, lane = tid & 63, w = F.wave, li = lane & 15, g = lane >> 4;
    const float SC = 0.08838834764831845f, L2E = 1.4426950408889634f;
    bf16x8 qf[4];
#pragma unroll
    for (int ks = 0; ks < 4; ++ks) qf[ks] = *(const bf16x8*)(Q + (size_t)(w * 16 + li) * 128 + ks * 32 + g * 8);
    f32x4 o[DV / 16];
#pragma unroll
    for (int c = 0; c < DV / 16; ++c) o[c] = (f32x4){0.f, 0.f, 0.f, 0.f};
    float m_run = -1e30f, l_run = 0.f;
    const int qpos = q0 + w * 16 + li;
    const int kend = CAUSAL ? (q0 + 128 < nkeys ? q0 + 128 : nkeys) : nkeys;
    for (int j0 = 0; j0 < kend; j0 += 64) {
        __syncthreads();
#pragma unroll
        for (int i = 0; i < 2; ++i) { const int c = tid + 512 * i, row = c >> 4, cc = c & 15; *(LAS v4u*)(Kl + row * KP + cc * 16) = *(const v4u*)(Kh + (size_t)(j0 + row) * 128 + cc * 8); }
#pragma unroll
        for (int i = 0; i < DV / 64; ++i) { const int c = tid + 512 * i, row = c >> 3, cc = c & 7; *(LAS v4u*)(Vl + row * VP + cc * 16) = *(const v4u*)(VT + (size_t)row * vpitch + j0 + cc * 8); }
        __syncthreads();
        f32x4 s[4];
#pragma unroll
        for (int t = 0; t < 4; ++t) { s[t] = (f32x4){0.f, 0.f, 0.f, 0.f};
#pragma unroll
            for (int ks = 0; ks < 4; ++ks) { const bf16x8 a = *(const LAS bf16x8*)(Kl + (t * 16 + li) * KP + (ks * 32 + g * 8) * 2); s[t] = __builtin_amdgcn_mfma_f32_16x16x32_bf16(a, qf[ks], s[t], 0, 0, 0); } }
        float mx = -__builtin_inff();
#pragma unroll
        for (int t = 0; t < 4; ++t)
#pragma unroll
            for (int r = 0; r < 4; ++r) { const int key = j0 + t * 16 + g * 4 + r; float x = s[t][r] * SC - slope * (float)(qpos - key); if (CAUSAL && key > qpos) x = -__builtin_inff(); s[t][r] = x; mx = fmaxf(mx, x); }
        mx = fmaxf(mx, __shfl_xor(mx, 16)); mx = fmaxf(mx, __shfl_xor(mx, 32));
        const float m_new = fmaxf(m_run, mx), alpha = exp2f((m_run - m_new) * L2E); m_run = m_new;
        float ps = 0.f;
#pragma unroll
        for (int t = 0; t < 4; ++t)
#pragma unroll
            for (int r = 0; r < 4; ++r) { const float p = exp2f((s[t][r] - m_new) * L2E); s[t][r] = p; ps += p; }
        ps += __shfl_xor(ps, 16); ps += __shfl_xor(ps, 32);
        l_run = l_run * alpha + ps;
        bf16x8 pf[2];
#pragma unroll
        for (int s2 = 0; s2 < 2; ++s2) { v4u pw; pw.x = pk2(s[2 * s2][0], s[2 * s2][1]); pw.y = pk2(s[2 * s2][2], s[2 * s2][3]); pw.z = pk2(s[2 * s2 + 1][0], s[2 * s2 + 1][1]); pw.w = pk2(s[2 * s2 + 1][2], s[2 * s2 + 1][3]); pf[s2] = __builtin_bit_cast(bf16x8, pw); }
        float al[4];
#pragma unroll
        for (int r = 0; r < 4; ++r) al[r] = __shfl(alpha, g * 4 + r);
#pragma unroll
        for (int c = 0; c < DV / 16; ++c) {
#pragma unroll
            for (int r = 0; r < 4; ++r) o[c][r] *= al[r];
#pragma unroll
            for (int s2 = 0; s2 < 2; ++s2) { const LAS unsigned char* vp = Vl + (c * 16 + li) * VP + (s2 * 32 + g * 4) * 2; const v2u lo = *(const LAS v2u*)vp, hi = *(const LAS v2u*)(vp + 32);
                v4u bw; bw.x = lo.x; bw.y = lo.y; bw.z = hi.x; bw.w = hi.y; o[c] = __builtin_amdgcn_mfma_f32_16x16x32_bf16(pf[s2], __builtin_bit_cast(bf16x8, bw), o[c], 0, 0, 0); }
        }
    }
    float il[4];
#pragma unroll
    for (int r = 0; r < 4; ++r) il[r] = 1.0f / __shfl(l_run, g * 4 + r);
#pragma unroll
    for (int c = 0; c < DV / 16; ++c)
#pragma unroll
        for (int r = 0; r < 4; ++r) { const unsigned off = (unsigned)((w * 16 + g * 4 + r) * opitch + c * 16 + li); const float v = o[c][r] * il[r];
            if (OUT_BF16) OUTB[off] = (bf16)f2bf(v); else OUTF[off] = v; }
}

__global__ void __launch_bounds__(NWAVES * 64, 2) mk_fwd(Args args) {
    extern __shared__ __attribute__((aligned(16))) unsigned char lds_raw[];
    Frame F;
    F.lds = (LAS unsigned char*)lds_raw;
    F.tid = threadIdx.x; F.lane = F.tid & 63; F.wave = __builtin_amdgcn_readfirstlane(F.tid >> 6);
    F.G = gridDim.x; { const int bx = blockIdx.x; F.vcu = (F.G % 8 == 0) ? (bx % 8) * (F.G / 8) + bx / 8 : bx; }
    F.gw = F.vcu * NWAVES + F.wave; F.NGW = F.G * NWAVES;
    volatile LAS unsigned* MISC = (volatile LAS unsigned*)(F.lds + MISC_OFF);
    LAS int* MTAB = (LAS int*)(F.lds + MISC_OFF + 128);
    unsigned char* ws = args.ws;
    unsigned* ctl = (unsigned*)(ws + WS_CTL);
    for (int u = F.tid; u < (LDS_BYTES - RING_BYTES) / 4; u += NWAVES * 64) ((LAS unsigned*)(F.lds + RING_BYTES))[u] = 0u;
    __syncthreads();
#if MK_ONE_LAUNCH
    XcdBarrier bar = xcd_barrier_post(ctl + CW_BAR, MISC + 8);
#define GRID_BAR() xcd_barrier(bar)
#else
#define GRID_BAR() do {} while (0)
#endif
    const int lo = args.ph_lo, hi = args.ph_hi;
#define IN(k) (lo <= (k) && (k) < hi)
#define SEAM(k) do { if (IN(k) && IN((k) + 1)) GRID_BAR(); } while (0)

    const float* x_in = (const float*)args.in[0]; const float* mem = (const float*)args.in[1]; const float* w_in = (const float*)args.in[2]; const float* conv_w = (const float*)args.in[3];
    const float* a_log = (const float*)args.in[4]; const float* dt_bias = (const float*)args.in[5]; const float* gdn_norm_w = (const float*)args.in[6]; const float* diff_lambda = (const float*)args.in[7];
    const float* diff_norm_w = (const float*)args.in[8]; const float* w_branch = (const float*)args.in[9]; const float* w_out = (const float*)args.in[10]; const float* mix_norm_w = (const float*)args.in[11];
    const float* mem_norm_w = (const float*)args.in[12]; const float* cross_norm_w = (const float*)args.in[13]; const float* cross_w_q = (const float*)args.in[14]; const float* cross_w_kv = (const float*)args.in[15];
    const float* cross_w_o = (const float*)args.in[16]; const float* ffn_norm_w = (const float*)args.in[17]; const float* dense_w_gu = (const float*)args.in[18]; const float* dense_w_down = (const float*)args.in[19];
    const float* router_w = (const float*)args.in[20]; const float* expert_w_gu = (const float*)args.in[21]; const float* expert_w_down = (const float*)args.in[22]; const float* final_norm_w = (const float*)args.in[23];
    bf16* WIN = (bf16*)(ws + WS_WIN); bf16* WBR = (bf16*)(ws + WS_WBR); bf16* WOUT = (bf16*)(ws + WS_WOUT); bf16* WQ = (bf16*)(ws + WS_WQ); bf16* WKV = (bf16*)(ws + WS_WKV); bf16* WO = (bf16*)(ws + WS_WO);
    bf16* WGU = (bf16*)(ws + WS_WGU); bf16* WDN = (bf16*)(ws + WS_WDN); bf16* WEGU = (bf16*)(ws + WS_WEGU); bf16* WEDN = (bf16*)(ws + WS_WEDN);
    float* XRES = (float*)(ws + WS_XRES); bf16* H = (bf16*)(ws + WS_H);
    bf16* RQ = (bf16*)(ws + WS_RQ); bf16* RK = (bf16*)(ws + WS_RK); bf16* RV = (bf16*)(ws + WS_RV); bf16* RG = (bf16*)(ws + WS_RG); bf16* BQKV = (bf16*)(ws + WS_BQKV); bf16* BZ = (bf16*)(ws + WS_BZ);
    float* BBA = (float*)(ws + WS_BBA); bf16* CQ = (bf16*)(ws + WS_CQ); bf16* CK = (bf16*)(ws + WS_CK); bf16* CVT = (bf16*)(ws + WS_CVT); bf16* GATES = (bf16*)(ws + WS_GATES);
    bf16* GQ = (bf16*)(ws + WS_GQ); bf16* GK = (bf16*)(ws + WS_GK); bf16* GV = (bf16*)(ws + WS_GV); float* GG = (float*)(ws + WS_GG); float* GB = (float*)(ws + WS_GB);
    float* OA = (float*)(ws + WS_OA); float* OB = (float*)(ws + WS_OB); float* O12 = (float*)(ws + WS_O12); bf16* OCAT = (bf16*)(ws + WS_OCAT);
    float* MERGE = (float*)(ws + WS_MERGE); bf16* MERGEB = (bf16*)(ws + WS_MERGEB); bf16* MEMN = (bf16*)(ws + WS_MEMN); bf16* KX = (bf16*)(ws + WS_KX); bf16* VXT = (bf16*)(ws + WS_VXT);
    bf16* QX = (bf16*)(ws + WS_QX); bf16* OX = (bf16*)(ws + WS_OX); bf16* ACT = (bf16*)(ws + WS_ACT); bf16* HG = (bf16*)(ws + WS_HG); bf16* EACT = (bf16*)(ws + WS_EACT); float* Y = (float*)(ws + WS_Y);
    int* ROUTE = (int*)(ws + WS_ROUTE);

    if (IN(0)) {
        for (int l = 0; l < 2; ++l) {
            conv_job(F, w_in + (size_t)l * D * 17424, D, 17424, WIN + (size_t)l * NINP * D, NINP, 1, 0);
            for (int s = 0; s < 3; ++s) conv_job(F, w_branch + ((size_t)l * 3072 + s * 1024) * D, 1024, D, WBR + ((size_t)l * 3 + s) * D * 1024, D, 0, 0);
            conv_job(F, w_out + (size_t)l * D * D, D, D, WOUT + (size_t)l * D * D, D, 0, 0);
            conv_job(F, cross_w_q + (size_t)l * D * 512, D, 512, WQ + (size_t)l * 512 * D, 512, 0, 0);
            conv_job(F, cross_w_kv + (size_t)l * D * 1024, D, 1024, WKV + (size_t)l * 1024 * D, 1024, 0, 0);
            conv_job(F, cross_w_o + (size_t)l * 512 * D, 512, D, WO + (size_t)l * D * 512, D, 0, 0);
        }
        conv_job(F, dense_w_gu, D, 2 * DFF, WGU, 2 * DFF, 2, DFF);
        conv_job(F, dense_w_down, DFF, D, WDN, D, 0, 0);
        for (int e = 0; e < NEXP; ++e) {
            conv_job(F, expert_w_gu + (size_t)e * D * 2 * EFF, D, 2 * EFF, WEGU + (size_t)e * 2 * EFF * D, 2 * EFF, 2, EFF);
            conv_job(F, expert_w_down + (size_t)e * EFF * D, EFF, D, WEDN + (size_t)e * D * EFF, D, 0, 0);
        }
        for (int r = F.gw; r < T; r += F.NGW) rms_row(x_in + (size_t)r * D, mix_norm_w, H + (size_t)r * D, F.lane);
        for (int r = F.gw; r < 2 * MEMR; r += F.NGW) { const int l = r / MEMR, rr = r % MEMR; rms_row(mem + (size_t)rr * D, mem_norm_w + l * D, MEMN + (size_t)r * D, F.lane); }
    }
    SEAM(0);
    if (IN(1)) {
        for (int l = 0; l < 2; ++l) {
            pg8::Gemm g{MEMN + (size_t)l * MEMR * D, WKV + (size_t)l * 1024 * D, MEMR, 1024, D}; pg8::StaticOrder S; S.init(MEMR, 1024, F.G, (int)((blockIdx.x + F.G - 16 * l) % F.G));
            pg8::EpiHeads E{KX + (size_t)l * NB * 4 * MEML * 128, VXT + (size_t)l * NB * 4 * 128 * MEML, 4, 8, 2};
            pg8::gemm_phase<pg8::EpiHeads, pg8::StaticOrder, true, true>(F.lds, g, S, E);
        }
    }
    SEAM(1);

    { constexpr int l = 0;
        const int pb = 2 + l * NPL;
        const float lambda_init = l == 0 ? 0.2f : 0.35550906f;
        const float* xin = l == 0 ? x_in : XRES;
        if (IN(pb + 0)) {
            pg8::Gemm g{H, WIN + (size_t)l * NINP * D, T, NINP, D}; pg8::StaticOrder S; S.init(T, NINP, F.G, (int)blockIdx.x);
            pg8::EpiIn E{RQ, RK, RV, RG, BQKV, BZ, CQ, CK, CVT, GATES, BBA};
            pg8::gemm_phase<pg8::EpiIn, pg8::StaticOrder, true, true>(F.lds, g, S, E);
        }
        SEAM(pb + 0);
        if (IN(pb + 1)) {
            const float* cw = conv_w + (size_t)l * 4 * 3072;
            for (int it = F.gw; it < T * 8; it += F.NGW) {
                const int t = it >> 3, h = it & 7, b = t >> 11, s = t & 2047, lane = F.lane;
                float val[3][2];
#pragma unroll
                for (int part = 0; part < 3; ++part) { const int col = part * 1024 + h * 128 + 2 * lane; float a0 = 0.f, a1 = 0.f;
#pragma unroll
                    for (int j = 0; j < 4; ++j) { if (s - 3 + j >= 0) { const unsigned xv = *(const unsigned*)(BQKV + (size_t)(t - 3 + j) * 3072 + col); a0 += bf2f(xv & 0xffffu) * cw[j * 3072 + col]; a1 += __uint_as_float(xv & 0xffff0000u) * cw[j * 3072 + col + 1]; } }
                    val[part][0] = pg8::fsilu(a0); val[part][1] = pg8::fsilu(a1); }
                const float qs_ = wave_sum(val[0][0] * val[0][0] + val[0][1] * val[0][1]), ks_ = wave_sum(val[1][0] * val[1][0] + val[1][1] * val[1][1]);
                const float qn = rsqrtf(qs_ + 1e-6f) * 0.08838834764831845f, kn = rsqrtf(ks_ + 1e-6f);
                const size_t o = ((size_t)((b * 8 + h) * SEQ + s)) * 128 + 2 * lane;
                *(unsigned*)(GQ + o) = pk2(val[0][0] * qn, val[0][1] * qn); *(unsigned*)(GK + o) = pk2(val[1][0] * kn, val[1][1] * kn); *(unsigned*)(GV + o) = pk2(val[2][0], val[2][1]);
                if (lane == 0) { const float bbv = BBA[(size_t)t * 16 + h], bav = BBA[(size_t)t * 16 + 8 + h] + dt_bias[l * 8 + h]; const float sp = bav > 20.f ? bav : log1pf(__expf(bav));
                    GB[(size_t)(b * 8 + h) * SEQ + s] = pg8::fsigm(bbv); GG[(size_t)(b * 8 + h) * SEQ + s] = -__expf(a_log[l * 8 + h]) * sp; }
            }
        }
        SEAM(pb + 1);
        if (IN(pb + 2)) {
            const int bx = F.vcu;
            if (bx < 32) { const int h = bx & 7; seq_mixer<false>(F, bx, RQ, RK, RV, nullptr, nullptr, OA, 1.0f - exp2f(-5.0f - (float)h)); }
            else if (bx < 64) seq_mixer<true>(F, bx - 32, GQ, GK, GV, GG, GB, OB, 0.f);
            else {
                for (int it = bx - 64; it < 512; it += F.G - 64) {
                    const int qt = 15 - (it >> 5), hd = it & 31, b = hd >> 3, hm = hd & 7, hh = hm >> 1, m = hm & 1;
                    const float slope = exp2f(-2.0f * (float)(hh + 1));
                    flash_item<256, true, false>(F, CQ + ((size_t)hd * SEQ + qt * 128) * 128, CK + (size_t)hd * SEQ * 128, CVT + (size_t)(b * 4 + hh) * 256 * SEQ, SEQ, qt * 128, SEQ, slope,
                                                 O12 + ((size_t)m * T + b * SEQ + qt * 128) * 1024 + hh * 256, nullptr, 1024);
                }
            }
        }
        SEAM(pb + 2);
        if (IN(pb + 3)) {
            const int lane = F.lane;
            const float* lv = diff_lambda + (size_t)l * 512;
            const float d01 = wave_sum(lv[lane] * lv[128 + lane] + lv[64 + lane] * lv[192 + lane]), d23 = wave_sum(lv[256 + lane] * lv[384 + lane] + lv[320 + lane] * lv[448 + lane]);
            const float lam = __expf(d01) - __expf(d23) + lambda_init;
            for (int t = F.gw; t < T; t += F.NGW) {
#pragma unroll
                for (int h = 0; h < 8; ++h) { const size_t o = (size_t)t * 1024 + h * 128 + 2 * lane;
                    { const float a0 = OA[o], a1 = OA[o + 1]; const float mean = wave_sum(a0 + a1) * (1.f / 128.f); const float c0 = a0 - mean, c1 = a1 - mean; const float rstd = rsqrtf(wave_sum(c0 * c0 + c1 * c1) * (1.f / 128.f) + EPS);
                      const unsigned gv = *(const unsigned*)(RG + o); *(unsigned*)(OCAT + o) = pk2(c0 * rstd * bf2f(gv & 0xffffu), c1 * rstd * __uint_as_float(gv & 0xffff0000u)); }
                    { const float a0 = OB[o], a1 = OB[o + 1]; const float rstd = rsqrtf(wave_sum(a0 * a0 + a1 * a1) * (1.f / 128.f) + EPS); const unsigned gv = *(const unsigned*)(BZ + o);
                      *(unsigned*)(OCAT + (size_t)T * 1024 + o) = pk2(a0 * rstd * gdn_norm_w[l * 128 + 2 * lane] * bf2f(gv & 0xffffu), a1 * rstd * gdn_norm_w[l * 128 + 2 * lane + 1] * __uint_as_float(gv & 0xffff0000u)); } }
#pragma unroll
                for (int h = 0; h < 4; ++h) { const size_t o = (size_t)t * 1024 + h * 256 + 4 * lane; const f32x4 p = *(const f32x4*)(O12 + o), q = *(const f32x4*)(O12 + (size_t)T * 1024 + o); const f32x4 d = p - q * lam;
                    const float rstd = rsqrtf(wave_sum((d[0] * d[0] + d[1] * d[1]) + (d[2] * d[2] + d[3] * d[3])) * (1.f / 256.f) + EPS) * (1.0f - lambda_init); const f32x4 ww = *(const f32x4*)(diff_norm_w + l * 256 + 4 * lane);
                    v2u ov; ov.x = pk2(d[0] * rstd * ww[0], d[1] * rstd * ww[1]); ov.y = pk2(d[2] * rstd * ww[2], d[3] * rstd * ww[3]); *(v2u*)(OCAT + (size_t)2 * T * 1024 + o) = ov; }
            }
        }
        SEAM(pb + 3);
        if (IN(pb + 4)) {
            for (int s = 0; s < 3; ++s) {
                pg8::Gemm g{OCAT + (size_t)s * T * 1024, WBR + ((size_t)l * 3 + s) * D * 1024, T, D, 1024}; pg8::StaticOrder S; S.init(T, D, F.G, (int)blockIdx.x);
                pg8::EpiBranch E{MERGE, MERGEB, GATES, s};
                pg8::gemm_phase<pg8::EpiBranch, pg8::StaticOrder, true, true>(F.lds, g, S, E);
            }
        }
        SEAM(pb + 4);
        if (IN(pb + 5)) {
            pg8::Gemm g{MERGEB, WOUT + (size_t)l * D * D, T, D, D}; pg8::StaticOrder S; S.init(T, D, F.G, (int)blockIdx.x);
            pg8::EpiResid E{xin, XRES, D};
            pg8::gemm_phase<pg8::EpiResid, pg8::StaticOrder, true, true>(F.lds, g, S, E);
        }
        SEAM(pb + 5);
        if (IN(pb + 6)) { for (int r = F.gw; r < T; r += F.NGW) rms_row(XRES + (size_t)r * D, cross_norm_w + l * D, H + (size_t)r * D, F.lane); }
        SEAM(pb + 6);
        if (IN(pb + 7)) {
            pg8::Gemm g{H, WQ + (size_t)l * 512 * D, T, 512, D}; pg8::StaticOrder S; S.init(T, 512, F.G, (int)blockIdx.x);
            pg8::EpiHeads E{QX, nullptr, 4, 11, 1 << 20};
            pg8::gemm_phase<pg8::EpiHeads, pg8::StaticOrder, true, true>(F.lds, g, S, E);
        }
        SEAM(pb + 7);
        if (IN(pb + 8)) {
            for (int it = F.vcu; it < 256; it += F.G) { const int hd = it >> 4, qt = it & 15, b = hd >> 2, hh = hd & 3;
                flash_item<128, false, true>(F, QX + ((size_t)hd * SEQ + qt * 128) * 128, KX + ((size_t)l * 16 + hd) * MEML * 128, VXT + ((size_t)l * 16 + hd) * 128 * MEML, MEML, qt * 128, MEML, 0.f,
                                             nullptr, OX + ((size_t)(b * SEQ + qt * 128)) * 512 + hh * 128, 512); }
        }
        SEAM(pb + 8);
        if (IN(pb + 9)) {
            pg8::Gemm g{OX, WO + (size_t)l * D * 512, T, D, 512}; pg8::StaticOrder S; S.init(T, D, F.G, (int)blockIdx.x);
            pg8::EpiResid E{XRES, XRES, D};
            pg8::gemm_phase<pg8::EpiResid, pg8::StaticOrder, true, true>(F.lds, g, S, E);
        }
        SEAM(pb + 9);
        if (IN(pb + 10)) {
            const int lane = F.lane; const float* w = ffn_norm_w + l * D;
            for (int r = F.gw; r < T; r += F.NGW) {
                const float* xrow = XRES + (size_t)r * D; f32x4 v[8]; float ss = 0.f;
#pragma unroll
                for (int j = 0; j < 8; ++j) { v[j] = *(const f32x4*)(xrow + 4 * (lane + 64 * j)); ss += (v[j][0] * v[j][0] + v[j][1] * v[j][1]) + (v[j][2] * v[j][2] + v[j][3] * v[j][3]); }
                const float rstd = rsqrtf(wave_sum(ss) * (1.f / D) + EPS);
                float lg[8];
#pragma unroll
                for (int e = 0; e < 8; ++e) lg[e] = 0.f;
#pragma unroll
                for (int j = 0; j < 8; ++j) { const f32x4 ww = *(const f32x4*)(w + 4 * (lane + 64 * j)); f32x4 y; y[0] = v[j][0] * rstd * ww[0]; y[1] = v[j][1] * rstd * ww[1]; y[2] = v[j][2] * rstd * ww[2]; y[3] = v[j][3] * rstd * ww[3];
                    v2u o; o.x = pk2(y[0], y[1]); o.y = pk2(y[2], y[3]); *(v2u*)(H + (size_t)r * D + 4 * (lane + 64 * j)) = o;
                    if (l == 1) {
#pragma unroll
                        for (int c = 0; c < 4; ++c) { const float* rw = router_w + (size_t)(4 * (lane + 64 * j) + c) * 8; const f32x4 r0 = *(const f32x4*)rw, r1 = *(const f32x4*)(rw + 4);
                            lg[0] += y[c] * r0[0]; lg[1] += y[c] * r0[1]; lg[2] += y[c] * r0[2]; lg[3] += y[c] * r0[3]; lg[4] += y[c] * r1[0]; lg[5] += y[c] * r1[1]; lg[6] += y[c] * r1[2]; lg[7] += y[c] * r1[3]; } } }
                if (l == 1) {
#pragma unroll
                    for (int e = 0; e < 8; ++e) lg[e] = wave_sum(lg[e]);
                    int e0 = 0; float v0 = lg[0];
#pragma unroll
                    for (int e = 1; e < 8; ++e) if (lg[e] > v0) { v0 = lg[e]; e0 = e; }
                    int e1 = -1; float v1 = -__builtin_inff();
#pragma unroll
                    for (int e = 0; e < 8; ++e) if (e != e0 && lg[e] > v1) { v1 = lg[e]; e1 = e; }
                    if (lane == 0) { const float p0 = 1.0f / (1.0f + __expf(v1 - v0)); int* ro = ROUTE + (size_t)r * 8;
                        ro[0] = e0; ro[1] = e1; ro[2] = (int)atomicAdd(ctl + CW_CNT + e0, 1u); ro[3] = (int)atomicAdd(ctl + CW_CNT + e1, 1u); ((float*)ro)[4] = p0; ((float*)ro)[5] = 1.0f - p0; }
                }
            }
        }
        SEAM(pb + 10);
        if (l == 0) {
            if (IN(pb + 11)) {
                pg8::Gemm g{H, WGU, T, 2 * DFF, D}; pg8::StaticOrder S; S.init(T, 2 * DFF, F.G, (int)blockIdx.x);
                pg8::EpiSwiglu E{ACT, DFF, 1 << 20};
                pg8::gemm_phase<pg8::EpiSwiglu, pg8::StaticOrder, true, true>(F.lds, g, S, E);
            }
            SEAM(pb + 11);
            if (IN(pb + 12)) {
                pg8::Gemm g{ACT, WDN, T, D, DFF}; pg8::StaticOrder S; S.init(T, D, F.G, (int)blockIdx.x);
                pg8::EpiResid E{XRES, XRES, D};
                pg8::gemm_phase<pg8::EpiResid, pg8::StaticOrder, true, true>(F.lds, g, S, E);
            }
            SEAM(pb + 12);
            if (IN(pb + 13)) { for (int r = F.gw; r < T; r += F.NGW) rms_row(XRES + (size_t)r * D, mix_norm_w + D, H + (size_t)r * D, F.lane); }
            SEAM(pb + 13);
            SEAM(pb + 14);
        } else {
            int off[9]; off[0] = 0;
#pragma unroll
            for (int e = 0; e < 8; ++e) { const int c = (int)__hip_atomic_load(ctl + CW_CNT + e, __ATOMIC_RELAXED, __HIP_MEMORY_SCOPE_AGENT); off[e + 1] = off[e] + ((c + 255) & ~255); }
            if (IN(pb + 11)) {
                for (int it = F.gw; it < T * 2; it += F.NGW) { const int t = it >> 1, k = it & 1; int* ro = ROUTE + (size_t)t * 8; const int e = ro[k], pos = ro[2 + k];
                    int base = 0;
#pragma unroll
                    for (int q = 0; q < 8; ++q) if (e == q) base = off[q];
                    const int slot = base + pos; if (F.lane == 0) ro[6 + k] = slot;
                    const v4u* src = (const v4u*)(H + (size_t)t * D); v4u* dst = (v4u*)(HG + (size_t)slot * D);
#pragma unroll
                    for (int j = 0; j < 4; ++j) dst[F.lane + 64 * j] = src[F.lane + 64 * j]; }
#pragma unroll
                for (int e = 0; e < 8; ++e) { const int c = (int)__hip_atomic_load(ctl + CW_CNT + e, __ATOMIC_RELAXED, __HIP_MEMORY_SCOPE_AGENT);
                    for (int rr = off[e] + c + F.gw; rr < off[e + 1]; rr += F.NGW) { v4u* dst = (v4u*)(HG + (size_t)rr * D);
#pragma unroll
                        for (int j = 0; j < 4; ++j) dst[F.lane + 64 * j] = (v4u){0u, 0u, 0u, 0u}; } }
            }
            SEAM(pb + 11);
            if (IN(pb + 12)) {
                if (F.tid == 0) { int cu = 0;
#pragma unroll
                    for (int e = 0; e < 8; ++e) { const int ne = (off[e + 1] - off[e]) >> 8; MTAB[e] = ne; MTAB[8 + e] = off[e] >> 8; MTAB[16 + e] = cu; cu += ne * 56; } MTAB[24] = cu; MTAB[25] = cu; }
                __syncthreads();
                pg8::Gemm g{HG, WEGU, MAXSLOT, NEXP * 2 * EFF, D}; pg8::MoeOrder S{(const LAS int*)MTAB, 56, F.G, (int)blockIdx.x};
                pg8::EpiSwiglu E{EACT, EFF, 56};
                pg8::gemm_phase<pg8::EpiSwiglu, pg8::MoeOrder, true, true>(F.lds, g, S, E);
            }
            SEAM(pb + 12);
            if (IN(pb + 13)) {
                __syncthreads();
                if (F.tid == 0) { int cu = 0;
#pragma unroll
                    for (int e = 0; e < 8; ++e) { const int ne = (off[e + 1] - off[e]) >> 8; MTAB[e] = ne; MTAB[8 + e] = off[e] >> 8; MTAB[16 + e] = cu; cu += ne * 8; } MTAB[24] = cu; MTAB[25] = cu; }
                __syncthreads();
                pg8::Gemm g{EACT, WEDN, MAXSLOT, NEXP * D, EFF}; pg8::MoeOrder S{(const LAS int*)MTAB, 8, F.G, (int)blockIdx.x};
                pg8::EpiStoreF32 E{Y, D, 8};
                pg8::gemm_phase<pg8::EpiStoreF32, pg8::MoeOrder, true, true>(F.lds, g, S, E);
            }
            SEAM(pb + 13);
            if (IN(pb + 14)) {
                const int lane = F.lane;
                for (int r = F.gw; r < T; r += F.NGW) { const int* ro = ROUTE + (size_t)r * 8; const float p0 = ((const float*)ro)[4], p1 = ((const float*)ro)[5]; const float* y0 = Y + (size_t)ro[6] * D; const float* y1 = Y + (size_t)ro[7] * D;
                    const float* xrow = XRES + (size_t)r * D; f32x4 v[8]; float ss = 0.f;
#pragma unroll
                    for (int j = 0; j < 8; ++j) { const int o = 4 * (lane + 64 * j); v[j] = *(const f32x4*)(xrow + o) + *(const f32x4*)(y0 + o) * p0 + *(const f32x4*)(y1 + o) * p1; ss += (v[j][0] * v[j][0] + v[j][1] * v[j][1]) + (v[j][2] * v[j][2] + v[j][3] * v[j][3]); }
                    const float rstd = rsqrtf(wave_sum(ss) * (1.f / D) + EPS);
#pragma unroll
                    for (int j = 0; j < 8; ++j) { const int o = 4 * (lane + 64 * j); const f32x4 ww = *(const f32x4*)(final_norm_w + o); *(f32x4*)(args.out + (size_t)r * D + o) = v[j] * rstd * ww; } }
            }
        }
    }
    { constexpr int l = 1;
        const int pb = 2 + l * NPL;
        const float lambda_init = l == 0 ? 0.2f : 0.35550906f;
        const float* xin = l == 0 ? x_in : XRES;
        if (IN(pb + 0)) {
            pg8::Gemm g{H, WIN + (size_t)l * NINP * D, T, NINP, D}; pg8::StaticOrder S; S.init(T, NINP, F.G, (int)blockIdx.x);
            pg8::EpiIn E{RQ, RK, RV, RG, BQKV, BZ, CQ, CK, CVT, GATES, BBA};
            pg8::gemm_phase<pg8::EpiIn, pg8::StaticOrder, true, true>(F.lds, g, S, E);
        }
        SEAM(pb + 0);
        if (IN(pb + 1)) {
            const float* cw = conv_w + (size_t)l * 4 * 3072;
            for (int it = F.gw; it < T * 8; it += F.NGW) {
                const int t = it >> 3, h = it & 7, b = t >> 11, s = t & 2047, lane = F.lane;
                float val[3][2];
#pragma unroll
                for (int part = 0; part < 3; ++part) { const int col = part * 1024 + h * 128 + 2 * lane; float a0 = 0.f, a1 = 0.f;
#pragma unroll
                    for (int j = 0; j < 4; ++j) { if (s - 3 + j >= 0) { const unsigned xv = *(const unsigned*)(BQKV + (size_t)(t - 3 + j) * 3072 + col); a0 += bf2f(xv & 0xffffu) * cw[j * 3072 + col]; a1 += __uint_as_float(xv & 0xffff0000u) * cw[j * 3072 + col + 1]; } }
                    val[part][0] = pg8::fsilu(a0); val[part][1] = pg8::fsilu(a1); }
                const float qs_ = wave_sum(val[0][0] * val[0][0] + val[0][1] * val[0][1]), ks_ = wave_sum(val[1][0] * val[1][0] + val[1][1] * val[1][1]);
                const float qn = rsqrtf(qs_ + 1e-6f) * 0.08838834764831845f, kn = rsqrtf(ks_ + 1e-6f);
                const size_t o = ((size_t)((b * 8 + h) * SEQ + s)) * 128 + 2 * lane;
                *(unsigned*)(GQ + o) = pk2(val[0][0] * qn, val[0][1] * qn); *(unsigned*)(GK + o) = pk2(val[1][0] * kn, val[1][1] * kn); *(unsigned*)(GV + o) = pk2(val[2][0], val[2][1]);
                if (lane == 0) { const float bbv = BBA[(size_t)t * 16 + h], bav = BBA[(size_t)t * 16 + 8 + h] + dt_bias[l * 8 + h]; const float sp = bav > 20.f ? bav : log1pf(__expf(bav));
                    GB[(size_t)(b * 8 + h) * SEQ + s] = pg8::fsigm(bbv); GG[(size_t)(b * 8 + h) * SEQ + s] = -__expf(a_log[l * 8 + h]) * sp; }
            }
        }
        SEAM(pb + 1);
        if (IN(pb + 2)) {
            const int bx = F.vcu;
            if (bx < 32) { const int h = bx & 7; seq_mixer<false>(F, bx, RQ, RK, RV, nullptr, nullptr, OA, 1.0f - exp2f(-5.0f - (float)h)); }
            else if (bx < 64) seq_mixer<true>(F, bx - 32, GQ, GK, GV, GG, GB, OB, 0.f);
            else {
                for (int it = bx - 64; it < 512; it += F.G - 64) {
                    const int qt = 15 - (it >> 5), hd = it & 31, b = hd >> 3, hm = hd & 7, hh = hm >> 1, m = hm & 1;
                    const float slope = exp2f(-2.0f * (float)(hh + 1));
                    flash_item<256, true, false>(F, CQ + ((size_t)hd * SEQ + qt * 128) * 128, CK + (size_t)hd * SEQ * 128, CVT + (size_t)(b * 4 + hh) * 256 * SEQ, SEQ, qt * 128, SEQ, slope,
                                                 O12 + ((size_t)m * T + b * SEQ + qt * 128) * 1024 + hh * 256, nullptr, 1024);
                }
            }
        }
        SEAM(pb + 2);
        if (IN(pb + 3)) {
            const int lane = F.lane;
            const float* lv = diff_lambda + (size_t)l * 512;
            const float d01 = wave_sum(lv[lane] * lv[128 + lane] + lv[64 + lane] * lv[192 + lane]), d23 = wave_sum(lv[256 + lane] * lv[384 + lane] + lv[320 + lane] * lv[448 + lane]);
            const float lam = __expf(d01) - __expf(d23) + lambda_init;
            for (int t = F.gw; t < T; t += F.NGW) {
#pragma unroll
                for (int h = 0; h < 8; ++h) { const size_t o = (size_t)t * 1024 + h * 128 + 2 * lane;
                    { const float a0 = OA[o], a1 = OA[o + 1]; const float mean = wave_sum(a0 + a1) * (1.f / 128.f); const float c0 = a0 - mean, c1 = a1 - mean; const float rstd = rsqrtf(wave_sum(c0 * c0 + c1 * c1) * (1.f / 128.f) + EPS);
                      const unsigned gv = *(const unsigned*)(RG + o); *(unsigned*)(OCAT + o) = pk2(c0 * rstd * bf2f(gv & 0xffffu), c1 * rstd * __uint_as_float(gv & 0xffff0000u)); }
                    { const float a0 = OB[o], a1 = OB[o + 1]; const float rstd = rsqrtf(wave_sum(a0 * a0 + a1 * a1) * (1.f / 128.f) + EPS); const unsigned gv = *(const unsigned*)(BZ + o);
                      *(unsigned*)(OCAT + (size_t)T * 1024 + o) = pk2(a0 * rstd * gdn_norm_w[l * 128 + 2 * lane] * bf2f(gv & 0xffffu), a1 * rstd * gdn_norm_w[l * 128 + 2 * lane + 1] * __uint_as_float(gv & 0xffff0000u)); } }
#pragma unroll
                for (int h = 0; h < 4; ++h) { const size_t o = (size_t)t * 1024 + h * 256 + 4 * lane; const f32x4 p = *(const f32x4*)(O12 + o), q = *(const f32x4*)(O12 + (size_t)T * 1024 + o); const f32x4 d = p - q * lam;
                    const float rstd = rsqrtf(wave_sum((d[0] * d[0] + d[1] * d[1]) + (d[2] * d[2] + d[3] * d[3])) * (1.f / 256.f) + EPS) * (1.0f - lambda_init); const f32x4 ww = *(const f32x4*)(diff_norm_w + l * 256 + 4 * lane);
                    v2u ov; ov.x = pk2(d[0] * rstd * ww[0], d[1] * rstd * ww[1]); ov.y = pk2(d[2] * rstd * ww[2], d[3] * rstd * ww[3]); *(v2u*)(OCAT + (size_t)2 * T * 1024 + o) = ov; }
            }
        }
        SEAM(pb + 3);
        if (IN(pb + 4)) {
            for (int s = 0; s < 3; ++s) {
                pg8::Gemm g{OCAT + (size_t)s * T * 1024, WBR + ((size_t)l * 3 + s) * D * 1024, T, D, 1024}; pg8::StaticOrder S; S.init(T, D, F.G, (int)blockIdx.x);
                pg8::EpiBranch E{MERGE, MERGEB, GATES, s};
                pg8::gemm_phase<pg8::EpiBranch, pg8::StaticOrder, true, true>(F.lds, g, S, E);
            }
        }
        SEAM(pb + 4);
        if (IN(pb + 5)) {
            pg8::Gemm g{MERGEB, WOUT + (size_t)l * D * D, T, D, D}; pg8::StaticOrder S; S.init(T, D, F.G, (int)blockIdx.x);
            pg8::EpiResid E{xin, XRES, D};
            pg8::gemm_phase<pg8::EpiResid, pg8::StaticOrder, true, true>(F.lds, g, S, E);
        }
        SEAM(pb + 5);
        if (IN(pb + 6)) { for (int r = F.gw; r < T; r += F.NGW) rms_row(XRES + (size_t)r * D, cross_norm_w + l * D, H + (size_t)r * D, F.lane); }
        SEAM(pb + 6);
        if (IN(pb + 7)) {
            pg8::Gemm g{H, WQ + (size_t)l * 512 * D, T, 512, D}; pg8::StaticOrder S; S.init(T, 512, F.G, (int)blockIdx.x);
            pg8::EpiHeads E{QX, nullptr, 4, 11, 1 << 20};
            pg8::gemm_phase<pg8::EpiHeads, pg8::StaticOrder, true, true>(F.lds, g, S, E);
        }
        SEAM(pb + 7);
        if (IN(pb + 8)) {
            for (int it = F.vcu; it < 256; it += F.G) { const int hd = it >> 4, qt = it & 15, b = hd >> 2, hh = hd & 3;
                flash_item<128, false, true>(F, QX + ((size_t)hd * SEQ + qt * 128) * 128, KX + ((size_t)l * 16 + hd) * MEML * 128, VXT + ((size_t)l * 16 + hd) * 128 * MEML, MEML, qt * 128, MEML, 0.f,
                                             nullptr, OX + ((size_t)(b * SEQ + qt * 128)) * 512 + hh * 128, 512); }
        }
        SEAM(pb + 8);
        if (IN(pb + 9)) {
            pg8::Gemm g{OX, WO + (size_t)l * D * 512, T, D, 512}; pg8::StaticOrder S; S.init(T, D, F.G, (int)blockIdx.x);
            pg8::EpiResid E{XRES, XRES, D};
            pg8::gemm_phase<pg8::EpiResid, pg8::StaticOrder, true, true>(F.lds, g, S, E);
        }
        SEAM(pb + 9);
        if (IN(pb + 10)) {
            const int lane = F.lane; const float* w = ffn_norm_w + l * D;
            for (int r = F.gw; r < T; r += F.NGW) {
                const float* xrow = XRES + (size_t)r * D; f32x4 v[8]; float ss = 0.f;
#pragma unroll
                for (int j = 0; j < 8; ++j) { v[j] = *(const f32x4*)(xrow + 4 * (lane + 64 * j)); ss += (v[j][0] * v[j][0] + v[j][1] * v[j][1]) + (v[j][2] * v[j][2] + v[j][3] * v[j][3]); }
                const float rstd = rsqrtf(wave_sum(ss) * (1.f / D) + EPS);
                float lg[8];
#pragma unroll
                for (int e = 0; e < 8; ++e) lg[e] = 0.f;
#pragma unroll
                for (int j = 0; j < 8; ++j) { const f32x4 ww = *(const f32x4*)(w + 4 * (lane + 64 * j)); f32x4 y; y[0] = v[j][0] * rstd * ww[0]; y[1] = v[j][1] * rstd * ww[1]; y[2] = v[j][2] * rstd * ww[2]; y[3] = v[j][3] * rstd * ww[3];
                    v2u o; o.x = pk2(y[0], y[1]); o.y = pk2(y[2], y[3]); *(v2u*)(H + (size_t)r * D + 4 * (lane + 64 * j)) = o;
                    if (l == 1) {
#pragma unroll
                        for (int c = 0; c < 4; ++c) { const float* rw = router_w + (size_t)(4 * (lane + 64 * j) + c) * 8; const f32x4 r0 = *(const f32x4*)rw, r1 = *(const f32x4*)(rw + 4);
                            lg[0] += y[c] * r0[0]; lg[1] += y[c] * r0[1]; lg[2] += y[c] * r0[2]; lg[3] += y[c] * r0[3]; lg[4] += y[c] * r1[0]; lg[5] += y[c] * r1[1]; lg[6] += y[c] * r1[2]; lg[7] += y[c] * r1[3]; } } }
                if (l == 1) {
#pragma unroll
                    for (int e = 0; e < 8; ++e) lg[e] = wave_sum(lg[e]);
                    int e0 = 0; float v0 = lg[0];
#pragma unroll
                    for (int e = 1; e < 8; ++e) if (lg[e] > v0) { v0 = lg[e]; e0 = e; }
                    int e1 = -1; float v1 = -__builtin_inff();
#pragma unroll
                    for (int e = 0; e < 8; ++e) if (e != e0 && lg[e] > v1) { v1 = lg[e]; e1 = e; }
                    if (lane == 0) { const float p0 = 1.0f / (1.0f + __expf(v1 - v0)); int* ro = ROUTE + (size_t)r * 8;
                        ro[0] = e0; ro[1] = e1; ro[2] = (int)atomicAdd(ctl + CW_CNT + e0, 1u); ro[3] = (int)atomicAdd(ctl + CW_CNT + e1, 1u); ((float*)ro)[4] = p0; ((float*)ro)[5] = 1.0f - p0; }
                }
            }
        }
        SEAM(pb + 10);
        if (l == 0) {
            if (IN(pb + 11)) {
                pg8::Gemm g{H, WGU, T, 2 * DFF, D}; pg8::StaticOrder S; S.init(T, 2 * DFF, F.G, (int)blockIdx.x);
                pg8::EpiSwiglu E{ACT, DFF, 1 << 20};
                pg8::gemm_phase<pg8::EpiSwiglu, pg8::StaticOrder, true, true>(F.lds, g, S, E);
            }
            SEAM(pb + 11);
            if (IN(pb + 12)) {
                pg8::Gemm g{ACT, WDN, T, D, DFF}; pg8::StaticOrder S; S.init(T, D, F.G, (int)blockIdx.x);
                pg8::EpiResid E{XRES, XRES, D};
                pg8::gemm_phase<pg8::EpiResid, pg8::StaticOrder, true, true>(F.lds, g, S, E);
            }
            SEAM(pb + 12);
            if (IN(pb + 13)) { for (int r = F.gw; r < T; r += F.NGW) rms_row(XRES + (size_t)r * D, mix_norm_w + D, H + (size_t)r * D, F.lane); }
            SEAM(pb + 13);
            SEAM(pb + 14);
        } else {
            int off[9]; off[0] = 0;
#pragma unroll
            for (int e = 0; e < 8; ++e) { const int c = (int)__hip_atomic_load(ctl + CW_CNT + e, __ATOMIC_RELAXED, __HIP_MEMORY_SCOPE_AGENT); off[e + 1] = off[e] + ((c + 255) & ~255); }
            if (IN(pb + 11)) {
                for (int it = F.gw; it < T * 2; it += F.NGW) { const int t = it >> 1, k = it & 1; int* ro = ROUTE + (size_t)t * 8; const int e = ro[k], pos = ro[2 + k];
                    int base = 0;
#pragma unroll
                    for (int q = 0; q < 8; ++q) if (e == q) base = off[q];
                    const int slot = base + pos; if (F.lane == 0) ro[6 + k] = slot;
                    const v4u* src = (const v4u*)(H + (size_t)t * D); v4u* dst = (v4u*)(HG + (size_t)slot * D);
#pragma unroll
                    for (int j = 0; j < 4; ++j) dst[F.lane + 64 * j] = src[F.lane + 64 * j]; }
#pragma unroll
                for (int e = 0; e < 8; ++e) { const int c = (int)__hip_atomic_load(ctl + CW_CNT + e, __ATOMIC_RELAXED, __HIP_MEMORY_SCOPE_AGENT);
                    for (int rr = off[e] + c + F.gw; rr < off[e + 1]; rr += F.NGW) { v4u* dst = (v4u*)(HG + (size_t)rr * D);
#pragma unroll
                        for (int j = 0; j < 4; ++j) dst[F.lane + 64 * j] = (v4u){0u, 0u, 0u, 0u}; } }
            }
            SEAM(pb + 11);
            if (IN(pb + 12)) {
                if (F.tid == 0) { int cu = 0;
#pragma unroll
                    for (int e = 0; e < 8; ++e) { const int ne = (off[e + 1] - off[e]) >> 8; MTAB[e] = ne; MTAB[8 + e] = off[e] >> 8; MTAB[16 + e] = cu; cu += ne * 56; } MTAB[24] = cu; MTAB[25] = cu; }
                __syncthreads();
                pg8::Gemm g{HG, WEGU, MAXSLOT, NEXP * 2 * EFF, D}; pg8::MoeOrder S{(const LAS int*)MTAB, 56, F.G, (int)blockIdx.x};
                pg8::EpiSwiglu E{EACT, EFF, 56};
                pg8::gemm_phase<pg8::EpiSwiglu, pg8::MoeOrder, true, true>(F.lds, g, S, E);
            }
            SEAM(pb + 12);
            if (IN(pb + 13)) {
                __syncthreads();
                if (F.tid == 0) { int cu = 0;
#pragma unroll
                    for (int e = 0; e < 8; ++e) { const int ne = (off[e + 1] - off[e]) >> 8; MTAB[e] = ne; MTAB[8 + e] = off[e] >> 8; MTAB[16 + e] = cu; cu += ne * 8; } MTAB[24] = cu; MTAB[25] = cu; }
                __syncthreads();
                pg8::Gemm g{EACT, WEDN, MAXSLOT, NEXP * D, EFF}; pg8::MoeOrder S{(const LAS int*)MTAB, 8, F.G, (int)blockIdx.x};
                pg8::EpiStoreF32 E{Y, D, 8};
                pg8::gemm_phase<pg8::EpiStoreF32, pg8::MoeOrder, true, true>(F.lds, g, S, E);
            }
            SEAM(pb + 13);
            if (IN(pb + 14)) {
                const int lane = F.lane;
                for (int r = F.gw; r < T; r += F.NGW) { const int* ro = ROUTE + (size_t)r * 8; const float p0 = ((const float*)ro)[4], p1 = ((const float*)ro)[5]; const float* y0 = Y + (size_t)ro[6] * D; const float* y1 = Y + (size_t)ro[7] * D;
                    const float* xrow = XRES + (size_t)r * D; f32x4 v[8]; float ss = 0.f;
#pragma unroll
                    for (int j = 0; j < 8; ++j) { const int o = 4 * (lane + 64 * j); v[j] = *(const f32x4*)(xrow + o) + *(const f32x4*)(y0 + o) * p0 + *(const f32x4*)(y1 + o) * p1; ss += (v[j][0] * v[j][0] + v[j][1] * v[j][1]) + (v[j][2] * v[j][2] + v[j][3] * v[j][3]); }
                    const float rstd = rsqrtf(wave_sum(ss) * (1.f / D) + EPS);
#pragma unroll
                    for (int j = 0; j < 8; ++j) { const int o = 4 * (lane + 64 * j); const f32x4 ww = *(const f32x4*)(final_norm_w + o); *(f32x4*)(args.out + (size_t)r * D + o) = v[j] * rstd * ww; } }
            }
        }
    }
#undef IN
#undef SEAM
}

extern "C" void kernel_launch(void* const* d_in, const int* in_sizes, int n_in, void* d_out, int out_size, void* d_ws, size_t ws_size, hipStream_t stream) {
    static int grid = 0;
    if (grid == 0) {
        if (n_in != 24 || out_size != T * D || ws_size < WS_END) { fprintf(stderr, "kernel_launch: unexpected shapes (n_in %d, out %d, ws %zu < %zu)\n", n_in, out_size, ws_size, (size_t)WS_END); grid = -1; return; }
        int dev = 0, cus = 0, per_cu = 0;
        if (hipGetDevice(&dev) != hipSuccess || hipDeviceGetAttribute(&cus, hipDeviceAttributeMultiprocessorCount, dev) != hipSuccess) { grid = -1; return; }
        if (hipFuncSetAttribute((const void*)mk_fwd, hipFuncAttributeMaxDynamicSharedMemorySize, LDS_BYTES) != hipSuccess) { fprintf(stderr, "kernel_launch: hipFuncSetAttribute failed\n"); grid = -1; return; }
        if (hipOccupancyMaxActiveBlocksPerMultiprocessor(&per_cu, (const void*)mk_fwd, NWAVES * 64, LDS_BYTES) != hipSuccess || per_cu < 1) fprintf(stderr, "kernel_launch: occupancy query says %d\n", per_cu);
        (void)hipGetLastError();
        grid = cus;
    }
    if (grid < 0) return;
    (void)hipMemsetAsync((char*)d_ws + WS_CTL, 0, CTL_BYTES, stream);
    Args a{};
    for (int i = 0; i < 24; ++i) a.in[i] = d_in[i];
    a.out = (float*)d_out; a.ws = (unsigned char*)d_ws;
#if MK_ONE_LAUNCH
    a.ph_lo = 0; a.ph_hi = NPH;
    hipLaunchKernelGGL(mk_fwd, dim3(grid), dim3(NWAVES * 64), LDS_BYTES, stream, a);
#else
    for (int p = 0; p < NPH; ++p) { a.ph_lo = p; a.ph_hi = p + 1; hipLaunchKernelGGL(mk_fwd, dim3(grid), dim3(NWAVES * 64), LDS_BYTES, stream, a); }
#endif
}
```

```cpp
#include <hip/hip_runtime.h>
#include <cstdio>
#include <cstdint>
#define MK_ONE_LAUNCH 1
namespace pg8 {
#define PG8_LAS __attribute__((address_space(3)))
typedef unsigned short bf16_t;
typedef short bf16x8 __attribute__((ext_vector_type(8)));
typedef float f32x4 __attribute__((ext_vector_type(4)));
typedef unsigned u32x4 __attribute__((ext_vector_type(4)));
constexpr int BM = 256, BK = 64, HALF = 128, HTB = HALF * BK * 2  , STAGE_BYTES = 8 * HTB, NXCD = 8, WGM = 8;

__host__ __device__ __forceinline__ int lds_byte(int r, int c) { const int st = (r >> 4) * 2 + (c >> 5), rr = r & 15, cc = c & 31, ob = rr * 64 + cc * 2; return st * 1024 + (ob ^ (((ob >> 9) & 1) << 5)); }
__host__ __device__ __forceinline__ void stage_rc(int b, int& R, int& C) { const int st = b / 1024, sb = b % 1024, swz = sb ^ (((sb >> 9) & 1) << 5); R = (st >> 1) * 16 + swz / 64; C = (st & 1) * 32 + (swz % 64) / 2; }
__host__ __device__ __forceinline__ int perm32(int rho) { const int n = rho >> 4, i = rho & 15; return 8 * (i >> 2) + 4 * n + (i & 3); }

struct Unit { int pm, pn; };
struct Gemm { const bf16_t* A; const bf16_t* Bt; int M, N, K; };

struct StaticOrder {
    int nM, nN, nwg, G, c;
    __host__ __device__ void init(int M, int N, int G_, int c_) { nM = M / BM; nN = N / BM; nwg = nM * nN; G = G_; c = c_; }
    __host__ __device__ bool next(int i, Unit& u) const {
        const long L = (long)i * G + c; if (L >= nwg) return false;
        int wgid = (int)L; { const int q = nwg / NXCD, r = nwg % NXCD, xcd = wgid % NXCD, off = wgid / NXCD; wgid = (xcd < r ? xcd * (q + 1) : r * (q + 1) + (xcd - r) * q) + off; }
        const int nig = WGM * nN, gid = wgid / nig, fm = gid * WGM, gsz = (nM - fm) < WGM ? (nM - fm) : WGM;
        u.pm = fm + ((wgid % nig) % gsz); u.pn = (wgid % nig) / gsz; return true;
    }
    __device__ __forceinline__ void a_ready(const Unit&) const {}
    __device__ __forceinline__ void done(const Unit&) const {}
};

__device__ __forceinline__ unsigned cvt_pk_bf16(float lo, float hi) { unsigned r; asm volatile("v_cvt_pk_bf16_f32 %0, %1, %2" : "=v"(r) : "v"(lo), "v"(hi)); return r; }
typedef float f32x2 __attribute__((ext_vector_type(2)));
__device__ __forceinline__ float fsilu(float v) { return v / (1.0f + __expf(-v)); }
__device__ __forceinline__ float fsigm(float v) { return 1.0f / (1.0f + __expf(-v)); }
__device__ __forceinline__ void st8bf(bf16_t* p, f32x4 v0, f32x4 v1) { u32x4 w; w.x = cvt_pk_bf16(v0[0], v0[1]); w.y = cvt_pk_bf16(v0[2], v0[3]); w.z = cvt_pk_bf16(v1[0], v1[1]); w.w = cvt_pk_bf16(v1[2], v1[3]); *(u32x4*)p = w; }
__device__ __forceinline__ bf16_t f2bf1(float f) { unsigned u = __builtin_bit_cast(unsigned, f); return (bf16_t)((u + 0x7fffu + ((u >> 16) & 1u)) >> 16); }

struct EpiIn {
    static constexpr bool PERM = true, AFTER_DRAIN = false;
    bf16_t *RQ, *RK, *RV, *RG, *BQKV, *BZ, *CQ, *CK, *CVT, *GATES; float* BBA;
    __device__ __forceinline__ void operator()(const f32x4 (&acc)[2][2][4][2], const Unit& u, int wr, int wc, int fr, int fq) const {
        const int pn = u.pn, b = u.pm >> 3;
        const int rowt = u.pm * BM + wr * 64 + fr;
        const int cin = wc * 32 + 8 * fq;
        if (pn < 12 || (pn >= 32 && pn < 40)) {
            auto heads = [&](bf16_t* base, int hb, float sc) __attribute__((always_inline)) {
#pragma unroll
                for (int ai = 0; ai < 2; ++ai)
#pragma unroll
                    for (int m = 0; m < 4; ++m) { const int s = (rowt + ai * HALF + m * 16) - b * 2048;
#pragma unroll
                        for (int bj = 0; bj < 2; ++bj) st8bf(base + ((size_t)((b * 8 + hb + bj) * 2048 + s)) * 128 + cin, acc[ai][bj][m][0] * sc, acc[ai][bj][m][1] * sc); } };
            if (pn < 4) heads(RQ, pn * 2, 1.f); else if (pn < 8) heads(RK, (pn - 4) * 2, 0.08838834764831845f); else if (pn < 12) heads(RV, (pn - 8) * 2, 1.f);
            else if (pn < 36) heads(CQ, (pn - 32) * 2, 1.f); else heads(CK, (pn - 36) * 2, 1.f);
        } else if (pn >= 40 && pn < 44) {
            const int h = pn - 40;
#pragma unroll
            for (int ai = 0; ai < 2; ++ai)
#pragma unroll
                for (int m = 0; m < 4; ++m) { const int s = (rowt + ai * HALF + m * 16) - b * 2048;
#pragma unroll
                    for (int bj = 0; bj < 2; ++bj)
#pragma unroll
                        for (int n = 0; n < 2; ++n)
#pragma unroll
                            for (int e = 0; e < 4; ++e) CVT[((size_t)((b * 4 + h) * 256 + bj * HALF + cin + 4 * n + e)) * 2048 + s] = f2bf1(acc[ai][bj][m][n][e]); }
        } else if (pn == 68) {
            if (wc == 0 && fq < 2) {
#pragma unroll
                for (int ai = 0; ai < 2; ++ai)
#pragma unroll
                    for (int m = 0; m < 4; ++m) { float* p = BBA + (size_t)(rowt + ai * HALF + m * 16) * 16 + 8 * fq; *(f32x4*)p = acc[ai][0][m][0]; *(f32x4*)(p + 4) = acc[ai][0][m][1]; }
            }
        } else {
            auto rows = [&](bf16_t* base, int ldc, int c0, int act) __attribute__((always_inline)) {
#pragma unroll
                for (int ai = 0; ai < 2; ++ai)
#pragma unroll
                    for (int m = 0; m < 4; ++m) { bf16_t* rowp = base + (size_t)(rowt + ai * HALF + m * 16) * ldc + c0 + cin;
#pragma unroll
                        for (int bj = 0; bj < 2; ++bj) { f32x4 v0 = acc[ai][bj][m][0], v1 = acc[ai][bj][m][1];
                            if (act == 1) {
#pragma unroll
                                for (int e = 0; e < 4; ++e) { v0[e] = fsilu(v0[e]); v1[e] = fsilu(v1[e]); } }
                            else if (act == 2) {
#pragma unroll
                                for (int e = 0; e < 4; ++e) { v0[e] = fsigm(v0[e]); v1[e] = fsigm(v1[e]); } }
                            st8bf(rowp + bj * HALF, v0, v1); } } };
            if (pn < 16) rows(RG, 1024, (pn - 12) * 256, 1); else if (pn < 28) rows(BQKV, 3072, (pn - 16) * 256, 0);
            else if (pn < 32) rows(BZ, 1024, (pn - 28) * 256, 1); else rows(GATES, 6144, (pn - 44) * 256, 2);
        }
    }
};

struct EpiHeads {
    static constexpr bool PERM = true, AFTER_DRAIN = false;
    bf16_t* O; bf16_t* VT; int NH, rpb_shift  , vt_from_pn;
    __device__ __forceinline__ void operator()(const f32x4 (&acc)[2][2][4][2], const Unit& u, int wr, int wc, int fr, int fq) const {
        const int rowt = u.pm * BM + wr * 64 + fr, cin = wc * 32 + 8 * fq, rpb = 1 << rpb_shift;
        if (u.pn < vt_from_pn) {
#pragma unroll
            for (int ai = 0; ai < 2; ++ai)
#pragma unroll
                for (int m = 0; m < 4; ++m) { const int row = rowt + ai * HALF + m * 16, b = row >> rpb_shift, s = row & (rpb - 1);
#pragma unroll
                    for (int bj = 0; bj < 2; ++bj) st8bf(O + ((size_t)((b * NH + u.pn * 2 + bj) * rpb + s)) * 128 + cin, acc[ai][bj][m][0], acc[ai][bj][m][1]); }
        } else {
            const int hb = (u.pn - vt_from_pn) * 2;
#pragma unroll
            for (int ai = 0; ai < 2; ++ai)
#pragma unroll
                for (int m = 0; m < 4; ++m) { const int row = rowt + ai * HALF + m * 16, b = row >> rpb_shift, s = row & (rpb - 1);
#pragma unroll
                    for (int bj = 0; bj < 2; ++bj)
#pragma unroll
                        for (int n = 0; n < 2; ++n)
#pragma unroll
                            for (int e = 0; e < 4; ++e) VT[((size_t)((b * NH + hb + bj) * 128 + cin + 4 * n + e)) * rpb + s] = f2bf1(acc[ai][bj][m][n][e]); }
        }
    }
};

struct EpiResid {
    static constexpr bool PERM = false, AFTER_DRAIN = false;
    const float* in; float* out; int ldc;
    __device__ __forceinline__ void operator()(const f32x4 (&acc)[2][2][4][2], const Unit& u, int wr, int wc, int fr, int fq) const {
        const int row0 = u.pm * BM + wr * 64 + fr, col0 = u.pn * BM + wc * 32 + 4 * fq;
#pragma unroll
        for (int ai = 0; ai < 2; ++ai)
#pragma unroll
            for (int m = 0; m < 4; ++m) { const size_t off = (size_t)(row0 + ai * HALF + m * 16) * ldc + col0;
#pragma unroll
                for (int bj = 0; bj < 2; ++bj)
#pragma unroll
                    for (int n = 0; n < 2; ++n) { const f32x4 x = *(const f32x4*)(in + off + bj * HALF + n * 16); *(f32x4*)(out + off + bj * HALF + n * 16) = x + acc[ai][bj][m][n]; } }
    }
};

struct EpiBranch {
    static constexpr bool PERM = false, AFTER_DRAIN = false;
    float* M; bf16_t* OUT; const bf16_t* GATES; int seg;
    __device__ __forceinline__ void operator()(const f32x4 (&acc)[2][2][4][2], const Unit& u, int wr, int wc, int fr, int fq) const {
        typedef unsigned u32x2 __attribute__((ext_vector_type(2)));
        const int row0 = u.pm * BM + wr * 64 + fr, col0 = u.pn * BM + wc * 32 + 4 * fq;
#pragma unroll
        for (int ai = 0; ai < 2; ++ai)
#pragma unroll
            for (int m = 0; m < 4; ++m) { const int row = row0 + ai * HALF + m * 16;
#pragma unroll
                for (int bj = 0; bj < 2; ++bj)
#pragma unroll
                    for (int n = 0; n < 2; ++n) { const int col = col0 + bj * HALF + n * 16; const size_t off = (size_t)row * 2048 + col;
                        const u32x2 gw = *(const u32x2*)(GATES + (size_t)row * 6144 + seg * 2048 + col);
                        f32x4 g; g[0] = __uint_as_float(gw.x << 16); g[1] = __uint_as_float(gw.x & 0xffff0000u); g[2] = __uint_as_float(gw.y << 16); g[3] = __uint_as_float(gw.y & 0xffff0000u);
                        f32x4 v = g * acc[ai][bj][m][n];
                        if (seg > 0) v = v + *(const f32x4*)(M + off);
                        if (seg < 2) *(f32x4*)(M + off) = v;
                        else { u32x2 w; w.x = cvt_pk_bf16(v[0], v[1]); w.y = cvt_pk_bf16(v[2], v[3]); *(u32x2*)(OUT + off) = w; } } }
    }
};

struct EpiSwiglu {
    static constexpr bool PERM = true, AFTER_DRAIN = false;
    bf16_t* O; int ldc, npn;
    __device__ __forceinline__ void operator()(const f32x4 (&acc)[2][2][4][2], const Unit& u, int wr, int wc, int fr, int fq) const {
        const int row0 = u.pm * BM + wr * 64 + fr, col0 = (u.pn % npn) * HALF + wc * 32 + 8 * fq;
#pragma unroll
        for (int ai = 0; ai < 2; ++ai)
#pragma unroll
            for (int m = 0; m < 4; ++m) { f32x4 v0, v1;
#pragma unroll
                for (int e = 0; e < 4; ++e) { v0[e] = fsilu(acc[ai][0][m][0][e]) * acc[ai][1][m][0][e]; v1[e] = fsilu(acc[ai][0][m][1][e]) * acc[ai][1][m][1][e]; }
                st8bf(O + (size_t)(row0 + ai * HALF + m * 16) * ldc + col0, v0, v1); }
    }
};

struct EpiStoreF32 {
    static constexpr bool PERM = false, AFTER_DRAIN = false;
    float* Y; int ldc, npn;
    __device__ __forceinline__ void operator()(const f32x4 (&acc)[2][2][4][2], const Unit& u, int wr, int wc, int fr, int fq) const {
        const int row0 = u.pm * BM + wr * 64 + fr, col0 = (u.pn % npn) * BM + wc * 32 + 4 * fq;
#pragma unroll
        for (int ai = 0; ai < 2; ++ai)
#pragma unroll
            for (int m = 0; m < 4; ++m) { float* rowp = Y + (size_t)(row0 + ai * HALF + m * 16) * ldc + col0;
#pragma unroll
                for (int bj = 0; bj < 2; ++bj)
#pragma unroll
                    for (int n = 0; n < 2; ++n) *(f32x4*)(rowp + bj * HALF + n * 16) = acc[ai][bj][m][n]; }
    }
};

struct MoeOrder {
    const PG8_LAS int* T; int npn, G, c;
    __device__ __forceinline__ bool next(int i, Unit& u) const {
        const int total = T[25]; const long L = (long)i * G + c; if (L >= total) return false;
        int wgid = (int)L; { const int q = total / NXCD, r = total % NXCD, xcd = wgid % NXCD, off = wgid / NXCD; wgid = (xcd < r ? xcd * (q + 1) : r * (q + 1) + (xcd - r) * q) + off; }
        int e = 0;
#pragma unroll
        for (int k = 1; k < 8; ++k) if (wgid >= T[16 + k]) e = k;
        const int loc = wgid - T[16 + e], ne = T[e];
        u.pm = T[8 + e] + loc % ne; u.pn = e * npn + loc / ne; return true;
    }
    __device__ __forceinline__ void a_ready(const Unit&) const {}
    __device__ __forceinline__ void done(const Unit&) const {}
};
template <class Epi, class Sched, bool ALIGN_EPI = false, bool SP2 = false>
__device__ __forceinline__ void gemm_phase(PG8_LAS unsigned char* lds, const Gemm g, const Sched& S, const Epi& E) {
    int tid_ = threadIdx.x; asm volatile("" : "+v"(tid_)); const int tid = tid_, wid = __builtin_amdgcn_readfirstlane(tid >> 6), lane = tid & 63, wr = wid >> 2, wc = wid & 3, fr = lane & 15, fq = lane >> 4;
    const int K = g.K, nt = K / BK;
    unsigned voffA[2], voffB[2];
#pragma unroll
    for (int i = 0; i < 2; ++i) { int R, C; stage_rc(tid * 16 + i * 8192, R, C); const int Rb = Epi::PERM ? ((R & ~31) + perm32(R & 31)) : R;
        voffA[i] = (unsigned)(R * K + C) * 2u; voffB[i] = (unsigned)(Rb * K + C) * 2u; }
    const size_t kstep = (size_t)(BK * 2);
    const size_t hstep = (size_t)HALF * K * 2;
    const size_t tstep = 2 * hstep;
    const unsigned ldsw = (unsigned)wid * 1024u;
    const int aoff = lds_byte(wr * 64 + fr, fq * 8), boff = lds_byte(wc * 32 + fr, fq * 8);
#define PG8_SA(b, h) (((b) * 2 + (h)) * HTB)
#define PG8_SB(b, h) ((4 + (b) * 2 + (h)) * HTB)
#define PG8_STAGE(bufoff, gbase, voff) do { _Pragma("unroll") for (int _i = 0; _i < 2; ++_i) \
        __builtin_amdgcn_global_load_lds((const unsigned*)((const char*)(gbase) + (voff)[_i]), (PG8_LAS unsigned*)(lds + (bufoff) + ldsw + _i * 8192), 16, 0, 0); } while (0)
#define PG8_LDA(dst, b, h) do { _Pragma("unroll") for (int m = 0; m < 4; ++m) _Pragma("unroll") for (int k = 0; k < 2; ++k) dst[m][k] = *(const PG8_LAS bf16x8*)(lds + PG8_SA(b, h) + aoff + m * 2048 + k * 1024); } while (0)
#define PG8_LDB(dst, b, h) do { _Pragma("unroll") for (int n = 0; n < 2; ++n) _Pragma("unroll") for (int k = 0; k < 2; ++k) dst[n][k] = *(const PG8_LAS bf16x8*)(lds + PG8_SB(b, h) + boff + n * 2048 + k * 1024); } while (0)
#define PG8_MMA(ai, bj, At, Bt) do { __builtin_amdgcn_s_setprio(1); _Pragma("unroll") for (int m = 0; m < 4; ++m) _Pragma("unroll") for (int n = 0; n < 2; ++n) _Pragma("unroll") for (int k = 0; k < 2; ++k) \
        acc[ai][bj][m][n] = __builtin_amdgcn_mfma_f32_16x16x32_bf16(Bt[n][k], At[m][k], acc[ai][bj][m][n], 0, 0, 0); __builtin_amdgcn_s_setprio(0); } while (0)
#define PG8_WAIT_V(n) asm volatile("s_waitcnt vmcnt(" #n ")" ::: "memory")
#define PG8_WAIT_L(n) asm volatile("s_waitcnt lgkmcnt(" #n ")" ::: "memory")
#define PG8_BAR __builtin_amdgcn_s_barrier()
#define PG8_SCHED __builtin_amdgcn_sched_barrier(0)
    Unit cur, nxt; int ui = 0;
    if (!S.next(0, cur)) return;
    f32x4 acc[2][2][4][2];
#pragma unroll
    for (int a = 0; a < 2; ++a)
#pragma unroll
        for (int b = 0; b < 2; ++b)
#pragma unroll
            for (int m = 0; m < 4; ++m)
#pragma unroll
                for (int n = 0; n < 2; ++n) acc[a][b][m][n] = (f32x4){0.f, 0.f, 0.f, 0.f};
    bf16x8 At[4][2], B0[2][2], B1[2][2];
    const char* cA = (const char*)g.A + (size_t)cur.pm * tstep; const char* cB = (const char*)g.Bt + (size_t)cur.pn * tstep;
    S.a_ready(cur);
    if constexpr (SP2) {
        PG8_STAGE(PG8_SB(0, 0), cB, voffB); PG8_STAGE(PG8_SB(0, 1), cB + hstep, voffB); PG8_STAGE(PG8_SA(0, 0), cA, voffA); PG8_STAGE(PG8_SA(0, 1), cA + hstep, voffA);
        if (wr == 1) PG8_BAR;
        PG8_WAIT_V(2); PG8_BAR;
        PG8_STAGE(PG8_SB(1, 0), cB + kstep, voffB); PG8_STAGE(PG8_SA(1, 0), cA + kstep, voffA); PG8_STAGE(PG8_SB(1, 1), cB + hstep + kstep, voffB);
        PG8_WAIT_V(6); PG8_BAR;
    } else {
        PG8_STAGE(PG8_SB(0, 0), cB, voffB); PG8_STAGE(PG8_SA(0, 0), cA, voffA); PG8_STAGE(PG8_SB(0, 1), cB + hstep, voffB); PG8_STAGE(PG8_SA(0, 1), cA + hstep, voffA);
        if (wr == 1) PG8_BAR;
        PG8_WAIT_V(4); PG8_BAR;
        PG8_STAGE(PG8_SB(1, 0), cB + kstep, voffB); PG8_STAGE(PG8_SA(1, 0), cA + kstep, voffA); PG8_STAGE(PG8_SB(1, 1), cB + hstep + kstep, voffB);
        PG8_WAIT_V(6); PG8_BAR;
    }
    for (;;) {
        const bool has_next = S.next(ui + 1, nxt);
        const char* nA = has_next ? (const char*)g.A + (size_t)nxt.pm * tstep : cA; const char* nB = has_next ? (const char*)g.Bt + (size_t)nxt.pn * tstep : cB;
        for (int t = 0; t < nt; t += 2) {
            const bool last = (t == nt - 2);
            const char* a1 = cA + (size_t)(t + 1) * kstep;
            const char* a2 = last ? nA : cA + (size_t)(t + 2) * kstep; const char* b2 = last ? nB : cB + (size_t)(t + 2) * kstep;
            const char* a3 = a2 + kstep; const char* b3 = b2 + kstep;
            if (last && has_next) S.a_ready(nxt);
            if constexpr (SP2) {
            PG8_LDB(B0, 0, 0); PG8_LDB(B1, 0, 1); PG8_SCHED; PG8_LDA(At, 0, 0); PG8_STAGE(PG8_SA(1, 1), a1 + hstep, voffA);
            PG8_WAIT_V(8); PG8_WAIT_L(0); PG8_BAR; PG8_MMA(0, 0, At, B0); PG8_MMA(0, 1, At, B1); PG8_BAR; PG8_SCHED;
            PG8_LDA(At, 0, 1); PG8_STAGE(PG8_SB(0, 0), b2, voffB); PG8_STAGE(PG8_SB(0, 1), b2 + hstep, voffB); PG8_STAGE(PG8_SA(0, 0), a2, voffA);
            PG8_WAIT_V(8); PG8_WAIT_L(0); PG8_BAR; PG8_MMA(1, 0, At, B0); PG8_MMA(1, 1, At, B1); PG8_BAR; PG8_SCHED;
            PG8_LDB(B0, 1, 0); PG8_LDB(B1, 1, 1); PG8_SCHED; PG8_LDA(At, 1, 0); PG8_STAGE(PG8_SA(0, 1), a2 + hstep, voffA);
            PG8_WAIT_V(8); PG8_WAIT_L(0); PG8_BAR; PG8_MMA(0, 0, At, B0); PG8_MMA(0, 1, At, B1); PG8_BAR; PG8_SCHED;
            PG8_LDA(At, 1, 1); PG8_STAGE(PG8_SB(1, 0), b3, voffB); PG8_STAGE(PG8_SB(1, 1), b3 + hstep, voffB); PG8_STAGE(PG8_SA(1, 0), a3, voffA);
            PG8_WAIT_V(8); PG8_WAIT_L(0); PG8_BAR; PG8_MMA(1, 0, At, B0); PG8_MMA(1, 1, At, B1); PG8_BAR; PG8_SCHED;
            } else {
            PG8_LDB(B0, 0, 0); PG8_SCHED; PG8_LDA(At, 0, 0); PG8_STAGE(PG8_SA(1, 1), a1 + hstep, voffA);
            PG8_WAIT_L(8); PG8_BAR; PG8_WAIT_L(0); PG8_MMA(0, 0, At, B0); PG8_BAR; PG8_SCHED;
            PG8_LDB(B1, 0, 1); PG8_STAGE(PG8_SB(0, 0), b2, voffB);
            PG8_BAR; PG8_WAIT_L(0); PG8_MMA(0, 1, At, B1); PG8_BAR;
            PG8_LDA(At, 0, 1); PG8_STAGE(PG8_SA(0, 0), a2, voffA);
            PG8_BAR; PG8_WAIT_L(0); PG8_MMA(1, 0, At, B0); PG8_BAR; PG8_SCHED;
            PG8_STAGE(PG8_SB(0, 1), b2 + hstep, voffB);
            PG8_WAIT_V(6); PG8_BAR; PG8_MMA(1, 1, At, B1); PG8_BAR;
            PG8_LDB(B0, 1, 0); PG8_SCHED; PG8_LDA(At, 1, 0); PG8_STAGE(PG8_SA(0, 1), a2 + hstep, voffA);
            PG8_WAIT_L(8); PG8_BAR; PG8_WAIT_L(0); PG8_MMA(0, 0, At, B0); PG8_BAR; PG8_SCHED;
            PG8_LDB(B1, 1, 1); PG8_STAGE(PG8_SB(1, 0), b3, voffB);
            PG8_BAR; PG8_WAIT_L(0); PG8_MMA(0, 1, At, B1); PG8_BAR;
            PG8_LDA(At, 1, 1); PG8_STAGE(PG8_SA(1, 0), a3, voffA);
            PG8_BAR; PG8_WAIT_L(0); PG8_MMA(1, 0, At, B0); PG8_BAR; PG8_SCHED;
            PG8_STAGE(PG8_SB(1, 1), b3 + hstep, voffB);
            PG8_WAIT_V(6); PG8_BAR; PG8_MMA(1, 1, At, B1); PG8_BAR;
            }
        }
        if constexpr (ALIGN_EPI) { if (wr == 0) PG8_BAR; }
        if constexpr (!Epi::AFTER_DRAIN) { E(acc, cur, wr, wc, fr, fq); S.done(cur); }
        if (!has_next) break;
#pragma unroll
        for (int a = 0; a < 2; ++a)
#pragma unroll
            for (int b = 0; b < 2; ++b)
#pragma unroll
                for (int m = 0; m < 4; ++m)
#pragma unroll
                    for (int n = 0; n < 2; ++n) acc[a][b][m][n] = (f32x4){0.f, 0.f, 0.f, 0.f};
        cur = nxt; cA = nA; cB = nB; ++ui;
        if constexpr (ALIGN_EPI) { if (wr == 1) PG8_BAR; }
    }
    PG8_WAIT_V(0);
    if constexpr (!ALIGN_EPI) { if (wr == 0) PG8_BAR; }
    PG8_BAR;
    if constexpr (Epi::AFTER_DRAIN) { E.fused(acc, cur, wr, wc, fr, fq, lds, wid, lane); S.done(cur); }
#undef PG8_SA
#undef PG8_SB
#undef PG8_STAGE
#undef PG8_LDA
#undef PG8_LDB
#undef PG8_MMA
#undef PG8_WAIT_V
#undef PG8_WAIT_L
#undef PG8_BAR
#undef PG8_SCHED
}
}
#ifndef MK_ONE_LAUNCH
#define MK_ONE_LAUNCH 0
#endif
constexpr int NWAVES = 8;
constexpr int NB = 4, SEQ = 2048, T = NB * SEQ, D = 2048, MEML = 256, MEMR = NB * MEML;
constexpr int NINP = 17664;
constexpr int DFF = 5632, EFF = 7168, NEXP = 8, MAXSLOT = 18432;
constexpr float EPS = 1e-6f;
constexpr int NPL = 15, NPH = 2 + 2 * NPL;

constexpr size_t MiB = 1u << 20;
constexpr size_t WS_CTL = 0, CTL_BYTES = 1 * MiB;
constexpr size_t WS_WIN = WS_CTL + CTL_BYTES;
constexpr size_t WS_WBR = WS_WIN + 2 * 69 * MiB;
constexpr size_t WS_WOUT = WS_WBR + 2 * 12 * MiB;
constexpr size_t WS_WQ = WS_WOUT + 2 * 8 * MiB;
constexpr size_t WS_WKV = WS_WQ + 2 * 2 * MiB;
constexpr size_t WS_WO = WS_WKV + 2 * 4 * MiB;
constexpr size_t WS_WGU = WS_WO + 2 * 2 * MiB;
constexpr size_t WS_WDN = WS_WGU + 44 * MiB;
constexpr size_t WS_WEGU = WS_WDN + 22 * MiB;
constexpr size_t WS_WEDN = WS_WEGU + 448 * MiB;
constexpr size_t WS_XRES = WS_WEDN + 224 * MiB;
constexpr size_t WS_H = WS_XRES + 64 * MiB;
constexpr size_t WS_RQ = WS_H + 32 * MiB, WS_RK = WS_RQ + 16 * MiB, WS_RV = WS_RK + 16 * MiB, WS_RG = WS_RV + 16 * MiB;
constexpr size_t WS_BQKV = WS_RG + 16 * MiB;
constexpr size_t WS_BZ = WS_BQKV + 48 * MiB;
constexpr size_t WS_BBA = WS_BZ + 16 * MiB;
constexpr size_t WS_CQ = WS_BBA + 1 * MiB, WS_CK = WS_CQ + 16 * MiB, WS_CVT = WS_CK + 16 * MiB;
constexpr size_t WS_GATES = WS_CVT + 16 * MiB;
constexpr size_t WS_GQ = WS_GATES + 96 * MiB, WS_GK = WS_GQ + 16 * MiB, WS_GV = WS_GK + 16 * MiB;
constexpr size_t WS_GG = WS_GV + 16 * MiB, WS_GB = WS_GG + 1 * MiB;
constexpr size_t WS_OA = WS_GB + 1 * MiB, WS_OB = WS_OA + 32 * MiB;
constexpr size_t WS_O12 = WS_OB + 32 * MiB;
constexpr size_t WS_OCAT = WS_O12 + 64 * MiB;
constexpr size_t WS_MERGE = WS_OCAT + 48 * MiB;
constexpr size_t WS_MERGEB = WS_MERGE + 64 * MiB;
constexpr size_t WS_MEMN = WS_MERGEB + 32 * MiB;
constexpr size_t WS_KX = WS_MEMN + 8 * MiB;
constexpr size_t WS_VXT = WS_KX + 2 * MiB;
constexpr size_t WS_QX = WS_VXT + 2 * MiB;
constexpr size_t WS_OX = WS_QX + 8 * MiB;
constexpr size_t WS_ACT = WS_OX + 8 * MiB;
constexpr size_t WS_HG = WS_ACT + 88 * MiB;
constexpr size_t WS_EACT = WS_HG + 72 * MiB;
constexpr size_t WS_Y = WS_EACT + 252 * MiB;
constexpr size_t WS_ROUTE = WS_Y + 144 * MiB;
constexpr size_t WS_END = WS_ROUTE + 1 * MiB;
constexpr int CW_CNT = 64;
constexpr int CW_BAR = 4096;

constexpr int RING_BYTES = 131072, MISC_OFF = RING_BYTES + 320, LDS_BYTES = 147456;

#define GAS __attribute__((address_space(1)))
#define LAS __attribute__((address_space(3)))
#define DI __device__ __forceinline__
typedef unsigned short bf16;
typedef unsigned v4u __attribute__((ext_vector_type(4)));
typedef unsigned v2u __attribute__((ext_vector_type(2)));
typedef float f32x4 __attribute__((ext_vector_type(4)));
typedef short bf16x8 __attribute__((ext_vector_type(8)));
typedef short s16x4 __attribute__((ext_vector_type(4)));
DI float bf2f(unsigned v) { return __uint_as_float(v << 16); }
DI unsigned f2bf(float f) { unsigned u = __builtin_bit_cast(unsigned, f); return (u + 0x7fffu + ((u >> 16) & 1u)) >> 16; }
DI unsigned pk2(float lo, float hi) { return f2bf(lo) | (f2bf(hi) << 16); }
DI float wave_sum(float v) {
#pragma unroll
    for (int o = 1; o < 64; o <<= 1) v += __shfl_xor(v, o);
    return v;
}

#define XB_TMO      128
#define XB_XCNT(j)  (256  + 64 * (j))
#define XB_XSUB(j)  (1280 + 64 * (j))
#define XB_XGEN(j)  (2304 + 64 * (j))
#define XB_TOP      3328
#define XB_TOPGEN   3392
#define XCD_BAR_WORDS 3456
#define XB_SPIN_CAP (1u << 18)

__device__ __forceinline__ unsigned xb_ld(unsigned* p)              { return __hip_atomic_load(p, __ATOMIC_RELAXED, __HIP_MEMORY_SCOPE_AGENT); }
__device__ __forceinline__ unsigned xb_add(unsigned* p, unsigned v) { return __hip_atomic_fetch_add(p, v, __ATOMIC_RELAXED, __HIP_MEMORY_SCOPE_AGENT); }
__device__ __forceinline__ unsigned xb_xcc_id() { return (unsigned)__builtin_amdgcn_s_getreg((3 << 11) | 20) & 0xFu; }
#define XB_SPIN(cond, bar) do { unsigned _sp = 0; while (cond) { __builtin_amdgcn_s_sleep(1); \
    if ((++_sp & 255u) == 0u) { if (xb_ld(&(bar)[XB_TMO])) break; if (_sp > XB_SPIN_CAP) { atomicAdd(&(bar)[XB_TMO], 1u); break; } } } } while (0)

struct XcdBarrier {
    unsigned* bar; unsigned x;
    volatile LAS unsigned* st;
};

__device__ __forceinline__ XcdBarrier xcd_barrier_post(unsigned* bar, volatile LAS unsigned* st) {
    XcdBarrier b; b.bar = bar; b.x = xb_xcc_id(); b.st = st;
    if (threadIdx.x == 0) (void)xb_add(&bar[XB_XCNT(b.x)], 1u);
    return b;
}
__device__ __forceinline__ void xcd_barrier_complete(unsigned* bar, unsigned x, unsigned& nloc, unsigned& nx) {
    const unsigned G = gridDim.x * gridDim.y * gridDim.z;
    unsigned sum, cnt, mine, sp = 0u;
    for (;;) {
        sum = 0u; cnt = 0u; mine = 0u;
#pragma unroll
        for (unsigned j = 0; j < 16; ++j) { const unsigned c = xb_ld(&bar[XB_XCNT(j)]); sum += c; cnt += (c > 0u) ? 1u : 0u; mine = (j == x) ? c : mine; }
        if (sum == G) break;
        __builtin_amdgcn_s_sleep(1);
        if ((++sp & 255u) == 0u) { if (xb_ld(&bar[XB_TMO])) break; if (sp > XB_SPIN_CAP) { atomicAdd(&bar[XB_TMO], 1u); break; } }
    }
    nloc = mine > 0u ? mine : 1u; nx = cnt > 0u ? cnt : 1u;
}

__device__ __forceinline__ void xcd_barrier(const XcdBarrier& b) {
    asm volatile("s_waitcnt vmcnt(0)" ::: "memory");
    __syncthreads();
    if (threadIdx.x == 0) {
        unsigned* bar = b.bar;
        __builtin_amdgcn_s_waitcnt(0);
        unsigned nloc = b.st[0], nx = b.st[1];
        if (nloc == 0u) { xcd_barrier_complete(bar, b.x, nloc, nx); b.st[0] = nloc; b.st[1] = nx; }
        const unsigned old = xb_add(&bar[XB_XSUB(b.x)], 1u);
        const unsigned gen = old / nloc;
        if (old + 1u == (gen + 1u) * nloc) {
            __builtin_amdgcn_fence(__ATOMIC_RELEASE, "agent");
            asm volatile("s_waitcnt vmcnt(0)" ::: "memory");
            const unsigned og = xb_add(&bar[XB_TOP], 1u);
            const unsigned tg = og / nx;
            if (og + 1u == (tg + 1u) * nx) xb_add(&bar[XB_TOPGEN], 1u);
            else XB_SPIN(xb_ld(&bar[XB_TOPGEN]) == tg, bar);
            __builtin_amdgcn_fence(__ATOMIC_ACQUIRE, "agent");
            xb_add(&bar[XB_XGEN(b.x)], 1u);
            asm volatile("s_waitcnt vmcnt(0)" ::: "memory");
        } else {
            XB_SPIN(xb_ld(&bar[XB_XGEN(b.x)]) == gen, bar);
            __builtin_amdgcn_fence(__ATOMIC_ACQUIRE, "agent");
            asm volatile("s_waitcnt vmcnt(0)" ::: "memory");
        }
    }
    __syncthreads();
}

struct Args { const void* in[24]; float* out; unsigned char* ws; int ph_lo, ph_hi; };

struct Frame {
    LAS unsigned char* lds;
    int tid, lane, wave, G, vcu, gw, NGW;
};

DI void conv_job(const Frame& F, const float* W, int K, int Nsrc, bf16* WT, int Ndst, int mode, int Fgu) {
    LAS unsigned* scr = (LAS unsigned*)(F.lds + F.wave * 8704);
    const int nkb = K / 64, nnb = Ndst / 64, items = nkb * nnb, lane = F.lane;
    for (int it = F.gw; it < items; it += F.NGW) {
        const int nb = it / nkb, kb = it % nkb, k0 = kb * 64, n0 = nb * 64, n = n0 + lane;
        int ns;
        if (mode == 0) ns = n;
        else if (mode == 1) ns = n < 8192 ? n : (n < 17408 ? n + 16 : (n < 17424 ? n - 17408 + 8192 : -1));
        else { const int pn = n >> 8, half = (n >> 7) & 1, j = n & 127; ns = half * Fgu + 128 * pn + j; }
        const float* src = W + (size_t)k0 * Nsrc + (ns < 0 ? 0 : ns);
#pragma unroll 8
        for (int i = 0; i < 32; ++i) { float a = src[(size_t)(2 * i) * Nsrc], b = src[(size_t)(2 * i + 1) * Nsrc]; if (ns < 0) { a = 0.f; b = 0.f; } scr[lane * 33 + i] = pk2(a, b); }
        asm volatile("s_waitcnt lgkmcnt(0)" ::: "memory");
#pragma unroll
        for (int j = 0; j < 8; ++j) { const int nn = (lane >> 3) + 8 * j, kq = lane & 7; v4u o; const LAS unsigned* s = scr + nn * 33 + 4 * kq; o.x = s[0]; o.y = s[1]; o.z = s[2]; o.w = s[3];
            *(v4u*)(WT + (size_t)(n0 + nn) * K + k0 + 8 * kq) = o; }
        asm volatile("s_waitcnt lgkmcnt(0)" ::: "memory");
    }
}

DI void rms_row(const float* xrow, const float* w, bf16* orow, int lane) {
    f32x4 v[8]; float ss = 0.f;
#pragma unroll
    for (int j = 0; j < 8; ++j) { v[j] = *(const f32x4*)(xrow + 4 * (lane + 64 * j)); ss += (v[j][0] * v[j][0] + v[j][1] * v[j][1]) + (v[j][2] * v[j][2] + v[j][3] * v[j][3]); }
    const float rstd = rsqrtf(wave_sum(ss) * (1.f / D) + EPS);
#pragma unroll
    for (int j = 0; j < 8; ++j) { const f32x4 ww = *(const f32x4*)(w + 4 * (lane + 64 * j)); v2u o; o.x = pk2(v[j][0] * rstd * ww[0], v[j][1] * rstd * ww[1]); o.y = pk2(v[j][2] * rstd * ww[2], v[j][3] * rstd * ww[3]);
        *(v2u*)(orow + 4 * (lane + 64 * j)) = o; }
}

template <bool GDN>
DI void seq_mixer(const Frame& F, int bh, const bf16* Q, const bf16* K, const bf16* V, const float* Gg, const float* Gb, float* OUT, float gamma) {
    LAS float* qs = (LAS float*)F.lds; LAS float* ks = qs + 32 * 128; LAS float* vs = ks + 32 * 128; LAS float* red = vs + 32 * 128; LAS float* gs = red + 2 * 4 * 128; LAS float* bs = gs + 32;
    const int tid = F.tid, v = tid & 127, kg = tid >> 7, b = bh >> 3, h = bh & 7;
    const size_t hb = (size_t)bh * SEQ * 128;
    float Sr[32];
#pragma unroll
    for (int i = 0; i < 32; ++i) Sr[i] = 0.f;
    for (int c0 = 0; c0 < SEQ; c0 += 32) {
        __syncthreads();
#pragma unroll
        for (int j = 0; j < 4; ++j) { const int idx = tid + 512 * j, tok = idx >> 6, d = (idx & 63) * 2; const size_t go = hb + (size_t)(c0 + tok) * 128 + d;
            const unsigned a = *(const unsigned*)(Q + go), bb = *(const unsigned*)(K + go), cc = *(const unsigned*)(V + go);
            qs[tok * 128 + d] = bf2f(a & 0xffffu); qs[tok * 128 + d + 1] = __uint_as_float(a & 0xffff0000u);
            ks[tok * 128 + d] = bf2f(bb & 0xffffu); ks[tok * 128 + d + 1] = __uint_as_float(bb & 0xffff0000u);
            vs[tok * 128 + d] = bf2f(cc & 0xffffu); vs[tok * 128 + d + 1] = __uint_as_float(cc & 0xffff0000u); }
        if (GDN && tid < 32) { gs[tid] = Gg[(size_t)bh * SEQ + c0 + tid]; bs[tid] = Gb[(size_t)bh * SEQ + c0 + tid]; }
        __syncthreads();
        for (int tt = 0; tt < 32; ++tt) {
            const LAS float* kt = ks + tt * 128 + kg * 32; const LAS float* qt = qs + tt * 128 + kg * 32;
            float po = 0.f;
            if (GDN) {
                const float a = __expf(gs[tt]); float p = 0.f;
#pragma unroll
                for (int i = 0; i < 32; ++i) { Sr[i] *= a; p += Sr[i] * kt[i]; }
                red[kg * 128 + v] = p; __syncthreads();
                const float kv = (red[v] + red[128 + v]) + (red[256 + v] + red[384 + v]);
                const float delta = bs[tt] * (vs[tt * 128 + v] - kv);
#pragma unroll
                for (int i = 0; i < 32; ++i) { Sr[i] += kt[i] * delta; po += Sr[i] * qt[i]; }
                red[512 + kg * 128 + v] = po; __syncthreads();
                if (kg == 0) OUT[((size_t)(b * SEQ + c0 + tt)) * 1024 + h * 128 + v] = (red[512 + v] + red[640 + v]) + (red[768 + v] + red[896 + v]);
            } else {
                const float vv = vs[tt * 128 + v]; LAS float* r = red + (tt & 1) * 512;
#pragma unroll
                for (int i = 0; i < 32; ++i) { Sr[i] = gamma * Sr[i] + kt[i] * vv; po += Sr[i] * qt[i]; }
                r[kg * 128 + v] = po; __syncthreads();
                if (kg == 0) OUT[((size_t)(b * SEQ + c0 + tt)) * 1024 + h * 128 + v] = (r[v] + r[128 + v]) + (r[256 + v] + r[384 + v]);
            }
        }
    }
    __syncthreads();
}

template <int DV, bool CAUSAL, bool OUT_BF16>
DI void flash_item(const Frame& F, const bf16* Q, const bf16* Kh, const bf16* VT, int vpitch, int q0, int nkeys, float slope, float* OUTF, bf16* OUTB, int opitch) {
    constexpr int KP = 272, VP = 144;
    LAS unsigned char* Kl = F.lds; LAS unsigned char* Vl = F.lds + 64 * KP;
    int tid_ = F.tid; asm volatile("" : "+v"(tid_));
    const int tid = tid_, lane = tid & 63, w = F.wave, li = lane & 15, g = lane >> 4;
    const float SC = 0.08838834764831845f, L2E = 1.4426950408889634f;
    bf16x8 qf[4];
#pragma unroll
    for (int ks = 0; ks < 4; ++ks) qf[ks] = *(const bf16x8*)(Q + (size_t)(w * 16 + li) * 128 + ks * 32 + g * 8);
    f32x4 o[DV / 16];
#pragma unroll
    for (int c = 0; c < DV / 16; ++c) o[c] = (f32x4){0.f, 0.f, 0.f, 0.f};
    float m_run = -1e30f, l_run = 0.f;
    const int qpos = q0 + w * 16 + li;
    const int kend = CAUSAL ? (q0 + 128 < nkeys ? q0 + 128 : nkeys) : nkeys;
    for (int j0 = 0; j0 < kend; j0 += 64) {
        __syncthreads();
#pragma unroll
        for (int i = 0; i < 2; ++i) { const int c = tid + 512 * i, row = c >> 4, cc = c & 15; *(LAS v4u*)(Kl + row * KP + cc * 16) = *(const v4u*)(Kh + (size_t)(j0 + row) * 128 + cc * 8); }
#pragma unroll
        for (int i = 0; i < DV / 64; ++i) { const int c = tid + 512 * i, row = c >> 3, cc = c & 7; *(LAS v4u*)(Vl + row * VP + cc * 16) = *(const v4u*)(VT + (size_t)row * vpitch + j0 + cc * 8); }
        __syncthreads();
        f32x4 s[4];
#pragma unroll
        for (int t = 0; t < 4; ++t) { s[t] = (f32x4){0.f, 0.f, 0.f, 0.f};
#pragma unroll
            for (int ks = 0; ks < 4; ++ks) { const bf16x8 a = *(const LAS bf16x8*)(Kl + (t * 16 + li) * KP + (ks * 32 + g * 8) * 2); s[t] = __builtin_amdgcn_mfma_f32_16x16x32_bf16(a, qf[ks], s[t], 0, 0, 0); } }
        float mx = -__builtin_inff();
#pragma unroll
        for (int t = 0; t < 4; ++t)
#pragma unroll
            for (int r = 0; r < 4; ++r) { const int key = j0 + t * 16 + g * 4 + r; float x = s[t][r] * SC - slope * (float)(qpos - key); if (CAUSAL && key > qpos) x = -__builtin_inff(); s[t][r] = x; mx = fmaxf(mx, x); }
        mx = fmaxf(mx, __shfl_xor(mx, 16)); mx = fmaxf(mx, __shfl_xor(mx, 32));
        const float m_new = fmaxf(m_run, mx), alpha = exp2f((m_run - m_new) * L2E); m_run = m_new;
        float ps = 0.f;
#pragma unroll
        for (int t = 0; t < 4; ++t)
#pragma unroll
            for (int r = 0; r < 4; ++r) { const float p = exp2f((s[t][r] - m_new) * L2E); s[t][r] = p; ps += p; }
        ps += __shfl_xor(ps, 16); ps += __shfl_xor(ps, 32);
        l_run = l_run * alpha + ps;
        bf16x8 pf[2];
#pragma unroll
        for (int s2 = 0; s2 < 2; ++s2) { v4u pw; pw.x = pk2(s[2 * s2][0], s[2 * s2][1]); pw.y = pk2(s[2 * s2][2], s[2 * s2][3]); pw.z = pk2(s[2 * s2 + 1][0], s[2 * s2 + 1][1]); pw.w = pk2(s[2 * s2 + 1][2], s[2 * s2 + 1][3]); pf[s2] = __builtin_bit_cast(bf16x8, pw); }
        float al[4];
#pragma unroll
        for (int r = 0; r < 4; ++r) al[r] = __shfl(alpha, g * 4 + r);
#pragma unroll
        for (int c = 0; c < DV / 16; ++c) {
#pragma unroll
            for (int r = 0; r < 4; ++r) o[c][r] *= al[r];
#pragma unroll
            for (int s2 = 0; s2 < 2; ++s2) { const LAS unsigned char* vp = Vl + (c * 16 + li) * VP + (s2 * 32 + g * 4) * 2; const v2u lo = *(const LAS v2u*)vp, hi = *(const LAS v2u*)(vp + 32);
                v4u bw; bw.x = lo.x; bw.y = lo.y; bw.z = hi.x; bw.w = hi.y; o[c] = __builtin_amdgcn_mfma_f32_16x16x32_bf16(pf[s2], __builtin_bit_cast(bf16x8, bw), o[c], 0, 0, 0); }
        }
    }
    float il[4];
#pragma unroll
    for (int r = 0; r < 4; ++r) il[r] = 1.0f / __shfl(l_run, g * 4 + r);
#pragma unroll
    for (int c = 0; c < DV / 16; ++c)
#pragma unroll
        for (int r = 0; r < 4; ++r) { const unsigned off = (unsigned)((w * 16 + g * 4 + r) * opitch + c * 16 + li); const float v = o[c][r] * il[r];
            if (OUT_BF16) OUTB[off] = (bf16)f2bf(v); else OUTF[off] = v; }
}

__global__ void __launch_bounds__(NWAVES * 64, 2) mk_fwd(Args args) {
    extern __shared__ __attribute__((aligned(16))) unsigned char lds_raw[];
    Frame F;
    F.lds = (LAS unsigned char*)lds_raw;
    F.tid = threadIdx.x; F.lane = F.tid & 63; F.wave = __builtin_amdgcn_readfirstlane(F.tid >> 6);
    F.G = gridDim.x; { const int bx = blockIdx.x; F.vcu = (F.G % 8 == 0) ? (bx % 8) * (F.G / 8) + bx / 8 : bx; }
    F.gw = F.vcu * NWAVES + F.wave; F.NGW = F.G * NWAVES;
    volatile LAS unsigned* MISC = (volatile LAS unsigned*)(F.lds + MISC_OFF);
    LAS int* MTAB = (LAS int*)(F.lds + MISC_OFF + 128);
    unsigned char* ws = args.ws;
    unsigned* ctl = (unsigned*)(ws + WS_CTL);
    for (int u = F.tid; u < (LDS_BYTES - RING_BYTES) / 4; u += NWAVES * 64) ((LAS unsigned*)(F.lds + RING_BYTES))[u] = 0u;
    __syncthreads();
#if MK_ONE_LAUNCH
    XcdBarrier bar = xcd_barrier_post(ctl + CW_BAR, MISC + 8);
#define GRID_BAR() xcd_barrier(bar)
#else
#define GRID_BAR() do {} while (0)
#endif
    const int lo = args.ph_lo, hi = args.ph_hi;
#define IN(k) (lo <= (k) && (k) < hi)
#define SEAM(k) do { if (IN(k) && IN((k) + 1)) GRID_BAR(); } while (0)

    const float* x_in = (const float*)args.in[0]; const float* mem = (const float*)args.in[1]; const float* w_in = (const float*)args.in[2]; const float* conv_w = (const float*)args.in[3];
    const float* a_log = (const float*)args.in[4]; const float* dt_bias = (const float*)args.in[5]; const float* gdn_norm_w = (const float*)args.in[6]; const float* diff_lambda = (const float*)args.in[7];
    const float* diff_norm_w = (const float*)args.in[8]; const float* w_branch = (const float*)args.in[9]; const float* w_out = (const float*)args.in[10]; const float* mix_norm_w = (const float*)args.in[11];
    const float* mem_norm_w = (const float*)args.in[12]; const float* cross_norm_w = (const float*)args.in[13]; const float* cross_w_q = (const float*)args.in[14]; const float* cross_w_kv = (const float*)args.in[15];
    const float* cross_w_o = (const float*)args.in[16]; const float* ffn_norm_w = (const float*)args.in[17]; const float* dense_w_gu = (const float*)args.in[18]; const float* dense_w_down = (const float*)args.in[19];
    const float* router_w = (const float*)args.in[20]; const float* expert_w_gu = (const float*)args.in[21]; const float* expert_w_down = (const float*)args.in[22]; const float* final_norm_w = (const float*)args.in[23];
    bf16* WIN = (bf16*)(ws + WS_WIN); bf16* WBR = (bf16*)(ws + WS_WBR); bf16* WOUT = (bf16*)(ws + WS_WOUT); bf16* WQ = (bf16*)(ws + WS_WQ); bf16* WKV = (bf16*)(ws + WS_WKV); bf16* WO = (bf16*)(ws + WS_WO);
    bf16* WGU = (bf16*)(ws + WS_WGU); bf16* WDN = (bf16*)(ws + WS_WDN); bf16* WEGU = (bf16*)(ws + WS_WEGU); bf16* WEDN = (bf16*)(ws + WS_WEDN);
    float* XRES = (float*)(ws + WS_XRES); bf16* H = (bf16*)(ws + WS_H);
    bf16* RQ = (bf16*)(ws + WS_RQ); bf16* RK = (bf16*)(ws + WS_RK); bf16* RV = (bf16*)(ws + WS_RV); bf16* RG = (bf16*)(ws + WS_RG); bf16* BQKV = (bf16*)(ws + WS_BQKV); bf16* BZ = (bf16*)(ws + WS_BZ);
    float* BBA = (float*)(ws + WS_BBA); bf16* CQ = (bf16*)(ws + WS_CQ); bf16* CK = (bf16*)(ws + WS_CK); bf16* CVT = (bf16*)(ws + WS_CVT); bf16* GATES = (bf16*)(ws + WS_GATES);
    bf16* GQ = (bf16*)(ws + WS_GQ); bf16* GK = (bf16*)(ws + WS_GK); bf16* GV = (bf16*)(ws + WS_GV); float* GG = (float*)(ws + WS_GG); float* GB = (float*)(ws + WS_GB);
    float* OA = (float*)(ws + WS_OA); float* OB = (float*)(ws + WS_OB); float* O12 = (float*)(ws + WS_O12); bf16* OCAT = (bf16*)(ws + WS_OCAT);
    float* MERGE = (float*)(ws + WS_MERGE); bf16* MERGEB = (bf16*)(ws + WS_MERGEB); bf16* MEMN = (bf16*)(ws + WS_MEMN); bf16* KX = (bf16*)(ws + WS_KX); bf16* VXT = (bf16*)(ws + WS_VXT);
    bf16* QX = (bf16*)(ws + WS_QX); bf16* OX = (bf16*)(ws + WS_OX); bf16* ACT = (bf16*)(ws + WS_ACT); bf16* HG = (bf16*)(ws + WS_HG); bf16* EACT = (bf16*)(ws + WS_EACT); float* Y = (float*)(ws + WS_Y);
    int* ROUTE = (int*)(ws + WS_ROUTE);

    if (IN(0)) {
        for (int l = 0; l < 2; ++l) {
            conv_job(F, w_in + (size_t)l * D * 17424, D, 17424, WIN + (size_t)l * NINP * D, NINP, 1, 0);
            for (int s = 0; s < 3; ++s) conv_job(F, w_branch + ((size_t)l * 3072 + s * 1024) * D, 1024, D, WBR + ((size_t)l * 3 + s) * D * 1024, D, 0, 0);
            conv_job(F, w_out + (size_t)l * D * D, D, D, WOUT + (size_t)l * D * D, D, 0, 0);
            conv_job(F, cross_w_q + (size_t)l * D * 512, D, 512, WQ + (size_t)l * 512 * D, 512, 0, 0);
            conv_job(F, cross_w_kv + (size_t)l * D * 1024, D, 1024, WKV + (size_t)l * 1024 * D, 1024, 0, 0);
            conv_job(F, cross_w_o + (size_t)l * 512 * D, 512, D, WO + (size_t)l * D * 512, D, 0, 0);
        }
        conv_job(F, dense_w_gu, D, 2 * DFF, WGU, 2 * DFF, 2, DFF);
        conv_job(F, dense_w_down, DFF, D, WDN, D, 0, 0);
        for (int e = 0; e < NEXP; ++e) {
            conv_job(F, expert_w_gu + (size_t)e * D * 2 * EFF, D, 2 * EFF, WEGU + (size_t)e * 2 * EFF * D, 2 * EFF, 2, EFF);
            conv_job(F, expert_w_down + (size_t)e * EFF * D, EFF, D, WEDN + (size_t)e * D * EFF, D, 0, 0);
        }
        for (int r = F.gw; r < T; r += F.NGW) rms_row(x_in + (size_t)r * D, mix_norm_w, H + (size_t)r * D, F.lane);
        for (int r = F.gw; r < 2 * MEMR; r += F.NGW) { const int l = r / MEMR, rr = r % MEMR; rms_row(mem + (size_t)rr * D, mem_norm_w + l * D, MEMN + (size_t)r * D, F.lane); }
    }
    SEAM(0);
    if (IN(1)) {
        for (int l = 0; l < 2; ++l) {
            pg8::Gemm g{MEMN + (size_t)l * MEMR * D, WKV + (size_t)l * 1024 * D, MEMR, 1024, D}; pg8::StaticOrder S; S.init(MEMR, 1024, F.G, (int)((blockIdx.x + F.G - 16 * l) % F.G));
            pg8::EpiHeads E{KX + (size_t)l * NB * 4 * MEML * 128, VXT + (size_t)l * NB * 4 * 128 * MEML, 4, 8, 2};
            pg8::gemm_phase<pg8::EpiHeads, pg8::StaticOrder, true, true>(F.lds, g, S, E);
        }
    }
    SEAM(1);

    { constexpr int l = 0;
        const int pb = 2 + l * NPL;
        const float lambda_init = l == 0 ? 0.2f : 0.35550906f;
        const float* xin = l == 0 ? x_in : XRES;
        if (IN(pb + 0)) {
            pg8::Gemm g{H, WIN + (size_t)l * NINP * D, T, NINP, D}; pg8::StaticOrder S; S.init(T, NINP, F.G, (int)blockIdx.x);
            pg8::EpiIn E{RQ, RK, RV, RG, BQKV, BZ, CQ, CK, CVT, GATES, BBA};
            pg8::gemm_phase<pg8::EpiIn, pg8::StaticOrder, true, true>(F.lds, g, S, E);
        }
        SEAM(pb + 0);
        if (IN(pb + 1)) {
            const float* cw = conv_w + (size_t)l * 4 * 3072;
            for (int it = F.gw; it < T * 8; it += F.NGW) {
                const int t = it >> 3, h = it & 7, b = t >> 11, s = t & 2047, lane = F.lane;
                float val[3][2];
#pragma unroll
                for (int part = 0; part < 3; ++part) { const int col = part * 1024 + h * 128 + 2 * lane; float a0 = 0.f, a1 = 0.f;
#pragma unroll
                    for (int j = 0; j < 4; ++j) { if (s - 3 + j >= 0) { const unsigned xv = *(const unsigned*)(BQKV + (size_t)(t - 3 + j) * 3072 + col); a0 += bf2f(xv & 0xffffu) * cw[j * 3072 + col]; a1 += __uint_as_float(xv & 0xffff0000u) * cw[j * 3072 + col + 1]; } }
                    val[part][0] = pg8::fsilu(a0); val[part][1] = pg8::fsilu(a1); }
                const float qs_ = wave_sum(val[0][0] * val[0][0] + val[0][1] * val[0][1]), ks_ = wave_sum(val[1][0] * val[1][0] + val[1][1] * val[1][1]);
                const float qn = rsqrtf(qs_ + 1e-6f) * 0.08838834764831845f, kn = rsqrtf(ks_ + 1e-6f);
                const size_t o = ((size_t)((b * 8 + h) * SEQ + s)) * 128 + 2 * lane;
                *(unsigned*)(GQ + o) = pk2(val[0][0] * qn, val[0][1] * qn); *(unsigned*)(GK + o) = pk2(val[1][0] * kn, val[1][1] * kn); *(unsigned*)(GV + o) = pk2(val[2][0], val[2][1]);
                if (lane == 0) { const float bbv = BBA[(size_t)t * 16 + h], bav = BBA[(size_t)t * 16 + 8 + h] + dt_bias[l * 8 + h]; const float sp = bav > 20.f ? bav : log1pf(__expf(bav));
                    GB[(size_t)(b * 8 + h) * SEQ + s] = pg8::fsigm(bbv); GG[(size_t)(b * 8 + h) * SEQ + s] = -__expf(a_log[l * 8 + h]) * sp; }
            }
        }
        SEAM(pb + 1);
        if (IN(pb + 2)) {
            const int bx = F.vcu;
            if (bx < 32) { const int h = bx & 7; seq_mixer<false>(F, bx, RQ, RK, RV, nullptr, nullptr, OA, 1.0f - exp2f(-5.0f - (float)h)); }
            else if (bx < 64) seq_mixer<true>(F, bx - 32, GQ, GK, GV, GG, GB, OB, 0.f);
            else {
                for (int it = bx - 64; it < 512; it += F.G - 64) {
                    const int qt = 15 - (it >> 5), hd = it & 31, b = hd >> 3, hm = hd & 7, hh = hm >> 1, m = hm & 1;
                    const float slope = exp2f(-2.0f * (float)(hh + 1));
                    flash_item<256, true, false>(F, CQ + ((size_t)hd * SEQ + qt * 128) * 128, CK + (size_t)hd * SEQ * 128, CVT + (size_t)(b * 4 + hh) * 256 * SEQ, SEQ, qt * 128, SEQ, slope,
                                                 O12 + ((size_t)m * T + b * SEQ + qt * 128) * 1024 + hh * 256, nullptr, 1024);
                }
            }
        }
        SEAM(pb + 2);
        if (IN(pb + 3)) {
            const int lane = F.lane;
            const float* lv = diff_lambda + (size_t)l * 512;
            const float d01 = wave_sum(lv[lane] * lv[128 + lane] + lv[64 + lane] * lv[192 + lane]), d23 = wave_sum(lv[256 + lane] * lv[384 + lane] + lv[320 + lane] * lv[448 + lane]);
            const float lam = __expf(d01) - __expf(d23) + lambda_init;
            for (int t = F.gw; t < T; t += F.NGW) {
#pragma unroll
                for (int h = 0; h < 8; ++h) { const size_t o = (size_t)t * 1024 + h * 128 + 2 * lane;
                    { const float a0 = OA[o], a1 = OA[o + 1]; const float mean = wave_sum(a0 + a1) * (1.f / 128.f); const float c0 = a0 - mean, c1 = a1 - mean; const float rstd = rsqrtf(wave_sum(c0 * c0 + c1 * c1) * (1.f / 128.f) + EPS);
                      const unsigned gv = *(const unsigned*)(RG + o); *(unsigned*)(OCAT + o) = pk2(c0 * rstd * bf2f(gv & 0xffffu), c1 * rstd * __uint_as_float(gv & 0xffff0000u)); }
                    { const float a0 = OB[o], a1 = OB[o + 1]; const float rstd = rsqrtf(wave_sum(a0 * a0 + a1 * a1) * (1.f / 128.f) + EPS); const unsigned gv = *(const unsigned*)(BZ + o);
                      *(unsigned*)(OCAT + (size_t)T * 1024 + o) = pk2(a0 * rstd * gdn_norm_w[l * 128 + 2 * lane] * bf2f(gv & 0xffffu), a1 * rstd * gdn_norm_w[l * 128 + 2 * lane + 1] * __uint_as_float(gv & 0xffff0000u)); } }
#pragma unroll
                for (int h = 0; h < 4; ++h) { const size_t o = (size_t)t * 1024 + h * 256 + 4 * lane; const f32x4 p = *(const f32x4*)(O12 + o), q = *(const f32x4*)(O12 + (size_t)T * 1024 + o); const f32x4 d = p - q * lam;
                    const float rstd = rsqrtf(wave_sum((d[0] * d[0] + d[1] * d[1]) + (d[2] * d[2] + d[3] * d[3])) * (1.f / 256.f) + EPS) * (1.0f - lambda_init); const f32x4 ww = *(const f32x4*)(diff_norm_w + l * 256 + 4 * lane);
                    v2u ov; ov.x = pk2(d[0] * rstd * ww[0], d[1] * rstd * ww[1]); ov.y = pk2(d[2] * rstd * ww[2], d[3] * rstd * ww[3]); *(v2u*)(OCAT + (size_t)2 * T * 1024 + o) = ov; }
            }
        }
        SEAM(pb + 3);
        if (IN(pb + 4)) {
            for (int s = 0; s < 3; ++s) {
                pg8::Gemm g{OCAT + (size_t)s * T * 1024, WBR + ((size_t)l * 3 + s) * D * 1024, T, D, 1024}; pg8::StaticOrder S; S.init(T, D, F.G, (int)blockIdx.x);
                pg8::EpiBranch E{MERGE, MERGEB, GATES, s};
                pg8::gemm_phase<pg8::EpiBranch, pg8::StaticOrder, true, true>(F.lds, g, S, E);
            }
        }
        SEAM(pb + 4);
        if (IN(pb + 5)) {
            pg8::Gemm g{MERGEB, WOUT + (size_t)l * D * D, T, D, D}; pg8::StaticOrder S; S.init(T, D, F.G, (int)blockIdx.x);
            pg8::EpiResid E{xin, XRES, D};
            pg8::gemm_phase<pg8::EpiResid, pg8::StaticOrder, true, true>(F.lds, g, S, E);
        }
        SEAM(pb + 5);
        if (IN(pb + 6)) { for (int r = F.gw; r < T; r += F.NGW) rms_row(XRES + (size_t)r * D, cross_norm_w + l * D, H + (size_t)r * D, F.lane); }
        SEAM(pb + 6);
        if (IN(pb + 7)) {
            pg8::Gemm g{H, WQ + (size_t)l * 512 * D, T, 512, D}; pg8::StaticOrder S; S.init(T, 512, F.G, (int)blockIdx.x);
            pg8::EpiHeads E{QX, nullptr, 4, 11, 1 << 20};
            pg8::gemm_phase<pg8::EpiHeads, pg8::StaticOrder, true, true>(F.lds, g, S, E);
        }
        SEAM(pb + 7);
        if (IN(pb + 8)) {
            for (int it = F.vcu; it < 256; it += F.G) { const int hd = it >> 4, qt = it & 15, b = hd >> 2, hh = hd & 3;
                flash_item<128, false, true>(F, QX + ((size_t)hd * SEQ + qt * 128) * 128, KX + ((size_t)l * 16 + hd) * MEML * 128, VXT + ((size_t)l * 16 + hd) * 128 * MEML, MEML, qt * 128, MEML, 0.f,
                                             nullptr, OX + ((size_t)(b * SEQ + qt * 128)) * 512 + hh * 128, 512); }
        }
        SEAM(pb + 8);
        if (IN(pb + 9)) {
            pg8::Gemm g{OX, WO + (size_t)l * D * 512, T, D, 512}; pg8::StaticOrder S; S.init(T, D, F.G, (int)blockIdx.x);
            pg8::EpiResid E{XRES, XRES, D};
            pg8::gemm_phase<pg8::EpiResid, pg8::StaticOrder, true, true>(F.lds, g, S, E);
        }
        SEAM(pb + 9);
        if (IN(pb + 10)) {
            const int lane = F.lane; const float* w = ffn_norm_w + l * D;
            for (int r = F.gw; r < T; r += F.NGW) {
                const float* xrow = XRES + (size_t)r * D; f32x4 v[8]; float ss = 0.f;
#pragma unroll
                for (int j = 0; j < 8; ++j) { v[j] = *(const f32x4*)(xrow + 4 * (lane + 64 * j)); ss += (v[j][0] * v[j][0] + v[j][1] * v[j][1]) + (v[j][2] * v[j][2] + v[j][3] * v[j][3]); }
                const float rstd = rsqrtf(wave_sum(ss) * (1.f / D) + EPS);
                float lg[8];
#pragma unroll
                for (int e = 0; e < 8; ++e) lg[e] = 0.f;
#pragma unroll
                for (int j = 0; j < 8; ++j) { const f32x4 ww = *(const f32x4*)(w + 4 * (lane + 64 * j)); f32x4 y; y[0] = v[j][0] * rstd * ww[0]; y[1] = v[j][1] * rstd * ww[1]; y[2] = v[j][2] * rstd * ww[2]; y[3] = v[j][3] * rstd * ww[3];
                    v2u o; o.x = pk2(y[0], y[1]); o.y = pk2(y[2], y[3]); *(v2u*)(H + (size_t)r * D + 4 * (lane + 64 * j)) = o;
                    if (l == 1) {
#pragma unroll
                        for (int c = 0; c < 4; ++c) { const float* rw = router_w + (size_t)(4 * (lane + 64 * j) + c) * 8; const f32x4 r0 = *(const f32x4*)rw, r1 = *(const f32x4*)(rw + 4);
                            lg[0] += y[c] * r0[0]; lg[1] += y[c] * r0[1]; lg[2] += y[c] * r0[2]; lg[3] += y[c] * r0[3]; lg[4] += y[c] * r1[0]; lg[5] += y[c] * r1[1]; lg[6] += y[c] * r1[2]; lg[7] += y[c] * r1[3]; } } }
                if (l == 1) {
#pragma unroll
                    for (int e = 0; e < 8; ++e) lg[e] = wave_sum(lg[e]);
                    int e0 = 0; float v0 = lg[0];
#pragma unroll
                    for (int e = 1; e < 8; ++e) if (lg[e] > v0) { v0 = lg[e]; e0 = e; }
                    int e1 = -1; float v1 = -__builtin_inff();
#pragma unroll
                    for (int e = 0; e < 8; ++e) if (e != e0 && lg[e] > v1) { v1 = lg[e]; e1 = e; }
                    if (lane == 0) { const float p0 = 1.0f / (1.0f + __expf(v1 - v0)); int* ro = ROUTE + (size_t)r * 8;
                        ro[0] = e0; ro[1] = e1; ro[2] = (int)atomicAdd(ctl + CW_CNT + e0, 1u); ro[3] = (int)atomicAdd(ctl + CW_CNT + e1, 1u); ((float*)ro)[4] = p0; ((float*)ro)[5] = 1.0f - p0; }
                }
            }
        }
        SEAM(pb + 10);
        if (l == 0) {
            if (IN(pb + 11)) {
                pg8::Gemm g{H, WGU, T, 2 * DFF, D}; pg8::StaticOrder S; S.init(T, 2 * DFF, F.G, (int)blockIdx.x);
                pg8::EpiSwiglu E{ACT, DFF, 1 << 20};
                pg8::gemm_phase<pg8::EpiSwiglu, pg8::StaticOrder, true, true>(F.lds, g, S, E);
            }
            SEAM(pb + 11);
            if (IN(pb + 12)) {
                pg8::Gemm g{ACT, WDN, T, D, DFF}; pg8::StaticOrder S; S.init(T, D, F.G, (int)blockIdx.x);
                pg8::EpiResid E{XRES, XRES, D};
                pg8::gemm_phase<pg8::EpiResid, pg8::StaticOrder, true, true>(F.lds, g, S, E);
            }
            SEAM(pb + 12);
            if (IN(pb + 13)) { for (int r = F.gw; r < T; r += F.NGW) rms_row(XRES + (size_t)r * D, mix_norm_w + D, H + (size_t)r * D, F.lane); }
            SEAM(pb + 13);
            SEAM(pb + 14);
        } else {
            int off[9]; off[0] = 0;
#pragma unroll
            for (int e = 0; e < 8; ++e) { const int c = (int)__hip_atomic_load(ctl + CW_CNT + e, __ATOMIC_RELAXED, __HIP_MEMORY_SCOPE_AGENT); off[e + 1] = off[e] + ((c + 255) & ~255); }
            if (IN(pb + 11)) {
                for (int it = F.gw; it < T * 2; it += F.NGW) { const int t = it >> 1, k = it & 1; int* ro = ROUTE + (size_t)t * 8; const int e = ro[k], pos = ro[2 + k];
                    int base = 0;
#pragma unroll
                    for (int q = 0; q < 8; ++q) if (e == q) base = off[q];
                    const int slot = base + pos; if (F.lane == 0) ro[6 + k] = slot;
                    const v4u* src = (const v4u*)(H + (size_t)t * D); v4u* dst = (v4u*)(HG + (size_t)slot * D);
#pragma unroll
                    for (int j = 0; j < 4; ++j) dst[F.lane + 64 * j] = src[F.lane + 64 * j]; }
#pragma unroll
                for (int e = 0; e < 8; ++e) { const int c = (int)__hip_atomic_load(ctl + CW_CNT + e, __ATOMIC_RELAXED, __HIP_MEMORY_SCOPE_AGENT);
                    for (int rr = off[e] + c + F.gw; rr < off[e + 1]; rr += F.NGW) { v4u* dst = (v4u*)(HG + (size_t)rr * D);
#pragma unroll
                        for (int j = 0; j < 4; ++j) dst[F.lane + 64 * j] = (v4u){0u, 0u, 0u, 0u}; } }
            }
            SEAM(pb + 11);
            if (IN(pb + 12)) {
                if (F.tid == 0) { int cu = 0;
#pragma unroll
                    for (int e = 0; e < 8; ++e) { const int ne = (off[e + 1] - off[e]) >> 8; MTAB[e] = ne; MTAB[8 + e] = off[e] >> 8; MTAB[16 + e] = cu; cu += ne * 56; } MTAB[24] = cu; MTAB[25] = cu; }
                __syncthreads();
                pg8::Gemm g{HG, WEGU, MAXSLOT, NEXP * 2 * EFF, D}; pg8::MoeOrder S{(const LAS int*)MTAB, 56, F.G, (int)blockIdx.x};
                pg8::EpiSwiglu E{EACT, EFF, 56};
                pg8::gemm_phase<pg8::EpiSwiglu, pg8::MoeOrder, true, true>(F.lds, g, S, E);
            }
            SEAM(pb + 12);
            if (IN(pb + 13)) {
                __syncthreads();
                if (F.tid == 0) { int cu = 0;
#pragma unroll
                    for (int e = 0; e < 8; ++e) { const int ne = (off[e + 1] - off[e]) >> 8; MTAB[e] = ne; MTAB[8 + e] = off[e] >> 8; MTAB[16 + e] = cu; cu += ne * 8; } MTAB[24] = cu; MTAB[25] = cu; }
                __syncthreads();
                pg8::Gemm g{EACT, WEDN, MAXSLOT, NEXP * D, EFF}; pg8::MoeOrder S{(const LAS int*)MTAB, 8, F.G, (int)blockIdx.x};
                pg8::EpiStoreF32 E{Y, D, 8};
                pg8::gemm_phase<pg8::EpiStoreF32, pg8::MoeOrder, true, true>(F.lds, g, S, E);
            }
            SEAM(pb + 13);
            if (IN(pb + 14)) {
                const int lane = F.lane;
                for (int r = F.gw; r < T; r += F.NGW) { const int* ro = ROUTE + (size_t)r * 8; const float p0 = ((const float*)ro)[4], p1 = ((const float*)ro)[5]; const float* y0 = Y + (size_t)ro[6] * D; const float* y1 = Y + (size_t)ro[7] * D;
                    const float* xrow = XRES + (size_t)r * D; f32x4 v[8]; float ss = 0.f;
#pragma unroll
                    for (int j = 0; j < 8; ++j) { const int o = 4 * (lane + 64 * j); v[j] = *(const f32x4*)(xrow + o) + *(const f32x4*)(y0 + o) * p0 + *(const f32x4*)(y1 + o) * p1; ss += (v[j][0] * v[j][0] + v[j][1] * v[j][1]) + (v[j][2] * v[j][2] + v[j][3] * v[j][3]); }
                    const float rstd = rsqrtf(wave_sum(ss) * (1.f / D) + EPS);
#pragma unroll
                    for (int j = 0; j < 8; ++j) { const int o = 4 * (lane + 64 * j); const f32x4 ww = *(const f32x4*)(final_norm_w + o); *(f32x4*)(args.out + (size_t)r * D + o) = v[j] * rstd * ww; } }
            }
        }
    }
    { constexpr int l = 1;
        const int pb = 2 + l * NPL;
        const float lambda_init = l == 0 ? 0.2f : 0.35550906f;
        const float* xin = l == 0 ? x_in : XRES;
        if (IN(pb + 0)) {
            pg8::Gemm g{H, WIN + (size_t)l * NINP * D, T, NINP, D}; pg8::StaticOrder S; S.init(T, NINP, F.G, (int)blockIdx.x);
            pg8::EpiIn E{RQ, RK, RV, RG, BQKV, BZ, CQ, CK, CVT, GATES, BBA};
            pg8::gemm_phase<pg8::EpiIn, pg8::StaticOrder, true, true>(F.lds, g, S, E);
        }
        SEAM(pb + 0);
        if (IN(pb + 1)) {
            const float* cw = conv_w + (size_t)l * 4 * 3072;
            for (int it = F.gw; it < T * 8; it += F.NGW) {
                const int t = it >> 3, h = it & 7, b = t >> 11, s = t & 2047, lane = F.lane;
                float val[3][2];
#pragma unroll
                for (int part = 0; part < 3; ++part) { const int col = part * 1024 + h * 128 + 2 * lane; float a0 = 0.f, a1 = 0.f;
#pragma unroll
                    for (int j = 0; j < 4; ++j) { if (s - 3 + j >= 0) { const unsigned xv = *(const unsigned*)(BQKV + (size_t)(t - 3 + j) * 3072 + col); a0 += bf2f(xv & 0xffffu) * cw[j * 3072 + col]; a1 += __uint_as_float(xv & 0xffff0000u) * cw[j * 3072 + col + 1]; } }
                    val[part][0] = pg8::fsilu(a0); val[part][1] = pg8::fsilu(a1); }
                const float qs_ = wave_sum(val[0][0] * val[0][0] + val[0][1] * val[0][1]), ks_ = wave_sum(val[1][0] * val[1][0] + val[1][1] * val[1][1]);
                const float qn = rsqrtf(qs_ + 1e-6f) * 0.08838834764831845f, kn = rsqrtf(ks_ + 1e-6f);
                const size_t o = ((size_t)((b * 8 + h) * SEQ + s)) * 128 + 2 * lane;
                *(unsigned*)(GQ + o) = pk2(val[0][0] * qn, val[0][1] * qn); *(unsigned*)(GK + o) = pk2(val[1][0] * kn, val[1][1] * kn); *(unsigned*)(GV + o) = pk2(val[2][0], val[2][1]);
                if (lane == 0) { const float bbv = BBA[(size_t)t * 16 + h], bav = BBA[(size_t)t * 16 + 8 + h] + dt_bias[l * 8 + h]; const float sp = bav > 20.f ? bav : log1pf(__expf(bav));
                    GB[(size_t)(b * 8 + h) * SEQ + s] = pg8::fsigm(bbv); GG[(size_t)(b * 8 + h) * SEQ + s] = -__expf(a_log[l * 8 + h]) * sp; }
            }
        }
        SEAM(pb + 1);
        if (IN(pb + 2)) {
            const int bx = F.vcu;
            if (bx < 32) { const int h = bx & 7; seq_mixer<false>(F, bx, RQ, RK, RV, nullptr, nullptr, OA, 1.0f - exp2f(-5.0f - (float)h)); }
            else if (bx < 64) seq_mixer<true>(F, bx - 32, GQ, GK, GV, GG, GB, OB, 0.f);
            else {
                for (int it = bx - 64; it < 512; it += F.G - 64) {
                    const int qt = 15 - (it >> 5), hd = it & 31, b = hd >> 3, hm = hd & 7, hh = hm >> 1, m = hm & 1;
                    const float slope = exp2f(-2.0f * (float)(hh + 1));
                    flash_item<256, true, false>(F, CQ + ((size_t)hd * SEQ + qt * 128) * 128, CK + (size_t)hd * SEQ * 128, CVT + (size_t)(b * 4 + hh) * 256 * SEQ, SEQ, qt * 128, SEQ, slope,
                                                 O12 + ((size_t)m * T + b * SEQ + qt * 128) * 1024 + hh * 256, nullptr, 1024);
                }
            }
        }
        SEAM(pb + 2);
        if (IN(pb + 3)) {
            const int lane = F.lane;
            const float* lv = diff_lambda + (size_t)l * 512;
            const float d01 = wave_sum(lv[lane] * lv[128 + lane] + lv[64 + lane] * lv[192 + lane]), d23 = wave_sum(lv[256 + lane] * lv[384 + lane] + lv[320 + lane] * lv[448 + lane]);
            const float lam = __expf(d01) - __expf(d23) + lambda_init;
            for (int t = F.gw; t < T; t += F.NGW) {
#pragma unroll
                for (int h = 0; h < 8; ++h) { const size_t o = (size_t)t * 1024 + h * 128 + 2 * lane;
                    { const float a0 = OA[o], a1 = OA[o + 1]; const float mean = wave_sum(a0 + a1) * (1.f / 128.f); const float c0 = a0 - mean, c1 = a1 - mean; const float rstd = rsqrtf(wave_sum(c0 * c0 + c1 * c1) * (1.f / 128.f) + EPS);
                      const unsigned gv = *(const unsigned*)(RG + o); *(unsigned*)(OCAT + o) = pk2(c0 * rstd * bf2f(gv & 0xffffu), c1 * rstd * __uint_as_float(gv & 0xffff0000u)); }
                    { const float a0 = OB[o], a1 = OB[o + 1]; const float rstd = rsqrtf(wave_sum(a0 * a0 + a1 * a1) * (1.f / 128.f) + EPS); const unsigned gv = *(const unsigned*)(BZ + o);
                      *(unsigned*)(OCAT + (size_t)T * 1024 + o) = pk2(a0 * rstd * gdn_norm_w[l * 128 + 2 * lane] * bf2f(gv & 0xffffu), a1 * rstd * gdn_norm_w[l * 128 + 2 * lane + 1] * __uint_as_float(gv & 0xffff0000u)); } }
#pragma unroll
                for (int h = 0; h < 4; ++h) { const size_t o = (size_t)t * 1024 + h * 256 + 4 * lane; const f32x4 p = *(const f32x4*)(O12 + o), q = *(const f32x4*)(O12 + (size_t)T * 1024 + o); const f32x4 d = p - q * lam;
                    const float rstd = rsqrtf(wave_sum((d[0] * d[0] + d[1] * d[1]) + (d[2] * d[2] + d[3] * d[3])) * (1.f / 256.f) + EPS) * (1.0f - lambda_init); const f32x4 ww = *(const f32x4*)(diff_norm_w + l * 256 + 4 * lane);
                    v2u ov; ov.x = pk2(d[0] * rstd * ww[0], d[1] * rstd * ww[1]); ov.y = pk2(d[2] * rstd * ww[2], d[3] * rstd * ww[3]); *(v2u*)(OCAT + (size_t)2 * T * 1024 + o) = ov; }
            }
        }
        SEAM(pb + 3);
        if (IN(pb + 4)) {
            for (int s = 0; s < 3; ++s) {
                pg8::Gemm g{OCAT + (size_t)s * T * 1024, WBR + ((size_t)l * 3 + s) * D * 1024, T, D, 1024}; pg8::StaticOrder S; S.init(T, D, F.G, (int)blockIdx.x);
                pg8::EpiBranch E{MERGE, MERGEB, GATES, s};
                pg8::gemm_phase<pg8::EpiBranch, pg8::StaticOrder, true, true>(F.lds, g, S, E);
            }
        }
        SEAM(pb + 4);
        if (IN(pb + 5)) {
            pg8::Gemm g{MERGEB, WOUT + (size_t)l * D * D, T, D, D}; pg8::StaticOrder S; S.init(T, D, F.G, (int)blockIdx.x);
            pg8::EpiResid E{xin, XRES, D};
            pg8::gemm_phase<pg8::EpiResid, pg8::StaticOrder, true, true>(F.lds, g, S, E);
        }
        SEAM(pb + 5);
        if (IN(pb + 6)) { for (int r = F.gw; r < T; r += F.NGW) rms_row(XRES + (size_t)r * D, cross_norm_w + l * D, H + (size_t)r * D, F.lane); }
        SEAM(pb + 6);
        if (IN(pb + 7)) {
            pg8::Gemm g{H, WQ + (size_t)l * 512 * D, T, 512, D}; pg8::StaticOrder S; S.init(T, 512, F.G, (int)blockIdx.x);
            pg8::EpiHeads E{QX, nullptr, 4, 11, 1 << 20};
            pg8::gemm_phase<pg8::EpiHeads, pg8::StaticOrder, true, true>(F.lds, g, S, E);
        }
        SEAM(pb + 7);
        if (IN(pb + 8)) {
            for (int it = F.vcu; it < 256; it += F.G) { const int hd = it >> 4, qt = it & 15, b = hd >> 2, hh = hd & 3;
                flash_item<128, false, true>(F, QX + ((size_t)hd * SEQ + qt * 128) * 128, KX + ((size_t)l * 16 + hd) * MEML * 128, VXT + ((size_t)l * 16 + hd) * 128 * MEML, MEML, qt * 128, MEML, 0.f,
                                             nullptr, OX + ((size_t)(b * SEQ + qt * 128)) * 512 + hh * 128, 512); }
        }
        SEAM(pb + 8);
        if (IN(pb + 9)) {
            pg8::Gemm g{OX, WO + (size_t)l * D * 512, T, D, 512}; pg8::StaticOrder S; S.init(T, D, F.G, (int)blockIdx.x);
            pg8::EpiResid E{XRES, XRES, D};
            pg8::gemm_phase<pg8::EpiResid, pg8::StaticOrder, true, true>(F.lds, g, S, E);
        }
        SEAM(pb + 9);
        if (IN(pb + 10)) {
            const int lane = F.lane; const float* w = ffn_norm_w + l * D;
            for (int r = F.gw; r < T; r += F.NGW) {
                const float* xrow = XRES + (size_t)r * D; f32x4 v[8]; float ss = 0.f;
#pragma unroll
                for (int j = 0; j < 8; ++j) { v[j] = *(const f32x4*)(xrow + 4 * (lane + 64 * j)); ss += (v[j][0] * v[j][0] + v[j][1] * v[j][1]) + (v[j][2] * v[j][2] + v[j][3] * v[j][3]); }
                const float rstd = rsqrtf(wave_sum(ss) * (1.f / D) + EPS);
                float lg[8];
#pragma unroll
                for (int e = 0; e < 8; ++e) lg[e] = 0.f;
#pragma unroll
                for (int j = 0; j < 8; ++j) { const f32x4 ww = *(const f32x4*)(w + 4 * (lane + 64 * j)); f32x4 y; y[0] = v[j][0] * rstd * ww[0]; y[1] = v[j][1] * rstd * ww[1]; y[2] = v[j][2] * rstd * ww[2]; y[3] = v[j][3] * rstd * ww[3];
                    v2u o; o.x = pk2(y[0], y[1]); o.y = pk2(y[2], y[3]); *(v2u*)(H + (size_t)r * D + 4 * (lane + 64 * j)) = o;
                    if (l == 1) {
#pragma unroll
                        for (int c = 0; c < 4; ++c) { const float* rw = router_w + (size_t)(4 * (lane + 64 * j) + c) * 8; const f32x4 r0 = *(const f32x4*)rw, r1 = *(const f32x4*)(rw + 4);
                            lg[0] += y[c] * r0[0]; lg[1] += y[c] * r0[1]; lg[2] += y[c] * r0[2]; lg[3] += y[c] * r0[3]; lg[4] += y[c] * r1[0]; lg[5] += y[c] * r1[1]; lg[6] += y[c] * r1[2]; lg[7] += y[c] * r1[3]; } } }
                if (l == 1) {
#pragma unroll
                    for (int e = 0; e < 8; ++e) lg[e] = wave_sum(lg[e]);
                    int e0 = 0; float v0 = lg[0];
#pragma unroll
                    for (int e = 1; e < 8; ++e) if (lg[e] > v0) { v0 = lg[e]; e0 = e; }
                    int e1 = -1; float v1 = -__builtin_inff();
#pragma unroll
                    for (int e = 0; e < 8; ++e) if (e != e0 && lg[e] > v1) { v1 = lg[e]; e1 = e; }
                    if (lane == 0) { const float p0 = 1.0f / (1.0f + __expf(v1 - v0)); int* ro = ROUTE + (size_t)r * 8;
                        ro[0] = e0; ro[1] = e1; ro[2] = (int)atomicAdd(ctl + CW_CNT + e0, 1u); ro[3] = (int)atomicAdd(ctl + CW_CNT + e1, 1u); ((float*)ro)[4] = p0; ((float*)ro)[5] = 1.0f - p0; }
                }
            }
        }
        SEAM(pb + 10);
        if (l == 0) {
            if (IN(pb + 11)) {
                pg8::Gemm g{H, WGU, T, 2 * DFF, D}; pg8::StaticOrder S; S.init(T, 2 * DFF, F.G, (int)blockIdx.x);
                pg8::EpiSwiglu E{ACT, DFF, 1 << 20};
                pg8::gemm_phase<pg8::EpiSwiglu, pg8::StaticOrder, true, true>(F.lds, g, S, E);
            }
            SEAM(pb + 11);
            if (IN(pb + 12)) {
                pg8::Gemm g{ACT, WDN, T, D, DFF}; pg8::StaticOrder S; S.init(T, D, F.G, (int)blockIdx.x);
                pg8::EpiResid E{XRES, XRES, D};
                pg8::gemm_phase<pg8::EpiResid, pg8::StaticOrder, true, true>(F.lds, g, S, E);
            }
            SEAM(pb + 12);
            if (IN(pb + 13)) { for (int r = F.gw; r < T; r += F.NGW) rms_row(XRES + (size_t)r * D, mix_norm_w + D, H + (size_t)r * D, F.lane); }
            SEAM(pb + 13);
            SEAM(pb + 14);
        } else {
            int off[9]; off[0] = 0;
#pragma unroll
            for (int e = 0; e < 8; ++e) { const int c = (int)__hip_atomic_load(ctl + CW_CNT + e, __ATOMIC_RELAXED, __HIP_MEMORY_SCOPE_AGENT); off[e + 1] = off[e] + ((c + 255) & ~255); }
            if (IN(pb + 11)) {
                for (int it = F.gw; it < T * 2; it += F.NGW) { const int t = it >> 1, k = it & 1; int* ro = ROUTE + (size_t)t * 8; const int e = ro[k], pos = ro[2 + k];
                    int base = 0;
#pragma unroll
                    for (int q = 0; q < 8; ++q) if (e == q) base = off[q];
                    const int slot = base + pos; if (F.lane == 0) ro[6 + k] = slot;
                    const v4u* src = (const v4u*)(H + (size_t)t * D); v4u* dst = (v4u*)(HG + (size_t)slot * D);
#pragma unroll
                    for (int j = 0; j < 4; ++j) dst[F.lane + 64 * j] = src[F.lane + 64 * j]; }
#pragma unroll
                for (int e = 0; e < 8; ++e) { const int c = (int)__hip_atomic_load(ctl + CW_CNT + e, __ATOMIC_RELAXED, __HIP_MEMORY_SCOPE_AGENT);
                    for (int rr = off[e] + c + F.gw; rr < off[e + 1]; rr += F.NGW) { v4u* dst = (v4u*)(HG + (size_t)rr * D);
#pragma unroll
                        for (int j = 0; j < 4; ++j) dst[F.lane + 64 * j] = (v4u){0u, 0u, 0u, 0u}; } }
            }
            SEAM(pb + 11);
            if (IN(pb + 12)) {
                if (F.tid == 0) { int cu = 0;
#pragma unroll
                    for (int e = 0; e < 8; ++e) { const int ne = (off[e + 1] - off[e]) >> 8; MTAB[e] = ne; MTAB[8 + e] = off[e] >> 8; MTAB[16 + e] = cu; cu += ne * 56; } MTAB[24] = cu; MTAB[25] = cu; }
                __syncthreads();
                pg8::Gemm g{HG, WEGU, MAXSLOT, NEXP * 2 * EFF, D}; pg8::MoeOrder S{(const LAS int*)MTAB, 56, F.G, (int)blockIdx.x};
                pg8::EpiSwiglu E{EACT, EFF, 56};
                pg8::gemm_phase<pg8::EpiSwiglu, pg8::MoeOrder, true, true>(F.lds, g, S, E);
            }
            SEAM(pb + 12);
            if (IN(pb + 13)) {
                __syncthreads();
                if (F.tid == 0) { int cu = 0;
#pragma unroll
                    for (int e = 0; e < 8; ++e) { const int ne = (off[e + 1] - off[e]) >> 8; MTAB[e] = ne; MTAB[8 + e] = off[e] >> 8; MTAB[16 + e] = cu; cu += ne * 8; } MTAB[24] = cu; MTAB[25] = cu; }
                __syncthreads();
                pg8::Gemm g{EACT, WEDN, MAXSLOT, NEXP * D, EFF}; pg8::MoeOrder S{(const LAS int*)MTAB, 8, F.G, (int)blockIdx.x};
                pg8::EpiStoreF32 E{Y, D, 8};
                pg8::gemm_phase<pg8::EpiStoreF32, pg8::MoeOrder, true, true>(F.lds, g, S, E);
            }
            SEAM(pb + 13);
            if (IN(pb + 14)) {
                const int lane = F.lane;
                for (int r = F.gw; r < T; r += F.NGW) { const int* ro = ROUTE + (size_t)r * 8; const float p0 = ((const float*)ro)[4], p1 = ((const float*)ro)[5]; const float* y0 = Y + (size_t)ro[6] * D; const float* y1 = Y + (size_t)ro[7] * D;
                    const float* xrow = XRES + (size_t)r * D; f32x4 v[8]; float ss = 0.f;
#pragma unroll
                    for (int j = 0; j < 8; ++j) { const int o = 4 * (lane + 64 * j); v[j] = *(const f32x4*)(xrow + o) + *(const f32x4*)(y0 + o) * p0 + *(const f32x4*)(y1 + o) * p1; ss += (v[j][0] * v[j][0] + v[j][1] * v[j][1]) + (v[j][2] * v[j][2] + v[j][3] * v[j][3]); }
                    const float rstd = rsqrtf(wave_sum(ss) * (1.f / D) + EPS);
#pragma unroll
                    for (int j = 0; j < 8; ++j) { const int o = 4 * (lane + 64 * j); const f32x4 ww = *(const f32x4*)(final_norm_w + o); *(f32x4*)(args.out + (size_t)r * D + o) = v[j] * rstd * ww; } }
            }
        }
    }
#undef IN
#undef SEAM
}

extern "C" void kernel_launch(void* const* d_in, const int* in_sizes, int n_in, void* d_out, int out_size, void* d_ws, size_t ws_size, hipStream_t stream) {
    static int grid = 0;
    if (grid == 0) {
        if (n_in != 24 || out_size != T * D || ws_size < WS_END) { fprintf(stderr, "kernel_launch: unexpected shapes (n_in %d, out %d, ws %zu < %zu)\n", n_in, out_size, ws_size, (size_t)WS_END); grid = -1; return; }
        int dev = 0, cus = 0, per_cu = 0;
        if (hipGetDevice(&dev) != hipSuccess || hipDeviceGetAttribute(&cus, hipDeviceAttributeMultiprocessorCount, dev) != hipSuccess) { grid = -1; return; }
        if (hipFuncSetAttribute((const void*)mk_fwd, hipFuncAttributeMaxDynamicSharedMemorySize, LDS_BYTES) != hipSuccess) { fprintf(stderr, "kernel_launch: hipFuncSetAttribute failed\n"); grid = -1; return; }
        if (hipOccupancyMaxActiveBlocksPerMultiprocessor(&per_cu, (const void*)mk_fwd, NWAVES * 64, LDS_BYTES) != hipSuccess || per_cu < 1) fprintf(stderr, "kernel_launch: occupancy query says %d\n", per_cu);
        (void)hipGetLastError();
        grid = cus;
    }
    if (grid < 0) return;
    (void)hipMemsetAsync((char*)d_ws + WS_CTL, 0, CTL_BYTES, stream);
    Args a{};
    for (int i = 0; i < 24; ++i) a.in[i] = d_in[i];
    a.out = (float*)d_out; a.ws = (unsigned char*)d_ws;
#if MK_ONE_LAUNCH
    a.ph_lo = 0; a.ph_hi = NPH;
    hipLaunchKernelGGL(mk_fwd, dim3(grid), dim3(NWAVES * 64), LDS_BYTES, stream, a);
#else
    for (int p = 0; p < NPH; ++p) { a.ph_lo = p; a.ph_hi = p + 1; hipLaunchKernelGGL(mk_fwd, dim3(grid), dim3(NWAVES * 64), LDS_BYTES, stream, a); }
#endif
}
```

```cpp
#include <hip/hip_runtime.h>
#include <cstdio>
#include <cstdint>
#define MK_ONE_LAUNCH 1
namespace pg8 {
#define PG8_LAS __attribute__((address_space(3)))
typedef unsigned short bf16_t;
typedef short bf16x8 __attribute__((ext_vector_type(8)));
typedef float f32x4 __attribute__((ext_vector_type(4)));
typedef unsigned u32x4 __attribute__((ext_vector_type(4)));
constexpr int BM = 256, BK = 64, HALF = 128, HTB = HALF * BK * 2  , STAGE_BYTES = 8 * HTB, NXCD = 8, WGM = 8;

__host__ __device__ __forceinline__ int lds_byte(int r, int c) { const int st = (r >> 4) * 2 + (c >> 5), rr = r & 15, cc = c & 31, ob = rr * 64 + cc * 2; return st * 1024 + (ob ^ (((ob >> 9) & 1) << 5)); }
__host__ __device__ __forceinline__ void stage_rc(int b, int& R, int& C) { const int st = b / 1024, sb = b % 1024, swz = sb ^ (((sb >> 9) & 1) << 5); R = (st >> 1) * 16 + swz / 64; C = (st & 1) * 32 + (swz % 64) / 2; }
__host__ __device__ __forceinline__ int perm32(int rho) { const int n = rho >> 4, i = rho & 15; return 8 * (i >> 2) + 4 * n + (i & 3); }

struct Unit { int pm, pn; };
struct Gemm { const bf16_t* A; const bf16_t* Bt; int M, N, K; };

struct StaticOrder {
    int nM, nN, nwg, G, c;
    __host__ __device__ void init(int M, int N, int G_, int c_) { nM = M / BM; nN = N / BM; nwg = nM * nN; G = G_; c = c_; }
    __host__ __device__ bool next(int i, Unit& u) const {
        const long L = (long)i * G + c; if (L >= nwg) return false;
        int wgid = (int)L; { const int q = nwg / NXCD, r = nwg % NXCD, xcd = wgid % NXCD, off = wgid / NXCD; wgid = (xcd < r ? xcd * (q + 1) : r * (q + 1) + (xcd - r) * q) + off; }
        const int nig = WGM * nN, gid = wgid / nig, fm = gid * WGM, gsz = (nM - fm) < WGM ? (nM - fm) : WGM;
        u.pm = fm + ((wgid % nig) % gsz); u.pn = (wgid % nig) / gsz; return true;
    }
    __device__ __forceinline__ void a_ready(const Unit&) const {}
    __device__ __forceinline__ void done(const Unit&) const {}
};

__device__ __forceinline__ unsigned cvt_pk_bf16(float lo, float hi) { unsigned r; asm volatile("v_cvt_pk_bf16_f32 %0, %1, %2" : "=v"(r) : "v"(lo), "v"(hi)); return r; }
typedef float f32x2 __attribute__((ext_vector_type(2)));
__device__ __forceinline__ float fsilu(float v) { return v / (1.0f + __expf(-v)); }
__device__ __forceinline__ float fsigm(float v) { return 1.0f / (1.0f + __expf(-v)); }
__device__ __forceinline__ void st8bf(bf16_t* p, f32x4 v0, f32x4 v1) { u32x4 w; w.x = cvt_pk_bf16(v0[0], v0[1]); w.y = cvt_pk_bf16(v0[2], v0[3]); w.z = cvt_pk_bf16(v1[0], v1[1]); w.w = cvt_pk_bf16(v1[2], v1[3]); *(u32x4*)p = w; }
__device__ __forceinline__ bf16_t f2bf1(float f) { unsigned u = __builtin_bit_cast(unsigned, f); return (bf16_t)((u + 0x7fffu + ((u >> 16) & 1u)) >> 16); }

struct EpiIn {
    static constexpr bool PERM = true, AFTER_DRAIN = false;
    bf16_t *RQ, *RK, *RVT, *RG, *BQKV, *BZ, *CQ, *CK, *CVT, *GATES; float* BBA;
    __device__ __forceinline__ void operator()(const f32x4 (&acc)[2][2][4][2], const Unit& u, int wr, int wc, int fr, int fq) const {
        const int pn = u.pn, b = u.pm >> 3;
        const int rowt = u.pm * BM + wr * 64 + fr;
        const int cin = wc * 32 + 8 * fq;
        if (pn < 8 || (pn >= 32 && pn < 40)) {
            auto heads = [&](bf16_t* base, int hb, float sc) __attribute__((always_inline)) {
#pragma unroll
                for (int ai = 0; ai < 2; ++ai)
#pragma unroll
                    for (int m = 0; m < 4; ++m) { const int s = (rowt + ai * HALF + m * 16) - b * 2048;
#pragma unroll
                        for (int bj = 0; bj < 2; ++bj) st8bf(base + ((size_t)((b * 8 + hb + bj) * 2048 + s)) * 128 + cin, acc[ai][bj][m][0] * sc, acc[ai][bj][m][1] * sc); } };
            if (pn < 4) heads(RQ, pn * 2, 1.f); else if (pn < 8) heads(RK, (pn - 4) * 2, 0.08838834764831845f);
            else if (pn < 36) heads(CQ, (pn - 32) * 2, 1.f); else heads(CK, (pn - 36) * 2, 1.f);
        } else if ((pn >= 40 && pn < 44) || (pn >= 8 && pn < 12)) {
            const bool isr = pn < 12; const int h = isr ? pn - 8 : pn - 40; bf16_t* CVT = isr ? RVT : this->CVT;
#pragma unroll
            for (int ai = 0; ai < 2; ++ai)
#pragma unroll
                for (int m = 0; m < 4; ++m) { const int s = (rowt + ai * HALF + m * 16) - b * 2048;
#pragma unroll
                    for (int bj = 0; bj < 2; ++bj)
#pragma unroll
                        for (int n = 0; n < 2; ++n)
#pragma unroll
                            for (int e = 0; e < 4; ++e) CVT[((size_t)((b * 4 + h) * 256 + bj * HALF + cin + 4 * n + e)) * 2048 + s] = f2bf1(acc[ai][bj][m][n][e]); }
        } else if (pn == 68) {
            if (wc == 0 && fq < 2) {
#pragma unroll
                for (int ai = 0; ai < 2; ++ai)
#pragma unroll
                    for (int m = 0; m < 4; ++m) { float* p = BBA + (size_t)(rowt + ai * HALF + m * 16) * 16 + 8 * fq; *(f32x4*)p = acc[ai][0][m][0]; *(f32x4*)(p + 4) = acc[ai][0][m][1]; }
            }
        } else {
            auto rows = [&](bf16_t* base, int ldc, int c0, int act) __attribute__((always_inline)) {
#pragma unroll
                for (int ai = 0; ai < 2; ++ai)
#pragma unroll
                    for (int m = 0; m < 4; ++m) { bf16_t* rowp = base + (size_t)(rowt + ai * HALF + m * 16) * ldc + c0 + cin;
#pragma unroll
                        for (int bj = 0; bj < 2; ++bj) { f32x4 v0 = acc[ai][bj][m][0], v1 = acc[ai][bj][m][1];
                            if (act == 1) {
#pragma unroll
                                for (int e = 0; e < 4; ++e) { v0[e] = fsilu(v0[e]); v1[e] = fsilu(v1[e]); } }
                            else if (act == 2) {
#pragma unroll
                                for (int e = 0; e < 4; ++e) { v0[e] = fsigm(v0[e]); v1[e] = fsigm(v1[e]); } }
                            st8bf(rowp + bj * HALF, v0, v1); } } };
            if (pn < 16) rows(RG, 1024, (pn - 12) * 256, 1); else if (pn < 28) rows(BQKV, 3072, (pn - 16) * 256, 0);
            else if (pn < 32) rows(BZ, 1024, (pn - 28) * 256, 1); else rows(GATES, 6144, (pn - 44) * 256, 2);
        }
    }
};

struct EpiHeads {
    static constexpr bool PERM = true, AFTER_DRAIN = false;
    bf16_t* O; bf16_t* VT; int NH, rpb_shift  , vt_from_pn;
    __device__ __forceinline__ void operator()(const f32x4 (&acc)[2][2][4][2], const Unit& u, int wr, int wc, int fr, int fq) const {
        const int rowt = u.pm * BM + wr * 64 + fr, cin = wc * 32 + 8 * fq, rpb = 1 << rpb_shift;
        if (u.pn < vt_from_pn) {
#pragma unroll
            for (int ai = 0; ai < 2; ++ai)
#pragma unroll
                for (int m = 0; m < 4; ++m) { const int row = rowt + ai * HALF + m * 16, b = row >> rpb_shift, s = row & (rpb - 1);
#pragma unroll
                    for (int bj = 0; bj < 2; ++bj) st8bf(O + ((size_t)((b * NH + u.pn * 2 + bj) * rpb + s)) * 128 + cin, acc[ai][bj][m][0], acc[ai][bj][m][1]); }
        } else {
            const int hb = (u.pn - vt_from_pn) * 2;
#pragma unroll
            for (int ai = 0; ai < 2; ++ai)
#pragma unroll
                for (int m = 0; m < 4; ++m) { const int row = rowt + ai * HALF + m * 16, b = row >> rpb_shift, s = row & (rpb - 1);
#pragma unroll
                    for (int bj = 0; bj < 2; ++bj)
#pragma unroll
                        for (int n = 0; n < 2; ++n)
#pragma unroll
                            for (int e = 0; e < 4; ++e) VT[((size_t)((b * NH + hb + bj) * 128 + cin + 4 * n + e)) * rpb + s] = f2bf1(acc[ai][bj][m][n][e]); }
        }
    }
};

struct EpiResid {
    static constexpr bool PERM = false, AFTER_DRAIN = false;
    const float* in; float* out; int ldc;
    __device__ __forceinline__ void operator()(const f32x4 (&acc)[2][2][4][2], const Unit& u, int wr, int wc, int fr, int fq) const {
        const int row0 = u.pm * BM + wr * 64 + fr, col0 = u.pn * BM + wc * 32 + 4 * fq;
#pragma unroll
        for (int ai = 0; ai < 2; ++ai)
#pragma unroll
            for (int m = 0; m < 4; ++m) { const size_t off = (size_t)(row0 + ai * HALF + m * 16) * ldc + col0;
#pragma unroll
                for (int bj = 0; bj < 2; ++bj)
#pragma unroll
                    for (int n = 0; n < 2; ++n) { const f32x4 x = *(const f32x4*)(in + off + bj * HALF + n * 16); *(f32x4*)(out + off + bj * HALF + n * 16) = x + acc[ai][bj][m][n]; } }
    }
};

struct EpiBranch {
    static constexpr bool PERM = false, AFTER_DRAIN = false;
    float* M; bf16_t* OUT; const bf16_t* GATES; int seg;
    __device__ __forceinline__ void operator()(const f32x4 (&acc)[2][2][4][2], const Unit& u, int wr, int wc, int fr, int fq) const {
        typedef unsigned u32x2 __attribute__((ext_vector_type(2)));
        const int row0 = u.pm * BM + wr * 64 + fr, col0 = u.pn * BM + wc * 32 + 4 * fq;
#pragma unroll
        for (int ai = 0; ai < 2; ++ai)
#pragma unroll
            for (int m = 0; m < 4; ++m) { const int row = row0 + ai * HALF + m * 16;
#pragma unroll
                for (int bj = 0; bj < 2; ++bj)
#pragma unroll
                    for (int n = 0; n < 2; ++n) { const int col = col0 + bj * HALF + n * 16; const size_t off = (size_t)row * 2048 + col;
                        const u32x2 gw = *(const u32x2*)(GATES + (size_t)row * 6144 + seg * 2048 + col);
                        f32x4 g; g[0] = __uint_as_float(gw.x << 16); g[1] = __uint_as_float(gw.x & 0xffff0000u); g[2] = __uint_as_float(gw.y << 16); g[3] = __uint_as_float(gw.y & 0xffff0000u);
                        f32x4 v = g * acc[ai][bj][m][n];
                        if (seg > 0) v = v + *(const f32x4*)(M + off);
                        if (seg < 2) *(f32x4*)(M + off) = v;
                        else { u32x2 w; w.x = cvt_pk_bf16(v[0], v[1]); w.y = cvt_pk_bf16(v[2], v[3]); *(u32x2*)(OUT + off) = w; } } }
    }
};

struct EpiSwiglu {
    static constexpr bool PERM = true, AFTER_DRAIN = false;
    bf16_t* O; int ldc, npn;
    __device__ __forceinline__ void operator()(const f32x4 (&acc)[2][2][4][2], const Unit& u, int wr, int wc, int fr, int fq) const {
        const int row0 = u.pm * BM + wr * 64 + fr, col0 = (u.pn % npn) * HALF + wc * 32 + 8 * fq;
#pragma unroll
        for (int ai = 0; ai < 2; ++ai)
#pragma unroll
            for (int m = 0; m < 4; ++m) { f32x4 v0, v1;
#pragma unroll
                for (int e = 0; e < 4; ++e) { v0[e] = fsilu(acc[ai][0][m][0][e]) * acc[ai][1][m][0][e]; v1[e] = fsilu(acc[ai][0][m][1][e]) * acc[ai][1][m][1][e]; }
                st8bf(O + (size_t)(row0 + ai * HALF + m * 16) * ldc + col0, v0, v1); }
    }
};

struct EpiStoreF32 {
    static constexpr bool PERM = false, AFTER_DRAIN = false;
    float* Y; int ldc, npn;
    __device__ __forceinline__ void operator()(const f32x4 (&acc)[2][2][4][2], const Unit& u, int wr, int wc, int fr, int fq) const {
        const int row0 = u.pm * BM + wr * 64 + fr, col0 = (u.pn % npn) * BM + wc * 32 + 4 * fq;
#pragma unroll
        for (int ai = 0; ai < 2; ++ai)
#pragma unroll
            for (int m = 0; m < 4; ++m) { float* rowp = Y + (size_t)(row0 + ai * HALF + m * 16) * ldc + col0;
#pragma unroll
                for (int bj = 0; bj < 2; ++bj)
#pragma unroll
                    for (int n = 0; n < 2; ++n) *(f32x4*)(rowp + bj * HALF + n * 16) = acc[ai][bj][m][n]; }
    }
};

struct MoeOrder {
    const PG8_LAS int* T; int npn, G, c;
    __device__ __forceinline__ bool next(int i, Unit& u) const {
        const int total = T[25]; const long L = (long)i * G + c; if (L >= total) return false;
        int wgid = (int)L; { const int q = total / NXCD, r = total % NXCD, xcd = wgid % NXCD, off = wgid / NXCD; wgid = (xcd < r ? xcd * (q + 1) : r * (q + 1) + (xcd - r) * q) + off; }
        int e = 0;
#pragma unroll
        for (int k = 1; k < 8; ++k) if (wgid >= T[16 + k]) e = k;
        const int loc = wgid - T[16 + e], ne = T[e];
        u.pm = T[8 + e] + loc % ne; u.pn = e * npn + loc / ne; return true;
    }
    __device__ __forceinline__ void a_ready(const Unit&) const {}
    __device__ __forceinline__ void done(const Unit&) const {}
};
template <class Epi, class Sched, bool ALIGN_EPI = false, bool SP2 = false>
__device__ __forceinline__ void gemm_phase(PG8_LAS unsigned char* lds, const Gemm g, const Sched& S, const Epi& E) {
    int tid_ = threadIdx.x; asm volatile("" : "+v"(tid_)); const int tid = tid_, wid = __builtin_amdgcn_readfirstlane(tid >> 6), lane = tid & 63, wr = wid >> 2, wc = wid & 3, fr = lane & 15, fq = lane >> 4;
    const int K = g.K, nt = K / BK;
    unsigned voffA[2], voffB[2];
#pragma unroll
    for (int i = 0; i < 2; ++i) { int R, C; stage_rc(tid * 16 + i * 8192, R, C); const int Rb = Epi::PERM ? ((R & ~31) + perm32(R & 31)) : R;
        voffA[i] = (unsigned)(R * K + C) * 2u; voffB[i] = (unsigned)(Rb * K + C) * 2u; }
    const size_t kstep = (size_t)(BK * 2);
    const size_t hstep = (size_t)HALF * K * 2;
    const size_t tstep = 2 * hstep;
    const unsigned ldsw = (unsigned)wid * 1024u;
    const int aoff = lds_byte(wr * 64 + fr, fq * 8), boff = lds_byte(wc * 32 + fr, fq * 8);
#define PG8_SA(b, h) (((b) * 2 + (h)) * HTB)
#define PG8_SB(b, h) ((4 + (b) * 2 + (h)) * HTB)
#define PG8_STAGE(bufoff, gbase, voff) do { _Pragma("unroll") for (int _i = 0; _i < 2; ++_i) \
        __builtin_amdgcn_global_load_lds((const unsigned*)((const char*)(gbase) + (voff)[_i]), (PG8_LAS unsigned*)(lds + (bufoff) + ldsw + _i * 8192), 16, 0, 0); } while (0)
#define PG8_LDA(dst, b, h) do { _Pragma("unroll") for (int m = 0; m < 4; ++m) _Pragma("unroll") for (int k = 0; k < 2; ++k) dst[m][k] = *(const PG8_LAS bf16x8*)(lds + PG8_SA(b, h) + aoff + m * 2048 + k * 1024); } while (0)
#define PG8_LDB(dst, b, h) do { _Pragma("unroll") for (int n = 0; n < 2; ++n) _Pragma("unroll") for (int k = 0; k < 2; ++k) dst[n][k] = *(const PG8_LAS bf16x8*)(lds + PG8_SB(b, h) + boff + n * 2048 + k * 1024); } while (0)
#define PG8_MMA(ai, bj, At, Bt) do { __builtin_amdgcn_s_setprio(1); _Pragma("unroll") for (int m = 0; m < 4; ++m) _Pragma("unroll") for (int n = 0; n < 2; ++n) _Pragma("unroll") for (int k = 0; k < 2; ++k) \
        acc[ai][bj][m][n] = __builtin_amdgcn_mfma_f32_16x16x32_bf16(Bt[n][k], At[m][k], acc[ai][bj][m][n], 0, 0, 0); __builtin_amdgcn_s_setprio(0); } while (0)
#define PG8_WAIT_V(n) asm volatile("s_waitcnt vmcnt(" #n ")" ::: "memory")
#define PG8_WAIT_L(n) asm volatile("s_waitcnt lgkmcnt(" #n ")" ::: "memory")
#define PG8_BAR __builtin_amdgcn_s_barrier()
#define PG8_SCHED __builtin_amdgcn_sched_barrier(0)
    Unit cur, nxt; int ui = 0;
    if (!S.next(0, cur)) return;
    f32x4 acc[2][2][4][2];
#pragma unroll
    for (int a = 0; a < 2; ++a)
#pragma unroll
        for (int b = 0; b < 2; ++b)
#pragma unroll
            for (int m = 0; m < 4; ++m)
#pragma unroll
                for (int n = 0; n < 2; ++n) acc[a][b][m][n] = (f32x4){0.f, 0.f, 0.f, 0.f};
    bf16x8 At[4][2], B0[2][2], B1[2][2];
    const char* cA = (const char*)g.A + (size_t)cur.pm * tstep; const char* cB = (const char*)g.Bt + (size_t)cur.pn * tstep;
    S.a_ready(cur);
    if constexpr (SP2) {
        PG8_STAGE(PG8_SB(0, 0), cB, voffB); PG8_STAGE(PG8_SB(0, 1), cB + hstep, voffB); PG8_STAGE(PG8_SA(0, 0), cA, voffA); PG8_STAGE(PG8_SA(0, 1), cA + hstep, voffA);
        if (wr == 1) PG8_BAR;
        PG8_WAIT_V(2); PG8_BAR;
        PG8_STAGE(PG8_SB(1, 0), cB + kstep, voffB); PG8_STAGE(PG8_SA(1, 0), cA + kstep, voffA); PG8_STAGE(PG8_SB(1, 1), cB + hstep + kstep, voffB);
        PG8_WAIT_V(6); PG8_BAR;
    } else {
        PG8_STAGE(PG8_SB(0, 0), cB, voffB); PG8_STAGE(PG8_SA(0, 0), cA, voffA); PG8_STAGE(PG8_SB(0, 1), cB + hstep, voffB); PG8_STAGE(PG8_SA(0, 1), cA + hstep, voffA);
        if (wr == 1) PG8_BAR;
        PG8_WAIT_V(4); PG8_BAR;
        PG8_STAGE(PG8_SB(1, 0), cB + kstep, voffB); PG8_STAGE(PG8_SA(1, 0), cA + kstep, voffA); PG8_STAGE(PG8_SB(1, 1), cB + hstep + kstep, voffB);
        PG8_WAIT_V(6); PG8_BAR;
    }
    for (;;) {
        const bool has_next = S.next(ui + 1, nxt);
        const char* nA = has_next ? (const char*)g.A + (size_t)nxt.pm * tstep : cA; const char* nB = has_next ? (const char*)g.Bt + (size_t)nxt.pn * tstep : cB;
        for (int t = 0; t < nt; t += 2) {
            const bool last = (t == nt - 2);
            const char* a1 = cA + (size_t)(t + 1) * kstep;
            const char* a2 = last ? nA : cA + (size_t)(t + 2) * kstep; const char* b2 = last ? nB : cB + (size_t)(t + 2) * kstep;
            const char* a3 = a2 + kstep; const char* b3 = b2 + kstep;
            if (last && has_next) S.a_ready(nxt);
            if constexpr (SP2) {
            PG8_LDB(B0, 0, 0); PG8_LDB(B1, 0, 1); PG8_SCHED; PG8_LDA(At, 0, 0); PG8_STAGE(PG8_SA(1, 1), a1 + hstep, voffA);
            PG8_WAIT_V(8); PG8_WAIT_L(0); PG8_BAR; PG8_MMA(0, 0, At, B0); PG8_MMA(0, 1, At, B1); PG8_BAR; PG8_SCHED;
            PG8_LDA(At, 0, 1); PG8_STAGE(PG8_SB(0, 0), b2, voffB); PG8_STAGE(PG8_SB(0, 1), b2 + hstep, voffB); PG8_STAGE(PG8_SA(0, 0), a2, voffA);
            PG8_WAIT_V(8); PG8_WAIT_L(0); PG8_BAR; PG8_MMA(1, 0, At, B0); PG8_MMA(1, 1, At, B1); PG8_BAR; PG8_SCHED;
            PG8_LDB(B0, 1, 0); PG8_LDB(B1, 1, 1); PG8_SCHED; PG8_LDA(At, 1, 0); PG8_STAGE(PG8_SA(0, 1), a2 + hstep, voffA);
            PG8_WAIT_V(8); PG8_WAIT_L(0); PG8_BAR; PG8_MMA(0, 0, At, B0); PG8_MMA(0, 1, At, B1); PG8_BAR; PG8_SCHED;
            PG8_LDA(At, 1, 1); PG8_STAGE(PG8_SB(1, 0), b3, voffB); PG8_STAGE(PG8_SB(1, 1), b3 + hstep, voffB); PG8_STAGE(PG8_SA(1, 0), a3, voffA);
            PG8_WAIT_V(8); PG8_WAIT_L(0); PG8_BAR; PG8_MMA(1, 0, At, B0); PG8_MMA(1, 1, At, B1); PG8_BAR; PG8_SCHED;
            } else {
            PG8_LDB(B0, 0, 0); PG8_SCHED; PG8_LDA(At, 0, 0); PG8_STAGE(PG8_SA(1, 1), a1 + hstep, voffA);
            PG8_WAIT_L(8); PG8_BAR; PG8_WAIT_L(0); PG8_MMA(0, 0, At, B0); PG8_BAR; PG8_SCHED;
            PG8_LDB(B1, 0, 1); PG8_STAGE(PG8_SB(0, 0), b2, voffB);
            PG8_BAR; PG8_WAIT_L(0); PG8_MMA(0, 1, At, B1); PG8_BAR;
            PG8_LDA(At, 0, 1); PG8_STAGE(PG8_SA(0, 0), a2, voffA);
            PG8_BAR; PG8_WAIT_L(0); PG8_MMA(1, 0, At, B0); PG8_BAR; PG8_SCHED;
            PG8_STAGE(PG8_SB(0, 1), b2 + hstep, voffB);
            PG8_WAIT_V(6); PG8_BAR; PG8_MMA(1, 1, At, B1); PG8_BAR;
            PG8_LDB(B0, 1, 0); PG8_SCHED; PG8_LDA(At, 1, 0); PG8_STAGE(PG8_SA(0, 1), a2 + hstep, voffA);
            PG8_WAIT_L(8); PG8_BAR; PG8_WAIT_L(0); PG8_MMA(0, 0, At, B0); PG8_BAR; PG8_SCHED;
            PG8_LDB(B1, 1, 1); PG8_STAGE(PG8_SB(1, 0), b3, voffB);
            PG8_BAR; PG8_WAIT_L(0); PG8_MMA(0, 1, At, B1); PG8_BAR;
            PG8_LDA(At, 1, 1); PG8_STAGE(PG8_SA(1, 0), a3, voffA);
            PG8_BAR; PG8_WAIT_L(0); PG8_MMA(1, 0, At, B0); PG8_BAR; PG8_SCHED;
            PG8_STAGE(PG8_SB(1, 1), b3 + hstep, voffB);
            PG8_WAIT_V(6); PG8_BAR; PG8_MMA(1, 1, At, B1); PG8_BAR;
            }
        }
        if constexpr (ALIGN_EPI) { if (wr == 0) PG8_BAR; }
        if constexpr (!Epi::AFTER_DRAIN) { E(acc, cur, wr, wc, fr, fq); S.done(cur); }
        if (!has_next) break;
#pragma unroll
        for (int a = 0; a < 2; ++a)
#pragma unroll
            for (int b = 0; b < 2; ++b)
#pragma unroll
                for (int m = 0; m < 4; ++m)
#pragma unroll
                    for (int n = 0; n < 2; ++n) acc[a][b][m][n] = (f32x4){0.f, 0.f, 0.f, 0.f};
        cur = nxt; cA = nA; cB = nB; ++ui;
        if constexpr (ALIGN_EPI) { if (wr == 1) PG8_BAR; }
    }
    PG8_WAIT_V(0);
    if constexpr (!ALIGN_EPI) { if (wr == 0) PG8_BAR; }
    PG8_BAR;
    if constexpr (Epi::AFTER_DRAIN) { E.fused(acc, cur, wr, wc, fr, fq, lds, wid, lane); S.done(cur); }
#undef PG8_SA
#undef PG8_SB
#undef PG8_STAGE
#undef PG8_LDA
#undef PG8_LDB
#undef PG8_MMA
#undef PG8_WAIT_V
#undef PG8_WAIT_L
#undef PG8_BAR
#undef PG8_SCHED
}
}
#ifndef MK_ONE_LAUNCH
#define MK_ONE_LAUNCH 0
#endif
constexpr int NWAVES = 8;
constexpr int NB = 4, SEQ = 2048, T = NB * SEQ, D = 2048, MEML = 256, MEMR = NB * MEML;
constexpr int NINP = 17664;
constexpr int DFF = 5632, EFF = 7168, NEXP = 8, MAXSLOT = 18432;
constexpr float EPS = 1e-6f;
constexpr int NPL = 15, NPH = 2 + 2 * NPL;

constexpr size_t MiB = 1u << 20;
constexpr size_t WS_CTL = 0, CTL_BYTES = 1 * MiB;
constexpr size_t WS_WIN = WS_CTL + CTL_BYTES;
constexpr size_t WS_WBR = WS_WIN + 2 * 69 * MiB;
constexpr size_t WS_WOUT = WS_WBR + 2 * 12 * MiB;
constexpr size_t WS_WQ = WS_WOUT + 2 * 8 * MiB;
constexpr size_t WS_WKV = WS_WQ + 2 * 2 * MiB;
constexpr size_t WS_WO = WS_WKV + 2 * 4 * MiB;
constexpr size_t WS_WGU = WS_WO + 2 * 2 * MiB;
constexpr size_t WS_WDN = WS_WGU + 44 * MiB;
constexpr size_t WS_WEGU = WS_WDN + 22 * MiB;
constexpr size_t WS_WEDN = WS_WEGU + 448 * MiB;
constexpr size_t WS_XRES = WS_WEDN + 224 * MiB;
constexpr size_t WS_H = WS_XRES + 64 * MiB;
constexpr size_t WS_RQ = WS_H + 32 * MiB, WS_RK = WS_RQ + 16 * MiB, WS_RV = WS_RK + 16 * MiB, WS_RG = WS_RV + 16 * MiB;
constexpr size_t WS_BQKV = WS_RG + 16 * MiB;
constexpr size_t WS_BZ = WS_BQKV + 48 * MiB;
constexpr size_t WS_BBA = WS_BZ + 16 * MiB;
constexpr size_t WS_CQ = WS_BBA + 1 * MiB, WS_CK = WS_CQ + 16 * MiB, WS_CVT = WS_CK + 16 * MiB;
constexpr size_t WS_GATES = WS_CVT + 16 * MiB;
constexpr size_t WS_GQ = WS_GATES + 96 * MiB, WS_GK = WS_GQ + 16 * MiB, WS_GV = WS_GK + 16 * MiB;
constexpr size_t WS_GG = WS_GV + 16 * MiB, WS_GB = WS_GG + 1 * MiB;
constexpr size_t WS_OA = WS_GB + 1 * MiB, WS_OB = WS_OA + 32 * MiB;
constexpr size_t WS_O12 = WS_OB + 32 * MiB;
constexpr size_t WS_OCAT = WS_O12 + 64 * MiB;
constexpr size_t WS_MERGE = WS_OCAT + 48 * MiB;
constexpr size_t WS_MERGEB = WS_MERGE + 64 * MiB;
constexpr size_t WS_MEMN = WS_MERGEB + 32 * MiB;
constexpr size_t WS_KX = WS_MEMN + 8 * MiB;
constexpr size_t WS_VXT = WS_KX + 2 * MiB;
constexpr size_t WS_QX = WS_VXT + 2 * MiB;
constexpr size_t WS_OX = WS_QX + 8 * MiB;
constexpr size_t WS_ACT = WS_OX + 8 * MiB;
constexpr size_t WS_HG = WS_ACT + 88 * MiB;
constexpr size_t WS_EACT = WS_HG + 72 * MiB;
constexpr size_t WS_Y = WS_EACT + 252 * MiB;
constexpr size_t WS_ROUTE = WS_Y + 144 * MiB;
constexpr size_t WS_GCH = WS_ROUTE + 1 * MiB;
constexpr size_t WS_GL = WS_GCH + 88 * MiB;
constexpr size_t WS_END = WS_GL + 1 * MiB;
constexpr int CW_CNT = 64;
constexpr int CW_BAR = 4096;

constexpr int RING_BYTES = 131072, MISC_OFF = RING_BYTES + 320, LDS_BYTES = 147456;

#define GAS __attribute__((address_space(1)))
#define LAS __attribute__((address_space(3)))
#define DI __device__ __forceinline__
typedef unsigned short bf16;
typedef unsigned v4u __attribute__((ext_vector_type(4)));
typedef unsigned v2u __attribute__((ext_vector_type(2)));
typedef float f32x4 __attribute__((ext_vector_type(4)));
typedef short bf16x8 __attribute__((ext_vector_type(8)));
typedef short s16x4 __attribute__((ext_vector_type(4)));
DI float bf2f(unsigned v) { return __uint_as_float(v << 16); }
DI unsigned f2bf(float f) { unsigned u = __builtin_bit_cast(unsigned, f); return (u + 0x7fffu + ((u >> 16) & 1u)) >> 16; }
DI unsigned pk2(float lo, float hi) { return f2bf(lo) | (f2bf(hi) << 16); }
DI float wave_sum(float v) {
#pragma unroll
    for (int o = 1; o < 64; o <<= 1) v += __shfl_xor(v, o);
    return v;
}

#define XB_TMO      128
#define XB_XCNT(j)  (256  + 64 * (j))
#define XB_XSUB(j)  (1280 + 64 * (j))
#define XB_XGEN(j)  (2304 + 64 * (j))
#define XB_TOP      3328
#define XB_TOPGEN   3392
#define XCD_BAR_WORDS 3456
#define XB_SPIN_CAP (1u << 18)

__device__ __forceinline__ unsigned xb_ld(unsigned* p)              { return __hip_atomic_load(p, __ATOMIC_RELAXED, __HIP_MEMORY_SCOPE_AGENT); }
__device__ __forceinline__ unsigned xb_add(unsigned* p, unsigned v) { return __hip_atomic_fetch_add(p, v, __ATOMIC_RELAXED, __HIP_MEMORY_SCOPE_AGENT); }
__device__ __forceinline__ unsigned xb_xcc_id() { return (unsigned)__builtin_amdgcn_s_getreg((3 << 11) | 20) & 0xFu; }
#define XB_SPIN(cond, bar) do { unsigned _sp = 0; while (cond) { __builtin_amdgcn_s_sleep(1); \
    if ((++_sp & 255u) == 0u) { if (xb_ld(&(bar)[XB_TMO])) break; if (_sp > XB_SPIN_CAP) { atomicAdd(&(bar)[XB_TMO], 1u); break; } } } } while (0)

struct XcdBarrier {
    unsigned* bar; unsigned x;
    volatile LAS unsigned* st;
};

__device__ __forceinline__ XcdBarrier xcd_barrier_post(unsigned* bar, volatile LAS unsigned* st) {
    XcdBarrier b; b.bar = bar; b.x = xb_xcc_id(); b.st = st;
    if (threadIdx.x == 0) (void)xb_add(&bar[XB_XCNT(b.x)], 1u);
    return b;
}
__device__ __forceinline__ void xcd_barrier_complete(unsigned* bar, unsigned x, unsigned& nloc, unsigned& nx) {
    const unsigned G = gridDim.x * gridDim.y * gridDim.z;
    unsigned sum, cnt, mine, sp = 0u;
    for (;;) {
        sum = 0u; cnt = 0u; mine = 0u;
#pragma unroll
        for (unsigned j = 0; j < 16; ++j) { const unsigned c = xb_ld(&bar[XB_XCNT(j)]); sum += c; cnt += (c > 0u) ? 1u : 0u; mine = (j == x) ? c : mine; }
        if (sum == G) break;
        __builtin_amdgcn_s_sleep(1);
        if ((++sp & 255u) == 0u) { if (xb_ld(&bar[XB_TMO])) break; if (sp > XB_SPIN_CAP) { atomicAdd(&bar[XB_TMO], 1u); break; } }
    }
    nloc = mine > 0u ? mine : 1u; nx = cnt > 0u ? cnt : 1u;
}

__device__ __forceinline__ void xcd_barrier(const XcdBarrier& b) {
    asm volatile("s_waitcnt vmcnt(0)" ::: "memory");
    __syncthreads();
    if (threadIdx.x == 0) {
        unsigned* bar = b.bar;
        __builtin_amdgcn_s_waitcnt(0);
        unsigned nloc = b.st[0], nx = b.st[1];
        if (nloc == 0u) { xcd_barrier_complete(bar, b.x, nloc, nx); b.st[0] = nloc; b.st[1] = nx; }
        const unsigned old = xb_add(&bar[XB_XSUB(b.x)], 1u);
        const unsigned gen = old / nloc;
        if (old + 1u == (gen + 1u) * nloc) {
            __builtin_amdgcn_fence(__ATOMIC_RELEASE, "agent");
            asm volatile("s_waitcnt vmcnt(0)" ::: "memory");
            const unsigned og = xb_add(&bar[XB_TOP], 1u);
            const unsigned tg = og / nx;
            if (og + 1u == (tg + 1u) * nx) xb_add(&bar[XB_TOPGEN], 1u);
            else XB_SPIN(xb_ld(&bar[XB_TOPGEN]) == tg, bar);
            __builtin_amdgcn_fence(__ATOMIC_ACQUIRE, "agent");
            xb_add(&bar[XB_XGEN(b.x)], 1u);
            asm volatile("s_waitcnt vmcnt(0)" ::: "memory");
        } else {
            XB_SPIN(xb_ld(&bar[XB_XGEN(b.x)]) == gen, bar);
            __builtin_amdgcn_fence(__ATOMIC_ACQUIRE, "agent");
            asm volatile("s_waitcnt vmcnt(0)" ::: "memory");
        }
    }
    __syncthreads();
}

struct Args { const void* in[24]; float* out; unsigned char* ws; int ph_lo, ph_hi; };

struct Frame {
    LAS unsigned char* lds;
    int tid, lane, wave, G, vcu, gw, NGW;
};

DI void conv_job(const Frame& F, const float* W, int K, int Nsrc, bf16* WT, int Ndst, int mode, int Fgu) {
    LAS unsigned* scr = (LAS unsigned*)(F.lds + F.wave * 8704);
    const int nkb = K / 64, nnb = Ndst / 64, items = nkb * nnb, lane = F.lane;
    for (int it = F.gw; it < items; it += F.NGW) {
        const int nb = it / nkb, kb = it % nkb, k0 = kb * 64, n0 = nb * 64, n = n0 + lane;
        int ns;
        if (mode == 0) ns = n;
        else if (mode == 1) ns = n < 8192 ? n : (n < 17408 ? n + 16 : (n < 17424 ? n - 17408 + 8192 : -1));
        else { const int pn = n >> 8, half = (n >> 7) & 1, j = n & 127; ns = half * Fgu + 128 * pn + j; }
        const float* src = W + (size_t)k0 * Nsrc + (ns < 0 ? 0 : ns);
#pragma unroll 8
        for (int i = 0; i < 32; ++i) { float a = src[(size_t)(2 * i) * Nsrc], b = src[(size_t)(2 * i + 1) * Nsrc]; if (ns < 0) { a = 0.f; b = 0.f; } scr[lane * 33 + i] = pk2(a, b); }
        asm volatile("s_waitcnt lgkmcnt(0)" ::: "memory");
#pragma unroll
        for (int j = 0; j < 8; ++j) { const int nn = (lane >> 3) + 8 * j, kq = lane & 7; v4u o; const LAS unsigned* s = scr + nn * 33 + 4 * kq; o.x = s[0]; o.y = s[1]; o.z = s[2]; o.w = s[3];
            *(v4u*)(WT + (size_t)(n0 + nn) * K + k0 + 8 * kq) = o; }
        asm volatile("s_waitcnt lgkmcnt(0)" ::: "memory");
    }
}

DI void rms_row(const float* xrow, const float* w, bf16* orow, int lane) {
    f32x4 v[8]; float ss = 0.f;
#pragma unroll
    for (int j = 0; j < 8; ++j) { v[j] = *(const f32x4*)(xrow + 4 * (lane + 64 * j)); ss += (v[j][0] * v[j][0] + v[j][1] * v[j][1]) + (v[j][2] * v[j][2] + v[j][3] * v[j][3]); }
    const float rstd = rsqrtf(wave_sum(ss) * (1.f / D) + EPS);
#pragma unroll
    for (int j = 0; j < 8; ++j) { const f32x4 ww = *(const f32x4*)(w + 4 * (lane + 64 * j)); v2u o; o.x = pk2(v[j][0] * rstd * ww[0], v[j][1] * rstd * ww[1]); o.y = pk2(v[j][2] * rstd * ww[2], v[j][3] * rstd * ww[3]);
        *(v2u*)(orow + 4 * (lane + 64 * j)) = o; }
}

template <bool GDN>
DI void seq_mixer(const Frame& F, int bh, const bf16* Q, const bf16* K, const bf16* V, const float* Gg, const float* Gb, float* OUT, float gamma) {
    LAS float* qs = (LAS float*)F.lds; LAS float* ks = qs + 32 * 128; LAS float* vs = ks + 32 * 128; LAS float* red = vs + 32 * 128; LAS float* gs = red + 2 * 4 * 128; LAS float* bs = gs + 32;
    const int tid = F.tid, v = tid & 127, kg = tid >> 7, b = bh >> 3, h = bh & 7;
    const size_t hb = (size_t)bh * SEQ * 128;
    float Sr[32];
#pragma unroll
    for (int i = 0; i < 32; ++i) Sr[i] = 0.f;
    for (int c0 = 0; c0 < SEQ; c0 += 32) {
        __syncthreads();
#pragma unroll
        for (int j = 0; j < 4; ++j) { const int idx = tid + 512 * j, tok = idx >> 6, d = (idx & 63) * 2; const size_t go = hb + (size_t)(c0 + tok) * 128 + d;
            const unsigned a = *(const unsigned*)(Q + go), bb = *(const unsigned*)(K + go), cc = *(const unsigned*)(V + go);
            qs[tok * 128 + d] = bf2f(a & 0xffffu); qs[tok * 128 + d + 1] = __uint_as_float(a & 0xffff0000u);
            ks[tok * 128 + d] = bf2f(bb & 0xffffu); ks[tok * 128 + d + 1] = __uint_as_float(bb & 0xffff0000u);
            vs[tok * 128 + d] = bf2f(cc & 0xffffu); vs[tok * 128 + d + 1] = __uint_as_float(cc & 0xffff0000u); }
        if (GDN && tid < 32) { gs[tid] = Gg[(size_t)bh * SEQ + c0 + tid]; bs[tid] = Gb[(size_t)bh * SEQ + c0 + tid]; }
        __syncthreads();
        for (int tt = 0; tt < 32; ++tt) {
            const LAS float* kt = ks + tt * 128 + kg * 32; const LAS float* qt = qs + tt * 128 + kg * 32;
            float po = 0.f;
            if (GDN) {
                const float a = __expf(gs[tt]); float p = 0.f;
#pragma unroll
                for (int i = 0; i < 32; ++i) { Sr[i] *= a; p += Sr[i] * kt[i]; }
                red[kg * 128 + v] = p; __syncthreads();
                const float kv = (red[v] + red[128 + v]) + (red[256 + v] + red[384 + v]);
                const float delta = bs[tt] * (vs[tt * 128 + v] - kv);
#pragma unroll
                for (int i = 0; i < 32; ++i) { Sr[i] += kt[i] * delta; po += Sr[i] * qt[i]; }
                red[512 + kg * 128 + v] = po; __syncthreads();
                if (kg == 0) OUT[((size_t)(b * SEQ + c0 + tt)) * 1024 + h * 128 + v] = (red[512 + v] + red[640 + v]) + (red[768 + v] + red[896 + v]);
            } else {
                const float vv = vs[tt * 128 + v]; LAS float* r = red + (tt & 1) * 512;
#pragma unroll
                for (int i = 0; i < 32; ++i) { Sr[i] = gamma * Sr[i] + kt[i] * vv; po += Sr[i] * qt[i]; }
                r[kg * 128 + v] = po; __syncthreads();
                if (kg == 0) OUT[((size_t)(b * SEQ + c0 + tt)) * 1024 + h * 128 + v] = (r[v] + r[128 + v]) + (r[256 + v] + r[384 + v]);
            }
        }
    }
    __syncthreads();
}

template <int DV, bool CAUSAL, bool OUT_BF16, bool DECAY>
DI void flash_item(const Frame& F, const bf16* Q, const bf16* Kh, const bf16* VT, int vpitch, int q0, int nkeys, float slope, float* OUTF, bf16* OUTB, int opitch) {
    constexpr int KP = 272, VP = 144;
    LAS unsigned char* Kl = F.lds; LAS unsigned char* Vl = F.lds + 64 * KP;
    int tid_ = F.tid; asm volatile("" : "+v"(tid_));
    const int tid = tid_, lane = tid & 63, w = F.wave, li = lane & 15, g = lane >> 4;
    const float SC = 0.08838834764831845f, L2E = 1.4426950408889634f;
    bf16x8 qf[4];
#pragma unroll
    for (int ks = 0; ks < 4; ++ks) qf[ks] = *(const bf16x8*)(Q + (size_t)(w * 16 + li) * 128 + ks * 32 + g * 8);
    f32x4 o[DV / 16];
#pragma unroll
    for (int c = 0; c < DV / 16; ++c) o[c] = (f32x4){0.f, 0.f, 0.f, 0.f};
    float m_run = -1e30f, l_run = 0.f;
    const int qpos = q0 + w * 16 + li;
    const int kend = CAUSAL ? (q0 + 128 < nkeys ? q0 + 128 : nkeys) : nkeys;
    for (int j0 = 0; j0 < kend; j0 += 64) {
        __syncthreads();
#pragma unroll
        for (int i = 0; i < 2; ++i) { const int c = tid + 512 * i, row = c >> 4, cc = c & 15; *(LAS v4u*)(Kl + row * KP + cc * 16) = *(const v4u*)(Kh + (size_t)(j0 + row) * 128 + cc * 8); }
#pragma unroll
        for (int i = 0; i < DV / 64; ++i) { const int c = tid + 512 * i, row = c >> 3, cc = c & 7; *(LAS v4u*)(Vl + row * VP + cc * 16) = *(const v4u*)(VT + (size_t)row * vpitch + j0 + cc * 8); }
        __syncthreads();
        f32x4 s[4];
#pragma unroll
        for (int t = 0; t < 4; ++t) { s[t] = (f32x4){0.f, 0.f, 0.f, 0.f};
#pragma unroll
            for (int ks = 0; ks < 4; ++ks) { const bf16x8 a = *(const LAS bf16x8*)(Kl + (t * 16 + li) * KP + (ks * 32 + g * 8) * 2); s[t] = __builtin_amdgcn_mfma_f32_16x16x32_bf16(a, qf[ks], s[t], 0, 0, 0); } }
        float alpha = 1.f;
        if (DECAY) {
#pragma unroll
            for (int t = 0; t < 4; ++t)
#pragma unroll
                for (int r = 0; r < 4; ++r) { const int key = j0 + t * 16 + g * 4 + r; const float dcy = exp2f(slope * (float)(qpos - key)); s[t][r] = key > qpos ? 0.f : s[t][r] * dcy; }
        } else {
        float mx = -__builtin_inff();
#pragma unroll
        for (int t = 0; t < 4; ++t)
#pragma unroll
            for (int r = 0; r < 4; ++r) { const int key = j0 + t * 16 + g * 4 + r; float x = s[t][r] * SC - slope * (float)(qpos - key); if (CAUSAL && key > qpos) x = -__builtin_inff(); s[t][r] = x; mx = fmaxf(mx, x); }
        mx = fmaxf(mx, __shfl_xor(mx, 16)); mx = fmaxf(mx, __shfl_xor(mx, 32));
        const float m_new = fmaxf(m_run, mx); alpha = exp2f((m_run - m_new) * L2E); m_run = m_new;
        float ps = 0.f;
#pragma unroll
        for (int t = 0; t < 4; ++t)
#pragma unroll
            for (int r = 0; r < 4; ++r) { const float p = exp2f((s[t][r] - m_new) * L2E); s[t][r] = p; ps += p; }
        ps += __shfl_xor(ps, 16); ps += __shfl_xor(ps, 32);
        l_run = l_run * alpha + ps;
        }
        bf16x8 pf[2];
#pragma unroll
        for (int s2 = 0; s2 < 2; ++s2) { v4u pw; pw.x = pk2(s[2 * s2][0], s[2 * s2][1]); pw.y = pk2(s[2 * s2][2], s[2 * s2][3]); pw.z = pk2(s[2 * s2 + 1][0], s[2 * s2 + 1][1]); pw.w = pk2(s[2 * s2 + 1][2], s[2 * s2 + 1][3]); pf[s2] = __builtin_bit_cast(bf16x8, pw); }
        float al[4];
#pragma unroll
        for (int r = 0; r < 4; ++r) al[r] = DECAY ? 1.f : __shfl(alpha, g * 4 + r);
#pragma unroll
        for (int c = 0; c < DV / 16; ++c) {
            if (!DECAY) {
#pragma unroll
                for (int r = 0; r < 4; ++r) o[c][r] *= al[r]; }
#pragma unroll
            for (int s2 = 0; s2 < 2; ++s2) { const LAS unsigned char* vp = Vl + (c * 16 + li) * VP + (s2 * 32 + g * 4) * 2; const v2u lo = *(const LAS v2u*)vp, hi = *(const LAS v2u*)(vp + 32);
                v4u bw; bw.x = lo.x; bw.y = lo.y; bw.z = hi.x; bw.w = hi.y; o[c] = __builtin_amdgcn_mfma_f32_16x16x32_bf16(pf[s2], __builtin_bit_cast(bf16x8, bw), o[c], 0, 0, 0); }
        }
    }
    float il[4];
#pragma unroll
    for (int r = 0; r < 4; ++r) il[r] = DECAY ? 1.f : 1.0f / __shfl(l_run, g * 4 + r);
#pragma unroll
    for (int c = 0; c < DV / 16; ++c)
#pragma unroll
        for (int r = 0; r < 4; ++r) { const unsigned off = (unsigned)((w * 16 + g * 4 + r) * opitch + c * 16 + li); const float v = o[c][r] * il[r];
            if (OUT_BF16) OUTB[off] = (bf16)f2bf(v); else OUTF[off] = v; }
}

constexpr int GDN_CH_BYTES = 16384 + 16384 + 8192 + 16384 + 32768;
DI int perm32pos(int k) { return (k & ~31) | (((k >> 2) & 3) << 3) | (((k >> 4) & 1) << 2) | (k & 3); }
DI void gdn_prep_item(const Frame& F, int l, int bh, int n, const bf16* BQKV, const float* BBA, const float* cw, const float* a_log, const float* dt_bias, unsigned char* CH, float* GLp) {
    LAS unsigned char* Kl = F.lds; LAS unsigned char* Ql = F.lds + 17408; LAS unsigned char* KBT = F.lds + 34816; LAS unsigned char* VBT = F.lds + 53248; LAS unsigned char* KTl = F.lds + 71680;
    LAS float* Am = (LAS float*)(F.lds + 90112); LAS unsigned char* Tl = F.lds + 106752; LAS unsigned char* AQl = F.lds + 115968; LAS float* Gs = (LAS float*)(F.lds + 125184); LAS float* gs = Gs + 64; LAS float* bs = gs + 64;
    LAS float* CWl = Am;
    int tid_ = F.tid; asm volatile("" : "+v"(tid_));
    const int tid = tid_, lane = tid & 63, w = F.wave, li = lane & 15, g = lane >> 4;
    const int b = bh >> 3, h = bh & 7, i = tid >> 3, cg = tid & 7, c0 = cg * 16, s = n * 64 + i, t = b * SEQ + s;
    bf16* Wn = (bf16*)CH; bf16* QD = (bf16*)(CH + 16384); bf16* AQK = (bf16*)(CH + 32768); bf16* KT = (bf16*)(CH + 40960); float* UT = (float*)(CH + 57344);
    __syncthreads();
    for (int e = tid; e < 1536; e += 512) { const int part = e >> 9, j = (e >> 7) & 3, c = e & 127; CWl[e] = cw[j * 3072 + part * 1024 + h * 128 + c]; }
    if (cg == 0) { const float bbv = BBA[(size_t)t * 16 + h], bav = BBA[(size_t)t * 16 + 8 + h] + dt_bias[l * 8 + h]; const float sp = bav > 20.f ? bav : log1pf(__expf(bav)); bs[i] = pg8::fsigm(bbv); gs[i] = -__expf(a_log[l * 8 + h]) * sp; }
    __syncthreads();
    float qv[16], kv[16], vv[16];
#pragma unroll
    for (int part = 0; part < 3; ++part) {
        float a[16];
#pragma unroll
        for (int c = 0; c < 16; ++c) a[c] = 0.f;
#pragma unroll
        for (int j = 0; j < 4; ++j) { if (s - 3 + j >= 0) { const v4u x0 = *(const v4u*)(BQKV + (size_t)(t - 3 + j) * 3072 + part * 1024 + h * 128 + c0), x1 = *(const v4u*)(BQKV + (size_t)(t - 3 + j) * 3072 + part * 1024 + h * 128 + c0 + 8);
                const LAS float* wj = CWl + part * 512 + j * 128 + c0;
#pragma unroll
                for (int c = 0; c < 4; ++c) { a[2 * c] += bf2f(x0[c] & 0xffffu) * wj[2 * c]; a[2 * c + 1] += __uint_as_float(x0[c] & 0xffff0000u) * wj[2 * c + 1]; a[8 + 2 * c] += bf2f(x1[c] & 0xffffu) * wj[8 + 2 * c]; a[9 + 2 * c] += __uint_as_float(x1[c] & 0xffff0000u) * wj[9 + 2 * c]; } } }
#pragma unroll
        for (int c = 0; c < 16; ++c) { const float y = pg8::fsilu(a[c]); if (part == 0) qv[c] = y; else if (part == 1) kv[c] = y; else vv[c] = y; }
    }
    { float sq = 0.f, sk = 0.f;
#pragma unroll
      for (int c = 0; c < 16; ++c) { sq += qv[c] * qv[c]; sk += kv[c] * kv[c]; }
      sq += __shfl_xor(sq, 1); sq += __shfl_xor(sq, 2); sq += __shfl_xor(sq, 4); sk += __shfl_xor(sk, 1); sk += __shfl_xor(sk, 2); sk += __shfl_xor(sk, 4);
      const float qn = rsqrtf(sq + 1e-6f) * 0.08838834764831845f, kn = rsqrtf(sk + 1e-6f);
#pragma unroll
      for (int c = 0; c < 16; ++c) { qv[c] *= qn; kv[c] *= kn; } }
    if (w == 0) { float v = gs[lane];
#pragma unroll
        for (int o = 1; o < 64; o <<= 1) { const float u = __shfl_up(v, o); if (lane >= o) v += u; }
        Gs[lane] = v; }
    __syncthreads();
    {
        const float Gi = Gs[i], Gl = Gs[63], be = bs[i], eg = __expf(Gi), kbs = be * eg, kts = __expf(Gl - Gi);
        v4u pk, pq;
#pragma unroll
        for (int hh = 0; hh < 2; ++hh) {
            pk.x = pk2(kv[8 * hh + 0], kv[8 * hh + 1]); pk.y = pk2(kv[8 * hh + 2], kv[8 * hh + 3]); pk.z = pk2(kv[8 * hh + 4], kv[8 * hh + 5]); pk.w = pk2(kv[8 * hh + 6], kv[8 * hh + 7]);
            pq.x = pk2(qv[8 * hh + 0], qv[8 * hh + 1]); pq.y = pk2(qv[8 * hh + 2], qv[8 * hh + 3]); pq.z = pk2(qv[8 * hh + 4], qv[8 * hh + 5]); pq.w = pk2(qv[8 * hh + 6], qv[8 * hh + 7]);
            *(LAS v4u*)(Kl + i * 272 + (c0 + 8 * hh) * 2) = pk; *(LAS v4u*)(Ql + i * 272 + (c0 + 8 * hh) * 2) = pq; }
        const int ip = perm32pos(i);
#pragma unroll
        for (int c = 0; c < 16; ++c) { *(LAS bf16*)(KBT + (c0 + c) * 144 + i * 2) = (bf16)f2bf(kv[c] * kbs); *(LAS bf16*)(VBT + (c0 + c) * 144 + i * 2) = (bf16)f2bf(vv[c] * be); *(LAS bf16*)(KTl + (c0 + c) * 144 + ip * 2) = (bf16)f2bf(kv[c] * kts); }
#pragma unroll
        for (int gp = 0; gp < 4; ++gp) { v2u o; o.x = pk2(qv[4 * gp] * eg, qv[4 * gp + 1] * eg); o.y = pk2(qv[4 * gp + 2] * eg, qv[4 * gp + 3] * eg); *(v2u*)(QD + i * 128 + 32 * (cg >> 1) + 8 * gp + 4 * (cg & 1)) = o; }
        if (tid == 0) *GLp = __expf(Gl);
    }
    __syncthreads();
    {
        const int kind = w >> 2, rb = w & 3; LAS unsigned char* Al = kind ? Ql : Kl;
        bf16x8 af[4];
#pragma unroll
        for (int ks = 0; ks < 4; ++ks) af[ks] = *(const LAS bf16x8*)(Al + (rb * 16 + li) * 272 + (ks * 32 + g * 8) * 2);
#pragma unroll
        for (int cb = 0; cb < 4; ++cb) {
            f32x4 acc = (f32x4){0.f, 0.f, 0.f, 0.f};
            if (cb <= rb) {
#pragma unroll
                for (int ks = 0; ks < 4; ++ks) { const bf16x8 bfr = *(const LAS bf16x8*)(Kl + (cb * 16 + li) * 272 + (ks * 32 + g * 8) * 2); acc = __builtin_amdgcn_mfma_f32_16x16x32_bf16(af[ks], bfr, acc, 0, 0, 0); } }
            const int j = cb * 16 + li; const float Gj = Gs[j];
#pragma unroll
            for (int r = 0; r < 4; ++r) { const int ii = rb * 16 + 4 * g + r; const float Lij = __expf(Gs[ii] - Gj);
                if (kind == 0) Am[ii * 65 + j] = ii > j ? acc[r] * Lij * bs[ii] : 0.f;
                else *(LAS bf16*)(AQl + ii * 144 + perm32pos(j) * 2) = (bf16)f2bf(ii >= j ? acc[r] * Lij : 0.f); }
        }
    }
    __syncthreads();
    if (w == 0) {
        int zv = 0; asm volatile("" : "+v"(zv)); const LAS float* Amv = Am + zv;
        float Tr[64];
#pragma unroll
        for (int ii = 0; ii < 64; ++ii) {
            float a0 = (ii == lane) ? 1.f : 0.f, a1 = 0.f;
#pragma unroll
            for (int j = 0; j < ii; ++j) { if (j & 1) a1 -= Amv[ii * 65 + j] * Tr[j]; else a0 -= Amv[ii * 65 + j] * Tr[j]; }
            Tr[ii] = a0 + a1;
            *(LAS bf16*)(Tl + ii * 144 + lane * 2) = (bf16)f2bf(Tr[ii]);
            asm volatile("" ::: "memory");
        }
    }
    __syncthreads();
    {
        const int kind = w >> 2; LAS unsigned char* Xl = kind ? VBT : KBT;
#pragma unroll
        for (int q2 = 0; q2 < 2; ++q2) { const int rbk = 2 * (w & 3) + q2;
            bf16x8 af[2];
#pragma unroll
            for (int ks = 0; ks < 2; ++ks) af[ks] = *(const LAS bf16x8*)(Xl + (rbk * 16 + li) * 144 + (ks * 32 + g * 8) * 2);
#pragma unroll
            for (int cb = 0; cb < 4; ++cb) { f32x4 acc = (f32x4){0.f, 0.f, 0.f, 0.f};
#pragma unroll
                for (int ks = 0; ks < 2; ++ks) { const bf16x8 bfr = *(const LAS bf16x8*)(Tl + (cb * 16 + li) * 144 + (ks * 32 + g * 8) * 2); acc = __builtin_amdgcn_mfma_f32_16x16x32_bf16(af[ks], bfr, acc, 0, 0, 0); }
                const int ii = cb * 16 + li;
                if (kind == 0) { v2u o; o.x = pk2(-acc[0], -acc[1]); o.y = pk2(-acc[2], -acc[3]); *(v2u*)(Wn + ii * 128 + 32 * (rbk >> 1) + 8 * g + 4 * (rbk & 1)) = o; }
                else {
#pragma unroll
                    for (int r = 0; r < 4; ++r) UT[(rbk * 16 + 4 * g + r) * 64 + ii] = acc[r]; } }
        }
    }
#pragma unroll
    for (int q2 = 0; q2 < 2; ++q2) { const int c = tid + 512 * q2, row = c >> 3, cc = c & 7; *(v4u*)(KT + row * 64 + cc * 8) = *(const LAS v4u*)(KTl + row * 144 + cc * 16); }
    { const int row = tid >> 3, cc = tid & 7; *(v4u*)(AQK + row * 64 + cc * 8) = *(const LAS v4u*)(AQl + row * 144 + cc * 16); }
}

DI void gdn_scan(const Frame& F, int bh, const unsigned char* CHB, const float* GLB, float* OB) {
    int lane_ = F.lane; asm volatile("" : "+v"(lane_));
    const int lane = lane_, w = F.wave, li = lane & 15, g = lane >> 4, b = bh >> 3, h = bh & 7;
    f32x4 S[8];
#pragma unroll
    for (int kb = 0; kb < 8; ++kb) S[kb] = (f32x4){0.f, 0.f, 0.f, 0.f};
    for (int n = 0; n < 32; ++n) {
        const unsigned char* CH = CHB + (size_t)(bh * 32 + n) * GDN_CH_BYTES;
        const bf16* Wn = (const bf16*)CH; const bf16* QD = (const bf16*)(CH + 16384); const bf16* AQK = (const bf16*)(CH + 32768); const bf16* KT = (const bf16*)(CH + 40960); const float* UT = (const float*)(CH + 57344);
        const float gl = GLB[bh * 32 + n];
        bf16x8 sf[4];
#pragma unroll
        for (int ks = 0; ks < 4; ++ks) { v4u p; p.x = pk2(S[2 * ks][0], S[2 * ks][1]); p.y = pk2(S[2 * ks][2], S[2 * ks][3]); p.z = pk2(S[2 * ks + 1][0], S[2 * ks + 1][1]); p.w = pk2(S[2 * ks + 1][2], S[2 * ks + 1][3]); sf[ks] = __builtin_bit_cast(bf16x8, p); }
        f32x4 vn[4];
#pragma unroll
        for (int jb = 0; jb < 4; ++jb) { vn[jb] = *(const f32x4*)(UT + (16 * w + li) * 64 + jb * 16 + 4 * g);
#pragma unroll
            for (int ks = 0; ks < 4; ++ks) { const bf16x8 a = *(const bf16x8*)(Wn + (jb * 16 + li) * 128 + ks * 32 + g * 8); vn[jb] = __builtin_amdgcn_mfma_f32_16x16x32_bf16(a, sf[ks], vn[jb], 0, 0, 0); } }
        bf16x8 vf[2];
#pragma unroll
        for (int js = 0; js < 2; ++js) { v4u p; p.x = pk2(vn[2 * js][0], vn[2 * js][1]); p.y = pk2(vn[2 * js][2], vn[2 * js][3]); p.z = pk2(vn[2 * js + 1][0], vn[2 * js + 1][1]); p.w = pk2(vn[2 * js + 1][2], vn[2 * js + 1][3]); vf[js] = __builtin_bit_cast(bf16x8, p); }
#pragma unroll
        for (int ib = 0; ib < 4; ++ib) { f32x4 z = (f32x4){0.f, 0.f, 0.f, 0.f};
#pragma unroll
            for (int ks = 0; ks < 4; ++ks) { const bf16x8 bq = *(const bf16x8*)(QD + (ib * 16 + li) * 128 + ks * 32 + g * 8); z = __builtin_amdgcn_mfma_f32_16x16x32_bf16(sf[ks], bq, z, 0, 0, 0); }
#pragma unroll
            for (int js = 0; js < 2; ++js) { const bf16x8 ba = *(const bf16x8*)(AQK + (ib * 16 + li) * 64 + js * 32 + g * 8); z = __builtin_amdgcn_mfma_f32_16x16x32_bf16(vf[js], ba, z, 0, 0, 0); }
            *(f32x4*)(OB + ((size_t)(b * SEQ + n * 64 + ib * 16 + li)) * 1024 + h * 128 + 16 * w + 4 * g) = z; }
#pragma unroll
        for (int kb = 0; kb < 8; ++kb) { S[kb] = S[kb] * gl;
#pragma unroll
            for (int js = 0; js < 2; ++js) { const bf16x8 a = *(const bf16x8*)(KT + (kb * 16 + li) * 64 + js * 32 + g * 8); S[kb] = __builtin_amdgcn_mfma_f32_16x16x32_bf16(a, vf[js], S[kb], 0, 0, 0); } }
    }
}

#define x_in ((const float*)args.in[0])
#define mem ((const float*)args.in[1])
#define w_in ((const float*)args.in[2])
#define conv_w ((const float*)args.in[3])
#define a_log ((const float*)args.in[4])
#define dt_bias ((const float*)args.in[5])
#define gdn_norm_w ((const float*)args.in[6])
#define diff_lambda ((const float*)args.in[7])
#define diff_norm_w ((const float*)args.in[8])
#define w_branch ((const float*)args.in[9])
#define w_out ((const float*)args.in[10])
#define mix_norm_w ((const float*)args.in[11])
#define mem_norm_w ((const float*)args.in[12])
#define cross_norm_w ((const float*)args.in[13])
#define cross_w_q ((const float*)args.in[14])
#define cross_w_kv ((const float*)args.in[15])
#define cross_w_o ((const float*)args.in[16])
#define ffn_norm_w ((const float*)args.in[17])
#define dense_w_gu ((const float*)args.in[18])
#define dense_w_down ((const float*)args.in[19])
#define router_w ((const float*)args.in[20])
#define expert_w_gu ((const float*)args.in[21])
#define expert_w_down ((const float*)args.in[22])
#define final_norm_w ((const float*)args.in[23])
#define WIN ((bf16*)(ws + WS_WIN))
#define WBR ((bf16*)(ws + WS_WBR))
#define WOUT ((bf16*)(ws + WS_WOUT))
#define WQ ((bf16*)(ws + WS_WQ))
#define WKV ((bf16*)(ws + WS_WKV))
#define WO ((bf16*)(ws + WS_WO))
#define WGU ((bf16*)(ws + WS_WGU))
#define WDN ((bf16*)(ws + WS_WDN))
#define WEGU ((bf16*)(ws + WS_WEGU))
#define WEDN ((bf16*)(ws + WS_WEDN))
#define XRES ((float*)(ws + WS_XRES))
#define H ((bf16*)(ws + WS_H))
#define RQ ((bf16*)(ws + WS_RQ))
#define RK ((bf16*)(ws + WS_RK))
#define RVT ((bf16*)(ws + WS_RV))
#define RG ((bf16*)(ws + WS_RG))
#define BQKV ((bf16*)(ws + WS_BQKV))
#define BZ ((bf16*)(ws + WS_BZ))
#define BBA ((float*)(ws + WS_BBA))
#define CQ ((bf16*)(ws + WS_CQ))
#define CK ((bf16*)(ws + WS_CK))
#define CVT ((bf16*)(ws + WS_CVT))
#define GATES ((bf16*)(ws + WS_GATES))
#define GQ ((bf16*)(ws + WS_GQ))
#define GK ((bf16*)(ws + WS_GK))
#define GV ((bf16*)(ws + WS_GV))
#define GG ((float*)(ws + WS_GG))
#define GB ((float*)(ws + WS_GB))
#define OA ((float*)(ws + WS_OA))
#define OB ((float*)(ws + WS_OB))
#define O12 ((float*)(ws + WS_O12))
#define OCAT ((bf16*)(ws + WS_OCAT))
#define MERGE ((float*)(ws + WS_MERGE))
#define MERGEB ((bf16*)(ws + WS_MERGEB))
#define MEMN ((bf16*)(ws + WS_MEMN))
#define KX ((bf16*)(ws + WS_KX))
#define VXT ((bf16*)(ws + WS_VXT))
#define QX ((bf16*)(ws + WS_QX))
#define OX ((bf16*)(ws + WS_OX))
#define ACT ((bf16*)(ws + WS_ACT))
#define HG ((bf16*)(ws + WS_HG))
#define EACT ((bf16*)(ws + WS_EACT))
#define Y ((float*)(ws + WS_Y))
#define ROUTE ((int*)(ws + WS_ROUTE))
__global__ void __launch_bounds__(NWAVES * 64, 2) mk_fwd(Args args) {
    extern __shared__ __attribute__((aligned(16))) unsigned char lds_raw[];
    Frame F;
    F.lds = (LAS unsigned char*)lds_raw;
    F.tid = threadIdx.x; F.lane = F.tid & 63; F.wave = __builtin_amdgcn_readfirstlane(F.tid >> 6);
    F.G = gridDim.x; { const int bx = blockIdx.x; F.vcu = (F.G % 8 == 0) ? (bx % 8) * (F.G / 8) + bx / 8 : bx; }
    F.gw = F.vcu * NWAVES + F.wave; F.NGW = F.G * NWAVES;
    volatile LAS unsigned* MISC = (volatile LAS unsigned*)(F.lds + MISC_OFF);
    LAS int* MTAB = (LAS int*)(F.lds + MISC_OFF + 128);
    unsigned char* ws = args.ws;
    unsigned* ctl = (unsigned*)(ws + WS_CTL);
    for (int u = F.tid; u < (LDS_BYTES - RING_BYTES) / 4; u += NWAVES * 64) ((LAS unsigned*)(F.lds + RING_BYTES))[u] = 0u;
    __syncthreads();
#if MK_ONE_LAUNCH
    XcdBarrier bar = xcd_barrier_post(ctl + CW_BAR, MISC + 8);
#define GRID_BAR() xcd_barrier(bar)
#else
#define GRID_BAR() do {} while (0)
#endif
    const int lo = args.ph_lo, hi = args.ph_hi;
#ifndef PROBE_PH
#define PROBE_PH -1
#endif
#define IN(k) (lo <= (k) && (k) < hi)
#define REP(k) for (int rep_ = 0; rep_ < ((k) == PROBE_PH ? 2 : 1); ++rep_)
#define SEAM(k) do { if (IN(k) && IN((k) + 1)) GRID_BAR(); } while (0)

    if (IN(0)) REP(0) {
        for (int l = 0; l < 2; ++l) {
            conv_job(F, w_in + (size_t)l * D * 17424, D, 17424, WIN + (size_t)l * NINP * D, NINP, 1, 0);
            for (int s = 0; s < 3; ++s) conv_job(F, w_branch + ((size_t)l * 3072 + s * 1024) * D, 1024, D, WBR + ((size_t)l * 3 + s) * D * 1024, D, 0, 0);
            conv_job(F, w_out + (size_t)l * D * D, D, D, WOUT + (size_t)l * D * D, D, 0, 0);
            conv_job(F, cross_w_q + (size_t)l * D * 512, D, 512, WQ + (size_t)l * 512 * D, 512, 0, 0);
            conv_job(F, cross_w_kv + (size_t)l * D * 1024, D, 1024, WKV + (size_t)l * 1024 * D, 1024, 0, 0);
            conv_job(F, cross_w_o + (size_t)l * 512 * D, 512, D, WO + (size_t)l * D * 512, D, 0, 0);
        }
        conv_job(F, dense_w_gu, D, 2 * DFF, WGU, 2 * DFF, 2, DFF);
        conv_job(F, dense_w_down, DFF, D, WDN, D, 0, 0);
        for (int e = 0; e < NEXP; ++e) {
            conv_job(F, expert_w_gu + (size_t)e * D * 2 * EFF, D, 2 * EFF, WEGU + (size_t)e * 2 * EFF * D, 2 * EFF, 2, EFF);
            conv_job(F, expert_w_down + (size_t)e * EFF * D, EFF, D, WEDN + (size_t)e * D * EFF, D, 0, 0);
        }
        for (int r = F.gw; r < T; r += F.NGW) rms_row(x_in + (size_t)r * D, mix_norm_w, H + (size_t)r * D, F.lane);
        for (int r = F.gw; r < 2 * MEMR; r += F.NGW) { const int l = r / MEMR, rr = r % MEMR; rms_row(mem + (size_t)rr * D, mem_norm_w + l * D, MEMN + (size_t)r * D, F.lane); }
    }
    SEAM(0);
    if (IN(1)) REP(1) {
        for (int l = 0; l < 2; ++l) {
            pg8::Gemm g{MEMN + (size_t)l * MEMR * D, WKV + (size_t)l * 1024 * D, MEMR, 1024, D}; pg8::StaticOrder S; S.init(MEMR, 1024, F.G, (int)((blockIdx.x + F.G - 16 * l) % F.G));
            pg8::EpiHeads E{KX + (size_t)l * NB * 4 * MEML * 128, VXT + (size_t)l * NB * 4 * 128 * MEML, 4, 8, 2};
            pg8::gemm_phase<pg8::EpiHeads, pg8::StaticOrder, true, true>(F.lds, g, S, E);
        }
    }
    SEAM(1);

    { constexpr int l = 0;
        const int pb = 2 + l * NPL;
        const float lambda_init = l == 0 ? 0.2f : 0.35550906f;
        const float* xin = l == 0 ? x_in : XRES;
        if (IN(pb + 0)) REP(pb + 0) {
            pg8::Gemm g{H, WIN + (size_t)l * NINP * D, T, NINP, D}; pg8::StaticOrder S; S.init(T, NINP, F.G, (int)blockIdx.x);
            pg8::EpiIn E{RQ, RK, RVT, RG, BQKV, BZ, CQ, CK, CVT, GATES, BBA};
            pg8::gemm_phase<pg8::EpiIn, pg8::StaticOrder, true, true>(F.lds, g, S, E);
        }
        SEAM(pb + 0);
        if (IN(pb + 1)) REP(pb + 1) {
            const float* cw = conv_w + (size_t)l * 4 * 3072;
            for (int it = F.vcu; it < 1024; it += F.G) gdn_prep_item(F, l, it >> 5, it & 31, BQKV, BBA, cw, a_log, dt_bias, ws + WS_GCH + (size_t)it * GDN_CH_BYTES, (float*)(ws + WS_GL) + it);
        }
        SEAM(pb + 1);
        if (IN(pb + 2)) REP(pb + 2) {
            const int bx = F.vcu;
            if (bx < 32) gdn_scan(F, bx, ws + WS_GCH, (const float*)(ws + WS_GL), OB);
            else {
                for (int it = bx - 32; it < 1024; it += F.G - 32) {
                    const int qt = 15 - (it >> 6), kind = (it >> 5) & 1, hd = it & 31, b = hd >> 3, hm = hd & 7;
                    if (kind == 0) { const int hh = hm >> 1, m = hm & 1; const float slope = exp2f(-2.0f * (float)(hh + 1));
                        flash_item<256, true, false, false>(F, CQ + ((size_t)hd * SEQ + qt * 128) * 128, CK + (size_t)hd * SEQ * 128, CVT + (size_t)(b * 4 + hh) * 256 * SEQ, SEQ, qt * 128, SEQ, slope,
                                                            O12 + ((size_t)m * T + b * SEQ + qt * 128) * 1024 + hh * 256, nullptr, 1024); }
                    else { const float lg = log2f(1.0f - exp2f(-5.0f - (float)hm));
                        flash_item<128, true, false, true>(F, RQ + ((size_t)hd * SEQ + qt * 128) * 128, RK + (size_t)hd * SEQ * 128, RVT + (size_t)hd * 128 * SEQ, SEQ, qt * 128, SEQ, lg,
                                                           OA + ((size_t)(b * SEQ + qt * 128)) * 1024 + hm * 128, nullptr, 1024); }
                }
            }
        }
        SEAM(pb + 2);
        if (IN(pb + 3)) REP(pb + 3) {
            const int lane = F.lane;
            const float* lv = diff_lambda + (size_t)l * 512;
            const float d01 = wave_sum(lv[lane] * lv[128 + lane] + lv[64 + lane] * lv[192 + lane]), d23 = wave_sum(lv[256 + lane] * lv[384 + lane] + lv[320 + lane] * lv[448 + lane]);
            const float lam = __expf(d01) - __expf(d23) + lambda_init;
            for (int t = F.gw; t < T; t += F.NGW) {
#pragma unroll
                for (int h = 0; h < 8; ++h) { const size_t o = (size_t)t * 1024 + h * 128 + 2 * lane;
                    { const float a0 = OA[o], a1 = OA[o + 1]; const float mean = wave_sum(a0 + a1) * (1.f / 128.f); const float c0 = a0 - mean, c1 = a1 - mean; const float rstd = rsqrtf(wave_sum(c0 * c0 + c1 * c1) * (1.f / 128.f) + EPS);
                      const unsigned gv = *(const unsigned*)(RG + o); *(unsigned*)(OCAT + o) = pk2(c0 * rstd * bf2f(gv & 0xffffu), c1 * rstd * __uint_as_float(gv & 0xffff0000u)); }
                    { const float a0 = OB[o], a1 = OB[o + 1]; const float rstd = rsqrtf(wave_sum(a0 * a0 + a1 * a1) * (1.f / 128.f) + EPS); const unsigned gv = *(const unsigned*)(BZ + o);
                      *(unsigned*)(OCAT + (size_t)T * 1024 + o) = pk2(a0 * rstd * gdn_norm_w[l * 128 + 2 * lane] * bf2f(gv & 0xffffu), a1 * rstd * gdn_norm_w[l * 128 + 2 * lane + 1] * __uint_as_float(gv & 0xffff0000u)); } }
#pragma unroll
                for (int h = 0; h < 4; ++h) { const size_t o = (size_t)t * 1024 + h * 256 + 4 * lane; const f32x4 p = *(const f32x4*)(O12 + o), q = *(const f32x4*)(O12 + (size_t)T * 1024 + o); const f32x4 d = p - q * lam;
                    const float rstd = rsqrtf(wave_sum((d[0] * d[0] + d[1] * d[1]) + (d[2] * d[2] + d[3] * d[3])) * (1.f / 256.f) + EPS) * (1.0f - lambda_init); const f32x4 ww = *(const f32x4*)(diff_norm_w + l * 256 + 4 * lane);
                    v2u ov; ov.x = pk2(d[0] * rstd * ww[0], d[1] * rstd * ww[1]); ov.y = pk2(d[2] * rstd * ww[2], d[3] * rstd * ww[3]); *(v2u*)(OCAT + (size_t)2 * T * 1024 + o) = ov; }
            }
        }
        SEAM(pb + 3);
        if (IN(pb + 4)) REP(pb + 4) {
            for (int s = 0; s < 3; ++s) {
                pg8::Gemm g{OCAT + (size_t)s * T * 1024, WBR + ((size_t)l * 3 + s) * D * 1024, T, D, 1024}; pg8::StaticOrder S; S.init(T, D, F.G, (int)blockIdx.x);
                pg8::EpiBranch E{MERGE, MERGEB, GATES, s};
                pg8::gemm_phase<pg8::EpiBranch, pg8::StaticOrder, true, true>(F.lds, g, S, E);
            }
        }
        SEAM(pb + 4);
        if (IN(pb + 5)) REP(pb + 5) {
            pg8::Gemm g{MERGEB, WOUT + (size_t)l * D * D, T, D, D}; pg8::StaticOrder S; S.init(T, D, F.G, (int)blockIdx.x);
            pg8::EpiResid E{xin, XRES, D};
            pg8::gemm_phase<pg8::EpiResid, pg8::StaticOrder, true, true>(F.lds, g, S, E);
        }
        SEAM(pb + 5);
        if (IN(pb + 6)) REP(pb + 6) { for (int r = F.gw; r < T; r += F.NGW) rms_row(XRES + (size_t)r * D, cross_norm_w + l * D, H + (size_t)r * D, F.lane); }
        SEAM(pb + 6);
        if (IN(pb + 7)) REP(pb + 7) {
            pg8::Gemm g{H, WQ + (size_t)l * 512 * D, T, 512, D}; pg8::StaticOrder S; S.init(T, 512, F.G, (int)blockIdx.x);
            pg8::EpiHeads E{QX, nullptr, 4, 11, 1 << 20};
            pg8::gemm_phase<pg8::EpiHeads, pg8::StaticOrder, true, true>(F.lds, g, S, E);
        }
        SEAM(pb + 7);
        if (IN(pb + 8)) REP(pb + 8) {
            for (int it = F.vcu; it < 256; it += F.G) { const int hd = it >> 4, qt = it & 15, b = hd >> 2, hh = hd & 3;
                flash_item<128, false, true, false>(F, QX + ((size_t)hd * SEQ + qt * 128) * 128, KX + ((size_t)l * 16 + hd) * MEML * 128, VXT + ((size_t)l * 16 + hd) * 128 * MEML, MEML, qt * 128, MEML, 0.f,
                                             nullptr, OX + ((size_t)(b * SEQ + qt * 128)) * 512 + hh * 128, 512); }
        }
        SEAM(pb + 8);
        if (IN(pb + 9)) REP(pb + 9) {
            pg8::Gemm g{OX, WO + (size_t)l * D * 512, T, D, 512}; pg8::StaticOrder S; S.init(T, D, F.G, (int)blockIdx.x);
            pg8::EpiResid E{XRES, XRES, D};
            pg8::gemm_phase<pg8::EpiResid, pg8::StaticOrder, true, true>(F.lds, g, S, E);
        }
        SEAM(pb + 9);
        if (IN(pb + 10)) REP(pb + 10) {
            const int lane = F.lane; const float* w = ffn_norm_w + l * D;
            for (int r = F.gw; r < T; r += F.NGW) {
                const float* xrow = XRES + (size_t)r * D; f32x4 v[8]; float ss = 0.f;
#pragma unroll
                for (int j = 0; j < 8; ++j) { v[j] = *(const f32x4*)(xrow + 4 * (lane + 64 * j)); ss += (v[j][0] * v[j][0] + v[j][1] * v[j][1]) + (v[j][2] * v[j][2] + v[j][3] * v[j][3]); }
                const float rstd = rsqrtf(wave_sum(ss) * (1.f / D) + EPS);
                float lg[8];
#pragma unroll
                for (int e = 0; e < 8; ++e) lg[e] = 0.f;
#pragma unroll
                for (int j = 0; j < 8; ++j) { const f32x4 ww = *(const f32x4*)(w + 4 * (lane + 64 * j)); f32x4 y; y[0] = v[j][0] * rstd * ww[0]; y[1] = v[j][1] * rstd * ww[1]; y[2] = v[j][2] * rstd * ww[2]; y[3] = v[j][3] * rstd * ww[3];
                    v2u o; o.x = pk2(y[0], y[1]); o.y = pk2(y[2], y[3]); *(v2u*)(H + (size_t)r * D + 4 * (lane + 64 * j)) = o;
                    if (l == 1) {
#pragma unroll
                        for (int c = 0; c < 4; ++c) { const float* rw = router_w + (size_t)(4 * (lane + 64 * j) + c) * 8; const f32x4 r0 = *(const f32x4*)rw, r1 = *(const f32x4*)(rw + 4);
                            lg[0] += y[c] * r0[0]; lg[1] += y[c] * r0[1]; lg[2] += y[c] * r0[2]; lg[3] += y[c] * r0[3]; lg[4] += y[c] * r1[0]; lg[5] += y[c] * r1[1]; lg[6] += y[c] * r1[2]; lg[7] += y[c] * r1[3]; } } }
                if (l == 1) {
#pragma unroll
                    for (int e = 0; e < 8; ++e) lg[e] = wave_sum(lg[e]);
                    int e0 = 0; float v0 = lg[0];
#pragma unroll
                    for (int e = 1; e < 8; ++e) if (lg[e] > v0) { v0 = lg[e]; e0 = e; }
                    int e1 = -1; float v1 = -__builtin_inff();
#pragma unroll
                    for (int e = 0; e < 8; ++e) if (e != e0 && lg[e] > v1) { v1 = lg[e]; e1 = e; }
                    if (lane == 0) { const float p0 = 1.0f / (1.0f + __expf(v1 - v0)); int* ro = ROUTE + (size_t)r * 8;
                        ro[0] = e0; ro[1] = e1; ro[2] = (int)atomicAdd(ctl + CW_CNT + e0, 1u); ro[3] = (int)atomicAdd(ctl + CW_CNT + e1, 1u); ((float*)ro)[4] = p0; ((float*)ro)[5] = 1.0f - p0; }
                }
            }
        }
        SEAM(pb + 10);
        if (l == 0) {
            if (IN(pb + 11)) REP(pb + 11) {
                pg8::Gemm g{H, WGU, T, 2 * DFF, D}; pg8::StaticOrder S; S.init(T, 2 * DFF, F.G, (int)blockIdx.x);
                pg8::EpiSwiglu E{ACT, DFF, 1 << 20};
                pg8::gemm_phase<pg8::EpiSwiglu, pg8::StaticOrder, true, true>(F.lds, g, S, E);
            }
            SEAM(pb + 11);
            if (IN(pb + 12)) REP(pb + 12) {
                pg8::Gemm g{ACT, WDN, T, D, DFF}; pg8::StaticOrder S; S.init(T, D, F.G, (int)blockIdx.x);
                pg8::EpiResid E{XRES, XRES, D};
                pg8::gemm_phase<pg8::EpiResid, pg8::StaticOrder, true, true>(F.lds, g, S, E);
            }
            SEAM(pb + 12);
            if (IN(pb + 13)) REP(pb + 13) { for (int r = F.gw; r < T; r += F.NGW) rms_row(XRES + (size_t)r * D, mix_norm_w + D, H + (size_t)r * D, F.lane); }
            SEAM(pb + 13);
            SEAM(pb + 14);
        } else {
            int off[9]; off[0] = 0;
#pragma unroll
            for (int e = 0; e < 8; ++e) { const int c = (int)__hip_atomic_load(ctl + CW_CNT + e, __ATOMIC_RELAXED, __HIP_MEMORY_SCOPE_AGENT); off[e + 1] = off[e] + ((c + 255) & ~255); }
            if (IN(pb + 11)) REP(pb + 11) {
                for (int it = F.gw; it < T * 2; it += F.NGW) { const int t = it >> 1, k = it & 1; int* ro = ROUTE + (size_t)t * 8; const int e = ro[k], pos = ro[2 + k];
                    int base = 0;
#pragma unroll
                    for (int q = 0; q < 8; ++q) if (e == q) base = off[q];
                    const int slot = base + pos; if (F.lane == 0) ro[6 + k] = slot;
                    const v4u* src = (const v4u*)(H + (size_t)t * D); v4u* dst = (v4u*)(HG + (size_t)slot * D);
#pragma unroll
                    for (int j = 0; j < 4; ++j) dst[F.lane + 64 * j] = src[F.lane + 64 * j]; }
#pragma unroll
                for (int e = 0; e < 8; ++e) { const int c = (int)__hip_atomic_load(ctl + CW_CNT + e, __ATOMIC_RELAXED, __HIP_MEMORY_SCOPE_AGENT);
                    for (int rr = off[e] + c + F.gw; rr < off[e + 1]; rr += F.NGW) { v4u* dst = (v4u*)(HG + (size_t)rr * D);
#pragma unroll
                        for (int j = 0; j < 4; ++j) dst[F.lane + 64 * j] = (v4u){0u, 0u, 0u, 0u}; } }
            }
            SEAM(pb + 11);
            if (IN(pb + 12)) REP(pb + 12) {
                if (F.tid == 0) { int cu = 0;
#pragma unroll
                    for (int e = 0; e < 8; ++e) { const int ne = (off[e + 1] - off[e]) >> 8; MTAB[e] = ne; MTAB[8 + e] = off[e] >> 8; MTAB[16 + e] = cu; cu += ne * 56; } MTAB[24] = cu; MTAB[25] = cu; }
                __syncthreads();
                pg8::Gemm g{HG, WEGU, MAXSLOT, NEXP * 2 * EFF, D}; pg8::MoeOrder S{(const LAS int*)MTAB, 56, F.G, (int)blockIdx.x};
                pg8::EpiSwiglu E{EACT, EFF, 56};
                pg8::gemm_phase<pg8::EpiSwiglu, pg8::MoeOrder, true, true>(F.lds, g, S, E);
            }
            SEAM(pb + 12);
            if (IN(pb + 13)) REP(pb + 13) {
                __syncthreads();
                if (F.tid == 0) { int cu = 0;
#pragma unroll
                    for (int e = 0; e < 8; ++e) { const int ne = (off[e + 1] - off[e]) >> 8; MTAB[e] = ne; MTAB[8 + e] = off[e] >> 8; MTAB[16 + e] = cu; cu += ne * 8; } MTAB[24] = cu; MTAB[25] = cu; }
                __syncthreads();
                pg8::Gemm g{EACT, WEDN, MAXSLOT, NEXP * D, EFF}; pg8::MoeOrder S{(const LAS int*)MTAB, 8, F.G, (int)blockIdx.x};
                pg8::EpiStoreF32 E{Y, D, 8};
                pg8::gemm_phase<pg8::EpiStoreF32, pg8::MoeOrder, true, true>(F.lds, g, S, E);
            }
            SEAM(pb + 13);
            if (IN(pb + 14)) REP(pb + 14) {
                const int lane = F.lane;
                for (int r = F.gw; r < T; r += F.NGW) { const int* ro = ROUTE + (size_t)r * 8; const float p0 = ((const float*)ro)[4], p1 = ((const float*)ro)[5]; const float* y0 = Y + (size_t)ro[6] * D; const float* y1 = Y + (size_t)ro[7] * D;
                    const float* xrow = XRES + (size_t)r * D; f32x4 v[8]; float ss = 0.f;
#pragma unroll
                    for (int j = 0; j < 8; ++j) { const int o = 4 * (lane + 64 * j); v[j] = *(const f32x4*)(xrow + o) + *(const f32x4*)(y0 + o) * p0 + *(const f32x4*)(y1 + o) * p1; ss += (v[j][0] * v[j][0] + v[j][1] * v[j][1]) + (v[j][2] * v[j][2] + v[j][3] * v[j][3]); }
                    const float rstd = rsqrtf(wave_sum(ss) * (1.f / D) + EPS);
#pragma unroll
                    for (int j = 0; j < 8; ++j) { const int o = 4 * (lane + 64 * j); const f32x4 ww = *(const f32x4*)(final_norm_w + o); *(f32x4*)(args.out + (size_t)r * D + o) = v[j] * rstd * ww; } }
            }
        }
    }
    { constexpr int l = 1;
        const int pb = 2 + l * NPL;
        const float lambda_init = l == 0 ? 0.2f : 0.35550906f;
        const float* xin = l == 0 ? x_in : XRES;
        if (IN(pb + 0)) REP(pb + 0) {
            pg8::Gemm g{H, WIN + (size_t)l * NINP * D, T, NINP, D}; pg8::StaticOrder S; S.init(T, NINP, F.G, (int)blockIdx.x);
            pg8::EpiIn E{RQ, RK, RVT, RG, BQKV, BZ, CQ, CK, CVT, GATES, BBA};
            pg8::gemm_phase<pg8::EpiIn, pg8::StaticOrder, true, true>(F.lds, g, S, E);
        }
        SEAM(pb + 0);
        if (IN(pb + 1)) REP(pb + 1) {
            const float* cw = conv_w + (size_t)l * 4 * 3072;
            for (int it = F.vcu; it < 1024; it += F.G) gdn_prep_item(F, l, it >> 5, it & 31, BQKV, BBA, cw, a_log, dt_bias, ws + WS_GCH + (size_t)it * GDN_CH_BYTES, (float*)(ws + WS_GL) + it);
        }
        SEAM(pb + 1);
        if (IN(pb + 2)) REP(pb + 2) {
            const int bx = F.vcu;
            if (bx < 32) gdn_scan(F, bx, ws + WS_GCH, (const float*)(ws + WS_GL), OB);
            else {
                for (int it = bx - 32; it < 1024; it += F.G - 32) {
                    const int qt = 15 - (it >> 6), kind = (it >> 5) & 1, hd = it & 31, b = hd >> 3, hm = hd & 7;
                    if (kind == 0) { const int hh = hm >> 1, m = hm & 1; const float slope = exp2f(-2.0f * (float)(hh + 1));
                        flash_item<256, true, false, false>(F, CQ + ((size_t)hd * SEQ + qt * 128) * 128, CK + (size_t)hd * SEQ * 128, CVT + (size_t)(b * 4 + hh) * 256 * SEQ, SEQ, qt * 128, SEQ, slope,
                                                            O12 + ((size_t)m * T + b * SEQ + qt * 128) * 1024 + hh * 256, nullptr, 1024); }
                    else { const float lg = log2f(1.0f - exp2f(-5.0f - (float)hm));
                        flash_item<128, true, false, true>(F, RQ + ((size_t)hd * SEQ + qt * 128) * 128, RK + (size_t)hd * SEQ * 128, RVT + (size_t)hd * 128 * SEQ, SEQ, qt * 128, SEQ, lg,
                                                           OA + ((size_t)(b * SEQ + qt * 128)) * 1024 + hm * 128, nullptr, 1024); }
                }
            }
        }
        SEAM(pb + 2);
        if (IN(pb + 3)) REP(pb + 3) {
            const int lane = F.lane;
            const float* lv = diff_lambda + (size_t)l * 512;
            const float d01 = wave_sum(lv[lane] * lv[128 + lane] + lv[64 + lane] * lv[192 + lane]), d23 = wave_sum(lv[256 + lane] * lv[384 + lane] + lv[320 + lane] * lv[448 + lane]);
            const float lam = __expf(d01) - __expf(d23) + lambda_init;
            for (int t = F.gw; t < T; t += F.NGW) {
#pragma unroll
                for (int h = 0; h < 8; ++h) { const size_t o = (size_t)t * 1024 + h * 128 + 2 * lane;
                    { const float a0 = OA[o], a1 = OA[o + 1]; const float mean = wave_sum(a0 + a1) * (1.f / 128.f); const float c0 = a0 - mean, c1 = a1 - mean; const float rstd = rsqrtf(wave_sum(c0 * c0 + c1 * c1) * (1.f / 128.f) + EPS);
                      const unsigned gv = *(const unsigned*)(RG + o); *(unsigned*)(OCAT + o) = pk2(c0 * rstd * bf2f(gv & 0xffffu), c1 * rstd * __uint_as_float(gv & 0xffff0000u)); }
                    { const float a0 = OB[o], a1 = OB[o + 1]; const float rstd = rsqrtf(wave_sum(a0 * a0 + a1 * a1) * (1.f / 128.f) + EPS); const unsigned gv = *(const unsigned*)(BZ + o);
                      *(unsigned*)(OCAT + (size_t)T * 1024 + o) = pk2(a0 * rstd * gdn_norm_w[l * 128 + 2 * lane] * bf2f(gv & 0xffffu), a1 * rstd * gdn_norm_w[l * 128 + 2 * lane + 1] * __uint_as_float(gv & 0xffff0000u)); } }
#pragma unroll
                for (int h = 0; h < 4; ++h) { const size_t o = (size_t)t * 1024 + h * 256 + 4 * lane; const f32x4 p = *(const f32x4*)(O12 + o), q = *(const f32x4*)(O12 + (size_t)T * 1024 + o); const f32x4 d = p - q * lam;
                    const float rstd = rsqrtf(wave_sum((d[0] * d[0] + d[1] * d[1]) + (d[2] * d[2] + d[3] * d[3])) * (1.f / 256.f) + EPS) * (1.0f - lambda_init); const f32x4 ww = *(const f32x4*)(diff_norm_w + l * 256 + 4 * lane);
                    v2u ov; ov.x = pk2(d[0] * rstd * ww[0], d[1] * rstd * ww[1]); ov.y = pk2(d[2] * rstd * ww[2], d[3] * rstd * ww[3]); *(v2u*)(OCAT + (size_t)2 * T * 1024 + o) = ov; }
            }
        }
        SEAM(pb + 3);
        if (IN(pb + 4)) REP(pb + 4) {
            for (int s = 0; s < 3; ++s) {
                pg8::Gemm g{OCAT + (size_t)s * T * 1024, WBR + ((size_t)l * 3 + s) * D * 1024, T, D, 1024}; pg8::StaticOrder S; S.init(T, D, F.G, (int)blockIdx.x);
                pg8::EpiBranch E{MERGE, MERGEB, GATES, s};
                pg8::gemm_phase<pg8::EpiBranch, pg8::StaticOrder, true, true>(F.lds, g, S, E);
            }
        }
        SEAM(pb + 4);
        if (IN(pb + 5)) REP(pb + 5) {
            pg8::Gemm g{MERGEB, WOUT + (size_t)l * D * D, T, D, D}; pg8::StaticOrder S; S.init(T, D, F.G, (int)blockIdx.x);
            pg8::EpiResid E{xin, XRES, D};
            pg8::gemm_phase<pg8::EpiResid, pg8::StaticOrder, true, true>(F.lds, g, S, E);
        }
        SEAM(pb + 5);
        if (IN(pb + 6)) REP(pb + 6) { for (int r = F.gw; r < T; r += F.NGW) rms_row(XRES + (size_t)r * D, cross_norm_w + l * D, H + (size_t)r * D, F.lane); }
        SEAM(pb + 6);
        if (IN(pb + 7)) REP(pb + 7) {
            pg8::Gemm g{H, WQ + (size_t)l * 512 * D, T, 512, D}; pg8::StaticOrder S; S.init(T, 512, F.G, (int)blockIdx.x);
            pg8::EpiHeads E{QX, nullptr, 4, 11, 1 << 20};
            pg8::gemm_phase<pg8::EpiHeads, pg8::StaticOrder, true, true>(F.lds, g, S, E);
        }
        SEAM(pb + 7);
        if (IN(pb + 8)) REP(pb + 8) {
            for (int it = F.vcu; it < 256; it += F.G) { const int hd = it >> 4, qt = it & 15, b = hd >> 2, hh = hd & 3;
                flash_item<128, false, true, false>(F, QX + ((size_t)hd * SEQ + qt * 128) * 128, KX + ((size_t)l * 16 + hd) * MEML * 128, VXT + ((size_t)l * 16 + hd) * 128 * MEML, MEML, qt * 128, MEML, 0.f,
                                             nullptr, OX + ((size_t)(b * SEQ + qt * 128)) * 512 + hh * 128, 512); }
        }
        SEAM(pb + 8);
        if (IN(pb + 9)) REP(pb + 9) {
            pg8::Gemm g{OX, WO + (size_t)l * D * 512, T, D, 512}; pg8::StaticOrder S; S.init(T, D, F.G, (int)blockIdx.x);
            pg8::EpiResid E{XRES, XRES, D};
            pg8::gemm_phase<pg8::EpiResid, pg8::StaticOrder, true, true>(F.lds, g, S, E);
        }
        SEAM(pb + 9);
        if (IN(pb + 10)) REP(pb + 10) {
            const int lane = F.lane; const float* w = ffn_norm_w + l * D;
            for (int r = F.gw; r < T; r += F.NGW) {
                const float* xrow = XRES + (size_t)r * D; f32x4 v[8]; float ss = 0.f;
#pragma unroll
                for (int j = 0; j < 8; ++j) { v[j] = *(const f32x4*)(xrow + 4 * (lane + 64 * j)); ss += (v[j][0] * v[j][0] + v[j][1] * v[j][1]) + (v[j][2] * v[j][2] + v[j][3] * v[j][3]); }
                const float rstd = rsqrtf(wave_sum(ss) * (1.f / D) + EPS);
                float lg[8];
#pragma unroll
                for (int e = 0; e < 8; ++e) lg[e] = 0.f;
#pragma unroll
                for (int j = 0; j < 8; ++j) { const f32x4 ww = *(const f32x4*)(w + 4 * (lane + 64 * j)); f32x4 y; y[0] = v[j][0] * rstd * ww[0]; y[1] = v[j][1] * rstd * ww[1]; y[2] = v[j][2] * rstd * ww[2]; y[3] = v[j][3] * rstd * ww[3];
                    v2u o; o.x = pk2(y[0], y[1]); o.y = pk2(y[2], y[3]); *(v2u*)(H + (size_t)r * D + 4 * (lane + 64 * j)) = o;
                    if (l == 1) {
#pragma unroll
                        for (int c = 0; c < 4; ++c) { const float* rw = router_w + (size_t)(4 * (lane + 64 * j) + c) * 8; const f32x4 r0 = *(const f32x4*)rw, r1 = *(const f32x4*)(rw + 4);
                            lg[0] += y[c] * r0[0]; lg[1] += y[c] * r0[1]; lg[2] += y[c] * r0[2]; lg[3] += y[c] * r0[3]; lg[4] += y[c] * r1[0]; lg[5] += y[c] * r1[1]; lg[6] += y[c] * r1[2]; lg[7] += y[c] * r1[3]; } } }
                if (l == 1) {
#pragma unroll
                    for (int e = 0; e < 8; ++e) lg[e] = wave_sum(lg[e]);
                    int e0 = 0; float v0 = lg[0];
#pragma unroll
                    for (int e = 1; e < 8; ++e) if (lg[e] > v0) { v0 = lg[e]; e0 = e; }
                    int e1 = -1; float v1 = -__builtin_inff();
#pragma unroll
                    for (int e = 0; e < 8; ++e) if (e != e0 && lg[e] > v1) { v1 = lg[e]; e1 = e; }
                    if (lane == 0) { const float p0 = 1.0f / (1.0f + __expf(v1 - v0)); int* ro = ROUTE + (size_t)r * 8;
                        ro[0] = e0; ro[1] = e1; ro[2] = (int)atomicAdd(ctl + CW_CNT + e0, 1u); ro[3] = (int)atomicAdd(ctl + CW_CNT + e1, 1u); ((float*)ro)[4] = p0; ((float*)ro)[5] = 1.0f - p0; }
                }
            }
        }
        SEAM(pb + 10);
        if (l == 0) {
            if (IN(pb + 11)) REP(pb + 11) {
                pg8::Gemm g{H, WGU, T, 2 * DFF, D}; pg8::StaticOrder S; S.init(T, 2 * DFF, F.G, (int)blockIdx.x);
                pg8::EpiSwiglu E{ACT, DFF, 1 << 20};
                pg8::gemm_phase<pg8::EpiSwiglu, pg8::StaticOrder, true, true>(F.lds, g, S, E);
            }
            SEAM(pb + 11);
            if (IN(pb + 12)) REP(pb + 12) {
                pg8::Gemm g{ACT, WDN, T, D, DFF}; pg8::StaticOrder S; S.init(T, D, F.G, (int)blockIdx.x);
                pg8::EpiResid E{XRES, XRES, D};
                pg8::gemm_phase<pg8::EpiResid, pg8::StaticOrder, true, true>(F.lds, g, S, E);
            }
            SEAM(pb + 12);
            if (IN(pb + 13)) REP(pb + 13) { for (int r = F.gw; r < T; r += F.NGW) rms_row(XRES + (size_t)r * D, mix_norm_w + D, H + (size_t)r * D, F.lane); }
            SEAM(pb + 13);
            SEAM(pb + 14);
        } else {
            int off[9]; off[0] = 0;
#pragma unroll
            for (int e = 0; e < 8; ++e) { const int c = (int)__hip_atomic_load(ctl + CW_CNT + e, __ATOMIC_RELAXED, __HIP_MEMORY_SCOPE_AGENT); off[e + 1] = off[e] + ((c + 255) & ~255); }
            if (IN(pb + 11)) REP(pb + 11) {
                for (int it = F.gw; it < T * 2; it += F.NGW) { const int t = it >> 1, k = it & 1; int* ro = ROUTE + (size_t)t * 8; const int e = ro[k], pos = ro[2 + k];
                    int base = 0;
#pragma unroll
                    for (int q = 0; q < 8; ++q) if (e == q) base = off[q];
                    const int slot = base + pos; if (F.lane == 0) ro[6 + k] = slot;
                    const v4u* src = (const v4u*)(H + (size_t)t * D); v4u* dst = (v4u*)(HG + (size_t)slot * D);
#pragma unroll
                    for (int j = 0; j < 4; ++j) dst[F.lane + 64 * j] = src[F.lane + 64 * j]; }
#pragma unroll
                for (int e = 0; e < 8; ++e) { const int c = (int)__hip_atomic_load(ctl + CW_CNT + e, __ATOMIC_RELAXED, __HIP_MEMORY_SCOPE_AGENT);
                    for (int rr = off[e] + c + F.gw; rr < off[e + 1]; rr += F.NGW) { v4u* dst = (v4u*)(HG + (size_t)rr * D);
#pragma unroll
                        for (int j = 0; j < 4; ++j) dst[F.lane + 64 * j] = (v4u){0u, 0u, 0u, 0u}; } }
            }
            SEAM(pb + 11);
            if (IN(pb + 12)) REP(pb + 12) {
                if (F.tid == 0) { int cu = 0;
#pragma unroll
                    for (int e = 0; e < 8; ++e) { const int ne = (off[e + 1] - off[e]) >> 8; MTAB[e] = ne; MTAB[8 + e] = off[e] >> 8; MTAB[16 + e] = cu; cu += ne * 56; } MTAB[24] = cu; MTAB[25] = cu; }
                __syncthreads();
                pg8::Gemm g{HG, WEGU, MAXSLOT, NEXP * 2 * EFF, D}; pg8::MoeOrder S{(const LAS int*)MTAB, 56, F.G, (int)blockIdx.x};
                pg8::EpiSwiglu E{EACT, EFF, 56};
                pg8::gemm_phase<pg8::EpiSwiglu, pg8::MoeOrder, true, true>(F.lds, g, S, E);
            }
            SEAM(pb + 12);
            if (IN(pb + 13)) REP(pb + 13) {
                __syncthreads();
                if (F.tid == 0) { int cu = 0;
#pragma unroll
                    for (int e = 0; e < 8; ++e) { const int ne = (off[e + 1] - off[e]) >> 8; MTAB[e] = ne; MTAB[8 + e] = off[e] >> 8; MTAB[16 + e] = cu; cu += ne * 8; } MTAB[24] = cu; MTAB[25] = cu; }
                __syncthreads();
                pg8::Gemm g{EACT, WEDN, MAXSLOT, NEXP * D, EFF}; pg8::MoeOrder S{(const LAS int*)MTAB, 8, F.G, (int)blockIdx.x};
                pg8::EpiStoreF32 E{Y, D, 8};
                pg8::gemm_phase<pg8::EpiStoreF32, pg8::MoeOrder, true, true>(F.lds, g, S, E);
            }
            SEAM(pb + 13);
            if (IN(pb + 14)) REP(pb + 14) {
                const int lane = F.lane;
                for (int r = F.gw; r < T; r += F.NGW) { const int* ro = ROUTE + (size_t)r * 8; const float p0 = ((const float*)ro)[4], p1 = ((const float*)ro)[5]; const float* y0 = Y + (size_t)ro[6] * D; const float* y1 = Y + (size_t)ro[7] * D;
                    const float* xrow = XRES + (size_t)r * D; f32x4 v[8]; float ss = 0.f;
#pragma unroll
                    for (int j = 0; j < 8; ++j) { const int o = 4 * (lane + 64 * j); v[j] = *(const f32x4*)(xrow + o) + *(const f32x4*)(y0 + o) * p0 + *(const f32x4*)(y1 + o) * p1; ss += (v[j][0] * v[j][0] + v[j][1] * v[j][1]) + (v[j][2] * v[j][2] + v[j][3] * v[j][3]); }
                    const float rstd = rsqrtf(wave_sum(ss) * (1.f / D) + EPS);
#pragma unroll
                    for (int j = 0; j < 8; ++j) { const int o = 4 * (lane + 64 * j); const f32x4 ww = *(const f32x4*)(final_norm_w + o); *(f32x4*)(args.out + (size_t)r * D + o) = v[j] * rstd * ww; } }
            }
        }
    }
#undef IN
#undef SEAM
}

extern "C" void kernel_launch(void* const* d_in, const int* in_sizes, int n_in, void* d_out, int out_size, void* d_ws, size_t ws_size, hipStream_t stream) {
    static int grid = 0;
    if (grid == 0) {
        if (n_in != 24 || out_size != T * D || ws_size < WS_END) { fprintf(stderr, "kernel_launch: unexpected shapes (n_in %d, out %d, ws %zu < %zu)\n", n_in, out_size, ws_size, (size_t)WS_END); grid = -1; return; }
        int dev = 0, cus = 0, per_cu = 0;
        if (hipGetDevice(&dev) != hipSuccess || hipDeviceGetAttribute(&cus, hipDeviceAttributeMultiprocessorCount, dev) != hipSuccess) { grid = -1; return; }
        if (hipFuncSetAttribute((const void*)mk_fwd, hipFuncAttributeMaxDynamicSharedMemorySize, LDS_BYTES) != hipSuccess) { fprintf(stderr, "kernel_launch: hipFuncSetAttribute failed\n"); grid = -1; return; }
        if (hipOccupancyMaxActiveBlocksPerMultiprocessor(&per_cu, (const void*)mk_fwd, NWAVES * 64, LDS_BYTES) != hipSuccess || per_cu < 1) fprintf(stderr, "kernel_launch: occupancy query says %d\n", per_cu);
        (void)hipGetLastError();
        grid = cus;
    }
    if (grid < 0) return;
    (void)hipMemsetAsync((char*)d_ws + WS_CTL, 0, CTL_BYTES, stream);
    Args a{};
    for (int i = 0; i < 24; ++i) a.in[i] = d_in[i];
    a.out = (float*)d_out; a.ws = (unsigned char*)d_ws;
#if MK_ONE_LAUNCH
    a.ph_lo = 0; a.ph_hi = NPH;
    hipLaunchKernelGGL(mk_fwd, dim3(grid), dim3(NWAVES * 64), LDS_BYTES, stream, a);
#else
    for (int p = 0; p < NPH; ++p) { a.ph_lo = p; a.ph_hi = p + 1; hipLaunchKernelGGL(mk_fwd, dim3(grid), dim3(NWAVES * 64), LDS_BYTES, stream, a); }
#endif
}
```

```cpp
#include <hip/hip_runtime.h>
#include <cstdio>
#include <cstdint>
#define MK_ONE_LAUNCH 1
namespace pg8 {
#define PG8_LAS __attribute__((address_space(3)))
typedef unsigned short bf16_t;
typedef short bf16x8 __attribute__((ext_vector_type(8)));
typedef float f32x4 __attribute__((ext_vector_type(4)));
typedef unsigned u32x4 __attribute__((ext_vector_type(4)));
constexpr int BM = 256, BK = 64, HALF = 128, HTB = HALF * BK * 2  , STAGE_BYTES = 8 * HTB, NXCD = 8, WGM = 8;

__host__ __device__ __forceinline__ int lds_byte(int r, int c) { const int st = (r >> 4) * 2 + (c >> 5), rr = r & 15, cc = c & 31, ob = rr * 64 + cc * 2; return st * 1024 + (ob ^ (((ob >> 9) & 1) << 5)); }
__host__ __device__ __forceinline__ void stage_rc(int b, int& R, int& C) { const int st = b / 1024, sb = b % 1024, swz = sb ^ (((sb >> 9) & 1) << 5); R = (st >> 1) * 16 + swz / 64; C = (st & 1) * 32 + (swz % 64) / 2; }
__host__ __device__ __forceinline__ int perm32(int rho) { const int n = rho >> 4, i = rho & 15; return 8 * (i >> 2) + 4 * n + (i & 3); }

struct Unit { int pm, pn; };
struct Gemm { const bf16_t* A; const bf16_t* Bt; int M, N, K; };

struct StaticOrder {
    int nM, nN, nwg, G, c;
    __host__ __device__ void init(int M, int N, int G_, int c_) { nM = M / BM; nN = N / BM; nwg = nM * nN; G = G_; c = c_; }
    __host__ __device__ bool next(int i, Unit& u) const {
        const long L = (long)i * G + c; if (L >= nwg) return false;
        int wgid = (int)L; { const int q = nwg / NXCD, r = nwg % NXCD, xcd = wgid % NXCD, off = wgid / NXCD; wgid = (xcd < r ? xcd * (q + 1) : r * (q + 1) + (xcd - r) * q) + off; }
        const int nig = WGM * nN, gid = wgid / nig, fm = gid * WGM, gsz = (nM - fm) < WGM ? (nM - fm) : WGM;
        u.pm = fm + ((wgid % nig) % gsz); u.pn = (wgid % nig) / gsz; return true;
    }
    __device__ __forceinline__ void a_ready(const Unit&) const {}
    __device__ __forceinline__ void done(const Unit&) const {}
};

__device__ __forceinline__ unsigned cvt_pk_bf16(float lo, float hi) { unsigned r; asm volatile("v_cvt_pk_bf16_f32 %0, %1, %2" : "=v"(r) : "v"(lo), "v"(hi)); return r; }
typedef float f32x2 __attribute__((ext_vector_type(2)));
__device__ __forceinline__ float fsilu(float v) { return v / (1.0f + __expf(-v)); }
__device__ __forceinline__ float fsigm(float v) { return 1.0f / (1.0f + __expf(-v)); }
__device__ __forceinline__ void st8bf(bf16_t* p, f32x4 v0, f32x4 v1) { u32x4 w; w.x = cvt_pk_bf16(v0[0], v0[1]); w.y = cvt_pk_bf16(v0[2], v0[3]); w.z = cvt_pk_bf16(v1[0], v1[1]); w.w = cvt_pk_bf16(v1[2], v1[3]); *(u32x4*)p = w; }
__device__ __forceinline__ bf16_t f2bf1(float f) { unsigned u = __builtin_bit_cast(unsigned, f); return (bf16_t)((u + 0x7fffu + ((u >> 16) & 1u)) >> 16); }

struct EpiIn {
    static constexpr bool PERM = true, AFTER_DRAIN = false;
    bf16_t *RQ, *RK, *RVT, *RG, *BQKV, *BZ, *CQ, *CK, *CVT, *GATES; float* BBA;
    __device__ __forceinline__ void operator()(const f32x4 (&acc)[2][2][4][2], const Unit& u, int wr, int wc, int fr, int fq) const {
        const int pn = u.pn, b = u.pm >> 3;
        const int rowt = u.pm * BM + wr * 64 + fr;
        const int cin = wc * 32 + 8 * fq;
        if (pn < 8 || (pn >= 32 && pn < 40)) {
            auto heads = [&](bf16_t* base, int hb, float sc) __attribute__((always_inline)) {
#pragma unroll
                for (int ai = 0; ai < 2; ++ai)
#pragma unroll
                    for (int m = 0; m < 4; ++m) { const int s = (rowt + ai * HALF + m * 16) - b * 2048;
#pragma unroll
                        for (int bj = 0; bj < 2; ++bj) st8bf(base + ((size_t)((b * 8 + hb + bj) * 2048 + s)) * 128 + cin, acc[ai][bj][m][0] * sc, acc[ai][bj][m][1] * sc); } };
            if (pn < 4) heads(RQ, pn * 2, 1.f); else if (pn < 8) heads(RK, (pn - 4) * 2, 0.08838834764831845f);
            else if (pn < 36) heads(CQ, (pn - 32) * 2, 1.f); else heads(CK, (pn - 36) * 2, 1.f);
        } else if ((pn >= 40 && pn < 44) || (pn >= 8 && pn < 12)) {
            const bool isr = pn < 12; const int h = isr ? pn - 8 : pn - 40; bf16_t* CVT = isr ? RVT : this->CVT;
#pragma unroll
            for (int ai = 0; ai < 2; ++ai)
#pragma unroll
                for (int m = 0; m < 4; ++m) { const int s = (rowt + ai * HALF + m * 16) - b * 2048;
#pragma unroll
                    for (int bj = 0; bj < 2; ++bj)
#pragma unroll
                        for (int n = 0; n < 2; ++n)
#pragma unroll
                            for (int e = 0; e < 4; ++e) CVT[((size_t)((b * 4 + h) * 256 + bj * HALF + cin + 4 * n + e)) * 2048 + s] = f2bf1(acc[ai][bj][m][n][e]); }
        } else if (pn == 68) {
            if (wc == 0 && fq < 2) {
#pragma unroll
                for (int ai = 0; ai < 2; ++ai)
#pragma unroll
                    for (int m = 0; m < 4; ++m) { float* p = BBA + (size_t)(rowt + ai * HALF + m * 16) * 16 + 8 * fq; *(f32x4*)p = acc[ai][0][m][0]; *(f32x4*)(p + 4) = acc[ai][0][m][1]; }
            }
        } else {
            auto rows = [&](bf16_t* base, int ldc, int c0, int act) __attribute__((always_inline)) {
#pragma unroll
                for (int ai = 0; ai < 2; ++ai)
#pragma unroll
                    for (int m = 0; m < 4; ++m) { bf16_t* rowp = base + (size_t)(rowt + ai * HALF + m * 16) * ldc + c0 + cin;
#pragma unroll
                        for (int bj = 0; bj < 2; ++bj) { f32x4 v0 = acc[ai][bj][m][0], v1 = acc[ai][bj][m][1];
                            if (act == 1) {
#pragma unroll
                                for (int e = 0; e < 4; ++e) { v0[e] = fsilu(v0[e]); v1[e] = fsilu(v1[e]); } }
                            else if (act == 2) {
#pragma unroll
                                for (int e = 0; e < 4; ++e) { v0[e] = fsigm(v0[e]); v1[e] = fsigm(v1[e]); } }
                            st8bf(rowp + bj * HALF, v0, v1); } } };
            if (pn < 16) rows(RG, 1024, (pn - 12) * 256, 1); else if (pn < 28) rows(BQKV, 3072, (pn - 16) * 256, 0);
            else if (pn < 32) rows(BZ, 1024, (pn - 28) * 256, 1); else rows(GATES, 6144, (pn - 44) * 256, 2);
        }
    }
};

struct EpiHeads {
    static constexpr bool PERM = true, AFTER_DRAIN = false;
    bf16_t* O; bf16_t* VT; int NH, rpb_shift  , vt_from_pn;
    __device__ __forceinline__ void operator()(const f32x4 (&acc)[2][2][4][2], const Unit& u, int wr, int wc, int fr, int fq) const {
        const int rowt = u.pm * BM + wr * 64 + fr, cin = wc * 32 + 8 * fq, rpb = 1 << rpb_shift;
        if (u.pn < vt_from_pn) {
#pragma unroll
            for (int ai = 0; ai < 2; ++ai)
#pragma unroll
                for (int m = 0; m < 4; ++m) { const int row = rowt + ai * HALF + m * 16, b = row >> rpb_shift, s = row & (rpb - 1);
#pragma unroll
                    for (int bj = 0; bj < 2; ++bj) st8bf(O + ((size_t)((b * NH + u.pn * 2 + bj) * rpb + s)) * 128 + cin, acc[ai][bj][m][0], acc[ai][bj][m][1]); }
        } else {
            const int hb = (u.pn - vt_from_pn) * 2;
#pragma unroll
            for (int ai = 0; ai < 2; ++ai)
#pragma unroll
                for (int m = 0; m < 4; ++m) { const int row = rowt + ai * HALF + m * 16, b = row >> rpb_shift, s = row & (rpb - 1);
#pragma unroll
                    for (int bj = 0; bj < 2; ++bj)
#pragma unroll
                        for (int n = 0; n < 2; ++n)
#pragma unroll
                            for (int e = 0; e < 4; ++e) VT[((size_t)((b * NH + hb + bj) * 128 + cin + 4 * n + e)) * rpb + s] = f2bf1(acc[ai][bj][m][n][e]); }
        }
    }
};

struct EpiResid {
    static constexpr bool PERM = false, AFTER_DRAIN = false;
    const float* in; float* out; int ldc;
    __device__ __forceinline__ void operator()(const f32x4 (&acc)[2][2][4][2], const Unit& u, int wr, int wc, int fr, int fq) const {
        const int row0 = u.pm * BM + wr * 64 + fr, col0 = u.pn * BM + wc * 32 + 4 * fq;
#pragma unroll
        for (int ai = 0; ai < 2; ++ai)
#pragma unroll
            for (int m = 0; m < 4; ++m) { const size_t off = (size_t)(row0 + ai * HALF + m * 16) * ldc + col0;
#pragma unroll
                for (int bj = 0; bj < 2; ++bj)
#pragma unroll
                    for (int n = 0; n < 2; ++n) { const f32x4 x = *(const f32x4*)(in + off + bj * HALF + n * 16); *(f32x4*)(out + off + bj * HALF + n * 16) = x + acc[ai][bj][m][n]; } }
    }
};

struct EpiBranch {
    static constexpr bool PERM = false, AFTER_DRAIN = false;
    float* M; bf16_t* OUT; const bf16_t* GATES; int seg;
    __device__ __forceinline__ void operator()(const f32x4 (&acc)[2][2][4][2], const Unit& u, int wr, int wc, int fr, int fq) const {
        typedef unsigned u32x2 __attribute__((ext_vector_type(2)));
        const int row0 = u.pm * BM + wr * 64 + fr, col0 = u.pn * BM + wc * 32 + 4 * fq;
#pragma unroll
        for (int ai = 0; ai < 2; ++ai)
#pragma unroll
            for (int m = 0; m < 4; ++m) { const int row = row0 + ai * HALF + m * 16;
#pragma unroll
                for (int bj = 0; bj < 2; ++bj)
#pragma unroll
                    for (int n = 0; n < 2; ++n) { const int col = col0 + bj * HALF + n * 16; const size_t off = (size_t)row * 2048 + col;
                        const u32x2 gw = *(const u32x2*)(GATES + (size_t)row * 6144 + seg * 2048 + col);
                        f32x4 g; g[0] = __uint_as_float(gw.x << 16); g[1] = __uint_as_float(gw.x & 0xffff0000u); g[2] = __uint_as_float(gw.y << 16); g[3] = __uint_as_float(gw.y & 0xffff0000u);
                        f32x4 v = g * acc[ai][bj][m][n];
                        if (seg > 0) v = v + *(const f32x4*)(M + off);
                        if (seg < 2) *(f32x4*)(M + off) = v;
                        else { u32x2 w; w.x = cvt_pk_bf16(v[0], v[1]); w.y = cvt_pk_bf16(v[2], v[3]); *(u32x2*)(OUT + off) = w; } } }
    }
};

struct EpiSwiglu {
    static constexpr bool PERM = true, AFTER_DRAIN = false;
    bf16_t* O; int ldc, npn;
    __device__ __forceinline__ void operator()(const f32x4 (&acc)[2][2][4][2], const Unit& u, int wr, int wc, int fr, int fq) const {
        const int row0 = u.pm * BM + wr * 64 + fr, col0 = (u.pn % npn) * HALF + wc * 32 + 8 * fq;
#pragma unroll
        for (int ai = 0; ai < 2; ++ai)
#pragma unroll
            for (int m = 0; m < 4; ++m) { f32x4 v0, v1;
#pragma unroll
                for (int e = 0; e < 4; ++e) { v0[e] = fsilu(acc[ai][0][m][0][e]) * acc[ai][1][m][0][e]; v1[e] = fsilu(acc[ai][0][m][1][e]) * acc[ai][1][m][1][e]; }
                st8bf(O + (size_t)(row0 + ai * HALF + m * 16) * ldc + col0, v0, v1); }
    }
};

struct EpiStoreF32 {
    static constexpr bool PERM = false, AFTER_DRAIN = false;
    float* Y; int ldc, npn;
    __device__ __forceinline__ void operator()(const f32x4 (&acc)[2][2][4][2], const Unit& u, int wr, int wc, int fr, int fq) const {
        const int row0 = u.pm * BM + wr * 64 + fr, col0 = (u.pn % npn) * BM + wc * 32 + 4 * fq;
#pragma unroll
        for (int ai = 0; ai < 2; ++ai)
#pragma unroll
            for (int m = 0; m < 4; ++m) { float* rowp = Y + (size_t)(row0 + ai * HALF + m * 16) * ldc + col0;
#pragma unroll
                for (int bj = 0; bj < 2; ++bj)
#pragma unroll
                    for (int n = 0; n < 2; ++n) *(f32x4*)(rowp + bj * HALF + n * 16) = acc[ai][bj][m][n]; }
    }
};

struct MoeOrder {
    const PG8_LAS int* T; int npn, G, c;
    __device__ __forceinline__ bool next(int i, Unit& u) const {
        const int total = T[25]; const long L = (long)i * G + c; if (L >= total) return false;
        int wgid = (int)L; { const int q = total / NXCD, r = total % NXCD, xcd = wgid % NXCD, off = wgid / NXCD; wgid = (xcd < r ? xcd * (q + 1) : r * (q + 1) + (xcd - r) * q) + off; }
        int e = 0;
#pragma unroll
        for (int k = 1; k < 8; ++k) if (wgid >= T[16 + k]) e = k;
        const int loc = wgid - T[16 + e], ne = T[e];
        u.pm = T[8 + e] + loc % ne; u.pn = e * npn + loc / ne; return true;
    }
    __device__ __forceinline__ void a_ready(const Unit&) const {}
    __device__ __forceinline__ void done(const Unit&) const {}
};
template <class Epi, class Sched, bool ALIGN_EPI = false, bool SP2 = false>
__device__ __forceinline__ void gemm_phase(PG8_LAS unsigned char* lds, const Gemm g, const Sched& S, const Epi& E) {
    int tid_ = threadIdx.x; asm volatile("" : "+v"(tid_)); const int tid = tid_, wid = __builtin_amdgcn_readfirstlane(tid >> 6), lane = tid & 63, wr = wid >> 2, wc = wid & 3, fr = lane & 15, fq = lane >> 4;
    const int K = g.K, nt = K / BK;
    unsigned voffA[2], voffB[2];
#pragma unroll
    for (int i = 0; i < 2; ++i) { int R, C; stage_rc(tid * 16 + i * 8192, R, C); const int Rb = Epi::PERM ? ((R & ~31) + perm32(R & 31)) : R;
        voffA[i] = (unsigned)(R * K + C) * 2u; voffB[i] = (unsigned)(Rb * K + C) * 2u; }
    const size_t kstep = (size_t)(BK * 2);
    const size_t hstep = (size_t)HALF * K * 2;
    const size_t tstep = 2 * hstep;
    const unsigned ldsw = (unsigned)wid * 1024u;
    const int aoff = lds_byte(wr * 64 + fr, fq * 8), boff = lds_byte(wc * 32 + fr, fq * 8);
#define PG8_SA(b, h) (((b) * 2 + (h)) * HTB)
#define PG8_SB(b, h) ((4 + (b) * 2 + (h)) * HTB)
#define PG8_STAGE(bufoff, gbase, voff) do { _Pragma("unroll") for (int _i = 0; _i < 2; ++_i) \
        __builtin_amdgcn_global_load_lds((const unsigned*)((const char*)(gbase) + (voff)[_i]), (PG8_LAS unsigned*)(lds + (bufoff) + ldsw + _i * 8192), 16, 0, 0); } while (0)
#define PG8_LDA(dst, b, h) do { _Pragma("unroll") for (int m = 0; m < 4; ++m) _Pragma("unroll") for (int k = 0; k < 2; ++k) dst[m][k] = *(const PG8_LAS bf16x8*)(lds + PG8_SA(b, h) + aoff + m * 2048 + k * 1024); } while (0)
#define PG8_LDB(dst, b, h) do { _Pragma("unroll") for (int n = 0; n < 2; ++n) _Pragma("unroll") for (int k = 0; k < 2; ++k) dst[n][k] = *(const PG8_LAS bf16x8*)(lds + PG8_SB(b, h) + boff + n * 2048 + k * 1024); } while (0)
#define PG8_MMA(ai, bj, At, Bt) do { __builtin_amdgcn_s_setprio(1); _Pragma("unroll") for (int m = 0; m < 4; ++m) _Pragma("unroll") for (int n = 0; n < 2; ++n) _Pragma("unroll") for (int k = 0; k < 2; ++k) \
        acc[ai][bj][m][n] = __builtin_amdgcn_mfma_f32_16x16x32_bf16(Bt[n][k], At[m][k], acc[ai][bj][m][n], 0, 0, 0); __builtin_amdgcn_s_setprio(0); } while (0)
#define PG8_WAIT_V(n) asm volatile("s_waitcnt vmcnt(" #n ")" ::: "memory")
#define PG8_WAIT_L(n) asm volatile("s_waitcnt lgkmcnt(" #n ")" ::: "memory")
#define PG8_BAR __builtin_amdgcn_s_barrier()
#define PG8_SCHED __builtin_amdgcn_sched_barrier(0)
    Unit cur, nxt; int ui = 0;
    if (!S.next(0, cur)) return;
    f32x4 acc[2][2][4][2];
#pragma unroll
    for (int a = 0; a < 2; ++a)
#pragma unroll
        for (int b = 0; b < 2; ++b)
#pragma unroll
            for (int m = 0; m < 4; ++m)
#pragma unroll
                for (int n = 0; n < 2; ++n) acc[a][b][m][n] = (f32x4){0.f, 0.f, 0.f, 0.f};
    bf16x8 At[4][2], B0[2][2], B1[2][2];
    const char* cA = (const char*)g.A + (size_t)cur.pm * tstep; const char* cB = (const char*)g.Bt + (size_t)cur.pn * tstep;
    S.a_ready(cur);
    if constexpr (SP2) {
        PG8_STAGE(PG8_SB(0, 0), cB, voffB); PG8_STAGE(PG8_SB(0, 1), cB + hstep, voffB); PG8_STAGE(PG8_SA(0, 0), cA, voffA); PG8_STAGE(PG8_SA(0, 1), cA + hstep, voffA);
        if (wr == 1) PG8_BAR;
        PG8_WAIT_V(2); PG8_BAR;
        PG8_STAGE(PG8_SB(1, 0), cB + kstep, voffB); PG8_STAGE(PG8_SA(1, 0), cA + kstep, voffA); PG8_STAGE(PG8_SB(1, 1), cB + hstep + kstep, voffB);
        PG8_WAIT_V(6); PG8_BAR;
    } else {
        PG8_STAGE(PG8_SB(0, 0), cB, voffB); PG8_STAGE(PG8_SA(0, 0), cA, voffA); PG8_STAGE(PG8_SB(0, 1), cB + hstep, voffB); PG8_STAGE(PG8_SA(0, 1), cA + hstep, voffA);
        if (wr == 1) PG8_BAR;
        PG8_WAIT_V(4); PG8_BAR;
        PG8_STAGE(PG8_SB(1, 0), cB + kstep, voffB); PG8_STAGE(PG8_SA(1, 0), cA + kstep, voffA); PG8_STAGE(PG8_SB(1, 1), cB + hstep + kstep, voffB);
        PG8_WAIT_V(6); PG8_BAR;
    }
    for (;;) {
        const bool has_next = S.next(ui + 1, nxt);
        const char* nA = has_next ? (const char*)g.A + (size_t)nxt.pm * tstep : cA; const char* nB = has_next ? (const char*)g.Bt + (size_t)nxt.pn * tstep : cB;
        for (int t = 0; t < nt; t += 2) {
            const bool last = (t == nt - 2);
            const char* a1 = cA + (size_t)(t + 1) * kstep;
            const char* a2 = last ? nA : cA + (size_t)(t + 2) * kstep; const char* b2 = last ? nB : cB + (size_t)(t + 2) * kstep;
            const char* a3 = a2 + kstep; const char* b3 = b2 + kstep;
            if (last && has_next) S.a_ready(nxt);
            if constexpr (SP2) {
            PG8_LDB(B0, 0, 0); PG8_LDB(B1, 0, 1); PG8_SCHED; PG8_LDA(At, 0, 0); PG8_STAGE(PG8_SA(1, 1), a1 + hstep, voffA);
            PG8_WAIT_V(8); PG8_WAIT_L(0); PG8_BAR; PG8_MMA(0, 0, At, B0); PG8_MMA(0, 1, At, B1); PG8_BAR; PG8_SCHED;
            PG8_LDA(At, 0, 1); PG8_STAGE(PG8_SB(0, 0), b2, voffB); PG8_STAGE(PG8_SB(0, 1), b2 + hstep, voffB); PG8_STAGE(PG8_SA(0, 0), a2, voffA);
            PG8_WAIT_V(8); PG8_WAIT_L(0); PG8_BAR; PG8_MMA(1, 0, At, B0); PG8_MMA(1, 1, At, B1); PG8_BAR; PG8_SCHED;
            PG8_LDB(B0, 1, 0); PG8_LDB(B1, 1, 1); PG8_SCHED; PG8_LDA(At, 1, 0); PG8_STAGE(PG8_SA(0, 1), a2 + hstep, voffA);
            PG8_WAIT_V(8); PG8_WAIT_L(0); PG8_BAR; PG8_MMA(0, 0, At, B0); PG8_MMA(0, 1, At, B1); PG8_BAR; PG8_SCHED;
            PG8_LDA(At, 1, 1); PG8_STAGE(PG8_SB(1, 0), b3, voffB); PG8_STAGE(PG8_SB(1, 1), b3 + hstep, voffB); PG8_STAGE(PG8_SA(1, 0), a3, voffA);
            PG8_WAIT_V(8); PG8_WAIT_L(0); PG8_BAR; PG8_MMA(1, 0, At, B0); PG8_MMA(1, 1, At, B1); PG8_BAR; PG8_SCHED;
            } else {
            PG8_LDB(B0, 0, 0); PG8_SCHED; PG8_LDA(At, 0, 0); PG8_STAGE(PG8_SA(1, 1), a1 + hstep, voffA);
            PG8_WAIT_L(8); PG8_BAR; PG8_WAIT_L(0); PG8_MMA(0, 0, At, B0); PG8_BAR; PG8_SCHED;
            PG8_LDB(B1, 0, 1); PG8_STAGE(PG8_SB(0, 0), b2, voffB);
            PG8_BAR; PG8_WAIT_L(0); PG8_MMA(0, 1, At, B1); PG8_BAR;
            PG8_LDA(At, 0, 1); PG8_STAGE(PG8_SA(0, 0), a2, voffA);
            PG8_BAR; PG8_WAIT_L(0); PG8_MMA(1, 0, At, B0); PG8_BAR; PG8_SCHED;
            PG8_STAGE(PG8_SB(0, 1), b2 + hstep, voffB);
            PG8_WAIT_V(6); PG8_BAR; PG8_MMA(1, 1, At, B1); PG8_BAR;
            PG8_LDB(B0, 1, 0); PG8_SCHED; PG8_LDA(At, 1, 0); PG8_STAGE(PG8_SA(0, 1), a2 + hstep, voffA);
            PG8_WAIT_L(8); PG8_BAR; PG8_WAIT_L(0); PG8_MMA(0, 0, At, B0); PG8_BAR; PG8_SCHED;
            PG8_LDB(B1, 1, 1); PG8_STAGE(PG8_SB(1, 0), b3, voffB);
            PG8_BAR; PG8_WAIT_L(0); PG8_MMA(0, 1, At, B1); PG8_BAR;
            PG8_LDA(At, 1, 1); PG8_STAGE(PG8_SA(1, 0), a3, voffA);
            PG8_BAR; PG8_WAIT_L(0); PG8_MMA(1, 0, At, B0); PG8_BAR; PG8_SCHED;
            PG8_STAGE(PG8_SB(1, 1), b3 + hstep, voffB);
            PG8_WAIT_V(6); PG8_BAR; PG8_MMA(1, 1, At, B1); PG8_BAR;
            }
        }
        if constexpr (ALIGN_EPI) { if (wr == 0) PG8_BAR; }
        if constexpr (!Epi::AFTER_DRAIN) { E(acc, cur, wr, wc, fr, fq); S.done(cur); }
        if (!has_next) break;
#pragma unroll
        for (int a = 0; a < 2; ++a)
#pragma unroll
            for (int b = 0; b < 2; ++b)
#pragma unroll
                for (int m = 0; m < 4; ++m)
#pragma unroll
                    for (int n = 0; n < 2; ++n) acc[a][b][m][n] = (f32x4){0.f, 0.f, 0.f, 0.f};
        cur = nxt; cA = nA; cB = nB; ++ui;
        if constexpr (ALIGN_EPI) { if (wr == 1) PG8_BAR; }
    }
    PG8_WAIT_V(0);
    if constexpr (!ALIGN_EPI) { if (wr == 0) PG8_BAR; }
    PG8_BAR;
    if constexpr (Epi::AFTER_DRAIN) { E.fused(acc, cur, wr, wc, fr, fq, lds, wid, lane); S.done(cur); }
#undef PG8_SA
#undef PG8_SB
#undef PG8_STAGE
#undef PG8_LDA
#undef PG8_LDB
#undef PG8_MMA
#undef PG8_WAIT_V
#undef PG8_WAIT_L
#undef PG8_BAR
#undef PG8_SCHED
}
}
#ifndef MK_ONE_LAUNCH
#define MK_ONE_LAUNCH 0
#endif
constexpr int NWAVES = 8;
constexpr int NB = 4, SEQ = 2048, T = NB * SEQ, D = 2048, MEML = 256, MEMR = NB * MEML;
constexpr int NINP = 17664;
constexpr int DFF = 5632, EFF = 7168, NEXP = 8, MAXSLOT = 18432;
constexpr float EPS = 1e-6f;
constexpr int NPL = 15, NPH = 2 + 2 * NPL;

constexpr size_t MiB = 1u << 20;
constexpr size_t WS_CTL = 0, CTL_BYTES = 1 * MiB;
constexpr size_t WS_WIN = WS_CTL + CTL_BYTES;
constexpr size_t WS_WBR = WS_WIN + 2 * 69 * MiB;
constexpr size_t WS_WOUT = WS_WBR + 2 * 12 * MiB;
constexpr size_t WS_WQ = WS_WOUT + 2 * 8 * MiB;
constexpr size_t WS_WKV = WS_WQ + 2 * 2 * MiB;
constexpr size_t WS_WO = WS_WKV + 2 * 4 * MiB;
constexpr size_t WS_WGU = WS_WO + 2 * 2 * MiB;
constexpr size_t WS_WDN = WS_WGU + 44 * MiB;
constexpr size_t WS_WEGU = WS_WDN + 22 * MiB;
constexpr size_t WS_WEDN = WS_WEGU + 448 * MiB;
constexpr size_t WS_XRES = WS_WEDN + 224 * MiB;
constexpr size_t WS_H = WS_XRES + 64 * MiB;
constexpr size_t WS_RQ = WS_H + 32 * MiB, WS_RK = WS_RQ + 16 * MiB, WS_RV = WS_RK + 16 * MiB, WS_RG = WS_RV + 16 * MiB;
constexpr size_t WS_BQKV = WS_RG + 16 * MiB;
constexpr size_t WS_BZ = WS_BQKV + 48 * MiB;
constexpr size_t WS_BBA = WS_BZ + 16 * MiB;
constexpr size_t WS_CQ = WS_BBA + 1 * MiB, WS_CK = WS_CQ + 16 * MiB, WS_CVT = WS_CK + 16 * MiB;
constexpr size_t WS_GATES = WS_CVT + 16 * MiB;
constexpr size_t WS_GQ = WS_GATES + 96 * MiB, WS_GK = WS_GQ + 16 * MiB, WS_GV = WS_GK + 16 * MiB;
constexpr size_t WS_GG = WS_GV + 16 * MiB, WS_GB = WS_GG + 1 * MiB;
constexpr size_t WS_OA = WS_GB + 1 * MiB, WS_OB = WS_OA + 32 * MiB;
constexpr size_t WS_O12 = WS_OB + 32 * MiB;
constexpr size_t WS_OCAT = WS_O12 + 64 * MiB;
constexpr size_t WS_MERGE = WS_OCAT + 48 * MiB;
constexpr size_t WS_MERGEB = WS_MERGE + 64 * MiB;
constexpr size_t WS_MEMN = WS_MERGEB + 32 * MiB;
constexpr size_t WS_KX = WS_MEMN + 8 * MiB;
constexpr size_t WS_VXT = WS_KX + 2 * MiB;
constexpr size_t WS_QX = WS_VXT + 2 * MiB;
constexpr size_t WS_OX = WS_QX + 8 * MiB;
constexpr size_t WS_ACT = WS_OX + 8 * MiB;
constexpr size_t WS_HG = WS_ACT + 88 * MiB;
constexpr size_t WS_EACT = WS_HG + 72 * MiB;
constexpr size_t WS_Y = WS_EACT + 252 * MiB;
constexpr size_t WS_ROUTE = WS_Y + 144 * MiB;
constexpr size_t WS_GCH = WS_ROUTE + 1 * MiB;
constexpr size_t WS_GL = WS_GCH + 88 * MiB;
constexpr size_t WS_END = WS_GL + 1 * MiB;
constexpr int CW_CNT = 64;
constexpr int CW_BAR = 4096;

constexpr int RING_BYTES = 131072, MISC_OFF = RING_BYTES + 320, LDS_BYTES = 147456;

#define GAS __attribute__((address_space(1)))
#define LAS __attribute__((address_space(3)))
#define DI __device__ __forceinline__
typedef unsigned short bf16;
typedef unsigned v4u __attribute__((ext_vector_type(4)));
typedef unsigned v2u __attribute__((ext_vector_type(2)));
typedef float f32x4 __attribute__((ext_vector_type(4)));
typedef short bf16x8 __attribute__((ext_vector_type(8)));
typedef short s16x4 __attribute__((ext_vector_type(4)));
DI float bf2f(unsigned v) { return __uint_as_float(v << 16); }
DI unsigned f2bf(float f) { unsigned u = __builtin_bit_cast(unsigned, f); return (u + 0x7fffu + ((u >> 16) & 1u)) >> 16; }
DI unsigned pk2(float lo, float hi) { return f2bf(lo) | (f2bf(hi) << 16); }
DI float wave_sum(float v) {
#pragma unroll
    for (int o = 1; o < 64; o <<= 1) v += __shfl_xor(v, o);
    return v;
}

#define XB_TMO      128
#define XB_XCNT(j)  (256  + 64 * (j))
#define XB_XSUB(j)  (1280 + 64 * (j))
#define XB_XGEN(j)  (2304 + 64 * (j))
#define XB_TOP      3328
#define XB_TOPGEN   3392
#define XCD_BAR_WORDS 3456
#define XB_SPIN_CAP (1u << 18)

__device__ __forceinline__ unsigned xb_ld(unsigned* p)              { return __hip_atomic_load(p, __ATOMIC_RELAXED, __HIP_MEMORY_SCOPE_AGENT); }
__device__ __forceinline__ unsigned xb_add(unsigned* p, unsigned v) { return __hip_atomic_fetch_add(p, v, __ATOMIC_RELAXED, __HIP_MEMORY_SCOPE_AGENT); }
__device__ __forceinline__ unsigned xb_xcc_id() { return (unsigned)__builtin_amdgcn_s_getreg((3 << 11) | 20) & 0xFu; }
#define XB_SPIN(cond, bar) do { unsigned _sp = 0; while (cond) { __builtin_amdgcn_s_sleep(1); \
    if ((++_sp & 255u) == 0u) { if (xb_ld(&(bar)[XB_TMO])) break; if (_sp > XB_SPIN_CAP) { atomicAdd(&(bar)[XB_TMO], 1u); break; } } } } while (0)

struct XcdBarrier {
    unsigned* bar; unsigned x;
    volatile LAS unsigned* st;
};

__device__ __forceinline__ XcdBarrier xcd_barrier_post(unsigned* bar, volatile LAS unsigned* st) {
    XcdBarrier b; b.bar = bar; b.x = xb_xcc_id(); b.st = st;
    if (threadIdx.x == 0) (void)xb_add(&bar[XB_XCNT(b.x)], 1u);
    return b;
}
__device__ __forceinline__ void xcd_barrier_complete(unsigned* bar, unsigned x, unsigned& nloc, unsigned& nx) {
    const unsigned G = gridDim.x * gridDim.y * gridDim.z;
    unsigned sum, cnt, mine, sp = 0u;
    for (;;) {
        sum = 0u; cnt = 0u; mine = 0u;
#pragma unroll
        for (unsigned j = 0; j < 16; ++j) { const unsigned c = xb_ld(&bar[XB_XCNT(j)]); sum += c; cnt += (c > 0u) ? 1u : 0u; mine = (j == x) ? c : mine; }
        if (sum == G) break;
        __builtin_amdgcn_s_sleep(1);
        if ((++sp & 255u) == 0u) { if (xb_ld(&bar[XB_TMO])) break; if (sp > XB_SPIN_CAP) { atomicAdd(&bar[XB_TMO], 1u); break; } }
    }
    nloc = mine > 0u ? mine : 1u; nx = cnt > 0u ? cnt : 1u;
}

__device__ __forceinline__ void xcd_barrier(const XcdBarrier& b) {
    asm volatile("s_waitcnt vmcnt(0)" ::: "memory");
    __syncthreads();
    if (threadIdx.x == 0) {
        unsigned* bar = b.bar;
        __builtin_amdgcn_s_waitcnt(0);
        unsigned nloc = b.st[0], nx = b.st[1];
        if (nloc == 0u) { xcd_barrier_complete(bar, b.x, nloc, nx); b.st[0] = nloc; b.st[1] = nx; }
        const unsigned old = xb_add(&bar[XB_XSUB(b.x)], 1u);
        const unsigned gen = old / nloc;
        if (old + 1u == (gen + 1u) * nloc) {
            __builtin_amdgcn_fence(__ATOMIC_RELEASE, "agent");
            asm volatile("s_waitcnt vmcnt(0)" ::: "memory");
            const unsigned og = xb_add(&bar[XB_TOP], 1u);
            const unsigned tg = og / nx;
            if (og + 1u == (tg + 1u) * nx) xb_add(&bar[XB_TOPGEN], 1u);
            else XB_SPIN(xb_ld(&bar[XB_TOPGEN]) == tg, bar);
            __builtin_amdgcn_fence(__ATOMIC_ACQUIRE, "agent");
            xb_add(&bar[XB_XGEN(b.x)], 1u);
            asm volatile("s_waitcnt vmcnt(0)" ::: "memory");
        } else {
            XB_SPIN(xb_ld(&bar[XB_XGEN(b.x)]) == gen, bar);
            __builtin_amdgcn_fence(__ATOMIC_ACQUIRE, "agent");
            asm volatile("s_waitcnt vmcnt(0)" ::: "memory");
        }
    }
    __syncthreads();
}

struct Args { const void* in[24]; float* out; unsigned char* ws; int ph_lo, ph_hi; };

struct Frame {
    LAS unsigned char* lds;
    int tid, lane, wave, G, vcu, gw, NGW;
};

DI void conv_job(const Frame& F, const float* W, int K, int Nsrc, bf16* WT, int Ndst, int mode, int Fgu) {
    LAS unsigned* scr = (LAS unsigned*)(F.lds + F.wave * 8704);
    const int nkb = K / 64, nnb = Ndst / 64, items = nkb * nnb, lane = F.lane;
    for (int it = F.gw; it < items; it += F.NGW) {
        const int nb = it / nkb, kb = it % nkb, k0 = kb * 64, n0 = nb * 64, n = n0 + lane;
        int ns;
        if (mode == 0) ns = n;
        else if (mode == 1) ns = n < 8192 ? n : (n < 17408 ? n + 16 : (n < 17424 ? n - 17408 + 8192 : -1));
        else { const int pn = n >> 8, half = (n >> 7) & 1, j = n & 127; ns = half * Fgu + 128 * pn + j; }
        const float* src = W + (size_t)k0 * Nsrc + (ns < 0 ? 0 : ns);
#pragma unroll 8
        for (int i = 0; i < 32; ++i) { float a = src[(size_t)(2 * i) * Nsrc], b = src[(size_t)(2 * i + 1) * Nsrc]; if (ns < 0) { a = 0.f; b = 0.f; } scr[lane * 33 + i] = pk2(a, b); }
        asm volatile("s_waitcnt lgkmcnt(0)" ::: "memory");
#pragma unroll
        for (int j = 0; j < 8; ++j) { const int nn = (lane >> 3) + 8 * j, kq = lane & 7; v4u o; const LAS unsigned* s = scr + nn * 33 + 4 * kq; o.x = s[0]; o.y = s[1]; o.z = s[2]; o.w = s[3];
            *(v4u*)(WT + (size_t)(n0 + nn) * K + k0 + 8 * kq) = o; }
        asm volatile("s_waitcnt lgkmcnt(0)" ::: "memory");
    }
}

DI void rms_row(const float* xrow, const float* w, bf16* orow, int lane) {
    f32x4 v[8]; float ss = 0.f;
#pragma unroll
    for (int j = 0; j < 8; ++j) { v[j] = *(const f32x4*)(xrow + 4 * (lane + 64 * j)); ss += (v[j][0] * v[j][0] + v[j][1] * v[j][1]) + (v[j][2] * v[j][2] + v[j][3] * v[j][3]); }
    const float rstd = rsqrtf(wave_sum(ss) * (1.f / D) + EPS);
#pragma unroll
    for (int j = 0; j < 8; ++j) { const f32x4 ww = *(const f32x4*)(w + 4 * (lane + 64 * j)); v2u o; o.x = pk2(v[j][0] * rstd * ww[0], v[j][1] * rstd * ww[1]); o.y = pk2(v[j][2] * rstd * ww[2], v[j][3] * rstd * ww[3]);
        *(v2u*)(orow + 4 * (lane + 64 * j)) = o; }
}

template <bool GDN>
DI void seq_mixer(const Frame& F, int bh, const bf16* Q, const bf16* K, const bf16* V, const float* Gg, const float* Gb, float* OUT, float gamma) {
    LAS float* qs = (LAS float*)F.lds; LAS float* ks = qs + 32 * 128; LAS float* vs = ks + 32 * 128; LAS float* red = vs + 32 * 128; LAS float* gs = red + 2 * 4 * 128; LAS float* bs = gs + 32;
    const int tid = F.tid, v = tid & 127, kg = tid >> 7, b = bh >> 3, h = bh & 7;
    const size_t hb = (size_t)bh * SEQ * 128;
    float Sr[32];
#pragma unroll
    for (int i = 0; i < 32; ++i) Sr[i] = 0.f;
    for (int c0 = 0; c0 < SEQ; c0 += 32) {
        __syncthreads();
#pragma unroll
        for (int j = 0; j < 4; ++j) { const int idx = tid + 512 * j, tok = idx >> 6, d = (idx & 63) * 2; const size_t go = hb + (size_t)(c0 + tok) * 128 + d;
            const unsigned a = *(const unsigned*)(Q + go), bb = *(const unsigned*)(K + go), cc = *(const unsigned*)(V + go);
            qs[tok * 128 + d] = bf2f(a & 0xffffu); qs[tok * 128 + d + 1] = __uint_as_float(a & 0xffff0000u);
            ks[tok * 128 + d] = bf2f(bb & 0xffffu); ks[tok * 128 + d + 1] = __uint_as_float(bb & 0xffff0000u);
            vs[tok * 128 + d] = bf2f(cc & 0xffffu); vs[tok * 128 + d + 1] = __uint_as_float(cc & 0xffff0000u); }
        if (GDN && tid < 32) { gs[tid] = Gg[(size_t)bh * SEQ + c0 + tid]; bs[tid] = Gb[(size_t)bh * SEQ + c0 + tid]; }
        __syncthreads();
        for (int tt = 0; tt < 32; ++tt) {
            const LAS float* kt = ks + tt * 128 + kg * 32; const LAS float* qt = qs + tt * 128 + kg * 32;
            float po = 0.f;
            if (GDN) {
                const float a = __expf(gs[tt]); float p = 0.f;
#pragma unroll
                for (int i = 0; i < 32; ++i) { Sr[i] *= a; p += Sr[i] * kt[i]; }
                red[kg * 128 + v] = p; __syncthreads();
                const float kv = (red[v] + red[128 + v]) + (red[256 + v] + red[384 + v]);
                const float delta = bs[tt] * (vs[tt * 128 + v] - kv);
#pragma unroll
                for (int i = 0; i < 32; ++i) { Sr[i] += kt[i] * delta; po += Sr[i] * qt[i]; }
                red[512 + kg * 128 + v] = po; __syncthreads();
                if (kg == 0) OUT[((size_t)(b * SEQ + c0 + tt)) * 1024 + h * 128 + v] = (red[512 + v] + red[640 + v]) + (red[768 + v] + red[896 + v]);
            } else {
                const float vv = vs[tt * 128 + v]; LAS float* r = red + (tt & 1) * 512;
#pragma unroll
                for (int i = 0; i < 32; ++i) { Sr[i] = gamma * Sr[i] + kt[i] * vv; po += Sr[i] * qt[i]; }
                r[kg * 128 + v] = po; __syncthreads();
                if (kg == 0) OUT[((size_t)(b * SEQ + c0 + tt)) * 1024 + h * 128 + v] = (r[v] + r[128 + v]) + (r[256 + v] + r[384 + v]);
            }
        }
    }
    __syncthreads();
}

template <int DV, bool CAUSAL, bool OUT_BF16, bool DECAY>
DI void flash_item(const Frame& F, const bf16* Q, const bf16* Kh, const bf16* VT, int vpitch, int q0, int nkeys, float slope, float* OUTF, bf16* OUTB, int opitch) {
    constexpr int KP = 272, VP = 144;
    LAS unsigned char* Kl = F.lds; LAS unsigned char* Vl = F.lds + 64 * KP;
    int tid_ = F.tid; asm volatile("" : "+v"(tid_));
    const int tid = tid_, lane = tid & 63, w = F.wave, li = lane & 15, g = lane >> 4;
    const float SC = 0.08838834764831845f, L2E = 1.4426950408889634f;
    bf16x8 qf[4];
#pragma unroll
    for (int ks = 0; ks < 4; ++ks) qf[ks] = *(const bf16x8*)(Q + (size_t)(w * 16 + li) * 128 + ks * 32 + g * 8);
    f32x4 o[DV / 16];
#pragma unroll
    for (int c = 0; c < DV / 16; ++c) o[c] = (f32x4){0.f, 0.f, 0.f, 0.f};
    float m_run = -1e30f, l_run = 0.f;
    const int qpos = q0 + w * 16 + li;
    const int kend = CAUSAL ? (q0 + 128 < nkeys ? q0 + 128 : nkeys) : nkeys;
    constexpr int BUFB = 64 * KP + DV * VP;
    v4u kr[2], vr[DV / 64];
    __syncthreads();
#pragma unroll
    for (int i = 0; i < 2; ++i) { const int c = tid + 512 * i; kr[i] = *(const v4u*)(Kh + (size_t)(c >> 4) * 128 + (c & 15) * 8); }
#pragma unroll
    for (int i = 0; i < DV / 64; ++i) { const int c = tid + 512 * i; vr[i] = *(const v4u*)(VT + (size_t)(c >> 3) * vpitch + (c & 7) * 8); }
#pragma unroll
    for (int i = 0; i < 2; ++i) { const int c = tid + 512 * i; *(LAS v4u*)(F.lds + (c >> 4) * KP + (c & 15) * 16) = kr[i]; }
#pragma unroll
    for (int i = 0; i < DV / 64; ++i) { const int c = tid + 512 * i; *(LAS v4u*)(F.lds + 64 * KP + (c >> 3) * VP + (c & 7) * 16) = vr[i]; }
    __syncthreads();
    for (int j0 = 0; j0 < kend; j0 += 64) {
        Kl = F.lds + ((j0 >> 6) & 1) * BUFB; Vl = Kl + 64 * KP;
        const bool more = j0 + 64 < kend;
        if (more) {
#pragma unroll
            for (int i = 0; i < 2; ++i) { const int c = tid + 512 * i; kr[i] = *(const v4u*)(Kh + (size_t)(j0 + 64 + (c >> 4)) * 128 + (c & 15) * 8); }
#pragma unroll
            for (int i = 0; i < DV / 64; ++i) { const int c = tid + 512 * i; vr[i] = *(const v4u*)(VT + (size_t)(c >> 3) * vpitch + j0 + 64 + (c & 7) * 8); }
        }
        f32x4 s[4];
#pragma unroll
        for (int t = 0; t < 4; ++t) { s[t] = (f32x4){0.f, 0.f, 0.f, 0.f};
#pragma unroll
            for (int ks = 0; ks < 4; ++ks) { const bf16x8 a = *(const LAS bf16x8*)(Kl + (t * 16 + li) * KP + (ks * 32 + g * 8) * 2); s[t] = __builtin_amdgcn_mfma_f32_16x16x32_bf16(a, qf[ks], s[t], 0, 0, 0); } }
        float alpha = 1.f;
        if (DECAY) {
#pragma unroll
            for (int t = 0; t < 4; ++t)
#pragma unroll
                for (int r = 0; r < 4; ++r) { const int key = j0 + t * 16 + g * 4 + r; const float dcy = exp2f(slope * (float)(qpos - key)); s[t][r] = key > qpos ? 0.f : s[t][r] * dcy; }
        } else {
        float mx = -__builtin_inff();
#pragma unroll
        for (int t = 0; t < 4; ++t)
#pragma unroll
            for (int r = 0; r < 4; ++r) { const int key = j0 + t * 16 + g * 4 + r; float x = s[t][r] * SC - slope * (float)(qpos - key); if (CAUSAL && key > qpos) x = -__builtin_inff(); s[t][r] = x; mx = fmaxf(mx, x); }
        mx = fmaxf(mx, __shfl_xor(mx, 16)); mx = fmaxf(mx, __shfl_xor(mx, 32));
        const float m_new = fmaxf(m_run, mx); alpha = exp2f((m_run - m_new) * L2E); m_run = m_new;
        float ps = 0.f;
#pragma unroll
        for (int t = 0; t < 4; ++t)
#pragma unroll
            for (int r = 0; r < 4; ++r) { const float p = exp2f((s[t][r] - m_new) * L2E); s[t][r] = p; ps += p; }
        ps += __shfl_xor(ps, 16); ps += __shfl_xor(ps, 32);
        l_run = l_run * alpha + ps;
        }
        bf16x8 pf[2];
#pragma unroll
        for (int s2 = 0; s2 < 2; ++s2) { v4u pw; pw.x = pk2(s[2 * s2][0], s[2 * s2][1]); pw.y = pk2(s[2 * s2][2], s[2 * s2][3]); pw.z = pk2(s[2 * s2 + 1][0], s[2 * s2 + 1][1]); pw.w = pk2(s[2 * s2 + 1][2], s[2 * s2 + 1][3]); pf[s2] = __builtin_bit_cast(bf16x8, pw); }
        float al[4];
#pragma unroll
        for (int r = 0; r < 4; ++r) al[r] = DECAY ? 1.f : __shfl(alpha, g * 4 + r);
#pragma unroll
        for (int c = 0; c < DV / 16; ++c) {
            if (!DECAY) {
#pragma unroll
                for (int r = 0; r < 4; ++r) o[c][r] *= al[r]; }
#pragma unroll
            for (int s2 = 0; s2 < 2; ++s2) { const LAS unsigned char* vp = Vl + (c * 16 + li) * VP + (s2 * 32 + g * 4) * 2; const v2u lo = *(const LAS v2u*)vp, hi = *(const LAS v2u*)(vp + 32);
                v4u bw; bw.x = lo.x; bw.y = lo.y; bw.z = hi.x; bw.w = hi.y; o[c] = __builtin_amdgcn_mfma_f32_16x16x32_bf16(pf[s2], __builtin_bit_cast(bf16x8, bw), o[c], 0, 0, 0); }
        }
        if (more) { LAS unsigned char* Kn = F.lds + (((j0 >> 6) + 1) & 1) * BUFB;
#pragma unroll
            for (int i = 0; i < 2; ++i) { const int c = tid + 512 * i; *(LAS v4u*)(Kn + (c >> 4) * KP + (c & 15) * 16) = kr[i]; }
#pragma unroll
            for (int i = 0; i < DV / 64; ++i) { const int c = tid + 512 * i; *(LAS v4u*)(Kn + 64 * KP + (c >> 3) * VP + (c & 7) * 16) = vr[i]; } }
        __syncthreads();
    }
    float il[4];
#pragma unroll
    for (int r = 0; r < 4; ++r) il[r] = DECAY ? 1.f : 1.0f / __shfl(l_run, g * 4 + r);
#pragma unroll
    for (int c = 0; c < DV / 16; ++c)
#pragma unroll
        for (int r = 0; r < 4; ++r) { const unsigned off = (unsigned)((w * 16 + g * 4 + r) * opitch + c * 16 + li); const float v = o[c][r] * il[r];
            if (OUT_BF16) OUTB[off] = (bf16)f2bf(v); else OUTF[off] = v; }
}

constexpr int GDN_CH_BYTES = 16384 + 16384 + 8192 + 16384 + 32768;
DI int perm32pos(int k) { return (k & ~31) | (((k >> 2) & 3) << 3) | (((k >> 4) & 1) << 2) | (k & 3); }
DI void gdn_prep_item(const Frame& F, int l, int bh, int n, const bf16* BQKV, const float* BBA, const float* cw, const float* a_log, const float* dt_bias, unsigned char* CH, float* GLp) {
    LAS unsigned char* Kl = F.lds; LAS unsigned char* Ql = F.lds + 17408; LAS unsigned char* KBT = F.lds + 34816; LAS unsigned char* VBT = F.lds + 53248; LAS unsigned char* KTl = F.lds + 71680;
    LAS float* Am = (LAS float*)(F.lds + 90112); LAS unsigned char* Tl = F.lds + 106752; LAS unsigned char* AQl = F.lds + 115968; LAS float* Gs = (LAS float*)(F.lds + 125184); LAS float* gs = Gs + 64; LAS float* bs = gs + 64;
    LAS float* CWl = Am;
    int tid_ = F.tid; asm volatile("" : "+v"(tid_));
    const int tid = tid_, lane = tid & 63, w = F.wave, li = lane & 15, g = lane >> 4;
    const int b = bh >> 3, h = bh & 7, i = tid >> 3, cg = tid & 7, c0 = cg * 16, s = n * 64 + i, t = b * SEQ + s;
    bf16* Wn = (bf16*)CH; bf16* QD = (bf16*)(CH + 16384); bf16* AQK = (bf16*)(CH + 32768); bf16* KT = (bf16*)(CH + 40960); float* UT = (float*)(CH + 57344);
    __syncthreads();
    for (int e = tid; e < 1536; e += 512) { const int part = e >> 9, j = (e >> 7) & 3, c = e & 127; CWl[e] = cw[j * 3072 + part * 1024 + h * 128 + c]; }
    if (cg == 0) { const float bbv = BBA[(size_t)t * 16 + h], bav = BBA[(size_t)t * 16 + 8 + h] + dt_bias[l * 8 + h]; const float sp = bav > 20.f ? bav : log1pf(__expf(bav)); bs[i] = pg8::fsigm(bbv); gs[i] = -__expf(a_log[l * 8 + h]) * sp; }
    __syncthreads();
    float qv[16], kv[16], vv[16];
#pragma unroll
    for (int part = 0; part < 3; ++part) {
        float a[16];
#pragma unroll
        for (int c = 0; c < 16; ++c) a[c] = 0.f;
#pragma unroll
        for (int j = 0; j < 4; ++j) { if (s - 3 + j >= 0) { const v4u x0 = *(const v4u*)(BQKV + (size_t)(t - 3 + j) * 3072 + part * 1024 + h * 128 + c0), x1 = *(const v4u*)(BQKV + (size_t)(t - 3 + j) * 3072 + part * 1024 + h * 128 + c0 + 8);
                const LAS float* wj = CWl + part * 512 + j * 128 + c0;
#pragma unroll
                for (int c = 0; c < 4; ++c) { a[2 * c] += bf2f(x0[c] & 0xffffu) * wj[2 * c]; a[2 * c + 1] += __uint_as_float(x0[c] & 0xffff0000u) * wj[2 * c + 1]; a[8 + 2 * c] += bf2f(x1[c] & 0xffffu) * wj[8 + 2 * c]; a[9 + 2 * c] += __uint_as_float(x1[c] & 0xffff0000u) * wj[9 + 2 * c]; } } }
#pragma unroll
        for (int c = 0; c < 16; ++c) { const float y = pg8::fsilu(a[c]); if (part == 0) qv[c] = y; else if (part == 1) kv[c] = y; else vv[c] = y; }
    }
    { float sq = 0.f, sk = 0.f;
#pragma unroll
      for (int c = 0; c < 16; ++c) { sq += qv[c] * qv[c]; sk += kv[c] * kv[c]; }
      sq += __shfl_xor(sq, 1); sq += __shfl_xor(sq, 2); sq += __shfl_xor(sq, 4); sk += __shfl_xor(sk, 1); sk += __shfl_xor(sk, 2); sk += __shfl_xor(sk, 4);
      const float qn = rsqrtf(sq + 1e-6f) * 0.08838834764831845f, kn = rsqrtf(sk + 1e-6f);
#pragma unroll
      for (int c = 0; c < 16; ++c) { qv[c] *= qn; kv[c] *= kn; } }
    if (w == 0) { float v = gs[lane];
#pragma unroll
        for (int o = 1; o < 64; o <<= 1) { const float u = __shfl_up(v, o); if (lane >= o) v += u; }
        Gs[lane] = v; }
    __syncthreads();
    {
        const float Gi = Gs[i], Gl = Gs[63], be = bs[i], eg = __expf(Gi), kbs = be * eg, kts = __expf(Gl - Gi);
        v4u pk, pq;
#pragma unroll
        for (int hh = 0; hh < 2; ++hh) {
            pk.x = pk2(kv[8 * hh + 0], kv[8 * hh + 1]); pk.y = pk2(kv[8 * hh + 2], kv[8 * hh + 3]); pk.z = pk2(kv[8 * hh + 4], kv[8 * hh + 5]); pk.w = pk2(kv[8 * hh + 6], kv[8 * hh + 7]);
            pq.x = pk2(qv[8 * hh + 0], qv[8 * hh + 1]); pq.y = pk2(qv[8 * hh + 2], qv[8 * hh + 3]); pq.z = pk2(qv[8 * hh + 4], qv[8 * hh + 5]); pq.w = pk2(qv[8 * hh + 6], qv[8 * hh + 7]);
            *(LAS v4u*)(Kl + i * 272 + (c0 + 8 * hh) * 2) = pk; *(LAS v4u*)(Ql + i * 272 + (c0 + 8 * hh) * 2) = pq; }
        const int ip = perm32pos(i);
#pragma unroll
        for (int c = 0; c < 16; ++c) { *(LAS bf16*)(KBT + (c0 + c) * 144 + i * 2) = (bf16)f2bf(kv[c] * kbs); *(LAS bf16*)(VBT + (c0 + c) * 144 + i * 2) = (bf16)f2bf(vv[c] * be); *(LAS bf16*)(KTl + (c0 + c) * 144 + ip * 2) = (bf16)f2bf(kv[c] * kts); }
#pragma unroll
        for (int gp = 0; gp < 4; ++gp) { v2u o; o.x = pk2(qv[4 * gp] * eg, qv[4 * gp + 1] * eg); o.y = pk2(qv[4 * gp + 2] * eg, qv[4 * gp + 3] * eg); *(v2u*)(QD + i * 128 + 32 * (cg >> 1) + 8 * gp + 4 * (cg & 1)) = o; }
        if (tid == 0) *GLp = __expf(Gl);
    }
    __syncthreads();
    {
        const int kind = w >> 2, rb = w & 3; LAS unsigned char* Al = kind ? Ql : Kl;
        bf16x8 af[4];
#pragma unroll
        for (int ks = 0; ks < 4; ++ks) af[ks] = *(const LAS bf16x8*)(Al + (rb * 16 + li) * 272 + (ks * 32 + g * 8) * 2);
#pragma unroll
        for (int cb = 0; cb < 4; ++cb) {
            f32x4 acc = (f32x4){0.f, 0.f, 0.f, 0.f};
            if (cb <= rb) {
#pragma unroll
                for (int ks = 0; ks < 4; ++ks) { const bf16x8 bfr = *(const LAS bf16x8*)(Kl + (cb * 16 + li) * 272 + (ks * 32 + g * 8) * 2); acc = __builtin_amdgcn_mfma_f32_16x16x32_bf16(af[ks], bfr, acc, 0, 0, 0); } }
            const int j = cb * 16 + li; const float Gj = Gs[j];
#pragma unroll
            for (int r = 0; r < 4; ++r) { const int ii = rb * 16 + 4 * g + r; const float Lij = __expf(Gs[ii] - Gj);
                if (kind == 0) Am[ii * 65 + j] = ii > j ? acc[r] * Lij * bs[ii] : 0.f;
                else *(LAS bf16*)(AQl + ii * 144 + perm32pos(j) * 2) = (bf16)f2bf(ii >= j ? acc[r] * Lij : 0.f); }
        }
    }
    __syncthreads();
    if (w == 0) {
        int zv = 0; asm volatile("" : "+v"(zv)); const LAS float* Amv = Am + zv;
        float Tr[64];
#pragma unroll
        for (int ii = 0; ii < 64; ++ii) {
            float a0 = (ii == lane) ? 1.f : 0.f, a1 = 0.f;
#pragma unroll
            for (int j = 0; j < ii; ++j) { if (j & 1) a1 -= Amv[ii * 65 + j] * Tr[j]; else a0 -= Amv[ii * 65 + j] * Tr[j]; }
            Tr[ii] = a0 + a1;
            *(LAS bf16*)(Tl + ii * 144 + lane * 2) = (bf16)f2bf(Tr[ii]);
            asm volatile("" ::: "memory");
        }
    }
    __syncthreads();
    {
        const int kind = w >> 2; LAS unsigned char* Xl = kind ? VBT : KBT;
#pragma unroll
        for (int q2 = 0; q2 < 2; ++q2) { const int rbk = 2 * (w & 3) + q2;
            bf16x8 af[2];
#pragma unroll
            for (int ks = 0; ks < 2; ++ks) af[ks] = *(const LAS bf16x8*)(Xl + (rbk * 16 + li) * 144 + (ks * 32 + g * 8) * 2);
#pragma unroll
            for (int cb = 0; cb < 4; ++cb) { f32x4 acc = (f32x4){0.f, 0.f, 0.f, 0.f};
#pragma unroll
                for (int ks = 0; ks < 2; ++ks) { const bf16x8 bfr = *(const LAS bf16x8*)(Tl + (cb * 16 + li) * 144 + (ks * 32 + g * 8) * 2); acc = __builtin_amdgcn_mfma_f32_16x16x32_bf16(af[ks], bfr, acc, 0, 0, 0); }
                const int ii = cb * 16 + li;
                if (kind == 0) { v2u o; o.x = pk2(-acc[0], -acc[1]); o.y = pk2(-acc[2], -acc[3]); *(v2u*)(Wn + ii * 128 + 32 * (rbk >> 1) + 8 * g + 4 * (rbk & 1)) = o; }
                else {
#pragma unroll
                    for (int r = 0; r < 4; ++r) UT[(rbk * 16 + 4 * g + r) * 64 + ii] = acc[r]; } }
        }
    }
#pragma unroll
    for (int q2 = 0; q2 < 2; ++q2) { const int c = tid + 512 * q2, row = c >> 3, cc = c & 7; *(v4u*)(KT + row * 64 + cc * 8) = *(const LAS v4u*)(KTl + row * 144 + cc * 16); }
    { const int row = tid >> 3, cc = tid & 7; *(v4u*)(AQK + row * 64 + cc * 8) = *(const LAS v4u*)(AQl + row * 144 + cc * 16); }
}

DI void gdn_scan(const Frame& F, int bh, const unsigned char* CHB, const float* GLB, float* OB) {
    constexpr int BUFB = 62464, O_QD = 17408, O_AQ = 34816, O_KT = 44032;
    int tid_ = F.tid; asm volatile("" : "+v"(tid_));
    const int tid = tid_, lane = tid & 63, w = F.wave, li = lane & 15, g = lane >> 4, b = bh >> 3, h = bh & 7;
    f32x4 S[8];
#pragma unroll
    for (int kb = 0; kb < 8; ++kb) S[kb] = (f32x4){0.f, 0.f, 0.f, 0.f};
    int ldso[7];
#pragma unroll
    for (int q = 0; q < 7; ++q) { const int c = tid + 512 * q;
        if (q < 2) ldso[q] = (c >> 4) * 272 + (c & 15) * 16; else if (q < 4) ldso[q] = O_QD + ((c - 1024) >> 4) * 272 + (c & 15) * 16;
        else if (q == 4) ldso[q] = O_AQ + ((c - 2048) >> 3) * 144 + (c & 7) * 16; else ldso[q] = O_KT + ((c - 2560) >> 3) * 144 + (c & 7) * 16; }
    const unsigned char* CH0 = CHB + (size_t)(bh * 32) * GDN_CH_BYTES;
    v4u st[7]; f32x4 utc[4], utn[4]; float glc, gln;
    __syncthreads();
#pragma unroll
    for (int q = 0; q < 7; ++q) st[q] = *(const v4u*)(CH0 + (size_t)(tid + 512 * q) * 16);
#pragma unroll
    for (int jb = 0; jb < 4; ++jb) utc[jb] = *(const f32x4*)((const float*)(CH0 + 57344) + (16 * w + li) * 64 + jb * 16 + 4 * g);
    glc = GLB[bh * 32];
#pragma unroll
    for (int q = 0; q < 7; ++q) *(LAS v4u*)(F.lds + ldso[q]) = st[q];
    __syncthreads();
    for (int n = 0; n < 32; ++n) {
        const LAS unsigned char* Lb = F.lds + (n & 1) * BUFB;
        if (n + 1 < 32) { const unsigned char* CH = CH0 + (size_t)(n + 1) * GDN_CH_BYTES;
#pragma unroll
            for (int q = 0; q < 7; ++q) st[q] = *(const v4u*)(CH + (size_t)(tid + 512 * q) * 16);
#pragma unroll
            for (int jb = 0; jb < 4; ++jb) utn[jb] = *(const f32x4*)((const float*)(CH + 57344) + (16 * w + li) * 64 + jb * 16 + 4 * g);
            gln = GLB[bh * 32 + n + 1]; }
        bf16x8 sf[4];
#pragma unroll
        for (int ks = 0; ks < 4; ++ks) { v4u p; p.x = pk2(S[2 * ks][0], S[2 * ks][1]); p.y = pk2(S[2 * ks][2], S[2 * ks][3]); p.z = pk2(S[2 * ks + 1][0], S[2 * ks + 1][1]); p.w = pk2(S[2 * ks + 1][2], S[2 * ks + 1][3]); sf[ks] = __builtin_bit_cast(bf16x8, p); }
        f32x4 vn[4];
#pragma unroll
        for (int jb = 0; jb < 4; ++jb) { vn[jb] = utc[jb];
#pragma unroll
            for (int ks = 0; ks < 4; ++ks) { const bf16x8 a = *(const LAS bf16x8*)(Lb + (jb * 16 + li) * 272 + (ks * 32 + g * 8) * 2); vn[jb] = __builtin_amdgcn_mfma_f32_16x16x32_bf16(a, sf[ks], vn[jb], 0, 0, 0); } }
        bf16x8 vf[2];
#pragma unroll
        for (int js = 0; js < 2; ++js) { v4u p; p.x = pk2(vn[2 * js][0], vn[2 * js][1]); p.y = pk2(vn[2 * js][2], vn[2 * js][3]); p.z = pk2(vn[2 * js + 1][0], vn[2 * js + 1][1]); p.w = pk2(vn[2 * js + 1][2], vn[2 * js + 1][3]); vf[js] = __builtin_bit_cast(bf16x8, p); }
#pragma unroll
        for (int ib = 0; ib < 4; ++ib) { f32x4 z = (f32x4){0.f, 0.f, 0.f, 0.f};
#pragma unroll
            for (int ks = 0; ks < 4; ++ks) { const bf16x8 bq = *(const LAS bf16x8*)(Lb + O_QD + (ib * 16 + li) * 272 + (ks * 32 + g * 8) * 2); z = __builtin_amdgcn_mfma_f32_16x16x32_bf16(sf[ks], bq, z, 0, 0, 0); }
#pragma unroll
            for (int js = 0; js < 2; ++js) { const bf16x8 ba = *(const LAS bf16x8*)(Lb + O_AQ + (ib * 16 + li) * 144 + (js * 32 + g * 8) * 2); z = __builtin_amdgcn_mfma_f32_16x16x32_bf16(vf[js], ba, z, 0, 0, 0); }
            *(f32x4*)(OB + ((size_t)(b * SEQ + n * 64 + ib * 16 + li)) * 1024 + h * 128 + 16 * w + 4 * g) = z; }
#pragma unroll
        for (int kb = 0; kb < 8; ++kb) { S[kb] = S[kb] * glc;
#pragma unroll
            for (int js = 0; js < 2; ++js) { const bf16x8 a = *(const LAS bf16x8*)(Lb + O_KT + (kb * 16 + li) * 144 + (js * 32 + g * 8) * 2); S[kb] = __builtin_amdgcn_mfma_f32_16x16x32_bf16(a, vf[js], S[kb], 0, 0, 0); } }
        if (n + 1 < 32) {
            LAS unsigned char* Ln = F.lds + ((n + 1) & 1) * BUFB;
#pragma unroll
            for (int q = 0; q < 7; ++q) *(LAS v4u*)(Ln + ldso[q]) = st[q];
#pragma unroll
            for (int jb = 0; jb < 4; ++jb) utc[jb] = utn[jb];
            glc = gln; }
        __syncthreads();
    }
}

#define x_in ((const float*)args.in[0])
#define mem ((const float*)args.in[1])
#define w_in ((const float*)args.in[2])
#define conv_w ((const float*)args.in[3])
#define a_log ((const float*)args.in[4])
#define dt_bias ((const float*)args.in[5])
#define gdn_norm_w ((const float*)args.in[6])
#define diff_lambda ((const float*)args.in[7])
#define diff_norm_w ((const float*)args.in[8])
#define w_branch ((const float*)args.in[9])
#define w_out ((const float*)args.in[10])
#define mix_norm_w ((const float*)args.in[11])
#define mem_norm_w ((const float*)args.in[12])
#define cross_norm_w ((const float*)args.in[13])
#define cross_w_q ((const float*)args.in[14])
#define cross_w_kv ((const float*)args.in[15])
#define cross_w_o ((const float*)args.in[16])
#define ffn_norm_w ((const float*)args.in[17])
#define dense_w_gu ((const float*)args.in[18])
#define dense_w_down ((const float*)args.in[19])
#define router_w ((const float*)args.in[20])
#define expert_w_gu ((const float*)args.in[21])
#define expert_w_down ((const float*)args.in[22])
#define final_norm_w ((const float*)args.in[23])
#define WIN ((bf16*)(ws + WS_WIN))
#define WBR ((bf16*)(ws + WS_WBR))
#define WOUT ((bf16*)(ws + WS_WOUT))
#define WQ ((bf16*)(ws + WS_WQ))
#define WKV ((bf16*)(ws + WS_WKV))
#define WO ((bf16*)(ws + WS_WO))
#define WGU ((bf16*)(ws + WS_WGU))
#define WDN ((bf16*)(ws + WS_WDN))
#define WEGU ((bf16*)(ws + WS_WEGU))
#define WEDN ((bf16*)(ws + WS_WEDN))
#define XRES ((float*)(ws + WS_XRES))
#define H ((bf16*)(ws + WS_H))
#define RQ ((bf16*)(ws + WS_RQ))
#define RK ((bf16*)(ws + WS_RK))
#define RVT ((bf16*)(ws + WS_RV))
#define RG ((bf16*)(ws + WS_RG))
#define BQKV ((bf16*)(ws + WS_BQKV))
#define BZ ((bf16*)(ws + WS_BZ))
#define BBA ((float*)(ws + WS_BBA))
#define CQ ((bf16*)(ws + WS_CQ))
#define CK ((bf16*)(ws + WS_CK))
#define CVT ((bf16*)(ws + WS_CVT))
#define GATES ((bf16*)(ws + WS_GATES))
#define GQ ((bf16*)(ws + WS_GQ))
#define GK ((bf16*)(ws + WS_GK))
#define GV ((bf16*)(ws + WS_GV))
#define GG ((float*)(ws + WS_GG))
#define GB ((float*)(ws + WS_GB))
#define OA ((float*)(ws + WS_OA))
#define OB ((float*)(ws + WS_OB))
#define O12 ((float*)(ws + WS_O12))
#define OCAT ((bf16*)(ws + WS_OCAT))
#define MERGE ((float*)(ws + WS_MERGE))
#define MERGEB ((bf16*)(ws + WS_MERGEB))
#define MEMN ((bf16*)(ws + WS_MEMN))
#define KX ((bf16*)(ws + WS_KX))
#define VXT ((bf16*)(ws + WS_VXT))
#define QX ((bf16*)(ws + WS_QX))
#define OX ((bf16*)(ws + WS_OX))
#define ACT ((bf16*)(ws + WS_ACT))
#define HG ((bf16*)(ws + WS_HG))
#define EACT ((bf16*)(ws + WS_EACT))
#define Y ((float*)(ws + WS_Y))
#define ROUTE ((int*)(ws + WS_ROUTE))
__global__ void __launch_bounds__(NWAVES * 64, 2) mk_fwd(Args args) {
    extern __shared__ __attribute__((aligned(16))) unsigned char lds_raw[];
    Frame F;
    F.lds = (LAS unsigned char*)lds_raw;
    F.tid = threadIdx.x; F.lane = F.tid & 63; F.wave = __builtin_amdgcn_readfirstlane(F.tid >> 6);
    F.G = gridDim.x; { const int bx = blockIdx.x; F.vcu = (F.G % 8 == 0) ? (bx % 8) * (F.G / 8) + bx / 8 : bx; }
    F.gw = F.vcu * NWAVES + F.wave; F.NGW = F.G * NWAVES;
    volatile LAS unsigned* MISC = (volatile LAS unsigned*)(F.lds + MISC_OFF);
    LAS int* MTAB = (LAS int*)(F.lds + MISC_OFF + 128);
    unsigned char* ws = args.ws;
    unsigned* ctl = (unsigned*)(ws + WS_CTL);
    for (int u = F.tid; u < (LDS_BYTES - RING_BYTES) / 4; u += NWAVES * 64) ((LAS unsigned*)(F.lds + RING_BYTES))[u] = 0u;
    __syncthreads();
#if MK_ONE_LAUNCH
    XcdBarrier bar = xcd_barrier_post(ctl + CW_BAR, MISC + 8);
#define GRID_BAR() xcd_barrier(bar)
#else
#define GRID_BAR() do {} while (0)
#endif
    const int lo = args.ph_lo, hi = args.ph_hi;
#ifndef PROBE_PH
#define PROBE_PH -1
#endif
#define IN(k) (lo <= (k) && (k) < hi)
#define REP(k) for (int rep_ = 0; rep_ < ((k) == PROBE_PH ? 2 : 1); ++rep_)
#define SEAM(k) do { if (IN(k) && IN((k) + 1)) GRID_BAR(); } while (0)

    if (IN(0)) REP(0) {
        for (int l = 0; l < 2; ++l) {
            conv_job(F, w_in + (size_t)l * D * 17424, D, 17424, WIN + (size_t)l * NINP * D, NINP, 1, 0);
            for (int s = 0; s < 3; ++s) conv_job(F, w_branch + ((size_t)l * 3072 + s * 1024) * D, 1024, D, WBR + ((size_t)l * 3 + s) * D * 1024, D, 0, 0);
            conv_job(F, w_out + (size_t)l * D * D, D, D, WOUT + (size_t)l * D * D, D, 0, 0);
            conv_job(F, cross_w_q + (size_t)l * D * 512, D, 512, WQ + (size_t)l * 512 * D, 512, 0, 0);
            conv_job(F, cross_w_kv + (size_t)l * D * 1024, D, 1024, WKV + (size_t)l * 1024 * D, 1024, 0, 0);
            conv_job(F, cross_w_o + (size_t)l * 512 * D, 512, D, WO + (size_t)l * D * 512, D, 0, 0);
        }
        conv_job(F, dense_w_gu, D, 2 * DFF, WGU, 2 * DFF, 2, DFF);
        conv_job(F, dense_w_down, DFF, D, WDN, D, 0, 0);
        for (int e = 0; e < NEXP; ++e) {
            conv_job(F, expert_w_gu + (size_t)e * D * 2 * EFF, D, 2 * EFF, WEGU + (size_t)e * 2 * EFF * D, 2 * EFF, 2, EFF);
            conv_job(F, expert_w_down + (size_t)e * EFF * D, EFF, D, WEDN + (size_t)e * D * EFF, D, 0, 0);
        }
        for (int r = F.gw; r < T; r += F.NGW) rms_row(x_in + (size_t)r * D, mix_norm_w, H + (size_t)r * D, F.lane);
        for (int r = F.gw; r < 2 * MEMR; r += F.NGW) { const int l = r / MEMR, rr = r % MEMR; rms_row(mem + (size_t)rr * D, mem_norm_w + l * D, MEMN + (size_t)r * D, F.lane); }
    }
    SEAM(0);
    if (IN(1)) REP(1) {
        for (int l = 0; l < 2; ++l) {
            pg8::Gemm g{MEMN + (size_t)l * MEMR * D, WKV + (size_t)l * 1024 * D, MEMR, 1024, D}; pg8::StaticOrder S; S.init(MEMR, 1024, F.G, (int)((blockIdx.x + F.G - 16 * l) % F.G));
            pg8::EpiHeads E{KX + (size_t)l * NB * 4 * MEML * 128, VXT + (size_t)l * NB * 4 * 128 * MEML, 4, 8, 2};
            pg8::gemm_phase<pg8::EpiHeads, pg8::StaticOrder, true, true>(F.lds, g, S, E);
        }
    }
    SEAM(1);

    { constexpr int l = 0;
        const int pb = 2 + l * NPL;
        const float lambda_init = l == 0 ? 0.2f : 0.35550906f;
        const float* xin = l == 0 ? x_in : XRES;
        if (IN(pb + 0)) REP(pb + 0) {
            pg8::Gemm g{H, WIN + (size_t)l * NINP * D, T, NINP, D}; pg8::StaticOrder S; S.init(T, NINP, F.G, (int)blockIdx.x);
            pg8::EpiIn E{RQ, RK, RVT, RG, BQKV, BZ, CQ, CK, CVT, GATES, BBA};
            pg8::gemm_phase<pg8::EpiIn, pg8::StaticOrder, true, true>(F.lds, g, S, E);
        }
        SEAM(pb + 0);
        if (IN(pb + 1)) REP(pb + 1) {
            const float* cw = conv_w + (size_t)l * 4 * 3072;
            for (int it = F.vcu; it < 1024; it += F.G) gdn_prep_item(F, l, it >> 5, it & 31, BQKV, BBA, cw, a_log, dt_bias, ws + WS_GCH + (size_t)it * GDN_CH_BYTES, (float*)(ws + WS_GL) + it);
        }
        SEAM(pb + 1);
        if (IN(pb + 2)) REP(pb + 2) {
            const int bx = F.vcu;
#ifndef PROBE_SCAN2
#define PROBE_SCAN2 1
#endif
#ifndef PROBE_FLASH2
#define PROBE_FLASH2 1
#endif
            if (bx < 32) { for (int rp = 0; rp < (l == 0 ? PROBE_SCAN2 : 1); ++rp) gdn_scan(F, bx, ws + WS_GCH, (const float*)(ws + WS_GL), OB); }
            else {
                for (int it = bx - 32; it < 1024 * (l == 0 ? PROBE_FLASH2 : 1); it += F.G - 32) {
                    const int qt = 15 - ((it & 1023) >> 6), kind = (it >> 5) & 1, hd = it & 31, b = hd >> 3, hm = hd & 7;
                    if (kind == 0) { const int hh = hm >> 1, m = hm & 1; const float slope = exp2f(-2.0f * (float)(hh + 1));
                        flash_item<256, true, false, false>(F, CQ + ((size_t)hd * SEQ + qt * 128) * 128, CK + (size_t)hd * SEQ * 128, CVT + (size_t)(b * 4 + hh) * 256 * SEQ, SEQ, qt * 128, SEQ, slope,
                                                            O12 + ((size_t)m * T + b * SEQ + qt * 128) * 1024 + hh * 256, nullptr, 1024); }
                    else { const float lg = log2f(1.0f - exp2f(-5.0f - (float)hm));
                        flash_item<128, true, false, true>(F, RQ + ((size_t)hd * SEQ + qt * 128) * 128, RK + (size_t)hd * SEQ * 128, RVT + (size_t)hd * 128 * SEQ, SEQ, qt * 128, SEQ, lg,
                                                           OA + ((size_t)(b * SEQ + qt * 128)) * 1024 + hm * 128, nullptr, 1024); }
                }
            }
        }
        SEAM(pb + 2);
        if (IN(pb + 3)) REP(pb + 3) {
            const int lane = F.lane;
            const float* lv = diff_lambda + (size_t)l * 512;
            const float d01 = wave_sum(lv[lane] * lv[128 + lane] + lv[64 + lane] * lv[192 + lane]), d23 = wave_sum(lv[256 + lane] * lv[384 + lane] + lv[320 + lane] * lv[448 + lane]);
            const float lam = __expf(d01) - __expf(d23) + lambda_init;
            for (int t = F.gw; t < T; t += F.NGW) {
#pragma unroll
                for (int h = 0; h < 8; ++h) { const size_t o = (size_t)t * 1024 + h * 128 + 2 * lane;
                    { const float a0 = OA[o], a1 = OA[o + 1]; const float mean = wave_sum(a0 + a1) * (1.f / 128.f); const float c0 = a0 - mean, c1 = a1 - mean; const float rstd = rsqrtf(wave_sum(c0 * c0 + c1 * c1) * (1.f / 128.f) + EPS);
                      const unsigned gv = *(const unsigned*)(RG + o); *(unsigned*)(OCAT + o) = pk2(c0 * rstd * bf2f(gv & 0xffffu), c1 * rstd * __uint_as_float(gv & 0xffff0000u)); }
                    { const float a0 = OB[o], a1 = OB[o + 1]; const float rstd = rsqrtf(wave_sum(a0 * a0 + a1 * a1) * (1.f / 128.f) + EPS); const unsigned gv = *(const unsigned*)(BZ + o);
                      *(unsigned*)(OCAT + (size_t)T * 1024 + o) = pk2(a0 * rstd * gdn_norm_w[l * 128 + 2 * lane] * bf2f(gv & 0xffffu), a1 * rstd * gdn_norm_w[l * 128 + 2 * lane + 1] * __uint_as_float(gv & 0xffff0000u)); } }
#pragma unroll
                for (int h = 0; h < 4; ++h) { const size_t o = (size_t)t * 1024 + h * 256 + 4 * lane; const f32x4 p = *(const f32x4*)(O12 + o), q = *(const f32x4*)(O12 + (size_t)T * 1024 + o); const f32x4 d = p - q * lam;
                    const float rstd = rsqrtf(wave_sum((d[0] * d[0] + d[1] * d[1]) + (d[2] * d[2] + d[3] * d[3])) * (1.f / 256.f) + EPS) * (1.0f - lambda_init); const f32x4 ww = *(const f32x4*)(diff_norm_w + l * 256 + 4 * lane);
                    v2u ov; ov.x = pk2(d[0] * rstd * ww[0], d[1] * rstd * ww[1]); ov.y = pk2(d[2] * rstd * ww[2], d[3] * rstd * ww[3]); *(v2u*)(OCAT + (size_t)2 * T * 1024 + o) = ov; }
            }
        }
        SEAM(pb + 3);
        if (IN(pb + 4)) REP(pb + 4) {
            for (int s = 0; s < 3; ++s) {
                pg8::Gemm g{OCAT + (size_t)s * T * 1024, WBR + ((size_t)l * 3 + s) * D * 1024, T, D, 1024}; pg8::StaticOrder S; S.init(T, D, F.G, (int)blockIdx.x);
                pg8::EpiBranch E{MERGE, MERGEB, GATES, s};
                pg8::gemm_phase<pg8::EpiBranch, pg8::StaticOrder, true, true>(F.lds, g, S, E);
            }
        }
        SEAM(pb + 4);
        if (IN(pb + 5)) REP(pb + 5) {
            pg8::Gemm g{MERGEB, WOUT + (size_t)l * D * D, T, D, D}; pg8::StaticOrder S; S.init(T, D, F.G, (int)blockIdx.x);
            pg8::EpiResid E{xin, XRES, D};
            pg8::gemm_phase<pg8::EpiResid, pg8::StaticOrder, true, true>(F.lds, g, S, E);
        }
        SEAM(pb + 5);
        if (IN(pb + 6)) REP(pb + 6) { for (int r = F.gw; r < T; r += F.NGW) rms_row(XRES + (size_t)r * D, cross_norm_w + l * D, H + (size_t)r * D, F.lane); }
        SEAM(pb + 6);
        if (IN(pb + 7)) REP(pb + 7) {
            pg8::Gemm g{H, WQ + (size_t)l * 512 * D, T, 512, D}; pg8::StaticOrder S; S.init(T, 512, F.G, (int)blockIdx.x);
            pg8::EpiHeads E{QX, nullptr, 4, 11, 1 << 20};
            pg8::gemm_phase<pg8::EpiHeads, pg8::StaticOrder, true, true>(F.lds, g, S, E);
        }
        SEAM(pb + 7);
        if (IN(pb + 8)) REP(pb + 8) {
            for (int it = F.vcu; it < 256; it += F.G) { const int hd = it >> 4, qt = it & 15, b = hd >> 2, hh = hd & 3;
                flash_item<128, false, true, false>(F, QX + ((size_t)hd * SEQ + qt * 128) * 128, KX + ((size_t)l * 16 + hd) * MEML * 128, VXT + ((size_t)l * 16 + hd) * 128 * MEML, MEML, qt * 128, MEML, 0.f,
                                             nullptr, OX + ((size_t)(b * SEQ + qt * 128)) * 512 + hh * 128, 512); }
        }
        SEAM(pb + 8);
        if (IN(pb + 9)) REP(pb + 9) {
            pg8::Gemm g{OX, WO + (size_t)l * D * 512, T, D, 512}; pg8::StaticOrder S; S.init(T, D, F.G, (int)blockIdx.x);
            pg8::EpiResid E{XRES, XRES, D};
            pg8::gemm_phase<pg8::EpiResid, pg8::StaticOrder, true, true>(F.lds, g, S, E);
        }
        SEAM(pb + 9);
        if (IN(pb + 10)) REP(pb + 10) {
            const int lane = F.lane; const float* w = ffn_norm_w + l * D;
            for (int r = F.gw; r < T; r += F.NGW) {
                const float* xrow = XRES + (size_t)r * D; f32x4 v[8]; float ss = 0.f;
#pragma unroll
                for (int j = 0; j < 8; ++j) { v[j] = *(const f32x4*)(xrow + 4 * (lane + 64 * j)); ss += (v[j][0] * v[j][0] + v[j][1] * v[j][1]) + (v[j][2] * v[j][2] + v[j][3] * v[j][3]); }
                const float rstd = rsqrtf(wave_sum(ss) * (1.f / D) + EPS);
                float lg[8];
#pragma unroll
                for (int e = 0; e < 8; ++e) lg[e] = 0.f;
#pragma unroll
                for (int j = 0; j < 8; ++j) { const f32x4 ww = *(const f32x4*)(w + 4 * (lane + 64 * j)); f32x4 y; y[0] = v[j][0] * rstd * ww[0]; y[1] = v[j][1] * rstd * ww[1]; y[2] = v[j][2] * rstd * ww[2]; y[3] = v[j][3] * rstd * ww[3];
                    v2u o; o.x = pk2(y[0], y[1]); o.y = pk2(y[2], y[3]); *(v2u*)(H + (size_t)r * D + 4 * (lane + 64 * j)) = o;
                    if (l == 1) {
#pragma unroll
                        for (int c = 0; c < 4; ++c) { const float* rw = router_w + (size_t)(4 * (lane + 64 * j) + c) * 8; const f32x4 r0 = *(const f32x4*)rw, r1 = *(const f32x4*)(rw + 4);
                            lg[0] += y[c] * r0[0]; lg[1] += y[c] * r0[1]; lg[2] += y[c] * r0[2]; lg[3] += y[c] * r0[3]; lg[4] += y[c] * r1[0]; lg[5] += y[c] * r1[1]; lg[6] += y[c] * r1[2]; lg[7] += y[c] * r1[3]; } } }
                if (l == 1) {
#pragma unroll
                    for (int e = 0; e < 8; ++e) lg[e] = wave_sum(lg[e]);
                    int e0 = 0; float v0 = lg[0];
#pragma unroll
                    for (int e = 1; e < 8; ++e) if (lg[e] > v0) { v0 = lg[e]; e0 = e; }
                    int e1 = -1; float v1 = -__builtin_inff();
#pragma unroll
                    for (int e = 0; e < 8; ++e) if (e != e0 && lg[e] > v1) { v1 = lg[e]; e1 = e; }
                    if (lane == 0) { const float p0 = 1.0f / (1.0f + __expf(v1 - v0)); int* ro = ROUTE + (size_t)r * 8;
                        ro[0] = e0; ro[1] = e1; ro[2] = (int)atomicAdd(ctl + CW_CNT + e0, 1u); ro[3] = (int)atomicAdd(ctl + CW_CNT + e1, 1u); ((float*)ro)[4] = p0; ((float*)ro)[5] = 1.0f - p0; }
                }
            }
        }
        SEAM(pb + 10);
        if (l == 0) {
            if (IN(pb + 11)) REP(pb + 11) {
                pg8::Gemm g{H, WGU, T, 2 * DFF, D}; pg8::StaticOrder S; S.init(T, 2 * DFF, F.G, (int)blockIdx.x);
                pg8::EpiSwiglu E{ACT, DFF, 1 << 20};
                pg8::gemm_phase<pg8::EpiSwiglu, pg8::StaticOrder, true, true>(F.lds, g, S, E);
            }
            SEAM(pb + 11);
            if (IN(pb + 12)) REP(pb + 12) {
                pg8::Gemm g{ACT, WDN, T, D, DFF}; pg8::StaticOrder S; S.init(T, D, F.G, (int)blockIdx.x);
                pg8::EpiResid E{XRES, XRES, D};
                pg8::gemm_phase<pg8::EpiResid, pg8::StaticOrder, true, true>(F.lds, g, S, E);
            }
            SEAM(pb + 12);
            if (IN(pb + 13)) REP(pb + 13) { for (int r = F.gw; r < T; r += F.NGW) rms_row(XRES + (size_t)r * D, mix_norm_w + D, H + (size_t)r * D, F.lane); }
            SEAM(pb + 13);
            SEAM(pb + 14);
        } else {
            int off[9]; off[0] = 0;
#pragma unroll
            for (int e = 0; e < 8; ++e) { const int c = (int)__hip_atomic_load(ctl + CW_CNT + e, __ATOMIC_RELAXED, __HIP_MEMORY_SCOPE_AGENT); off[e + 1] = off[e] + ((c + 255) & ~255); }
            if (IN(pb + 11)) REP(pb + 11) {
                for (int it = F.gw; it < T * 2; it += F.NGW) { const int t = it >> 1, k = it & 1; int* ro = ROUTE + (size_t)t * 8; const int e = ro[k], pos = ro[2 + k];
                    int base = 0;
#pragma unroll
                    for (int q = 0; q < 8; ++q) if (e == q) base = off[q];
                    const int slot = base + pos; if (F.lane == 0) ro[6 + k] = slot;
                    const v4u* src = (const v4u*)(H + (size_t)t * D); v4u* dst = (v4u*)(HG + (size_t)slot * D);
#pragma unroll
                    for (int j = 0; j < 4; ++j) dst[F.lane + 64 * j] = src[F.lane + 64 * j]; }
#pragma unroll
                for (int e = 0; e < 8; ++e) { const int c = (int)__hip_atomic_load(ctl + CW_CNT + e, __ATOMIC_RELAXED, __HIP_MEMORY_SCOPE_AGENT);
                    for (int rr = off[e] + c + F.gw; rr < off[e + 1]; rr += F.NGW) { v4u* dst = (v4u*)(HG + (size_t)rr * D);
#pragma unroll
                        for (int j = 0; j < 4; ++j) dst[F.lane + 64 * j] = (v4u){0u, 0u, 0u, 0u}; } }
            }
            SEAM(pb + 11);
            if (IN(pb + 12)) REP(pb + 12) {
                if (F.tid == 0) { int cu = 0;
#pragma unroll
                    for (int e = 0; e < 8; ++e) { const int ne = (off[e + 1] - off[e]) >> 8; MTAB[e] = ne; MTAB[8 + e] = off[e] >> 8; MTAB[16 + e] = cu; cu += ne * 56; } MTAB[24] = cu; MTAB[25] = cu; }
                __syncthreads();
                pg8::Gemm g{HG, WEGU, MAXSLOT, NEXP * 2 * EFF, D}; pg8::MoeOrder S{(const LAS int*)MTAB, 56, F.G, (int)blockIdx.x};
                pg8::EpiSwiglu E{EACT, EFF, 56};
                pg8::gemm_phase<pg8::EpiSwiglu, pg8::MoeOrder, true, true>(F.lds, g, S, E);
            }
            SEAM(pb + 12);
            if (IN(pb + 13)) REP(pb + 13) {
                __syncthreads();
                if (F.tid == 0) { int cu = 0;
#pragma unroll
                    for (int e = 0; e < 8; ++e) { const int ne = (off[e + 1] - off[e]) >> 8; MTAB[e] = ne; MTAB[8 + e] = off[e] >> 8; MTAB[16 + e] = cu; cu += ne * 8; } MTAB[24] = cu; MTAB[25] = cu; }
                __syncthreads();
                pg8::Gemm g{EACT, WEDN, MAXSLOT, NEXP * D, EFF}; pg8::MoeOrder S{(const LAS int*)MTAB, 8, F.G, (int)blockIdx.x};
                pg8::EpiStoreF32 E{Y, D, 8};
                pg8::gemm_phase<pg8::EpiStoreF32, pg8::MoeOrder, true, true>(F.lds, g, S, E);
            }
            SEAM(pb + 13);
            if (IN(pb + 14)) REP(pb + 14) {
                const int lane = F.lane;
                for (int r = F.gw; r < T; r += F.NGW) { const int* ro = ROUTE + (size_t)r * 8; const float p0 = ((const float*)ro)[4], p1 = ((const float*)ro)[5]; const float* y0 = Y + (size_t)ro[6] * D; const float* y1 = Y + (size_t)ro[7] * D;
                    const float* xrow = XRES + (size_t)r * D; f32x4 v[8]; float ss = 0.f;
#pragma unroll
                    for (int j = 0; j < 8; ++j) { const int o = 4 * (lane + 64 * j); v[j] = *(const f32x4*)(xrow + o) + *(const f32x4*)(y0 + o) * p0 + *(const f32x4*)(y1 + o) * p1; ss += (v[j][0] * v[j][0] + v[j][1] * v[j][1]) + (v[j][2] * v[j][2] + v[j][3] * v[j][3]); }
                    const float rstd = rsqrtf(wave_sum(ss) * (1.f / D) + EPS);
#pragma unroll
                    for (int j = 0; j < 8; ++j) { const int o = 4 * (lane + 64 * j); const f32x4 ww = *(const f32x4*)(final_norm_w + o); *(f32x4*)(args.out + (size_t)r * D + o) = v[j] * rstd * ww; } }
            }
        }
    }
    { constexpr int l = 1;
        const int pb = 2 + l * NPL;
        const float lambda_init = l == 0 ? 0.2f : 0.35550906f;
        const float* xin = l == 0 ? x_in : XRES;
        if (IN(pb + 0)) REP(pb + 0) {
            pg8::Gemm g{H, WIN + (size_t)l * NINP * D, T, NINP, D}; pg8::StaticOrder S; S.init(T, NINP, F.G, (int)blockIdx.x);
            pg8::EpiIn E{RQ, RK, RVT, RG, BQKV, BZ, CQ, CK, CVT, GATES, BBA};
            pg8::gemm_phase<pg8::EpiIn, pg8::StaticOrder, true, true>(F.lds, g, S, E);
        }
        SEAM(pb + 0);
        if (IN(pb + 1)) REP(pb + 1) {
            const float* cw = conv_w + (size_t)l * 4 * 3072;
            for (int it = F.vcu; it < 1024; it += F.G) gdn_prep_item(F, l, it >> 5, it & 31, BQKV, BBA, cw, a_log, dt_bias, ws + WS_GCH + (size_t)it * GDN_CH_BYTES, (float*)(ws + WS_GL) + it);
        }
        SEAM(pb + 1);
        if (IN(pb + 2)) REP(pb + 2) {
            const int bx = F.vcu;
#ifndef PROBE_SCAN2
#define PROBE_SCAN2 1
#endif
#ifndef PROBE_FLASH2
#define PROBE_FLASH2 1
#endif
            if (bx < 32) { for (int rp = 0; rp < (l == 0 ? PROBE_SCAN2 : 1); ++rp) gdn_scan(F, bx, ws + WS_GCH, (const float*)(ws + WS_GL), OB); }
            else {
                for (int it = bx - 32; it < 1024 * (l == 0 ? PROBE_FLASH2 : 1); it += F.G - 32) {
                    const int qt = 15 - ((it & 1023) >> 6), kind = (it >> 5) & 1, hd = it & 31, b = hd >> 3, hm = hd & 7;
                    if (kind == 0) { const int hh = hm >> 1, m = hm & 1; const float slope = exp2f(-2.0f * (float)(hh + 1));
                        flash_item<256, true, false, false>(F, CQ + ((size_t)hd * SEQ + qt * 128) * 128, CK + (size_t)hd * SEQ * 128, CVT + (size_t)(b * 4 + hh) * 256 * SEQ, SEQ, qt * 128, SEQ, slope,
                                                            O12 + ((size_t)m * T + b * SEQ + qt * 128) * 1024 + hh * 256, nullptr, 1024); }
                    else { const float lg = log2f(1.0f - exp2f(-5.0f - (float)hm));
                        flash_item<128, true, false, true>(F, RQ + ((size_t)hd * SEQ + qt * 128) * 128, RK + (size_t)hd * SEQ * 128, RVT + (size_t)hd * 128 * SEQ, SEQ, qt * 128, SEQ, lg,
                                                           OA + ((size_t)(b * SEQ + qt * 128)) * 1024 + hm * 128, nullptr, 1024); }
                }
            }
        }
        SEAM(pb + 2);
        if (IN(pb + 3)) REP(pb + 3) {
            const int lane = F.lane;
            const float* lv = diff_lambda + (size_t)l * 512;
            const float d01 = wave_sum(lv[lane] * lv[128 + lane] + lv[64 + lane] * lv[192 + lane]), d23 = wave_sum(lv[256 + lane] * lv[384 + lane] + lv[320 + lane] * lv[448 + lane]);
            const float lam = __expf(d01) - __expf(d23) + lambda_init;
            for (int t = F.gw; t < T; t += F.NGW) {
#pragma unroll
                for (int h = 0; h < 8; ++h) { const size_t o = (size_t)t * 1024 + h * 128 + 2 * lane;
                    { const float a0 = OA[o], a1 = OA[o + 1]; const float mean = wave_sum(a0 + a1) * (1.f / 128.f); const float c0 = a0 - mean, c1 = a1 - mean; const float rstd = rsqrtf(wave_sum(c0 * c0 + c1 * c1) * (1.f / 128.f) + EPS);
                      const unsigned gv = *(const unsigned*)(RG + o); *(unsigned*)(OCAT + o) = pk2(c0 * rstd * bf2f(gv & 0xffffu), c1 * rstd * __uint_as_float(gv & 0xffff0000u)); }
                    { const float a0 = OB[o], a1 = OB[o + 1]; const float rstd = rsqrtf(wave_sum(a0 * a0 + a1 * a1) * (1.f / 128.f) + EPS); const unsigned gv = *(const unsigned*)(BZ + o);
                      *(unsigned*)(OCAT + (size_t)T * 1024 + o) = pk2(a0 * rstd * gdn_norm_w[l * 128 + 2 * lane] * bf2f(gv & 0xffffu), a1 * rstd * gdn_norm_w[l * 128 + 2 * lane + 1] * __uint_as_float(gv & 0xffff0000u)); } }
#pragma unroll
                for (int h = 0; h < 4; ++h) { const size_t o = (size_t)t * 1024 + h * 256 + 4 * lane; const f32x4 p = *(const f32x4*)(O12 + o), q = *(const f32x4*)(O12 + (size_t)T * 1024 + o); const f32x4 d = p - q * lam;
                    const float rstd = rsqrtf(wave_sum((d[0] * d[0] + d[1] * d[1]) + (d[2] * d[2] + d[3] * d[3])) * (1.f / 256.f) + EPS) * (1.0f - lambda_init); const f32x4 ww = *(const f32x4*)(diff_norm_w + l * 256 + 4 * lane);
                    v2u ov; ov.x = pk2(d[0] * rstd * ww[0], d[1] * rstd * ww[1]); ov.y = pk2(d[2] * rstd * ww[2], d[3] * rstd * ww[3]); *(v2u*)(OCAT + (size_t)2 * T * 1024 + o) = ov; }
            }
        }
        SEAM(pb + 3);
        if (IN(pb + 4)) REP(pb + 4) {
            for (int s = 0; s < 3; ++s) {
                pg8::Gemm g{OCAT + (size_t)s * T * 1024, WBR + ((size_t)l * 3 + s) * D * 1024, T, D, 1024}; pg8::StaticOrder S; S.init(T, D, F.G, (int)blockIdx.x);
                pg8::EpiBranch E{MERGE, MERGEB, GATES, s};
                pg8::gemm_phase<pg8::EpiBranch, pg8::StaticOrder, true, true>(F.lds, g, S, E);
            }
        }
        SEAM(pb + 4);
        if (IN(pb + 5)) REP(pb + 5) {
            pg8::Gemm g{MERGEB, WOUT + (size_t)l * D * D, T, D, D}; pg8::StaticOrder S; S.init(T, D, F.G, (int)blockIdx.x);
            pg8::EpiResid E{xin, XRES, D};
            pg8::gemm_phase<pg8::EpiResid, pg8::StaticOrder, true, true>(F.lds, g, S, E);
        }
        SEAM(pb + 5);
        if (IN(pb + 6)) REP(pb + 6) { for (int r = F.gw; r < T; r += F.NGW) rms_row(XRES + (size_t)r * D, cross_norm_w + l * D, H + (size_t)r * D, F.lane); }
        SEAM(pb + 6);
        if (IN(pb + 7)) REP(pb + 7) {
            pg8::Gemm g{H, WQ + (size_t)l * 512 * D, T, 512, D}; pg8::StaticOrder S; S.init(T, 512, F.G, (int)blockIdx.x);
            pg8::EpiHeads E{QX, nullptr, 4, 11, 1 << 20};
            pg8::gemm_phase<pg8::EpiHeads, pg8::StaticOrder, true, true>(F.lds, g, S, E);
        }
        SEAM(pb + 7);
        if (IN(pb + 8)) REP(pb + 8) {
            for (int it = F.vcu; it < 256; it += F.G) { const int hd = it >> 4, qt = it & 15, b = hd >> 2, hh = hd & 3;
                flash_item<128, false, true, false>(F, QX + ((size_t)hd * SEQ + qt * 128) * 128, KX + ((size_t)l * 16 + hd) * MEML * 128, VXT + ((size_t)l * 16 + hd) * 128 * MEML, MEML, qt * 128, MEML, 0.f,
                                             nullptr, OX + ((size_t)(b * SEQ + qt * 128)) * 512 + hh * 128, 512); }
        }
        SEAM(pb + 8);
        if (IN(pb + 9)) REP(pb + 9) {
            pg8::Gemm g{OX, WO + (size_t)l * D * 512, T, D, 512}; pg8::StaticOrder S; S.init(T, D, F.G, (int)blockIdx.x);
            pg8::EpiResid E{XRES, XRES, D};
            pg8::gemm_phase<pg8::EpiResid, pg8::StaticOrder, true, true>(F.lds, g, S, E);
        }
        SEAM(pb + 9);
        if (IN(pb + 10)) REP(pb + 10) {
            const int lane = F.lane; const float* w = ffn_norm_w + l * D;
            for (int r = F.gw; r < T; r += F.NGW) {
                const float* xrow = XRES + (size_t)r * D; f32x4 v[8]; float ss = 0.f;
#pragma unroll
                for (int j = 0; j < 8; ++j) { v[j] = *(const f32x4*)(xrow + 4 * (lane + 64 * j)); ss += (v[j][0] * v[j][0] + v[j][1] * v[j][1]) + (v[j][2] * v[j][2] + v[j][3] * v[j][3]); }
                const float rstd = rsqrtf(wave_sum(ss) * (1.f / D) + EPS);
                float lg[8];
#pragma unroll
                for (int e = 0; e < 8; ++e) lg[e] = 0.f;
#pragma unroll
                for (int j = 0; j < 8; ++j) { const f32x4 ww = *(const f32x4*)(w + 4 * (lane + 64 * j)); f32x4 y; y[0] = v[j][0] * rstd * ww[0]; y[1] = v[j][1] * rstd * ww[1]; y[2] = v[j][2] * rstd * ww[2]; y[3] = v[j][3] * rstd * ww[3];
                    v2u o; o.x = pk2(y[0], y[1]); o.y = pk2(y[2], y[3]); *(v2u*)(H + (size_t)r * D + 4 * (lane + 64 * j)) = o;
                    if (l == 1) {
#pragma unroll
                        for (int c = 0; c < 4; ++c) { const float* rw = router_w + (size_t)(4 * (lane + 64 * j) + c) * 8; const f32x4 r0 = *(const f32x4*)rw, r1 = *(const f32x4*)(rw + 4);
                            lg[0] += y[c] * r0[0]; lg[1] += y[c] * r0[1]; lg[2] += y[c] * r0[2]; lg[3] += y[c] * r0[3]; lg[4] += y[c] * r1[0]; lg[5] += y[c] * r1[1]; lg[6] += y[c] * r1[2]; lg[7] += y[c] * r1[3]; } } }
                if (l == 1) {
#pragma unroll
                    for (int e = 0; e < 8; ++e) lg[e] = wave_sum(lg[e]);
                    int e0 = 0; float v0 = lg[0];
#pragma unroll
                    for (int e = 1; e < 8; ++e) if (lg[e] > v0) { v0 = lg[e]; e0 = e; }
                    int e1 = -1; float v1 = -__builtin_inff();
#pragma unroll
                    for (int e = 0; e < 8; ++e) if (e != e0 && lg[e] > v1) { v1 = lg[e]; e1 = e; }
                    if (lane == 0) { const float p0 = 1.0f / (1.0f + __expf(v1 - v0)); int* ro = ROUTE + (size_t)r * 8;
                        ro[0] = e0; ro[1] = e1; ro[2] = (int)atomicAdd(ctl + CW_CNT + e0, 1u); ro[3] = (int)atomicAdd(ctl + CW_CNT + e1, 1u); ((float*)ro)[4] = p0; ((float*)ro)[5] = 1.0f - p0; }
                }
            }
        }
        SEAM(pb + 10);
        if (l == 0) {
            if (IN(pb + 11)) REP(pb + 11) {
                pg8::Gemm g{H, WGU, T, 2 * DFF, D}; pg8::StaticOrder S; S.init(T, 2 * DFF, F.G, (int)blockIdx.x);
                pg8::EpiSwiglu E{ACT, DFF, 1 << 20};
                pg8::gemm_phase<pg8::EpiSwiglu, pg8::StaticOrder, true, true>(F.lds, g, S, E);
            }
            SEAM(pb + 11);
            if (IN(pb + 12)) REP(pb + 12) {
                pg8::Gemm g{ACT, WDN, T, D, DFF}; pg8::StaticOrder S; S.init(T, D, F.G, (int)blockIdx.x);
                pg8::EpiResid E{XRES, XRES, D};
                pg8::gemm_phase<pg8::EpiResid, pg8::StaticOrder, true, true>(F.lds, g, S, E);
            }
            SEAM(pb + 12);
            if (IN(pb + 13)) REP(pb + 13) { for (int r = F.gw; r < T; r += F.NGW) rms_row(XRES + (size_t)r * D, mix_norm_w + D, H + (size_t)r * D, F.lane); }
            SEAM(pb + 13);
            SEAM(pb + 14);
        } else {
            int off[9]; off[0] = 0;
#pragma unroll
            for (int e = 0; e < 8; ++e) { const int c = (int)__hip_atomic_load(ctl + CW_CNT + e, __ATOMIC_RELAXED, __HIP_MEMORY_SCOPE_AGENT); off[e + 1] = off[e] + ((c + 255) & ~255); }
            if (IN(pb + 11)) REP(pb + 11) {
                for (int it = F.gw; it < T * 2; it += F.NGW) { const int t = it >> 1, k = it & 1; int* ro = ROUTE + (size_t)t * 8; const int e = ro[k], pos = ro[2 + k];
                    int base = 0;
#pragma unroll
                    for (int q = 0; q < 8; ++q) if (e == q) base = off[q];
                    const int slot = base + pos; if (F.lane == 0) ro[6 + k] = slot;
                    const v4u* src = (const v4u*)(H + (size_t)t * D); v4u* dst = (v4u*)(HG + (size_t)slot * D);
#pragma unroll
                    for (int j = 0; j < 4; ++j) dst[F.lane + 64 * j] = src[F.lane + 64 * j]; }
#pragma unroll
                for (int e = 0; e < 8; ++e) { const int c = (int)__hip_atomic_load(ctl + CW_CNT + e, __ATOMIC_RELAXED, __HIP_MEMORY_SCOPE_AGENT);
                    for (int rr = off[e] + c + F.gw; rr < off[e + 1]; rr += F.NGW) { v4u* dst = (v4u*)(HG + (size_t)rr * D);
#pragma unroll
                        for (int j = 0; j < 4; ++j) dst[F.lane + 64 * j] = (v4u){0u, 0u, 0u, 0u}; } }
            }
            SEAM(pb + 11);
            if (IN(pb + 12)) REP(pb + 12) {
                if (F.tid == 0) { int cu = 0;
#pragma unroll
                    for (int e = 0; e < 8; ++e) { const int ne = (off[e + 1] - off[e]) >> 8; MTAB[e] = ne; MTAB[8 + e] = off[e] >> 8; MTAB[16 + e] = cu; cu += ne * 56; } MTAB[24] = cu; MTAB[25] = cu; }
                __syncthreads();
                pg8::Gemm g{HG, WEGU, MAXSLOT, NEXP * 2 * EFF, D}; pg8::MoeOrder S{(const LAS int*)MTAB, 56, F.G, (int)blockIdx.x};
                pg8::EpiSwiglu E{EACT, EFF, 56};
                pg8::gemm_phase<pg8::EpiSwiglu, pg8::MoeOrder, true, true>(F.lds, g, S, E);
            }
            SEAM(pb + 12);
            if (IN(pb + 13)) REP(pb + 13) {
                __syncthreads();
                if (F.tid == 0) { int cu = 0;
#pragma unroll
                    for (int e = 0; e < 8; ++e) { const int ne = (off[e + 1] - off[e]) >> 8; MTAB[e] = ne; MTAB[8 + e] = off[e] >> 8; MTAB[16 + e] = cu; cu += ne * 8; } MTAB[24] = cu; MTAB[25] = cu; }
                __syncthreads();
                pg8::Gemm g{EACT, WEDN, MAXSLOT, NEXP * D, EFF}; pg8::MoeOrder S{(const LAS int*)MTAB, 8, F.G, (int)blockIdx.x};
                pg8::EpiStoreF32 E{Y, D, 8};
                pg8::gemm_phase<pg8::EpiStoreF32, pg8::MoeOrder, true, true>(F.lds, g, S, E);
            }
            SEAM(pb + 13);
            if (IN(pb + 14)) REP(pb + 14) {
                const int lane = F.lane;
                for (int r = F.gw; r < T; r += F.NGW) { const int* ro = ROUTE + (size_t)r * 8; const float p0 = ((const float*)ro)[4], p1 = ((const float*)ro)[5]; const float* y0 = Y + (size_t)ro[6] * D; const float* y1 = Y + (size_t)ro[7] * D;
                    const float* xrow = XRES + (size_t)r * D; f32x4 v[8]; float ss = 0.f;
#pragma unroll
                    for (int j = 0; j < 8; ++j) { const int o = 4 * (lane + 64 * j); v[j] = *(const f32x4*)(xrow + o) + *(const f32x4*)(y0 + o) * p0 + *(const f32x4*)(y1 + o) * p1; ss += (v[j][0] * v[j][0] + v[j][1] * v[j][1]) + (v[j][2] * v[j][2] + v[j][3] * v[j][3]); }
                    const float rstd = rsqrtf(wave_sum(ss) * (1.f / D) + EPS);
#pragma unroll
                    for (int j = 0; j < 8; ++j) { const int o = 4 * (lane + 64 * j); const f32x4 ww = *(const f32x4*)(final_norm_w + o); *(f32x4*)(args.out + (size_t)r * D + o) = v[j] * rstd * ww; } }
            }
        }
    }
#undef IN
#undef SEAM
}

extern "C" void kernel_launch(void* const* d_in, const int* in_sizes, int n_in, void* d_out, int out_size, void* d_ws, size_t ws_size, hipStream_t stream) {
    static int grid = 0;
    if (grid == 0) {
        if (n_in != 24 || out_size != T * D || ws_size < WS_END) { fprintf(stderr, "kernel_launch: unexpected shapes (n_in %d, out %d, ws %zu < %zu)\n", n_in, out_size, ws_size, (size_t)WS_END); grid = -1; return; }
        int dev = 0, cus = 0, per_cu = 0;
        if (hipGetDevice(&dev) != hipSuccess || hipDeviceGetAttribute(&cus, hipDeviceAttributeMultiprocessorCount, dev) != hipSuccess) { grid = -1; return; }
        if (hipFuncSetAttribute((const void*)mk_fwd, hipFuncAttributeMaxDynamicSharedMemorySize, LDS_BYTES) != hipSuccess) { fprintf(stderr, "kernel_launch: hipFuncSetAttribute failed\n"); grid = -1; return; }
        if (hipOccupancyMaxActiveBlocksPerMultiprocessor(&per_cu, (const void*)mk_fwd, NWAVES * 64, LDS_BYTES) != hipSuccess || per_cu < 1) fprintf(stderr, "kernel_launch: occupancy query says %d\n", per_cu);
        (void)hipGetLastError();
        grid = cus;
    }
    if (grid < 0) return;
    (void)hipMemsetAsync((char*)d_ws + WS_CTL, 0, CTL_BYTES, stream);
    Args a{};
    for (int i = 0; i < 24; ++i) a.in[i] = d_in[i];
    a.out = (float*)d_out; a.ws = (unsigned char*)d_ws;
#if MK_ONE_LAUNCH
    a.ph_lo = 0; a.ph_hi = NPH;
    hipLaunchKernelGGL(mk_fwd, dim3(grid), dim3(NWAVES * 64), LDS_BYTES, stream, a);
#else
    for (int p = 0; p < NPH; ++p) { a.ph_lo = p; a.ph_hi = p + 1; hipLaunchKernelGGL(mk_fwd, dim3(grid), dim3(NWAVES * 64), LDS_BYTES, stream, a); }
#endif
}
```

```cpp
#include <hip/hip_runtime.h>
#include <cstdio>
#include <cstdint>
#define MK_ONE_LAUNCH 1
namespace pg8 {
#define PG8_LAS __attribute__((address_space(3)))
typedef unsigned short bf16_t;
typedef short bf16x8 __attribute__((ext_vector_type(8)));
typedef float f32x4 __attribute__((ext_vector_type(4)));
typedef unsigned u32x4 __attribute__((ext_vector_type(4)));
typedef int i32x4 __attribute__((ext_vector_type(4)));
constexpr int BM = 256, BK = 64, HALF = 128, HTB = HALF * BK * 2  , STAGE_BYTES = 8 * HTB, NXCD = 8, WGM = 8;

__host__ __device__ __forceinline__ int lds_byte(int r, int c) { const int st = (r >> 4) * 2 + (c >> 5), rr = r & 15, cc = c & 31, ob = rr * 64 + cc * 2; return st * 1024 + (ob ^ (((ob >> 9) & 1) << 5)); }
__host__ __device__ __forceinline__ void stage_rc(int b, int& R, int& C) { const int st = b / 1024, sb = b % 1024, swz = sb ^ (((sb >> 9) & 1) << 5); R = (st >> 1) * 16 + swz / 64; C = (st & 1) * 32 + (swz % 64) / 2; }
__host__ __device__ __forceinline__ int perm32(int rho) { const int n = rho >> 4, i = rho & 15; return 8 * (i >> 2) + 4 * n + (i & 3); }

struct Unit { int pm, pn; };
struct Gemm { const bf16_t* A; const bf16_t* Bt; int M, N, K; };

struct StaticOrder {
    int nM, nN, nwg, G, c;
    __host__ __device__ void init(int M, int N, int G_, int c_) { nM = M / BM; nN = N / BM; nwg = nM * nN; G = G_; c = c_; }
    __host__ __device__ bool next(int i, Unit& u) const {
        const long L = (long)i * G + c; if (L >= nwg) return false;
        int wgid = (int)L; { const int q = nwg / NXCD, r = nwg % NXCD, xcd = wgid % NXCD, off = wgid / NXCD; wgid = (xcd < r ? xcd * (q + 1) : r * (q + 1) + (xcd - r) * q) + off; }
        const int nig = WGM * nN, gid = wgid / nig, fm = gid * WGM, gsz = (nM - fm) < WGM ? (nM - fm) : WGM;
        u.pm = fm + ((wgid % nig) % gsz); u.pn = (wgid % nig) / gsz; return true;
    }
    __device__ __forceinline__ void a_ready(const Unit&) const {}
    __device__ __forceinline__ void done(const Unit&) const {}
};

__device__ __forceinline__ unsigned cvt_pk_bf16(float lo, float hi) { unsigned r; asm volatile("v_cvt_pk_bf16_f32 %0, %1, %2" : "=v"(r) : "v"(lo), "v"(hi)); return r; }
typedef float f32x2 __attribute__((ext_vector_type(2)));
__device__ __forceinline__ float fsilu(float v) { return v / (1.0f + __expf(-v)); }
__device__ __forceinline__ float fsigm(float v) { return 1.0f / (1.0f + __expf(-v)); }
__device__ __forceinline__ void st8bf(bf16_t* p, f32x4 v0, f32x4 v1) { u32x4 w; w.x = cvt_pk_bf16(v0[0], v0[1]); w.y = cvt_pk_bf16(v0[2], v0[3]); w.z = cvt_pk_bf16(v1[0], v1[1]); w.w = cvt_pk_bf16(v1[2], v1[3]); *(u32x4*)p = w; }
__device__ __forceinline__ bf16_t f2bf1(float f) { unsigned u = __builtin_bit_cast(unsigned, f); return (bf16_t)((u + 0x7fffu + ((u >> 16) & 1u)) >> 16); }

struct EpiIn {
    static constexpr bool PERM = true, AFTER_DRAIN = false;
    bf16_t *RQ, *RK, *RVT, *RG, *BQKV, *BZ, *CQ, *CK, *CVT, *GATES; float* BBA;
    __device__ __forceinline__ void operator()(const f32x4 (&acc)[2][2][4][2], const Unit& u, int wr, int wc, int fr, int fq) const {
        const int pn = u.pn, b = u.pm >> 3;
        const int rowt = u.pm * BM + wr * 64 + fr;
        const int cin = wc * 32 + 8 * fq;
        if (pn < 8 || (pn >= 32 && pn < 40)) {
            auto heads = [&](bf16_t* base, int hb, float sc) __attribute__((always_inline)) {
#pragma unroll
                for (int ai = 0; ai < 2; ++ai)
#pragma unroll
                    for (int m = 0; m < 4; ++m) { const int s = (rowt + ai * HALF + m * 16) - b * 2048;
#pragma unroll
                        for (int bj = 0; bj < 2; ++bj) st8bf(base + ((size_t)((b * 8 + hb + bj) * 2048 + s)) * 128 + cin, acc[ai][bj][m][0] * sc, acc[ai][bj][m][1] * sc); } };
            if (pn < 4) heads(RQ, pn * 2, 1.f); else if (pn < 8) heads(RK, (pn - 4) * 2, 0.08838834764831845f);
            else if (pn < 36) heads(CQ, (pn - 32) * 2, 1.f); else heads(CK, (pn - 36) * 2, 1.f);
        } else if ((pn >= 40 && pn < 44) || (pn >= 8 && pn < 12)) {
            const bool isr = pn < 12; const int h = isr ? pn - 8 : pn - 40; bf16_t* CVT = isr ? RVT : this->CVT;
#pragma unroll
            for (int ai = 0; ai < 2; ++ai)
#pragma unroll
                for (int m = 0; m < 4; ++m) { const int s = (rowt + ai * HALF + m * 16) - b * 2048;
#pragma unroll
                    for (int bj = 0; bj < 2; ++bj)
#pragma unroll
                        for (int n = 0; n < 2; ++n)
#pragma unroll
                            for (int e = 0; e < 4; ++e) CVT[((size_t)((b * 4 + h) * 256 + bj * HALF + cin + 4 * n + e)) * 2048 + s] = f2bf1(acc[ai][bj][m][n][e]); }
        } else if (pn == 68) {
            if (wc == 0 && fq < 2) {
#pragma unroll
                for (int ai = 0; ai < 2; ++ai)
#pragma unroll
                    for (int m = 0; m < 4; ++m) { float* p = BBA + (size_t)(rowt + ai * HALF + m * 16) * 16 + 8 * fq; *(f32x4*)p = acc[ai][0][m][0]; *(f32x4*)(p + 4) = acc[ai][0][m][1]; }
            }
        } else {
            auto rows = [&](bf16_t* base, int ldc, int c0, int act) __attribute__((always_inline)) {
#pragma unroll
                for (int ai = 0; ai < 2; ++ai)
#pragma unroll
                    for (int m = 0; m < 4; ++m) { bf16_t* rowp = base + (size_t)(rowt + ai * HALF + m * 16) * ldc + c0 + cin;
#pragma unroll
                        for (int bj = 0; bj < 2; ++bj) { f32x4 v0 = acc[ai][bj][m][0], v1 = acc[ai][bj][m][1];
                            if (act == 1) {
#pragma unroll
                                for (int e = 0; e < 4; ++e) { v0[e] = fsilu(v0[e]); v1[e] = fsilu(v1[e]); } }
                            else if (act == 2) {
#pragma unroll
                                for (int e = 0; e < 4; ++e) { v0[e] = fsigm(v0[e]); v1[e] = fsigm(v1[e]); } }
                            st8bf(rowp + bj * HALF, v0, v1); } } };
            if (pn < 16) rows(RG, 1024, (pn - 12) * 256, 1); else if (pn < 28) rows(BQKV, 3072, (pn - 16) * 256, 0);
            else if (pn < 32) rows(BZ, 1024, (pn - 28) * 256, 1); else rows(GATES, 6144, (pn - 44) * 256, 2);
        }
    }
};

struct EpiHeads {
    static constexpr bool PERM = true, AFTER_DRAIN = false;
    bf16_t* O; bf16_t* VT; int NH, rpb_shift  , vt_from_pn;
    __device__ __forceinline__ void operator()(const f32x4 (&acc)[2][2][4][2], const Unit& u, int wr, int wc, int fr, int fq) const {
        const int rowt = u.pm * BM + wr * 64 + fr, cin = wc * 32 + 8 * fq, rpb = 1 << rpb_shift;
        if (u.pn < vt_from_pn) {
#pragma unroll
            for (int ai = 0; ai < 2; ++ai)
#pragma unroll
                for (int m = 0; m < 4; ++m) { const int row = rowt + ai * HALF + m * 16, b = row >> rpb_shift, s = row & (rpb - 1);
#pragma unroll
                    for (int bj = 0; bj < 2; ++bj) st8bf(O + ((size_t)((b * NH + u.pn * 2 + bj) * rpb + s)) * 128 + cin, acc[ai][bj][m][0], acc[ai][bj][m][1]); }
        } else {
            const int hb = (u.pn - vt_from_pn) * 2;
#pragma unroll
            for (int ai = 0; ai < 2; ++ai)
#pragma unroll
                for (int m = 0; m < 4; ++m) { const int row = rowt + ai * HALF + m * 16, b = row >> rpb_shift, s = row & (rpb - 1);
#pragma unroll
                    for (int bj = 0; bj < 2; ++bj)
#pragma unroll
                        for (int n = 0; n < 2; ++n)
#pragma unroll
                            for (int e = 0; e < 4; ++e) VT[((size_t)((b * NH + hb + bj) * 128 + cin + 4 * n + e)) * rpb + s] = f2bf1(acc[ai][bj][m][n][e]); }
        }
    }
};

struct EpiResid {
    static constexpr bool PERM = false, AFTER_DRAIN = false;
    const float* in; float* out; int ldc;
    __device__ __forceinline__ void operator()(const f32x4 (&acc)[2][2][4][2], const Unit& u, int wr, int wc, int fr, int fq) const {
        const int row0 = u.pm * BM + wr * 64 + fr, col0 = u.pn * BM + wc * 32 + 4 * fq;
#pragma unroll
        for (int ai = 0; ai < 2; ++ai)
#pragma unroll
            for (int m = 0; m < 4; ++m) { const size_t off = (size_t)(row0 + ai * HALF + m * 16) * ldc + col0;
#pragma unroll
                for (int bj = 0; bj < 2; ++bj)
#pragma unroll
                    for (int n = 0; n < 2; ++n) { const f32x4 x = *(const f32x4*)(in + off + bj * HALF + n * 16); *(f32x4*)(out + off + bj * HALF + n * 16) = x + acc[ai][bj][m][n]; } }
    }
};

struct EpiBranch {
    static constexpr bool PERM = false, AFTER_DRAIN = false;
    float* M; bf16_t* OUT; const bf16_t* GATES; int seg;
    __device__ __forceinline__ void operator()(const f32x4 (&acc)[2][2][4][2], const Unit& u, int wr, int wc, int fr, int fq) const {
        typedef unsigned u32x2 __attribute__((ext_vector_type(2)));
        const int row0 = u.pm * BM + wr * 64 + fr, col0 = u.pn * BM + wc * 32 + 4 * fq;
#pragma unroll
        for (int ai = 0; ai < 2; ++ai)
#pragma unroll
            for (int m = 0; m < 4; ++m) { const int row = row0 + ai * HALF + m * 16;
#pragma unroll
                for (int bj = 0; bj < 2; ++bj)
#pragma unroll
                    for (int n = 0; n < 2; ++n) { const int col = col0 + bj * HALF + n * 16; const size_t off = (size_t)row * 2048 + col;
                        const u32x2 gw = *(const u32x2*)(GATES + (size_t)row * 6144 + seg * 2048 + col);
                        f32x4 g; g[0] = __uint_as_float(gw.x << 16); g[1] = __uint_as_float(gw.x & 0xffff0000u); g[2] = __uint_as_float(gw.y << 16); g[3] = __uint_as_float(gw.y & 0xffff0000u);
                        f32x4 v = g * acc[ai][bj][m][n];
                        if (seg > 0) v = v + *(const f32x4*)(M + off);
                        if (seg < 2) *(f32x4*)(M + off) = v;
                        else { u32x2 w; w.x = cvt_pk_bf16(v[0], v[1]); w.y = cvt_pk_bf16(v[2], v[3]); *(u32x2*)(OUT + off) = w; } } }
    }
};

struct EpiSwiglu {
    static constexpr bool PERM = true, AFTER_DRAIN = false;
    bf16_t* O; int ldc, npn;
    __device__ __forceinline__ void operator()(const f32x4 (&acc)[2][2][4][2], const Unit& u, int wr, int wc, int fr, int fq) const {
        const int row0 = u.pm * BM + wr * 64 + fr, col0 = (u.pn % npn) * HALF + wc * 32 + 8 * fq;
#pragma unroll
        for (int ai = 0; ai < 2; ++ai)
#pragma unroll
            for (int m = 0; m < 4; ++m) { f32x4 v0, v1;
#pragma unroll
                for (int e = 0; e < 4; ++e) { v0[e] = fsilu(acc[ai][0][m][0][e]) * acc[ai][1][m][0][e]; v1[e] = fsilu(acc[ai][0][m][1][e]) * acc[ai][1][m][1][e]; }
                st8bf(O + (size_t)(row0 + ai * HALF + m * 16) * ldc + col0, v0, v1); }
    }
};


__device__ __forceinline__ float clamp8(float v) { return __builtin_fminf(__builtin_fmaxf(v, -448.f), 448.f); }
__device__ __forceinline__ unsigned pk4_fp8(float a, float b, float c, float d) { int r = 0; r = __builtin_amdgcn_cvt_pk_fp8_f32(clamp8(a), clamp8(b), r, false); r = __builtin_amdgcn_cvt_pk_fp8_f32(clamp8(c), clamp8(d), r, true); return (unsigned)r; }
struct EpiSwiglu8 {
    static constexpr bool PERM = true, AFTER_DRAIN = false;
    unsigned char* O; int ldc, npn; float ws, as;
    __device__ __forceinline__ void operator()(const f32x4 (&acc)[2][2][4][2], const Unit& u, int wr, int wc, int fr, int fq) const {
        typedef unsigned u32x2 __attribute__((ext_vector_type(2)));
        const int row0 = u.pm * BM + wr * 64 + fr, col0 = (u.pn % npn) * HALF + wc * 32 + 8 * fq;
#pragma unroll
        for (int ai = 0; ai < 2; ++ai)
#pragma unroll
            for (int m = 0; m < 4; ++m) { float v[8];
#pragma unroll
                for (int n = 0; n < 2; ++n)
#pragma unroll
                    for (int e = 0; e < 4; ++e) v[4 * n + e] = fsilu(acc[ai][0][m][n][e] * ws) * (acc[ai][1][m][n][e] * ws) * as;
                u32x2 o; o.x = pk4_fp8(v[0], v[1], v[2], v[3]); o.y = pk4_fp8(v[4], v[5], v[6], v[7]);
                *(u32x2*)(O + (size_t)(row0 + ai * HALF + m * 16) * ldc + col0) = o; }
    }
};

struct EpiStoreF32 {
    static constexpr bool PERM = false, AFTER_DRAIN = false;
    float* Y; int ldc, npn; float sc;
    __device__ __forceinline__ void operator()(const f32x4 (&acc)[2][2][4][2], const Unit& u, int wr, int wc, int fr, int fq) const {
        const int row0 = u.pm * BM + wr * 64 + fr, col0 = (u.pn % npn) * BM + wc * 32 + 4 * fq;
#pragma unroll
        for (int ai = 0; ai < 2; ++ai)
#pragma unroll
            for (int m = 0; m < 4; ++m) { float* rowp = Y + (size_t)(row0 + ai * HALF + m * 16) * ldc + col0;
#pragma unroll
                for (int bj = 0; bj < 2; ++bj)
#pragma unroll
                    for (int n = 0; n < 2; ++n) *(f32x4*)(rowp + bj * HALF + n * 16) = acc[ai][bj][m][n] * sc; }
    }
};

struct MoeOrder {
    const PG8_LAS int* T; int npn, G, c;
    __device__ __forceinline__ int rd(int k) const { return __builtin_amdgcn_readfirstlane(T[k]); }
    __device__ __forceinline__ bool next(int i, Unit& u) const {
        const int total = rd(25); const long L = (long)i * G + c; if (L >= total) return false;
        int wgid = (int)L; { const int q = total / NXCD, r = total % NXCD, xcd = wgid % NXCD, off = wgid / NXCD; wgid = (xcd < r ? xcd * (q + 1) : r * (q + 1) + (xcd - r) * q) + off; }
        int e = 0, cue = 0;
#pragma unroll
        for (int k = 1; k < 8; ++k) { const int ck = rd(16 + k); if (wgid >= ck) { e = k; cue = ck; } }
        const int loc = wgid - cue, ne = rd(e), r0 = rd(8 + e);
        u.pm = r0 + loc % ne; u.pn = e * npn + loc / ne; return true;
    }
    __device__ __forceinline__ void a_ready(const Unit&) const {}
    __device__ __forceinline__ void done(const Unit&) const {}
};
template <class Epi, class Sched, bool ALIGN_EPI = false, bool SP2 = false, bool F8 = false>
__device__ __forceinline__ void gemm_phase(PG8_LAS unsigned char* lds, const Gemm g, const Sched& S, const Epi& E) {
    int tid_ = threadIdx.x; asm volatile("" : "+v"(tid_)); const int tid = tid_, wid = __builtin_amdgcn_readfirstlane(tid >> 6), lane = tid & 63, wr = wid >> 2, wc = wid & 3, fr = lane & 15, fq = lane >> 4;
    const int K = g.K, nt = K / BK; typedef int i32x8 __attribute__((ext_vector_type(8))); int f8scale_ = 0x7f7f7f7f; asm volatile("" : "+v"(f8scale_));
    unsigned voffA[2], voffB[2];
#pragma unroll
    for (int i = 0; i < 2; ++i) { int R, C; stage_rc(tid * 16 + i * 8192, R, C); const int Rb = Epi::PERM ? ((R & ~31) + perm32(R & 31)) : R;
        voffA[i] = (unsigned)(R * K + C) * 2u; voffB[i] = (unsigned)(Rb * K + C) * 2u; }
    const size_t kstep = (size_t)(BK * 2);
    const size_t hstep = (size_t)HALF * K * 2;
    const size_t tstep = 2 * hstep;
    const unsigned ldsw = (unsigned)wid * 1024u;
    const int aoff = lds_byte(wr * 64 + fr, fq * 8), boff = lds_byte(wc * 32 + fr, fq * 8);
#define PG8_SA(b, h) (((b) * 2 + (h)) * HTB)
#define PG8_SB(b, h) ((4 + (b) * 2 + (h)) * HTB)
#define PG8_STAGE(bufoff, gbase, voff) do { _Pragma("unroll") for (int _i = 0; _i < 2; ++_i) \
        __builtin_amdgcn_global_load_lds((const unsigned*)((const char*)(gbase) + (voff)[_i]), (PG8_LAS unsigned*)(lds + (bufoff) + ldsw + _i * 8192), 16, 0, 0); } while (0)
#define PG8_LDA(dst, b, h) do { _Pragma("unroll") for (int m = 0; m < 4; ++m) _Pragma("unroll") for (int k = 0; k < 2; ++k) dst[m][k] = *(const PG8_LAS bf16x8*)(lds + PG8_SA(b, h) + aoff + m * 2048 + k * 1024); } while (0)
#define PG8_LDB(dst, b, h) do { _Pragma("unroll") for (int n = 0; n < 2; ++n) _Pragma("unroll") for (int k = 0; k < 2; ++k) dst[n][k] = *(const PG8_LAS bf16x8*)(lds + PG8_SB(b, h) + boff + n * 2048 + k * 1024); } while (0)
#define PG8_MMA(ai, bj, At, Bt) do { __builtin_amdgcn_s_setprio(1); \
        if constexpr (F8) { _Pragma("unroll") for (int m = 0; m < 4; ++m) _Pragma("unroll") for (int n = 0; n < 2; ++n) { \
            const i32x4 b0_ = __builtin_bit_cast(i32x4, Bt[n][0]), b1_ = __builtin_bit_cast(i32x4, Bt[n][1]), a0_ = __builtin_bit_cast(i32x4, At[m][0]), a1_ = __builtin_bit_cast(i32x4, At[m][1]); \
            const i32x8 bb_ = __builtin_shufflevector(b0_, b1_, 0, 1, 2, 3, 4, 5, 6, 7), aa_ = __builtin_shufflevector(a0_, a1_, 0, 1, 2, 3, 4, 5, 6, 7); \
            asm volatile("v_mfma_scale_f32_16x16x128_f8f6f4 %0, %1, %2, %0, %3, %3 op_sel_hi:[0,0,0]" : "+v"(acc[ai][bj][m][n]) : "v"(bb_), "v"(aa_), "v"(f8scale_)); } } \
        else { _Pragma("unroll") for (int m = 0; m < 4; ++m) _Pragma("unroll") for (int n = 0; n < 2; ++n) _Pragma("unroll") for (int k = 0; k < 2; ++k) \
        acc[ai][bj][m][n] = __builtin_amdgcn_mfma_f32_16x16x32_bf16(Bt[n][k], At[m][k], acc[ai][bj][m][n], 0, 0, 0); } __builtin_amdgcn_s_setprio(0); } while (0)
#define PG8_WAIT_V(n) asm volatile("s_waitcnt vmcnt(" #n ")" ::: "memory")
#define PG8_WAIT_L(n) asm volatile("s_waitcnt lgkmcnt(" #n ")" ::: "memory")
#define PG8_BAR __builtin_amdgcn_s_barrier()
#define PG8_SCHED __builtin_amdgcn_sched_barrier(0)
    Unit cur, nxt; int ui = 0;
    if (!S.next(0, cur)) return;
    f32x4 acc[2][2][4][2];
#pragma unroll
    for (int a = 0; a < 2; ++a)
#pragma unroll
        for (int b = 0; b < 2; ++b)
#pragma unroll
            for (int m = 0; m < 4; ++m)
#pragma unroll
                for (int n = 0; n < 2; ++n) acc[a][b][m][n] = (f32x4){0.f, 0.f, 0.f, 0.f};
    bf16x8 At[4][2], B0[2][2], B1[2][2];
    const char* cA = (const char*)g.A + (size_t)cur.pm * tstep; const char* cB = (const char*)g.Bt + (size_t)cur.pn * tstep;
    S.a_ready(cur);
    if constexpr (SP2) {
        PG8_STAGE(PG8_SB(0, 0), cB, voffB); PG8_STAGE(PG8_SB(0, 1), cB + hstep, voffB); PG8_STAGE(PG8_SA(0, 0), cA, voffA); PG8_STAGE(PG8_SA(0, 1), cA + hstep, voffA);
        if (wr == 1) PG8_BAR;
        PG8_WAIT_V(2); PG8_BAR;
        PG8_STAGE(PG8_SB(1, 0), cB + kstep, voffB); PG8_STAGE(PG8_SA(1, 0), cA + kstep, voffA); PG8_STAGE(PG8_SB(1, 1), cB + hstep + kstep, voffB);
        PG8_WAIT_V(6); PG8_BAR;
    } else {
        PG8_STAGE(PG8_SB(0, 0), cB, voffB); PG8_STAGE(PG8_SA(0, 0), cA, voffA); PG8_STAGE(PG8_SB(0, 1), cB + hstep, voffB); PG8_STAGE(PG8_SA(0, 1), cA + hstep, voffA);
        if (wr == 1) PG8_BAR;
        PG8_WAIT_V(4); PG8_BAR;
        PG8_STAGE(PG8_SB(1, 0), cB + kstep, voffB); PG8_STAGE(PG8_SA(1, 0), cA + kstep, voffA); PG8_STAGE(PG8_SB(1, 1), cB + hstep + kstep, voffB);
        PG8_WAIT_V(6); PG8_BAR;
    }
    for (;;) {
        const bool has_next = S.next(ui + 1, nxt);
        const char* nA = has_next ? (const char*)g.A + (size_t)nxt.pm * tstep : cA; const char* nB = has_next ? (const char*)g.Bt + (size_t)nxt.pn * tstep : cB;
        for (int t = 0; t < nt; t += 2) {
            const bool last = (t == nt - 2);
            const char* a1 = cA + (size_t)(t + 1) * kstep;
            const char* a2 = last ? nA : cA + (size_t)(t + 2) * kstep; const char* b2 = last ? nB : cB + (size_t)(t + 2) * kstep;
            const char* a3 = a2 + kstep; const char* b3 = b2 + kstep;
            if (last && has_next) S.a_ready(nxt);
            if constexpr (SP2) {
            PG8_LDB(B0, 0, 0); PG8_LDB(B1, 0, 1); PG8_SCHED; PG8_LDA(At, 0, 0); PG8_STAGE(PG8_SA(1, 1), a1 + hstep, voffA);
            PG8_WAIT_V(8); PG8_WAIT_L(0); PG8_BAR; PG8_MMA(0, 0, At, B0); PG8_MMA(0, 1, At, B1); PG8_BAR; PG8_SCHED;
            PG8_LDA(At, 0, 1); PG8_STAGE(PG8_SB(0, 0), b2, voffB); PG8_STAGE(PG8_SB(0, 1), b2 + hstep, voffB); PG8_STAGE(PG8_SA(0, 0), a2, voffA);
            PG8_WAIT_V(8); PG8_WAIT_L(0); PG8_BAR; PG8_MMA(1, 0, At, B0); PG8_MMA(1, 1, At, B1); PG8_BAR; PG8_SCHED;
            PG8_LDB(B0, 1, 0); PG8_LDB(B1, 1, 1); PG8_SCHED; PG8_LDA(At, 1, 0); PG8_STAGE(PG8_SA(0, 1), a2 + hstep, voffA);
            PG8_WAIT_V(8); PG8_WAIT_L(0); PG8_BAR; PG8_MMA(0, 0, At, B0); PG8_MMA(0, 1, At, B1); PG8_BAR; PG8_SCHED;
            PG8_LDA(At, 1, 1); PG8_STAGE(PG8_SB(1, 0), b3, voffB); PG8_STAGE(PG8_SB(1, 1), b3 + hstep, voffB); PG8_STAGE(PG8_SA(1, 0), a3, voffA);
            PG8_WAIT_V(8); PG8_WAIT_L(0); PG8_BAR; PG8_MMA(1, 0, At, B0); PG8_MMA(1, 1, At, B1); PG8_BAR; PG8_SCHED;
            } else {
            PG8_LDB(B0, 0, 0); PG8_SCHED; PG8_LDA(At, 0, 0); PG8_STAGE(PG8_SA(1, 1), a1 + hstep, voffA);
            PG8_WAIT_L(8); PG8_BAR; PG8_WAIT_L(0); PG8_MMA(0, 0, At, B0); PG8_BAR; PG8_SCHED;
            PG8_LDB(B1, 0, 1); PG8_STAGE(PG8_SB(0, 0), b2, voffB);
            PG8_BAR; PG8_WAIT_L(0); PG8_MMA(0, 1, At, B1); PG8_BAR;
            PG8_LDA(At, 0, 1); PG8_STAGE(PG8_SA(0, 0), a2, voffA);
            PG8_BAR; PG8_WAIT_L(0); PG8_MMA(1, 0, At, B0); PG8_BAR; PG8_SCHED;
            PG8_STAGE(PG8_SB(0, 1), b2 + hstep, voffB);
            PG8_WAIT_V(6); PG8_BAR; PG8_MMA(1, 1, At, B1); PG8_BAR;
            PG8_LDB(B0, 1, 0); PG8_SCHED; PG8_LDA(At, 1, 0); PG8_STAGE(PG8_SA(0, 1), a2 + hstep, voffA);
            PG8_WAIT_L(8); PG8_BAR; PG8_WAIT_L(0); PG8_MMA(0, 0, At, B0); PG8_BAR; PG8_SCHED;
            PG8_LDB(B1, 1, 1); PG8_STAGE(PG8_SB(1, 0), b3, voffB);
            PG8_BAR; PG8_WAIT_L(0); PG8_MMA(0, 1, At, B1); PG8_BAR;
            PG8_LDA(At, 1, 1); PG8_STAGE(PG8_SA(1, 0), a3, voffA);
            PG8_BAR; PG8_WAIT_L(0); PG8_MMA(1, 0, At, B0); PG8_BAR; PG8_SCHED;
            PG8_STAGE(PG8_SB(1, 1), b3 + hstep, voffB);
            PG8_WAIT_V(6); PG8_BAR; PG8_MMA(1, 1, At, B1); PG8_BAR;
            }
        }
        if constexpr (ALIGN_EPI) { if (wr == 0) PG8_BAR; }
        if constexpr (F8) asm volatile("s_nop 15\n\ts_nop 15" ::: "memory");
        if constexpr (!Epi::AFTER_DRAIN) { E(acc, cur, wr, wc, fr, fq); S.done(cur); }
        if (!has_next) break;
#pragma unroll
        for (int a = 0; a < 2; ++a)
#pragma unroll
            for (int b = 0; b < 2; ++b)
#pragma unroll
                for (int m = 0; m < 4; ++m)
#pragma unroll
                    for (int n = 0; n < 2; ++n) acc[a][b][m][n] = (f32x4){0.f, 0.f, 0.f, 0.f};
        cur = nxt; cA = nA; cB = nB; ++ui;
        if constexpr (ALIGN_EPI) { if (wr == 1) PG8_BAR; }
    }
    PG8_WAIT_V(0);
    if constexpr (!ALIGN_EPI) { if (wr == 0) PG8_BAR; }
    PG8_BAR;
    if constexpr (Epi::AFTER_DRAIN) { E.fused(acc, cur, wr, wc, fr, fq, lds, wid, lane); S.done(cur); }
#undef PG8_SA
#undef PG8_SB
#undef PG8_STAGE
#undef PG8_LDA
#undef PG8_LDB
#undef PG8_MMA
#undef PG8_WAIT_V
#undef PG8_WAIT_L
#undef PG8_BAR
#undef PG8_SCHED
}
}
#ifndef MK_ONE_LAUNCH
#define MK_ONE_LAUNCH 0
#endif
constexpr int NWAVES = 8;
constexpr int NB = 4, SEQ = 2048, T = NB * SEQ, D = 2048, MEML = 256, MEMR = NB * MEML;
constexpr int NINP = 17664;
constexpr int DFF = 5632, EFF = 7168, NEXP = 8, MAXSLOT = 18432;
constexpr float EPS = 1e-6f;
constexpr int NPL = 15, NPH = 2 + 2 * NPL;

constexpr size_t MiB = 1u << 20;
constexpr size_t WS_CTL = 0, CTL_BYTES = 1 * MiB;
constexpr size_t WS_WIN = WS_CTL + CTL_BYTES;
constexpr size_t WS_WBR = WS_WIN + 2 * 69 * MiB;
constexpr size_t WS_WOUT = WS_WBR + 2 * 12 * MiB;
constexpr size_t WS_WQ = WS_WOUT + 2 * 8 * MiB;
constexpr size_t WS_WKV = WS_WQ + 2 * 2 * MiB;
constexpr size_t WS_WO = WS_WKV + 2 * 4 * MiB;
constexpr size_t WS_WGU = WS_WO + 2 * 2 * MiB;
constexpr size_t WS_WDN = WS_WGU + 44 * MiB;
constexpr size_t WS_WEGU = WS_WDN + 22 * MiB;
constexpr size_t WS_WEDN = WS_WEGU + 448 * MiB;
constexpr size_t WS_XRES = WS_WEDN + 224 * MiB;
constexpr size_t WS_H = WS_XRES + 64 * MiB;
constexpr size_t WS_RQ = WS_H + 32 * MiB, WS_RK = WS_RQ + 16 * MiB, WS_RV = WS_RK + 16 * MiB, WS_RG = WS_RV + 16 * MiB;
constexpr size_t WS_BQKV = WS_RG + 16 * MiB;
constexpr size_t WS_BZ = WS_BQKV + 48 * MiB;
constexpr size_t WS_BBA = WS_BZ + 16 * MiB;
constexpr size_t WS_CQ = WS_BBA + 1 * MiB, WS_CK = WS_CQ + 16 * MiB, WS_CVT = WS_CK + 16 * MiB;
constexpr size_t WS_GATES = WS_CVT + 16 * MiB;
constexpr size_t WS_GQ = WS_GATES + 96 * MiB, WS_GK = WS_GQ + 16 * MiB, WS_GV = WS_GK + 16 * MiB;
constexpr size_t WS_GG = WS_GV + 16 * MiB, WS_GB = WS_GG + 1 * MiB;
constexpr size_t WS_OA = WS_GB + 1 * MiB, WS_OB = WS_OA + 32 * MiB;
constexpr size_t WS_O12 = WS_OB + 32 * MiB;
constexpr size_t WS_OCAT = WS_O12 + 64 * MiB;
constexpr size_t WS_MERGE = WS_OCAT + 48 * MiB;
constexpr size_t WS_MERGEB = WS_MERGE + 64 * MiB;
constexpr size_t WS_MEMN = WS_MERGEB + 32 * MiB;
constexpr size_t WS_KX = WS_MEMN + 8 * MiB;
constexpr size_t WS_VXT = WS_KX + 2 * MiB;
constexpr size_t WS_QX = WS_VXT + 2 * MiB;
constexpr size_t WS_OX = WS_QX + 8 * MiB;
constexpr size_t WS_ACT = WS_OX + 8 * MiB;
constexpr size_t WS_HG = WS_ACT + 88 * MiB;
constexpr size_t WS_EACT = WS_HG + 72 * MiB;
constexpr size_t WS_Y = WS_EACT + 252 * MiB;
constexpr size_t WS_ROUTE = WS_Y + 144 * MiB;
constexpr size_t WS_GCH = WS_ROUTE + 1 * MiB;
constexpr size_t WS_GL = WS_GCH + 88 * MiB;
constexpr size_t WS_H8 = WS_GL + 1 * MiB;
constexpr size_t WS_END = WS_H8 + 16 * MiB;
constexpr int CW_CNT = 64;
constexpr int CW_BAR = 4096;

constexpr int RING_BYTES = 131072, MISC_OFF = RING_BYTES + 320, LDS_BYTES = 147456;

#define GAS __attribute__((address_space(1)))
#define LAS __attribute__((address_space(3)))
#define DI __device__ __forceinline__
typedef unsigned short bf16;
typedef unsigned v4u __attribute__((ext_vector_type(4)));
typedef unsigned v2u __attribute__((ext_vector_type(2)));
typedef float f32x4 __attribute__((ext_vector_type(4)));
typedef short bf16x8 __attribute__((ext_vector_type(8)));
typedef short s16x4 __attribute__((ext_vector_type(4)));
DI float bf2f(unsigned v) { return __uint_as_float(v << 16); }
DI unsigned f2bf(float f) { unsigned u = __builtin_bit_cast(unsigned, f); return (u + 0x7fffu + ((u >> 16) & 1u)) >> 16; }
DI unsigned pk2(float lo, float hi) { return f2bf(lo) | (f2bf(hi) << 16); }
DI float wave_sum(float v) {
#pragma unroll
    for (int o = 1; o < 64; o <<= 1) v += __shfl_xor(v, o);
    return v;
}

#define XB_TMO      128
#define XB_XCNT(j)  (256  + 64 * (j))
#define XB_XSUB(j)  (1280 + 64 * (j))
#define XB_XGEN(j)  (2304 + 64 * (j))
#define XB_TOP      3328
#define XB_TOPGEN   3392
#define XCD_BAR_WORDS 3456
#define XB_SPIN_CAP (1u << 18)

__device__ __forceinline__ unsigned xb_ld(unsigned* p)              { return __hip_atomic_load(p, __ATOMIC_RELAXED, __HIP_MEMORY_SCOPE_AGENT); }
__device__ __forceinline__ unsigned xb_add(unsigned* p, unsigned v) { return __hip_atomic_fetch_add(p, v, __ATOMIC_RELAXED, __HIP_MEMORY_SCOPE_AGENT); }
__device__ __forceinline__ unsigned xb_xcc_id() { return (unsigned)__builtin_amdgcn_s_getreg((3 << 11) | 20) & 0xFu; }
#define XB_SPIN(cond, bar) do { unsigned _sp = 0; while (cond) { __builtin_amdgcn_s_sleep(1); \
    if ((++_sp & 255u) == 0u) { if (xb_ld(&(bar)[XB_TMO])) break; if (_sp > XB_SPIN_CAP) { atomicAdd(&(bar)[XB_TMO], 1u); break; } } } } while (0)

struct XcdBarrier {
    unsigned* bar; unsigned x;
    volatile LAS unsigned* st;
};

__device__ __forceinline__ XcdBarrier xcd_barrier_post(unsigned* bar, volatile LAS unsigned* st) {
    XcdBarrier b; b.bar = bar; b.x = xb_xcc_id(); b.st = st;
    if (threadIdx.x == 0) (void)xb_add(&bar[XB_XCNT(b.x)], 1u);
    return b;
}
__device__ __forceinline__ void xcd_barrier_complete(unsigned* bar, unsigned x, unsigned& nloc, unsigned& nx) {
    const unsigned G = gridDim.x * gridDim.y * gridDim.z;
    unsigned sum, cnt, mine, sp = 0u;
    for (;;) {
        sum = 0u; cnt = 0u; mine = 0u;
#pragma unroll
        for (unsigned j = 0; j < 16; ++j) { const unsigned c = xb_ld(&bar[XB_XCNT(j)]); sum += c; cnt += (c > 0u) ? 1u : 0u; mine = (j == x) ? c : mine; }
        if (sum == G) break;
        __builtin_amdgcn_s_sleep(1);
        if ((++sp & 255u) == 0u) { if (xb_ld(&bar[XB_TMO])) break; if (sp > XB_SPIN_CAP) { atomicAdd(&bar[XB_TMO], 1u); break; } }
    }
    nloc = mine > 0u ? mine : 1u; nx = cnt > 0u ? cnt : 1u;
}

__device__ __forceinline__ void xcd_barrier(const XcdBarrier& b) {
    asm volatile("s_waitcnt vmcnt(0)" ::: "memory");
    __syncthreads();
    if (threadIdx.x == 0) {
        unsigned* bar = b.bar;
        __builtin_amdgcn_s_waitcnt(0);
        unsigned nloc = b.st[0], nx = b.st[1];
        if (nloc == 0u) { xcd_barrier_complete(bar, b.x, nloc, nx); b.st[0] = nloc; b.st[1] = nx; }
        const unsigned old = xb_add(&bar[XB_XSUB(b.x)], 1u);
        const unsigned gen = old / nloc;
        if (old + 1u == (gen + 1u) * nloc) {
            __builtin_amdgcn_fence(__ATOMIC_RELEASE, "agent");
            asm volatile("s_waitcnt vmcnt(0)" ::: "memory");
            const unsigned og = xb_add(&bar[XB_TOP], 1u);
            const unsigned tg = og / nx;
            if (og + 1u == (tg + 1u) * nx) xb_add(&bar[XB_TOPGEN], 1u);
            else XB_SPIN(xb_ld(&bar[XB_TOPGEN]) == tg, bar);
            __builtin_amdgcn_fence(__ATOMIC_ACQUIRE, "agent");
            xb_add(&bar[XB_XGEN(b.x)], 1u);
            asm volatile("s_waitcnt vmcnt(0)" ::: "memory");
        } else {
            XB_SPIN(xb_ld(&bar[XB_XGEN(b.x)]) == gen, bar);
            __builtin_amdgcn_fence(__ATOMIC_ACQUIRE, "agent");
            asm volatile("s_waitcnt vmcnt(0)" ::: "memory");
        }
    }
    __syncthreads();
}

struct Args { const void* in[24]; float* out; unsigned char* ws; int ph_lo, ph_hi; };

struct Frame {
    LAS unsigned char* lds;
    int tid, lane, wave, G, vcu, gw, NGW;
};

DI void conv_job(const Frame& F, const float* W, int K, int Nsrc, bf16* WT, int Ndst, int mode, int Fgu) {
    LAS unsigned* scr = (LAS unsigned*)(F.lds + F.wave * 8704);
    const int nkb = K / 64, nnb = Ndst / 64, items = nkb * nnb, lane = F.lane;
    for (int it = F.gw; it < items; it += F.NGW) {
        const int nb = it / nkb, kb = it % nkb, k0 = kb * 64, n0 = nb * 64, n = n0 + lane;
        int ns;
        if (mode == 0) ns = n;
        else if (mode == 1) ns = n < 8192 ? n : (n < 17408 ? n + 16 : (n < 17424 ? n - 17408 + 8192 : -1));
        else { const int pn = n >> 8, half = (n >> 7) & 1, j = n & 127; ns = half * Fgu + 128 * pn + j; }
        const float* src = W + (size_t)k0 * Nsrc + (ns < 0 ? 0 : ns);
#pragma unroll 8
        for (int i = 0; i < 32; ++i) { float a = src[(size_t)(2 * i) * Nsrc], b = src[(size_t)(2 * i + 1) * Nsrc]; if (ns < 0) { a = 0.f; b = 0.f; } scr[lane * 33 + i] = pk2(a, b); }
        asm volatile("s_waitcnt lgkmcnt(0)" ::: "memory");
#pragma unroll
        for (int j = 0; j < 8; ++j) { const int nn = (lane >> 3) + 8 * j, kq = lane & 7; v4u o; const LAS unsigned* s = scr + nn * 33 + 4 * kq; o.x = s[0]; o.y = s[1]; o.z = s[2]; o.w = s[3];
            *(v4u*)(WT + (size_t)(n0 + nn) * K + k0 + 8 * kq) = o; }
        asm volatile("s_waitcnt lgkmcnt(0)" ::: "memory");
    }
}

DI void conv_job_f8(const Frame& F, const float* W, int K, int Nsrc, unsigned char* WT, int Ndst, int mode, int Fgu, float scale) {
    LAS unsigned* scr = (LAS unsigned*)(F.lds + F.wave * 8704);
    const int nkb = K / 128, nnb = Ndst / 64, items = nkb * nnb, lane = F.lane;
    for (int it = F.gw; it < items; it += F.NGW) {
        const int nb = it / nkb, kb = it % nkb, k0 = kb * 128, n0 = nb * 64, n = n0 + lane;
        int ns;
        if (mode == 0) ns = n; else { const int pn = n >> 8, half = (n >> 7) & 1, j = n & 127; ns = half * Fgu + 128 * pn + j; }
        const float* src = W + (size_t)k0 * Nsrc + ns;
#pragma unroll 4
        for (int i = 0; i < 32; ++i) { const float a = src[(size_t)(4 * i) * Nsrc], b = src[(size_t)(4 * i + 1) * Nsrc], c = src[(size_t)(4 * i + 2) * Nsrc], d = src[(size_t)(4 * i + 3) * Nsrc]; scr[lane * 33 + i] = pg8::pk4_fp8(a * scale, b * scale, c * scale, d * scale); }
        asm volatile("s_waitcnt lgkmcnt(0)" ::: "memory");
#pragma unroll
        for (int j = 0; j < 8; ++j) { const int nn = (lane >> 3) + 8 * j, kq = lane & 7; v4u o; const LAS unsigned* s = scr + nn * 33 + 4 * kq; o.x = s[0]; o.y = s[1]; o.z = s[2]; o.w = s[3];
            *(v4u*)(WT + (size_t)(n0 + nn) * K + k0 + 16 * kq) = o; }
        asm volatile("s_waitcnt lgkmcnt(0)" ::: "memory");
    }
}

DI void rms_row(const float* xrow, const float* w, bf16* orow, int lane) {
    f32x4 v[8]; float ss = 0.f;
#pragma unroll
    for (int j = 0; j < 8; ++j) { v[j] = *(const f32x4*)(xrow + 4 * (lane + 64 * j)); ss += (v[j][0] * v[j][0] + v[j][1] * v[j][1]) + (v[j][2] * v[j][2] + v[j][3] * v[j][3]); }
    const float rstd = rsqrtf(wave_sum(ss) * (1.f / D) + EPS);
#pragma unroll
    for (int j = 0; j < 8; ++j) { const f32x4 ww = *(const f32x4*)(w + 4 * (lane + 64 * j)); v2u o; o.x = pk2(v[j][0] * rstd * ww[0], v[j][1] * rstd * ww[1]); o.y = pk2(v[j][2] * rstd * ww[2], v[j][3] * rstd * ww[3]);
        *(v2u*)(orow + 4 * (lane + 64 * j)) = o; }
}

template <bool GDN>
DI void seq_mixer(const Frame& F, int bh, const bf16* Q, const bf16* K, const bf16* V, const float* Gg, const float* Gb, float* OUT, float gamma) {
    LAS float* qs = (LAS float*)F.lds; LAS float* ks = qs + 32 * 128; LAS float* vs = ks + 32 * 128; LAS float* red = vs + 32 * 128; LAS float* gs = red + 2 * 4 * 128; LAS float* bs = gs + 32;
    const int tid = F.tid, v = tid & 127, kg = tid >> 7, b = bh >> 3, h = bh & 7;
    const size_t hb = (size_t)bh * SEQ * 128;
    float Sr[32];
#pragma unroll
    for (int i = 0; i < 32; ++i) Sr[i] = 0.f;
    for (int c0 = 0; c0 < SEQ; c0 += 32) {
        __syncthreads();
#pragma unroll
        for (int j = 0; j < 4; ++j) { const int idx = tid + 512 * j, tok = idx >> 6, d = (idx & 63) * 2; const size_t go = hb + (size_t)(c0 + tok) * 128 + d;
            const unsigned a = *(const unsigned*)(Q + go), bb = *(const unsigned*)(K + go), cc = *(const unsigned*)(V + go);
            qs[tok * 128 + d] = bf2f(a & 0xffffu); qs[tok * 128 + d + 1] = __uint_as_float(a & 0xffff0000u);
            ks[tok * 128 + d] = bf2f(bb & 0xffffu); ks[tok * 128 + d + 1] = __uint_as_float(bb & 0xffff0000u);
            vs[tok * 128 + d] = bf2f(cc & 0xffffu); vs[tok * 128 + d + 1] = __uint_as_float(cc & 0xffff0000u); }
        if (GDN && tid < 32) { gs[tid] = Gg[(size_t)bh * SEQ + c0 + tid]; bs[tid] = Gb[(size_t)bh * SEQ + c0 + tid]; }
        __syncthreads();
        for (int tt = 0; tt < 32; ++tt) {
            const LAS float* kt = ks + tt * 128 + kg * 32; const LAS float* qt = qs + tt * 128 + kg * 32;
            float po = 0.f;
            if (GDN) {
                const float a = __expf(gs[tt]); float p = 0.f;
#pragma unroll
                for (int i = 0; i < 32; ++i) { Sr[i] *= a; p += Sr[i] * kt[i]; }
                red[kg * 128 + v] = p; __syncthreads();
                const float kv = (red[v] + red[128 + v]) + (red[256 + v] + red[384 + v]);
                const float delta = bs[tt] * (vs[tt * 128 + v] - kv);
#pragma unroll
                for (int i = 0; i < 32; ++i) { Sr[i] += kt[i] * delta; po += Sr[i] * qt[i]; }
                red[512 + kg * 128 + v] = po; __syncthreads();
                if (kg == 0) OUT[((size_t)(b * SEQ + c0 + tt)) * 1024 + h * 128 + v] = (red[512 + v] + red[640 + v]) + (red[768 + v] + red[896 + v]);
            } else {
                const float vv = vs[tt * 128 + v]; LAS float* r = red + (tt & 1) * 512;
#pragma unroll
                for (int i = 0; i < 32; ++i) { Sr[i] = gamma * Sr[i] + kt[i] * vv; po += Sr[i] * qt[i]; }
                r[kg * 128 + v] = po; __syncthreads();
                if (kg == 0) OUT[((size_t)(b * SEQ + c0 + tt)) * 1024 + h * 128 + v] = (r[v] + r[128 + v]) + (r[256 + v] + r[384 + v]);
            }
        }
    }
    __syncthreads();
}

template <int DV, bool CAUSAL, bool OUT_BF16, bool DECAY>
DI void flash_item(const Frame& F, const bf16* Q, const bf16* Kh, const bf16* VT, int vpitch, int q0, int nkeys, float slope, float* OUTF, bf16* OUTB, int opitch) {
    constexpr int KP = 272, VP = 144;
    LAS unsigned char* Kl = F.lds; LAS unsigned char* Vl = F.lds + 64 * KP;
    int tid_ = F.tid; asm volatile("" : "+v"(tid_));
    const int tid = tid_, lane = tid & 63, w = F.wave, li = lane & 15, g = lane >> 4;
    const float SC = 0.08838834764831845f, L2E = 1.4426950408889634f;
    bf16x8 qf[4];
#pragma unroll
    for (int ks = 0; ks < 4; ++ks) qf[ks] = *(const bf16x8*)(Q + (size_t)(w * 16 + li) * 128 + ks * 32 + g * 8);
    f32x4 o[DV / 16];
#pragma unroll
    for (int c = 0; c < DV / 16; ++c) o[c] = (f32x4){0.f, 0.f, 0.f, 0.f};
    float m_run = -1e30f, l_run = 0.f;
    const int qpos = q0 + w * 16 + li;
    const int kend = CAUSAL ? (q0 + 128 < nkeys ? q0 + 128 : nkeys) : nkeys;
    constexpr int BUFB = 64 * KP + DV * VP;
    v4u kr[2], vr[DV / 64];
    __syncthreads();
#pragma unroll
    for (int i = 0; i < 2; ++i) { const int c = tid + 512 * i; kr[i] = *(const v4u*)(Kh + (size_t)(c >> 4) * 128 + (c & 15) * 8); }
#pragma unroll
    for (int i = 0; i < DV / 64; ++i) { const int c = tid + 512 * i; vr[i] = *(const v4u*)(VT + (size_t)(c >> 3) * vpitch + (c & 7) * 8); }
#pragma unroll
    for (int i = 0; i < 2; ++i) { const int c = tid + 512 * i; *(LAS v4u*)(F.lds + (c >> 4) * KP + (c & 15) * 16) = kr[i]; }
#pragma unroll
    for (int i = 0; i < DV / 64; ++i) { const int c = tid + 512 * i; *(LAS v4u*)(F.lds + 64 * KP + (c >> 3) * VP + (c & 7) * 16) = vr[i]; }
    __syncthreads();
    for (int j0 = 0; j0 < kend; j0 += 64) {
        Kl = F.lds + ((j0 >> 6) & 1) * BUFB; Vl = Kl + 64 * KP;
        const bool more = j0 + 64 < kend;
        if (more) {
#pragma unroll
            for (int i = 0; i < 2; ++i) { const int c = tid + 512 * i; kr[i] = *(const v4u*)(Kh + (size_t)(j0 + 64 + (c >> 4)) * 128 + (c & 15) * 8); }
#pragma unroll
            for (int i = 0; i < DV / 64; ++i) { const int c = tid + 512 * i; vr[i] = *(const v4u*)(VT + (size_t)(c >> 3) * vpitch + j0 + 64 + (c & 7) * 8); }
        }
        f32x4 s[4];
#pragma unroll
        for (int t = 0; t < 4; ++t) { s[t] = (f32x4){0.f, 0.f, 0.f, 0.f};
#pragma unroll
            for (int ks = 0; ks < 4; ++ks) { const bf16x8 a = *(const LAS bf16x8*)(Kl + (t * 16 + li) * KP + (ks * 32 + g * 8) * 2); s[t] = __builtin_amdgcn_mfma_f32_16x16x32_bf16(a, qf[ks], s[t], 0, 0, 0); } }
        float alpha = 1.f;
        if (DECAY) {
#pragma unroll
            for (int t = 0; t < 4; ++t)
#pragma unroll
                for (int r = 0; r < 4; ++r) { const int key = j0 + t * 16 + g * 4 + r; const float dcy = exp2f(slope * (float)(qpos - key)); s[t][r] = key > qpos ? 0.f : s[t][r] * dcy; }
        } else {
        float mx = -__builtin_inff();
#pragma unroll
        for (int t = 0; t < 4; ++t)
#pragma unroll
            for (int r = 0; r < 4; ++r) { const int key = j0 + t * 16 + g * 4 + r; float x = s[t][r] * SC - slope * (float)(qpos - key); if (CAUSAL && key > qpos) x = -__builtin_inff(); s[t][r] = x; mx = fmaxf(mx, x); }
        mx = fmaxf(mx, __shfl_xor(mx, 16)); mx = fmaxf(mx, __shfl_xor(mx, 32));
        const float m_new = fmaxf(m_run, mx); alpha = exp2f((m_run - m_new) * L2E); m_run = m_new;
        float ps = 0.f;
#pragma unroll
        for (int t = 0; t < 4; ++t)
#pragma unroll
            for (int r = 0; r < 4; ++r) { const float p = exp2f((s[t][r] - m_new) * L2E); s[t][r] = p; ps += p; }
        ps += __shfl_xor(ps, 16); ps += __shfl_xor(ps, 32);
        l_run = l_run * alpha + ps;
        }
        bf16x8 pf[2];
#pragma unroll
        for (int s2 = 0; s2 < 2; ++s2) { v4u pw; pw.x = pk2(s[2 * s2][0], s[2 * s2][1]); pw.y = pk2(s[2 * s2][2], s[2 * s2][3]); pw.z = pk2(s[2 * s2 + 1][0], s[2 * s2 + 1][1]); pw.w = pk2(s[2 * s2 + 1][2], s[2 * s2 + 1][3]); pf[s2] = __builtin_bit_cast(bf16x8, pw); }
        float al[4];
#pragma unroll
        for (int r = 0; r < 4; ++r) al[r] = DECAY ? 1.f : __shfl(alpha, g * 4 + r);
#pragma unroll
        for (int c = 0; c < DV / 16; ++c) {
            if (!DECAY) {
#pragma unroll
                for (int r = 0; r < 4; ++r) o[c][r] *= al[r]; }
#pragma unroll
            for (int s2 = 0; s2 < 2; ++s2) { const LAS unsigned char* vp = Vl + (c * 16 + li) * VP + (s2 * 32 + g * 4) * 2; const v2u lo = *(const LAS v2u*)vp, hi = *(const LAS v2u*)(vp + 32);
                v4u bw; bw.x = lo.x; bw.y = lo.y; bw.z = hi.x; bw.w = hi.y; o[c] = __builtin_amdgcn_mfma_f32_16x16x32_bf16(pf[s2], __builtin_bit_cast(bf16x8, bw), o[c], 0, 0, 0); }
        }
        if (more) { LAS unsigned char* Kn = F.lds + (((j0 >> 6) + 1) & 1) * BUFB;
#pragma unroll
            for (int i = 0; i < 2; ++i) { const int c = tid + 512 * i; *(LAS v4u*)(Kn + (c >> 4) * KP + (c & 15) * 16) = kr[i]; }
#pragma unroll
            for (int i = 0; i < DV / 64; ++i) { const int c = tid + 512 * i; *(LAS v4u*)(Kn + 64 * KP + (c >> 3) * VP + (c & 7) * 16) = vr[i]; } }
        __syncthreads();
    }
    float il[4];
#pragma unroll
    for (int r = 0; r < 4; ++r) il[r] = DECAY ? 1.f : 1.0f / __shfl(l_run, g * 4 + r);
#pragma unroll
    for (int c = 0; c < DV / 16; ++c)
#pragma unroll
        for (int r = 0; r < 4; ++r) { const unsigned off = (unsigned)((w * 16 + g * 4 + r) * opitch + c * 16 + li); const float v = o[c][r] * il[r];
            if (OUT_BF16) OUTB[off] = (bf16)f2bf(v); else OUTF[off] = v; }
}

constexpr int GDN_CH_BYTES = 16384 + 16384 + 8192 + 16384 + 32768;
DI int perm32pos(int k) { return (k & ~31) | (((k >> 2) & 3) << 3) | (((k >> 4) & 1) << 2) | (k & 3); }
DI void gdn_prep_item(const Frame& F, int l, int bh, int n, const bf16* BQKV, const float* BBA, const float* cw, const float* a_log, const float* dt_bias, unsigned char* CH, float* GLp) {
    LAS unsigned char* Kl = F.lds; LAS unsigned char* Ql = F.lds + 17408; LAS unsigned char* KBT = F.lds + 34816; LAS unsigned char* VBT = F.lds + 53248; LAS unsigned char* KTl = F.lds + 71680;
    LAS float* Am = (LAS float*)(F.lds + 90112); LAS unsigned char* Tl = F.lds + 106752; LAS unsigned char* AQl = F.lds + 115968; LAS float* Gs = (LAS float*)(F.lds + 125184); LAS float* gs = Gs + 64; LAS float* bs = gs + 64;
    LAS float* CWl = Am;
    int tid_ = F.tid; asm volatile("" : "+v"(tid_));
    const int tid = tid_, lane = tid & 63, w = F.wave, li = lane & 15, g = lane >> 4;
    const int b = bh >> 3, h = bh & 7, i = tid >> 3, cg = tid & 7, c0 = cg * 16, s = n * 64 + i, t = b * SEQ + s;
    bf16* Wn = (bf16*)CH; bf16* QD = (bf16*)(CH + 16384); bf16* AQK = (bf16*)(CH + 32768); bf16* KT = (bf16*)(CH + 40960); float* UT = (float*)(CH + 57344);
    __syncthreads();
    for (int e = tid; e < 1536; e += 512) { const int part = e >> 9, j = (e >> 7) & 3, c = e & 127; CWl[e] = cw[j * 3072 + part * 1024 + h * 128 + c]; }
    if (cg == 0) { const float bbv = BBA[(size_t)t * 16 + h], bav = BBA[(size_t)t * 16 + 8 + h] + dt_bias[l * 8 + h]; const float sp = bav > 20.f ? bav : log1pf(__expf(bav)); bs[i] = pg8::fsigm(bbv); gs[i] = -__expf(a_log[l * 8 + h]) * sp; }
    __syncthreads();
    float qv[16], kv[16], vv[16];
#pragma unroll
    for (int part = 0; part < 3; ++part) {
        float a[16];
#pragma unroll
        for (int c = 0; c < 16; ++c) a[c] = 0.f;
#pragma unroll
        for (int j = 0; j < 4; ++j) { if (s - 3 + j >= 0) { const v4u x0 = *(const v4u*)(BQKV + (size_t)(t - 3 + j) * 3072 + part * 1024 + h * 128 + c0), x1 = *(const v4u*)(BQKV + (size_t)(t - 3 + j) * 3072 + part * 1024 + h * 128 + c0 + 8);
                const LAS float* wj = CWl + part * 512 + j * 128 + c0;
#pragma unroll
                for (int c = 0; c < 4; ++c) { a[2 * c] += bf2f(x0[c] & 0xffffu) * wj[2 * c]; a[2 * c + 1] += __uint_as_float(x0[c] & 0xffff0000u) * wj[2 * c + 1]; a[8 + 2 * c] += bf2f(x1[c] & 0xffffu) * wj[8 + 2 * c]; a[9 + 2 * c] += __uint_as_float(x1[c] & 0xffff0000u) * wj[9 + 2 * c]; } } }
#pragma unroll
        for (int c = 0; c < 16; ++c) { const float y = pg8::fsilu(a[c]); if (part == 0) qv[c] = y; else if (part == 1) kv[c] = y; else vv[c] = y; }
    }
    { float sq = 0.f, sk = 0.f;
#pragma unroll
      for (int c = 0; c < 16; ++c) { sq += qv[c] * qv[c]; sk += kv[c] * kv[c]; }
      sq += __shfl_xor(sq, 1); sq += __shfl_xor(sq, 2); sq += __shfl_xor(sq, 4); sk += __shfl_xor(sk, 1); sk += __shfl_xor(sk, 2); sk += __shfl_xor(sk, 4);
      const float qn = rsqrtf(sq + 1e-6f) * 0.08838834764831845f, kn = rsqrtf(sk + 1e-6f);
#pragma unroll
      for (int c = 0; c < 16; ++c) { qv[c] *= qn; kv[c] *= kn; } }
    if (w == 0) { float v = gs[lane];
#pragma unroll
        for (int o = 1; o < 64; o <<= 1) { const float u = __shfl_up(v, o); if (lane >= o) v += u; }
        Gs[lane] = v; }
    __syncthreads();
    {
        const float Gi = Gs[i], Gl = Gs[63], be = bs[i], eg = __expf(Gi), kbs = be * eg, kts = __expf(Gl - Gi);
        v4u pk, pq;
#pragma unroll
        for (int hh = 0; hh < 2; ++hh) {
            pk.x = pk2(kv[8 * hh + 0], kv[8 * hh + 1]); pk.y = pk2(kv[8 * hh + 2], kv[8 * hh + 3]); pk.z = pk2(kv[8 * hh + 4], kv[8 * hh + 5]); pk.w = pk2(kv[8 * hh + 6], kv[8 * hh + 7]);
            pq.x = pk2(qv[8 * hh + 0], qv[8 * hh + 1]); pq.y = pk2(qv[8 * hh + 2], qv[8 * hh + 3]); pq.z = pk2(qv[8 * hh + 4], qv[8 * hh + 5]); pq.w = pk2(qv[8 * hh + 6], qv[8 * hh + 7]);
            *(LAS v4u*)(Kl + i * 272 + (c0 + 8 * hh) * 2) = pk; *(LAS v4u*)(Ql + i * 272 + (c0 + 8 * hh) * 2) = pq; }
        const int ip = perm32pos(i);
#pragma unroll
        for (int c = 0; c < 16; ++c) { *(LAS bf16*)(KBT + (c0 + c) * 144 + i * 2) = (bf16)f2bf(kv[c] * kbs); *(LAS bf16*)(VBT + (c0 + c) * 144 + i * 2) = (bf16)f2bf(vv[c] * be); *(LAS bf16*)(KTl + (c0 + c) * 144 + ip * 2) = (bf16)f2bf(kv[c] * kts); }
#pragma unroll
        for (int gp = 0; gp < 4; ++gp) { v2u o; o.x = pk2(qv[4 * gp] * eg, qv[4 * gp + 1] * eg); o.y = pk2(qv[4 * gp + 2] * eg, qv[4 * gp + 3] * eg); *(v2u*)(QD + i * 128 + 32 * (cg >> 1) + 8 * gp + 4 * (cg & 1)) = o; }
        if (tid == 0) *GLp = __expf(Gl);
    }
    __syncthreads();
    {
        const int kind = w >> 2, rb = w & 3; LAS unsigned char* Al = kind ? Ql : Kl;
        bf16x8 af[4];
#pragma unroll
        for (int ks = 0; ks < 4; ++ks) af[ks] = *(const LAS bf16x8*)(Al + (rb * 16 + li) * 272 + (ks * 32 + g * 8) * 2);
#pragma unroll
        for (int cb = 0; cb < 4; ++cb) {
            f32x4 acc = (f32x4){0.f, 0.f, 0.f, 0.f};
            if (cb <= rb) {
#pragma unroll
                for (int ks = 0; ks < 4; ++ks) { const bf16x8 bfr = *(const LAS bf16x8*)(Kl + (cb * 16 + li) * 272 + (ks * 32 + g * 8) * 2); acc = __builtin_amdgcn_mfma_f32_16x16x32_bf16(af[ks], bfr, acc, 0, 0, 0); } }
            const int j = cb * 16 + li; const float Gj = Gs[j];
#pragma unroll
            for (int r = 0; r < 4; ++r) { const int ii = rb * 16 + 4 * g + r; const float Lij = __expf(Gs[ii] - Gj);
                if (kind == 0) Am[ii * 65 + j] = ii > j ? acc[r] * Lij * bs[ii] : 0.f;
                else *(LAS bf16*)(AQl + ii * 144 + perm32pos(j) * 2) = (bf16)f2bf(ii >= j ? acc[r] * Lij : 0.f); }
        }
    }
    __syncthreads();
    if (w == 0) {
        int zv = 0; asm volatile("" : "+v"(zv)); const LAS float* Amv = Am + zv;
        float Tr[64];
#pragma unroll
        for (int ii = 0; ii < 64; ++ii) {
            float a0 = (ii == lane) ? 1.f : 0.f, a1 = 0.f;
#pragma unroll
            for (int j = 0; j < ii; ++j) { if (j & 1) a1 -= Amv[ii * 65 + j] * Tr[j]; else a0 -= Amv[ii * 65 + j] * Tr[j]; }
            Tr[ii] = a0 + a1;
            *(LAS bf16*)(Tl + ii * 144 + lane * 2) = (bf16)f2bf(Tr[ii]);
            asm volatile("" ::: "memory");
        }
    }
    __syncthreads();
    {
        const int kind = w >> 2; LAS unsigned char* Xl = kind ? VBT : KBT;
#pragma unroll
        for (int q2 = 0; q2 < 2; ++q2) { const int rbk = 2 * (w & 3) + q2;
            bf16x8 af[2];
#pragma unroll
            for (int ks = 0; ks < 2; ++ks) af[ks] = *(const LAS bf16x8*)(Xl + (rbk * 16 + li) * 144 + (ks * 32 + g * 8) * 2);
#pragma unroll
            for (int cb = 0; cb < 4; ++cb) { f32x4 acc = (f32x4){0.f, 0.f, 0.f, 0.f};
#pragma unroll
                for (int ks = 0; ks < 2; ++ks) { const bf16x8 bfr = *(const LAS bf16x8*)(Tl + (cb * 16 + li) * 144 + (ks * 32 + g * 8) * 2); acc = __builtin_amdgcn_mfma_f32_16x16x32_bf16(af[ks], bfr, acc, 0, 0, 0); }
                const int ii = cb * 16 + li;
                if (kind == 0) { v2u o; o.x = pk2(-acc[0], -acc[1]); o.y = pk2(-acc[2], -acc[3]); *(v2u*)(Wn + ii * 128 + 32 * (rbk >> 1) + 8 * g + 4 * (rbk & 1)) = o; }
                else {
#pragma unroll
                    for (int r = 0; r < 4; ++r) UT[(rbk * 16 + 4 * g + r) * 64 + ii] = acc[r]; } }
        }
    }
#pragma unroll
    for (int q2 = 0; q2 < 2; ++q2) { const int c = tid + 512 * q2, row = c >> 3, cc = c & 7; *(v4u*)(KT + row * 64 + cc * 8) = *(const LAS v4u*)(KTl + row * 144 + cc * 16); }
    { const int row = tid >> 3, cc = tid & 7; *(v4u*)(AQK + row * 64 + cc * 8) = *(const LAS v4u*)(AQl + row * 144 + cc * 16); }
}

DI void gdn_scan(const Frame& F, int bh, const unsigned char* CHB, const float* GLB, float* OB) {
    constexpr int BUFB = 62464, O_QD = 17408, O_AQ = 34816, O_KT = 44032;
    int tid_ = F.tid; asm volatile("" : "+v"(tid_));
    const int tid = tid_, lane = tid & 63, w = F.wave, li = lane & 15, g = lane >> 4, b = bh >> 3, h = bh & 7;
    f32x4 S[8];
#pragma unroll
    for (int kb = 0; kb < 8; ++kb) S[kb] = (f32x4){0.f, 0.f, 0.f, 0.f};
    int ldso[7];
#pragma unroll
    for (int q = 0; q < 7; ++q) { const int c = tid + 512 * q;
        if (q < 2) ldso[q] = (c >> 4) * 272 + (c & 15) * 16; else if (q < 4) ldso[q] = O_QD + ((c - 1024) >> 4) * 272 + (c & 15) * 16;
        else if (q == 4) ldso[q] = O_AQ + ((c - 2048) >> 3) * 144 + (c & 7) * 16; else ldso[q] = O_KT + ((c - 2560) >> 3) * 144 + (c & 7) * 16; }
    const unsigned char* CH0 = CHB + (size_t)(bh * 32) * GDN_CH_BYTES;
    v4u st[7]; f32x4 utc[4], utn[4]; float glc, gln;
    __syncthreads();
#pragma unroll
    for (int q = 0; q < 7; ++q) st[q] = *(const v4u*)(CH0 + (size_t)(tid + 512 * q) * 16);
#pragma unroll
    for (int jb = 0; jb < 4; ++jb) utc[jb] = *(const f32x4*)((const float*)(CH0 + 57344) + (16 * w + li) * 64 + jb * 16 + 4 * g);
    glc = GLB[bh * 32];
#pragma unroll
    for (int q = 0; q < 7; ++q) *(LAS v4u*)(F.lds + ldso[q]) = st[q];
    __syncthreads();
    for (int n = 0; n < 32; ++n) {
        const LAS unsigned char* Lb = F.lds + (n & 1) * BUFB;
        if (n + 1 < 32) { const unsigned char* CH = CH0 + (size_t)(n + 1) * GDN_CH_BYTES;
#pragma unroll
            for (int q = 0; q < 7; ++q) st[q] = *(const v4u*)(CH + (size_t)(tid + 512 * q) * 16);
#pragma unroll
            for (int jb = 0; jb < 4; ++jb) utn[jb] = *(const f32x4*)((const float*)(CH + 57344) + (16 * w + li) * 64 + jb * 16 + 4 * g);
            gln = GLB[bh * 32 + n + 1]; }
        bf16x8 sf[4];
#pragma unroll
        for (int ks = 0; ks < 4; ++ks) { v4u p; p.x = pk2(S[2 * ks][0], S[2 * ks][1]); p.y = pk2(S[2 * ks][2], S[2 * ks][3]); p.z = pk2(S[2 * ks + 1][0], S[2 * ks + 1][1]); p.w = pk2(S[2 * ks + 1][2], S[2 * ks + 1][3]); sf[ks] = __builtin_bit_cast(bf16x8, p); }
        f32x4 vn[4];
#pragma unroll
        for (int jb = 0; jb < 4; ++jb) { vn[jb] = utc[jb];
#pragma unroll
            for (int ks = 0; ks < 4; ++ks) { const bf16x8 a = *(const LAS bf16x8*)(Lb + (jb * 16 + li) * 272 + (ks * 32 + g * 8) * 2); vn[jb] = __builtin_amdgcn_mfma_f32_16x16x32_bf16(a, sf[ks], vn[jb], 0, 0, 0); } }
        bf16x8 vf[2];
#pragma unroll
        for (int js = 0; js < 2; ++js) { v4u p; p.x = pk2(vn[2 * js][0], vn[2 * js][1]); p.y = pk2(vn[2 * js][2], vn[2 * js][3]); p.z = pk2(vn[2 * js + 1][0], vn[2 * js + 1][1]); p.w = pk2(vn[2 * js + 1][2], vn[2 * js + 1][3]); vf[js] = __builtin_bit_cast(bf16x8, p); }
#pragma unroll
        for (int ib = 0; ib < 4; ++ib) { f32x4 z = (f32x4){0.f, 0.f, 0.f, 0.f};
#pragma unroll
            for (int ks = 0; ks < 4; ++ks) { const bf16x8 bq = *(const LAS bf16x8*)(Lb + O_QD + (ib * 16 + li) * 272 + (ks * 32 + g * 8) * 2); z = __builtin_amdgcn_mfma_f32_16x16x32_bf16(sf[ks], bq, z, 0, 0, 0); }
#pragma unroll
            for (int js = 0; js < 2; ++js) { const bf16x8 ba = *(const LAS bf16x8*)(Lb + O_AQ + (ib * 16 + li) * 144 + (js * 32 + g * 8) * 2); z = __builtin_amdgcn_mfma_f32_16x16x32_bf16(vf[js], ba, z, 0, 0, 0); }
            *(f32x4*)(OB + ((size_t)(b * SEQ + n * 64 + ib * 16 + li)) * 1024 + h * 128 + 16 * w + 4 * g) = z; }
#pragma unroll
        for (int kb = 0; kb < 8; ++kb) { S[kb] = S[kb] * glc;
#pragma unroll
            for (int js = 0; js < 2; ++js) { const bf16x8 a = *(const LAS bf16x8*)(Lb + O_KT + (kb * 16 + li) * 144 + (js * 32 + g * 8) * 2); S[kb] = __builtin_amdgcn_mfma_f32_16x16x32_bf16(a, vf[js], S[kb], 0, 0, 0); } }
        if (n + 1 < 32) {
            LAS unsigned char* Ln = F.lds + ((n + 1) & 1) * BUFB;
#pragma unroll
            for (int q = 0; q < 7; ++q) *(LAS v4u*)(Ln + ldso[q]) = st[q];
#pragma unroll
            for (int jb = 0; jb < 4; ++jb) utc[jb] = utn[jb];
            glc = gln; }
        __syncthreads();
    }
}

#define x_in ((const float*)args.in[0])
#define mem ((const float*)args.in[1])
#define w_in ((const float*)args.in[2])
#define conv_w ((const float*)args.in[3])
#define a_log ((const float*)args.in[4])
#define dt_bias ((const float*)args.in[5])
#define gdn_norm_w ((const float*)args.in[6])
#define diff_lambda ((const float*)args.in[7])
#define diff_norm_w ((const float*)args.in[8])
#define w_branch ((const float*)args.in[9])
#define w_out ((const float*)args.in[10])
#define mix_norm_w ((const float*)args.in[11])
#define mem_norm_w ((const float*)args.in[12])
#define cross_norm_w ((const float*)args.in[13])
#define cross_w_q ((const float*)args.in[14])
#define cross_w_kv ((const float*)args.in[15])
#define cross_w_o ((const float*)args.in[16])
#define ffn_norm_w ((const float*)args.in[17])
#define dense_w_gu ((const float*)args.in[18])
#define dense_w_down ((const float*)args.in[19])
#define router_w ((const float*)args.in[20])
#define expert_w_gu ((const float*)args.in[21])
#define expert_w_down ((const float*)args.in[22])
#define final_norm_w ((const float*)args.in[23])
#define WIN ((bf16*)(ws + WS_WIN))
#define WBR ((bf16*)(ws + WS_WBR))
#define WOUT ((bf16*)(ws + WS_WOUT))
#define WQ ((bf16*)(ws + WS_WQ))
#define WKV ((bf16*)(ws + WS_WKV))
#define WO ((bf16*)(ws + WS_WO))
#define WGU ((bf16*)(ws + WS_WGU))
#define WDN ((bf16*)(ws + WS_WDN))
#define WEGU ((bf16*)(ws + WS_WEGU))
#define WEDN ((bf16*)(ws + WS_WEDN))
#define XRES ((float*)(ws + WS_XRES))
#define H ((bf16*)(ws + WS_H))
#define RQ ((bf16*)(ws + WS_RQ))
#define RK ((bf16*)(ws + WS_RK))
#define RVT ((bf16*)(ws + WS_RV))
#define RG ((bf16*)(ws + WS_RG))
#define BQKV ((bf16*)(ws + WS_BQKV))
#define BZ ((bf16*)(ws + WS_BZ))
#define BBA ((float*)(ws + WS_BBA))
#define CQ ((bf16*)(ws + WS_CQ))
#define CK ((bf16*)(ws + WS_CK))
#define CVT ((bf16*)(ws + WS_CVT))
#define GATES ((bf16*)(ws + WS_GATES))
#define GQ ((bf16*)(ws + WS_GQ))
#define GK ((bf16*)(ws + WS_GK))
#define GV ((bf16*)(ws + WS_GV))
#define GG ((float*)(ws + WS_GG))
#define GB ((float*)(ws + WS_GB))
#define OA ((float*)(ws + WS_OA))
#define OB ((float*)(ws + WS_OB))
#define O12 ((float*)(ws + WS_O12))
#define OCAT ((bf16*)(ws + WS_OCAT))
#define MERGE ((float*)(ws + WS_MERGE))
#define MERGEB ((bf16*)(ws + WS_MERGEB))
#define MEMN ((bf16*)(ws + WS_MEMN))
#define KX ((bf16*)(ws + WS_KX))
#define VXT ((bf16*)(ws + WS_VXT))
#define QX ((bf16*)(ws + WS_QX))
#define OX ((bf16*)(ws + WS_OX))
#define ACT ((bf16*)(ws + WS_ACT))
#define HG ((bf16*)(ws + WS_HG))
#define EACT ((bf16*)(ws + WS_EACT))
#define Y ((float*)(ws + WS_Y))
#define ROUTE ((int*)(ws + WS_ROUTE))
#define H8 ((unsigned char*)(ws + WS_H8))
__global__ void __launch_bounds__(NWAVES * 64, 2) mk_fwd(Args args) {
    extern __shared__ __attribute__((aligned(16))) unsigned char lds_raw[];
    Frame F;
    F.lds = (LAS unsigned char*)lds_raw;
    F.tid = threadIdx.x; F.lane = F.tid & 63; F.wave = __builtin_amdgcn_readfirstlane(F.tid >> 6);
    F.G = gridDim.x; { const int bx = blockIdx.x; F.vcu = (F.G % 8 == 0) ? (bx % 8) * (F.G / 8) + bx / 8 : bx; }
    F.gw = F.vcu * NWAVES + F.wave; F.NGW = F.G * NWAVES;
    volatile LAS unsigned* MISC = (volatile LAS unsigned*)(F.lds + MISC_OFF);
    LAS int* MTAB = (LAS int*)(F.lds + MISC_OFF + 128);
    unsigned char* ws = args.ws;
    unsigned* ctl = (unsigned*)(ws + WS_CTL);
    for (int u = F.tid; u < (LDS_BYTES - RING_BYTES) / 4; u += NWAVES * 64) ((LAS unsigned*)(F.lds + RING_BYTES))[u] = 0u;
    __syncthreads();
#if MK_ONE_LAUNCH
    XcdBarrier bar = xcd_barrier_post(ctl + CW_BAR, MISC + 8);
#define GRID_BAR() xcd_barrier(bar)
#else
#define GRID_BAR() do {} while (0)
#endif
    const int lo = args.ph_lo, hi = args.ph_hi;
#ifndef PROBE_PH
#define PROBE_PH -1
#endif
#define IN(k) (lo <= (k) && (k) < hi)
#define REP(k) for (int rep_ = 0; rep_ < ((k) == PROBE_PH ? 2 : 1); ++rep_)
#define SEAM(k) do { if (IN(k) && IN((k) + 1)) GRID_BAR(); } while (0)

    if (IN(0)) REP(0) {
        for (int l = 0; l < 2; ++l) {
            conv_job(F, w_in + (size_t)l * D * 17424, D, 17424, WIN + (size_t)l * NINP * D, NINP, 1, 0);
            for (int s = 0; s < 3; ++s) conv_job(F, w_branch + ((size_t)l * 3072 + s * 1024) * D, 1024, D, WBR + ((size_t)l * 3 + s) * D * 1024, D, 0, 0);
            conv_job(F, w_out + (size_t)l * D * D, D, D, WOUT + (size_t)l * D * D, D, 0, 0);
            conv_job(F, cross_w_q + (size_t)l * D * 512, D, 512, WQ + (size_t)l * 512 * D, 512, 0, 0);
            conv_job(F, cross_w_kv + (size_t)l * D * 1024, D, 1024, WKV + (size_t)l * 1024 * D, 1024, 0, 0);
            conv_job(F, cross_w_o + (size_t)l * 512 * D, 512, D, WO + (size_t)l * D * 512, D, 0, 0);
        }
        conv_job(F, dense_w_gu, D, 2 * DFF, WGU, 2 * DFF, 2, DFF);
        conv_job(F, dense_w_down, DFF, D, WDN, D, 0, 0);
        for (int e = 0; e < NEXP; ++e) {
            conv_job_f8(F, expert_w_gu + (size_t)e * D * 2 * EFF, D, 2 * EFF, (unsigned char*)WEGU + (size_t)e * 2 * EFF * D, 2 * EFF, 2, EFF, 256.f);
            conv_job_f8(F, expert_w_down + (size_t)e * EFF * D, EFF, D, (unsigned char*)WEDN + (size_t)e * D * EFF, D, 0, 0, 256.f);
        }
        for (int r = F.gw; r < T; r += F.NGW) rms_row(x_in + (size_t)r * D, mix_norm_w, H + (size_t)r * D, F.lane);
        for (int r = F.gw; r < 2 * MEMR; r += F.NGW) { const int l = r / MEMR, rr = r % MEMR; rms_row(mem + (size_t)rr * D, mem_norm_w + l * D, MEMN + (size_t)r * D, F.lane); }
    }
    SEAM(0);
    if (IN(1)) REP(1) {
        for (int l = 0; l < 2; ++l) {
            pg8::Gemm g{MEMN + (size_t)l * MEMR * D, WKV + (size_t)l * 1024 * D, MEMR, 1024, D}; pg8::StaticOrder S; S.init(MEMR, 1024, F.G, (int)((blockIdx.x + F.G - 16 * l) % F.G));
            pg8::EpiHeads E{KX + (size_t)l * NB * 4 * MEML * 128, VXT + (size_t)l * NB * 4 * 128 * MEML, 4, 8, 2};
            pg8::gemm_phase<pg8::EpiHeads, pg8::StaticOrder, true, true>(F.lds, g, S, E);
        }
    }
    SEAM(1);

    { constexpr int l = 0;
        const int pb = 2 + l * NPL;
        const float lambda_init = l == 0 ? 0.2f : 0.35550906f;
        const float* xin = l == 0 ? x_in : XRES;
        if (IN(pb + 0)) REP(pb + 0) {
            pg8::Gemm g{H, WIN + (size_t)l * NINP * D, T, NINP, D}; pg8::StaticOrder S; S.init(T, NINP, F.G, (int)blockIdx.x);
            pg8::EpiIn E{RQ, RK, RVT, RG, BQKV, BZ, CQ, CK, CVT, GATES, BBA};
            pg8::gemm_phase<pg8::EpiIn, pg8::StaticOrder, true, true>(F.lds, g, S, E);
        }
        SEAM(pb + 0);
        if (IN(pb + 1)) REP(pb + 1) {
            const float* cw = conv_w + (size_t)l * 4 * 3072;
            for (int it = F.vcu; it < 1024; it += F.G) gdn_prep_item(F, l, it >> 5, it & 31, BQKV, BBA, cw, a_log, dt_bias, ws + WS_GCH + (size_t)it * GDN_CH_BYTES, (float*)(ws + WS_GL) + it);
        }
        SEAM(pb + 1);
        if (IN(pb + 2)) REP(pb + 2) {
            const int bx = F.vcu;
#ifndef PROBE_SCAN2
#define PROBE_SCAN2 1
#endif
#ifndef PROBE_FLASH2
#define PROBE_FLASH2 1
#endif
            if (bx < 32) { for (int rp = 0; rp < (l == 0 ? PROBE_SCAN2 : 1); ++rp) gdn_scan(F, bx, ws + WS_GCH, (const float*)(ws + WS_GL), OB); }
            else {
                for (int it = bx - 32; it < 1024 * (l == 0 ? PROBE_FLASH2 : 1); it += F.G - 32) {
                    const int qt = 15 - ((it & 1023) >> 6), kind = (it >> 5) & 1, hd = it & 31, b = hd >> 3, hm = hd & 7;
                    if (kind == 0) { const int hh = hm >> 1, m = hm & 1; const float slope = exp2f(-2.0f * (float)(hh + 1));
                        flash_item<256, true, false, false>(F, CQ + ((size_t)hd * SEQ + qt * 128) * 128, CK + (size_t)hd * SEQ * 128, CVT + (size_t)(b * 4 + hh) * 256 * SEQ, SEQ, qt * 128, SEQ, slope,
                                                            O12 + ((size_t)m * T + b * SEQ + qt * 128) * 1024 + hh * 256, nullptr, 1024); }
                    else { const float lg = log2f(1.0f - exp2f(-5.0f - (float)hm));
                        flash_item<128, true, false, true>(F, RQ + ((size_t)hd * SEQ + qt * 128) * 128, RK + (size_t)hd * SEQ * 128, RVT + (size_t)hd * 128 * SEQ, SEQ, qt * 128, SEQ, lg,
                                                           OA + ((size_t)(b * SEQ + qt * 128)) * 1024 + hm * 128, nullptr, 1024); }
                }
            }
        }
        SEAM(pb + 2);
        if (IN(pb + 3)) REP(pb + 3) {
            const int lane = F.lane;
            const float* lv = diff_lambda + (size_t)l * 512;
            const float d01 = wave_sum(lv[lane] * lv[128 + lane] + lv[64 + lane] * lv[192 + lane]), d23 = wave_sum(lv[256 + lane] * lv[384 + lane] + lv[320 + lane] * lv[448 + lane]);
            const float lam = __expf(d01) - __expf(d23) + lambda_init;
            for (int t = F.gw; t < T; t += F.NGW) {
#pragma unroll
                for (int h = 0; h < 8; ++h) { const size_t o = (size_t)t * 1024 + h * 128 + 2 * lane;
                    { const float a0 = OA[o], a1 = OA[o + 1]; const float mean = wave_sum(a0 + a1) * (1.f / 128.f); const float c0 = a0 - mean, c1 = a1 - mean; const float rstd = rsqrtf(wave_sum(c0 * c0 + c1 * c1) * (1.f / 128.f) + EPS);
                      const unsigned gv = *(const unsigned*)(RG + o); *(unsigned*)(OCAT + o) = pk2(c0 * rstd * bf2f(gv & 0xffffu), c1 * rstd * __uint_as_float(gv & 0xffff0000u)); }
                    { const float a0 = OB[o], a1 = OB[o + 1]; const float rstd = rsqrtf(wave_sum(a0 * a0 + a1 * a1) * (1.f / 128.f) + EPS); const unsigned gv = *(const unsigned*)(BZ + o);
                      *(unsigned*)(OCAT + (size_t)T * 1024 + o) = pk2(a0 * rstd * gdn_norm_w[l * 128 + 2 * lane] * bf2f(gv & 0xffffu), a1 * rstd * gdn_norm_w[l * 128 + 2 * lane + 1] * __uint_as_float(gv & 0xffff0000u)); } }
#pragma unroll
                for (int h = 0; h < 4; ++h) { const size_t o = (size_t)t * 1024 + h * 256 + 4 * lane; const f32x4 p = *(const f32x4*)(O12 + o), q = *(const f32x4*)(O12 + (size_t)T * 1024 + o); const f32x4 d = p - q * lam;
                    const float rstd = rsqrtf(wave_sum((d[0] * d[0] + d[1] * d[1]) + (d[2] * d[2] + d[3] * d[3])) * (1.f / 256.f) + EPS) * (1.0f - lambda_init); const f32x4 ww = *(const f32x4*)(diff_norm_w + l * 256 + 4 * lane);
                    v2u ov; ov.x = pk2(d[0] * rstd * ww[0], d[1] * rstd * ww[1]); ov.y = pk2(d[2] * rstd * ww[2], d[3] * rstd * ww[3]); *(v2u*)(OCAT + (size_t)2 * T * 1024 + o) = ov; }
            }
        }
        SEAM(pb + 3);
        if (IN(pb + 4)) REP(pb + 4) {
            for (int s = 0; s < 3; ++s) {
                pg8::Gemm g{OCAT + (size_t)s * T * 1024, WBR + ((size_t)l * 3 + s) * D * 1024, T, D, 1024}; pg8::StaticOrder S; S.init(T, D, F.G, (int)blockIdx.x);
                pg8::EpiBranch E{MERGE, MERGEB, GATES, s};
                pg8::gemm_phase<pg8::EpiBranch, pg8::StaticOrder, true, true>(F.lds, g, S, E);
            }
        }
        SEAM(pb + 4);
        if (IN(pb + 5)) REP(pb + 5) {
            pg8::Gemm g{MERGEB, WOUT + (size_t)l * D * D, T, D, D}; pg8::StaticOrder S; S.init(T, D, F.G, (int)blockIdx.x);
            pg8::EpiResid E{xin, XRES, D};
            pg8::gemm_phase<pg8::EpiResid, pg8::StaticOrder, true, true>(F.lds, g, S, E);
        }
        SEAM(pb + 5);
        if (IN(pb + 6)) REP(pb + 6) { for (int r = F.gw; r < T; r += F.NGW) rms_row(XRES + (size_t)r * D, cross_norm_w + l * D, H + (size_t)r * D, F.lane); }
        SEAM(pb + 6);
        if (IN(pb + 7)) REP(pb + 7) {
            pg8::Gemm g{H, WQ + (size_t)l * 512 * D, T, 512, D}; pg8::StaticOrder S; S.init(T, 512, F.G, (int)blockIdx.x);
            pg8::EpiHeads E{QX, nullptr, 4, 11, 1 << 20};
            pg8::gemm_phase<pg8::EpiHeads, pg8::StaticOrder, true, true>(F.lds, g, S, E);
        }
        SEAM(pb + 7);
        if (IN(pb + 8)) REP(pb + 8) {
            for (int it = F.vcu; it < 256; it += F.G) { const int hd = it >> 4, qt = it & 15, b = hd >> 2, hh = hd & 3;
                flash_item<128, false, true, false>(F, QX + ((size_t)hd * SEQ + qt * 128) * 128, KX + ((size_t)l * 16 + hd) * MEML * 128, VXT + ((size_t)l * 16 + hd) * 128 * MEML, MEML, qt * 128, MEML, 0.f,
                                             nullptr, OX + ((size_t)(b * SEQ + qt * 128)) * 512 + hh * 128, 512); }
        }
        SEAM(pb + 8);
        if (IN(pb + 9)) REP(pb + 9) {
            pg8::Gemm g{OX, WO + (size_t)l * D * 512, T, D, 512}; pg8::StaticOrder S; S.init(T, D, F.G, (int)blockIdx.x);
            pg8::EpiResid E{XRES, XRES, D};
            pg8::gemm_phase<pg8::EpiResid, pg8::StaticOrder, true, true>(F.lds, g, S, E);
        }
        SEAM(pb + 9);
        if (IN(pb + 10)) REP(pb + 10) {
            const int lane = F.lane; const float* w = ffn_norm_w + l * D;
            for (int r = F.gw; r < T; r += F.NGW) {
                const float* xrow = XRES + (size_t)r * D; f32x4 v[8]; float ss = 0.f;
#pragma unroll
                for (int j = 0; j < 8; ++j) { v[j] = *(const f32x4*)(xrow + 4 * (lane + 64 * j)); ss += (v[j][0] * v[j][0] + v[j][1] * v[j][1]) + (v[j][2] * v[j][2] + v[j][3] * v[j][3]); }
                const float rstd = rsqrtf(wave_sum(ss) * (1.f / D) + EPS);
                float lg[8];
#pragma unroll
                for (int e = 0; e < 8; ++e) lg[e] = 0.f;
#pragma unroll
                for (int j = 0; j < 8; ++j) { const f32x4 ww = *(const f32x4*)(w + 4 * (lane + 64 * j)); f32x4 y; y[0] = v[j][0] * rstd * ww[0]; y[1] = v[j][1] * rstd * ww[1]; y[2] = v[j][2] * rstd * ww[2]; y[3] = v[j][3] * rstd * ww[3];
                    if (l == 0) { v2u o; o.x = pk2(y[0], y[1]); o.y = pk2(y[2], y[3]); *(v2u*)(H + (size_t)r * D + 4 * (lane + 64 * j)) = o; }
                    else *(unsigned*)(H8 + (size_t)r * D + 4 * (lane + 64 * j)) = pg8::pk4_fp8(y[0], y[1], y[2], y[3]);
                    if (l == 1) {
#pragma unroll
                        for (int c = 0; c < 4; ++c) { const float* rw = router_w + (size_t)(4 * (lane + 64 * j) + c) * 8; const f32x4 r0 = *(const f32x4*)rw, r1 = *(const f32x4*)(rw + 4);
                            lg[0] += y[c] * r0[0]; lg[1] += y[c] * r0[1]; lg[2] += y[c] * r0[2]; lg[3] += y[c] * r0[3]; lg[4] += y[c] * r1[0]; lg[5] += y[c] * r1[1]; lg[6] += y[c] * r1[2]; lg[7] += y[c] * r1[3]; } } }
                if (l == 1) {
#pragma unroll
                    for (int e = 0; e < 8; ++e) lg[e] = wave_sum(lg[e]);
                    int e0 = 0; float v0 = lg[0];
#pragma unroll
                    for (int e = 1; e < 8; ++e) if (lg[e] > v0) { v0 = lg[e]; e0 = e; }
                    int e1 = -1; float v1 = -__builtin_inff();
#pragma unroll
                    for (int e = 0; e < 8; ++e) if (e != e0 && lg[e] > v1) { v1 = lg[e]; e1 = e; }
                    if (lane == 0) { const float p0 = 1.0f / (1.0f + __expf(v1 - v0)); int* ro = ROUTE + (size_t)r * 8;
                        ro[0] = e0; ro[1] = e1; ro[2] = (int)atomicAdd(ctl + CW_CNT + e0, 1u); ro[3] = (int)atomicAdd(ctl + CW_CNT + e1, 1u); ((float*)ro)[4] = p0; ((float*)ro)[5] = 1.0f - p0; }
                }
            }
        }
        SEAM(pb + 10);
        if (l == 0) {
            if (IN(pb + 11)) REP(pb + 11) {
                pg8::Gemm g{H, WGU, T, 2 * DFF, D}; pg8::StaticOrder S; S.init(T, 2 * DFF, F.G, (int)blockIdx.x);
                pg8::EpiSwiglu E{ACT, DFF, 1 << 20};
                pg8::gemm_phase<pg8::EpiSwiglu, pg8::StaticOrder, true, true>(F.lds, g, S, E);
            }
            SEAM(pb + 11);
            if (IN(pb + 12)) REP(pb + 12) {
                pg8::Gemm g{ACT, WDN, T, D, DFF}; pg8::StaticOrder S; S.init(T, D, F.G, (int)blockIdx.x);
                pg8::EpiResid E{XRES, XRES, D};
                pg8::gemm_phase<pg8::EpiResid, pg8::StaticOrder, true, true>(F.lds, g, S, E);
            }
            SEAM(pb + 12);
            if (IN(pb + 13)) REP(pb + 13) { for (int r = F.gw; r < T; r += F.NGW) rms_row(XRES + (size_t)r * D, mix_norm_w + D, H + (size_t)r * D, F.lane); }
            SEAM(pb + 13);
            SEAM(pb + 14);
        } else {
#define MOE_OFFSETS() int off[9]; off[0] = 0; _Pragma("unroll") for (int e = 0; e < 8; ++e) { const int c = __builtin_amdgcn_readfirstlane((int)__hip_atomic_load(ctl + CW_CNT + e, __ATOMIC_RELAXED, __HIP_MEMORY_SCOPE_AGENT)); off[e + 1] = off[e] + ((c + 255) & ~255); }
            if (IN(pb + 11)) REP(pb + 11) {
                MOE_OFFSETS();
                for (int it = F.gw; it < T * 2; it += F.NGW) { const int t = it >> 1, k = it & 1; int* ro = ROUTE + (size_t)t * 8; const int e = ro[k], pos = ro[2 + k];
                    int base = 0;
#pragma unroll
                    for (int q = 0; q < 8; ++q) if (e == q) base = off[q];
                    const int slot = base + pos; if (F.lane == 0) ro[6 + k] = slot;
                    const v4u* src = (const v4u*)(H8 + (size_t)t * D); v4u* dst = (v4u*)((unsigned char*)HG + (size_t)slot * D);
#pragma unroll
                    for (int j = 0; j < 2; ++j) dst[F.lane + 64 * j] = src[F.lane + 64 * j]; }
#pragma unroll
                for (int e = 0; e < 8; ++e) { const int c = __builtin_amdgcn_readfirstlane((int)__hip_atomic_load(ctl + CW_CNT + e, __ATOMIC_RELAXED, __HIP_MEMORY_SCOPE_AGENT));
                    for (int rr = off[e] + c + F.gw; rr < off[e + 1]; rr += F.NGW) { v4u* dst = (v4u*)((unsigned char*)HG + (size_t)rr * D);
#pragma unroll
                        for (int j = 0; j < 2; ++j) dst[F.lane + 64 * j] = (v4u){0u, 0u, 0u, 0u}; } }
            }
            SEAM(pb + 11);
            if (IN(pb + 12)) REP(pb + 12) {
                if (F.tid == 0) { MOE_OFFSETS(); int cu = 0;
#pragma unroll
                    for (int e = 0; e < 8; ++e) { const int ne = (off[e + 1] - off[e]) >> 8; MTAB[e] = ne; MTAB[8 + e] = off[e] >> 8; MTAB[16 + e] = cu; cu += ne * 56; } MTAB[24] = cu; MTAB[25] = cu; }
                __syncthreads();
                pg8::Gemm g{HG, WEGU, MAXSLOT, NEXP * 2 * EFF, D / 2}; pg8::MoeOrder S{(const LAS int*)MTAB, 56, F.G, (int)blockIdx.x};
                pg8::EpiSwiglu8 E{(unsigned char*)EACT, EFF, 56, 1.0f / 256.f, 8.f};
                pg8::gemm_phase<pg8::EpiSwiglu8, pg8::MoeOrder, true, true, true>(F.lds, g, S, E);
            }
            SEAM(pb + 12);
            if (IN(pb + 13)) REP(pb + 13) {
                __syncthreads();
                if (F.tid == 0) { MOE_OFFSETS(); int cu = 0;
#pragma unroll
                    for (int e = 0; e < 8; ++e) { const int ne = (off[e + 1] - off[e]) >> 8; MTAB[e] = ne; MTAB[8 + e] = off[e] >> 8; MTAB[16 + e] = cu; cu += ne * 8; } MTAB[24] = cu; MTAB[25] = cu; }
                __syncthreads();
                pg8::Gemm g{EACT, WEDN, MAXSLOT, NEXP * D, EFF / 2}; pg8::MoeOrder S{(const LAS int*)MTAB, 8, F.G, (int)blockIdx.x};
                pg8::EpiStoreF32 E{Y, D, 8, 1.0f / 2048.f};
                pg8::gemm_phase<pg8::EpiStoreF32, pg8::MoeOrder, true, true, true>(F.lds, g, S, E);
            }
            SEAM(pb + 13);
            if (IN(pb + 14)) REP(pb + 14) {
                const int lane = F.lane;
                for (int r = F.gw; r < T; r += F.NGW) { const int* ro = ROUTE + (size_t)r * 8; const float p0 = ((const float*)ro)[4], p1 = ((const float*)ro)[5]; const float* y0 = Y + (size_t)ro[6] * D; const float* y1 = Y + (size_t)ro[7] * D;
                    const float* xrow = XRES + (size_t)r * D; f32x4 v[8]; float ss = 0.f;
#pragma unroll
                    for (int j = 0; j < 8; ++j) { const int o = 4 * (lane + 64 * j); v[j] = *(const f32x4*)(xrow + o) + *(const f32x4*)(y0 + o) * p0 + *(const f32x4*)(y1 + o) * p1; ss += (v[j][0] * v[j][0] + v[j][1] * v[j][1]) + (v[j][2] * v[j][2] + v[j][3] * v[j][3]); }
                    const float rstd = rsqrtf(wave_sum(ss) * (1.f / D) + EPS);
#pragma unroll
                    for (int j = 0; j < 8; ++j) { const int o = 4 * (lane + 64 * j); const f32x4 ww = *(const f32x4*)(final_norm_w + o); *(f32x4*)(args.out + (size_t)r * D + o) = v[j] * rstd * ww; } }
            }
        }
    }
    { constexpr int l = 1;
        const int pb = 2 + l * NPL;
        const float lambda_init = l == 0 ? 0.2f : 0.35550906f;
        const float* xin = l == 0 ? x_in : XRES;
        if (IN(pb + 0)) REP(pb + 0) {
            pg8::Gemm g{H, WIN + (size_t)l * NINP * D, T, NINP, D}; pg8::StaticOrder S; S.init(T, NINP, F.G, (int)blockIdx.x);
            pg8::EpiIn E{RQ, RK, RVT, RG, BQKV, BZ, CQ, CK, CVT, GATES, BBA};
            pg8::gemm_phase<pg8::EpiIn, pg8::StaticOrder, true, true>(F.lds, g, S, E);
        }
        SEAM(pb + 0);
        if (IN(pb + 1)) REP(pb + 1) {
            const float* cw = conv_w + (size_t)l * 4 * 3072;
            for (int it = F.vcu; it < 1024; it += F.G) gdn_prep_item(F, l, it >> 5, it & 31, BQKV, BBA, cw, a_log, dt_bias, ws + WS_GCH + (size_t)it * GDN_CH_BYTES, (float*)(ws + WS_GL) + it);
        }
        SEAM(pb + 1);
        if (IN(pb + 2)) REP(pb + 2) {
            const int bx = F.vcu;
#ifndef PROBE_SCAN2
#define PROBE_SCAN2 1
#endif
#ifndef PROBE_FLASH2
#define PROBE_FLASH2 1
#endif
            if (bx < 32) { for (int rp = 0; rp < (l == 0 ? PROBE_SCAN2 : 1); ++rp) gdn_scan(F, bx, ws + WS_GCH, (const float*)(ws + WS_GL), OB); }
            else {
                for (int it = bx - 32; it < 1024 * (l == 0 ? PROBE_FLASH2 : 1); it += F.G - 32) {
                    const int qt = 15 - ((it & 1023) >> 6), kind = (it >> 5) & 1, hd = it & 31, b = hd >> 3, hm = hd & 7;
                    if (kind == 0) { const int hh = hm >> 1, m = hm & 1; const float slope = exp2f(-2.0f * (float)(hh + 1));
                        flash_item<256, true, false, false>(F, CQ + ((size_t)hd * SEQ + qt * 128) * 128, CK + (size_t)hd * SEQ * 128, CVT + (size_t)(b * 4 + hh) * 256 * SEQ, SEQ, qt * 128, SEQ, slope,
                                                            O12 + ((size_t)m * T + b * SEQ + qt * 128) * 1024 + hh * 256, nullptr, 1024); }
                    else { const float lg = log2f(1.0f - exp2f(-5.0f - (float)hm));
                        flash_item<128, true, false, true>(F, RQ + ((size_t)hd * SEQ + qt * 128) * 128, RK + (size_t)hd * SEQ * 128, RVT + (size_t)hd * 128 * SEQ, SEQ, qt * 128, SEQ, lg,
                                                           OA + ((size_t)(b * SEQ + qt * 128)) * 1024 + hm * 128, nullptr, 1024); }
                }
            }
        }
        SEAM(pb + 2);
        if (IN(pb + 3)) REP(pb + 3) {
            const int lane = F.lane;
            const float* lv = diff_lambda + (size_t)l * 512;
            const float d01 = wave_sum(lv[lane] * lv[128 + lane] + lv[64 + lane] * lv[192 + lane]), d23 = wave_sum(lv[256 + lane] * lv[384 + lane] + lv[320 + lane] * lv[448 + lane]);
            const float lam = __expf(d01) - __expf(d23) + lambda_init;
            for (int t = F.gw; t < T; t += F.NGW) {
#pragma unroll
                for (int h = 0; h < 8; ++h) { const size_t o = (size_t)t * 1024 + h * 128 + 2 * lane;
                    { const float a0 = OA[o], a1 = OA[o + 1]; const float mean = wave_sum(a0 + a1) * (1.f / 128.f); const float c0 = a0 - mean, c1 = a1 - mean; const float rstd = rsqrtf(wave_sum(c0 * c0 + c1 * c1) * (1.f / 128.f) + EPS);
                      const unsigned gv = *(const unsigned*)(RG + o); *(unsigned*)(OCAT + o) = pk2(c0 * rstd * bf2f(gv & 0xffffu), c1 * rstd * __uint_as_float(gv & 0xffff0000u)); }
                    { const float a0 = OB[o], a1 = OB[o + 1]; const float rstd = rsqrtf(wave_sum(a0 * a0 + a1 * a1) * (1.f / 128.f) + EPS); const unsigned gv = *(const unsigned*)(BZ + o);
                      *(unsigned*)(OCAT + (size_t)T * 1024 + o) = pk2(a0 * rstd * gdn_norm_w[l * 128 + 2 * lane] * bf2f(gv & 0xffffu), a1 * rstd * gdn_norm_w[l * 128 + 2 * lane + 1] * __uint_as_float(gv & 0xffff0000u)); } }
#pragma unroll
                for (int h = 0; h < 4; ++h) { const size_t o = (size_t)t * 1024 + h * 256 + 4 * lane; const f32x4 p = *(const f32x4*)(O12 + o), q = *(const f32x4*)(O12 + (size_t)T * 1024 + o); const f32x4 d = p - q * lam;
                    const float rstd = rsqrtf(wave_sum((d[0] * d[0] + d[1] * d[1]) + (d[2] * d[2] + d[3] * d[3])) * (1.f / 256.f) + EPS) * (1.0f - lambda_init); const f32x4 ww = *(const f32x4*)(diff_norm_w + l * 256 + 4 * lane);
                    v2u ov; ov.x = pk2(d[0] * rstd * ww[0], d[1] * rstd * ww[1]); ov.y = pk2(d[2] * rstd * ww[2], d[3] * rstd * ww[3]); *(v2u*)(OCAT + (size_t)2 * T * 1024 + o) = ov; }
            }
        }
        SEAM(pb + 3);
        if (IN(pb + 4)) REP(pb + 4) {
            for (int s = 0; s < 3; ++s) {
                pg8::Gemm g{OCAT + (size_t)s * T * 1024, WBR + ((size_t)l * 3 + s) * D * 1024, T, D, 1024}; pg8::StaticOrder S; S.init(T, D, F.G, (int)blockIdx.x);
                pg8::EpiBranch E{MERGE, MERGEB, GATES, s};
                pg8::gemm_phase<pg8::EpiBranch, pg8::StaticOrder, true, true>(F.lds, g, S, E);
            }
        }
        SEAM(pb + 4);
        if (IN(pb + 5)) REP(pb + 5) {
            pg8::Gemm g{MERGEB, WOUT + (size_t)l * D * D, T, D, D}; pg8::StaticOrder S; S.init(T, D, F.G, (int)blockIdx.x);
            pg8::EpiResid E{xin, XRES, D};
            pg8::gemm_phase<pg8::EpiResid, pg8::StaticOrder, true, true>(F.lds, g, S, E);
        }
        SEAM(pb + 5);
        if (IN(pb + 6)) REP(pb + 6) { for (int r = F.gw; r < T; r += F.NGW) rms_row(XRES + (size_t)r * D, cross_norm_w + l * D, H + (size_t)r * D, F.lane); }
        SEAM(pb + 6);
        if (IN(pb + 7)) REP(pb + 7) {
            pg8::Gemm g{H, WQ + (size_t)l * 512 * D, T, 512, D}; pg8::StaticOrder S; S.init(T, 512, F.G, (int)blockIdx.x);
            pg8::EpiHeads E{QX, nullptr, 4, 11, 1 << 20};
            pg8::gemm_phase<pg8::EpiHeads, pg8::StaticOrder, true, true>(F.lds, g, S, E);
        }
        SEAM(pb + 7);
        if (IN(pb + 8)) REP(pb + 8) {
            for (int it = F.vcu; it < 256; it += F.G) { const int hd = it >> 4, qt = it & 15, b = hd >> 2, hh = hd & 3;
                flash_item<128, false, true, false>(F, QX + ((size_t)hd * SEQ + qt * 128) * 128, KX + ((size_t)l * 16 + hd) * MEML * 128, VXT + ((size_t)l * 16 + hd) * 128 * MEML, MEML, qt * 128, MEML, 0.f,
                                             nullptr, OX + ((size_t)(b * SEQ + qt * 128)) * 512 + hh * 128, 512); }
        }
        SEAM(pb + 8);
        if (IN(pb + 9)) REP(pb + 9) {
            pg8::Gemm g{OX, WO + (size_t)l * D * 512, T, D, 512}; pg8::StaticOrder S; S.init(T, D, F.G, (int)blockIdx.x);
            pg8::EpiResid E{XRES, XRES, D};
            pg8::gemm_phase<pg8::EpiResid, pg8::StaticOrder, true, true>(F.lds, g, S, E);
        }
        SEAM(pb + 9);
        if (IN(pb + 10)) REP(pb + 10) {
            const int lane = F.lane; const float* w = ffn_norm_w + l * D;
            for (int r = F.gw; r < T; r += F.NGW) {
                const float* xrow = XRES + (size_t)r * D; f32x4 v[8]; float ss = 0.f;
#pragma unroll
                for (int j = 0; j < 8; ++j) { v[j] = *(const f32x4*)(xrow + 4 * (lane + 64 * j)); ss += (v[j][0] * v[j][0] + v[j][1] * v[j][1]) + (v[j][2] * v[j][2] + v[j][3] * v[j][3]); }
                const float rstd = rsqrtf(wave_sum(ss) * (1.f / D) + EPS);
                float lg[8];
#pragma unroll
                for (int e = 0; e < 8; ++e) lg[e] = 0.f;
#pragma unroll
                for (int j = 0; j < 8; ++j) { const f32x4 ww = *(const f32x4*)(w + 4 * (lane + 64 * j)); f32x4 y; y[0] = v[j][0] * rstd * ww[0]; y[1] = v[j][1] * rstd * ww[1]; y[2] = v[j][2] * rstd * ww[2]; y[3] = v[j][3] * rstd * ww[3];
                    if (l == 0) { v2u o; o.x = pk2(y[0], y[1]); o.y = pk2(y[2], y[3]); *(v2u*)(H + (size_t)r * D + 4 * (lane + 64 * j)) = o; }
                    else *(unsigned*)(H8 + (size_t)r * D + 4 * (lane + 64 * j)) = pg8::pk4_fp8(y[0], y[1], y[2], y[3]);
                    if (l == 1) {
#pragma unroll
                        for (int c = 0; c < 4; ++c) { const float* rw = router_w + (size_t)(4 * (lane + 64 * j) + c) * 8; const f32x4 r0 = *(const f32x4*)rw, r1 = *(const f32x4*)(rw + 4);
                            lg[0] += y[c] * r0[0]; lg[1] += y[c] * r0[1]; lg[2] += y[c] * r0[2]; lg[3] += y[c] * r0[3]; lg[4] += y[c] * r1[0]; lg[5] += y[c] * r1[1]; lg[6] += y[c] * r1[2]; lg[7] += y[c] * r1[3]; } } }
                if (l == 1) {
#pragma unroll
                    for (int e = 0; e < 8; ++e) lg[e] = wave_sum(lg[e]);
                    int e0 = 0; float v0 = lg[0];
#pragma unroll
                    for (int e = 1; e < 8; ++e) if (lg[e] > v0) { v0 = lg[e]; e0 = e; }
                    int e1 = -1; float v1 = -__builtin_inff();
#pragma unroll
                    for (int e = 0; e < 8; ++e) if (e != e0 && lg[e] > v1) { v1 = lg[e]; e1 = e; }
                    if (lane == 0) { const float p0 = 1.0f / (1.0f + __expf(v1 - v0)); int* ro = ROUTE + (size_t)r * 8;
                        ro[0] = e0; ro[1] = e1; ro[2] = (int)atomicAdd(ctl + CW_CNT + e0, 1u); ro[3] = (int)atomicAdd(ctl + CW_CNT + e1, 1u); ((float*)ro)[4] = p0; ((float*)ro)[5] = 1.0f - p0; }
                }
            }
        }
        SEAM(pb + 10);
        if (l == 0) {
            if (IN(pb + 11)) REP(pb + 11) {
                pg8::Gemm g{H, WGU, T, 2 * DFF, D}; pg8::StaticOrder S; S.init(T, 2 * DFF, F.G, (int)blockIdx.x);
                pg8::EpiSwiglu E{ACT, DFF, 1 << 20};
                pg8::gemm_phase<pg8::EpiSwiglu, pg8::StaticOrder, true, true>(F.lds, g, S, E);
            }
            SEAM(pb + 11);
            if (IN(pb + 12)) REP(pb + 12) {
                pg8::Gemm g{ACT, WDN, T, D, DFF}; pg8::StaticOrder S; S.init(T, D, F.G, (int)blockIdx.x);
                pg8::EpiResid E{XRES, XRES, D};
                pg8::gemm_phase<pg8::EpiResid, pg8::StaticOrder, true, true>(F.lds, g, S, E);
            }
            SEAM(pb + 12);
            if (IN(pb + 13)) REP(pb + 13) { for (int r = F.gw; r < T; r += F.NGW) rms_row(XRES + (size_t)r * D, mix_norm_w + D, H + (size_t)r * D, F.lane); }
            SEAM(pb + 13);
            SEAM(pb + 14);
        } else {
#define MOE_OFFSETS() int off[9]; off[0] = 0; _Pragma("unroll") for (int e = 0; e < 8; ++e) { const int c = __builtin_amdgcn_readfirstlane((int)__hip_atomic_load(ctl + CW_CNT + e, __ATOMIC_RELAXED, __HIP_MEMORY_SCOPE_AGENT)); off[e + 1] = off[e] + ((c + 255) & ~255); }
            if (IN(pb + 11)) REP(pb + 11) {
                MOE_OFFSETS();
                for (int it = F.gw; it < T * 2; it += F.NGW) { const int t = it >> 1, k = it & 1; int* ro = ROUTE + (size_t)t * 8; const int e = ro[k], pos = ro[2 + k];
                    int base = 0;
#pragma unroll
                    for (int q = 0; q < 8; ++q) if (e == q) base = off[q];
                    const int slot = base + pos; if (F.lane == 0) ro[6 + k] = slot;
                    const v4u* src = (const v4u*)(H8 + (size_t)t * D); v4u* dst = (v4u*)((unsigned char*)HG + (size_t)slot * D);
#pragma unroll
                    for (int j = 0; j < 2; ++j) dst[F.lane + 64 * j] = src[F.lane + 64 * j]; }
#pragma unroll
                for (int e = 0; e < 8; ++e) { const int c = __builtin_amdgcn_readfirstlane((int)__hip_atomic_load(ctl + CW_CNT + e, __ATOMIC_RELAXED, __HIP_MEMORY_SCOPE_AGENT));
                    for (int rr = off[e] + c + F.gw; rr < off[e + 1]; rr += F.NGW) { v4u* dst = (v4u*)((unsigned char*)HG + (size_t)rr * D);
#pragma unroll
                        for (int j = 0; j < 2; ++j) dst[F.lane + 64 * j] = (v4u){0u, 0u, 0u, 0u}; } }
            }
            SEAM(pb + 11);
            if (IN(pb + 12)) REP(pb + 12) {
                if (F.tid == 0) { MOE_OFFSETS(); int cu = 0;
#pragma unroll
                    for (int e = 0; e < 8; ++e) { const int ne = (off[e + 1] - off[e]) >> 8; MTAB[e] = ne; MTAB[8 + e] = off[e] >> 8; MTAB[16 + e] = cu; cu += ne * 56; } MTAB[24] = cu; MTAB[25] = cu; }
                __syncthreads();
                pg8::Gemm g{HG, WEGU, MAXSLOT, NEXP * 2 * EFF, D / 2}; pg8::MoeOrder S{(const LAS int*)MTAB, 56, F.G, (int)blockIdx.x};
                pg8::EpiSwiglu8 E{(unsigned char*)EACT, EFF, 56, 1.0f / 256.f, 8.f};
                pg8::gemm_phase<pg8::EpiSwiglu8, pg8::MoeOrder, true, true, true>(F.lds, g, S, E);
            }
            SEAM(pb + 12);
            if (IN(pb + 13)) REP(pb + 13) {
                __syncthreads();
                if (F.tid == 0) { MOE_OFFSETS(); int cu = 0;
#pragma unroll
                    for (int e = 0; e < 8; ++e) { const int ne = (off[e + 1] - off[e]) >> 8; MTAB[e] = ne; MTAB[8 + e] = off[e] >> 8; MTAB[16 + e] = cu; cu += ne * 8; } MTAB[24] = cu; MTAB[25] = cu; }
                __syncthreads();
                pg8::Gemm g{EACT, WEDN, MAXSLOT, NEXP * D, EFF / 2}; pg8::MoeOrder S{(const LAS int*)MTAB, 8, F.G, (int)blockIdx.x};
                pg8::EpiStoreF32 E{Y, D, 8, 1.0f / 2048.f};
                pg8::gemm_phase<pg8::EpiStoreF32, pg8::MoeOrder, true, true, true>(F.lds, g, S, E);
            }
            SEAM(pb + 13);
            if (IN(pb + 14)) REP(pb + 14) {
                const int lane = F.lane;
                for (int r = F.gw; r < T; r += F.NGW) { const int* ro = ROUTE + (size_t)r * 8; const float p0 = ((const float*)ro)[4], p1 = ((const float*)ro)[5]; const float* y0 = Y + (size_t)ro[6] * D; const float* y1 = Y + (size_t)ro[7] * D;
                    const float* xrow = XRES + (size_t)r * D; f32x4 v[8]; float ss = 0.f;
#pragma unroll
                    for (int j = 0; j < 8; ++j) { const int o = 4 * (lane + 64 * j); v[j] = *(const f32x4*)(xrow + o) + *(const f32x4*)(y0 + o) * p0 + *(const f32x4*)(y1 + o) * p1; ss += (v[j][0] * v[j][0] + v[j][1] * v[j][1]) + (v[j][2] * v[j][2] + v[j][3] * v[j][3]); }
                    const float rstd = rsqrtf(wave_sum(ss) * (1.f / D) + EPS);
#pragma unroll
                    for (int j = 0; j < 8; ++j) { const int o = 4 * (lane + 64 * j); const f32x4 ww = *(const f32x4*)(final_norm_w + o); *(f32x4*)(args.out + (size_t)r * D + o) = v[j] * rstd * ww; } }
            }
        }
    }
#undef IN
#undef SEAM
}

extern "C" void kernel_launch(void* const* d_in, const int* in_sizes, int n_in, void* d_out, int out_size, void* d_ws, size_t ws_size, hipStream_t stream) {
    static int grid = 0;
    if (grid == 0) {
        if (n_in != 24 || out_size != T * D || ws_size < WS_END) { fprintf(stderr, "kernel_launch: unexpected shapes (n_in %d, out %d, ws %zu < %zu)\n", n_in, out_size, ws_size, (size_t)WS_END); grid = -1; return; }
        int dev = 0, cus = 0, per_cu = 0;
        if (hipGetDevice(&dev) != hipSuccess || hipDeviceGetAttribute(&cus, hipDeviceAttributeMultiprocessorCount, dev) != hipSuccess) { grid = -1; return; }
        if (hipFuncSetAttribute((const void*)mk_fwd, hipFuncAttributeMaxDynamicSharedMemorySize, LDS_BYTES) != hipSuccess) { fprintf(stderr, "kernel_launch: hipFuncSetAttribute failed\n"); grid = -1; return; }
        if (hipOccupancyMaxActiveBlocksPerMultiprocessor(&per_cu, (const void*)mk_fwd, NWAVES * 64, LDS_BYTES) != hipSuccess || per_cu < 1) fprintf(stderr, "kernel_launch: occupancy query says %d\n", per_cu);
        (void)hipGetLastError();
        grid = cus;
    }
    if (grid < 0) return;
    (void)hipMemsetAsync((char*)d_ws + WS_CTL, 0, CTL_BYTES, stream);
    Args a{};
    for (int i = 0; i < 24; ++i) a.in[i] = d_in[i];
    a.out = (float*)d_out; a.ws = (unsigned char*)d_ws;
#if MK_ONE_LAUNCH
    a.ph_lo = 0; a.ph_hi = NPH;
    hipLaunchKernelGGL(mk_fwd, dim3(grid), dim3(NWAVES * 64), LDS_BYTES, stream, a);
#else
    for (int p = 0; p < NPH; ++p) { a.ph_lo = p; a.ph_hi = p + 1; hipLaunchKernelGGL(mk_fwd, dim3(grid), dim3(NWAVES * 64), LDS_BYTES, stream, a); }
#endif
}
```

```cpp
#include <hip/hip_runtime.h>
#include <cstdio>
#include <cstdint>
#define MK_ONE_LAUNCH 1
namespace pg8 {
#define PG8_LAS __attribute__((address_space(3)))
typedef unsigned short bf16_t;
typedef short bf16x8 __attribute__((ext_vector_type(8)));
typedef float f32x4 __attribute__((ext_vector_type(4)));
typedef unsigned u32x4 __attribute__((ext_vector_type(4)));
typedef int i32x4 __attribute__((ext_vector_type(4)));
constexpr int BM = 256, BK = 64, HALF = 128, HTB = HALF * BK * 2  , STAGE_BYTES = 8 * HTB, NXCD = 8, WGM = 8;

__host__ __device__ __forceinline__ int lds_byte(int r, int c) { const int st = (r >> 4) * 2 + (c >> 5), rr = r & 15, cc = c & 31, ob = rr * 64 + cc * 2; return st * 1024 + (ob ^ (((ob >> 9) & 1) << 5)); }
__host__ __device__ __forceinline__ void stage_rc(int b, int& R, int& C) { const int st = b / 1024, sb = b % 1024, swz = sb ^ (((sb >> 9) & 1) << 5); R = (st >> 1) * 16 + swz / 64; C = (st & 1) * 32 + (swz % 64) / 2; }
__host__ __device__ __forceinline__ int perm32(int rho) { const int n = rho >> 4, i = rho & 15; return 8 * (i >> 2) + 4 * n + (i & 3); }

struct Unit { int pm, pn; };
struct Gemm { const bf16_t* A; const bf16_t* Bt; int M, N, K; };

struct StaticOrder {
    int nM, nN, nwg, G, c;
    __host__ __device__ void init(int M, int N, int G_, int c_) { nM = M / BM; nN = N / BM; nwg = nM * nN; G = G_; c = c_; }
    __host__ __device__ bool next(int i, Unit& u) const {
        const long L = (long)i * G + c; if (L >= nwg) return false;
        int wgid = (int)L; { const int q = nwg / NXCD, r = nwg % NXCD, xcd = wgid % NXCD, off = wgid / NXCD; wgid = (xcd < r ? xcd * (q + 1) : r * (q + 1) + (xcd - r) * q) + off; }
        const int nig = WGM * nN, gid = wgid / nig, fm = gid * WGM, gsz = (nM - fm) < WGM ? (nM - fm) : WGM;
        u.pm = fm + ((wgid % nig) % gsz); u.pn = (wgid % nig) / gsz; return true;
    }
    __device__ __forceinline__ void a_ready(const Unit&) const {}
    __device__ __forceinline__ void done(const Unit&) const {}
};

__device__ __forceinline__ unsigned cvt_pk_bf16(float lo, float hi) { unsigned r; asm volatile("v_cvt_pk_bf16_f32 %0, %1, %2" : "=v"(r) : "v"(lo), "v"(hi)); return r; }
typedef float f32x2 __attribute__((ext_vector_type(2)));
__device__ __forceinline__ float fsilu(float v) { return v / (1.0f + __expf(-v)); }
__device__ __forceinline__ float fsigm(float v) { return 1.0f / (1.0f + __expf(-v)); }
__device__ __forceinline__ void st8bf(bf16_t* p, f32x4 v0, f32x4 v1) { u32x4 w; w.x = cvt_pk_bf16(v0[0], v0[1]); w.y = cvt_pk_bf16(v0[2], v0[3]); w.z = cvt_pk_bf16(v1[0], v1[1]); w.w = cvt_pk_bf16(v1[2], v1[3]); *(u32x4*)p = w; }
__device__ __forceinline__ bf16_t f2bf1(float f) { unsigned u = __builtin_bit_cast(unsigned, f); return (bf16_t)((u + 0x7fffu + ((u >> 16) & 1u)) >> 16); }

struct EpiIn {
    static constexpr bool PERM = true, AFTER_DRAIN = false, HOOK = false;
    bf16_t *RQ, *RK, *RVT, *RG, *BQKV, *BZ, *CQ, *CK, *CVT, *GATES; float* BBA;
    __device__ __forceinline__ void operator()(const f32x4 (&acc)[2][2][4][2], const Unit& u, int wr, int wc, int fr, int fq) const {
        const int pn = u.pn, b = u.pm >> 3;
        const int rowt = u.pm * BM + wr * 64 + fr;
        const int cin = wc * 32 + 8 * fq;
        if (pn < 8 || (pn >= 32 && pn < 40)) {
            auto heads = [&](bf16_t* base, int hb, float sc) __attribute__((always_inline)) {
#pragma unroll
                for (int ai = 0; ai < 2; ++ai)
#pragma unroll
                    for (int m = 0; m < 4; ++m) { const int s = (rowt + ai * HALF + m * 16) - b * 2048;
#pragma unroll
                        for (int bj = 0; bj < 2; ++bj) st8bf(base + ((size_t)((b * 8 + hb + bj) * 2048 + s)) * 128 + cin, acc[ai][bj][m][0] * sc, acc[ai][bj][m][1] * sc); } };
            if (pn < 4) heads(RQ, pn * 2, 1.f); else if (pn < 8) heads(RK, (pn - 4) * 2, 0.08838834764831845f);
            else if (pn < 36) heads(CQ, (pn - 32) * 2, 1.f); else heads(CK, (pn - 36) * 2, 1.f);
        } else if ((pn >= 40 && pn < 44) || (pn >= 8 && pn < 12)) {
            const bool isr = pn < 12; const int h = isr ? pn - 8 : pn - 40; bf16_t* CVT = isr ? RVT : this->CVT;
#pragma unroll
            for (int ai = 0; ai < 2; ++ai)
#pragma unroll
                for (int m = 0; m < 4; ++m) { const int s = (rowt + ai * HALF + m * 16) - b * 2048;
#pragma unroll
                    for (int bj = 0; bj < 2; ++bj)
#pragma unroll
                        for (int n = 0; n < 2; ++n)
#pragma unroll
                            for (int e = 0; e < 4; ++e) CVT[((size_t)((b * 4 + h) * 256 + bj * HALF + cin + 4 * n + e)) * 2048 + s] = f2bf1(acc[ai][bj][m][n][e]); }
        } else if (pn == 68) {
            if (wc == 0 && fq < 2) {
#pragma unroll
                for (int ai = 0; ai < 2; ++ai)
#pragma unroll
                    for (int m = 0; m < 4; ++m) { float* p = BBA + (size_t)(rowt + ai * HALF + m * 16) * 16 + 8 * fq; *(f32x4*)p = acc[ai][0][m][0]; *(f32x4*)(p + 4) = acc[ai][0][m][1]; }
            }
        } else {
            auto rows = [&](bf16_t* base, int ldc, int c0, int act) __attribute__((always_inline)) {
#pragma unroll
                for (int ai = 0; ai < 2; ++ai)
#pragma unroll
                    for (int m = 0; m < 4; ++m) { bf16_t* rowp = base + (size_t)(rowt + ai * HALF + m * 16) * ldc + c0 + cin;
#pragma unroll
                        for (int bj = 0; bj < 2; ++bj) { f32x4 v0 = acc[ai][bj][m][0], v1 = acc[ai][bj][m][1];
                            if (act == 1) {
#pragma unroll
                                for (int e = 0; e < 4; ++e) { v0[e] = fsilu(v0[e]); v1[e] = fsilu(v1[e]); } }
                            else if (act == 2) {
#pragma unroll
                                for (int e = 0; e < 4; ++e) { v0[e] = fsigm(v0[e]); v1[e] = fsigm(v1[e]); } }
                            st8bf(rowp + bj * HALF, v0, v1); } } };
            if (pn < 16) rows(RG, 1024, (pn - 12) * 256, 1); else if (pn < 28) rows(BQKV, 3072, (pn - 16) * 256, 0);
            else if (pn < 32) rows(BZ, 1024, (pn - 28) * 256, 1); else rows(GATES, 6144, (pn - 44) * 256, 2);
        }
    }
};

struct EpiHeads {
    static constexpr bool PERM = true, AFTER_DRAIN = false, HOOK = false;
    bf16_t* O; bf16_t* VT; int NH, rpb_shift  , vt_from_pn;
    __device__ __forceinline__ void operator()(const f32x4 (&acc)[2][2][4][2], const Unit& u, int wr, int wc, int fr, int fq) const {
        const int rowt = u.pm * BM + wr * 64 + fr, cin = wc * 32 + 8 * fq, rpb = 1 << rpb_shift;
        if (u.pn < vt_from_pn) {
#pragma unroll
            for (int ai = 0; ai < 2; ++ai)
#pragma unroll
                for (int m = 0; m < 4; ++m) { const int row = rowt + ai * HALF + m * 16, b = row >> rpb_shift, s = row & (rpb - 1);
#pragma unroll
                    for (int bj = 0; bj < 2; ++bj) st8bf(O + ((size_t)((b * NH + u.pn * 2 + bj) * rpb + s)) * 128 + cin, acc[ai][bj][m][0], acc[ai][bj][m][1]); }
        } else {
            const int hb = (u.pn - vt_from_pn) * 2;
#pragma unroll
            for (int ai = 0; ai < 2; ++ai)
#pragma unroll
                for (int m = 0; m < 4; ++m) { const int row = rowt + ai * HALF + m * 16, b = row >> rpb_shift, s = row & (rpb - 1);
#pragma unroll
                    for (int bj = 0; bj < 2; ++bj)
#pragma unroll
                        for (int n = 0; n < 2; ++n)
#pragma unroll
                            for (int e = 0; e < 4; ++e) VT[((size_t)((b * NH + hb + bj) * 128 + cin + 4 * n + e)) * rpb + s] = f2bf1(acc[ai][bj][m][n][e]); }
        }
    }
};

struct EpiResid {
    static constexpr bool PERM = false, AFTER_DRAIN = false, HOOK = false;
    const float* in; float* out; int ldc; float sc;
    __device__ __forceinline__ void operator()(const f32x4 (&acc)[2][2][4][2], const Unit& u, int wr, int wc, int fr, int fq) const {
        const int row0 = u.pm * BM + wr * 64 + fr, col0 = u.pn * BM + wc * 32 + 4 * fq;
#pragma unroll
        for (int ai = 0; ai < 2; ++ai)
#pragma unroll
            for (int m = 0; m < 4; ++m) { const size_t off = (size_t)(row0 + ai * HALF + m * 16) * ldc + col0;
#pragma unroll
                for (int bj = 0; bj < 2; ++bj)
#pragma unroll
                    for (int n = 0; n < 2; ++n) { const f32x4 x = *(const f32x4*)(in + off + bj * HALF + n * 16); *(f32x4*)(out + off + bj * HALF + n * 16) = x + acc[ai][bj][m][n] * sc; } }
    }
};

struct EpiBranch {
    static constexpr bool PERM = false, AFTER_DRAIN = false, HOOK = true;
    bf16_t* OUT; const bf16_t* GATES; int hk0, hk1;
    typedef unsigned u32x2 __attribute__((ext_vector_type(2)));
    static __device__ __forceinline__ f32x4 g4(const bf16_t* p) { const u32x2 gw = *(const u32x2*)p; f32x4 g; g[0] = __uint_as_float(gw.x << 16); g[1] = __uint_as_float(gw.x & 0xffff0000u); g[2] = __uint_as_float(gw.y << 16); g[3] = __uint_as_float(gw.y & 0xffff0000u); return g; }
    __device__ __forceinline__ void hook(f32x4 (&acc)[2][2][4][2], const Unit& u, int s, int wr, int wc, int fr, int fq) const {
        int z_ = 0; asm volatile("" : "+v"(z_));
        const int row0 = u.pm * BM + wr * 64 + fr + z_, col0 = u.pn * BM + wc * 32 + 4 * fq;
#pragma unroll
        for (int ai = 0; ai < 2; ++ai)
#pragma unroll
            for (int m = 0; m < 4; ++m) { const bf16_t* gp = GATES + (size_t)(row0 + ai * HALF + m * 16) * 6144 + s * 2048 + col0;
#pragma unroll
                for (int bj = 0; bj < 2; ++bj)
#pragma unroll
                    for (int n = 0; n < 2; ++n) { const f32x4 ga = g4(gp + bj * HALF + n * 16), gb = g4(gp + 2048 + bj * HALF + n * 16);
#pragma unroll
                        for (int e = 0; e < 4; ++e) acc[ai][bj][m][n][e] *= ga[e] * __builtin_amdgcn_rcpf(__builtin_fmaxf(gb[e], 1e-30f)); } }
    }
    __device__ __forceinline__ void operator()(const f32x4 (&acc)[2][2][4][2], const Unit& u, int wr, int wc, int fr, int fq) const {
        const int row0 = u.pm * BM + wr * 64 + fr, col0 = u.pn * BM + wc * 32 + 4 * fq;
#pragma unroll
        for (int ai = 0; ai < 2; ++ai)
#pragma unroll
            for (int m = 0; m < 4; ++m) { const int row = row0 + ai * HALF + m * 16;
#pragma unroll
                for (int bj = 0; bj < 2; ++bj)
#pragma unroll
                    for (int n = 0; n < 2; ++n) { const int col = col0 + bj * HALF + n * 16; const f32x4 v = g4(GATES + (size_t)row * 6144 + 4096 + col) * acc[ai][bj][m][n];
                        u32x2 w; w.x = cvt_pk_bf16(v[0], v[1]); w.y = cvt_pk_bf16(v[2], v[3]); *(u32x2*)(OUT + (size_t)row * 2048 + col) = w; } }
    }
};

struct EpiSwiglu {
    static constexpr bool PERM = true, AFTER_DRAIN = false, HOOK = false;
    bf16_t* O; int ldc, npn;
    __device__ __forceinline__ void operator()(const f32x4 (&acc)[2][2][4][2], const Unit& u, int wr, int wc, int fr, int fq) const {
        const int row0 = u.pm * BM + wr * 64 + fr, col0 = (u.pn % npn) * HALF + wc * 32 + 8 * fq;
#pragma unroll
        for (int ai = 0; ai < 2; ++ai)
#pragma unroll
            for (int m = 0; m < 4; ++m) { f32x4 v0, v1;
#pragma unroll
                for (int e = 0; e < 4; ++e) { v0[e] = fsilu(acc[ai][0][m][0][e]) * acc[ai][1][m][0][e]; v1[e] = fsilu(acc[ai][0][m][1][e]) * acc[ai][1][m][1][e]; }
                st8bf(O + (size_t)(row0 + ai * HALF + m * 16) * ldc + col0, v0, v1); }
    }
};


__device__ __forceinline__ float clamp8(float v) { return __builtin_fminf(__builtin_fmaxf(v, -448.f), 448.f); }
__device__ __forceinline__ unsigned pk4_fp8(float a, float b, float c, float d) { int r = 0; r = __builtin_amdgcn_cvt_pk_fp8_f32(clamp8(a), clamp8(b), r, false); r = __builtin_amdgcn_cvt_pk_fp8_f32(clamp8(c), clamp8(d), r, true); return (unsigned)r; }
struct EpiSwiglu8 {
    static constexpr bool PERM = true, AFTER_DRAIN = false, HOOK = false;
    unsigned char* O; int ldc, npn; float ws, as;
    __device__ __forceinline__ void operator()(const f32x4 (&acc)[2][2][4][2], const Unit& u, int wr, int wc, int fr, int fq) const {
        typedef unsigned u32x2 __attribute__((ext_vector_type(2)));
        const int row0 = u.pm * BM + wr * 64 + fr, col0 = (u.pn % npn) * HALF + wc * 32 + 8 * fq;
#pragma unroll
        for (int ai = 0; ai < 2; ++ai)
#pragma unroll
            for (int m = 0; m < 4; ++m) { float v[8];
#pragma unroll
                for (int n = 0; n < 2; ++n)
#pragma unroll
                    for (int e = 0; e < 4; ++e) v[4 * n + e] = fsilu(acc[ai][0][m][n][e] * ws) * (acc[ai][1][m][n][e] * ws) * as;
                u32x2 o; o.x = pk4_fp8(v[0], v[1], v[2], v[3]); o.y = pk4_fp8(v[4], v[5], v[6], v[7]);
                *(u32x2*)(O + (size_t)(row0 + ai * HALF + m * 16) * ldc + col0) = o; }
    }
};

struct EpiStoreF32 {
    static constexpr bool PERM = false, AFTER_DRAIN = false, HOOK = false;
    float* Y; int ldc, npn; float sc;
    __device__ __forceinline__ void operator()(const f32x4 (&acc)[2][2][4][2], const Unit& u, int wr, int wc, int fr, int fq) const {
        const int row0 = u.pm * BM + wr * 64 + fr, col0 = (u.pn % npn) * BM + wc * 32 + 4 * fq;
#pragma unroll
        for (int ai = 0; ai < 2; ++ai)
#pragma unroll
            for (int m = 0; m < 4; ++m) { float* rowp = Y + (size_t)(row0 + ai * HALF + m * 16) * ldc + col0;
#pragma unroll
                for (int bj = 0; bj < 2; ++bj)
#pragma unroll
                    for (int n = 0; n < 2; ++n) *(f32x4*)(rowp + bj * HALF + n * 16) = acc[ai][bj][m][n] * sc; }
    }
};

struct MoeOrder {
    const PG8_LAS int* T; int npn, G, c;
    __device__ __forceinline__ int rd(int k) const { return __builtin_amdgcn_readfirstlane(T[k]); }
    __device__ __forceinline__ bool next(int i, Unit& u) const {
        const int total = rd(25); const long L = (long)i * G + c; if (L >= total) return false;
        int wgid = (int)L; { const int q = total / NXCD, r = total % NXCD, xcd = wgid % NXCD, off = wgid / NXCD; wgid = (xcd < r ? xcd * (q + 1) : r * (q + 1) + (xcd - r) * q) + off; }
        int e = 0, cue = 0;
#pragma unroll
        for (int k = 1; k < 8; ++k) { const int ck = rd(16 + k); if (wgid >= ck) { e = k; cue = ck; } }
        const int loc = wgid - cue, ne = rd(e), r0 = rd(8 + e);
        u.pm = r0 + loc % ne; u.pn = e * npn + loc / ne; return true;
    }
    __device__ __forceinline__ void a_ready(const Unit&) const {}
    __device__ __forceinline__ void done(const Unit&) const {}
};

struct SegOrder {
    int nM, nN, nseg, G, c;
    __device__ __forceinline__ bool next(int i, Unit& u) const {
        const int nwg = nM * nN; const long L = (long)i * G + c; if (L >= (long)nseg * nwg) return false;
        const int s = (int)(L / nwg); int wgid = (int)(L % nwg); { const int q = nwg / NXCD, r = nwg % NXCD, xcd = wgid % NXCD, off = wgid / NXCD; wgid = (xcd < r ? xcd * (q + 1) : r * (q + 1) + (xcd - r) * q) + off; }
        const int nig = WGM * nN, gid = wgid / nig, fm = gid * WGM, gsz = (nM - fm) < WGM ? (nM - fm) : WGM;
        u.pm = s * nM + fm + ((wgid % nig) % gsz); u.pn = s * nN + (wgid % nig) / gsz; return true;
    }
    __device__ __forceinline__ void a_ready(const Unit&) const {}
    __device__ __forceinline__ void done(const Unit&) const {}
};
template <class Epi, class Sched, bool ALIGN_EPI = false, bool SP2 = false, bool F8 = false>
__device__ __forceinline__ void gemm_phase(PG8_LAS unsigned char* lds, const Gemm g, const Sched& S, const Epi& E) {
    int tid_ = threadIdx.x; asm volatile("" : "+v"(tid_)); const int tid = tid_, wid = __builtin_amdgcn_readfirstlane(tid >> 6), lane = tid & 63, wr = wid >> 2, wc = wid & 3, fr = lane & 15, fq = lane >> 4;
    const int K = g.K, nt = K / BK; typedef int i32x8 __attribute__((ext_vector_type(8))); int f8scale_ = 0x7f7f7f7f; asm volatile("" : "+v"(f8scale_));
    unsigned voffA[2], voffB[2];
#pragma unroll
    for (int i = 0; i < 2; ++i) { int R, C; stage_rc(tid * 16 + i * 8192, R, C); const int Rb = Epi::PERM ? ((R & ~31) + perm32(R & 31)) : R;
        voffA[i] = (unsigned)(R * K + C) * 2u; voffB[i] = (unsigned)(Rb * K + C) * 2u; }
    const size_t kstep = (size_t)(BK * 2);
    const size_t hstep = (size_t)HALF * K * 2;
    const size_t tstep = 2 * hstep;
    const unsigned ldsw = (unsigned)wid * 1024u;
    const int aoff = lds_byte(wr * 64 + fr, fq * 8), boff = lds_byte(wc * 32 + fr, fq * 8);
#define PG8_SA(b, h) (((b) * 2 + (h)) * HTB)
#define PG8_SB(b, h) ((4 + (b) * 2 + (h)) * HTB)
#define PG8_STAGE(bufoff, gbase, voff) do { _Pragma("unroll") for (int _i = 0; _i < 2; ++_i) \
        __builtin_amdgcn_global_load_lds((const unsigned*)((const char*)(gbase) + (voff)[_i]), (PG8_LAS unsigned*)(lds + (bufoff) + ldsw + _i * 8192), 16, 0, 0); } while (0)
#define PG8_LDA(dst, b, h) do { _Pragma("unroll") for (int m = 0; m < 4; ++m) _Pragma("unroll") for (int k = 0; k < 2; ++k) dst[m][k] = *(const PG8_LAS bf16x8*)(lds + PG8_SA(b, h) + aoff + m * 2048 + k * 1024); } while (0)
#define PG8_LDB(dst, b, h) do { _Pragma("unroll") for (int n = 0; n < 2; ++n) _Pragma("unroll") for (int k = 0; k < 2; ++k) dst[n][k] = *(const PG8_LAS bf16x8*)(lds + PG8_SB(b, h) + boff + n * 2048 + k * 1024); } while (0)
#define PG8_MMA(ai, bj, At, Bt) do { __builtin_amdgcn_s_setprio(1); \
        if constexpr (F8) { _Pragma("unroll") for (int m = 0; m < 4; ++m) _Pragma("unroll") for (int n = 0; n < 2; ++n) { \
            const i32x4 b0_ = __builtin_bit_cast(i32x4, Bt[n][0]), b1_ = __builtin_bit_cast(i32x4, Bt[n][1]), a0_ = __builtin_bit_cast(i32x4, At[m][0]), a1_ = __builtin_bit_cast(i32x4, At[m][1]); \
            const i32x8 bb_ = __builtin_shufflevector(b0_, b1_, 0, 1, 2, 3, 4, 5, 6, 7), aa_ = __builtin_shufflevector(a0_, a1_, 0, 1, 2, 3, 4, 5, 6, 7); \
            asm volatile("v_mfma_scale_f32_16x16x128_f8f6f4 %0, %1, %2, %0, %3, %3 op_sel_hi:[0,0,0]" : "+v"(acc[ai][bj][m][n]) : "v"(bb_), "v"(aa_), "v"(f8scale_)); } } \
        else { _Pragma("unroll") for (int m = 0; m < 4; ++m) _Pragma("unroll") for (int n = 0; n < 2; ++n) _Pragma("unroll") for (int k = 0; k < 2; ++k) \
        acc[ai][bj][m][n] = __builtin_amdgcn_mfma_f32_16x16x32_bf16(Bt[n][k], At[m][k], acc[ai][bj][m][n], 0, 0, 0); } __builtin_amdgcn_s_setprio(0); } while (0)
#define PG8_WAIT_V(n) asm volatile("s_waitcnt vmcnt(" #n ")" ::: "memory")
#define PG8_WAIT_L(n) asm volatile("s_waitcnt lgkmcnt(" #n ")" ::: "memory")
#define PG8_BAR __builtin_amdgcn_s_barrier()
#define PG8_SCHED __builtin_amdgcn_sched_barrier(0)
    Unit cur, nxt; int ui = 0;
    if (!S.next(0, cur)) return;
    f32x4 acc[2][2][4][2];
#pragma unroll
    for (int a = 0; a < 2; ++a)
#pragma unroll
        for (int b = 0; b < 2; ++b)
#pragma unroll
            for (int m = 0; m < 4; ++m)
#pragma unroll
                for (int n = 0; n < 2; ++n) acc[a][b][m][n] = (f32x4){0.f, 0.f, 0.f, 0.f};
    bf16x8 At[4][2], B0[2][2], B1[2][2];
    const char* cA = (const char*)g.A + (size_t)cur.pm * tstep; const char* cB = (const char*)g.Bt + (size_t)cur.pn * tstep;
    S.a_ready(cur);
    if constexpr (SP2) {
        PG8_STAGE(PG8_SB(0, 0), cB, voffB); PG8_STAGE(PG8_SB(0, 1), cB + hstep, voffB); PG8_STAGE(PG8_SA(0, 0), cA, voffA); PG8_STAGE(PG8_SA(0, 1), cA + hstep, voffA);
        if (wr == 1) PG8_BAR;
        PG8_WAIT_V(2); PG8_BAR;
        PG8_STAGE(PG8_SB(1, 0), cB + kstep, voffB); PG8_STAGE(PG8_SA(1, 0), cA + kstep, voffA); PG8_STAGE(PG8_SB(1, 1), cB + hstep + kstep, voffB);
        PG8_WAIT_V(6); PG8_BAR;
    } else {
        PG8_STAGE(PG8_SB(0, 0), cB, voffB); PG8_STAGE(PG8_SA(0, 0), cA, voffA); PG8_STAGE(PG8_SB(0, 1), cB + hstep, voffB); PG8_STAGE(PG8_SA(0, 1), cA + hstep, voffA);
        if (wr == 1) PG8_BAR;
        PG8_WAIT_V(4); PG8_BAR;
        PG8_STAGE(PG8_SB(1, 0), cB + kstep, voffB); PG8_STAGE(PG8_SA(1, 0), cA + kstep, voffA); PG8_STAGE(PG8_SB(1, 1), cB + hstep + kstep, voffB);
        PG8_WAIT_V(6); PG8_BAR;
    }
    for (;;) {
        const bool has_next = S.next(ui + 1, nxt);
        const char* nA = has_next ? (const char*)g.A + (size_t)nxt.pm * tstep : cA; const char* nB = has_next ? (const char*)g.Bt + (size_t)nxt.pn * tstep : cB;
        for (int t = 0; t < nt; t += 2) {
            const bool last = (t == nt - 2);
            const char* a1 = cA + (size_t)(t + 1) * kstep;
            const char* a2 = last ? nA : cA + (size_t)(t + 2) * kstep; const char* b2 = last ? nB : cB + (size_t)(t + 2) * kstep;
            const char* a3 = a2 + kstep; const char* b3 = b2 + kstep;
            if (last && has_next) S.a_ready(nxt);
            if constexpr (Epi::HOOK) { if (t == E.hk0 || t == E.hk1) E.hook(acc, cur, t == E.hk0 ? 0 : 1, wr, wc, fr, fq); }
            if constexpr (SP2) {
            PG8_LDB(B0, 0, 0); PG8_LDB(B1, 0, 1); PG8_SCHED; PG8_LDA(At, 0, 0); PG8_STAGE(PG8_SA(1, 1), a1 + hstep, voffA);
            PG8_WAIT_V(8); PG8_WAIT_L(0); PG8_BAR; PG8_MMA(0, 0, At, B0); PG8_MMA(0, 1, At, B1); PG8_BAR; PG8_SCHED;
            PG8_LDA(At, 0, 1); PG8_STAGE(PG8_SB(0, 0), b2, voffB); PG8_STAGE(PG8_SB(0, 1), b2 + hstep, voffB); PG8_STAGE(PG8_SA(0, 0), a2, voffA);
            PG8_WAIT_V(8); PG8_WAIT_L(0); PG8_BAR; PG8_MMA(1, 0, At, B0); PG8_MMA(1, 1, At, B1); PG8_BAR; PG8_SCHED;
            PG8_LDB(B0, 1, 0); PG8_LDB(B1, 1, 1); PG8_SCHED; PG8_LDA(At, 1, 0); PG8_STAGE(PG8_SA(0, 1), a2 + hstep, voffA);
            PG8_WAIT_V(8); PG8_WAIT_L(0); PG8_BAR; PG8_MMA(0, 0, At, B0); PG8_MMA(0, 1, At, B1); PG8_BAR; PG8_SCHED;
            PG8_LDA(At, 1, 1); PG8_STAGE(PG8_SB(1, 0), b3, voffB); PG8_STAGE(PG8_SB(1, 1), b3 + hstep, voffB); PG8_STAGE(PG8_SA(1, 0), a3, voffA);
            PG8_WAIT_V(8); PG8_WAIT_L(0); PG8_BAR; PG8_MMA(1, 0, At, B0); PG8_MMA(1, 1, At, B1); PG8_BAR; PG8_SCHED;
            } else {
            PG8_LDB(B0, 0, 0); PG8_SCHED; PG8_LDA(At, 0, 0); PG8_STAGE(PG8_SA(1, 1), a1 + hstep, voffA);
            PG8_WAIT_L(8); PG8_BAR; PG8_WAIT_L(0); PG8_MMA(0, 0, At, B0); PG8_BAR; PG8_SCHED;
            PG8_LDB(B1, 0, 1); PG8_STAGE(PG8_SB(0, 0), b2, voffB);
            PG8_BAR; PG8_WAIT_L(0); PG8_MMA(0, 1, At, B1); PG8_BAR;
            PG8_LDA(At, 0, 1); PG8_STAGE(PG8_SA(0, 0), a2, voffA);
            PG8_BAR; PG8_WAIT_L(0); PG8_MMA(1, 0, At, B0); PG8_BAR; PG8_SCHED;
            PG8_STAGE(PG8_SB(0, 1), b2 + hstep, voffB);
            PG8_WAIT_V(6); PG8_BAR; PG8_MMA(1, 1, At, B1); PG8_BAR;
            PG8_LDB(B0, 1, 0); PG8_SCHED; PG8_LDA(At, 1, 0); PG8_STAGE(PG8_SA(0, 1), a2 + hstep, voffA);
            PG8_WAIT_L(8); PG8_BAR; PG8_WAIT_L(0); PG8_MMA(0, 0, At, B0); PG8_BAR; PG8_SCHED;
            PG8_LDB(B1, 1, 1); PG8_STAGE(PG8_SB(1, 0), b3, voffB);
            PG8_BAR; PG8_WAIT_L(0); PG8_MMA(0, 1, At, B1); PG8_BAR;
            PG8_LDA(At, 1, 1); PG8_STAGE(PG8_SA(1, 0), a3, voffA);
            PG8_BAR; PG8_WAIT_L(0); PG8_MMA(1, 0, At, B0); PG8_BAR; PG8_SCHED;
            PG8_STAGE(PG8_SB(1, 1), b3 + hstep, voffB);
            PG8_WAIT_V(6); PG8_BAR; PG8_MMA(1, 1, At, B1); PG8_BAR;
            }
        }
        if constexpr (ALIGN_EPI) { if (wr == 0) PG8_BAR; }
        if constexpr (F8) asm volatile("s_nop 15\n\ts_nop 15" ::: "memory");
        if constexpr (!Epi::AFTER_DRAIN) { E(acc, cur, wr, wc, fr, fq); S.done(cur); }
        if (!has_next) break;
#pragma unroll
        for (int a = 0; a < 2; ++a)
#pragma unroll
            for (int b = 0; b < 2; ++b)
#pragma unroll
                for (int m = 0; m < 4; ++m)
#pragma unroll
                    for (int n = 0; n < 2; ++n) acc[a][b][m][n] = (f32x4){0.f, 0.f, 0.f, 0.f};
        cur = nxt; cA = nA; cB = nB; ++ui;
        if constexpr (ALIGN_EPI) { if (wr == 1) PG8_BAR; }
    }
    PG8_WAIT_V(0);
    if constexpr (!ALIGN_EPI) { if (wr == 0) PG8_BAR; }
    PG8_BAR;
    if constexpr (Epi::AFTER_DRAIN) { E.fused(acc, cur, wr, wc, fr, fq, lds, wid, lane); S.done(cur); }
#undef PG8_SA
#undef PG8_SB
#undef PG8_STAGE
#undef PG8_LDA
#undef PG8_LDB
#undef PG8_MMA
#undef PG8_WAIT_V
#undef PG8_WAIT_L
#undef PG8_BAR
#undef PG8_SCHED
}
}
#ifndef MK_ONE_LAUNCH
#define MK_ONE_LAUNCH 0
#endif
constexpr int NWAVES = 8;
constexpr int NB = 4, SEQ = 2048, T = NB * SEQ, D = 2048, MEML = 256, MEMR = NB * MEML;
constexpr int NINP = 17664;
constexpr int DFF = 5632, EFF = 7168, NEXP = 8, MAXSLOT = 18432;
constexpr float EPS = 1e-6f;
constexpr int NPL = 15, NPH = 2 + 2 * NPL;

constexpr size_t MiB = 1u << 20;
constexpr size_t WS_CTL = 0, CTL_BYTES = 1 * MiB;
constexpr size_t WS_WIN = WS_CTL + CTL_BYTES;
constexpr size_t WS_WBR = WS_WIN + 2 * 69 * MiB;
constexpr size_t WS_WOUT = WS_WBR + 2 * 12 * MiB;
constexpr size_t WS_WQ = WS_WOUT + 2 * 8 * MiB;
constexpr size_t WS_WKV = WS_WQ + 2 * 2 * MiB;
constexpr size_t WS_WO = WS_WKV + 2 * 4 * MiB;
constexpr size_t WS_WGU = WS_WO + 2 * 2 * MiB;
constexpr size_t WS_WDN = WS_WGU + 44 * MiB;
constexpr size_t WS_WEGU = WS_WDN + 22 * MiB;
constexpr size_t WS_WEDN = WS_WEGU + 448 * MiB;
constexpr size_t WS_XRES = WS_WEDN + 224 * MiB;
constexpr size_t WS_H = WS_XRES + 64 * MiB;
constexpr size_t WS_RQ = WS_H + 32 * MiB, WS_RK = WS_RQ + 16 * MiB, WS_RV = WS_RK + 16 * MiB, WS_RG = WS_RV + 16 * MiB;
constexpr size_t WS_BQKV = WS_RG + 16 * MiB;
constexpr size_t WS_BZ = WS_BQKV + 48 * MiB;
constexpr size_t WS_BBA = WS_BZ + 16 * MiB;
constexpr size_t WS_CQ = WS_BBA + 1 * MiB, WS_CK = WS_CQ + 16 * MiB, WS_CVT = WS_CK + 16 * MiB;
constexpr size_t WS_GATES = WS_CVT + 16 * MiB;
constexpr size_t WS_GQ = WS_GATES + 96 * MiB, WS_GK = WS_GQ + 16 * MiB, WS_GV = WS_GK + 16 * MiB;
constexpr size_t WS_GG = WS_GV + 16 * MiB, WS_GB = WS_GG + 1 * MiB;
constexpr size_t WS_OA = WS_GB + 1 * MiB, WS_OB = WS_OA + 32 * MiB;
constexpr size_t WS_O12 = WS_OB + 32 * MiB;
constexpr size_t WS_OCAT = WS_O12 + 64 * MiB;
constexpr size_t WS_MERGE = WS_OCAT + 48 * MiB;
constexpr size_t WS_MERGEB = WS_MERGE + 64 * MiB;
constexpr size_t WS_MEMN = WS_MERGEB + 32 * MiB;
constexpr size_t WS_KX = WS_MEMN + 8 * MiB;
constexpr size_t WS_VXT = WS_KX + 2 * MiB;
constexpr size_t WS_QX = WS_VXT + 2 * MiB;
constexpr size_t WS_OX = WS_QX + 8 * MiB;
constexpr size_t WS_ACT = WS_OX + 8 * MiB;
constexpr size_t WS_HG = WS_ACT + 88 * MiB;
constexpr size_t WS_EACT = WS_HG + 72 * MiB;
constexpr size_t WS_Y = WS_EACT + 252 * MiB;
constexpr size_t WS_ROUTE = WS_Y + 144 * MiB;
constexpr size_t WS_GCH = WS_ROUTE + 1 * MiB;
constexpr size_t WS_GL = WS_GCH + 88 * MiB;
constexpr size_t WS_H8 = WS_GL + 1 * MiB;
constexpr size_t WS_END = WS_H8 + 16 * MiB;
constexpr int CW_CNT = 64;
constexpr int CW_BAR = 4096;

constexpr int RING_BYTES = 131072, MISC_OFF = RING_BYTES + 320, LDS_BYTES = 147456;

#define GAS __attribute__((address_space(1)))
#define LAS __attribute__((address_space(3)))
#define DI __device__ __forceinline__
typedef unsigned short bf16;
typedef unsigned v4u __attribute__((ext_vector_type(4)));
typedef unsigned v2u __attribute__((ext_vector_type(2)));
typedef float f32x4 __attribute__((ext_vector_type(4)));
typedef short bf16x8 __attribute__((ext_vector_type(8)));
typedef short s16x4 __attribute__((ext_vector_type(4)));
DI float bf2f(unsigned v) { return __uint_as_float(v << 16); }
DI unsigned f2bf(float f) { unsigned u = __builtin_bit_cast(unsigned, f); return (u + 0x7fffu + ((u >> 16) & 1u)) >> 16; }
DI unsigned pk2(float lo, float hi) { return f2bf(lo) | (f2bf(hi) << 16); }
DI float wave_sum(float v) {
#pragma unroll
    for (int o = 1; o < 64; o <<= 1) v += __shfl_xor(v, o);
    return v;
}

#define XB_TMO      128
#define XB_XCNT(j)  (256  + 64 * (j))
#define XB_XSUB(j)  (1280 + 64 * (j))
#define XB_XGEN(j)  (2304 + 64 * (j))
#define XB_TOP      3328
#define XB_TOPGEN   3392
#define XCD_BAR_WORDS 3456
#define XB_SPIN_CAP (1u << 18)

__device__ __forceinline__ unsigned xb_ld(unsigned* p)              { return __hip_atomic_load(p, __ATOMIC_RELAXED, __HIP_MEMORY_SCOPE_AGENT); }
__device__ __forceinline__ unsigned xb_add(unsigned* p, unsigned v) { return __hip_atomic_fetch_add(p, v, __ATOMIC_RELAXED, __HIP_MEMORY_SCOPE_AGENT); }
__device__ __forceinline__ unsigned xb_xcc_id() { return (unsigned)__builtin_amdgcn_s_getreg((3 << 11) | 20) & 0xFu; }
#define XB_SPIN(cond, bar) do { unsigned _sp = 0; while (cond) { __builtin_amdgcn_s_sleep(1); \
    if ((++_sp & 255u) == 0u) { if (xb_ld(&(bar)[XB_TMO])) break; if (_sp > XB_SPIN_CAP) { atomicAdd(&(bar)[XB_TMO], 1u); break; } } } } while (0)

struct XcdBarrier {
    unsigned* bar; unsigned x;
    volatile LAS unsigned* st;
};

__device__ __forceinline__ XcdBarrier xcd_barrier_post(unsigned* bar, volatile LAS unsigned* st) {
    XcdBarrier b; b.bar = bar; b.x = xb_xcc_id(); b.st = st;
    if (threadIdx.x == 0) (void)xb_add(&bar[XB_XCNT(b.x)], 1u);
    return b;
}
__device__ __forceinline__ void xcd_barrier_complete(unsigned* bar, unsigned x, unsigned& nloc, unsigned& nx) {
    const unsigned G = gridDim.x * gridDim.y * gridDim.z;
    unsigned sum, cnt, mine, sp = 0u;
    for (;;) {
        sum = 0u; cnt = 0u; mine = 0u;
#pragma unroll
        for (unsigned j = 0; j < 16; ++j) { const unsigned c = xb_ld(&bar[XB_XCNT(j)]); sum += c; cnt += (c > 0u) ? 1u : 0u; mine = (j == x) ? c : mine; }
        if (sum == G) break;
        __builtin_amdgcn_s_sleep(1);
        if ((++sp & 255u) == 0u) { if (xb_ld(&bar[XB_TMO])) break; if (sp > XB_SPIN_CAP) { atomicAdd(&bar[XB_TMO], 1u); break; } }
    }
    nloc = mine > 0u ? mine : 1u; nx = cnt > 0u ? cnt : 1u;
}

__device__ __forceinline__ void xcd_barrier(const XcdBarrier& b) {
    asm volatile("s_waitcnt vmcnt(0)" ::: "memory");
    __syncthreads();
    if (threadIdx.x == 0) {
        unsigned* bar = b.bar;
        __builtin_amdgcn_s_waitcnt(0);
        unsigned nloc = b.st[0], nx = b.st[1];
        if (nloc == 0u) { xcd_barrier_complete(bar, b.x, nloc, nx); b.st[0] = nloc; b.st[1] = nx; }
        const unsigned old = xb_add(&bar[XB_XSUB(b.x)], 1u);
        const unsigned gen = old / nloc;
        if (old + 1u == (gen + 1u) * nloc) {
            __builtin_amdgcn_fence(__ATOMIC_RELEASE, "agent");
            asm volatile("s_waitcnt vmcnt(0)" ::: "memory");
            const unsigned og = xb_add(&bar[XB_TOP], 1u);
            const unsigned tg = og / nx;
            if (og + 1u == (tg + 1u) * nx) xb_add(&bar[XB_TOPGEN], 1u);
            else XB_SPIN(xb_ld(&bar[XB_TOPGEN]) == tg, bar);
            __builtin_amdgcn_fence(__ATOMIC_ACQUIRE, "agent");
            xb_add(&bar[XB_XGEN(b.x)], 1u);
            asm volatile("s_waitcnt vmcnt(0)" ::: "memory");
        } else {
            XB_SPIN(xb_ld(&bar[XB_XGEN(b.x)]) == gen, bar);
            __builtin_amdgcn_fence(__ATOMIC_ACQUIRE, "agent");
            asm volatile("s_waitcnt vmcnt(0)" ::: "memory");
        }
    }
    __syncthreads();
}

struct Args { const void* in[24]; float* out; unsigned char* ws; int ph_lo, ph_hi; };

struct Frame {
    LAS unsigned char* lds;
    int tid, lane, wave, G, vcu, gw, NGW;
};

DI void conv_job(const Frame& F, const float* W, int K, int Nsrc, bf16* WT, int Ndst, int mode, int Fgu) {
    LAS unsigned* scr = (LAS unsigned*)(F.lds + F.wave * 8704);
    const int nkb = K / 64, nnb = Ndst / 64, items = nkb * nnb, lane = F.lane;
    for (int it = F.gw; it < items; it += F.NGW) {
        const int nb = it / nkb, kb = it % nkb, k0 = kb * 64, n0 = nb * 64, n = n0 + lane;
        int ns;
        if (mode == 0) ns = n;
        else if (mode == 1) ns = n < 8192 ? n : (n < 17408 ? n + 16 : (n < 17424 ? n - 17408 + 8192 : -1));
        else { const int pn = n >> 8, half = (n >> 7) & 1, j = n & 127; ns = half * Fgu + 128 * pn + j; }
        const float* src = W + (size_t)k0 * Nsrc + (ns < 0 ? 0 : ns);
#pragma unroll 8
        for (int i = 0; i < 32; ++i) { float a = src[(size_t)(2 * i) * Nsrc], b = src[(size_t)(2 * i + 1) * Nsrc]; if (ns < 0) { a = 0.f; b = 0.f; } scr[lane * 33 + i] = pk2(a, b); }
        asm volatile("s_waitcnt lgkmcnt(0)" ::: "memory");
#pragma unroll
        for (int j = 0; j < 8; ++j) { const int nn = (lane >> 3) + 8 * j, kq = lane & 7; v4u o; const LAS unsigned* s = scr + nn * 33 + 4 * kq; o.x = s[0]; o.y = s[1]; o.z = s[2]; o.w = s[3];
            *(v4u*)(WT + (size_t)(n0 + nn) * K + k0 + 8 * kq) = o; }
        asm volatile("s_waitcnt lgkmcnt(0)" ::: "memory");
    }
}

DI void conv_job_f8(const Frame& F, const float* W, int K, int Nsrc, unsigned char* WT, int Ndst, int mode, int Fgu, float scale) {
    LAS unsigned* scr = (LAS unsigned*)(F.lds + F.wave * 8704);
    const int nkb = K / 128, nnb = Ndst / 64, items = nkb * nnb, lane = F.lane;
    for (int it = F.gw; it < items; it += F.NGW) {
        const int nb = it / nkb, kb = it % nkb, k0 = kb * 128, n0 = nb * 64, n = n0 + lane;
        int ns;
        if (mode == 0) ns = n; else { const int pn = n >> 8, half = (n >> 7) & 1, j = n & 127; ns = half * Fgu + 128 * pn + j; }
        const float* src = W + (size_t)k0 * Nsrc + ns;
#pragma unroll 4
        for (int i = 0; i < 32; ++i) { const float a = src[(size_t)(4 * i) * Nsrc], b = src[(size_t)(4 * i + 1) * Nsrc], c = src[(size_t)(4 * i + 2) * Nsrc], d = src[(size_t)(4 * i + 3) * Nsrc]; scr[lane * 33 + i] = pg8::pk4_fp8(a * scale, b * scale, c * scale, d * scale); }
        asm volatile("s_waitcnt lgkmcnt(0)" ::: "memory");
#pragma unroll
        for (int j = 0; j < 8; ++j) { const int nn = (lane >> 3) + 8 * j, kq = lane & 7; v4u o; const LAS unsigned* s = scr + nn * 33 + 4 * kq; o.x = s[0]; o.y = s[1]; o.z = s[2]; o.w = s[3];
            *(v4u*)(WT + (size_t)(n0 + nn) * K + k0 + 16 * kq) = o; }
        asm volatile("s_waitcnt lgkmcnt(0)" ::: "memory");
    }
}

template <bool F8>
DI void conv_wg(const Frame& F, const float* W, int K, int Nsrc, void* WTv, int Ndst, int mode, int Fgu, float scale) {
    constexpr int KI = F8 ? 256 : 128;
    LAS unsigned* scr = (LAS unsigned*)F.lds;
    const int nkb = K / KI, items = nkb * (Ndst / 256), lane = F.lane, w = F.wave, tid = F.tid;
    for (int it = F.vcu; it < items; it += F.G) {
        const int nb = it / nkb, kb = it % nkb, k0 = kb * KI, n0 = nb * 256, n = n0 + 4 * lane;
        int ns;
        if (mode == 0) ns = n;
        else if (mode == 1) ns = n < 8192 ? n : (n < 17408 ? n + 16 : (n < 17424 ? n - 17408 + 8192 : -1));
        else { const int pn = n >> 8, half = (n >> 7) & 1, j = n & 127; ns = half * Fgu + 128 * pn + j; }
        __syncthreads();
#pragma unroll
        for (int h = 0; h < (F8 ? 2 : 1); ++h) {
            const float* src = W + (size_t)(k0 + (F8 ? 32 : 16) * w + 16 * h) * Nsrc + (ns < 0 ? 0 : ns);
            f32x4 a[16];
#pragma unroll
            for (int i = 0; i < 16; ++i) a[i] = *(const f32x4*)(src + (size_t)i * Nsrc);
            if (ns < 0) {
#pragma unroll
                for (int i = 0; i < 16; ++i) a[i] = (f32x4){0.f, 0.f, 0.f, 0.f}; }
#pragma unroll
            for (int c = 0; c < 4; ++c) {
                if (F8) {
#pragma unroll
                    for (int q = 0; q < 4; ++q) scr[(4 * lane + c) * 65 + 8 * w + 4 * h + q] = pg8::pk4_fp8(a[4 * q][c] * scale, a[4 * q + 1][c] * scale, a[4 * q + 2][c] * scale, a[4 * q + 3][c] * scale);
                } else {
#pragma unroll
                    for (int p = 0; p < 8; ++p) scr[(4 * lane + c) * 65 + 8 * w + p] = pk2(a[2 * p][c], a[2 * p + 1][c]); } }
        }
        __syncthreads();
#pragma unroll
        for (int ps = 0; ps < 8; ++ps) { const int row = ps * 32 + (tid >> 4), kq = tid & 15; const LAS unsigned* s = scr + row * 65 + 4 * kq; v4u o; o.x = s[0]; o.y = s[1]; o.z = s[2]; o.w = s[3];
            *(v4u*)((unsigned char*)WTv + ((size_t)(n0 + row) * K + k0) * (F8 ? 1 : 2) + 16 * kq) = o; }
    }
}

DI void rms_row(const float* xrow, const float* w, bf16* orow, int lane) {
    f32x4 v[8]; float ss = 0.f;
#pragma unroll
    for (int j = 0; j < 8; ++j) { v[j] = *(const f32x4*)(xrow + 4 * (lane + 64 * j)); ss += (v[j][0] * v[j][0] + v[j][1] * v[j][1]) + (v[j][2] * v[j][2] + v[j][3] * v[j][3]); }
    const float rstd = rsqrtf(wave_sum(ss) * (1.f / D) + EPS);
#pragma unroll
    for (int j = 0; j < 8; ++j) { const f32x4 ww = *(const f32x4*)(w + 4 * (lane + 64 * j)); v2u o; o.x = pk2(v[j][0] * rstd * ww[0], v[j][1] * rstd * ww[1]); o.y = pk2(v[j][2] * rstd * ww[2], v[j][3] * rstd * ww[3]);
        *(v2u*)(orow + 4 * (lane + 64 * j)) = o; }
}

template <bool GDN>
DI void seq_mixer(const Frame& F, int bh, const bf16* Q, const bf16* K, const bf16* V, const float* Gg, const float* Gb, float* OUT, float gamma) {
    LAS float* qs = (LAS float*)F.lds; LAS float* ks = qs + 32 * 128; LAS float* vs = ks + 32 * 128; LAS float* red = vs + 32 * 128; LAS float* gs = red + 2 * 4 * 128; LAS float* bs = gs + 32;
    const int tid = F.tid, v = tid & 127, kg = tid >> 7, b = bh >> 3, h = bh & 7;
    const size_t hb = (size_t)bh * SEQ * 128;
    float Sr[32];
#pragma unroll
    for (int i = 0; i < 32; ++i) Sr[i] = 0.f;
    for (int c0 = 0; c0 < SEQ; c0 += 32) {
        __syncthreads();
#pragma unroll
        for (int j = 0; j < 4; ++j) { const int idx = tid + 512 * j, tok = idx >> 6, d = (idx & 63) * 2; const size_t go = hb + (size_t)(c0 + tok) * 128 + d;
            const unsigned a = *(const unsigned*)(Q + go), bb = *(const unsigned*)(K + go), cc = *(const unsigned*)(V + go);
            qs[tok * 128 + d] = bf2f(a & 0xffffu); qs[tok * 128 + d + 1] = __uint_as_float(a & 0xffff0000u);
            ks[tok * 128 + d] = bf2f(bb & 0xffffu); ks[tok * 128 + d + 1] = __uint_as_float(bb & 0xffff0000u);
            vs[tok * 128 + d] = bf2f(cc & 0xffffu); vs[tok * 128 + d + 1] = __uint_as_float(cc & 0xffff0000u); }
        if (GDN && tid < 32) { gs[tid] = Gg[(size_t)bh * SEQ + c0 + tid]; bs[tid] = Gb[(size_t)bh * SEQ + c0 + tid]; }
        __syncthreads();
        for (int tt = 0; tt < 32; ++tt) {
            const LAS float* kt = ks + tt * 128 + kg * 32; const LAS float* qt = qs + tt * 128 + kg * 32;
            float po = 0.f;
            if (GDN) {
                const float a = __expf(gs[tt]); float p = 0.f;
#pragma unroll
                for (int i = 0; i < 32; ++i) { Sr[i] *= a; p += Sr[i] * kt[i]; }
                red[kg * 128 + v] = p; __syncthreads();
                const float kv = (red[v] + red[128 + v]) + (red[256 + v] + red[384 + v]);
                const float delta = bs[tt] * (vs[tt * 128 + v] - kv);
#pragma unroll
                for (int i = 0; i < 32; ++i) { Sr[i] += kt[i] * delta; po += Sr[i] * qt[i]; }
                red[512 + kg * 128 + v] = po; __syncthreads();
                if (kg == 0) OUT[((size_t)(b * SEQ + c0 + tt)) * 1024 + h * 128 + v] = (red[512 + v] + red[640 + v]) + (red[768 + v] + red[896 + v]);
            } else {
                const float vv = vs[tt * 128 + v]; LAS float* r = red + (tt & 1) * 512;
#pragma unroll
                for (int i = 0; i < 32; ++i) { Sr[i] = gamma * Sr[i] + kt[i] * vv; po += Sr[i] * qt[i]; }
                r[kg * 128 + v] = po; __syncthreads();
                if (kg == 0) OUT[((size_t)(b * SEQ + c0 + tt)) * 1024 + h * 128 + v] = (r[v] + r[128 + v]) + (r[256 + v] + r[384 + v]);
            }
        }
    }
    __syncthreads();
}

template <int DV, int KT, bool CAUSAL, bool OUT_BF16, bool DECAY>
DI void flash_item(const Frame& F, const bf16* Q, const bf16* Kh, const bf16* VT, int vpitch, int q0, int nkeys, float slope, float* OUTF, bf16* OUTB, int opitch) {
    constexpr int KP = 272, VP = KT * 2 + 16, NKC = KT / 32, NVC = DV * KT / 4096, VCH = KT / 8;
    LAS unsigned char* Kl = F.lds; LAS unsigned char* Vl = F.lds + KT * KP;
    int tid_ = F.tid; asm volatile("" : "+v"(tid_));
    const int tid = tid_, lane = tid & 63, w = F.wave, li = lane & 15, g = lane >> 4;
    const float SC = 0.08838834764831845f, L2E = 1.4426950408889634f;
    bf16x8 qf[4];
#pragma unroll
    for (int ks = 0; ks < 4; ++ks) qf[ks] = *(const bf16x8*)(Q + (size_t)(w * 16 + li) * 128 + ks * 32 + g * 8);
    f32x4 o[DV / 16];
#pragma unroll
    for (int c = 0; c < DV / 16; ++c) o[c] = (f32x4){0.f, 0.f, 0.f, 0.f};
    float m_run = -1e30f, l_run = 0.f;
    const int qpos = q0 + w * 16 + li;
    const int kend = CAUSAL ? (q0 + 128 < nkeys ? q0 + 128 : nkeys) : nkeys;
    v4u kr[NKC], vr[NVC];
#pragma unroll
    for (int i = 0; i < NKC; ++i) { const int c = tid + 512 * i; kr[i] = *(const v4u*)(Kh + (size_t)(c >> 4) * 128 + (c & 15) * 8); }
#pragma unroll
    for (int i = 0; i < NVC; ++i) { const int c = tid + 512 * i; vr[i] = *(const v4u*)(VT + (size_t)(c / VCH) * vpitch + (c % VCH) * 8); }
    for (int j0 = 0; j0 < kend; j0 += KT) {
        __syncthreads();
#pragma unroll
        for (int i = 0; i < NKC; ++i) { const int c = tid + 512 * i; *(LAS v4u*)(Kl + (c >> 4) * KP + (c & 15) * 16) = kr[i]; }
#pragma unroll
        for (int i = 0; i < NVC; ++i) { const int c = tid + 512 * i, cc = c % VCH, j = cc & 3; LAS unsigned char* rp = Vl + (c / VCH) * VP + (cc >> 2) * 64;
            *(LAS v2u*)(rp + (8 * ((2 * j) & 3) + 4 * (j >> 1)) * 2) = (v2u){vr[i].x, vr[i].y}; *(LAS v2u*)(rp + (8 * ((2 * j + 1) & 3) + 4 * (j >> 1)) * 2) = (v2u){vr[i].z, vr[i].w}; }
        __syncthreads();
        if (j0 + KT < kend) {
#pragma unroll
            for (int i = 0; i < NKC; ++i) { const int c = tid + 512 * i; kr[i] = *(const v4u*)(Kh + (size_t)(j0 + KT + (c >> 4)) * 128 + (c & 15) * 8); }
#pragma unroll
            for (int i = 0; i < NVC; ++i) { const int c = tid + 512 * i; vr[i] = *(const v4u*)(VT + (size_t)(c / VCH) * vpitch + j0 + KT + (c % VCH) * 8); }
        }
        f32x4 s[KT / 16];
        {
            bf16x8 ka[2][4];
#pragma unroll
            for (int ks = 0; ks < 4; ++ks) ka[0][ks] = *(const LAS bf16x8*)(Kl + li * KP + (ks * 32 + g * 8) * 2);
#pragma unroll
            for (int t = 0; t < KT / 16; ++t) {
                if (t + 1 < KT / 16) {
#pragma unroll
                    for (int ks = 0; ks < 4; ++ks) ka[(t + 1) & 1][ks] = *(const LAS bf16x8*)(Kl + ((t + 1) * 16 + li) * KP + (ks * 32 + g * 8) * 2); }
                __builtin_amdgcn_sched_barrier(0);
                s[t] = (f32x4){0.f, 0.f, 0.f, 0.f};
#pragma unroll
                for (int ks = 0; ks < 4; ++ks) s[t] = __builtin_amdgcn_mfma_f32_16x16x32_bf16(ka[t & 1][ks], qf[ks], s[t], 0, 0, 0);
                __builtin_amdgcn_sched_barrier(0);
            }
        }
        float alpha = 1.f;
        if (DECAY) {
#pragma unroll
            for (int t = 0; t < KT / 16; ++t)
#pragma unroll
                for (int r = 0; r < 4; ++r) { const int key = j0 + t * 16 + g * 4 + r; const float dcy = exp2f(slope * (float)(qpos - key)); s[t][r] = key > qpos ? 0.f : s[t][r] * dcy; }
        } else {
        float mx = -__builtin_inff();
#pragma unroll
        for (int t = 0; t < KT / 16; ++t)
#pragma unroll
            for (int r = 0; r < 4; ++r) { const int key = j0 + t * 16 + g * 4 + r; float x = s[t][r] * SC - slope * (float)(qpos - key); if (CAUSAL && key > qpos) x = -__builtin_inff(); s[t][r] = x; mx = fmaxf(mx, x); }
        mx = fmaxf(mx, __shfl_xor(mx, 16)); mx = fmaxf(mx, __shfl_xor(mx, 32));
        const float m_new = fmaxf(m_run, mx); alpha = exp2f((m_run - m_new) * L2E); m_run = m_new;
        float ps = 0.f;
#pragma unroll
        for (int t = 0; t < KT / 16; ++t)
#pragma unroll
            for (int r = 0; r < 4; ++r) { const float p = exp2f((s[t][r] - m_new) * L2E); s[t][r] = p; ps += p; }
        ps += __shfl_xor(ps, 16); ps += __shfl_xor(ps, 32);
        l_run = l_run * alpha + ps;
        }
        bf16x8 pf[KT / 32];
#pragma unroll
        for (int s2 = 0; s2 < KT / 32; ++s2) { v4u pw; pw.x = pk2(s[2 * s2][0], s[2 * s2][1]); pw.y = pk2(s[2 * s2][2], s[2 * s2][3]); pw.z = pk2(s[2 * s2 + 1][0], s[2 * s2 + 1][1]); pw.w = pk2(s[2 * s2 + 1][2], s[2 * s2 + 1][3]); pf[s2] = __builtin_bit_cast(bf16x8, pw); }
        float al[4];
#pragma unroll
        for (int r = 0; r < 4; ++r) al[r] = DECAY ? 1.f : __shfl(alpha, g * 4 + r);
        {
            v4u vb[2][KT / 32];
#pragma unroll
            for (int s2 = 0; s2 < KT / 32; ++s2) vb[0][s2] = *(const LAS v4u*)(Vl + li * VP + (s2 * 32 + g * 8) * 2);
#pragma unroll
            for (int c = 0; c < DV / 16; ++c) {
                if (c + 1 < DV / 16) {
#pragma unroll
                    for (int s2 = 0; s2 < KT / 32; ++s2) vb[(c + 1) & 1][s2] = *(const LAS v4u*)(Vl + ((c + 1) * 16 + li) * VP + (s2 * 32 + g * 8) * 2); }
                __builtin_amdgcn_sched_barrier(0);
                if (!DECAY) {
#pragma unroll
                    for (int r = 0; r < 4; ++r) o[c][r] *= al[r]; }
#pragma unroll
                for (int s2 = 0; s2 < KT / 32; ++s2) o[c] = __builtin_amdgcn_mfma_f32_16x16x32_bf16(pf[s2], __builtin_bit_cast(bf16x8, vb[c & 1][s2]), o[c], 0, 0, 0);
                __builtin_amdgcn_sched_barrier(0);
            }
        }
    }
    float il[4];
#pragma unroll
    for (int r = 0; r < 4; ++r) il[r] = DECAY ? 1.f : 1.0f / __shfl(l_run, g * 4 + r);
#pragma unroll
    for (int c = 0; c < DV / 16; ++c)
#pragma unroll
        for (int r = 0; r < 4; ++r) { const unsigned off = (unsigned)((w * 16 + g * 4 + r) * opitch + c * 16 + li); const float v = o[c][r] * il[r];
            if (OUT_BF16) OUTB[off] = (bf16)f2bf(v); else OUTF[off] = v; }
}

constexpr int GDN_CH_BYTES = 16384 + 16384 + 8192 + 16384 + 32768;
DI int perm32pos(int k) { return (k & ~31) | (((k >> 2) & 3) << 3) | (((k >> 4) & 1) << 2) | (k & 3); }
DI void gdn_prep_item(const Frame& F, int l, int bh, int n, const bf16* BQKV, const float* BBA, const float* cw, const float* a_log, const float* dt_bias, unsigned char* CH, float* GLp) {
    LAS unsigned char* Kl = F.lds; LAS unsigned char* Ql = F.lds + 17408; LAS unsigned char* KBT = F.lds + 34816; LAS unsigned char* VBT = F.lds + 53248; LAS unsigned char* KTl = F.lds + 71680;
    LAS float* Am = (LAS float*)(F.lds + 90112); LAS unsigned char* Tl = F.lds + 106752; LAS unsigned char* AQl = F.lds + 115968; LAS float* Gs = (LAS float*)(F.lds + 125184); LAS float* gs = Gs + 64; LAS float* bs = gs + 64;
    LAS float* CWl = Am;
    int tid_ = F.tid; asm volatile("" : "+v"(tid_));
    const int tid = tid_, lane = tid & 63, w = F.wave, li = lane & 15, g = lane >> 4;
    const int b = bh >> 3, h = bh & 7, i = tid >> 3, cg = tid & 7, c0 = cg * 16, s = n * 64 + i, t = b * SEQ + s;
    bf16* Wn = (bf16*)CH; bf16* QD = (bf16*)(CH + 16384); bf16* AQK = (bf16*)(CH + 32768); bf16* KT = (bf16*)(CH + 40960); float* UT = (float*)(CH + 57344);
    __syncthreads();
    for (int e = tid; e < 1536; e += 512) { const int part = e >> 9, j = (e >> 7) & 3, c = e & 127; CWl[e] = cw[j * 3072 + part * 1024 + h * 128 + c]; }
    if (cg == 0) { const float bbv = BBA[(size_t)t * 16 + h], bav = BBA[(size_t)t * 16 + 8 + h] + dt_bias[l * 8 + h]; const float sp = bav > 20.f ? bav : log1pf(__expf(bav)); bs[i] = pg8::fsigm(bbv); gs[i] = -__expf(a_log[l * 8 + h]) * sp; }
    __syncthreads();
    float qv[16], kv[16], vv[16];
#pragma unroll
    for (int part = 0; part < 3; ++part) {
        float a[16];
#pragma unroll
        for (int c = 0; c < 16; ++c) a[c] = 0.f;
#pragma unroll
        for (int j = 0; j < 4; ++j) { if (s - 3 + j >= 0) { const v4u x0 = *(const v4u*)(BQKV + (size_t)(t - 3 + j) * 3072 + part * 1024 + h * 128 + c0), x1 = *(const v4u*)(BQKV + (size_t)(t - 3 + j) * 3072 + part * 1024 + h * 128 + c0 + 8);
                const LAS float* wj = CWl + part * 512 + j * 128 + c0;
#pragma unroll
                for (int c = 0; c < 4; ++c) { a[2 * c] += bf2f(x0[c] & 0xffffu) * wj[2 * c]; a[2 * c + 1] += __uint_as_float(x0[c] & 0xffff0000u) * wj[2 * c + 1]; a[8 + 2 * c] += bf2f(x1[c] & 0xffffu) * wj[8 + 2 * c]; a[9 + 2 * c] += __uint_as_float(x1[c] & 0xffff0000u) * wj[9 + 2 * c]; } } }
#pragma unroll
        for (int c = 0; c < 16; ++c) { const float y = pg8::fsilu(a[c]); if (part == 0) qv[c] = y; else if (part == 1) kv[c] = y; else vv[c] = y; }
    }
    { float sq = 0.f, sk = 0.f;
#pragma unroll
      for (int c = 0; c < 16; ++c) { sq += qv[c] * qv[c]; sk += kv[c] * kv[c]; }
      sq += __shfl_xor(sq, 1); sq += __shfl_xor(sq, 2); sq += __shfl_xor(sq, 4); sk += __shfl_xor(sk, 1); sk += __shfl_xor(sk, 2); sk += __shfl_xor(sk, 4);
      const float qn = rsqrtf(sq + 1e-6f) * 0.08838834764831845f, kn = rsqrtf(sk + 1e-6f);
#pragma unroll
      for (int c = 0; c < 16; ++c) { qv[c] *= qn; kv[c] *= kn; } }
    if (w == 0) { float v = gs[lane];
#pragma unroll
        for (int o = 1; o < 64; o <<= 1) { const float u = __shfl_up(v, o); if (lane >= o) v += u; }
        Gs[lane] = v; }
    __syncthreads();
    {
        const float Gi = Gs[i], Gl = Gs[63], be = bs[i], eg = __expf(Gi), kbs = be * eg, kts = __expf(Gl - Gi);
        v4u pk, pq;
#pragma unroll
        for (int hh = 0; hh < 2; ++hh) {
            pk.x = pk2(kv[8 * hh + 0], kv[8 * hh + 1]); pk.y = pk2(kv[8 * hh + 2], kv[8 * hh + 3]); pk.z = pk2(kv[8 * hh + 4], kv[8 * hh + 5]); pk.w = pk2(kv[8 * hh + 6], kv[8 * hh + 7]);
            pq.x = pk2(qv[8 * hh + 0], qv[8 * hh + 1]); pq.y = pk2(qv[8 * hh + 2], qv[8 * hh + 3]); pq.z = pk2(qv[8 * hh + 4], qv[8 * hh + 5]); pq.w = pk2(qv[8 * hh + 6], qv[8 * hh + 7]);
            *(LAS v4u*)(Kl + i * 272 + (c0 + 8 * hh) * 2) = pk; *(LAS v4u*)(Ql + i * 272 + (c0 + 8 * hh) * 2) = pq; }
        const int ip = perm32pos(i);
#pragma unroll
        for (int c = 0; c < 16; ++c) { *(LAS bf16*)(KBT + (c0 + c) * 144 + i * 2) = (bf16)f2bf(kv[c] * kbs); *(LAS bf16*)(VBT + (c0 + c) * 144 + i * 2) = (bf16)f2bf(vv[c] * be); *(LAS bf16*)(KTl + (c0 + c) * 144 + ip * 2) = (bf16)f2bf(kv[c] * kts); }
#pragma unroll
        for (int gp = 0; gp < 4; ++gp) { v2u o; o.x = pk2(qv[4 * gp] * eg, qv[4 * gp + 1] * eg); o.y = pk2(qv[4 * gp + 2] * eg, qv[4 * gp + 3] * eg); *(v2u*)(QD + i * 128 + 32 * (cg >> 1) + 8 * gp + 4 * (cg & 1)) = o; }
        if (tid == 0) *GLp = __expf(Gl);
    }
    __syncthreads();
    {
        const int kind = w >> 2, rb = w & 3; LAS unsigned char* Al = kind ? Ql : Kl;
        bf16x8 af[4];
#pragma unroll
        for (int ks = 0; ks < 4; ++ks) af[ks] = *(const LAS bf16x8*)(Al + (rb * 16 + li) * 272 + (ks * 32 + g * 8) * 2);
#pragma unroll
        for (int cb = 0; cb < 4; ++cb) {
            f32x4 acc = (f32x4){0.f, 0.f, 0.f, 0.f};
            if (cb <= rb) {
#pragma unroll
                for (int ks = 0; ks < 4; ++ks) { const bf16x8 bfr = *(const LAS bf16x8*)(Kl + (cb * 16 + li) * 272 + (ks * 32 + g * 8) * 2); acc = __builtin_amdgcn_mfma_f32_16x16x32_bf16(af[ks], bfr, acc, 0, 0, 0); } }
            const int j = cb * 16 + li; const float Gj = Gs[j];
#pragma unroll
            for (int r = 0; r < 4; ++r) { const int ii = rb * 16 + 4 * g + r; const float Lij = __expf(Gs[ii] - Gj);
                if (kind == 0) Am[ii * 65 + j] = ii > j ? acc[r] * Lij * bs[ii] : 0.f;
                else *(LAS bf16*)(AQl + ii * 144 + perm32pos(j) * 2) = (bf16)f2bf(ii >= j ? acc[r] * Lij : 0.f); }
        }
    }
    __syncthreads();
    if (w == 0) {
        int zv = 0; asm volatile("" : "+v"(zv)); const LAS float* Amv = Am + zv;
        float Tr[64];
#pragma unroll
        for (int ii = 0; ii < 64; ++ii) {
            float a0 = (ii == lane) ? 1.f : 0.f, a1 = 0.f;
#pragma unroll
            for (int j = 0; j < ii; ++j) { if (j & 1) a1 -= Amv[ii * 65 + j] * Tr[j]; else a0 -= Amv[ii * 65 + j] * Tr[j]; }
            Tr[ii] = a0 + a1;
            *(LAS bf16*)(Tl + ii * 144 + lane * 2) = (bf16)f2bf(Tr[ii]);
            asm volatile("" ::: "memory");
        }
    }
    __syncthreads();
    {
        const int kind = w >> 2; LAS unsigned char* Xl = kind ? VBT : KBT;
#pragma unroll
        for (int q2 = 0; q2 < 2; ++q2) { const int rbk = 2 * (w & 3) + q2;
            bf16x8 af[2];
#pragma unroll
            for (int ks = 0; ks < 2; ++ks) af[ks] = *(const LAS bf16x8*)(Xl + (rbk * 16 + li) * 144 + (ks * 32 + g * 8) * 2);
#pragma unroll
            for (int cb = 0; cb < 4; ++cb) { f32x4 acc = (f32x4){0.f, 0.f, 0.f, 0.f};
#pragma unroll
                for (int ks = 0; ks < 2; ++ks) { const bf16x8 bfr = *(const LAS bf16x8*)(Tl + (cb * 16 + li) * 144 + (ks * 32 + g * 8) * 2); acc = __builtin_amdgcn_mfma_f32_16x16x32_bf16(af[ks], bfr, acc, 0, 0, 0); }
                const int ii = cb * 16 + li;
                if (kind == 0) { v2u o; o.x = pk2(-acc[0], -acc[1]); o.y = pk2(-acc[2], -acc[3]); *(v2u*)(Wn + ii * 128 + 32 * (rbk >> 1) + 8 * g + 4 * (rbk & 1)) = o; }
                else {
#pragma unroll
                    for (int r = 0; r < 4; ++r) UT[(rbk * 16 + 4 * g + r) * 64 + ii] = acc[r]; } }
        }
    }
#pragma unroll
    for (int q2 = 0; q2 < 2; ++q2) { const int c = tid + 512 * q2, row = c >> 3, cc = c & 7; *(v4u*)(KT + row * 64 + cc * 8) = *(const LAS v4u*)(KTl + row * 144 + cc * 16); }
    { const int row = tid >> 3, cc = tid & 7; *(v4u*)(AQK + row * 64 + cc * 8) = *(const LAS v4u*)(AQl + row * 144 + cc * 16); }
}

DI void gdn_scan(const Frame& F, int bh, const unsigned char* CHB, const float* GLB, float* OB) {
    constexpr int BUFB = 62464, O_QD = 17408, O_AQ = 34816, O_KT = 44032;
    int tid_ = F.tid; asm volatile("" : "+v"(tid_));
    const int tid = tid_, lane = tid & 63, w = F.wave, li = lane & 15, g = lane >> 4, b = bh >> 3, h = bh & 7;
    f32x4 S[8];
#pragma unroll
    for (int kb = 0; kb < 8; ++kb) S[kb] = (f32x4){0.f, 0.f, 0.f, 0.f};
    int ldso[7];
#pragma unroll
    for (int q = 0; q < 7; ++q) { const int c = tid + 512 * q;
        if (q < 2) ldso[q] = (c >> 4) * 272 + (c & 15) * 16; else if (q < 4) ldso[q] = O_QD + ((c - 1024) >> 4) * 272 + (c & 15) * 16;
        else if (q == 4) ldso[q] = O_AQ + ((c - 2048) >> 3) * 144 + (c & 7) * 16; else ldso[q] = O_KT + ((c - 2560) >> 3) * 144 + (c & 7) * 16; }
    const unsigned char* CH0 = CHB + (size_t)(bh * 32) * GDN_CH_BYTES;
    v4u st[7]; f32x4 utc[4], utn[4]; float glc, gln;
    __syncthreads();
#pragma unroll
    for (int q = 0; q < 7; ++q) st[q] = *(const v4u*)(CH0 + (size_t)(tid + 512 * q) * 16);
#pragma unroll
    for (int jb = 0; jb < 4; ++jb) utc[jb] = *(const f32x4*)((const float*)(CH0 + 57344) + (16 * w + li) * 64 + jb * 16 + 4 * g);
    glc = GLB[bh * 32];
#pragma unroll
    for (int q = 0; q < 7; ++q) *(LAS v4u*)(F.lds + ldso[q]) = st[q];
    __syncthreads();
    for (int n = 0; n < 32; ++n) {
        const LAS unsigned char* Lb = F.lds + (n & 1) * BUFB;
        if (n + 1 < 32) { const unsigned char* CH = CH0 + (size_t)(n + 1) * GDN_CH_BYTES;
#pragma unroll
            for (int q = 0; q < 7; ++q) st[q] = *(const v4u*)(CH + (size_t)(tid + 512 * q) * 16);
#pragma unroll
            for (int jb = 0; jb < 4; ++jb) utn[jb] = *(const f32x4*)((const float*)(CH + 57344) + (16 * w + li) * 64 + jb * 16 + 4 * g);
            gln = GLB[bh * 32 + n + 1]; }
        bf16x8 sf[4];
#pragma unroll
        for (int ks = 0; ks < 4; ++ks) { v4u p; p.x = pk2(S[2 * ks][0], S[2 * ks][1]); p.y = pk2(S[2 * ks][2], S[2 * ks][3]); p.z = pk2(S[2 * ks + 1][0], S[2 * ks + 1][1]); p.w = pk2(S[2 * ks + 1][2], S[2 * ks + 1][3]); sf[ks] = __builtin_bit_cast(bf16x8, p); }
        f32x4 vn[4];
#pragma unroll
        for (int jb = 0; jb < 4; ++jb) { vn[jb] = utc[jb];
#pragma unroll
            for (int ks = 0; ks < 4; ++ks) { const bf16x8 a = *(const LAS bf16x8*)(Lb + (jb * 16 + li) * 272 + (ks * 32 + g * 8) * 2); vn[jb] = __builtin_amdgcn_mfma_f32_16x16x32_bf16(a, sf[ks], vn[jb], 0, 0, 0); } }
        bf16x8 vf[2];
#pragma unroll
        for (int js = 0; js < 2; ++js) { v4u p; p.x = pk2(vn[2 * js][0], vn[2 * js][1]); p.y = pk2(vn[2 * js][2], vn[2 * js][3]); p.z = pk2(vn[2 * js + 1][0], vn[2 * js + 1][1]); p.w = pk2(vn[2 * js + 1][2], vn[2 * js + 1][3]); vf[js] = __builtin_bit_cast(bf16x8, p); }
#pragma unroll
        for (int ib = 0; ib < 4; ++ib) { f32x4 z = (f32x4){0.f, 0.f, 0.f, 0.f};
#pragma unroll
            for (int ks = 0; ks < 4; ++ks) { const bf16x8 bq = *(const LAS bf16x8*)(Lb + O_QD + (ib * 16 + li) * 272 + (ks * 32 + g * 8) * 2); z = __builtin_amdgcn_mfma_f32_16x16x32_bf16(sf[ks], bq, z, 0, 0, 0); }
#pragma unroll
            for (int js = 0; js < 2; ++js) { const bf16x8 ba = *(const LAS bf16x8*)(Lb + O_AQ + (ib * 16 + li) * 144 + (js * 32 + g * 8) * 2); z = __builtin_amdgcn_mfma_f32_16x16x32_bf16(vf[js], ba, z, 0, 0, 0); }
            *(f32x4*)(OB + ((size_t)(b * SEQ + n * 64 + ib * 16 + li)) * 1024 + h * 128 + 16 * w + 4 * g) = z; }
#pragma unroll
        for (int kb = 0; kb < 8; ++kb) { S[kb] = S[kb] * glc;
#pragma unroll
            for (int js = 0; js < 2; ++js) { const bf16x8 a = *(const LAS bf16x8*)(Lb + O_KT + (kb * 16 + li) * 144 + (js * 32 + g * 8) * 2); S[kb] = __builtin_amdgcn_mfma_f32_16x16x32_bf16(a, vf[js], S[kb], 0, 0, 0); } }
        if (n + 1 < 32) {
            LAS unsigned char* Ln = F.lds + ((n + 1) & 1) * BUFB;
#pragma unroll
            for (int q = 0; q < 7; ++q) *(LAS v4u*)(Ln + ldso[q]) = st[q];
#pragma unroll
            for (int jb = 0; jb < 4; ++jb) utc[jb] = utn[jb];
            glc = gln; }
        __syncthreads();
    }
}

#define x_in ((const float*)args.in[0])
#define mem ((const float*)args.in[1])
#define w_in ((const float*)args.in[2])
#define conv_w ((const float*)args.in[3])
#define a_log ((const float*)args.in[4])
#define dt_bias ((const float*)args.in[5])
#define gdn_norm_w ((const float*)args.in[6])
#define diff_lambda ((const float*)args.in[7])
#define diff_norm_w ((const float*)args.in[8])
#define w_branch ((const float*)args.in[9])
#define w_out ((const float*)args.in[10])
#define mix_norm_w ((const float*)args.in[11])
#define mem_norm_w ((const float*)args.in[12])
#define cross_norm_w ((const float*)args.in[13])
#define cross_w_q ((const float*)args.in[14])
#define cross_w_kv ((const float*)args.in[15])
#define cross_w_o ((const float*)args.in[16])
#define ffn_norm_w ((const float*)args.in[17])
#define dense_w_gu ((const float*)args.in[18])
#define dense_w_down ((const float*)args.in[19])
#define router_w ((const float*)args.in[20])
#define expert_w_gu ((const float*)args.in[21])
#define expert_w_down ((const float*)args.in[22])
#define final_norm_w ((const float*)args.in[23])
#define WIN ((bf16*)(ws + WS_WIN))
#define WBR ((bf16*)(ws + WS_WBR))
#define WOUT ((bf16*)(ws + WS_WOUT))
#define WQ ((bf16*)(ws + WS_WQ))
#define WKV ((bf16*)(ws + WS_WKV))
#define WO ((bf16*)(ws + WS_WO))
#define WGU ((bf16*)(ws + WS_WGU))
#define WDN ((bf16*)(ws + WS_WDN))
#define WEGU ((bf16*)(ws + WS_WEGU))
#define WEDN ((bf16*)(ws + WS_WEDN))
#define XRES ((float*)(ws + WS_XRES))
#define H ((bf16*)(ws + WS_H))
#define RQ ((bf16*)(ws + WS_RQ))
#define RK ((bf16*)(ws + WS_RK))
#define RVT ((bf16*)(ws + WS_RV))
#define RG ((bf16*)(ws + WS_RG))
#define BQKV ((bf16*)(ws + WS_BQKV))
#define BZ ((bf16*)(ws + WS_BZ))
#define BBA ((float*)(ws + WS_BBA))
#define CQ ((bf16*)(ws + WS_CQ))
#define CK ((bf16*)(ws + WS_CK))
#define CVT ((bf16*)(ws + WS_CVT))
#define GATES ((bf16*)(ws + WS_GATES))
#define GQ ((bf16*)(ws + WS_GQ))
#define GK ((bf16*)(ws + WS_GK))
#define GV ((bf16*)(ws + WS_GV))
#define GG ((float*)(ws + WS_GG))
#define GB ((float*)(ws + WS_GB))
#define OA ((float*)(ws + WS_OA))
#define OB ((float*)(ws + WS_OB))
#define O12 ((float*)(ws + WS_O12))
#define OCAT ((bf16*)(ws + WS_OCAT))
#define MERGE ((float*)(ws + WS_MERGE))
#define MERGEB ((bf16*)(ws + WS_MERGEB))
#define MEMN ((bf16*)(ws + WS_MEMN))
#define KX ((bf16*)(ws + WS_KX))
#define VXT ((bf16*)(ws + WS_VXT))
#define QX ((bf16*)(ws + WS_QX))
#define OX ((bf16*)(ws + WS_OX))
#define ACT ((bf16*)(ws + WS_ACT))
#define HG ((bf16*)(ws + WS_HG))
#define EACT ((bf16*)(ws + WS_EACT))
#define Y ((float*)(ws + WS_Y))
#define ROUTE ((int*)(ws + WS_ROUTE))
#define H8 ((unsigned char*)(ws + WS_H8))
__global__ void __launch_bounds__(NWAVES * 64, 2) mk_fwd(Args args) {
    extern __shared__ __attribute__((aligned(16))) unsigned char lds_raw[];
    Frame F;
    F.lds = (LAS unsigned char*)lds_raw;
    F.tid = threadIdx.x; F.lane = F.tid & 63; F.wave = __builtin_amdgcn_readfirstlane(F.tid >> 6);
    F.G = gridDim.x; { const int bx = blockIdx.x; F.vcu = (F.G % 8 == 0) ? (bx % 8) * (F.G / 8) + bx / 8 : bx; }
    F.gw = F.vcu * NWAVES + F.wave; F.NGW = F.G * NWAVES;
    volatile LAS unsigned* MISC = (volatile LAS unsigned*)(F.lds + MISC_OFF);
    LAS int* MTAB = (LAS int*)(F.lds + MISC_OFF + 128);
    unsigned char* ws = args.ws;
    unsigned* ctl = (unsigned*)(ws + WS_CTL);
    for (int u = F.tid; u < (LDS_BYTES - RING_BYTES) / 4; u += NWAVES * 64) ((LAS unsigned*)(F.lds + RING_BYTES))[u] = 0u;
    __syncthreads();
#if MK_ONE_LAUNCH
    XcdBarrier bar = xcd_barrier_post(ctl + CW_BAR, MISC + 8);
#define GRID_BAR() xcd_barrier(bar)
#else
#define GRID_BAR() do {} while (0)
#endif
    const int lo = args.ph_lo, hi = args.ph_hi;
#ifndef PROBE_PH
#define PROBE_PH -1
#endif
#define IN(k) (lo <= (k) && ((k) < hi) && (hi <= 100 || (k) == lo))
#define REP(k) for (int rep_ = 0; rep_ < ((k) == PROBE_PH ? 2 : 1); ++rep_)
#define SEAM(k) do { if (IN(k) && IN((k) + 1)) GRID_BAR(); } while (0)

    if (IN(0)) REP(0) {
        for (int l = 0; l < 2; ++l) {
            conv_wg<false>(F, w_in + (size_t)l * D * 17424, D, 17424, WIN + (size_t)l * NINP * D, NINP, 1, 0, 1.f);
            conv_wg<false>(F, w_branch + (size_t)l * 3072 * D, 3072, D, WBR + (size_t)l * D * 3072, D, 0, 0, 1.f);
            conv_wg<false>(F, w_out + (size_t)l * D * D, D, D, WOUT + (size_t)l * D * D, D, 0, 0, 1.f);
            conv_wg<false>(F, cross_w_q + (size_t)l * D * 512, D, 512, WQ + (size_t)l * 512 * D, 512, 0, 0, 1.f);
            conv_wg<false>(F, cross_w_kv + (size_t)l * D * 1024, D, 1024, WKV + (size_t)l * 1024 * D, 1024, 0, 0, 1.f);
            conv_wg<false>(F, cross_w_o + (size_t)l * 512 * D, 512, D, WO + (size_t)l * D * 512, D, 0, 0, 1.f);
        }
        conv_wg<false>(F, dense_w_gu, D, 2 * DFF, WGU, 2 * DFF, 2, DFF, 1.f);
        conv_wg<false>(F, dense_w_down, DFF, D, WDN, D, 0, 0, 1.f);
        for (int e = 0; e < NEXP; ++e) {
            conv_wg<true>(F, expert_w_gu + (size_t)e * D * 2 * EFF, D, 2 * EFF, (unsigned char*)WEGU + (size_t)e * 2 * EFF * D, 2 * EFF, 2, EFF, 256.f);
            conv_wg<true>(F, expert_w_down + (size_t)e * EFF * D, EFF, D, (unsigned char*)WEDN + (size_t)e * D * EFF, D, 0, 0, 256.f);
        }
        for (int r = F.gw; r < T; r += F.NGW) rms_row(x_in + (size_t)r * D, mix_norm_w, H + (size_t)r * D, F.lane);
        for (int r = F.gw; r < 2 * MEMR; r += F.NGW) { const int l = r / MEMR, rr = r % MEMR; rms_row(mem + (size_t)rr * D, mem_norm_w + l * D, MEMN + (size_t)r * D, F.lane); }
    }
    SEAM(0);
    if (IN(1)) REP(1) {
        for (int l = 0; l < 2; ++l) {
            pg8::Gemm g{MEMN + (size_t)l * MEMR * D, WKV + (size_t)l * 1024 * D, MEMR, 1024, D}; pg8::StaticOrder S; S.init(MEMR, 1024, F.G, (int)((blockIdx.x + F.G - 16 * l) % F.G));
            pg8::EpiHeads E{KX + (size_t)l * NB * 4 * MEML * 128, VXT + (size_t)l * NB * 4 * 128 * MEML, 4, 8, 2};
            pg8::gemm_phase<pg8::EpiHeads, pg8::StaticOrder, true, true>(F.lds, g, S, E);
        }
    }
    SEAM(1);

    { constexpr int l = 0;
        const int pb = 2 + l * NPL;
        const float lambda_init = l == 0 ? 0.2f : 0.35550906f;
        const float* xin = l == 0 ? x_in : XRES;
        if (IN(pb + 0)) REP(pb + 0) {
            pg8::Gemm g{H, WIN + (size_t)l * NINP * D, T, NINP, D}; pg8::StaticOrder S; S.init(T, NINP, F.G, (int)blockIdx.x);
            pg8::EpiIn E{RQ, RK, RVT, RG, BQKV, BZ, CQ, CK, CVT, GATES, BBA};
            pg8::gemm_phase<pg8::EpiIn, pg8::StaticOrder, true, true>(F.lds, g, S, E);
        }
        SEAM(pb + 0);
        if (IN(pb + 1)) REP(pb + 1) {
            const float* cw = conv_w + (size_t)l * 4 * 3072;
            for (int it = F.vcu; it < 1024; it += F.G) gdn_prep_item(F, l, it >> 5, it & 31, BQKV, BBA, cw, a_log, dt_bias, ws + WS_GCH + (size_t)it * GDN_CH_BYTES, (float*)(ws + WS_GL) + it);
        }
        SEAM(pb + 1);
        if (IN(pb + 2)) REP(pb + 2) {
            const int bx = F.vcu;
            const int mixsel = (l == 0 && args.ph_hi > 100) ? (args.ph_hi - 100) : 3, qw = (l == 0 && args.ph_hi > 100) ? 104 : 100 + l;
            if (bx < 32 && (mixsel & 1)) gdn_scan(F, bx, ws + WS_GCH, (const float*)(ws + WS_GL), OB);
            if (mixsel & 2) {
                volatile LAS int* qslot = (volatile LAS int*)(F.lds + MISC_OFF + 256);
                int nxt = 0; if (F.tid == 0) nxt = (int)atomicAdd(ctl + qw, 1u);
                for (;;) {
                    __syncthreads(); if (F.tid == 0) qslot[0] = nxt; __syncthreads();
                    const int it = __builtin_amdgcn_readfirstlane(qslot[0]); if (it >= 1024) break;
                    if (F.tid == 0) nxt = (int)atomicAdd(ctl + qw, 1u);
                    const int qt = 15 - (it >> 6), kind = (it >> 5) & 1, hd = it & 31, b = hd >> 3, hm = hd & 7;
                    if (kind == 0) { const int hh = hm >> 1, m = hm & 1; const float slope = exp2f(-2.0f * (float)(hh + 1));
                        flash_item<256, 128, true, false, false>(F, CQ + ((size_t)hd * SEQ + qt * 128) * 128, CK + (size_t)hd * SEQ * 128, CVT + (size_t)(b * 4 + hh) * 256 * SEQ, SEQ, qt * 128, SEQ, slope,
                                                            O12 + ((size_t)m * T + b * SEQ + qt * 128) * 1024 + hh * 256, nullptr, 1024); }
                    else { const float lg = log2f(1.0f - exp2f(-5.0f - (float)hm));
                        flash_item<128, 128, true, false, true>(F, RQ + ((size_t)hd * SEQ + qt * 128) * 128, RK + (size_t)hd * SEQ * 128, RVT + (size_t)hd * 128 * SEQ, SEQ, qt * 128, SEQ, lg,
                                                           OA + ((size_t)(b * SEQ + qt * 128)) * 1024 + hm * 128, nullptr, 1024); }
                }
            }
        }
        SEAM(pb + 2);
        if (IN(pb + 3)) REP(pb + 3) {
            const int lane = F.lane;
            const float* lv = diff_lambda + (size_t)l * 512;
            const float d01 = wave_sum(lv[lane] * lv[128 + lane] + lv[64 + lane] * lv[192 + lane]), d23 = wave_sum(lv[256 + lane] * lv[384 + lane] + lv[320 + lane] * lv[448 + lane]);
            const float lam = __expf(d01) - __expf(d23) + lambda_init;
            for (int t = F.gw; t < T; t += F.NGW) {
#pragma unroll
                for (int h = 0; h < 8; ++h) { const size_t o = (size_t)t * 1024 + h * 128 + 2 * lane;
                    { const float a0 = OA[o], a1 = OA[o + 1]; const float mean = wave_sum(a0 + a1) * (1.f / 128.f); const float c0 = a0 - mean, c1 = a1 - mean; const float rstd = rsqrtf(wave_sum(c0 * c0 + c1 * c1) * (1.f / 128.f) + EPS);
                      const unsigned gv = *(const unsigned*)(RG + o); *(unsigned*)(OCAT + (size_t)t * 3072 + h * 128 + 2 * lane) = pk2(c0 * rstd * bf2f(gv & 0xffffu), c1 * rstd * __uint_as_float(gv & 0xffff0000u)); }
                    { const float a0 = OB[o], a1 = OB[o + 1]; const float rstd = rsqrtf(wave_sum(a0 * a0 + a1 * a1) * (1.f / 128.f) + EPS); const unsigned gv = *(const unsigned*)(BZ + o);
                      *(unsigned*)(OCAT + (size_t)t * 3072 + 1024 + h * 128 + 2 * lane) = pk2(a0 * rstd * gdn_norm_w[l * 128 + 2 * lane] * bf2f(gv & 0xffffu), a1 * rstd * gdn_norm_w[l * 128 + 2 * lane + 1] * __uint_as_float(gv & 0xffff0000u)); } }
#pragma unroll
                for (int h = 0; h < 4; ++h) { const size_t o = (size_t)t * 1024 + h * 256 + 4 * lane; const f32x4 p = *(const f32x4*)(O12 + o), q = *(const f32x4*)(O12 + (size_t)T * 1024 + o); const f32x4 d = p - q * lam;
                    const float rstd = rsqrtf(wave_sum((d[0] * d[0] + d[1] * d[1]) + (d[2] * d[2] + d[3] * d[3])) * (1.f / 256.f) + EPS) * (1.0f - lambda_init); const f32x4 ww = *(const f32x4*)(diff_norm_w + l * 256 + 4 * lane);
                    v2u ov; ov.x = pk2(d[0] * rstd * ww[0], d[1] * rstd * ww[1]); ov.y = pk2(d[2] * rstd * ww[2], d[3] * rstd * ww[3]); *(v2u*)(OCAT + (size_t)t * 3072 + 2048 + h * 256 + 4 * lane) = ov; }
            }
        }
        SEAM(pb + 3);
        if (IN(pb + 4)) REP(pb + 4) {
            pg8::Gemm g{OCAT, WBR + (size_t)l * D * 3072, T, D, 3072}; pg8::StaticOrder S; S.init(T, D, F.G, (int)blockIdx.x);
            pg8::EpiBranch E{MERGEB, GATES, 16, 32};
            pg8::gemm_phase<pg8::EpiBranch, pg8::StaticOrder, true, true>(F.lds, g, S, E);
        }
        SEAM(pb + 4);
        if (IN(pb + 5)) REP(pb + 5) {
            pg8::Gemm g{MERGEB, WOUT + (size_t)l * D * D, T, D, D}; pg8::StaticOrder S; S.init(T, D, F.G, (int)blockIdx.x);
            pg8::EpiResid E{xin, XRES, D, 1.f};
            pg8::gemm_phase<pg8::EpiResid, pg8::StaticOrder, true, true>(F.lds, g, S, E);
        }
        SEAM(pb + 5);
        if (IN(pb + 6)) REP(pb + 6) { for (int r = F.gw; r < T; r += F.NGW) rms_row(XRES + (size_t)r * D, cross_norm_w + l * D, H + (size_t)r * D, F.lane); }
        SEAM(pb + 6);
        if (IN(pb + 7)) REP(pb + 7) {
            pg8::Gemm g{H, WQ + (size_t)l * 512 * D, T, 512, D}; pg8::StaticOrder S; S.init(T, 512, F.G, (int)blockIdx.x);
            pg8::EpiHeads E{QX, nullptr, 4, 11, 1 << 20};
            pg8::gemm_phase<pg8::EpiHeads, pg8::StaticOrder, true, true>(F.lds, g, S, E);
        }
        SEAM(pb + 7);
        if (IN(pb + 8)) REP(pb + 8) {
            for (int it = F.vcu; it < 256; it += F.G) { const int hd = it >> 4, qt = it & 15, b = hd >> 2, hh = hd & 3;
                flash_item<128, 128, false, true, false>(F, QX + ((size_t)hd * SEQ + qt * 128) * 128, KX + ((size_t)l * 16 + hd) * MEML * 128, VXT + ((size_t)l * 16 + hd) * 128 * MEML, MEML, qt * 128, MEML, 0.f,
                                             nullptr, OX + ((size_t)(b * SEQ + qt * 128)) * 512 + hh * 128, 512); }
        }
        SEAM(pb + 8);
        if (IN(pb + 9)) REP(pb + 9) {
            pg8::Gemm g{OX, WO + (size_t)l * D * 512, T, D, 512}; pg8::StaticOrder S; S.init(T, D, F.G, (int)blockIdx.x);
            pg8::EpiResid E{XRES, XRES, D, 1.f};
            pg8::gemm_phase<pg8::EpiResid, pg8::StaticOrder, true, true>(F.lds, g, S, E);
        }
        SEAM(pb + 9);
        if (IN(pb + 10)) REP(pb + 10) {
            const int lane = F.lane; const float* w = ffn_norm_w + l * D;
            for (int r = F.gw; r < T; r += F.NGW) {
                const float* xrow = XRES + (size_t)r * D; f32x4 v[8]; float ss = 0.f;
#pragma unroll
                for (int j = 0; j < 8; ++j) { v[j] = *(const f32x4*)(xrow + 4 * (lane + 64 * j)); ss += (v[j][0] * v[j][0] + v[j][1] * v[j][1]) + (v[j][2] * v[j][2] + v[j][3] * v[j][3]); }
                const float rstd = rsqrtf(wave_sum(ss) * (1.f / D) + EPS);
                float lg[8];
#pragma unroll
                for (int e = 0; e < 8; ++e) lg[e] = 0.f;
#pragma unroll
                for (int j = 0; j < 8; ++j) { const f32x4 ww = *(const f32x4*)(w + 4 * (lane + 64 * j)); f32x4 y; y[0] = v[j][0] * rstd * ww[0]; y[1] = v[j][1] * rstd * ww[1]; y[2] = v[j][2] * rstd * ww[2]; y[3] = v[j][3] * rstd * ww[3];
                    if (l == 0) { v2u o; o.x = pk2(y[0], y[1]); o.y = pk2(y[2], y[3]); *(v2u*)(H + (size_t)r * D + 4 * (lane + 64 * j)) = o; }
                    else *(unsigned*)(H8 + (size_t)r * D + 4 * (lane + 64 * j)) = pg8::pk4_fp8(y[0], y[1], y[2], y[3]);
                    if (l == 1) {
#pragma unroll
                        for (int c = 0; c < 4; ++c) { const float* rw = router_w + (size_t)(4 * (lane + 64 * j) + c) * 8; const f32x4 r0 = *(const f32x4*)rw, r1 = *(const f32x4*)(rw + 4);
                            lg[0] += y[c] * r0[0]; lg[1] += y[c] * r0[1]; lg[2] += y[c] * r0[2]; lg[3] += y[c] * r0[3]; lg[4] += y[c] * r1[0]; lg[5] += y[c] * r1[1]; lg[6] += y[c] * r1[2]; lg[7] += y[c] * r1[3]; } } }
                if (l == 1) {
#pragma unroll
                    for (int e = 0; e < 8; ++e) lg[e] = wave_sum(lg[e]);
                    int e0 = 0; float v0 = lg[0];
#pragma unroll
                    for (int e = 1; e < 8; ++e) if (lg[e] > v0) { v0 = lg[e]; e0 = e; }
                    int e1 = -1; float v1 = -__builtin_inff();
#pragma unroll
                    for (int e = 0; e < 8; ++e) if (e != e0 && lg[e] > v1) { v1 = lg[e]; e1 = e; }
                    if (lane == 0) { const float p0 = 1.0f / (1.0f + __expf(v1 - v0)); int* ro = ROUTE + (size_t)r * 8;
                        ro[0] = e0; ro[1] = e1; ro[2] = (int)atomicAdd(ctl + CW_CNT + e0, 1u); ro[3] = (int)atomicAdd(ctl + CW_CNT + e1, 1u); ((float*)ro)[4] = p0; ((float*)ro)[5] = 1.0f - p0; }
                }
            }
        }
        SEAM(pb + 10);
        if (l == 0) {
            if (IN(pb + 11)) REP(pb + 11) {
                pg8::Gemm g{H, WGU, T, 2 * DFF, D}; pg8::StaticOrder S; S.init(T, 2 * DFF, F.G, (int)blockIdx.x);
                pg8::EpiSwiglu E{ACT, DFF, 1 << 20};
                pg8::gemm_phase<pg8::EpiSwiglu, pg8::StaticOrder, true, true>(F.lds, g, S, E);
            }
            SEAM(pb + 11);
            if (IN(pb + 12)) REP(pb + 12) {
                pg8::Gemm g{ACT, WDN, T, D, DFF}; pg8::StaticOrder S; S.init(T, D, F.G, (int)blockIdx.x);
                pg8::EpiResid E{XRES, XRES, D, 1.f};
                pg8::gemm_phase<pg8::EpiResid, pg8::StaticOrder, true, true>(F.lds, g, S, E);
            }
            SEAM(pb + 12);
            if (IN(pb + 13)) REP(pb + 13) { for (int r = F.gw; r < T; r += F.NGW) rms_row(XRES + (size_t)r * D, mix_norm_w + D, H + (size_t)r * D, F.lane); }
            SEAM(pb + 13);
        } else {
#define MOE_OFFSETS() int off[9]; off[0] = 0; _Pragma("unroll") for (int e = 0; e < 8; ++e) { const int c = __builtin_amdgcn_readfirstlane((int)__hip_atomic_load(ctl + CW_CNT + e, __ATOMIC_RELAXED, __HIP_MEMORY_SCOPE_AGENT)); off[e + 1] = off[e] + ((c + 255) & ~255); }
            if (IN(pb + 11)) REP(pb + 11) {
                MOE_OFFSETS();
                for (int it = F.gw; it < T * 2; it += F.NGW) { const int t = it >> 1, k = it & 1; int* ro = ROUTE + (size_t)t * 8; const int e = ro[k], pos = ro[2 + k];
                    int base = 0;
#pragma unroll
                    for (int q = 0; q < 8; ++q) if (e == q) base = off[q];
                    const int slot = base + pos; if (F.lane == 0) ro[6 + k] = slot;
                    const v4u* src = (const v4u*)(H8 + (size_t)t * D); v4u* dst = (v4u*)((unsigned char*)HG + (size_t)slot * D);
#pragma unroll
                    for (int j = 0; j < 2; ++j) dst[F.lane + 64 * j] = src[F.lane + 64 * j]; }
#pragma unroll
                for (int e = 0; e < 8; ++e) { const int c = __builtin_amdgcn_readfirstlane((int)__hip_atomic_load(ctl + CW_CNT + e, __ATOMIC_RELAXED, __HIP_MEMORY_SCOPE_AGENT));
                    for (int rr = off[e] + c + F.gw; rr < off[e + 1]; rr += F.NGW) { v4u* dst = (v4u*)((unsigned char*)HG + (size_t)rr * D);
#pragma unroll
                        for (int j = 0; j < 2; ++j) dst[F.lane + 64 * j] = (v4u){0u, 0u, 0u, 0u}; } }
            }
            SEAM(pb + 11);
            if (IN(pb + 12)) REP(pb + 12) {
                if (F.tid == 0) { MOE_OFFSETS(); int cu = 0;
#pragma unroll
                    for (int e = 0; e < 8; ++e) { const int ne = (off[e + 1] - off[e]) >> 8; MTAB[e] = ne; MTAB[8 + e] = off[e] >> 8; MTAB[16 + e] = cu; cu += ne * 56; } MTAB[24] = cu; MTAB[25] = cu; }
                __syncthreads();
                pg8::Gemm g{HG, WEGU, MAXSLOT, NEXP * 2 * EFF, D / 2}; pg8::MoeOrder S{(const LAS int*)MTAB, 56, F.G, (int)blockIdx.x};
                pg8::EpiSwiglu8 E{(unsigned char*)EACT, EFF, 56, 1.0f / 256.f, 8.f};
                pg8::gemm_phase<pg8::EpiSwiglu8, pg8::MoeOrder, true, true, true>(F.lds, g, S, E);
            }
            SEAM(pb + 12);
            if (IN(pb + 13)) REP(pb + 13) {
                __syncthreads();
                if (F.tid == 0) { MOE_OFFSETS(); int cu = 0;
#pragma unroll
                    for (int e = 0; e < 8; ++e) { const int ne = (off[e + 1] - off[e]) >> 8; MTAB[e] = ne; MTAB[8 + e] = off[e] >> 8; MTAB[16 + e] = cu; cu += ne * 8; } MTAB[24] = cu; MTAB[25] = cu; }
                __syncthreads();
                pg8::Gemm g{EACT, WEDN, MAXSLOT, NEXP * D, EFF / 2}; pg8::MoeOrder S{(const LAS int*)MTAB, 8, F.G, (int)blockIdx.x};
                pg8::EpiStoreF32 E{Y, D, 8, 1.0f / 2048.f};
                pg8::gemm_phase<pg8::EpiStoreF32, pg8::MoeOrder, true, true, true>(F.lds, g, S, E);
            }
            SEAM(pb + 13);
            if (IN(pb + 14)) REP(pb + 14) {
                const int lane = F.lane;
                for (int r = F.gw; r < T; r += F.NGW) { const int* ro = ROUTE + (size_t)r * 8; const float p0 = ((const float*)ro)[4], p1 = ((const float*)ro)[5]; const float* y0 = Y + (size_t)ro[6] * D; const float* y1 = Y + (size_t)ro[7] * D;
                    const float* xrow = XRES + (size_t)r * D; f32x4 v[8]; float ss = 0.f;
#pragma unroll
                    for (int j = 0; j < 8; ++j) { const int o = 4 * (lane + 64 * j); v[j] = *(const f32x4*)(xrow + o) + *(const f32x4*)(y0 + o) * p0 + *(const f32x4*)(y1 + o) * p1; ss += (v[j][0] * v[j][0] + v[j][1] * v[j][1]) + (v[j][2] * v[j][2] + v[j][3] * v[j][3]); }
                    const float rstd = rsqrtf(wave_sum(ss) * (1.f / D) + EPS);
#pragma unroll
                    for (int j = 0; j < 8; ++j) { const int o = 4 * (lane + 64 * j); const f32x4 ww = *(const f32x4*)(final_norm_w + o); *(f32x4*)(args.out + (size_t)r * D + o) = v[j] * rstd * ww; } }
            }
        }
    }
    { constexpr int l = 1;
        const int pb = 2 + l * NPL;
        const float lambda_init = l == 0 ? 0.2f : 0.35550906f;
        const float* xin = l == 0 ? x_in : XRES;
        if (IN(pb + 0)) REP(pb + 0) {
            pg8::Gemm g{H, WIN + (size_t)l * NINP * D, T, NINP, D}; pg8::StaticOrder S; S.init(T, NINP, F.G, (int)blockIdx.x);
            pg8::EpiIn E{RQ, RK, RVT, RG, BQKV, BZ, CQ, CK, CVT, GATES, BBA};
            pg8::gemm_phase<pg8::EpiIn, pg8::StaticOrder, true, true>(F.lds, g, S, E);
        }
        SEAM(pb + 0);
        if (IN(pb + 1)) REP(pb + 1) {
            const float* cw = conv_w + (size_t)l * 4 * 3072;
            for (int it = F.vcu; it < 1024; it += F.G) gdn_prep_item(F, l, it >> 5, it & 31, BQKV, BBA, cw, a_log, dt_bias, ws + WS_GCH + (size_t)it * GDN_CH_BYTES, (float*)(ws + WS_GL) + it);
        }
        SEAM(pb + 1);
        if (IN(pb + 2)) REP(pb + 2) {
            const int bx = F.vcu;
            const int mixsel = (l == 0 && args.ph_hi > 100) ? (args.ph_hi - 100) : 3, qw = (l == 0 && args.ph_hi > 100) ? 104 : 100 + l;
            if (bx < 32 && (mixsel & 1)) gdn_scan(F, bx, ws + WS_GCH, (const float*)(ws + WS_GL), OB);
            if (mixsel & 2) {
                volatile LAS int* qslot = (volatile LAS int*)(F.lds + MISC_OFF + 256);
                int nxt = 0; if (F.tid == 0) nxt = (int)atomicAdd(ctl + qw, 1u);
                for (;;) {
                    __syncthreads(); if (F.tid == 0) qslot[0] = nxt; __syncthreads();
                    const int it = __builtin_amdgcn_readfirstlane(qslot[0]); if (it >= 1024) break;
                    if (F.tid == 0) nxt = (int)atomicAdd(ctl + qw, 1u);
                    const int qt = 15 - (it >> 6), kind = (it >> 5) & 1, hd = it & 31, b = hd >> 3, hm = hd & 7;
                    if (kind == 0) { const int hh = hm >> 1, m = hm & 1; const float slope = exp2f(-2.0f * (float)(hh + 1));
                        flash_item<256, 128, true, false, false>(F, CQ + ((size_t)hd * SEQ + qt * 128) * 128, CK + (size_t)hd * SEQ * 128, CVT + (size_t)(b * 4 + hh) * 256 * SEQ, SEQ, qt * 128, SEQ, slope,
                                                            O12 + ((size_t)m * T + b * SEQ + qt * 128) * 1024 + hh * 256, nullptr, 1024); }
                    else { const float lg = log2f(1.0f - exp2f(-5.0f - (float)hm));
                        flash_item<128, 128, true, false, true>(F, RQ + ((size_t)hd * SEQ + qt * 128) * 128, RK + (size_t)hd * SEQ * 128, RVT + (size_t)hd * 128 * SEQ, SEQ, qt * 128, SEQ, lg,
                                                           OA + ((size_t)(b * SEQ + qt * 128)) * 1024 + hm * 128, nullptr, 1024); }
                }
            }
        }
        SEAM(pb + 2);
        if (IN(pb + 3)) REP(pb + 3) {
            const int lane = F.lane;
            const float* lv = diff_lambda + (size_t)l * 512;
            const float d01 = wave_sum(lv[lane] * lv[128 + lane] + lv[64 + lane] * lv[192 + lane]), d23 = wave_sum(lv[256 + lane] * lv[384 + lane] + lv[320 + lane] * lv[448 + lane]);
            const float lam = __expf(d01) - __expf(d23) + lambda_init;
            for (int t = F.gw; t < T; t += F.NGW) {
#pragma unroll
                for (int h = 0; h < 8; ++h) { const size_t o = (size_t)t * 1024 + h * 128 + 2 * lane;
                    { const float a0 = OA[o], a1 = OA[o + 1]; const float mean = wave_sum(a0 + a1) * (1.f / 128.f); const float c0 = a0 - mean, c1 = a1 - mean; const float rstd = rsqrtf(wave_sum(c0 * c0 + c1 * c1) * (1.f / 128.f) + EPS);
                      const unsigned gv = *(const unsigned*)(RG + o); *(unsigned*)(OCAT + (size_t)t * 3072 + h * 128 + 2 * lane) = pk2(c0 * rstd * bf2f(gv & 0xffffu), c1 * rstd * __uint_as_float(gv & 0xffff0000u)); }
                    { const float a0 = OB[o], a1 = OB[o + 1]; const float rstd = rsqrtf(wave_sum(a0 * a0 + a1 * a1) * (1.f / 128.f) + EPS); const unsigned gv = *(const unsigned*)(BZ + o);
                      *(unsigned*)(OCAT + (size_t)t * 3072 + 1024 + h * 128 + 2 * lane) = pk2(a0 * rstd * gdn_norm_w[l * 128 + 2 * lane] * bf2f(gv & 0xffffu), a1 * rstd * gdn_norm_w[l * 128 + 2 * lane + 1] * __uint_as_float(gv & 0xffff0000u)); } }
#pragma unroll
                for (int h = 0; h < 4; ++h) { const size_t o = (size_t)t * 1024 + h * 256 + 4 * lane; const f32x4 p = *(const f32x4*)(O12 + o), q = *(const f32x4*)(O12 + (size_t)T * 1024 + o); const f32x4 d = p - q * lam;
                    const float rstd = rsqrtf(wave_sum((d[0] * d[0] + d[1] * d[1]) + (d[2] * d[2] + d[3] * d[3])) * (1.f / 256.f) + EPS) * (1.0f - lambda_init); const f32x4 ww = *(const f32x4*)(diff_norm_w + l * 256 + 4 * lane);
                    v2u ov; ov.x = pk2(d[0] * rstd * ww[0], d[1] * rstd * ww[1]); ov.y = pk2(d[2] * rstd * ww[2], d[3] * rstd * ww[3]); *(v2u*)(OCAT + (size_t)t * 3072 + 2048 + h * 256 + 4 * lane) = ov; }
            }
        }
        SEAM(pb + 3);
        if (IN(pb + 4)) REP(pb + 4) {
            pg8::Gemm g{OCAT, WBR + (size_t)l * D * 3072, T, D, 3072}; pg8::StaticOrder S; S.init(T, D, F.G, (int)blockIdx.x);
            pg8::EpiBranch E{MERGEB, GATES, 16, 32};
            pg8::gemm_phase<pg8::EpiBranch, pg8::StaticOrder, true, true>(F.lds, g, S, E);
        }
        SEAM(pb + 4);
        if (IN(pb + 5)) REP(pb + 5) {
            pg8::Gemm g{MERGEB, WOUT + (size_t)l * D * D, T, D, D}; pg8::StaticOrder S; S.init(T, D, F.G, (int)blockIdx.x);
            pg8::EpiResid E{xin, XRES, D, 1.f};
            pg8::gemm_phase<pg8::EpiResid, pg8::StaticOrder, true, true>(F.lds, g, S, E);
        }
        SEAM(pb + 5);
        if (IN(pb + 6)) REP(pb + 6) { for (int r = F.gw; r < T; r += F.NGW) rms_row(XRES + (size_t)r * D, cross_norm_w + l * D, H + (size_t)r * D, F.lane); }
        SEAM(pb + 6);
        if (IN(pb + 7)) REP(pb + 7) {
            pg8::Gemm g{H, WQ + (size_t)l * 512 * D, T, 512, D}; pg8::StaticOrder S; S.init(T, 512, F.G, (int)blockIdx.x);
            pg8::EpiHeads E{QX, nullptr, 4, 11, 1 << 20};
            pg8::gemm_phase<pg8::EpiHeads, pg8::StaticOrder, true, true>(F.lds, g, S, E);
        }
        SEAM(pb + 7);
        if (IN(pb + 8)) REP(pb + 8) {
            for (int it = F.vcu; it < 256; it += F.G) { const int hd = it >> 4, qt = it & 15, b = hd >> 2, hh = hd & 3;
                flash_item<128, 128, false, true, false>(F, QX + ((size_t)hd * SEQ + qt * 128) * 128, KX + ((size_t)l * 16 + hd) * MEML * 128, VXT + ((size_t)l * 16 + hd) * 128 * MEML, MEML, qt * 128, MEML, 0.f,
                                             nullptr, OX + ((size_t)(b * SEQ + qt * 128)) * 512 + hh * 128, 512); }
        }
        SEAM(pb + 8);
        if (IN(pb + 9)) REP(pb + 9) {
            pg8::Gemm g{OX, WO + (size_t)l * D * 512, T, D, 512}; pg8::StaticOrder S; S.init(T, D, F.G, (int)blockIdx.x);
            pg8::EpiResid E{XRES, XRES, D, 1.f};
            pg8::gemm_phase<pg8::EpiResid, pg8::StaticOrder, true, true>(F.lds, g, S, E);
        }
        SEAM(pb + 9);
        if (IN(pb + 10)) REP(pb + 10) {
            const int lane = F.lane; const float* w = ffn_norm_w + l * D;
            for (int r = F.gw; r < T; r += F.NGW) {
                const float* xrow = XRES + (size_t)r * D; f32x4 v[8]; float ss = 0.f;
#pragma unroll
                for (int j = 0; j < 8; ++j) { v[j] = *(const f32x4*)(xrow + 4 * (lane + 64 * j)); ss += (v[j][0] * v[j][0] + v[j][1] * v[j][1]) + (v[j][2] * v[j][2] + v[j][3] * v[j][3]); }
                const float rstd = rsqrtf(wave_sum(ss) * (1.f / D) + EPS);
                float lg[8];
#pragma unroll
                for (int e = 0; e < 8; ++e) lg[e] = 0.f;
#pragma unroll
                for (int j = 0; j < 8; ++j) { const f32x4 ww = *(const f32x4*)(w + 4 * (lane + 64 * j)); f32x4 y; y[0] = v[j][0] * rstd * ww[0]; y[1] = v[j][1] * rstd * ww[1]; y[2] = v[j][2] * rstd * ww[2]; y[3] = v[j][3] * rstd * ww[3];
                    if (l == 0) { v2u o; o.x = pk2(y[0], y[1]); o.y = pk2(y[2], y[3]); *(v2u*)(H + (size_t)r * D + 4 * (lane + 64 * j)) = o; }
                    else *(unsigned*)(H8 + (size_t)r * D + 4 * (lane + 64 * j)) = pg8::pk4_fp8(y[0], y[1], y[2], y[3]);
                    if (l == 1) {
#pragma unroll
                        for (int c = 0; c < 4; ++c) { const float* rw = router_w + (size_t)(4 * (lane + 64 * j) + c) * 8; const f32x4 r0 = *(const f32x4*)rw, r1 = *(const f32x4*)(rw + 4);
                            lg[0] += y[c] * r0[0]; lg[1] += y[c] * r0[1]; lg[2] += y[c] * r0[2]; lg[3] += y[c] * r0[3]; lg[4] += y[c] * r1[0]; lg[5] += y[c] * r1[1]; lg[6] += y[c] * r1[2]; lg[7] += y[c] * r1[3]; } } }
                if (l == 1) {
#pragma unroll
                    for (int e = 0; e < 8; ++e) lg[e] = wave_sum(lg[e]);
                    int e0 = 0; float v0 = lg[0];
#pragma unroll
                    for (int e = 1; e < 8; ++e) if (lg[e] > v0) { v0 = lg[e]; e0 = e; }
                    int e1 = -1; float v1 = -__builtin_inff();
#pragma unroll
                    for (int e = 0; e < 8; ++e) if (e != e0 && lg[e] > v1) { v1 = lg[e]; e1 = e; }
                    if (lane == 0) { const float p0 = 1.0f / (1.0f + __expf(v1 - v0)); int* ro = ROUTE + (size_t)r * 8;
                        ro[0] = e0; ro[1] = e1; ro[2] = (int)atomicAdd(ctl + CW_CNT + e0, 1u); ro[3] = (int)atomicAdd(ctl + CW_CNT + e1, 1u); ((float*)ro)[4] = p0; ((float*)ro)[5] = 1.0f - p0; }
                }
            }
        }
        SEAM(pb + 10);
        if (l == 0) {
            if (IN(pb + 11)) REP(pb + 11) {
                pg8::Gemm g{H, WGU, T, 2 * DFF, D}; pg8::StaticOrder S; S.init(T, 2 * DFF, F.G, (int)blockIdx.x);
                pg8::EpiSwiglu E{ACT, DFF, 1 << 20};
                pg8::gemm_phase<pg8::EpiSwiglu, pg8::StaticOrder, true, true>(F.lds, g, S, E);
            }
            SEAM(pb + 11);
            if (IN(pb + 12)) REP(pb + 12) {
                pg8::Gemm g{ACT, WDN, T, D, DFF}; pg8::StaticOrder S; S.init(T, D, F.G, (int)blockIdx.x);
                pg8::EpiResid E{XRES, XRES, D, 1.f};
                pg8::gemm_phase<pg8::EpiResid, pg8::StaticOrder, true, true>(F.lds, g, S, E);
            }
            SEAM(pb + 12);
            if (IN(pb + 13)) REP(pb + 13) { for (int r = F.gw; r < T; r += F.NGW) rms_row(XRES + (size_t)r * D, mix_norm_w + D, H + (size_t)r * D, F.lane); }
            SEAM(pb + 13);
        } else {
#define MOE_OFFSETS() int off[9]; off[0] = 0; _Pragma("unroll") for (int e = 0; e < 8; ++e) { const int c = __builtin_amdgcn_readfirstlane((int)__hip_atomic_load(ctl + CW_CNT + e, __ATOMIC_RELAXED, __HIP_MEMORY_SCOPE_AGENT)); off[e + 1] = off[e] + ((c + 255) & ~255); }
            if (IN(pb + 11)) REP(pb + 11) {
                MOE_OFFSETS();
                for (int it = F.gw; it < T * 2; it += F.NGW) { const int t = it >> 1, k = it & 1; int* ro = ROUTE + (size_t)t * 8; const int e = ro[k], pos = ro[2 + k];
                    int base = 0;
#pragma unroll
                    for (int q = 0; q < 8; ++q) if (e == q) base = off[q];
                    const int slot = base + pos; if (F.lane == 0) ro[6 + k] = slot;
                    const v4u* src = (const v4u*)(H8 + (size_t)t * D); v4u* dst = (v4u*)((unsigned char*)HG + (size_t)slot * D);
#pragma unroll
                    for (int j = 0; j < 2; ++j) dst[F.lane + 64 * j] = src[F.lane + 64 * j]; }
#pragma unroll
                for (int e = 0; e < 8; ++e) { const int c = __builtin_amdgcn_readfirstlane((int)__hip_atomic_load(ctl + CW_CNT + e, __ATOMIC_RELAXED, __HIP_MEMORY_SCOPE_AGENT));
                    for (int rr = off[e] + c + F.gw; rr < off[e + 1]; rr += F.NGW) { v4u* dst = (v4u*)((unsigned char*)HG + (size_t)rr * D);
#pragma unroll
                        for (int j = 0; j < 2; ++j) dst[F.lane + 64 * j] = (v4u){0u, 0u, 0u, 0u}; } }
            }
            SEAM(pb + 11);
            if (IN(pb + 12)) REP(pb + 12) {
                if (F.tid == 0) { MOE_OFFSETS(); int cu = 0;
#pragma unroll
                    for (int e = 0; e < 8; ++e) { const int ne = (off[e + 1] - off[e]) >> 8; MTAB[e] = ne; MTAB[8 + e] = off[e] >> 8; MTAB[16 + e] = cu; cu += ne * 56; } MTAB[24] = cu; MTAB[25] = cu; }
                __syncthreads();
                pg8::Gemm g{HG, WEGU, MAXSLOT, NEXP * 2 * EFF, D / 2}; pg8::MoeOrder S{(const LAS int*)MTAB, 56, F.G, (int)blockIdx.x};
                pg8::EpiSwiglu8 E{(unsigned char*)EACT, EFF, 56, 1.0f / 256.f, 8.f};
                pg8::gemm_phase<pg8::EpiSwiglu8, pg8::MoeOrder, true, true, true>(F.lds, g, S, E);
            }
            SEAM(pb + 12);
            if (IN(pb + 13)) REP(pb + 13) {
                __syncthreads();
                if (F.tid == 0) { MOE_OFFSETS(); int cu = 0;
#pragma unroll
                    for (int e = 0; e < 8; ++e) { const int ne = (off[e + 1] - off[e]) >> 8; MTAB[e] = ne; MTAB[8 + e] = off[e] >> 8; MTAB[16 + e] = cu; cu += ne * 8; } MTAB[24] = cu; MTAB[25] = cu; }
                __syncthreads();
                pg8::Gemm g{EACT, WEDN, MAXSLOT, NEXP * D, EFF / 2}; pg8::MoeOrder S{(const LAS int*)MTAB, 8, F.G, (int)blockIdx.x};
                pg8::EpiStoreF32 E{Y, D, 8, 1.0f / 2048.f};
                pg8::gemm_phase<pg8::EpiStoreF32, pg8::MoeOrder, true, true, true>(F.lds, g, S, E);
            }
            SEAM(pb + 13);
            if (IN(pb + 14)) REP(pb + 14) {
                const int lane = F.lane;
                for (int r = F.gw; r < T; r += F.NGW) { const int* ro = ROUTE + (size_t)r * 8; const float p0 = ((const float*)ro)[4], p1 = ((const float*)ro)[5]; const float* y0 = Y + (size_t)ro[6] * D; const float* y1 = Y + (size_t)ro[7] * D;
                    const float* xrow = XRES + (size_t)r * D; f32x4 v[8]; float ss = 0.f;
#pragma unroll
                    for (int j = 0; j < 8; ++j) { const int o = 4 * (lane + 64 * j); v[j] = *(const f32x4*)(xrow + o) + *(const f32x4*)(y0 + o) * p0 + *(const f32x4*)(y1 + o) * p1; ss += (v[j][0] * v[j][0] + v[j][1] * v[j][1]) + (v[j][2] * v[j][2] + v[j][3] * v[j][3]); }
                    const float rstd = rsqrtf(wave_sum(ss) * (1.f / D) + EPS);
#pragma unroll
                    for (int j = 0; j < 8; ++j) { const int o = 4 * (lane + 64 * j); const f32x4 ww = *(const f32x4*)(final_norm_w + o); *(f32x4*)(args.out + (size_t)r * D + o) = v[j] * rstd * ww; } }
            }
        }
    }
#undef IN
#undef SEAM
}

extern "C" void kernel_launch(void* const* d_in, const int* in_sizes, int n_in, void* d_out, int out_size, void* d_ws, size_t ws_size, hipStream_t stream) {
    static int grid = 0;
    if (grid == 0) {
        if (n_in != 24 || out_size != T * D || ws_size < WS_END) { fprintf(stderr, "kernel_launch: unexpected shapes (n_in %d, out %d, ws %zu < %zu)\n", n_in, out_size, ws_size, (size_t)WS_END); grid = -1; return; }
        int dev = 0, cus = 0, per_cu = 0;
        if (hipGetDevice(&dev) != hipSuccess || hipDeviceGetAttribute(&cus, hipDeviceAttributeMultiprocessorCount, dev) != hipSuccess) { grid = -1; return; }
        if (hipFuncSetAttribute((const void*)mk_fwd, hipFuncAttributeMaxDynamicSharedMemorySize, LDS_BYTES) != hipSuccess) { fprintf(stderr, "kernel_launch: hipFuncSetAttribute failed\n"); grid = -1; return; }
        if (hipOccupancyMaxActiveBlocksPerMultiprocessor(&per_cu, (const void*)mk_fwd, NWAVES * 64, LDS_BYTES) != hipSuccess || per_cu < 1) fprintf(stderr, "kernel_launch: occupancy query says %d\n", per_cu);
        (void)hipGetLastError();
        grid = cus;
    }
    if (grid < 0) return;
    (void)hipMemsetAsync((char*)d_ws + WS_CTL, 0, CTL_BYTES, stream);
    Args a{};
    for (int i = 0; i < 24; ++i) a.in[i] = d_in[i];
    a.out = (float*)d_out; a.ws = (unsigned char*)d_ws;
#if MK_ONE_LAUNCH
    a.ph_lo = 0; a.ph_hi = NPH;
    hipLaunchKernelGGL(mk_fwd, dim3(grid), dim3(NWAVES * 64), LDS_BYTES, stream, a);
#else
#ifndef DUP_MASK
#define DUP_MASK 0ull
#endif
    for (int p = 0; p < NPH; ++p) { a.ph_lo = p; a.ph_hi = p + 1; const int reps = ((DUP_MASK >> p) & 1ull) ? 2 : 1;
        for (int r = 0; r < reps; ++r) hipLaunchKernelGGL(mk_fwd, dim3(grid), dim3(NWAVES * 64), LDS_BYTES, stream, a);
#ifdef MIX_EXTRA
        if (p == 4) { a.ph_hi = 100 + MIX_EXTRA; hipLaunchKernelGGL(mk_fwd, dim3(grid), dim3(NWAVES * 64), LDS_BYTES, stream, a); }
#endif
    }
#endif
}
```

```cpp
#include <hip/hip_runtime.h>
#include <cstdio>
#include <cstdint>
#define MK_ONE_LAUNCH 1
namespace pg8 {
#define PG8_LAS __attribute__((address_space(3)))
typedef unsigned short bf16_t;
typedef short bf16x8 __attribute__((ext_vector_type(8)));
typedef float f32x4 __attribute__((ext_vector_type(4)));
typedef unsigned u32x4 __attribute__((ext_vector_type(4)));
typedef int i32x4 __attribute__((ext_vector_type(4)));
constexpr int BM = 256, BK = 64, HALF = 128, HTB = HALF * BK * 2  , STAGE_BYTES = 8 * HTB, NXCD = 8, WGM = 8;

__host__ __device__ __forceinline__ int lds_byte(int r, int c) { const int st = (r >> 4) * 2 + (c >> 5), rr = r & 15, cc = c & 31, ob = rr * 64 + cc * 2; return st * 1024 + (ob ^ (((ob >> 9) & 1) << 5)); }
__host__ __device__ __forceinline__ void stage_rc(int b, int& R, int& C) { const int st = b / 1024, sb = b % 1024, swz = sb ^ (((sb >> 9) & 1) << 5); R = (st >> 1) * 16 + swz / 64; C = (st & 1) * 32 + (swz % 64) / 2; }
__host__ __device__ __forceinline__ int perm32(int rho) { const int n = rho >> 4, i = rho & 15; return 8 * (i >> 2) + 4 * n + (i & 3); }

struct Unit { int pm, pn; };
struct Gemm { const bf16_t* A; const bf16_t* Bt; int M, N, K; };

struct StaticOrder {
    int nM, nN, nwg, G, c;
    __host__ __device__ void init(int M, int N, int G_, int c_) { nM = M / BM; nN = N / BM; nwg = nM * nN; G = G_; c = c_; }
    __host__ __device__ bool next(int i, Unit& u) const {
        const long L = (long)i * G + c; if (L >= nwg) return false;
        int wgid = (int)L; { const int q = nwg / NXCD, r = nwg % NXCD, xcd = wgid % NXCD, off = wgid / NXCD; wgid = (xcd < r ? xcd * (q + 1) : r * (q + 1) + (xcd - r) * q) + off; }
        const int nig = WGM * nN, gid = wgid / nig, fm = gid * WGM, gsz = (nM - fm) < WGM ? (nM - fm) : WGM;
        u.pm = fm + ((wgid % nig) % gsz); u.pn = (wgid % nig) / gsz; return true;
    }
    __device__ __forceinline__ void a_ready(const Unit&) const {}
    __device__ __forceinline__ void done(const Unit&) const {}
};

__device__ __forceinline__ unsigned cvt_pk_bf16(float lo, float hi) { unsigned r; asm volatile("v_cvt_pk_bf16_f32 %0, %1, %2" : "=v"(r) : "v"(lo), "v"(hi)); return r; }
typedef float f32x2 __attribute__((ext_vector_type(2)));
__device__ __forceinline__ float fsilu(float v) { return v / (1.0f + __expf(-v)); }
__device__ __forceinline__ float fsigm(float v) { return 1.0f / (1.0f + __expf(-v)); }
__device__ __forceinline__ void st8bf(bf16_t* p, f32x4 v0, f32x4 v1) { u32x4 w; w.x = cvt_pk_bf16(v0[0], v0[1]); w.y = cvt_pk_bf16(v0[2], v0[3]); w.z = cvt_pk_bf16(v1[0], v1[1]); w.w = cvt_pk_bf16(v1[2], v1[3]); *(u32x4*)p = w; }
__device__ __forceinline__ bf16_t f2bf1(float f) { unsigned u = __builtin_bit_cast(unsigned, f); return (bf16_t)((u + 0x7fffu + ((u >> 16) & 1u)) >> 16); }

struct EpiIn {
    static constexpr bool PERM = true, AFTER_DRAIN = false, HOOK = false;
    bf16_t *RQ, *RK, *RVT, *RG, *BQKV, *BZ, *CQ, *CK, *CVT, *GATES; float* BBA; int set; float sc8;
    __device__ __forceinline__ void operator()(const f32x4 (&acc_)[2][2][4][2], const Unit& u, int wr, int wc, int fr, int fq) const {
        f32x4 acc[2][2][4][2];
#pragma unroll
        for (int a_ = 0; a_ < 2; ++a_)
#pragma unroll
            for (int b_ = 0; b_ < 2; ++b_)
#pragma unroll
                for (int m_ = 0; m_ < 4; ++m_)
#pragma unroll
                    for (int n_ = 0; n_ < 2; ++n_) acc[a_][b_][m_][n_] = set ? acc_[a_][b_][m_][n_] * sc8 : acc_[a_][b_][m_][n_];
        const int lp = u.pn, pn = set == 0 ? (lp < 44 ? lp : 68) : lp + 44, b = u.pm >> 3;
        const int rowt = u.pm * BM + wr * 64 + fr;
        const int cin = wc * 32 + 8 * fq;
        if (pn < 8 || (pn >= 32 && pn < 40)) {
            auto heads = [&](bf16_t* base, int hb, float sc) __attribute__((always_inline)) {
#pragma unroll
                for (int ai = 0; ai < 2; ++ai)
#pragma unroll
                    for (int m = 0; m < 4; ++m) { const int s = (rowt + ai * HALF + m * 16) - b * 2048;
#pragma unroll
                        for (int bj = 0; bj < 2; ++bj) st8bf(base + ((size_t)((b * 8 + hb + bj) * 2048 + s)) * 128 + cin, acc[ai][bj][m][0] * sc, acc[ai][bj][m][1] * sc); } };
            if (pn < 4) heads(RQ, pn * 2, 1.f); else if (pn < 8) heads(RK, (pn - 4) * 2, 0.08838834764831845f);
            else if (pn < 36) heads(CQ, (pn - 32) * 2, 1.f); else heads(CK, (pn - 36) * 2, 1.f);
        } else if ((pn >= 40 && pn < 44) || (pn >= 8 && pn < 12)) {
            const bool isr = pn < 12; const int h = isr ? pn - 8 : pn - 40; bf16_t* CVT = isr ? RVT : this->CVT;
#pragma unroll
            for (int ai = 0; ai < 2; ++ai)
#pragma unroll
                for (int m = 0; m < 4; ++m) { const int s = (rowt + ai * HALF + m * 16) - b * 2048;
#pragma unroll
                    for (int bj = 0; bj < 2; ++bj)
#pragma unroll
                        for (int n = 0; n < 2; ++n)
#pragma unroll
                            for (int e = 0; e < 4; ++e) CVT[((size_t)((b * 4 + h) * 256 + bj * HALF + cin + 4 * n + e)) * 2048 + s] = f2bf1(acc[ai][bj][m][n][e]); }
        } else if (pn == 68) {
            if (wc == 0 && fq < 2) {
#pragma unroll
                for (int ai = 0; ai < 2; ++ai)
#pragma unroll
                    for (int m = 0; m < 4; ++m) { float* p = BBA + (size_t)(rowt + ai * HALF + m * 16) * 16 + 8 * fq; *(f32x4*)p = acc[ai][0][m][0]; *(f32x4*)(p + 4) = acc[ai][0][m][1]; }
            }
        } else {
            auto rows = [&](bf16_t* base, int ldc, int c0, int act) __attribute__((always_inline)) {
#pragma unroll
                for (int ai = 0; ai < 2; ++ai)
#pragma unroll
                    for (int m = 0; m < 4; ++m) { bf16_t* rowp = base + (size_t)(rowt + ai * HALF + m * 16) * ldc + c0 + cin;
#pragma unroll
                        for (int bj = 0; bj < 2; ++bj) { f32x4 v0 = acc[ai][bj][m][0], v1 = acc[ai][bj][m][1];
                            if (act == 1) {
#pragma unroll
                                for (int e = 0; e < 4; ++e) { v0[e] = fsilu(v0[e]); v1[e] = fsilu(v1[e]); } }
                            else if (act == 2) {
#pragma unroll
                                for (int e = 0; e < 4; ++e) { v0[e] = fsigm(v0[e]); v1[e] = fsigm(v1[e]); } }
                            st8bf(rowp + bj * HALF, v0, v1); } } };
            if (pn < 16) rows(RG, 1024, (pn - 12) * 256, 1); else if (pn < 28) rows(BQKV, 3072, (pn - 16) * 256, 0);
            else if (pn < 32) rows(BZ, 1024, (pn - 28) * 256, 1); else rows(GATES, 6144, (pn - 44) * 256, 2);
        }
    }
};

struct EpiHeads {
    static constexpr bool PERM = true, AFTER_DRAIN = false, HOOK = false;
    bf16_t* O; bf16_t* VT; int NH, rpb_shift  , vt_from_pn;
    __device__ __forceinline__ void operator()(const f32x4 (&acc)[2][2][4][2], const Unit& u, int wr, int wc, int fr, int fq) const {
        const int rowt = u.pm * BM + wr * 64 + fr, cin = wc * 32 + 8 * fq, rpb = 1 << rpb_shift;
        if (u.pn < vt_from_pn) {
#pragma unroll
            for (int ai = 0; ai < 2; ++ai)
#pragma unroll
                for (int m = 0; m < 4; ++m) { const int row = rowt + ai * HALF + m * 16, b = row >> rpb_shift, s = row & (rpb - 1);
#pragma unroll
                    for (int bj = 0; bj < 2; ++bj) st8bf(O + ((size_t)((b * NH + u.pn * 2 + bj) * rpb + s)) * 128 + cin, acc[ai][bj][m][0], acc[ai][bj][m][1]); }
        } else {
            const int hb = (u.pn - vt_from_pn) * 2;
#pragma unroll
            for (int ai = 0; ai < 2; ++ai)
#pragma unroll
                for (int m = 0; m < 4; ++m) { const int row = rowt + ai * HALF + m * 16, b = row >> rpb_shift, s = row & (rpb - 1);
#pragma unroll
                    for (int bj = 0; bj < 2; ++bj)
#pragma unroll
                        for (int n = 0; n < 2; ++n)
#pragma unroll
                            for (int e = 0; e < 4; ++e) VT[((size_t)((b * NH + hb + bj) * 128 + cin + 4 * n + e)) * rpb + s] = f2bf1(acc[ai][bj][m][n][e]); }
        }
    }
};

struct EpiResid {
    static constexpr bool PERM = false, AFTER_DRAIN = false, HOOK = false;
    const float* in; float* out; int ldc; float sc;
    __device__ __forceinline__ void operator()(const f32x4 (&acc)[2][2][4][2], const Unit& u, int wr, int wc, int fr, int fq) const {
        const int row0 = u.pm * BM + wr * 64 + fr, col0 = u.pn * BM + wc * 32 + 4 * fq;
#pragma unroll
        for (int ai = 0; ai < 2; ++ai)
#pragma unroll
            for (int m = 0; m < 4; ++m) { const size_t off = (size_t)(row0 + ai * HALF + m * 16) * ldc + col0;
#pragma unroll
                for (int bj = 0; bj < 2; ++bj)
#pragma unroll
                    for (int n = 0; n < 2; ++n) { const f32x4 x = *(const f32x4*)(in + off + bj * HALF + n * 16); *(f32x4*)(out + off + bj * HALF + n * 16) = x + acc[ai][bj][m][n] * sc; } }
    }
};

struct EpiBranch {
    static constexpr bool PERM = false, AFTER_DRAIN = false, HOOK = true;
    bf16_t* OUT; const bf16_t* GATES; int hk0, hk1;
    typedef unsigned u32x2 __attribute__((ext_vector_type(2)));
    static __device__ __forceinline__ f32x4 g4(const bf16_t* p) { const u32x2 gw = *(const u32x2*)p; f32x4 g; g[0] = __uint_as_float(gw.x << 16); g[1] = __uint_as_float(gw.x & 0xffff0000u); g[2] = __uint_as_float(gw.y << 16); g[3] = __uint_as_float(gw.y & 0xffff0000u); return g; }
    __device__ __forceinline__ void hook(f32x4 (&acc)[2][2][4][2], const Unit& u, int s, int wr, int wc, int fr, int fq) const {
        int z_ = 0; asm volatile("" : "+v"(z_));
        const int row0 = u.pm * BM + wr * 64 + fr + z_, col0 = u.pn * BM + wc * 32 + 4 * fq;
#pragma unroll
        for (int ai = 0; ai < 2; ++ai)
#pragma unroll
            for (int m = 0; m < 4; ++m) { const bf16_t* gp = GATES + (size_t)(row0 + ai * HALF + m * 16) * 6144 + s * 2048 + col0;
#pragma unroll
                for (int bj = 0; bj < 2; ++bj)
#pragma unroll
                    for (int n = 0; n < 2; ++n) { const f32x4 ga = g4(gp + bj * HALF + n * 16), gb = g4(gp + 2048 + bj * HALF + n * 16);
#pragma unroll
                        for (int e = 0; e < 4; ++e) acc[ai][bj][m][n][e] *= ga[e] * __builtin_amdgcn_rcpf(__builtin_fmaxf(gb[e], 1e-30f)); } }
    }
    __device__ __forceinline__ void operator()(const f32x4 (&acc)[2][2][4][2], const Unit& u, int wr, int wc, int fr, int fq) const {
        const int row0 = u.pm * BM + wr * 64 + fr, col0 = u.pn * BM + wc * 32 + 4 * fq;
#pragma unroll
        for (int ai = 0; ai < 2; ++ai)
#pragma unroll
            for (int m = 0; m < 4; ++m) { const int row = row0 + ai * HALF + m * 16;
#pragma unroll
                for (int bj = 0; bj < 2; ++bj)
#pragma unroll
                    for (int n = 0; n < 2; ++n) { const int col = col0 + bj * HALF + n * 16; const f32x4 v = g4(GATES + (size_t)row * 6144 + 4096 + col) * acc[ai][bj][m][n];
                        u32x2 w; w.x = cvt_pk_bf16(v[0], v[1]); w.y = cvt_pk_bf16(v[2], v[3]); *(u32x2*)(OUT + (size_t)row * 2048 + col) = w; } }
    }
};

struct EpiSwiglu {
    static constexpr bool PERM = true, AFTER_DRAIN = false, HOOK = false;
    bf16_t* O; int ldc, npn;
    __device__ __forceinline__ void operator()(const f32x4 (&acc)[2][2][4][2], const Unit& u, int wr, int wc, int fr, int fq) const {
        const int row0 = u.pm * BM + wr * 64 + fr, col0 = (u.pn % npn) * HALF + wc * 32 + 8 * fq;
#pragma unroll
        for (int ai = 0; ai < 2; ++ai)
#pragma unroll
            for (int m = 0; m < 4; ++m) { f32x4 v0, v1;
#pragma unroll
                for (int e = 0; e < 4; ++e) { v0[e] = fsilu(acc[ai][0][m][0][e]) * acc[ai][1][m][0][e]; v1[e] = fsilu(acc[ai][0][m][1][e]) * acc[ai][1][m][1][e]; }
                st8bf(O + (size_t)(row0 + ai * HALF + m * 16) * ldc + col0, v0, v1); }
    }
};


__device__ __forceinline__ float clamp8(float v) { return __builtin_fminf(__builtin_fmaxf(v, -448.f), 448.f); }
__device__ __forceinline__ unsigned pk4_fp8(float a, float b, float c, float d) { int r = 0; r = __builtin_amdgcn_cvt_pk_fp8_f32(clamp8(a), clamp8(b), r, false); r = __builtin_amdgcn_cvt_pk_fp8_f32(clamp8(c), clamp8(d), r, true); return (unsigned)r; }
struct EpiSwiglu8 {
    static constexpr bool PERM = true, AFTER_DRAIN = false, HOOK = false;
    unsigned char* O; int ldc, npn; float ws, as;
    __device__ __forceinline__ void operator()(const f32x4 (&acc)[2][2][4][2], const Unit& u, int wr, int wc, int fr, int fq) const {
        typedef unsigned u32x2 __attribute__((ext_vector_type(2)));
        const int row0 = u.pm * BM + wr * 64 + fr, col0 = (u.pn % npn) * HALF + wc * 32 + 8 * fq;
#pragma unroll
        for (int ai = 0; ai < 2; ++ai)
#pragma unroll
            for (int m = 0; m < 4; ++m) { float v[8];
#pragma unroll
                for (int n = 0; n < 2; ++n)
#pragma unroll
                    for (int e = 0; e < 4; ++e) v[4 * n + e] = fsilu(acc[ai][0][m][n][e] * ws) * (acc[ai][1][m][n][e] * ws) * as;
                u32x2 o; o.x = pk4_fp8(v[0], v[1], v[2], v[3]); o.y = pk4_fp8(v[4], v[5], v[6], v[7]);
                *(u32x2*)(O + (size_t)(row0 + ai * HALF + m * 16) * ldc + col0) = o; }
    }
};

struct EpiStoreF32 {
    static constexpr bool PERM = false, AFTER_DRAIN = false, HOOK = false;
    float* Y; int ldc, npn; float sc;
    __device__ __forceinline__ void operator()(const f32x4 (&acc)[2][2][4][2], const Unit& u, int wr, int wc, int fr, int fq) const {
        const int row0 = u.pm * BM + wr * 64 + fr, col0 = (u.pn % npn) * BM + wc * 32 + 4 * fq;
#pragma unroll
        for (int ai = 0; ai < 2; ++ai)
#pragma unroll
            for (int m = 0; m < 4; ++m) { float* rowp = Y + (size_t)(row0 + ai * HALF + m * 16) * ldc + col0;
#pragma unroll
                for (int bj = 0; bj < 2; ++bj)
#pragma unroll
                    for (int n = 0; n < 2; ++n) *(f32x4*)(rowp + bj * HALF + n * 16) = acc[ai][bj][m][n] * sc; }
    }
};

struct MoeOrder {
    const PG8_LAS int* T; int npn, G, c;
    __device__ __forceinline__ int rd(int k) const { return __builtin_amdgcn_readfirstlane(T[k]); }
    __device__ __forceinline__ bool next(int i, Unit& u) const {
        const int total = rd(25); const long L = (long)i * G + c; if (L >= total) return false;
        int wgid = (int)L; { const int q = total / NXCD, r = total % NXCD, xcd = wgid % NXCD, off = wgid / NXCD; wgid = (xcd < r ? xcd * (q + 1) : r * (q + 1) + (xcd - r) * q) + off; }
        int e = 0, cue = 0;
#pragma unroll
        for (int k = 1; k < 8; ++k) { const int ck = rd(16 + k); if (wgid >= ck) { e = k; cue = ck; } }
        const int loc = wgid - cue, ne = rd(e), r0 = rd(8 + e);
        u.pm = r0 + loc % ne; u.pn = e * npn + loc / ne; return true;
    }
    __device__ __forceinline__ void a_ready(const Unit&) const {}
    __device__ __forceinline__ void done(const Unit&) const {}
};

struct SegOrder {
    int nM, nN, nseg, G, c;
    __device__ __forceinline__ bool next(int i, Unit& u) const {
        const int nwg = nM * nN; const long L = (long)i * G + c; if (L >= (long)nseg * nwg) return false;
        const int s = (int)(L / nwg); int wgid = (int)(L % nwg); { const int q = nwg / NXCD, r = nwg % NXCD, xcd = wgid % NXCD, off = wgid / NXCD; wgid = (xcd < r ? xcd * (q + 1) : r * (q + 1) + (xcd - r) * q) + off; }
        const int nig = WGM * nN, gid = wgid / nig, fm = gid * WGM, gsz = (nM - fm) < WGM ? (nM - fm) : WGM;
        u.pm = s * nM + fm + ((wgid % nig) % gsz); u.pn = s * nN + (wgid % nig) / gsz; return true;
    }
    __device__ __forceinline__ void a_ready(const Unit&) const {}
    __device__ __forceinline__ void done(const Unit&) const {}
};
template <class Epi, class Sched, bool ALIGN_EPI = false, bool SP2 = false, bool F8 = false>
__device__ __forceinline__ void gemm_phase(PG8_LAS unsigned char* lds, const Gemm g, const Sched& S, const Epi& E) {
    int tid_ = threadIdx.x; asm volatile("" : "+v"(tid_)); const int tid = tid_, wid = __builtin_amdgcn_readfirstlane(tid >> 6), lane = tid & 63, wr = wid >> 2, wc = wid & 3, fr = lane & 15, fq = lane >> 4;
    const int K = g.K, nt = K / BK; typedef int i32x8 __attribute__((ext_vector_type(8))); int f8scale_ = 0x7f7f7f7f; asm volatile("" : "+v"(f8scale_));
    unsigned voffA[2], voffB[2];
#pragma unroll
    for (int i = 0; i < 2; ++i) { int R, C; stage_rc(tid * 16 + i * 8192, R, C); const int Rb = Epi::PERM ? ((R & ~31) + perm32(R & 31)) : R;
        voffA[i] = (unsigned)(R * K + C) * 2u; voffB[i] = (unsigned)(Rb * K + C) * 2u; }
    const size_t kstep = (size_t)(BK * 2);
    const size_t hstep = (size_t)HALF * K * 2;
    const size_t tstep = 2 * hstep;
    const unsigned ldsw = (unsigned)wid * 1024u;
    const int aoff = lds_byte(wr * 64 + fr, fq * 8), boff = lds_byte(wc * 32 + fr, fq * 8);
#define PG8_SA(b, h) (((b) * 2 + (h)) * HTB)
#define PG8_SB(b, h) ((4 + (b) * 2 + (h)) * HTB)
#define PG8_STAGE(bufoff, gbase, voff) do { _Pragma("unroll") for (int _i = 0; _i < 2; ++_i) \
        __builtin_amdgcn_global_load_lds((const unsigned*)((const char*)(gbase) + (voff)[_i]), (PG8_LAS unsigned*)(lds + (bufoff) + ldsw + _i * 8192), 16, 0, 0); } while (0)
#define PG8_LDA(dst, b, h) do { _Pragma("unroll") for (int m = 0; m < 4; ++m) _Pragma("unroll") for (int k = 0; k < 2; ++k) dst[m][k] = *(const PG8_LAS bf16x8*)(lds + PG8_SA(b, h) + aoff + m * 2048 + k * 1024); } while (0)
#define PG8_LDB(dst, b, h) do { _Pragma("unroll") for (int n = 0; n < 2; ++n) _Pragma("unroll") for (int k = 0; k < 2; ++k) dst[n][k] = *(const PG8_LAS bf16x8*)(lds + PG8_SB(b, h) + boff + n * 2048 + k * 1024); } while (0)
#define PG8_MMA(ai, bj, At, Bt) do { __builtin_amdgcn_s_setprio(1); \
        if constexpr (F8) { _Pragma("unroll") for (int m = 0; m < 4; ++m) _Pragma("unroll") for (int n = 0; n < 2; ++n) { \
            const i32x4 b0_ = __builtin_bit_cast(i32x4, Bt[n][0]), b1_ = __builtin_bit_cast(i32x4, Bt[n][1]), a0_ = __builtin_bit_cast(i32x4, At[m][0]), a1_ = __builtin_bit_cast(i32x4, At[m][1]); \
            const i32x8 bb_ = __builtin_shufflevector(b0_, b1_, 0, 1, 2, 3, 4, 5, 6, 7), aa_ = __builtin_shufflevector(a0_, a1_, 0, 1, 2, 3, 4, 5, 6, 7); \
            asm volatile("v_mfma_scale_f32_16x16x128_f8f6f4 %0, %1, %2, %0, %3, %3 op_sel_hi:[0,0,0]" : "+v"(acc[ai][bj][m][n]) : "v"(bb_), "v"(aa_), "v"(f8scale_)); } } \
        else { _Pragma("unroll") for (int m = 0; m < 4; ++m) _Pragma("unroll") for (int n = 0; n < 2; ++n) _Pragma("unroll") for (int k = 0; k < 2; ++k) \
        acc[ai][bj][m][n] = __builtin_amdgcn_mfma_f32_16x16x32_bf16(Bt[n][k], At[m][k], acc[ai][bj][m][n], 0, 0, 0); } __builtin_amdgcn_s_setprio(0); } while (0)
#define PG8_WAIT_V(n) asm volatile("s_waitcnt vmcnt(" #n ")" ::: "memory")
#define PG8_WAIT_L(n) asm volatile("s_waitcnt lgkmcnt(" #n ")" ::: "memory")
#define PG8_BAR __builtin_amdgcn_s_barrier()
#define PG8_SCHED __builtin_amdgcn_sched_barrier(0)
    Unit cur, nxt; int ui = 0;
    if (!S.next(0, cur)) return;
    f32x4 acc[2][2][4][2];
#pragma unroll
    for (int a = 0; a < 2; ++a)
#pragma unroll
        for (int b = 0; b < 2; ++b)
#pragma unroll
            for (int m = 0; m < 4; ++m)
#pragma unroll
                for (int n = 0; n < 2; ++n) acc[a][b][m][n] = (f32x4){0.f, 0.f, 0.f, 0.f};
    bf16x8 At[4][2], B0[2][2], B1[2][2];
    const char* cA = (const char*)g.A + (size_t)cur.pm * tstep; const char* cB = (const char*)g.Bt + (size_t)cur.pn * tstep;
    S.a_ready(cur);
    if constexpr (SP2) {
        PG8_STAGE(PG8_SB(0, 0), cB, voffB); PG8_STAGE(PG8_SB(0, 1), cB + hstep, voffB); PG8_STAGE(PG8_SA(0, 0), cA, voffA); PG8_STAGE(PG8_SA(0, 1), cA + hstep, voffA);
        if (wr == 1) PG8_BAR;
        PG8_WAIT_V(2); PG8_BAR;
        PG8_STAGE(PG8_SB(1, 0), cB + kstep, voffB); PG8_STAGE(PG8_SA(1, 0), cA + kstep, voffA); PG8_STAGE(PG8_SB(1, 1), cB + hstep + kstep, voffB);
        PG8_WAIT_V(6); PG8_BAR;
    } else {
        PG8_STAGE(PG8_SB(0, 0), cB, voffB); PG8_STAGE(PG8_SA(0, 0), cA, voffA); PG8_STAGE(PG8_SB(0, 1), cB + hstep, voffB); PG8_STAGE(PG8_SA(0, 1), cA + hstep, voffA);
        if (wr == 1) PG8_BAR;
        PG8_WAIT_V(4); PG8_BAR;
        PG8_STAGE(PG8_SB(1, 0), cB + kstep, voffB); PG8_STAGE(PG8_SA(1, 0), cA + kstep, voffA); PG8_STAGE(PG8_SB(1, 1), cB + hstep + kstep, voffB);
        PG8_WAIT_V(6); PG8_BAR;
    }
    for (;;) {
        const bool has_next = S.next(ui + 1, nxt);
        const char* nA = has_next ? (const char*)g.A + (size_t)nxt.pm * tstep : cA; const char* nB = has_next ? (const char*)g.Bt + (size_t)nxt.pn * tstep : cB;
        for (int t = 0; t < nt; t += 2) {
            const bool last = (t == nt - 2);
            const char* a1 = cA + (size_t)(t + 1) * kstep;
            const char* a2 = last ? nA : cA + (size_t)(t + 2) * kstep; const char* b2 = last ? nB : cB + (size_t)(t + 2) * kstep;
            const char* a3 = a2 + kstep; const char* b3 = b2 + kstep;
            if (last && has_next) S.a_ready(nxt);
            if constexpr (Epi::HOOK) { if (t == E.hk0 || t == E.hk1) E.hook(acc, cur, t == E.hk0 ? 0 : 1, wr, wc, fr, fq); }
            if constexpr (SP2) {
            PG8_LDB(B0, 0, 0); PG8_LDB(B1, 0, 1); PG8_SCHED; PG8_LDA(At, 0, 0); PG8_STAGE(PG8_SA(1, 1), a1 + hstep, voffA);
            PG8_WAIT_V(8); PG8_WAIT_L(0); PG8_BAR; PG8_MMA(0, 0, At, B0); PG8_MMA(0, 1, At, B1); PG8_BAR; PG8_SCHED;
            PG8_LDA(At, 0, 1); PG8_STAGE(PG8_SB(0, 0), b2, voffB); PG8_STAGE(PG8_SB(0, 1), b2 + hstep, voffB); PG8_STAGE(PG8_SA(0, 0), a2, voffA);
            PG8_WAIT_V(8); PG8_WAIT_L(0); PG8_BAR; PG8_MMA(1, 0, At, B0); PG8_MMA(1, 1, At, B1); PG8_BAR; PG8_SCHED;
            PG8_LDB(B0, 1, 0); PG8_LDB(B1, 1, 1); PG8_SCHED; PG8_LDA(At, 1, 0); PG8_STAGE(PG8_SA(0, 1), a2 + hstep, voffA);
            PG8_WAIT_V(8); PG8_WAIT_L(0); PG8_BAR; PG8_MMA(0, 0, At, B0); PG8_MMA(0, 1, At, B1); PG8_BAR; PG8_SCHED;
            PG8_LDA(At, 1, 1); PG8_STAGE(PG8_SB(1, 0), b3, voffB); PG8_STAGE(PG8_SB(1, 1), b3 + hstep, voffB); PG8_STAGE(PG8_SA(1, 0), a3, voffA);
            PG8_WAIT_V(8); PG8_WAIT_L(0); PG8_BAR; PG8_MMA(1, 0, At, B0); PG8_MMA(1, 1, At, B1); PG8_BAR; PG8_SCHED;
            } else {
            PG8_LDB(B0, 0, 0); PG8_SCHED; PG8_LDA(At, 0, 0); PG8_STAGE(PG8_SA(1, 1), a1 + hstep, voffA);
            PG8_WAIT_L(8); PG8_BAR; PG8_WAIT_L(0); PG8_MMA(0, 0, At, B0); PG8_BAR; PG8_SCHED;
            PG8_LDB(B1, 0, 1); PG8_STAGE(PG8_SB(0, 0), b2, voffB);
            PG8_BAR; PG8_WAIT_L(0); PG8_MMA(0, 1, At, B1); PG8_BAR;
            PG8_LDA(At, 0, 1); PG8_STAGE(PG8_SA(0, 0), a2, voffA);
            PG8_BAR; PG8_WAIT_L(0); PG8_MMA(1, 0, At, B0); PG8_BAR; PG8_SCHED;
            PG8_STAGE(PG8_SB(0, 1), b2 + hstep, voffB);
            PG8_WAIT_V(6); PG8_BAR; PG8_MMA(1, 1, At, B1); PG8_BAR;
            PG8_LDB(B0, 1, 0); PG8_SCHED; PG8_LDA(At, 1, 0); PG8_STAGE(PG8_SA(0, 1), a2 + hstep, voffA);
            PG8_WAIT_L(8); PG8_BAR; PG8_WAIT_L(0); PG8_MMA(0, 0, At, B0); PG8_BAR; PG8_SCHED;
            PG8_LDB(B1, 1, 1); PG8_STAGE(PG8_SB(1, 0), b3, voffB);
            PG8_BAR; PG8_WAIT_L(0); PG8_MMA(0, 1, At, B1); PG8_BAR;
            PG8_LDA(At, 1, 1); PG8_STAGE(PG8_SA(1, 0), a3, voffA);
            PG8_BAR; PG8_WAIT_L(0); PG8_MMA(1, 0, At, B0); PG8_BAR; PG8_SCHED;
            PG8_STAGE(PG8_SB(1, 1), b3 + hstep, voffB);
            PG8_WAIT_V(6); PG8_BAR; PG8_MMA(1, 1, At, B1); PG8_BAR;
            }
        }
        if constexpr (ALIGN_EPI) { if (wr == 0) PG8_BAR; }
        if constexpr (F8) asm volatile("s_nop 15\n\ts_nop 15" ::: "memory");
        if constexpr (!Epi::AFTER_DRAIN) { E(acc, cur, wr, wc, fr, fq); S.done(cur); }
        if (!has_next) break;
#pragma unroll
        for (int a = 0; a < 2; ++a)
#pragma unroll
            for (int b = 0; b < 2; ++b)
#pragma unroll
                for (int m = 0; m < 4; ++m)
#pragma unroll
                    for (int n = 0; n < 2; ++n) acc[a][b][m][n] = (f32x4){0.f, 0.f, 0.f, 0.f};
        cur = nxt; cA = nA; cB = nB; ++ui;
        if constexpr (ALIGN_EPI) { if (wr == 1) PG8_BAR; }
    }
    PG8_WAIT_V(0);
    if constexpr (!ALIGN_EPI) { if (wr == 0) PG8_BAR; }
    PG8_BAR;
    if constexpr (Epi::AFTER_DRAIN) { E.fused(acc, cur, wr, wc, fr, fq, lds, wid, lane); S.done(cur); }
#undef PG8_SA
#undef PG8_SB
#undef PG8_STAGE
#undef PG8_LDA
#undef PG8_LDB
#undef PG8_MMA
#undef PG8_WAIT_V
#undef PG8_WAIT_L
#undef PG8_BAR
#undef PG8_SCHED
}
}
#ifndef MK_ONE_LAUNCH
#define MK_ONE_LAUNCH 0
#endif
constexpr int NWAVES = 8;
constexpr int NB = 4, SEQ = 2048, T = NB * SEQ, D = 2048, MEML = 256, MEMR = NB * MEML;
constexpr int NINP = 17664;
constexpr int DFF = 5632, EFF = 7168, NEXP = 8, MAXSLOT = 18432;
constexpr float EPS = 1e-6f;
constexpr int NPL = 15, NPH = 2 + 2 * NPL;

constexpr size_t MiB = 1u << 20;
constexpr size_t WS_CTL = 0, CTL_BYTES = 1 * MiB;
constexpr size_t WS_WIN = WS_CTL + CTL_BYTES;
constexpr size_t WS_WBR = WS_WIN + 2 * 69 * MiB;
constexpr size_t WS_WOUT = WS_WBR + 2 * 12 * MiB;
constexpr size_t WS_WQ = WS_WOUT + 2 * 8 * MiB;
constexpr size_t WS_WKV = WS_WQ + 2 * 2 * MiB;
constexpr size_t WS_WO = WS_WKV + 2 * 4 * MiB;
constexpr size_t WS_WGU = WS_WO + 2 * 2 * MiB;
constexpr size_t WS_WDN = WS_WGU + 44 * MiB;
constexpr size_t WS_WEGU = WS_WDN + 22 * MiB;
constexpr size_t WS_WEDN = WS_WEGU + 448 * MiB;
constexpr size_t WS_XRES = WS_WEDN + 224 * MiB;
constexpr size_t WS_H = WS_XRES + 64 * MiB;
constexpr size_t WS_RQ = WS_H + 32 * MiB, WS_RK = WS_RQ + 16 * MiB, WS_RV = WS_RK + 16 * MiB, WS_RG = WS_RV + 16 * MiB;
constexpr size_t WS_BQKV = WS_RG + 16 * MiB;
constexpr size_t WS_BZ = WS_BQKV + 48 * MiB;
constexpr size_t WS_BBA = WS_BZ + 16 * MiB;
constexpr size_t WS_CQ = WS_BBA + 1 * MiB, WS_CK = WS_CQ + 16 * MiB, WS_CVT = WS_CK + 16 * MiB;
constexpr size_t WS_GATES = WS_CVT + 16 * MiB;
constexpr size_t WS_GQ = WS_GATES + 96 * MiB, WS_GK = WS_GQ + 16 * MiB, WS_GV = WS_GK + 16 * MiB;
constexpr size_t WS_GG = WS_GV + 16 * MiB, WS_GB = WS_GG + 1 * MiB;
constexpr size_t WS_OA = WS_GB + 1 * MiB, WS_OB = WS_OA + 32 * MiB;
constexpr size_t WS_O12 = WS_OB + 32 * MiB;
constexpr size_t WS_OCAT = WS_O12 + 64 * MiB;
constexpr size_t WS_MERGE = WS_OCAT + 48 * MiB;
constexpr size_t WS_MERGEB = WS_MERGE + 64 * MiB;
constexpr size_t WS_MEMN = WS_MERGEB + 32 * MiB;
constexpr size_t WS_KX = WS_MEMN + 8 * MiB;
constexpr size_t WS_VXT = WS_KX + 2 * MiB;
constexpr size_t WS_QX = WS_VXT + 2 * MiB;
constexpr size_t WS_OX = WS_QX + 8 * MiB;
constexpr size_t WS_ACT = WS_OX + 8 * MiB;
constexpr size_t WS_HG = WS_ACT + 88 * MiB;
constexpr size_t WS_EACT = WS_HG + 72 * MiB;
constexpr size_t WS_Y = WS_EACT + 252 * MiB;
constexpr size_t WS_ROUTE = WS_Y + 144 * MiB;
constexpr size_t WS_GCH = WS_ROUTE + 1 * MiB;
constexpr size_t WS_GL = WS_GCH + 88 * MiB;
constexpr size_t WS_H8 = WS_GL + 1 * MiB;
constexpr size_t WS_WIN8 = WS_H8 + 16 * MiB;
constexpr size_t WS_END = WS_WIN8 + 32 * MiB;
constexpr int CW_CNT = 64;
constexpr int CW_BAR = 4096;

constexpr int RING_BYTES = 131072, MISC_OFF = RING_BYTES + 320, LDS_BYTES = 147456;

#define GAS __attribute__((address_space(1)))
#define LAS __attribute__((address_space(3)))
#define DI __device__ __forceinline__
typedef unsigned short bf16;
typedef unsigned v4u __attribute__((ext_vector_type(4)));
typedef unsigned v2u __attribute__((ext_vector_type(2)));
typedef float f32x4 __attribute__((ext_vector_type(4)));
typedef short bf16x8 __attribute__((ext_vector_type(8)));
typedef short s16x4 __attribute__((ext_vector_type(4)));
DI float bf2f(unsigned v) { return __uint_as_float(v << 16); }
DI unsigned f2bf(float f) { unsigned u = __builtin_bit_cast(unsigned, f); return (u + 0x7fffu + ((u >> 16) & 1u)) >> 16; }
DI unsigned pk2(float lo, float hi) { return f2bf(lo) | (f2bf(hi) << 16); }
DI float wave_sum(float v) {
#pragma unroll
    for (int o = 1; o < 64; o <<= 1) v += __shfl_xor(v, o);
    return v;
}

#define XB_TMO      128
#define XB_XCNT(j)  (256  + 64 * (j))
#define XB_XSUB(j)  (1280 + 64 * (j))
#define XB_XGEN(j)  (2304 + 64 * (j))
#define XB_TOP      3328
#define XB_TOPGEN   3392
#define XCD_BAR_WORDS 3456
#define XB_SPIN_CAP (1u << 18)

__device__ __forceinline__ unsigned xb_ld(unsigned* p)              { return __hip_atomic_load(p, __ATOMIC_RELAXED, __HIP_MEMORY_SCOPE_AGENT); }
__device__ __forceinline__ unsigned xb_add(unsigned* p, unsigned v) { return __hip_atomic_fetch_add(p, v, __ATOMIC_RELAXED, __HIP_MEMORY_SCOPE_AGENT); }
__device__ __forceinline__ unsigned xb_xcc_id() { return (unsigned)__builtin_amdgcn_s_getreg((3 << 11) | 20) & 0xFu; }
#define XB_SPIN(cond, bar) do { unsigned _sp = 0; while (cond) { __builtin_amdgcn_s_sleep(1); \
    if ((++_sp & 255u) == 0u) { if (xb_ld(&(bar)[XB_TMO])) break; if (_sp > XB_SPIN_CAP) { atomicAdd(&(bar)[XB_TMO], 1u); break; } } } } while (0)

struct XcdBarrier {
    unsigned* bar; unsigned x;
    volatile LAS unsigned* st;
};

__device__ __forceinline__ XcdBarrier xcd_barrier_post(unsigned* bar, volatile LAS unsigned* st) {
    XcdBarrier b; b.bar = bar; b.x = xb_xcc_id(); b.st = st;
    if (threadIdx.x == 0) (void)xb_add(&bar[XB_XCNT(b.x)], 1u);
    return b;
}
__device__ __forceinline__ void xcd_barrier_complete(unsigned* bar, unsigned x, unsigned& nloc, unsigned& nx) {
    const unsigned G = gridDim.x * gridDim.y * gridDim.z;
    unsigned sum, cnt, mine, sp = 0u;
    for (;;) {
        sum = 0u; cnt = 0u; mine = 0u;
#pragma unroll
        for (unsigned j = 0; j < 16; ++j) { const unsigned c = xb_ld(&bar[XB_XCNT(j)]); sum += c; cnt += (c > 0u) ? 1u : 0u; mine = (j == x) ? c : mine; }
        if (sum == G) break;
        __builtin_amdgcn_s_sleep(1);
        if ((++sp & 255u) == 0u) { if (xb_ld(&bar[XB_TMO])) break; if (sp > XB_SPIN_CAP) { atomicAdd(&bar[XB_TMO], 1u); break; } }
    }
    nloc = mine > 0u ? mine : 1u; nx = cnt > 0u ? cnt : 1u;
}

__device__ __forceinline__ void xcd_barrier(const XcdBarrier& b) {
    asm volatile("s_waitcnt vmcnt(0)" ::: "memory");
    __syncthreads();
    if (threadIdx.x == 0) {
        unsigned* bar = b.bar;
        __builtin_amdgcn_s_waitcnt(0);
        unsigned nloc = b.st[0], nx = b.st[1];
        if (nloc == 0u) { xcd_barrier_complete(bar, b.x, nloc, nx); b.st[0] = nloc; b.st[1] = nx; }
        const unsigned old = xb_add(&bar[XB_XSUB(b.x)], 1u);
        const unsigned gen = old / nloc;
        if (old + 1u == (gen + 1u) * nloc) {
            __builtin_amdgcn_fence(__ATOMIC_RELEASE, "agent");
            asm volatile("s_waitcnt vmcnt(0)" ::: "memory");
            const unsigned og = xb_add(&bar[XB_TOP], 1u);
            const unsigned tg = og / nx;
            if (og + 1u == (tg + 1u) * nx) xb_add(&bar[XB_TOPGEN], 1u);
            else XB_SPIN(xb_ld(&bar[XB_TOPGEN]) == tg, bar);
            __builtin_amdgcn_fence(__ATOMIC_ACQUIRE, "agent");
            xb_add(&bar[XB_XGEN(b.x)], 1u);
            asm volatile("s_waitcnt vmcnt(0)" ::: "memory");
        } else {
            XB_SPIN(xb_ld(&bar[XB_XGEN(b.x)]) == gen, bar);
            __builtin_amdgcn_fence(__ATOMIC_ACQUIRE, "agent");
            asm volatile("s_waitcnt vmcnt(0)" ::: "memory");
        }
    }
    __syncthreads();
}

struct Args { const void* in[24]; float* out; unsigned char* ws; int ph_lo, ph_hi; };

struct Frame {
    LAS unsigned char* lds;
    int tid, lane, wave, G, vcu, gw, NGW;
};

DI void conv_job(const Frame& F, const float* W, int K, int Nsrc, bf16* WT, int Ndst, int mode, int Fgu) {
    LAS unsigned* scr = (LAS unsigned*)(F.lds + F.wave * 8704);
    const int nkb = K / 64, nnb = Ndst / 64, items = nkb * nnb, lane = F.lane;
    for (int it = F.gw; it < items; it += F.NGW) {
        const int nb = it / nkb, kb = it % nkb, k0 = kb * 64, n0 = nb * 64, n = n0 + lane;
        int ns;
        if (mode == 0) ns = n;
        else if (mode == 1) ns = n < 8192 ? n : (n < 17408 ? n + 16 : (n < 17424 ? n - 17408 + 8192 : -1));
        else { const int pn = n >> 8, half = (n >> 7) & 1, j = n & 127; ns = half * Fgu + 128 * pn + j; }
        const float* src = W + (size_t)k0 * Nsrc + (ns < 0 ? 0 : ns);
#pragma unroll 8
        for (int i = 0; i < 32; ++i) { float a = src[(size_t)(2 * i) * Nsrc], b = src[(size_t)(2 * i + 1) * Nsrc]; if (ns < 0) { a = 0.f; b = 0.f; } scr[lane * 33 + i] = pk2(a, b); }
        asm volatile("s_waitcnt lgkmcnt(0)" ::: "memory");
#pragma unroll
        for (int j = 0; j < 8; ++j) { const int nn = (lane >> 3) + 8 * j, kq = lane & 7; v4u o; const LAS unsigned* s = scr + nn * 33 + 4 * kq; o.x = s[0]; o.y = s[1]; o.z = s[2]; o.w = s[3];
            *(v4u*)(WT + (size_t)(n0 + nn) * K + k0 + 8 * kq) = o; }
        asm volatile("s_waitcnt lgkmcnt(0)" ::: "memory");
    }
}

DI void conv_job_f8(const Frame& F, const float* W, int K, int Nsrc, unsigned char* WT, int Ndst, int mode, int Fgu, float scale) {
    LAS unsigned* scr = (LAS unsigned*)(F.lds + F.wave * 8704);
    const int nkb = K / 128, nnb = Ndst / 64, items = nkb * nnb, lane = F.lane;
    for (int it = F.gw; it < items; it += F.NGW) {
        const int nb = it / nkb, kb = it % nkb, k0 = kb * 128, n0 = nb * 64, n = n0 + lane;
        int ns;
        if (mode == 0) ns = n; else { const int pn = n >> 8, half = (n >> 7) & 1, j = n & 127; ns = half * Fgu + 128 * pn + j; }
        const float* src = W + (size_t)k0 * Nsrc + ns;
#pragma unroll 4
        for (int i = 0; i < 32; ++i) { const float a = src[(size_t)(4 * i) * Nsrc], b = src[(size_t)(4 * i + 1) * Nsrc], c = src[(size_t)(4 * i + 2) * Nsrc], d = src[(size_t)(4 * i + 3) * Nsrc]; scr[lane * 33 + i] = pg8::pk4_fp8(a * scale, b * scale, c * scale, d * scale); }
        asm volatile("s_waitcnt lgkmcnt(0)" ::: "memory");
#pragma unroll
        for (int j = 0; j < 8; ++j) { const int nn = (lane >> 3) + 8 * j, kq = lane & 7; v4u o; const LAS unsigned* s = scr + nn * 33 + 4 * kq; o.x = s[0]; o.y = s[1]; o.z = s[2]; o.w = s[3];
            *(v4u*)(WT + (size_t)(n0 + nn) * K + k0 + 16 * kq) = o; }
        asm volatile("s_waitcnt lgkmcnt(0)" ::: "memory");
    }
}

template <bool F8>
DI void conv_wg(const Frame& F, const float* W, int K, int Nsrc, void* WTv, int Ndst, int mode, int Fgu, float scale) {
    constexpr int KI = F8 ? 256 : 128;
    LAS unsigned* scr = (LAS unsigned*)F.lds;
    const int nkb = K / KI, items = nkb * (Ndst / 256), lane = F.lane, w = F.wave, tid = F.tid;
    for (int it = F.vcu; it < items; it += F.G) {
        const int nb = it / nkb, kb = it % nkb, k0 = kb * KI, n0 = nb * 256, n = n0 + 4 * lane;
        int ns;
        if (mode == 0) ns = n;
        else if (mode == 1 || mode == 3 || mode == 4) {
            int ng = n;
            if (mode == 3) { const int lp = n >> 8; ng = ((lp < 44 ? lp : 68) << 8) + (n & 255); }
            if (mode == 4) ng = n + 44 * 256;
            ns = ng < 8192 ? ng : (ng < 17408 ? ng + 16 : (ng < 17424 ? ng - 17408 + 8192 : -1)); }
        else { const int pn = n >> 8, half = (n >> 7) & 1, j = n & 127; ns = half * Fgu + 128 * pn + j; }
        __syncthreads();
#pragma unroll
        for (int h = 0; h < (F8 ? 2 : 1); ++h) {
            const float* src = W + (size_t)(k0 + (F8 ? 32 : 16) * w + 16 * h) * Nsrc + (ns < 0 ? 0 : ns);
            f32x4 a[16];
#pragma unroll
            for (int i = 0; i < 16; ++i) a[i] = *(const f32x4*)(src + (size_t)i * Nsrc);
            if (ns < 0) {
#pragma unroll
                for (int i = 0; i < 16; ++i) a[i] = (f32x4){0.f, 0.f, 0.f, 0.f}; }
#pragma unroll
            for (int c = 0; c < 4; ++c) {
                if (F8) {
#pragma unroll
                    for (int q = 0; q < 4; ++q) scr[(4 * lane + c) * 65 + 8 * w + 4 * h + q] = pg8::pk4_fp8(a[4 * q][c] * scale, a[4 * q + 1][c] * scale, a[4 * q + 2][c] * scale, a[4 * q + 3][c] * scale);
                } else {
#pragma unroll
                    for (int p = 0; p < 8; ++p) scr[(4 * lane + c) * 65 + 8 * w + p] = pk2(a[2 * p][c], a[2 * p + 1][c]); } }
        }
        __syncthreads();
#pragma unroll
        for (int ps = 0; ps < 8; ++ps) { const int row = ps * 32 + (tid >> 4), kq = tid & 15; const LAS unsigned* s = scr + row * 65 + 4 * kq; v4u o; o.x = s[0]; o.y = s[1]; o.z = s[2]; o.w = s[3];
            *(v4u*)((unsigned char*)WTv + ((size_t)(n0 + row) * K + k0) * (F8 ? 1 : 2) + 16 * kq) = o; }
    }
}

DI void rms_row(const float* xrow, const float* w, bf16* orow, int lane, unsigned char* o8 = nullptr) {
    f32x4 v[8]; float ss = 0.f;
#pragma unroll
    for (int j = 0; j < 8; ++j) { v[j] = *(const f32x4*)(xrow + 4 * (lane + 64 * j)); ss += (v[j][0] * v[j][0] + v[j][1] * v[j][1]) + (v[j][2] * v[j][2] + v[j][3] * v[j][3]); }
    const float rstd = rsqrtf(wave_sum(ss) * (1.f / D) + EPS);
#pragma unroll
    for (int j = 0; j < 8; ++j) { const f32x4 ww = *(const f32x4*)(w + 4 * (lane + 64 * j)); v2u o; o.x = pk2(v[j][0] * rstd * ww[0], v[j][1] * rstd * ww[1]); o.y = pk2(v[j][2] * rstd * ww[2], v[j][3] * rstd * ww[3]);
        *(v2u*)(orow + 4 * (lane + 64 * j)) = o;
        if (o8) *(unsigned*)(o8 + 4 * (lane + 64 * j)) = pg8::pk4_fp8(v[j][0] * rstd * ww[0], v[j][1] * rstd * ww[1], v[j][2] * rstd * ww[2], v[j][3] * rstd * ww[3]); }
}

template <bool GDN>
DI void seq_mixer(const Frame& F, int bh, const bf16* Q, const bf16* K, const bf16* V, const float* Gg, const float* Gb, float* OUT, float gamma) {
    LAS float* qs = (LAS float*)F.lds; LAS float* ks = qs + 32 * 128; LAS float* vs = ks + 32 * 128; LAS float* red = vs + 32 * 128; LAS float* gs = red + 2 * 4 * 128; LAS float* bs = gs + 32;
    const int tid = F.tid, v = tid & 127, kg = tid >> 7, b = bh >> 3, h = bh & 7;
    const size_t hb = (size_t)bh * SEQ * 128;
    float Sr[32];
#pragma unroll
    for (int i = 0; i < 32; ++i) Sr[i] = 0.f;
    for (int c0 = 0; c0 < SEQ; c0 += 32) {
        __syncthreads();
#pragma unroll
        for (int j = 0; j < 4; ++j) { const int idx = tid + 512 * j, tok = idx >> 6, d = (idx & 63) * 2; const size_t go = hb + (size_t)(c0 + tok) * 128 + d;
            const unsigned a = *(const unsigned*)(Q + go), bb = *(const unsigned*)(K + go), cc = *(const unsigned*)(V + go);
            qs[tok * 128 + d] = bf2f(a & 0xffffu); qs[tok * 128 + d + 1] = __uint_as_float(a & 0xffff0000u);
            ks[tok * 128 + d] = bf2f(bb & 0xffffu); ks[tok * 128 + d + 1] = __uint_as_float(bb & 0xffff0000u);
            vs[tok * 128 + d] = bf2f(cc & 0xffffu); vs[tok * 128 + d + 1] = __uint_as_float(cc & 0xffff0000u); }
        if (GDN && tid < 32) { gs[tid] = Gg[(size_t)bh * SEQ + c0 + tid]; bs[tid] = Gb[(size_t)bh * SEQ + c0 + tid]; }
        __syncthreads();
        for (int tt = 0; tt < 32; ++tt) {
            const LAS float* kt = ks + tt * 128 + kg * 32; const LAS float* qt = qs + tt * 128 + kg * 32;
            float po = 0.f;
            if (GDN) {
                const float a = __expf(gs[tt]); float p = 0.f;
#pragma unroll
                for (int i = 0; i < 32; ++i) { Sr[i] *= a; p += Sr[i] * kt[i]; }
                red[kg * 128 + v] = p; __syncthreads();
                const float kv = (red[v] + red[128 + v]) + (red[256 + v] + red[384 + v]);
                const float delta = bs[tt] * (vs[tt * 128 + v] - kv);
#pragma unroll
                for (int i = 0; i < 32; ++i) { Sr[i] += kt[i] * delta; po += Sr[i] * qt[i]; }
                red[512 + kg * 128 + v] = po; __syncthreads();
                if (kg == 0) OUT[((size_t)(b * SEQ + c0 + tt)) * 1024 + h * 128 + v] = (red[512 + v] + red[640 + v]) + (red[768 + v] + red[896 + v]);
            } else {
                const float vv = vs[tt * 128 + v]; LAS float* r = red + (tt & 1) * 512;
#pragma unroll
                for (int i = 0; i < 32; ++i) { Sr[i] = gamma * Sr[i] + kt[i] * vv; po += Sr[i] * qt[i]; }
                r[kg * 128 + v] = po; __syncthreads();
                if (kg == 0) OUT[((size_t)(b * SEQ + c0 + tt)) * 1024 + h * 128 + v] = (r[v] + r[128 + v]) + (r[256 + v] + r[384 + v]);
            }
        }
    }
    __syncthreads();
}

template <int DV, int KT, bool CAUSAL, bool OUT_BF16, bool DECAY>
DI void flash_item(const Frame& F, const bf16* Q, const bf16* Kh, const bf16* VT, int vpitch, int q0, int nkeys, float slope, float* OUTF, bf16* OUTB, int opitch) {
    constexpr int KP = 272, VP = KT * 2 + 16, NKC = KT / 32, NVC = DV * KT / 4096, VCH = KT / 8;
    LAS unsigned char* Kl = F.lds; LAS unsigned char* Vl = F.lds + KT * KP;
    int tid_ = F.tid; asm volatile("" : "+v"(tid_));
    const int tid = tid_, lane = tid & 63, w = F.wave, li = lane & 15, g = lane >> 4;
    const float SC = 0.08838834764831845f, L2E = 1.4426950408889634f;
    bf16x8 qf[4];
#pragma unroll
    for (int ks = 0; ks < 4; ++ks) qf[ks] = *(const bf16x8*)(Q + (size_t)(w * 16 + li) * 128 + ks * 32 + g * 8);
    f32x4 o[DV / 16];
#pragma unroll
    for (int c = 0; c < DV / 16; ++c) o[c] = (f32x4){0.f, 0.f, 0.f, 0.f};
    float m_run = -1e30f, l_run = 0.f;
    const int qpos = q0 + w * 16 + li;
    const int kend = CAUSAL ? (q0 + 128 < nkeys ? q0 + 128 : nkeys) : nkeys;
    v4u kr[NKC], vr[NVC];
#pragma unroll
    for (int i = 0; i < NKC; ++i) { const int c = tid + 512 * i; kr[i] = *(const v4u*)(Kh + (size_t)(c >> 4) * 128 + (c & 15) * 8); }
#pragma unroll
    for (int i = 0; i < NVC; ++i) { const int c = tid + 512 * i; vr[i] = *(const v4u*)(VT + (size_t)(c / VCH) * vpitch + (c % VCH) * 8); }
    for (int j0 = 0; j0 < kend; j0 += KT) {
        __syncthreads();
#pragma unroll
        for (int i = 0; i < NKC; ++i) { const int c = tid + 512 * i; *(LAS v4u*)(Kl + (c >> 4) * KP + (c & 15) * 16) = kr[i]; }
#pragma unroll
        for (int i = 0; i < NVC; ++i) { const int c = tid + 512 * i, cc = c % VCH, j = cc & 3; LAS unsigned char* rp = Vl + (c / VCH) * VP + (cc >> 2) * 64;
            *(LAS v2u*)(rp + (8 * ((2 * j) & 3) + 4 * (j >> 1)) * 2) = (v2u){vr[i].x, vr[i].y}; *(LAS v2u*)(rp + (8 * ((2 * j + 1) & 3) + 4 * (j >> 1)) * 2) = (v2u){vr[i].z, vr[i].w}; }
        __syncthreads();
        if (j0 + KT < kend) {
#pragma unroll
            for (int i = 0; i < NKC; ++i) { const int c = tid + 512 * i; kr[i] = *(const v4u*)(Kh + (size_t)(j0 + KT + (c >> 4)) * 128 + (c & 15) * 8); }
#pragma unroll
            for (int i = 0; i < NVC; ++i) { const int c = tid + 512 * i; vr[i] = *(const v4u*)(VT + (size_t)(c / VCH) * vpitch + j0 + KT + (c % VCH) * 8); }
        }
        f32x4 s[KT / 16];
        {
            bf16x8 ka[2][4];
#pragma unroll
            for (int ks = 0; ks < 4; ++ks) ka[0][ks] = *(const LAS bf16x8*)(Kl + li * KP + (ks * 32 + g * 8) * 2);
#pragma unroll
            for (int t = 0; t < KT / 16; ++t) {
                if (t + 1 < KT / 16) {
#pragma unroll
                    for (int ks = 0; ks < 4; ++ks) ka[(t + 1) & 1][ks] = *(const LAS bf16x8*)(Kl + ((t + 1) * 16 + li) * KP + (ks * 32 + g * 8) * 2); }
                __builtin_amdgcn_sched_barrier(0);
                s[t] = (f32x4){0.f, 0.f, 0.f, 0.f};
#pragma unroll
                for (int ks = 0; ks < 4; ++ks) s[t] = __builtin_amdgcn_mfma_f32_16x16x32_bf16(ka[t & 1][ks], qf[ks], s[t], 0, 0, 0);
                __builtin_amdgcn_sched_barrier(0);
            }
        }
        float alpha = 1.f;
        if (DECAY) {
#pragma unroll
            for (int t = 0; t < KT / 16; ++t)
#pragma unroll
                for (int r = 0; r < 4; ++r) { const int key = j0 + t * 16 + g * 4 + r; const float dcy = exp2f(slope * (float)(qpos - key)); s[t][r] = key > qpos ? 0.f : s[t][r] * dcy; }
        } else {
        float mx = -__builtin_inff();
#pragma unroll
        for (int t = 0; t < KT / 16; ++t)
#pragma unroll
            for (int r = 0; r < 4; ++r) { const int key = j0 + t * 16 + g * 4 + r; float x = s[t][r] * SC - slope * (float)(qpos - key); if (CAUSAL && key > qpos) x = -__builtin_inff(); s[t][r] = x; mx = fmaxf(mx, x); }
        mx = fmaxf(mx, __shfl_xor(mx, 16)); mx = fmaxf(mx, __shfl_xor(mx, 32));
        const float m_new = fmaxf(m_run, mx); alpha = exp2f((m_run - m_new) * L2E); m_run = m_new;
        float ps = 0.f;
#pragma unroll
        for (int t = 0; t < KT / 16; ++t)
#pragma unroll
            for (int r = 0; r < 4; ++r) { const float p = exp2f((s[t][r] - m_new) * L2E); s[t][r] = p; ps += p; }
        ps += __shfl_xor(ps, 16); ps += __shfl_xor(ps, 32);
        l_run = l_run * alpha + ps;
        }
        bf16x8 pf[KT / 32];
#pragma unroll
        for (int s2 = 0; s2 < KT / 32; ++s2) { v4u pw; pw.x = pk2(s[2 * s2][0], s[2 * s2][1]); pw.y = pk2(s[2 * s2][2], s[2 * s2][3]); pw.z = pk2(s[2 * s2 + 1][0], s[2 * s2 + 1][1]); pw.w = pk2(s[2 * s2 + 1][2], s[2 * s2 + 1][3]); pf[s2] = __builtin_bit_cast(bf16x8, pw); }
        float al[4];
#pragma unroll
        for (int r = 0; r < 4; ++r) al[r] = DECAY ? 1.f : __shfl(alpha, g * 4 + r);
        {
            v4u vb[2][KT / 32];
#pragma unroll
            for (int s2 = 0; s2 < KT / 32; ++s2) vb[0][s2] = *(const LAS v4u*)(Vl + li * VP + (s2 * 32 + g * 8) * 2);
#pragma unroll
            for (int c = 0; c < DV / 16; ++c) {
                if (c + 1 < DV / 16) {
#pragma unroll
                    for (int s2 = 0; s2 < KT / 32; ++s2) vb[(c + 1) & 1][s2] = *(const LAS v4u*)(Vl + ((c + 1) * 16 + li) * VP + (s2 * 32 + g * 8) * 2); }
                __builtin_amdgcn_sched_barrier(0);
                if (!DECAY) {
#pragma unroll
                    for (int r = 0; r < 4; ++r) o[c][r] *= al[r]; }
#pragma unroll
                for (int s2 = 0; s2 < KT / 32; ++s2) o[c] = __builtin_amdgcn_mfma_f32_16x16x32_bf16(pf[s2], __builtin_bit_cast(bf16x8, vb[c & 1][s2]), o[c], 0, 0, 0);
                __builtin_amdgcn_sched_barrier(0);
            }
        }
    }
    float il[4];
#pragma unroll
    for (int r = 0; r < 4; ++r) il[r] = DECAY ? 1.f : 1.0f / __shfl(l_run, g * 4 + r);
#pragma unroll
    for (int c = 0; c < DV / 16; ++c)
#pragma unroll
        for (int r = 0; r < 4; ++r) { const unsigned off = (unsigned)((w * 16 + g * 4 + r) * opitch + c * 16 + li); const float v = o[c][r] * il[r];
            if (OUT_BF16) OUTB[off] = (bf16)f2bf(v); else OUTF[off] = v; }
}

constexpr int GDN_CH_BYTES = 16384 + 16384 + 8192 + 16384 + 32768;
DI int perm32pos(int k) { return (k & ~31) | (((k >> 2) & 3) << 3) | (((k >> 4) & 1) << 2) | (k & 3); }
DI void gdn_prep_item(const Frame& F, int l, int bh, int n, const bf16* BQKV, const float* BBA, const float* cw, const float* a_log, const float* dt_bias, unsigned char* CH, float* GLp) {
    LAS unsigned char* Kl = F.lds; LAS unsigned char* Ql = F.lds + 17408; LAS unsigned char* KBT = F.lds + 34816; LAS unsigned char* VBT = F.lds + 53248; LAS unsigned char* KTl = F.lds + 71680;
    LAS float* Am = (LAS float*)(F.lds + 90112); LAS unsigned char* Tl = F.lds + 106752; LAS unsigned char* AQl = F.lds + 115968; LAS float* Gs = (LAS float*)(F.lds + 125184); LAS float* gs = Gs + 64; LAS float* bs = gs + 64;
    LAS float* CWl = Am;
    int tid_ = F.tid; asm volatile("" : "+v"(tid_));
    const int tid = tid_, lane = tid & 63, w = F.wave, li = lane & 15, g = lane >> 4;
    const int b = bh >> 3, h = bh & 7, i = tid >> 3, cg = tid & 7, c0 = cg * 16, s = n * 64 + i, t = b * SEQ + s;
    bf16* Wn = (bf16*)CH; bf16* QD = (bf16*)(CH + 16384); bf16* AQK = (bf16*)(CH + 32768); bf16* KT = (bf16*)(CH + 40960); float* UT = (float*)(CH + 57344);
    __syncthreads();
    for (int e = tid; e < 1536; e += 512) { const int part = e >> 9, j = (e >> 7) & 3, c = e & 127; CWl[e] = cw[j * 3072 + part * 1024 + h * 128 + c]; }
    if (cg == 0) { const float bbv = BBA[(size_t)t * 16 + h], bav = BBA[(size_t)t * 16 + 8 + h] + dt_bias[l * 8 + h]; const float sp = bav > 20.f ? bav : log1pf(__expf(bav)); bs[i] = pg8::fsigm(bbv); gs[i] = -__expf(a_log[l * 8 + h]) * sp; }
    __syncthreads();
    float qv[16], kv[16], vv[16];
#pragma unroll
    for (int part = 0; part < 3; ++part) {
        float a[16];
#pragma unroll
        for (int c = 0; c < 16; ++c) a[c] = 0.f;
#pragma unroll
        for (int j = 0; j < 4; ++j) { if (s - 3 + j >= 0) { const v4u x0 = *(const v4u*)(BQKV + (size_t)(t - 3 + j) * 3072 + part * 1024 + h * 128 + c0), x1 = *(const v4u*)(BQKV + (size_t)(t - 3 + j) * 3072 + part * 1024 + h * 128 + c0 + 8);
                const LAS float* wj = CWl + part * 512 + j * 128 + c0;
#pragma unroll
                for (int c = 0; c < 4; ++c) { a[2 * c] += bf2f(x0[c] & 0xffffu) * wj[2 * c]; a[2 * c + 1] += __uint_as_float(x0[c] & 0xffff0000u) * wj[2 * c + 1]; a[8 + 2 * c] += bf2f(x1[c] & 0xffffu) * wj[8 + 2 * c]; a[9 + 2 * c] += __uint_as_float(x1[c] & 0xffff0000u) * wj[9 + 2 * c]; } } }
#pragma unroll
        for (int c = 0; c < 16; ++c) { const float y = pg8::fsilu(a[c]); if (part == 0) qv[c] = y; else if (part == 1) kv[c] = y; else vv[c] = y; }
    }
    { float sq = 0.f, sk = 0.f;
#pragma unroll
      for (int c = 0; c < 16; ++c) { sq += qv[c] * qv[c]; sk += kv[c] * kv[c]; }
      sq += __shfl_xor(sq, 1); sq += __shfl_xor(sq, 2); sq += __shfl_xor(sq, 4); sk += __shfl_xor(sk, 1); sk += __shfl_xor(sk, 2); sk += __shfl_xor(sk, 4);
      const float qn = rsqrtf(sq + 1e-6f) * 0.08838834764831845f, kn = rsqrtf(sk + 1e-6f);
#pragma unroll
      for (int c = 0; c < 16; ++c) { qv[c] *= qn; kv[c] *= kn; } }
    if (w == 0) { float v = gs[lane];
#pragma unroll
        for (int o = 1; o < 64; o <<= 1) { const float u = __shfl_up(v, o); if (lane >= o) v += u; }
        Gs[lane] = v; }
    __syncthreads();
    {
        const float Gi = Gs[i], Gl = Gs[63], be = bs[i], eg = __expf(Gi), kbs = be * eg, kts = __expf(Gl - Gi);
        v4u pk, pq;
#pragma unroll
        for (int hh = 0; hh < 2; ++hh) {
            pk.x = pk2(kv[8 * hh + 0], kv[8 * hh + 1]); pk.y = pk2(kv[8 * hh + 2], kv[8 * hh + 3]); pk.z = pk2(kv[8 * hh + 4], kv[8 * hh + 5]); pk.w = pk2(kv[8 * hh + 6], kv[8 * hh + 7]);
            pq.x = pk2(qv[8 * hh + 0], qv[8 * hh + 1]); pq.y = pk2(qv[8 * hh + 2], qv[8 * hh + 3]); pq.z = pk2(qv[8 * hh + 4], qv[8 * hh + 5]); pq.w = pk2(qv[8 * hh + 6], qv[8 * hh + 7]);
            *(LAS v4u*)(Kl + i * 272 + (c0 + 8 * hh) * 2) = pk; *(LAS v4u*)(Ql + i * 272 + (c0 + 8 * hh) * 2) = pq; }
        const int ip = perm32pos(i);
#pragma unroll
        for (int c = 0; c < 16; ++c) { *(LAS bf16*)(KBT + (c0 + c) * 144 + i * 2) = (bf16)f2bf(kv[c] * kbs); *(LAS bf16*)(VBT + (c0 + c) * 144 + i * 2) = (bf16)f2bf(vv[c] * be); *(LAS bf16*)(KTl + (c0 + c) * 144 + ip * 2) = (bf16)f2bf(kv[c] * kts); }
#pragma unroll
        for (int gp = 0; gp < 4; ++gp) { v2u o; o.x = pk2(qv[4 * gp] * eg, qv[4 * gp + 1] * eg); o.y = pk2(qv[4 * gp + 2] * eg, qv[4 * gp + 3] * eg); *(v2u*)(QD + i * 128 + 32 * (cg >> 1) + 8 * gp + 4 * (cg & 1)) = o; }
        if (tid == 0) *GLp = __expf(Gl);
    }
    __syncthreads();
    {
        const int kind = w >> 2, rb = w & 3; LAS unsigned char* Al = kind ? Ql : Kl;
        bf16x8 af[4];
#pragma unroll
        for (int ks = 0; ks < 4; ++ks) af[ks] = *(const LAS bf16x8*)(Al + (rb * 16 + li) * 272 + (ks * 32 + g * 8) * 2);
#pragma unroll
        for (int cb = 0; cb < 4; ++cb) {
            f32x4 acc = (f32x4){0.f, 0.f, 0.f, 0.f};
            if (cb <= rb) {
#pragma unroll
                for (int ks = 0; ks < 4; ++ks) { const bf16x8 bfr = *(const LAS bf16x8*)(Kl + (cb * 16 + li) * 272 + (ks * 32 + g * 8) * 2); acc = __builtin_amdgcn_mfma_f32_16x16x32_bf16(af[ks], bfr, acc, 0, 0, 0); } }
            const int j = cb * 16 + li; const float Gj = Gs[j];
#pragma unroll
            for (int r = 0; r < 4; ++r) { const int ii = rb * 16 + 4 * g + r; const float Lij = __expf(Gs[ii] - Gj);
                if (kind == 0) Am[ii * 65 + j] = ii > j ? acc[r] * Lij * bs[ii] : 0.f;
                else *(LAS bf16*)(AQl + ii * 144 + perm32pos(j) * 2) = (bf16)f2bf(ii >= j ? acc[r] * Lij : 0.f); }
        }
    }
    __syncthreads();
    if (w == 0) {
        int zv = 0; asm volatile("" : "+v"(zv)); const LAS float* Amv = Am + zv;
        float Tr[64];
#pragma unroll
        for (int ii = 0; ii < 64; ++ii) {
            float a0 = (ii == lane) ? 1.f : 0.f, a1 = 0.f;
#pragma unroll
            for (int j = 0; j < ii; ++j) { if (j & 1) a1 -= Amv[ii * 65 + j] * Tr[j]; else a0 -= Amv[ii * 65 + j] * Tr[j]; }
            Tr[ii] = a0 + a1;
            *(LAS bf16*)(Tl + ii * 144 + lane * 2) = (bf16)f2bf(Tr[ii]);
            asm volatile("" ::: "memory");
        }
    }
    __syncthreads();
    {
        const int kind = w >> 2; LAS unsigned char* Xl = kind ? VBT : KBT;
#pragma unroll
        for (int q2 = 0; q2 < 2; ++q2) { const int rbk = 2 * (w & 3) + q2;
            bf16x8 af[2];
#pragma unroll
            for (int ks = 0; ks < 2; ++ks) af[ks] = *(const LAS bf16x8*)(Xl + (rbk * 16 + li) * 144 + (ks * 32 + g * 8) * 2);
#pragma unroll
            for (int cb = 0; cb < 4; ++cb) { f32x4 acc = (f32x4){0.f, 0.f, 0.f, 0.f};
#pragma unroll
                for (int ks = 0; ks < 2; ++ks) { const bf16x8 bfr = *(const LAS bf16x8*)(Tl + (cb * 16 + li) * 144 + (ks * 32 + g * 8) * 2); acc = __builtin_amdgcn_mfma_f32_16x16x32_bf16(af[ks], bfr, acc, 0, 0, 0); }
                const int ii = cb * 16 + li;
                if (kind == 0) { v2u o; o.x = pk2(-acc[0], -acc[1]); o.y = pk2(-acc[2], -acc[3]); *(v2u*)(Wn + ii * 128 + 32 * (rbk >> 1) + 8 * g + 4 * (rbk & 1)) = o; }
                else {
#pragma unroll
                    for (int r = 0; r < 4; ++r) UT[(rbk * 16 + 4 * g + r) * 64 + ii] = acc[r]; } }
        }
    }
#pragma unroll
    for (int q2 = 0; q2 < 2; ++q2) { const int c = tid + 512 * q2, row = c >> 3, cc = c & 7; *(v4u*)(KT + row * 64 + cc * 8) = *(const LAS v4u*)(KTl + row * 144 + cc * 16); }
    { const int row = tid >> 3, cc = tid & 7; *(v4u*)(AQK + row * 64 + cc * 8) = *(const LAS v4u*)(AQl + row * 144 + cc * 16); }
}

DI void gdn_scan(const Frame& F, int bh, const unsigned char* CHB, const float* GLB, float* OB) {
    constexpr int BUFB = 62464, O_QD = 17408, O_AQ = 34816, O_KT = 44032;
    int tid_ = F.tid; asm volatile("" : "+v"(tid_));
    const int tid = tid_, lane = tid & 63, w = F.wave, li = lane & 15, g = lane >> 4, b = bh >> 3, h = bh & 7;
    f32x4 S[8];
#pragma unroll
    for (int kb = 0; kb < 8; ++kb) S[kb] = (f32x4){0.f, 0.f, 0.f, 0.f};
    int ldso[7];
#pragma unroll
    for (int q = 0; q < 7; ++q) { const int c = tid + 512 * q;
        if (q < 2) ldso[q] = (c >> 4) * 272 + (c & 15) * 16; else if (q < 4) ldso[q] = O_QD + ((c - 1024) >> 4) * 272 + (c & 15) * 16;
        else if (q == 4) ldso[q] = O_AQ + ((c - 2048) >> 3) * 144 + (c & 7) * 16; else ldso[q] = O_KT + ((c - 2560) >> 3) * 144 + (c & 7) * 16; }
    const unsigned char* CH0 = CHB + (size_t)(bh * 32) * GDN_CH_BYTES;
    v4u st[7]; f32x4 utc[4], utn[4]; float glc, gln;
    __syncthreads();
#pragma unroll
    for (int q = 0; q < 7; ++q) st[q] = *(const v4u*)(CH0 + (size_t)(tid + 512 * q) * 16);
#pragma unroll
    for (int jb = 0; jb < 4; ++jb) utc[jb] = *(const f32x4*)((const float*)(CH0 + 57344) + (16 * w + li) * 64 + jb * 16 + 4 * g);
    glc = GLB[bh * 32];
#pragma unroll
    for (int q = 0; q < 7; ++q) *(LAS v4u*)(F.lds + ldso[q]) = st[q];
    __syncthreads();
    for (int n = 0; n < 32; ++n) {
        const LAS unsigned char* Lb = F.lds + (n & 1) * BUFB;
        if (n + 1 < 32) { const unsigned char* CH = CH0 + (size_t)(n + 1) * GDN_CH_BYTES;
#pragma unroll
            for (int q = 0; q < 7; ++q) st[q] = *(const v4u*)(CH + (size_t)(tid + 512 * q) * 16);
#pragma unroll
            for (int jb = 0; jb < 4; ++jb) utn[jb] = *(const f32x4*)((const float*)(CH + 57344) + (16 * w + li) * 64 + jb * 16 + 4 * g);
            gln = GLB[bh * 32 + n + 1]; }
        bf16x8 sf[4];
#pragma unroll
        for (int ks = 0; ks < 4; ++ks) { v4u p; p.x = pk2(S[2 * ks][0], S[2 * ks][1]); p.y = pk2(S[2 * ks][2], S[2 * ks][3]); p.z = pk2(S[2 * ks + 1][0], S[2 * ks + 1][1]); p.w = pk2(S[2 * ks + 1][2], S[2 * ks + 1][3]); sf[ks] = __builtin_bit_cast(bf16x8, p); }
        f32x4 vn[4];
#pragma unroll
        for (int jb = 0; jb < 4; ++jb) { vn[jb] = utc[jb];
#pragma unroll
            for (int ks = 0; ks < 4; ++ks) { const bf16x8 a = *(const LAS bf16x8*)(Lb + (jb * 16 + li) * 272 + (ks * 32 + g * 8) * 2); vn[jb] = __builtin_amdgcn_mfma_f32_16x16x32_bf16(a, sf[ks], vn[jb], 0, 0, 0); } }
        bf16x8 vf[2];
#pragma unroll
        for (int js = 0; js < 2; ++js) { v4u p; p.x = pk2(vn[2 * js][0], vn[2 * js][1]); p.y = pk2(vn[2 * js][2], vn[2 * js][3]); p.z = pk2(vn[2 * js + 1][0], vn[2 * js + 1][1]); p.w = pk2(vn[2 * js + 1][2], vn[2 * js + 1][3]); vf[js] = __builtin_bit_cast(bf16x8, p); }
#pragma unroll
        for (int ib = 0; ib < 4; ++ib) { f32x4 z = (f32x4){0.f, 0.f, 0.f, 0.f};
#pragma unroll
            for (int ks = 0; ks < 4; ++ks) { const bf16x8 bq = *(const LAS bf16x8*)(Lb + O_QD + (ib * 16 + li) * 272 + (ks * 32 + g * 8) * 2); z = __builtin_amdgcn_mfma_f32_16x16x32_bf16(sf[ks], bq, z, 0, 0, 0); }
#pragma unroll
            for (int js = 0; js < 2; ++js) { const bf16x8 ba = *(const LAS bf16x8*)(Lb + O_AQ + (ib * 16 + li) * 144 + (js * 32 + g * 8) * 2); z = __builtin_amdgcn_mfma_f32_16x16x32_bf16(vf[js], ba, z, 0, 0, 0); }
            *(f32x4*)(OB + ((size_t)(b * SEQ + n * 64 + ib * 16 + li)) * 1024 + h * 128 + 16 * w + 4 * g) = z; }
#pragma unroll
        for (int kb = 0; kb < 8; ++kb) { S[kb] = S[kb] * glc;
#pragma unroll
            for (int js = 0; js < 2; ++js) { const bf16x8 a = *(const LAS bf16x8*)(Lb + O_KT + (kb * 16 + li) * 144 + (js * 32 + g * 8) * 2); S[kb] = __builtin_amdgcn_mfma_f32_16x16x32_bf16(a, vf[js], S[kb], 0, 0, 0); } }
        if (n + 1 < 32) {
            LAS unsigned char* Ln = F.lds + ((n + 1) & 1) * BUFB;
#pragma unroll
            for (int q = 0; q < 7; ++q) *(LAS v4u*)(Ln + ldso[q]) = st[q];
#pragma unroll
            for (int jb = 0; jb < 4; ++jb) utc[jb] = utn[jb];
            glc = gln; }
        __syncthreads();
    }
}

#define x_in ((const float*)args.in[0])
#define mem ((const float*)args.in[1])
#define w_in ((const float*)args.in[2])
#define conv_w ((const float*)args.in[3])
#define a_log ((const float*)args.in[4])
#define dt_bias ((const float*)args.in[5])
#define gdn_norm_w ((const float*)args.in[6])
#define diff_lambda ((const float*)args.in[7])
#define diff_norm_w ((const float*)args.in[8])
#define w_branch ((const float*)args.in[9])
#define w_out ((const float*)args.in[10])
#define mix_norm_w ((const float*)args.in[11])
#define mem_norm_w ((const float*)args.in[12])
#define cross_norm_w ((const float*)args.in[13])
#define cross_w_q ((const float*)args.in[14])
#define cross_w_kv ((const float*)args.in[15])
#define cross_w_o ((const float*)args.in[16])
#define ffn_norm_w ((const float*)args.in[17])
#define dense_w_gu ((const float*)args.in[18])
#define dense_w_down ((const float*)args.in[19])
#define router_w ((const float*)args.in[20])
#define expert_w_gu ((const float*)args.in[21])
#define expert_w_down ((const float*)args.in[22])
#define final_norm_w ((const float*)args.in[23])
#define WIN ((bf16*)(ws + WS_WIN))
#define WBR ((bf16*)(ws + WS_WBR))
#define WOUT ((bf16*)(ws + WS_WOUT))
#define WQ ((bf16*)(ws + WS_WQ))
#define WKV ((bf16*)(ws + WS_WKV))
#define WO ((bf16*)(ws + WS_WO))
#define WGU ((bf16*)(ws + WS_WGU))
#define WDN ((bf16*)(ws + WS_WDN))
#define WEGU ((bf16*)(ws + WS_WEGU))
#define WEDN ((bf16*)(ws + WS_WEDN))
#define XRES ((float*)(ws + WS_XRES))
#define H ((bf16*)(ws + WS_H))
#define RQ ((bf16*)(ws + WS_RQ))
#define RK ((bf16*)(ws + WS_RK))
#define RVT ((bf16*)(ws + WS_RV))
#define RG ((bf16*)(ws + WS_RG))
#define BQKV ((bf16*)(ws + WS_BQKV))
#define BZ ((bf16*)(ws + WS_BZ))
#define BBA ((float*)(ws + WS_BBA))
#define CQ ((bf16*)(ws + WS_CQ))
#define CK ((bf16*)(ws + WS_CK))
#define CVT ((bf16*)(ws + WS_CVT))
#define GATES ((bf16*)(ws + WS_GATES))
#define GQ ((bf16*)(ws + WS_GQ))
#define GK ((bf16*)(ws + WS_GK))
#define GV ((bf16*)(ws + WS_GV))
#define GG ((float*)(ws + WS_GG))
#define GB ((float*)(ws + WS_GB))
#define OA ((float*)(ws + WS_OA))
#define OB ((float*)(ws + WS_OB))
#define O12 ((float*)(ws + WS_O12))
#define OCAT ((bf16*)(ws + WS_OCAT))
#define MERGE ((float*)(ws + WS_MERGE))
#define MERGEB ((bf16*)(ws + WS_MERGEB))
#define MEMN ((bf16*)(ws + WS_MEMN))
#define KX ((bf16*)(ws + WS_KX))
#define VXT ((bf16*)(ws + WS_VXT))
#define QX ((bf16*)(ws + WS_QX))
#define OX ((bf16*)(ws + WS_OX))
#define ACT ((bf16*)(ws + WS_ACT))
#define HG ((bf16*)(ws + WS_HG))
#define EACT ((bf16*)(ws + WS_EACT))
#define Y ((float*)(ws + WS_Y))
#define ROUTE ((int*)(ws + WS_ROUTE))
#define H8 ((unsigned char*)(ws + WS_H8))
#define WIN8 ((unsigned char*)(ws + WS_WIN8))
__global__ void __launch_bounds__(NWAVES * 64, 2) mk_fwd(Args args) {
    extern __shared__ __attribute__((aligned(16))) unsigned char lds_raw[];
    Frame F;
    F.lds = (LAS unsigned char*)lds_raw;
    F.tid = threadIdx.x; F.lane = F.tid & 63; F.wave = __builtin_amdgcn_readfirstlane(F.tid >> 6);
    F.G = gridDim.x; { const int bx = blockIdx.x; F.vcu = (F.G % 8 == 0) ? (bx % 8) * (F.G / 8) + bx / 8 : bx; }
    F.gw = F.vcu * NWAVES + F.wave; F.NGW = F.G * NWAVES;
    volatile LAS unsigned* MISC = (volatile LAS unsigned*)(F.lds + MISC_OFF);
    LAS int* MTAB = (LAS int*)(F.lds + MISC_OFF + 128);
    unsigned char* ws = args.ws;
    unsigned* ctl = (unsigned*)(ws + WS_CTL);
    for (int u = F.tid; u < (LDS_BYTES - RING_BYTES) / 4; u += NWAVES * 64) ((LAS unsigned*)(F.lds + RING_BYTES))[u] = 0u;
    __syncthreads();
#if MK_ONE_LAUNCH
    XcdBarrier bar = xcd_barrier_post(ctl + CW_BAR, MISC + 8);
#define GRID_BAR() xcd_barrier(bar)
#else
#define GRID_BAR() do {} while (0)
#endif
    const int lo = args.ph_lo, hi = args.ph_hi;
#ifndef PROBE_PH
#define PROBE_PH -1
#endif
#define IN(k) (lo <= (k) && ((k) < hi) && (hi <= 100 || (k) == lo))
#define REP(k) for (int rep_ = 0; rep_ < ((k) == PROBE_PH ? 2 : 1); ++rep_)
#define SEAM(k) do { if (IN(k) && IN((k) + 1)) GRID_BAR(); } while (0)

    if (IN(0)) REP(0) {
        for (int l = 0; l < 2; ++l) {
            conv_wg<false>(F, w_in + (size_t)l * D * 17424, D, 17424, WIN + (size_t)l * NINP * D, 45 * 256, 3, 0, 1.f);
            conv_wg<true>(F, w_in + (size_t)l * D * 17424, D, 17424, WIN8 + (size_t)l * 32 * 256 * D, 24 * 256, 4, 0, 256.f);
            conv_wg<false>(F, w_branch + (size_t)l * 3072 * D, 3072, D, WBR + (size_t)l * D * 3072, D, 0, 0, 1.f);
            conv_wg<false>(F, w_out + (size_t)l * D * D, D, D, WOUT + (size_t)l * D * D, D, 0, 0, 1.f);
            conv_wg<false>(F, cross_w_q + (size_t)l * D * 512, D, 512, WQ + (size_t)l * 512 * D, 512, 0, 0, 1.f);
            conv_wg<false>(F, cross_w_kv + (size_t)l * D * 1024, D, 1024, WKV + (size_t)l * 1024 * D, 1024, 0, 0, 1.f);
            conv_wg<false>(F, cross_w_o + (size_t)l * 512 * D, 512, D, WO + (size_t)l * D * 512, D, 0, 0, 1.f);
        }
        conv_wg<false>(F, dense_w_gu, D, 2 * DFF, WGU, 2 * DFF, 2, DFF, 1.f);
        conv_wg<false>(F, dense_w_down, DFF, D, WDN, D, 0, 0, 1.f);
        for (int e = 0; e < NEXP; ++e) {
            conv_wg<true>(F, expert_w_gu + (size_t)e * D * 2 * EFF, D, 2 * EFF, (unsigned char*)WEGU + (size_t)e * 2 * EFF * D, 2 * EFF, 2, EFF, 256.f);
            conv_wg<true>(F, expert_w_down + (size_t)e * EFF * D, EFF, D, (unsigned char*)WEDN + (size_t)e * D * EFF, D, 0, 0, 256.f);
        }
        for (int r = F.gw; r < T; r += F.NGW) rms_row(x_in + (size_t)r * D, mix_norm_w, H + (size_t)r * D, F.lane, H8 + (size_t)r * D);
        for (int r = F.gw; r < 2 * MEMR; r += F.NGW) { const int l = r / MEMR, rr = r % MEMR; rms_row(mem + (size_t)rr * D, mem_norm_w + l * D, MEMN + (size_t)r * D, F.lane); }
    }
    SEAM(0);
    if (IN(1)) REP(1) {
        for (int l = 0; l < 2; ++l) {
            pg8::Gemm g{MEMN + (size_t)l * MEMR * D, WKV + (size_t)l * 1024 * D, MEMR, 1024, D}; pg8::StaticOrder S; S.init(MEMR, 1024, F.G, (int)((blockIdx.x + F.G - 16 * l) % F.G));
            pg8::EpiHeads E{KX + (size_t)l * NB * 4 * MEML * 128, VXT + (size_t)l * NB * 4 * 128 * MEML, 4, 8, 2};
            pg8::gemm_phase<pg8::EpiHeads, pg8::StaticOrder, true, true>(F.lds, g, S, E);
        }
    }
    SEAM(1);

    { constexpr int l = 0;
        const int pb = 2 + l * NPL;
        const float lambda_init = l == 0 ? 0.2f : 0.35550906f;
        const float* xin = l == 0 ? x_in : XRES;
        if (IN(pb + 0)) REP(pb + 0) {
            { pg8::Gemm g{H, WIN + (size_t)l * NINP * D, T, 45 * 256, D}; pg8::StaticOrder S; S.init(T, 45 * 256, F.G, (int)blockIdx.x);
              pg8::EpiIn E{RQ, RK, RVT, RG, BQKV, BZ, CQ, CK, CVT, GATES, BBA, 0, 1.f};
              pg8::gemm_phase<pg8::EpiIn, pg8::StaticOrder, true, true>(F.lds, g, S, E); }
            { pg8::Gemm g{(const bf16*)H8, (const bf16*)(WIN8 + (size_t)l * 32 * 256 * D), T, 24 * 256, D / 2}; pg8::StaticOrder S; S.init(T, 24 * 256, F.G, (int)blockIdx.x);
              pg8::EpiIn E{RQ, RK, RVT, RG, BQKV, BZ, CQ, CK, CVT, GATES, BBA, 1, 1.0f / 256.f};
              pg8::gemm_phase<pg8::EpiIn, pg8::StaticOrder, true, true, true>(F.lds, g, S, E); }
        }
        SEAM(pb + 0);
        if (IN(pb + 1)) REP(pb + 1) {
            const float* cw = conv_w + (size_t)l * 4 * 3072;
            for (int it = F.vcu; it < 1024; it += F.G) gdn_prep_item(F, l, it >> 5, it & 31, BQKV, BBA, cw, a_log, dt_bias, ws + WS_GCH + (size_t)it * GDN_CH_BYTES, (float*)(ws + WS_GL) + it);
        }
        SEAM(pb + 1);
        if (IN(pb + 2)) REP(pb + 2) {
            const int bx = F.vcu;
            const int mixsel = (l == 0 && args.ph_hi > 100) ? (args.ph_hi - 100) : 3, qw = (l == 0 && args.ph_hi > 100) ? 104 : 100 + l;
            if (bx < 32 && (mixsel & 1)) gdn_scan(F, bx, ws + WS_GCH, (const float*)(ws + WS_GL), OB);
            if (mixsel & 2) {
                volatile LAS int* qslot = (volatile LAS int*)(F.lds + MISC_OFF + 256);
                int nxt = 0; if (F.tid == 0) nxt = (int)atomicAdd(ctl + qw, 1u);
                for (;;) {
                    __syncthreads(); if (F.tid == 0) qslot[0] = nxt; __syncthreads();
                    const int it = __builtin_amdgcn_readfirstlane(qslot[0]); if (it >= 1024) break;
                    if (F.tid == 0) nxt = (int)atomicAdd(ctl + qw, 1u);
                    const int qt = 15 - (it >> 6), kind = (it >> 5) & 1, hd = it & 31, b = hd >> 3, hm = hd & 7;
                    if (kind == 0) { const int hh = hm >> 1, m = hm & 1; const float slope = exp2f(-2.0f * (float)(hh + 1));
                        flash_item<256, 128, true, false, false>(F, CQ + ((size_t)hd * SEQ + qt * 128) * 128, CK + (size_t)hd * SEQ * 128, CVT + (size_t)(b * 4 + hh) * 256 * SEQ, SEQ, qt * 128, SEQ, slope,
                                                            O12 + ((size_t)m * T + b * SEQ + qt * 128) * 1024 + hh * 256, nullptr, 1024); }
                    else { const float lg = log2f(1.0f - exp2f(-5.0f - (float)hm));
                        flash_item<128, 128, true, false, true>(F, RQ + ((size_t)hd * SEQ + qt * 128) * 128, RK + (size_t)hd * SEQ * 128, RVT + (size_t)hd * 128 * SEQ, SEQ, qt * 128, SEQ, lg,
                                                           OA + ((size_t)(b * SEQ + qt * 128)) * 1024 + hm * 128, nullptr, 1024); }
                }
            }
        }
        SEAM(pb + 2);
        if (IN(pb + 3)) REP(pb + 3) {
            const int lane = F.lane;
            const float* lv = diff_lambda + (size_t)l * 512;
            const float d01 = wave_sum(lv[lane] * lv[128 + lane] + lv[64 + lane] * lv[192 + lane]), d23 = wave_sum(lv[256 + lane] * lv[384 + lane] + lv[320 + lane] * lv[448 + lane]);
            const float lam = __expf(d01) - __expf(d23) + lambda_init;
            for (int t = F.gw; t < T; t += F.NGW) {
#pragma unroll
                for (int h = 0; h < 8; ++h) { const size_t o = (size_t)t * 1024 + h * 128 + 2 * lane;
                    { const float a0 = OA[o], a1 = OA[o + 1]; const float mean = wave_sum(a0 + a1) * (1.f / 128.f); const float c0 = a0 - mean, c1 = a1 - mean; const float rstd = rsqrtf(wave_sum(c0 * c0 + c1 * c1) * (1.f / 128.f) + EPS);
                      const unsigned gv = *(const unsigned*)(RG + o); *(unsigned*)(OCAT + (size_t)t * 3072 + h * 128 + 2 * lane) = pk2(c0 * rstd * bf2f(gv & 0xffffu), c1 * rstd * __uint_as_float(gv & 0xffff0000u)); }
                    { const float a0 = OB[o], a1 = OB[o + 1]; const float rstd = rsqrtf(wave_sum(a0 * a0 + a1 * a1) * (1.f / 128.f) + EPS); const unsigned gv = *(const unsigned*)(BZ + o);
                      *(unsigned*)(OCAT + (size_t)t * 3072 + 1024 + h * 128 + 2 * lane) = pk2(a0 * rstd * gdn_norm_w[l * 128 + 2 * lane] * bf2f(gv & 0xffffu), a1 * rstd * gdn_norm_w[l * 128 + 2 * lane + 1] * __uint_as_float(gv & 0xffff0000u)); } }
#pragma unroll
                for (int h = 0; h < 4; ++h) { const size_t o = (size_t)t * 1024 + h * 256 + 4 * lane; const f32x4 p = *(const f32x4*)(O12 + o), q = *(const f32x4*)(O12 + (size_t)T * 1024 + o); const f32x4 d = p - q * lam;
                    const float rstd = rsqrtf(wave_sum((d[0] * d[0] + d[1] * d[1]) + (d[2] * d[2] + d[3] * d[3])) * (1.f / 256.f) + EPS) * (1.0f - lambda_init); const f32x4 ww = *(const f32x4*)(diff_norm_w + l * 256 + 4 * lane);
                    v2u ov; ov.x = pk2(d[0] * rstd * ww[0], d[1] * rstd * ww[1]); ov.y = pk2(d[2] * rstd * ww[2], d[3] * rstd * ww[3]); *(v2u*)(OCAT + (size_t)t * 3072 + 2048 + h * 256 + 4 * lane) = ov; }
            }
        }
        SEAM(pb + 3);
        if (IN(pb + 4)) REP(pb + 4) {
            pg8::Gemm g{OCAT, WBR + (size_t)l * D * 3072, T, D, 3072}; pg8::StaticOrder S; S.init(T, D, F.G, (int)blockIdx.x);
            pg8::EpiBranch E{MERGEB, GATES, 16, 32};
            pg8::gemm_phase<pg8::EpiBranch, pg8::StaticOrder, true, true>(F.lds, g, S, E);
        }
        SEAM(pb + 4);
        if (IN(pb + 5)) REP(pb + 5) {
            pg8::Gemm g{MERGEB, WOUT + (size_t)l * D * D, T, D, D}; pg8::StaticOrder S; S.init(T, D, F.G, (int)blockIdx.x);
            pg8::EpiResid E{xin, XRES, D, 1.f};
            pg8::gemm_phase<pg8::EpiResid, pg8::StaticOrder, true, true>(F.lds, g, S, E);
        }
        SEAM(pb + 5);
        if (IN(pb + 6)) REP(pb + 6) { for (int r = F.gw; r < T; r += F.NGW) rms_row(XRES + (size_t)r * D, cross_norm_w + l * D, H + (size_t)r * D, F.lane); }
        SEAM(pb + 6);
        if (IN(pb + 7)) REP(pb + 7) {
            pg8::Gemm g{H, WQ + (size_t)l * 512 * D, T, 512, D}; pg8::StaticOrder S; S.init(T, 512, F.G, (int)blockIdx.x);
            pg8::EpiHeads E{QX, nullptr, 4, 11, 1 << 20};
            pg8::gemm_phase<pg8::EpiHeads, pg8::StaticOrder, true, true>(F.lds, g, S, E);
        }
        SEAM(pb + 7);
        if (IN(pb + 8)) REP(pb + 8) {
            for (int it = F.vcu; it < 256; it += F.G) { const int hd = it >> 4, qt = it & 15, b = hd >> 2, hh = hd & 3;
                flash_item<128, 128, false, true, false>(F, QX + ((size_t)hd * SEQ + qt * 128) * 128, KX + ((size_t)l * 16 + hd) * MEML * 128, VXT + ((size_t)l * 16 + hd) * 128 * MEML, MEML, qt * 128, MEML, 0.f,
                                             nullptr, OX + ((size_t)(b * SEQ + qt * 128)) * 512 + hh * 128, 512); }
        }
        SEAM(pb + 8);
        if (IN(pb + 9)) REP(pb + 9) {
            pg8::Gemm g{OX, WO + (size_t)l * D * 512, T, D, 512}; pg8::StaticOrder S; S.init(T, D, F.G, (int)blockIdx.x);
            pg8::EpiResid E{XRES, XRES, D, 1.f};
            pg8::gemm_phase<pg8::EpiResid, pg8::StaticOrder, true, true>(F.lds, g, S, E);
        }
        SEAM(pb + 9);
        if (IN(pb + 10)) REP(pb + 10) {
            const int lane = F.lane; const float* w = ffn_norm_w + l * D;
            for (int r = F.gw; r < T; r += F.NGW) {
                const float* xrow = XRES + (size_t)r * D; f32x4 v[8]; float ss = 0.f;
#pragma unroll
                for (int j = 0; j < 8; ++j) { v[j] = *(const f32x4*)(xrow + 4 * (lane + 64 * j)); ss += (v[j][0] * v[j][0] + v[j][1] * v[j][1]) + (v[j][2] * v[j][2] + v[j][3] * v[j][3]); }
                const float rstd = rsqrtf(wave_sum(ss) * (1.f / D) + EPS);
                float lg[8];
#pragma unroll
                for (int e = 0; e < 8; ++e) lg[e] = 0.f;
#pragma unroll
                for (int j = 0; j < 8; ++j) { const f32x4 ww = *(const f32x4*)(w + 4 * (lane + 64 * j)); f32x4 y; y[0] = v[j][0] * rstd * ww[0]; y[1] = v[j][1] * rstd * ww[1]; y[2] = v[j][2] * rstd * ww[2]; y[3] = v[j][3] * rstd * ww[3];
                    if (l == 0) { v2u o; o.x = pk2(y[0], y[1]); o.y = pk2(y[2], y[3]); *(v2u*)(H + (size_t)r * D + 4 * (lane + 64 * j)) = o; }
                    else *(unsigned*)(H8 + (size_t)r * D + 4 * (lane + 64 * j)) = pg8::pk4_fp8(y[0], y[1], y[2], y[3]);
                    if (l == 1) {
#pragma unroll
                        for (int c = 0; c < 4; ++c) { const float* rw = router_w + (size_t)(4 * (lane + 64 * j) + c) * 8; const f32x4 r0 = *(const f32x4*)rw, r1 = *(const f32x4*)(rw + 4);
                            lg[0] += y[c] * r0[0]; lg[1] += y[c] * r0[1]; lg[2] += y[c] * r0[2]; lg[3] += y[c] * r0[3]; lg[4] += y[c] * r1[0]; lg[5] += y[c] * r1[1]; lg[6] += y[c] * r1[2]; lg[7] += y[c] * r1[3]; } } }
                if (l == 1) {
#pragma unroll
                    for (int e = 0; e < 8; ++e) lg[e] = wave_sum(lg[e]);
                    int e0 = 0; float v0 = lg[0];
#pragma unroll
                    for (int e = 1; e < 8; ++e) if (lg[e] > v0) { v0 = lg[e]; e0 = e; }
                    int e1 = -1; float v1 = -__builtin_inff();
#pragma unroll
                    for (int e = 0; e < 8; ++e) if (e != e0 && lg[e] > v1) { v1 = lg[e]; e1 = e; }
                    if (lane == 0) { const float p0 = 1.0f / (1.0f + __expf(v1 - v0)); int* ro = ROUTE + (size_t)r * 8;
                        ro[0] = e0; ro[1] = e1; ro[2] = (int)atomicAdd(ctl + CW_CNT + e0, 1u); ro[3] = (int)atomicAdd(ctl + CW_CNT + e1, 1u); ((float*)ro)[4] = p0; ((float*)ro)[5] = 1.0f - p0; }
                }
            }
        }
        SEAM(pb + 10);
        if (l == 0) {
            if (IN(pb + 11)) REP(pb + 11) {
                pg8::Gemm g{H, WGU, T, 2 * DFF, D}; pg8::StaticOrder S; S.init(T, 2 * DFF, F.G, (int)blockIdx.x);
                pg8::EpiSwiglu E{ACT, DFF, 1 << 20};
                pg8::gemm_phase<pg8::EpiSwiglu, pg8::StaticOrder, true, true>(F.lds, g, S, E);
            }
            SEAM(pb + 11);
            if (IN(pb + 12)) REP(pb + 12) {
                pg8::Gemm g{ACT, WDN, T, D, DFF}; pg8::StaticOrder S; S.init(T, D, F.G, (int)blockIdx.x);
                pg8::EpiResid E{XRES, XRES, D, 1.f};
                pg8::gemm_phase<pg8::EpiResid, pg8::StaticOrder, true, true>(F.lds, g, S, E);
            }
            SEAM(pb + 12);
            if (IN(pb + 13)) REP(pb + 13) { for (int r = F.gw; r < T; r += F.NGW) rms_row(XRES + (size_t)r * D, mix_norm_w + D, H + (size_t)r * D, F.lane, H8 + (size_t)r * D); }
            SEAM(pb + 13);
        } else {
#define MOE_OFFSETS() int off[9]; off[0] = 0; _Pragma("unroll") for (int e = 0; e < 8; ++e) { const int c = __builtin_amdgcn_readfirstlane((int)__hip_atomic_load(ctl + CW_CNT + e, __ATOMIC_RELAXED, __HIP_MEMORY_SCOPE_AGENT)); off[e + 1] = off[e] + ((c + 255) & ~255); }
            if (IN(pb + 11)) REP(pb + 11) {
                MOE_OFFSETS();
                for (int it = F.gw; it < T * 2; it += F.NGW) { const int t = it >> 1, k = it & 1; int* ro = ROUTE + (size_t)t * 8; const int e = ro[k], pos = ro[2 + k];
                    int base = 0;
#pragma unroll
                    for (int q = 0; q < 8; ++q) if (e == q) base = off[q];
                    const int slot = base + pos; if (F.lane == 0) ro[6 + k] = slot;
                    const v4u* src = (const v4u*)(H8 + (size_t)t * D); v4u* dst = (v4u*)((unsigned char*)HG + (size_t)slot * D);
#pragma unroll
                    for (int j = 0; j < 2; ++j) dst[F.lane + 64 * j] = src[F.lane + 64 * j]; }
#pragma unroll
                for (int e = 0; e < 8; ++e) { const int c = __builtin_amdgcn_readfirstlane((int)__hip_atomic_load(ctl + CW_CNT + e, __ATOMIC_RELAXED, __HIP_MEMORY_SCOPE_AGENT));
                    for (int rr = off[e] + c + F.gw; rr < off[e + 1]; rr += F.NGW) { v4u* dst = (v4u*)((unsigned char*)HG + (size_t)rr * D);
#pragma unroll
                        for (int j = 0; j < 2; ++j) dst[F.lane + 64 * j] = (v4u){0u, 0u, 0u, 0u}; } }
            }
            SEAM(pb + 11);
            if (IN(pb + 12)) REP(pb + 12) {
                if (F.tid == 0) { MOE_OFFSETS(); int cu = 0;
#pragma unroll
                    for (int e = 0; e < 8; ++e) { const int ne = (off[e + 1] - off[e]) >> 8; MTAB[e] = ne; MTAB[8 + e] = off[e] >> 8; MTAB[16 + e] = cu; cu += ne * 56; } MTAB[24] = cu; MTAB[25] = cu; }
                __syncthreads();
                pg8::Gemm g{HG, WEGU, MAXSLOT, NEXP * 2 * EFF, D / 2}; pg8::MoeOrder S{(const LAS int*)MTAB, 56, F.G, (int)blockIdx.x};
                pg8::EpiSwiglu8 E{(unsigned char*)EACT, EFF, 56, 1.0f / 256.f, 8.f};
                pg8::gemm_phase<pg8::EpiSwiglu8, pg8::MoeOrder, true, true, true>(F.lds, g, S, E);
            }
            SEAM(pb + 12);
            if (IN(pb + 13)) REP(pb + 13) {
                __syncthreads();
                if (F.tid == 0) { MOE_OFFSETS(); int cu = 0;
#pragma unroll
                    for (int e = 0; e < 8; ++e) { const int ne = (off[e + 1] - off[e]) >> 8; MTAB[e] = ne; MTAB[8 + e] = off[e] >> 8; MTAB[16 + e] = cu; cu += ne * 8; } MTAB[24] = cu; MTAB[25] = cu; }
                __syncthreads();
                pg8::Gemm g{EACT, WEDN, MAXSLOT, NEXP * D, EFF / 2}; pg8::MoeOrder S{(const LAS int*)MTAB, 8, F.G, (int)blockIdx.x};
                pg8::EpiStoreF32 E{Y, D, 8, 1.0f / 2048.f};
                pg8::gemm_phase<pg8::EpiStoreF32, pg8::MoeOrder, true, true, true>(F.lds, g, S, E);
            }
            SEAM(pb + 13);
            if (IN(pb + 14)) REP(pb + 14) {
                const int lane = F.lane;
                for (int r = F.gw; r < T; r += F.NGW) { const int* ro = ROUTE + (size_t)r * 8; const float p0 = ((const float*)ro)[4], p1 = ((const float*)ro)[5]; const float* y0 = Y + (size_t)ro[6] * D; const float* y1 = Y + (size_t)ro[7] * D;
                    const float* xrow = XRES + (size_t)r * D; f32x4 v[8]; float ss = 0.f;
#pragma unroll
                    for (int j = 0; j < 8; ++j) { const int o = 4 * (lane + 64 * j); v[j] = *(const f32x4*)(xrow + o) + *(const f32x4*)(y0 + o) * p0 + *(const f32x4*)(y1 + o) * p1; ss += (v[j][0] * v[j][0] + v[j][1] * v[j][1]) + (v[j][2] * v[j][2] + v[j][3] * v[j][3]); }
                    const float rstd = rsqrtf(wave_sum(ss) * (1.f / D) + EPS);
#pragma unroll
                    for (int j = 0; j < 8; ++j) { const int o = 4 * (lane + 64 * j); const f32x4 ww = *(const f32x4*)(final_norm_w + o); *(f32x4*)(args.out + (size_t)r * D + o) = v[j] * rstd * ww; } }
            }
        }
    }
    { constexpr int l = 1;
        const int pb = 2 + l * NPL;
        const float lambda_init = l == 0 ? 0.2f : 0.35550906f;
        const float* xin = l == 0 ? x_in : XRES;
        if (IN(pb + 0)) REP(pb + 0) {
            { pg8::Gemm g{H, WIN + (size_t)l * NINP * D, T, 45 * 256, D}; pg8::StaticOrder S; S.init(T, 45 * 256, F.G, (int)blockIdx.x);
              pg8::EpiIn E{RQ, RK, RVT, RG, BQKV, BZ, CQ, CK, CVT, GATES, BBA, 0, 1.f};
              pg8::gemm_phase<pg8::EpiIn, pg8::StaticOrder, true, true>(F.lds, g, S, E); }
            { pg8::Gemm g{(const bf16*)H8, (const bf16*)(WIN8 + (size_t)l * 32 * 256 * D), T, 24 * 256, D / 2}; pg8::StaticOrder S; S.init(T, 24 * 256, F.G, (int)blockIdx.x);
              pg8::EpiIn E{RQ, RK, RVT, RG, BQKV, BZ, CQ, CK, CVT, GATES, BBA, 1, 1.0f / 256.f};
              pg8::gemm_phase<pg8::EpiIn, pg8::StaticOrder, true, true, true>(F.lds, g, S, E); }
        }
        SEAM(pb + 0);
        if (IN(pb + 1)) REP(pb + 1) {
            const float* cw = conv_w + (size_t)l * 4 * 3072;
            for (int it = F.vcu; it < 1024; it += F.G) gdn_prep_item(F, l, it >> 5, it & 31, BQKV, BBA, cw, a_log, dt_bias, ws + WS_GCH + (size_t)it * GDN_CH_BYTES, (float*)(ws + WS_GL) + it);
        }
        SEAM(pb + 1);
        if (IN(pb + 2)) REP(pb + 2) {
            const int bx = F.vcu;
            const int mixsel = (l == 0 && args.ph_hi > 100) ? (args.ph_hi - 100) : 3, qw = (l == 0 && args.ph_hi > 100) ? 104 : 100 + l;
            if (bx < 32 && (mixsel & 1)) gdn_scan(F, bx, ws + WS_GCH, (const float*)(ws + WS_GL), OB);
            if (mixsel & 2) {
                volatile LAS int* qslot = (volatile LAS int*)(F.lds + MISC_OFF + 256);
                int nxt = 0; if (F.tid == 0) nxt = (int)atomicAdd(ctl + qw, 1u);
                for (;;) {
                    __syncthreads(); if (F.tid == 0) qslot[0] = nxt; __syncthreads();
                    const int it = __builtin_amdgcn_readfirstlane(qslot[0]); if (it >= 1024) break;
                    if (F.tid == 0) nxt = (int)atomicAdd(ctl + qw, 1u);
                    const int qt = 15 - (it >> 6), kind = (it >> 5) & 1, hd = it & 31, b = hd >> 3, hm = hd & 7;
                    if (kind == 0) { const int hh = hm >> 1, m = hm & 1; const float slope = exp2f(-2.0f * (float)(hh + 1));
                        flash_item<256, 128, true, false, false>(F, CQ + ((size_t)hd * SEQ + qt * 128) * 128, CK + (size_t)hd * SEQ * 128, CVT + (size_t)(b * 4 + hh) * 256 * SEQ, SEQ, qt * 128, SEQ, slope,
                                                            O12 + ((size_t)m * T + b * SEQ + qt * 128) * 1024 + hh * 256, nullptr, 1024); }
                    else { const float lg = log2f(1.0f - exp2f(-5.0f - (float)hm));
                        flash_item<128, 128, true, false, true>(F, RQ + ((size_t)hd * SEQ + qt * 128) * 128, RK + (size_t)hd * SEQ * 128, RVT + (size_t)hd * 128 * SEQ, SEQ, qt * 128, SEQ, lg,
                                                           OA + ((size_t)(b * SEQ + qt * 128)) * 1024 + hm * 128, nullptr, 1024); }
                }
            }
        }
        SEAM(pb + 2);
        if (IN(pb + 3)) REP(pb + 3) {
            const int lane = F.lane;
            const float* lv = diff_lambda + (size_t)l * 512;
            const float d01 = wave_sum(lv[lane] * lv[128 + lane] + lv[64 + lane] * lv[192 + lane]), d23 = wave_sum(lv[256 + lane] * lv[384 + lane] + lv[320 + lane] * lv[448 + lane]);
            const float lam = __expf(d01) - __expf(d23) + lambda_init;
            for (int t = F.gw; t < T; t += F.NGW) {
#pragma unroll
                for (int h = 0; h < 8; ++h) { const size_t o = (size_t)t * 1024 + h * 128 + 2 * lane;
                    { const float a0 = OA[o], a1 = OA[o + 1]; const float mean = wave_sum(a0 + a1) * (1.f / 128.f); const float c0 = a0 - mean, c1 = a1 - mean; const float rstd = rsqrtf(wave_sum(c0 * c0 + c1 * c1) * (1.f / 128.f) + EPS);
                      const unsigned gv = *(const unsigned*)(RG + o); *(unsigned*)(OCAT + (size_t)t * 3072 + h * 128 + 2 * lane) = pk2(c0 * rstd * bf2f(gv & 0xffffu), c1 * rstd * __uint_as_float(gv & 0xffff0000u)); }
                    { const float a0 = OB[o], a1 = OB[o + 1]; const float rstd = rsqrtf(wave_sum(a0 * a0 + a1 * a1) * (1.f / 128.f) + EPS); const unsigned gv = *(const unsigned*)(BZ + o);
                      *(unsigned*)(OCAT + (size_t)t * 3072 + 1024 + h * 128 + 2 * lane) = pk2(a0 * rstd * gdn_norm_w[l * 128 + 2 * lane] * bf2f(gv & 0xffffu), a1 * rstd * gdn_norm_w[l * 128 + 2 * lane + 1] * __uint_as_float(gv & 0xffff0000u)); } }
#pragma unroll
                for (int h = 0; h < 4; ++h) { const size_t o = (size_t)t * 1024 + h * 256 + 4 * lane; const f32x4 p = *(const f32x4*)(O12 + o), q = *(const f32x4*)(O12 + (size_t)T * 1024 + o); const f32x4 d = p - q * lam;
                    const float rstd = rsqrtf(wave_sum((d[0] * d[0] + d[1] * d[1]) + (d[2] * d[2] + d[3] * d[3])) * (1.f / 256.f) + EPS) * (1.0f - lambda_init); const f32x4 ww = *(const f32x4*)(diff_norm_w + l * 256 + 4 * lane);
                    v2u ov; ov.x = pk2(d[0] * rstd * ww[0], d[1] * rstd * ww[1]); ov.y = pk2(d[2] * rstd * ww[2], d[3] * rstd * ww[3]); *(v2u*)(OCAT + (size_t)t * 3072 + 2048 + h * 256 + 4 * lane) = ov; }
            }
        }
        SEAM(pb + 3);
        if (IN(pb + 4)) REP(pb + 4) {
            pg8::Gemm g{OCAT, WBR + (size_t)l * D * 3072, T, D, 3072}; pg8::StaticOrder S; S.init(T, D, F.G, (int)blockIdx.x);
            pg8::EpiBranch E{MERGEB, GATES, 16, 32};
            pg8::gemm_phase<pg8::EpiBranch, pg8::StaticOrder, true, true>(F.lds, g, S, E);
        }
        SEAM(pb + 4);
        if (IN(pb + 5)) REP(pb + 5) {
            pg8::Gemm g{MERGEB, WOUT + (size_t)l * D * D, T, D, D}; pg8::StaticOrder S; S.init(T, D, F.G, (int)blockIdx.x);
            pg8::EpiResid E{xin, XRES, D, 1.f};
            pg8::gemm_phase<pg8::EpiResid, pg8::StaticOrder, true, true>(F.lds, g, S, E);
        }
        SEAM(pb + 5);
        if (IN(pb + 6)) REP(pb + 6) { for (int r = F.gw; r < T; r += F.NGW) rms_row(XRES + (size_t)r * D, cross_norm_w + l * D, H + (size_t)r * D, F.lane); }
        SEAM(pb + 6);
        if (IN(pb + 7)) REP(pb + 7) {
            pg8::Gemm g{H, WQ + (size_t)l * 512 * D, T, 512, D}; pg8::StaticOrder S; S.init(T, 512, F.G, (int)blockIdx.x);
            pg8::EpiHeads E{QX, nullptr, 4, 11, 1 << 20};
            pg8::gemm_phase<pg8::EpiHeads, pg8::StaticOrder, true, true>(F.lds, g, S, E);
        }
        SEAM(pb + 7);
        if (IN(pb + 8)) REP(pb + 8) {
            for (int it = F.vcu; it < 256; it += F.G) { const int hd = it >> 4, qt = it & 15, b = hd >> 2, hh = hd & 3;
                flash_item<128, 128, false, true, false>(F, QX + ((size_t)hd * SEQ + qt * 128) * 128, KX + ((size_t)l * 16 + hd) * MEML * 128, VXT + ((size_t)l * 16 + hd) * 128 * MEML, MEML, qt * 128, MEML, 0.f,
                                             nullptr, OX + ((size_t)(b * SEQ + qt * 128)) * 512 + hh * 128, 512); }
        }
        SEAM(pb + 8);
        if (IN(pb + 9)) REP(pb + 9) {
            pg8::Gemm g{OX, WO + (size_t)l * D * 512, T, D, 512}; pg8::StaticOrder S; S.init(T, D, F.G, (int)blockIdx.x);
            pg8::EpiResid E{XRES, XRES, D, 1.f};
            pg8::gemm_phase<pg8::EpiResid, pg8::StaticOrder, true, true>(F.lds, g, S, E);
        }
        SEAM(pb + 9);
        if (IN(pb + 10)) REP(pb + 10) {
            const int lane = F.lane; const float* w = ffn_norm_w + l * D;
            for (int r = F.gw; r < T; r += F.NGW) {
                const float* xrow = XRES + (size_t)r * D; f32x4 v[8]; float ss = 0.f;
#pragma unroll
                for (int j = 0; j < 8; ++j) { v[j] = *(const f32x4*)(xrow + 4 * (lane + 64 * j)); ss += (v[j][0] * v[j][0] + v[j][1] * v[j][1]) + (v[j][2] * v[j][2] + v[j][3] * v[j][3]); }
                const float rstd = rsqrtf(wave_sum(ss) * (1.f / D) + EPS);
                float lg[8];
#pragma unroll
                for (int e = 0; e < 8; ++e) lg[e] = 0.f;
#pragma unroll
                for (int j = 0; j < 8; ++j) { const f32x4 ww = *(const f32x4*)(w + 4 * (lane + 64 * j)); f32x4 y; y[0] = v[j][0] * rstd * ww[0]; y[1] = v[j][1] * rstd * ww[1]; y[2] = v[j][2] * rstd * ww[2]; y[3] = v[j][3] * rstd * ww[3];
                    if (l == 0) { v2u o; o.x = pk2(y[0], y[1]); o.y = pk2(y[2], y[3]); *(v2u*)(H + (size_t)r * D + 4 * (lane + 64 * j)) = o; }
                    else *(unsigned*)(H8 + (size_t)r * D + 4 * (lane + 64 * j)) = pg8::pk4_fp8(y[0], y[1], y[2], y[3]);
                    if (l == 1) {
#pragma unroll
                        for (int c = 0; c < 4; ++c) { const float* rw = router_w + (size_t)(4 * (lane + 64 * j) + c) * 8; const f32x4 r0 = *(const f32x4*)rw, r1 = *(const f32x4*)(rw + 4);
                            lg[0] += y[c] * r0[0]; lg[1] += y[c] * r0[1]; lg[2] += y[c] * r0[2]; lg[3] += y[c] * r0[3]; lg[4] += y[c] * r1[0]; lg[5] += y[c] * r1[1]; lg[6] += y[c] * r1[2]; lg[7] += y[c] * r1[3]; } } }
                if (l == 1) {
#pragma unroll
                    for (int e = 0; e < 8; ++e) lg[e] = wave_sum(lg[e]);
                    int e0 = 0; float v0 = lg[0];
#pragma unroll
                    for (int e = 1; e < 8; ++e) if (lg[e] > v0) { v0 = lg[e]; e0 = e; }
                    int e1 = -1; float v1 = -__builtin_inff();
#pragma unroll
                    for (int e = 0; e < 8; ++e) if (e != e0 && lg[e] > v1) { v1 = lg[e]; e1 = e; }
                    if (lane == 0) { const float p0 = 1.0f / (1.0f + __expf(v1 - v0)); int* ro = ROUTE + (size_t)r * 8;
                        ro[0] = e0; ro[1] = e1; ro[2] = (int)atomicAdd(ctl + CW_CNT + e0, 1u); ro[3] = (int)atomicAdd(ctl + CW_CNT + e1, 1u); ((float*)ro)[4] = p0; ((float*)ro)[5] = 1.0f - p0; }
                }
            }
        }
        SEAM(pb + 10);
        if (l == 0) {
            if (IN(pb + 11)) REP(pb + 11) {
                pg8::Gemm g{H, WGU, T, 2 * DFF, D}; pg8::StaticOrder S; S.init(T, 2 * DFF, F.G, (int)blockIdx.x);
                pg8::EpiSwiglu E{ACT, DFF, 1 << 20};
                pg8::gemm_phase<pg8::EpiSwiglu, pg8::StaticOrder, true, true>(F.lds, g, S, E);
            }
            SEAM(pb + 11);
            if (IN(pb + 12)) REP(pb + 12) {
                pg8::Gemm g{ACT, WDN, T, D, DFF}; pg8::StaticOrder S; S.init(T, D, F.G, (int)blockIdx.x);
                pg8::EpiResid E{XRES, XRES, D, 1.f};
                pg8::gemm_phase<pg8::EpiResid, pg8::StaticOrder, true, true>(F.lds, g, S, E);
            }
            SEAM(pb + 12);
            if (IN(pb + 13)) REP(pb + 13) { for (int r = F.gw; r < T; r += F.NGW) rms_row(XRES + (size_t)r * D, mix_norm_w + D, H + (size_t)r * D, F.lane, H8 + (size_t)r * D); }
            SEAM(pb + 13);
        } else {
#define MOE_OFFSETS() int off[9]; off[0] = 0; _Pragma("unroll") for (int e = 0; e < 8; ++e) { const int c = __builtin_amdgcn_readfirstlane((int)__hip_atomic_load(ctl + CW_CNT + e, __ATOMIC_RELAXED, __HIP_MEMORY_SCOPE_AGENT)); off[e + 1] = off[e] + ((c + 255) & ~255); }
            if (IN(pb + 11)) REP(pb + 11) {
                MOE_OFFSETS();
                for (int it = F.gw; it < T * 2; it += F.NGW) { const int t = it >> 1, k = it & 1; int* ro = ROUTE + (size_t)t * 8; const int e = ro[k], pos = ro[2 + k];
                    int base = 0;
#pragma unroll
                    for (int q = 0; q < 8; ++q) if (e == q) base = off[q];
                    const int slot = base + pos; if (F.lane == 0) ro[6 + k] = slot;
                    const v4u* src = (const v4u*)(H8 + (size_t)t * D); v4u* dst = (v4u*)((unsigned char*)HG + (size_t)slot * D);
#pragma unroll
                    for (int j = 0; j < 2; ++j) dst[F.lane + 64 * j] = src[F.lane + 64 * j]; }
#pragma unroll
                for (int e = 0; e < 8; ++e) { const int c = __builtin_amdgcn_readfirstlane((int)__hip_atomic_load(ctl + CW_CNT + e, __ATOMIC_RELAXED, __HIP_MEMORY_SCOPE_AGENT));
                    for (int rr = off[e] + c + F.gw; rr < off[e + 1]; rr += F.NGW) { v4u* dst = (v4u*)((unsigned char*)HG + (size_t)rr * D);
#pragma unroll
                        for (int j = 0; j < 2; ++j) dst[F.lane + 64 * j] = (v4u){0u, 0u, 0u, 0u}; } }
            }
            SEAM(pb + 11);
            if (IN(pb + 12)) REP(pb + 12) {
                if (F.tid == 0) { MOE_OFFSETS(); int cu = 0;
#pragma unroll
                    for (int e = 0; e < 8; ++e) { const int ne = (off[e + 1] - off[e]) >> 8; MTAB[e] = ne; MTAB[8 + e] = off[e] >> 8; MTAB[16 + e] = cu; cu += ne * 56; } MTAB[24] = cu; MTAB[25] = cu; }
                __syncthreads();
                pg8::Gemm g{HG, WEGU, MAXSLOT, NEXP * 2 * EFF, D / 2}; pg8::MoeOrder S{(const LAS int*)MTAB, 56, F.G, (int)blockIdx.x};
                pg8::EpiSwiglu8 E{(unsigned char*)EACT, EFF, 56, 1.0f / 256.f, 8.f};
                pg8::gemm_phase<pg8::EpiSwiglu8, pg8::MoeOrder, true, true, true>(F.lds, g, S, E);
            }
            SEAM(pb + 12);
            if (IN(pb + 13)) REP(pb + 13) {
                __syncthreads();
                if (F.tid == 0) { MOE_OFFSETS(); int cu = 0;
#pragma unroll
                    for (int e = 0; e < 8; ++e) { const int ne = (off[e + 1] - off[e]) >> 8; MTAB[e] = ne; MTAB[8 + e] = off[e] >> 8; MTAB[16 + e] = cu; cu += ne * 8; } MTAB[24] = cu; MTAB[25] = cu; }
                __syncthreads();
                pg8::Gemm g{EACT, WEDN, MAXSLOT, NEXP * D, EFF / 2}; pg8::MoeOrder S{(const LAS int*)MTAB, 8, F.G, (int)blockIdx.x};
                pg8::EpiStoreF32 E{Y, D, 8, 1.0f / 2048.f};
                pg8::gemm_phase<pg8::EpiStoreF32, pg8::MoeOrder, true, true, true>(F.lds, g, S, E);
            }
            SEAM(pb + 13);
            if (IN(pb + 14)) REP(pb + 14) {
                const int lane = F.lane;
                for (int r = F.gw; r < T; r += F.NGW) { const int* ro = ROUTE + (size_t)r * 8; const float p0 = ((const float*)ro)[4], p1 = ((const float*)ro)[5]; const float* y0 = Y + (size_t)ro[6] * D; const float* y1 = Y + (size_t)ro[7] * D;
                    const float* xrow = XRES + (size_t)r * D; f32x4 v[8]; float ss = 0.f;
#pragma unroll
                    for (int j = 0; j < 8; ++j) { const int o = 4 * (lane + 64 * j); v[j] = *(const f32x4*)(xrow + o) + *(const f32x4*)(y0 + o) * p0 + *(const f32x4*)(y1 + o) * p1; ss += (v[j][0] * v[j][0] + v[j][1] * v[j][1]) + (v[j][2] * v[j][2] + v[j][3] * v[j][3]); }
                    const float rstd = rsqrtf(wave_sum(ss) * (1.f / D) + EPS);
#pragma unroll
                    for (int j = 0; j < 8; ++j) { const int o = 4 * (lane + 64 * j); const f32x4 ww = *(const f32x4*)(final_norm_w + o); *(f32x4*)(args.out + (size_t)r * D + o) = v[j] * rstd * ww; } }
            }
        }
    }
#undef IN
#undef SEAM
}

extern "C" void kernel_launch(void* const* d_in, const int* in_sizes, int n_in, void* d_out, int out_size, void* d_ws, size_t ws_size, hipStream_t stream) {
    static int grid = 0;
    if (grid == 0) {
        if (n_in != 24 || out_size != T * D || ws_size < WS_END) { fprintf(stderr, "kernel_launch: unexpected shapes (n_in %d, out %d, ws %zu < %zu)\n", n_in, out_size, ws_size, (size_t)WS_END); grid = -1; return; }
        int dev = 0, cus = 0, per_cu = 0;
        if (hipGetDevice(&dev) != hipSuccess || hipDeviceGetAttribute(&cus, hipDeviceAttributeMultiprocessorCount, dev) != hipSuccess) { grid = -1; return; }
        if (hipFuncSetAttribute((const void*)mk_fwd, hipFuncAttributeMaxDynamicSharedMemorySize, LDS_BYTES) != hipSuccess) { fprintf(stderr, "kernel_launch: hipFuncSetAttribute failed\n"); grid = -1; return; }
        if (hipOccupancyMaxActiveBlocksPerMultiprocessor(&per_cu, (const void*)mk_fwd, NWAVES * 64, LDS_BYTES) != hipSuccess || per_cu < 1) fprintf(stderr, "kernel_launch: occupancy query says %d\n", per_cu);
        (void)hipGetLastError();
        grid = cus;
    }
    if (grid < 0) return;
    (void)hipMemsetAsync((char*)d_ws + WS_CTL, 0, CTL_BYTES, stream);
    Args a{};
    for (int i = 0; i < 24; ++i) a.in[i] = d_in[i];
    a.out = (float*)d_out; a.ws = (unsigned char*)d_ws;
#if MK_ONE_LAUNCH
    a.ph_lo = 0; a.ph_hi = NPH;
    hipLaunchKernelGGL(mk_fwd, dim3(grid), dim3(NWAVES * 64), LDS_BYTES, stream, a);
#else
#ifndef DUP_MASK
#define DUP_MASK 0ull
#endif
    for (int p = 0; p < NPH; ++p) { a.ph_lo = p; a.ph_hi = p + 1; const int reps = ((DUP_MASK >> p) & 1ull) ? 2 : 1;
        for (int r = 0; r < reps; ++r) hipLaunchKernelGGL(mk_fwd, dim3(grid), dim3(NWAVES * 64), LDS_BYTES, stream, a);
#ifdef MIX_EXTRA
        if (p == 4) { a.ph_hi = 100 + MIX_EXTRA; hipLaunchKernelGGL(mk_fwd, dim3(grid), dim3(NWAVES * 64), LDS_BYTES, stream, a); }
#endif
    }
#endif
}
```

```cpp
#include <hip/hip_runtime.h>
#include <cstdio>
#include <cstdint>
#define MK_ONE_LAUNCH 1
namespace pg8 {
#define PG8_LAS __attribute__((address_space(3)))
typedef unsigned short bf16_t;
typedef short bf16x8 __attribute__((ext_vector_type(8)));
typedef float f32x4 __attribute__((ext_vector_type(4)));
typedef unsigned u32x4 __attribute__((ext_vector_type(4)));
typedef int i32x4 __attribute__((ext_vector_type(4)));
constexpr int BM = 256, BK = 64, HALF = 128, HTB = HALF * BK * 2  , STAGE_BYTES = 8 * HTB, NXCD = 8, WGM = 8;

__host__ __device__ __forceinline__ int lds_byte(int r, int c) { const int st = (r >> 4) * 2 + (c >> 5), rr = r & 15, cc = c & 31, ob = rr * 64 + cc * 2; return st * 1024 + (ob ^ (((ob >> 9) & 1) << 5)); }
__host__ __device__ __forceinline__ void stage_rc(int b, int& R, int& C) { const int st = b / 1024, sb = b % 1024, swz = sb ^ (((sb >> 9) & 1) << 5); R = (st >> 1) * 16 + swz / 64; C = (st & 1) * 32 + (swz % 64) / 2; }
__host__ __device__ __forceinline__ int perm32(int rho) { const int n = rho >> 4, i = rho & 15; return 8 * (i >> 2) + 4 * n + (i & 3); }

struct Unit { int pm, pn; };
struct Gemm { const bf16_t* A; const bf16_t* Bt; int M, N, K; };

struct StaticOrder {
    int nM, nN, nwg, G, c;
    __host__ __device__ void init(int M, int N, int G_, int c_) { nM = M / BM; nN = N / BM; nwg = nM * nN; G = G_; c = c_; }
    __host__ __device__ bool next(int i, Unit& u) const {
        const long L = (long)i * G + c; if (L >= nwg) return false;
        int wgid = (int)L; { const int q = nwg / NXCD, r = nwg % NXCD, xcd = wgid % NXCD, off = wgid / NXCD; wgid = (xcd < r ? xcd * (q + 1) : r * (q + 1) + (xcd - r) * q) + off; }
        const int nig = WGM * nN, gid = wgid / nig, fm = gid * WGM, gsz = (nM - fm) < WGM ? (nM - fm) : WGM;
        u.pm = fm + ((wgid % nig) % gsz); u.pn = (wgid % nig) / gsz; return true;
    }
    __device__ __forceinline__ void a_ready(const Unit&) const {}
    __device__ __forceinline__ void done(const Unit&) const {}
};

__device__ __forceinline__ unsigned cvt_pk_bf16(float lo, float hi) { unsigned r; asm volatile("v_cvt_pk_bf16_f32 %0, %1, %2" : "=v"(r) : "v"(lo), "v"(hi)); return r; }
typedef float f32x2 __attribute__((ext_vector_type(2)));
__device__ __forceinline__ float fsilu(float v) { return v / (1.0f + __expf(-v)); }
__device__ __forceinline__ float fsigm(float v) { return 1.0f / (1.0f + __expf(-v)); }
__device__ __forceinline__ void st8bf(bf16_t* p, f32x4 v0, f32x4 v1) { u32x4 w; w.x = cvt_pk_bf16(v0[0], v0[1]); w.y = cvt_pk_bf16(v0[2], v0[3]); w.z = cvt_pk_bf16(v1[0], v1[1]); w.w = cvt_pk_bf16(v1[2], v1[3]); *(u32x4*)p = w; }
__device__ __forceinline__ bf16_t f2bf1(float f) { unsigned u = __builtin_bit_cast(unsigned, f); return (bf16_t)((u + 0x7fffu + ((u >> 16) & 1u)) >> 16); }

struct EpiIn {
    static constexpr bool PERM = true, AFTER_DRAIN = false, HOOK = false;
    bf16_t *RQ, *RK, *RVT, *RG, *BQKV, *BZ, *CQ, *CK, *CVT, *GATES; float* BBA; int set; float sc8;
    __device__ __forceinline__ void operator()(const f32x4 (&acc_)[2][2][4][2], const Unit& u, int wr, int wc, int fr, int fq) const {
        f32x4 acc[2][2][4][2];
#pragma unroll
        for (int a_ = 0; a_ < 2; ++a_)
#pragma unroll
            for (int b_ = 0; b_ < 2; ++b_)
#pragma unroll
                for (int m_ = 0; m_ < 4; ++m_)
#pragma unroll
                    for (int n_ = 0; n_ < 2; ++n_) acc[a_][b_][m_][n_] = set ? acc_[a_][b_][m_][n_] * sc8 : acc_[a_][b_][m_][n_];
        const int lp = u.pn, pn = set == 0 ? (lp < 44 ? lp : 68) : lp + 44, b = u.pm >> 3;
        const int rowt = u.pm * BM + wr * 64 + fr;
        const int cin = wc * 32 + 8 * fq;
        if (pn < 8 || (pn >= 32 && pn < 40)) {
            auto heads = [&](bf16_t* base, int hb, float sc) __attribute__((always_inline)) {
#pragma unroll
                for (int ai = 0; ai < 2; ++ai)
#pragma unroll
                    for (int m = 0; m < 4; ++m) { const int s = (rowt + ai * HALF + m * 16) - b * 2048;
#pragma unroll
                        for (int bj = 0; bj < 2; ++bj) st8bf(base + ((size_t)((b * 8 + hb + bj) * 2048 + s)) * 128 + cin, acc[ai][bj][m][0] * sc, acc[ai][bj][m][1] * sc); } };
            if (pn < 4) heads(RQ, pn * 2, 1.f); else if (pn < 8) heads(RK, (pn - 4) * 2, 0.08838834764831845f);
            else if (pn < 36) heads(CQ, (pn - 32) * 2, 1.f); else heads(CK, (pn - 36) * 2, 1.f);
        } else if ((pn >= 40 && pn < 44) || (pn >= 8 && pn < 12)) {
            const bool isr = pn < 12; const int h = isr ? pn - 8 : pn - 40; bf16_t* CVT = isr ? RVT : this->CVT;
#pragma unroll
            for (int ai = 0; ai < 2; ++ai)
#pragma unroll
                for (int m = 0; m < 4; ++m) { const int s = (rowt + ai * HALF + m * 16) - b * 2048;
#pragma unroll
                    for (int bj = 0; bj < 2; ++bj)
#pragma unroll
                        for (int n = 0; n < 2; ++n)
#pragma unroll
                            for (int e = 0; e < 4; ++e) CVT[((size_t)((b * 4 + h) * 256 + bj * HALF + cin + 4 * n + e)) * 2048 + s] = f2bf1(acc[ai][bj][m][n][e]); }
        } else if (pn == 68) {
            if (wc == 0 && fq < 2) {
#pragma unroll
                for (int ai = 0; ai < 2; ++ai)
#pragma unroll
                    for (int m = 0; m < 4; ++m) { float* p = BBA + (size_t)(rowt + ai * HALF + m * 16) * 16 + 8 * fq; *(f32x4*)p = acc[ai][0][m][0]; *(f32x4*)(p + 4) = acc[ai][0][m][1]; }
            }
        } else {
            auto rows = [&](bf16_t* base, int ldc, int c0, int act) __attribute__((always_inline)) {
#pragma unroll
                for (int ai = 0; ai < 2; ++ai)
#pragma unroll
                    for (int m = 0; m < 4; ++m) { bf16_t* rowp = base + (size_t)(rowt + ai * HALF + m * 16) * ldc + c0 + cin;
#pragma unroll
                        for (int bj = 0; bj < 2; ++bj) { f32x4 v0 = acc[ai][bj][m][0], v1 = acc[ai][bj][m][1];
                            if (act == 1) {
#pragma unroll
                                for (int e = 0; e < 4; ++e) { v0[e] = fsilu(v0[e]); v1[e] = fsilu(v1[e]); } }
                            else if (act == 2) {
#pragma unroll
                                for (int e = 0; e < 4; ++e) { v0[e] = fsigm(v0[e]); v1[e] = fsigm(v1[e]); } }
                            st8bf(rowp + bj * HALF, v0, v1); } } };
            if (pn < 16) rows(RG, 1024, (pn - 12) * 256, 1); else if (pn < 28) rows(BQKV, 3072, (pn - 16) * 256, 0);
            else if (pn < 32) rows(BZ, 1024, (pn - 28) * 256, 1); else rows(GATES, 6144, (pn - 44) * 256, 2);
        }
    }
};

struct EpiHeads {
    static constexpr bool PERM = true, AFTER_DRAIN = false, HOOK = false;
    bf16_t* O; bf16_t* VT; int NH, rpb_shift  , vt_from_pn;
    __device__ __forceinline__ void operator()(const f32x4 (&acc)[2][2][4][2], const Unit& u, int wr, int wc, int fr, int fq) const {
        const int rowt = u.pm * BM + wr * 64 + fr, cin = wc * 32 + 8 * fq, rpb = 1 << rpb_shift;
        if (u.pn < vt_from_pn) {
#pragma unroll
            for (int ai = 0; ai < 2; ++ai)
#pragma unroll
                for (int m = 0; m < 4; ++m) { const int row = rowt + ai * HALF + m * 16, b = row >> rpb_shift, s = row & (rpb - 1);
#pragma unroll
                    for (int bj = 0; bj < 2; ++bj) st8bf(O + ((size_t)((b * NH + u.pn * 2 + bj) * rpb + s)) * 128 + cin, acc[ai][bj][m][0], acc[ai][bj][m][1]); }
        } else {
            const int hb = (u.pn - vt_from_pn) * 2;
#pragma unroll
            for (int ai = 0; ai < 2; ++ai)
#pragma unroll
                for (int m = 0; m < 4; ++m) { const int row = rowt + ai * HALF + m * 16, b = row >> rpb_shift, s = row & (rpb - 1);
#pragma unroll
                    for (int bj = 0; bj < 2; ++bj)
#pragma unroll
                        for (int n = 0; n < 2; ++n)
#pragma unroll
                            for (int e = 0; e < 4; ++e) VT[((size_t)((b * NH + hb + bj) * 128 + cin + 4 * n + e)) * rpb + s] = f2bf1(acc[ai][bj][m][n][e]); }
        }
    }
};

struct EpiResid {
    static constexpr bool PERM = false, AFTER_DRAIN = false, HOOK = false;
    const float* in; float* out; int ldc; float sc;
    __device__ __forceinline__ void operator()(const f32x4 (&acc)[2][2][4][2], const Unit& u, int wr, int wc, int fr, int fq) const {
        const int row0 = u.pm * BM + wr * 64 + fr, col0 = u.pn * BM + wc * 32 + 4 * fq;
#pragma unroll
        for (int ai = 0; ai < 2; ++ai)
#pragma unroll
            for (int m = 0; m < 4; ++m) { const size_t off = (size_t)(row0 + ai * HALF + m * 16) * ldc + col0;
#pragma unroll
                for (int bj = 0; bj < 2; ++bj)
#pragma unroll
                    for (int n = 0; n < 2; ++n) { const f32x4 x = *(const f32x4*)(in + off + bj * HALF + n * 16); *(f32x4*)(out + off + bj * HALF + n * 16) = x + acc[ai][bj][m][n] * sc; } }
    }
};

struct EpiBranch {
    static constexpr bool PERM = false, AFTER_DRAIN = false, HOOK = true;
    bf16_t* OUT; const bf16_t* GATES; int hk0, hk1;
    typedef unsigned u32x2 __attribute__((ext_vector_type(2)));
    static __device__ __forceinline__ f32x4 g4(const bf16_t* p) { const u32x2 gw = *(const u32x2*)p; f32x4 g; g[0] = __uint_as_float(gw.x << 16); g[1] = __uint_as_float(gw.x & 0xffff0000u); g[2] = __uint_as_float(gw.y << 16); g[3] = __uint_as_float(gw.y & 0xffff0000u); return g; }
    __device__ __forceinline__ void hook(f32x4 (&acc)[2][2][4][2], const Unit& u, int s, int wr, int wc, int fr, int fq) const {
        int z_ = 0; asm volatile("" : "+v"(z_));
        const int row0 = u.pm * BM + wr * 64 + fr + z_, col0 = u.pn * BM + wc * 32 + 4 * fq;
#pragma unroll
        for (int ai = 0; ai < 2; ++ai)
#pragma unroll
            for (int m = 0; m < 4; ++m) { const bf16_t* gp = GATES + (size_t)(row0 + ai * HALF + m * 16) * 6144 + s * 2048 + col0;
#pragma unroll
                for (int bj = 0; bj < 2; ++bj)
#pragma unroll
                    for (int n = 0; n < 2; ++n) { const f32x4 ga = g4(gp + bj * HALF + n * 16), gb = g4(gp + 2048 + bj * HALF + n * 16);
#pragma unroll
                        for (int e = 0; e < 4; ++e) acc[ai][bj][m][n][e] *= ga[e] * __builtin_amdgcn_rcpf(__builtin_fmaxf(gb[e], 1e-30f)); } }
    }
    __device__ __forceinline__ void operator()(const f32x4 (&acc)[2][2][4][2], const Unit& u, int wr, int wc, int fr, int fq) const {
        const int row0 = u.pm * BM + wr * 64 + fr, col0 = u.pn * BM + wc * 32 + 4 * fq;
#pragma unroll
        for (int ai = 0; ai < 2; ++ai)
#pragma unroll
            for (int m = 0; m < 4; ++m) { const int row = row0 + ai * HALF + m * 16;
#pragma unroll
                for (int bj = 0; bj < 2; ++bj)
#pragma unroll
                    for (int n = 0; n < 2; ++n) { const int col = col0 + bj * HALF + n * 16; const f32x4 v = g4(GATES + (size_t)row * 6144 + 4096 + col) * acc[ai][bj][m][n];
                        u32x2 w; w.x = cvt_pk_bf16(v[0], v[1]); w.y = cvt_pk_bf16(v[2], v[3]); *(u32x2*)(OUT + (size_t)row * 2048 + col) = w; } }
    }
};

struct EpiSwiglu {
    static constexpr bool PERM = true, AFTER_DRAIN = false, HOOK = false;
    bf16_t* O; int ldc, npn;
    __device__ __forceinline__ void operator()(const f32x4 (&acc)[2][2][4][2], const Unit& u, int wr, int wc, int fr, int fq) const {
        const int row0 = u.pm * BM + wr * 64 + fr, col0 = (u.pn % npn) * HALF + wc * 32 + 8 * fq;
#pragma unroll
        for (int ai = 0; ai < 2; ++ai)
#pragma unroll
            for (int m = 0; m < 4; ++m) { f32x4 v0, v1;
#pragma unroll
                for (int e = 0; e < 4; ++e) { v0[e] = fsilu(acc[ai][0][m][0][e]) * acc[ai][1][m][0][e]; v1[e] = fsilu(acc[ai][0][m][1][e]) * acc[ai][1][m][1][e]; }
                st8bf(O + (size_t)(row0 + ai * HALF + m * 16) * ldc + col0, v0, v1); }
    }
};


__device__ __forceinline__ float clamp8(float v) { return __builtin_fminf(__builtin_fmaxf(v, -448.f), 448.f); }
__device__ __forceinline__ unsigned pk4_fp8(float a, float b, float c, float d) { int r = 0; r = __builtin_amdgcn_cvt_pk_fp8_f32(clamp8(a), clamp8(b), r, false); r = __builtin_amdgcn_cvt_pk_fp8_f32(clamp8(c), clamp8(d), r, true); return (unsigned)r; }
struct EpiSwiglu8 {
    static constexpr bool PERM = true, AFTER_DRAIN = false, HOOK = false;
    unsigned char* O; int ldc, npn; float ws, as;
    __device__ __forceinline__ void operator()(const f32x4 (&acc)[2][2][4][2], const Unit& u, int wr, int wc, int fr, int fq) const {
        typedef unsigned u32x2 __attribute__((ext_vector_type(2)));
        const int row0 = u.pm * BM + wr * 64 + fr, col0 = (u.pn % npn) * HALF + wc * 32 + 8 * fq;
#pragma unroll
        for (int ai = 0; ai < 2; ++ai)
#pragma unroll
            for (int m = 0; m < 4; ++m) { float v[8];
#pragma unroll
                for (int n = 0; n < 2; ++n)
#pragma unroll
                    for (int e = 0; e < 4; ++e) v[4 * n + e] = fsilu(acc[ai][0][m][n][e] * ws) * (acc[ai][1][m][n][e] * ws) * as;
                u32x2 o; o.x = pk4_fp8(v[0], v[1], v[2], v[3]); o.y = pk4_fp8(v[4], v[5], v[6], v[7]);
                *(u32x2*)(O + (size_t)(row0 + ai * HALF + m * 16) * ldc + col0) = o; }
    }
};

struct EpiStoreF32 {
    static constexpr bool PERM = false, AFTER_DRAIN = false, HOOK = false;
    float* Y; int ldc, npn; float sc;
    __device__ __forceinline__ void operator()(const f32x4 (&acc)[2][2][4][2], const Unit& u, int wr, int wc, int fr, int fq) const {
        const int row0 = u.pm * BM + wr * 64 + fr, col0 = (u.pn % npn) * BM + wc * 32 + 4 * fq;
#pragma unroll
        for (int ai = 0; ai < 2; ++ai)
#pragma unroll
            for (int m = 0; m < 4; ++m) { float* rowp = Y + (size_t)(row0 + ai * HALF + m * 16) * ldc + col0;
#pragma unroll
                for (int bj = 0; bj < 2; ++bj)
#pragma unroll
                    for (int n = 0; n < 2; ++n) *(f32x4*)(rowp + bj * HALF + n * 16) = acc[ai][bj][m][n] * sc; }
    }
};

struct MoeOrder {
    const PG8_LAS int* T; int npn, G, c;
    __device__ __forceinline__ int rd(int k) const { return __builtin_amdgcn_readfirstlane(T[k]); }
    __device__ __forceinline__ bool next(int i, Unit& u) const {
        const int total = rd(25); const long L = (long)i * G + c; if (L >= total) return false;
        int wgid = (int)L; { const int q = total / NXCD, r = total % NXCD, xcd = wgid % NXCD, off = wgid / NXCD; wgid = (xcd < r ? xcd * (q + 1) : r * (q + 1) + (xcd - r) * q) + off; }
        int e = 0, cue = 0;
#pragma unroll
        for (int k = 1; k < 8; ++k) { const int ck = rd(16 + k); if (wgid >= ck) { e = k; cue = ck; } }
        const int loc = wgid - cue, ne = rd(e), r0 = rd(8 + e);
        u.pm = r0 + loc % ne; u.pn = e * npn + loc / ne; return true;
    }
    __device__ __forceinline__ void a_ready(const Unit&) const {}
    __device__ __forceinline__ void done(const Unit&) const {}
};

struct SegOrder {
    int nM, nN, nseg, G, c;
    __device__ __forceinline__ bool next(int i, Unit& u) const {
        const int nwg = nM * nN; const long L = (long)i * G + c; if (L >= (long)nseg * nwg) return false;
        const int s = (int)(L / nwg); int wgid = (int)(L % nwg); { const int q = nwg / NXCD, r = nwg % NXCD, xcd = wgid % NXCD, off = wgid / NXCD; wgid = (xcd < r ? xcd * (q + 1) : r * (q + 1) + (xcd - r) * q) + off; }
        const int nig = WGM * nN, gid = wgid / nig, fm = gid * WGM, gsz = (nM - fm) < WGM ? (nM - fm) : WGM;
        u.pm = s * nM + fm + ((wgid % nig) % gsz); u.pn = s * nN + (wgid % nig) / gsz; return true;
    }
    __device__ __forceinline__ void a_ready(const Unit&) const {}
    __device__ __forceinline__ void done(const Unit&) const {}
};
template <class Epi, class Sched, bool ALIGN_EPI = false, bool SP2 = false, bool F8 = false>
__device__ __forceinline__ void gemm_phase(PG8_LAS unsigned char* lds, const Gemm g, const Sched& S, const Epi& E) {
    int tid_ = threadIdx.x; asm volatile("" : "+v"(tid_)); const int tid = tid_, wid = __builtin_amdgcn_readfirstlane(tid >> 6), lane = tid & 63, wr = wid >> 2, wc = wid & 3, fr = lane & 15, fq = lane >> 4;
    const int K = g.K, nt = K / BK; typedef int i32x8 __attribute__((ext_vector_type(8))); int f8scale_ = 0x7f7f7f7f; asm volatile("" : "+v"(f8scale_));
    unsigned voffA[2], voffB[2];
#pragma unroll
    for (int i = 0; i < 2; ++i) { int R, C; stage_rc(tid * 16 + i * 8192, R, C); const int Rb = Epi::PERM ? ((R & ~31) + perm32(R & 31)) : R;
        voffA[i] = (unsigned)(R * K + C) * 2u; voffB[i] = (unsigned)(Rb * K + C) * 2u; }
    const size_t kstep = (size_t)(BK * 2);
    const size_t hstep = (size_t)HALF * K * 2;
    const size_t tstep = 2 * hstep;
    const unsigned ldsw = (unsigned)wid * 1024u;
    const int aoff = lds_byte(wr * 64 + fr, fq * 8), boff = lds_byte(wc * 32 + fr, fq * 8);
#define PG8_SA(b, h) (((b) * 2 + (h)) * HTB)
#define PG8_SB(b, h) ((4 + (b) * 2 + (h)) * HTB)
#define PG8_STAGE(bufoff, gbase, voff) do { _Pragma("unroll") for (int _i = 0; _i < 2; ++_i) \
        __builtin_amdgcn_global_load_lds((const unsigned*)((const char*)(gbase) + (voff)[_i]), (PG8_LAS unsigned*)(lds + (bufoff) + ldsw + _i * 8192), 16, 0, 0); } while (0)
#define PG8_LDA(dst, b, h) do { _Pragma("unroll") for (int m = 0; m < 4; ++m) _Pragma("unroll") for (int k = 0; k < 2; ++k) dst[m][k] = *(const PG8_LAS bf16x8*)(lds + PG8_SA(b, h) + aoff + m * 2048 + k * 1024); } while (0)
#define PG8_LDB(dst, b, h) do { _Pragma("unroll") for (int n = 0; n < 2; ++n) _Pragma("unroll") for (int k = 0; k < 2; ++k) dst[n][k] = *(const PG8_LAS bf16x8*)(lds + PG8_SB(b, h) + boff + n * 2048 + k * 1024); } while (0)
#define PG8_MMA(ai, bj, At, Bt) do { __builtin_amdgcn_s_setprio(1); \
        if constexpr (F8) { _Pragma("unroll") for (int m = 0; m < 4; ++m) _Pragma("unroll") for (int n = 0; n < 2; ++n) { \
            const i32x4 b0_ = __builtin_bit_cast(i32x4, Bt[n][0]), b1_ = __builtin_bit_cast(i32x4, Bt[n][1]), a0_ = __builtin_bit_cast(i32x4, At[m][0]), a1_ = __builtin_bit_cast(i32x4, At[m][1]); \
            const i32x8 bb_ = __builtin_shufflevector(b0_, b1_, 0, 1, 2, 3, 4, 5, 6, 7), aa_ = __builtin_shufflevector(a0_, a1_, 0, 1, 2, 3, 4, 5, 6, 7); \
            asm volatile("v_mfma_scale_f32_16x16x128_f8f6f4 %0, %1, %2, %0, %3, %3 op_sel_hi:[0,0,0]" : "+v"(acc[ai][bj][m][n]) : "v"(bb_), "v"(aa_), "v"(f8scale_)); } } \
        else { _Pragma("unroll") for (int m = 0; m < 4; ++m) _Pragma("unroll") for (int n = 0; n < 2; ++n) _Pragma("unroll") for (int k = 0; k < 2; ++k) \
        acc[ai][bj][m][n] = __builtin_amdgcn_mfma_f32_16x16x32_bf16(Bt[n][k], At[m][k], acc[ai][bj][m][n], 0, 0, 0); } __builtin_amdgcn_s_setprio(0); } while (0)
#define PG8_WAIT_V(n) asm volatile("s_waitcnt vmcnt(" #n ")" ::: "memory")
#define PG8_WAIT_L(n) asm volatile("s_waitcnt lgkmcnt(" #n ")" ::: "memory")
#define PG8_BAR __builtin_amdgcn_s_barrier()
#define PG8_SCHED __builtin_amdgcn_sched_barrier(0)
    Unit cur, nxt; int ui = 0;
    if (!S.next(0, cur)) return;
    f32x4 acc[2][2][4][2];
#pragma unroll
    for (int a = 0; a < 2; ++a)
#pragma unroll
        for (int b = 0; b < 2; ++b)
#pragma unroll
            for (int m = 0; m < 4; ++m)
#pragma unroll
                for (int n = 0; n < 2; ++n) acc[a][b][m][n] = (f32x4){0.f, 0.f, 0.f, 0.f};
    bf16x8 At[4][2], B0[2][2], B1[2][2];
    const char* cA = (const char*)g.A + (size_t)cur.pm * tstep; const char* cB = (const char*)g.Bt + (size_t)cur.pn * tstep;
    S.a_ready(cur);
    if constexpr (SP2) {
        PG8_STAGE(PG8_SB(0, 0), cB, voffB); PG8_STAGE(PG8_SB(0, 1), cB + hstep, voffB); PG8_STAGE(PG8_SA(0, 0), cA, voffA); PG8_STAGE(PG8_SA(0, 1), cA + hstep, voffA);
        if (wr == 1) PG8_BAR;
        PG8_WAIT_V(2); PG8_BAR;
        PG8_STAGE(PG8_SB(1, 0), cB + kstep, voffB); PG8_STAGE(PG8_SA(1, 0), cA + kstep, voffA); PG8_STAGE(PG8_SB(1, 1), cB + hstep + kstep, voffB);
        PG8_WAIT_V(6); PG8_BAR;
    } else {
        PG8_STAGE(PG8_SB(0, 0), cB, voffB); PG8_STAGE(PG8_SA(0, 0), cA, voffA); PG8_STAGE(PG8_SB(0, 1), cB + hstep, voffB); PG8_STAGE(PG8_SA(0, 1), cA + hstep, voffA);
        if (wr == 1) PG8_BAR;
        PG8_WAIT_V(4); PG8_BAR;
        PG8_STAGE(PG8_SB(1, 0), cB + kstep, voffB); PG8_STAGE(PG8_SA(1, 0), cA + kstep, voffA); PG8_STAGE(PG8_SB(1, 1), cB + hstep + kstep, voffB);
        PG8_WAIT_V(6); PG8_BAR;
    }
    for (;;) {
        const bool has_next = S.next(ui + 1, nxt);
        const char* nA = has_next ? (const char*)g.A + (size_t)nxt.pm * tstep : cA; const char* nB = has_next ? (const char*)g.Bt + (size_t)nxt.pn * tstep : cB;
        for (int t = 0; t < nt; t += 2) {
            const bool last = (t == nt - 2);
            const char* a1 = cA + (size_t)(t + 1) * kstep;
            const char* a2 = last ? nA : cA + (size_t)(t + 2) * kstep; const char* b2 = last ? nB : cB + (size_t)(t + 2) * kstep;
            const char* a3 = a2 + kstep; const char* b3 = b2 + kstep;
            if (last && has_next) S.a_ready(nxt);
            if constexpr (Epi::HOOK) { if (t == E.hk0 || t == E.hk1) E.hook(acc, cur, t == E.hk0 ? 0 : 1, wr, wc, fr, fq); }
            if constexpr (SP2) {
            PG8_LDB(B0, 0, 0); PG8_LDB(B1, 0, 1); PG8_SCHED; PG8_LDA(At, 0, 0); PG8_STAGE(PG8_SA(1, 1), a1 + hstep, voffA);
            PG8_WAIT_V(8); PG8_WAIT_L(0); PG8_BAR; PG8_MMA(0, 0, At, B0); PG8_MMA(0, 1, At, B1); PG8_BAR; PG8_SCHED;
            PG8_LDA(At, 0, 1); PG8_STAGE(PG8_SB(0, 0), b2, voffB); PG8_STAGE(PG8_SB(0, 1), b2 + hstep, voffB); PG8_STAGE(PG8_SA(0, 0), a2, voffA);
            PG8_WAIT_V(8); PG8_WAIT_L(0); PG8_BAR; PG8_MMA(1, 0, At, B0); PG8_MMA(1, 1, At, B1); PG8_BAR; PG8_SCHED;
            PG8_LDB(B0, 1, 0); PG8_LDB(B1, 1, 1); PG8_SCHED; PG8_LDA(At, 1, 0); PG8_STAGE(PG8_SA(0, 1), a2 + hstep, voffA);
            PG8_WAIT_V(8); PG8_WAIT_L(0); PG8_BAR; PG8_MMA(0, 0, At, B0); PG8_MMA(0, 1, At, B1); PG8_BAR; PG8_SCHED;
            PG8_LDA(At, 1, 1); PG8_STAGE(PG8_SB(1, 0), b3, voffB); PG8_STAGE(PG8_SB(1, 1), b3 + hstep, voffB); PG8_STAGE(PG8_SA(1, 0), a3, voffA);
            PG8_WAIT_V(8); PG8_WAIT_L(0); PG8_BAR; PG8_MMA(1, 0, At, B0); PG8_MMA(1, 1, At, B1); PG8_BAR; PG8_SCHED;
            } else {
            PG8_LDB(B0, 0, 0); PG8_SCHED; PG8_LDA(At, 0, 0); PG8_STAGE(PG8_SA(1, 1), a1 + hstep, voffA);
            PG8_WAIT_L(8); PG8_BAR; PG8_WAIT_L(0); PG8_MMA(0, 0, At, B0); PG8_BAR; PG8_SCHED;
            PG8_LDB(B1, 0, 1); PG8_STAGE(PG8_SB(0, 0), b2, voffB);
            PG8_BAR; PG8_WAIT_L(0); PG8_MMA(0, 1, At, B1); PG8_BAR;
            PG8_LDA(At, 0, 1); PG8_STAGE(PG8_SA(0, 0), a2, voffA);
            PG8_BAR; PG8_WAIT_L(0); PG8_MMA(1, 0, At, B0); PG8_BAR; PG8_SCHED;
            PG8_STAGE(PG8_SB(0, 1), b2 + hstep, voffB);
            PG8_WAIT_V(6); PG8_BAR; PG8_MMA(1, 1, At, B1); PG8_BAR;
            PG8_LDB(B0, 1, 0); PG8_SCHED; PG8_LDA(At, 1, 0); PG8_STAGE(PG8_SA(0, 1), a2 + hstep, voffA);
            PG8_WAIT_L(8); PG8_BAR; PG8_WAIT_L(0); PG8_MMA(0, 0, At, B0); PG8_BAR; PG8_SCHED;
            PG8_LDB(B1, 1, 1); PG8_STAGE(PG8_SB(1, 0), b3, voffB);
            PG8_BAR; PG8_WAIT_L(0); PG8_MMA(0, 1, At, B1); PG8_BAR;
            PG8_LDA(At, 1, 1); PG8_STAGE(PG8_SA(1, 0), a3, voffA);
            PG8_BAR; PG8_WAIT_L(0); PG8_MMA(1, 0, At, B0); PG8_BAR; PG8_SCHED;
            PG8_STAGE(PG8_SB(1, 1), b3 + hstep, voffB);
            PG8_WAIT_V(6); PG8_BAR; PG8_MMA(1, 1, At, B1); PG8_BAR;
            }
        }
        if constexpr (ALIGN_EPI) { if (wr == 0) PG8_BAR; }
        if constexpr (F8) asm volatile("s_nop 15\n\ts_nop 15" ::: "memory");
        if constexpr (!Epi::AFTER_DRAIN) { E(acc, cur, wr, wc, fr, fq); S.done(cur); }
        if (!has_next) break;
#pragma unroll
        for (int a = 0; a < 2; ++a)
#pragma unroll
            for (int b = 0; b < 2; ++b)
#pragma unroll
                for (int m = 0; m < 4; ++m)
#pragma unroll
                    for (int n = 0; n < 2; ++n) acc[a][b][m][n] = (f32x4){0.f, 0.f, 0.f, 0.f};
        cur = nxt; cA = nA; cB = nB; ++ui;
        if constexpr (ALIGN_EPI) { if (wr == 1) PG8_BAR; }
    }
    PG8_WAIT_V(0);
    if constexpr (!ALIGN_EPI) { if (wr == 0) PG8_BAR; }
    PG8_BAR;
    if constexpr (Epi::AFTER_DRAIN) { E.fused(acc, cur, wr, wc, fr, fq, lds, wid, lane); S.done(cur); }
#undef PG8_SA
#undef PG8_SB
#undef PG8_STAGE
#undef PG8_LDA
#undef PG8_LDB
#undef PG8_MMA
#undef PG8_WAIT_V
#undef PG8_WAIT_L
#undef PG8_BAR
#undef PG8_SCHED
}
}
#ifndef MK_ONE_LAUNCH
#define MK_ONE_LAUNCH 0
#endif
constexpr int NWAVES = 8;
constexpr int NB = 4, SEQ = 2048, T = NB * SEQ, D = 2048, MEML = 256, MEMR = NB * MEML;
constexpr int NINP = 17664;
constexpr int DFF = 5632, EFF = 7168, NEXP = 8, MAXSLOT = 18432;
constexpr float EPS = 1e-6f;
constexpr int NPL = 15, NPH = 2 + 2 * NPL;

constexpr size_t MiB = 1u << 20;
constexpr size_t WS_CTL = 0, CTL_BYTES = 1 * MiB;
constexpr size_t WS_WIN = WS_CTL + CTL_BYTES;
constexpr size_t WS_WBR = WS_WIN + 2 * 69 * MiB;
constexpr size_t WS_WOUT = WS_WBR + 2 * 12 * MiB;
constexpr size_t WS_WQ = WS_WOUT + 2 * 8 * MiB;
constexpr size_t WS_WKV = WS_WQ + 2 * 2 * MiB;
constexpr size_t WS_WO = WS_WKV + 2 * 4 * MiB;
constexpr size_t WS_WGU = WS_WO + 2 * 2 * MiB;
constexpr size_t WS_WDN = WS_WGU + 44 * MiB;
constexpr size_t WS_WEGU = WS_WDN + 22 * MiB;
constexpr size_t WS_WEDN = WS_WEGU + 448 * MiB;
constexpr size_t WS_XRES = WS_WEDN + 224 * MiB;
constexpr size_t WS_H = WS_XRES + 64 * MiB;
constexpr size_t WS_RQ = WS_H + 32 * MiB, WS_RK = WS_RQ + 16 * MiB, WS_RV = WS_RK + 16 * MiB, WS_RG = WS_RV + 16 * MiB;
constexpr size_t WS_BQKV = WS_RG + 16 * MiB;
constexpr size_t WS_BZ = WS_BQKV + 48 * MiB;
constexpr size_t WS_BBA = WS_BZ + 16 * MiB;
constexpr size_t WS_CQ = WS_BBA + 1 * MiB, WS_CK = WS_CQ + 16 * MiB, WS_CVT = WS_CK + 16 * MiB;
constexpr size_t WS_GATES = WS_CVT + 16 * MiB;
constexpr size_t WS_GQ = WS_GATES + 96 * MiB, WS_GK = WS_GQ + 16 * MiB, WS_GV = WS_GK + 16 * MiB;
constexpr size_t WS_GG = WS_GV + 16 * MiB, WS_GB = WS_GG + 1 * MiB;
constexpr size_t WS_OA = WS_GB + 1 * MiB, WS_OB = WS_OA + 32 * MiB;
constexpr size_t WS_O12 = WS_OB + 32 * MiB;
constexpr size_t WS_OCAT = WS_O12 + 64 * MiB;
constexpr size_t WS_MERGE = WS_OCAT + 48 * MiB;
constexpr size_t WS_MERGEB = WS_MERGE + 64 * MiB;
constexpr size_t WS_MEMN = WS_MERGEB + 32 * MiB;
constexpr size_t WS_KX = WS_MEMN + 8 * MiB;
constexpr size_t WS_VXT = WS_KX + 2 * MiB;
constexpr size_t WS_QX = WS_VXT + 2 * MiB;
constexpr size_t WS_OX = WS_QX + 8 * MiB;
constexpr size_t WS_ACT = WS_OX + 8 * MiB;
constexpr size_t WS_HG = WS_ACT + 88 * MiB;
constexpr size_t WS_EACT = WS_HG + 72 * MiB;
constexpr size_t WS_Y = WS_EACT + 252 * MiB;
constexpr size_t WS_ROUTE = WS_Y + 144 * MiB;
constexpr size_t WS_GCH = WS_ROUTE + 1 * MiB;
constexpr size_t WS_GL = WS_GCH + 88 * MiB;
constexpr size_t WS_H8 = WS_GL + 1 * MiB;
constexpr size_t WS_WIN8 = WS_H8 + 16 * MiB;
constexpr size_t WS_END = WS_WIN8 + 32 * MiB;
constexpr int CW_CNT = 64;
constexpr int CW_BAR = 4096;

constexpr int RING_BYTES = 131072, MISC_OFF = RING_BYTES + 320, LDS_BYTES = 147456;

#define GAS __attribute__((address_space(1)))
#define LAS __attribute__((address_space(3)))
#define DI __device__ __forceinline__
typedef unsigned short bf16;
typedef unsigned v4u __attribute__((ext_vector_type(4)));
typedef unsigned v2u __attribute__((ext_vector_type(2)));
typedef float f32x4 __attribute__((ext_vector_type(4)));
typedef short bf16x8 __attribute__((ext_vector_type(8)));
typedef short s16x4 __attribute__((ext_vector_type(4)));
DI float bf2f(unsigned v) { return __uint_as_float(v << 16); }
DI unsigned f2bf(float f) { unsigned u = __builtin_bit_cast(unsigned, f); return (u + 0x7fffu + ((u >> 16) & 1u)) >> 16; }
typedef float f32x2_t __attribute__((ext_vector_type(2))); typedef __bf16 bf16x2_t __attribute__((ext_vector_type(2)));
DI unsigned pk2(float lo, float hi) { const f32x2_t v = {lo, hi}; const bf16x2_t b = __builtin_convertvector(v, bf16x2_t); return __builtin_bit_cast(unsigned, b); }
DI float wave_sum(float v) {
#pragma unroll
    for (int o = 1; o < 64; o <<= 1) v += __shfl_xor(v, o);
    return v;
}

#define XB_TMO      128
#define XB_XCNT(j)  (256  + 64 * (j))
#define XB_XSUB(j)  (1280 + 64 * (j))
#define XB_XGEN(j)  (2304 + 64 * (j))
#define XB_TOP      3328
#define XB_TOPGEN   3392
#define XCD_BAR_WORDS 3456
#define XB_SPIN_CAP (1u << 18)

__device__ __forceinline__ unsigned xb_ld(unsigned* p)              { return __hip_atomic_load(p, __ATOMIC_RELAXED, __HIP_MEMORY_SCOPE_AGENT); }
__device__ __forceinline__ unsigned xb_add(unsigned* p, unsigned v) { return __hip_atomic_fetch_add(p, v, __ATOMIC_RELAXED, __HIP_MEMORY_SCOPE_AGENT); }
__device__ __forceinline__ unsigned xb_xcc_id() { return (unsigned)__builtin_amdgcn_s_getreg((3 << 11) | 20) & 0xFu; }
#define XB_SPIN(cond, bar) do { unsigned _sp = 0; while (cond) { __builtin_amdgcn_s_sleep(1); \
    if ((++_sp & 255u) == 0u) { if (xb_ld(&(bar)[XB_TMO])) break; if (_sp > XB_SPIN_CAP) { atomicAdd(&(bar)[XB_TMO], 1u); break; } } } } while (0)

struct XcdBarrier {
    unsigned* bar; unsigned x;
    volatile LAS unsigned* st;
};

__device__ __forceinline__ XcdBarrier xcd_barrier_post(unsigned* bar, volatile LAS unsigned* st) {
    XcdBarrier b; b.bar = bar; b.x = xb_xcc_id(); b.st = st;
    if (threadIdx.x == 0) (void)xb_add(&bar[XB_XCNT(b.x)], 1u);
    return b;
}
__device__ __forceinline__ void xcd_barrier_complete(unsigned* bar, unsigned x, unsigned& nloc, unsigned& nx) {
    const unsigned G = gridDim.x * gridDim.y * gridDim.z;
    unsigned sum, cnt, mine, sp = 0u;
    for (;;) {
        sum = 0u; cnt = 0u; mine = 0u;
#pragma unroll
        for (unsigned j = 0; j < 16; ++j) { const unsigned c = xb_ld(&bar[XB_XCNT(j)]); sum += c; cnt += (c > 0u) ? 1u : 0u; mine = (j == x) ? c : mine; }
        if (sum == G) break;
        __builtin_amdgcn_s_sleep(1);
        if ((++sp & 255u) == 0u) { if (xb_ld(&bar[XB_TMO])) break; if (sp > XB_SPIN_CAP) { atomicAdd(&bar[XB_TMO], 1u); break; } }
    }
    nloc = mine > 0u ? mine : 1u; nx = cnt > 0u ? cnt : 1u;
}

__device__ __forceinline__ void xcd_barrier(const XcdBarrier& b) {
    asm volatile("s_waitcnt vmcnt(0)" ::: "memory");
    __syncthreads();
    if (threadIdx.x == 0) {
        unsigned* bar = b.bar;
        __builtin_amdgcn_s_waitcnt(0);
        unsigned nloc = b.st[0], nx = b.st[1];
        if (nloc == 0u) { xcd_barrier_complete(bar, b.x, nloc, nx); b.st[0] = nloc; b.st[1] = nx; }
        const unsigned old = xb_add(&bar[XB_XSUB(b.x)], 1u);
        const unsigned gen = old / nloc;
        if (old + 1u == (gen + 1u) * nloc) {
            __builtin_amdgcn_fence(__ATOMIC_RELEASE, "agent");
            asm volatile("s_waitcnt vmcnt(0)" ::: "memory");
            const unsigned og = xb_add(&bar[XB_TOP], 1u);
            const unsigned tg = og / nx;
            if (og + 1u == (tg + 1u) * nx) xb_add(&bar[XB_TOPGEN], 1u);
            else XB_SPIN(xb_ld(&bar[XB_TOPGEN]) == tg, bar);
            __builtin_amdgcn_fence(__ATOMIC_ACQUIRE, "agent");
            xb_add(&bar[XB_XGEN(b.x)], 1u);
            asm volatile("s_waitcnt vmcnt(0)" ::: "memory");
        } else {
            XB_SPIN(xb_ld(&bar[XB_XGEN(b.x)]) == gen, bar);
            __builtin_amdgcn_fence(__ATOMIC_ACQUIRE, "agent");
            asm volatile("s_waitcnt vmcnt(0)" ::: "memory");
        }
    }
    __syncthreads();
}

struct Args { const void* in[24]; float* out; unsigned char* ws; int ph_lo, ph_hi; };

struct Frame {
    LAS unsigned char* lds;
    int tid, lane, wave, G, vcu, gw, NGW;
};

DI void conv_job(const Frame& F, const float* W, int K, int Nsrc, bf16* WT, int Ndst, int mode, int Fgu) {
    LAS unsigned* scr = (LAS unsigned*)(F.lds + F.wave * 8704);
    const int nkb = K / 64, nnb = Ndst / 64, items = nkb * nnb, lane = F.lane;
    for (int it = F.gw; it < items; it += F.NGW) {
        const int nb = it / nkb, kb = it % nkb, k0 = kb * 64, n0 = nb * 64, n = n0 + lane;
        int ns;
        if (mode == 0) ns = n;
        else if (mode == 1) ns = n < 8192 ? n : (n < 17408 ? n + 16 : (n < 17424 ? n - 17408 + 8192 : -1));
        else { const int pn = n >> 8, half = (n >> 7) & 1, j = n & 127; ns = half * Fgu + 128 * pn + j; }
        const float* src = W + (size_t)k0 * Nsrc + (ns < 0 ? 0 : ns);
#pragma unroll 8
        for (int i = 0; i < 32; ++i) { float a = src[(size_t)(2 * i) * Nsrc], b = src[(size_t)(2 * i + 1) * Nsrc]; if (ns < 0) { a = 0.f; b = 0.f; } scr[lane * 33 + i] = pk2(a, b); }
        asm volatile("s_waitcnt lgkmcnt(0)" ::: "memory");
#pragma unroll
        for (int j = 0; j < 8; ++j) { const int nn = (lane >> 3) + 8 * j, kq = lane & 7; v4u o; const LAS unsigned* s = scr + nn * 33 + 4 * kq; o.x = s[0]; o.y = s[1]; o.z = s[2]; o.w = s[3];
            *(v4u*)(WT + (size_t)(n0 + nn) * K + k0 + 8 * kq) = o; }
        asm volatile("s_waitcnt lgkmcnt(0)" ::: "memory");
    }
}

DI void conv_job_f8(const Frame& F, const float* W, int K, int Nsrc, unsigned char* WT, int Ndst, int mode, int Fgu, float scale) {
    LAS unsigned* scr = (LAS unsigned*)(F.lds + F.wave * 8704);
    const int nkb = K / 128, nnb = Ndst / 64, items = nkb * nnb, lane = F.lane;
    for (int it = F.gw; it < items; it += F.NGW) {
        const int nb = it / nkb, kb = it % nkb, k0 = kb * 128, n0 = nb * 64, n = n0 + lane;
        int ns;
        if (mode == 0) ns = n; else { const int pn = n >> 8, half = (n >> 7) & 1, j = n & 127; ns = half * Fgu + 128 * pn + j; }
        const float* src = W + (size_t)k0 * Nsrc + ns;
#pragma unroll 4
        for (int i = 0; i < 32; ++i) { const float a = src[(size_t)(4 * i) * Nsrc], b = src[(size_t)(4 * i + 1) * Nsrc], c = src[(size_t)(4 * i + 2) * Nsrc], d = src[(size_t)(4 * i + 3) * Nsrc]; scr[lane * 33 + i] = pg8::pk4_fp8(a * scale, b * scale, c * scale, d * scale); }
        asm volatile("s_waitcnt lgkmcnt(0)" ::: "memory");
#pragma unroll
        for (int j = 0; j < 8; ++j) { const int nn = (lane >> 3) + 8 * j, kq = lane & 7; v4u o; const LAS unsigned* s = scr + nn * 33 + 4 * kq; o.x = s[0]; o.y = s[1]; o.z = s[2]; o.w = s[3];
            *(v4u*)(WT + (size_t)(n0 + nn) * K + k0 + 16 * kq) = o; }
        asm volatile("s_waitcnt lgkmcnt(0)" ::: "memory");
    }
}

template <bool F8>
DI void conv_wg(const Frame& F, const float* W, int K, int Nsrc, void* WTv, int Ndst, int mode, int Fgu, float scale) {
    constexpr int KI = F8 ? 256 : 128;
    LAS unsigned* scr = (LAS unsigned*)F.lds;
    const int nkb = K / KI, items = nkb * (Ndst / 256), lane = F.lane, w = F.wave, tid = F.tid;
    for (int it = F.vcu; it < items; it += F.G) {
        const int nb = it / nkb, kb = it % nkb, k0 = kb * KI, n0 = nb * 256, n = n0 + 4 * lane;
        int ns;
        if (mode == 0) ns = n;
        else if (mode == 1 || mode == 3 || mode == 4) {
            int ng = n;
            if (mode == 3) { const int lp = n >> 8; ng = ((lp < 44 ? lp : 68) << 8) + (n & 255); }
            if (mode == 4) ng = n + 44 * 256;
            ns = ng < 8192 ? ng : (ng < 17408 ? ng + 16 : (ng < 17424 ? ng - 17408 + 8192 : -1)); }
        else { const int pn = n >> 8, half = (n >> 7) & 1, j = n & 127; ns = half * Fgu + 128 * pn + j; }
        __syncthreads();
#pragma unroll
        for (int h = 0; h < (F8 ? 2 : 1); ++h) {
            const float* src = W + (size_t)(k0 + (F8 ? 32 : 16) * w + 16 * h) * Nsrc + (ns < 0 ? 0 : ns);
            f32x4 a[16];
#pragma unroll
            for (int i = 0; i < 16; ++i) a[i] = __builtin_nontemporal_load((const f32x4*)(src + (size_t)i * Nsrc));
            if (ns < 0) {
#pragma unroll
                for (int i = 0; i < 16; ++i) a[i] = (f32x4){0.f, 0.f, 0.f, 0.f}; }
#pragma unroll
            for (int c = 0; c < 4; ++c) {
                if (F8) {
#pragma unroll
                    for (int q = 0; q < 4; ++q) scr[(4 * lane + c) * 65 + 8 * w + 4 * h + q] = pg8::pk4_fp8(a[4 * q][c] * scale, a[4 * q + 1][c] * scale, a[4 * q + 2][c] * scale, a[4 * q + 3][c] * scale);
                } else {
#pragma unroll
                    for (int p = 0; p < 8; ++p) scr[(4 * lane + c) * 65 + 8 * w + p] = pk2(a[2 * p][c], a[2 * p + 1][c]); } }
        }
        __syncthreads();
#pragma unroll
        for (int ps = 0; ps < 8; ++ps) { const int row = ps * 32 + (tid >> 4), kq = tid & 15; const LAS unsigned* s = scr + row * 65 + 4 * kq; v4u o; o.x = s[0]; o.y = s[1]; o.z = s[2]; o.w = s[3];
            __builtin_nontemporal_store(o, (v4u*)((unsigned char*)WTv + ((size_t)(n0 + row) * K + k0) * (F8 ? 1 : 2) + 16 * kq)); }
    }
}

DI void rms_row(const float* xrow, const float* w, bf16* orow, int lane, unsigned char* o8 = nullptr) {
    f32x4 v[8]; float ss = 0.f;
#pragma unroll
    for (int j = 0; j < 8; ++j) { v[j] = *(const f32x4*)(xrow + 4 * (lane + 64 * j)); ss += (v[j][0] * v[j][0] + v[j][1] * v[j][1]) + (v[j][2] * v[j][2] + v[j][3] * v[j][3]); }
    const float rstd = rsqrtf(wave_sum(ss) * (1.f / D) + EPS);
#pragma unroll
    for (int j = 0; j < 8; ++j) { const f32x4 ww = *(const f32x4*)(w + 4 * (lane + 64 * j)); v2u o; o.x = pk2(v[j][0] * rstd * ww[0], v[j][1] * rstd * ww[1]); o.y = pk2(v[j][2] * rstd * ww[2], v[j][3] * rstd * ww[3]);
        *(v2u*)(orow + 4 * (lane + 64 * j)) = o;
        if (o8) *(unsigned*)(o8 + 4 * (lane + 64 * j)) = pg8::pk4_fp8(v[j][0] * rstd * ww[0], v[j][1] * rstd * ww[1], v[j][2] * rstd * ww[2], v[j][3] * rstd * ww[3]); }
}

template <bool GDN>
DI void seq_mixer(const Frame& F, int bh, const bf16* Q, const bf16* K, const bf16* V, const float* Gg, const float* Gb, float* OUT, float gamma) {
    LAS float* qs = (LAS float*)F.lds; LAS float* ks = qs + 32 * 128; LAS float* vs = ks + 32 * 128; LAS float* red = vs + 32 * 128; LAS float* gs = red + 2 * 4 * 128; LAS float* bs = gs + 32;
    const int tid = F.tid, v = tid & 127, kg = tid >> 7, b = bh >> 3, h = bh & 7;
    const size_t hb = (size_t)bh * SEQ * 128;
    float Sr[32];
#pragma unroll
    for (int i = 0; i < 32; ++i) Sr[i] = 0.f;
    for (int c0 = 0; c0 < SEQ; c0 += 32) {
        __syncthreads();
#pragma unroll
        for (int j = 0; j < 4; ++j) { const int idx = tid + 512 * j, tok = idx >> 6, d = (idx & 63) * 2; const size_t go = hb + (size_t)(c0 + tok) * 128 + d;
            const unsigned a = *(const unsigned*)(Q + go), bb = *(const unsigned*)(K + go), cc = *(const unsigned*)(V + go);
            qs[tok * 128 + d] = bf2f(a & 0xffffu); qs[tok * 128 + d + 1] = __uint_as_float(a & 0xffff0000u);
            ks[tok * 128 + d] = bf2f(bb & 0xffffu); ks[tok * 128 + d + 1] = __uint_as_float(bb & 0xffff0000u);
            vs[tok * 128 + d] = bf2f(cc & 0xffffu); vs[tok * 128 + d + 1] = __uint_as_float(cc & 0xffff0000u); }
        if (GDN && tid < 32) { gs[tid] = Gg[(size_t)bh * SEQ + c0 + tid]; bs[tid] = Gb[(size_t)bh * SEQ + c0 + tid]; }
        __syncthreads();
        for (int tt = 0; tt < 32; ++tt) {
            const LAS float* kt = ks + tt * 128 + kg * 32; const LAS float* qt = qs + tt * 128 + kg * 32;
            float po = 0.f;
            if (GDN) {
                const float a = __expf(gs[tt]); float p = 0.f;
#pragma unroll
                for (int i = 0; i < 32; ++i) { Sr[i] *= a; p += Sr[i] * kt[i]; }
                red[kg * 128 + v] = p; __syncthreads();
                const float kv = (red[v] + red[128 + v]) + (red[256 + v] + red[384 + v]);
                const float delta = bs[tt] * (vs[tt * 128 + v] - kv);
#pragma unroll
                for (int i = 0; i < 32; ++i) { Sr[i] += kt[i] * delta; po += Sr[i] * qt[i]; }
                red[512 + kg * 128 + v] = po; __syncthreads();
                if (kg == 0) OUT[((size_t)(b * SEQ + c0 + tt)) * 1024 + h * 128 + v] = (red[512 + v] + red[640 + v]) + (red[768 + v] + red[896 + v]);
            } else {
                const float vv = vs[tt * 128 + v]; LAS float* r = red + (tt & 1) * 512;
#pragma unroll
                for (int i = 0; i < 32; ++i) { Sr[i] = gamma * Sr[i] + kt[i] * vv; po += Sr[i] * qt[i]; }
                r[kg * 128 + v] = po; __syncthreads();
                if (kg == 0) OUT[((size_t)(b * SEQ + c0 + tt)) * 1024 + h * 128 + v] = (r[v] + r[128 + v]) + (r[256 + v] + r[384 + v]);
            }
        }
    }
    __syncthreads();
}

template <int DV, int KT, bool CAUSAL, bool OUT_BF16, bool DECAY>
DI void flash_item(const Frame& F, const bf16* Q, const bf16* Kh, const bf16* VT, int vpitch, int q0, int nkeys, float slope, float* OUTF, bf16* OUTB, int opitch) {
    constexpr int KP = 272, VP = KT * 2 + 16, NKC = KT / 32, NVC = DV * KT / 4096, VCH = KT / 8;
    LAS unsigned char* Kl = F.lds; LAS unsigned char* Vl = F.lds + KT * KP;
    int tid_ = F.tid; asm volatile("" : "+v"(tid_));
    const int tid = tid_, lane = tid & 63, w = F.wave, li = lane & 15, g = lane >> 4;
    const float SC = 0.08838834764831845f, L2E = 1.4426950408889634f;
    bf16x8 qf[4];
#pragma unroll
    for (int ks = 0; ks < 4; ++ks) qf[ks] = *(const bf16x8*)(Q + (size_t)(w * 16 + li) * 128 + ks * 32 + g * 8);
    f32x4 o[DV / 16];
#pragma unroll
    for (int c = 0; c < DV / 16; ++c) o[c] = (f32x4){0.f, 0.f, 0.f, 0.f};
    float m_run = -1e30f, l_run = 0.f;
    const int qpos = q0 + w * 16 + li;
    const int kend = CAUSAL ? (q0 + 128 < nkeys ? q0 + 128 : nkeys) : nkeys;
    v4u kr[NKC], vr[NVC];
#pragma unroll
    for (int i = 0; i < NKC; ++i) { const int c = tid + 512 * i; kr[i] = *(const v4u*)(Kh + (size_t)(c >> 4) * 128 + (c & 15) * 8); }
#pragma unroll
    for (int i = 0; i < NVC; ++i) { const int c = tid + 512 * i; vr[i] = *(const v4u*)(VT + (size_t)(c / VCH) * vpitch + (c % VCH) * 8); }
    for (int j0 = 0; j0 < kend; j0 += KT) {
        __syncthreads();
#pragma unroll
        for (int i = 0; i < NKC; ++i) { const int c = tid + 512 * i; *(LAS v4u*)(Kl + (c >> 4) * KP + (c & 15) * 16) = kr[i]; }
#pragma unroll
        for (int i = 0; i < NVC; ++i) { const int c = tid + 512 * i, cc = c % VCH, j = cc & 3; LAS unsigned char* rp = Vl + (c / VCH) * VP + (cc >> 2) * 64;
            *(LAS v2u*)(rp + (8 * ((2 * j) & 3) + 4 * (j >> 1)) * 2) = (v2u){vr[i].x, vr[i].y}; *(LAS v2u*)(rp + (8 * ((2 * j + 1) & 3) + 4 * (j >> 1)) * 2) = (v2u){vr[i].z, vr[i].w}; }
        __syncthreads();
        if (j0 + KT < kend) {
#pragma unroll
            for (int i = 0; i < NKC; ++i) { const int c = tid + 512 * i; kr[i] = *(const v4u*)(Kh + (size_t)(j0 + KT + (c >> 4)) * 128 + (c & 15) * 8); }
#pragma unroll
            for (int i = 0; i < NVC; ++i) { const int c = tid + 512 * i; vr[i] = *(const v4u*)(VT + (size_t)(c / VCH) * vpitch + j0 + KT + (c % VCH) * 8); }
        }
        f32x4 s[KT / 16];
        {
            bf16x8 ka[2][4];
#pragma unroll
            for (int ks = 0; ks < 4; ++ks) ka[0][ks] = *(const LAS bf16x8*)(Kl + li * KP + (ks * 32 + g * 8) * 2);
#pragma unroll
            for (int t = 0; t < KT / 16; ++t) {
                if (t + 1 < KT / 16) {
#pragma unroll
                    for (int ks = 0; ks < 4; ++ks) ka[(t + 1) & 1][ks] = *(const LAS bf16x8*)(Kl + ((t + 1) * 16 + li) * KP + (ks * 32 + g * 8) * 2); }
                __builtin_amdgcn_sched_barrier(0);
                s[t] = (f32x4){0.f, 0.f, 0.f, 0.f};
#pragma unroll
                for (int ks = 0; ks < 4; ++ks) s[t] = __builtin_amdgcn_mfma_f32_16x16x32_bf16(ka[t & 1][ks], qf[ks], s[t], 0, 0, 0);
                __builtin_amdgcn_sched_barrier(0);
            }
        }
        float alpha = 1.f;
        const bool diag = CAUSAL && (j0 + KT - 1 > q0 + w * 16);
        if (DECAY) {
            const float base = slope * (float)(qpos - j0 - 4 * g);
#pragma unroll
            for (int t = 0; t < KT / 16; ++t)
#pragma unroll
                for (int r = 0; r < 4; ++r) s[t][r] *= __builtin_amdgcn_exp2f(fmaf(slope, -(float)(16 * t + r), base));
            if (diag) {
#pragma unroll
                for (int t = 0; t < KT / 16; ++t)
#pragma unroll
                    for (int r = 0; r < 4; ++r) if (j0 + t * 16 + g * 4 + r > qpos) s[t][r] = 0.f; }
        } else {
        const float C2 = SC * L2E, sl2 = slope * L2E, base = -sl2 * (float)(qpos - j0 - 4 * g);
        float mx = -__builtin_inff();
#pragma unroll
        for (int t = 0; t < KT / 16; ++t)
#pragma unroll
            for (int r = 0; r < 4; ++r) s[t][r] = fmaf(s[t][r], C2, fmaf(sl2, (float)(16 * t + r), base));
        if (diag) {
#pragma unroll
            for (int t = 0; t < KT / 16; ++t)
#pragma unroll
                for (int r = 0; r < 4; ++r) if (j0 + t * 16 + g * 4 + r > qpos) s[t][r] = -__builtin_inff(); }
#pragma unroll
        for (int t = 0; t < KT / 16; ++t)
#pragma unroll
            for (int r = 0; r < 4; ++r) mx = fmaxf(mx, s[t][r]);
        mx = fmaxf(mx, __shfl_xor(mx, 16)); mx = fmaxf(mx, __shfl_xor(mx, 32));
        const float m_new = fmaxf(m_run, mx); alpha = __builtin_amdgcn_exp2f(m_run - m_new); m_run = m_new;
        float ps = 0.f;
#pragma unroll
        for (int t = 0; t < KT / 16; ++t)
#pragma unroll
            for (int r = 0; r < 4; ++r) { const float p = __builtin_amdgcn_exp2f(s[t][r] - m_new); s[t][r] = p; ps += p; }
        ps += __shfl_xor(ps, 16); ps += __shfl_xor(ps, 32);
        l_run = l_run * alpha + ps;
        }
        bf16x8 pf[KT / 32];
#pragma unroll
        for (int s2 = 0; s2 < KT / 32; ++s2) { v4u pw; pw.x = pk2(s[2 * s2][0], s[2 * s2][1]); pw.y = pk2(s[2 * s2][2], s[2 * s2][3]); pw.z = pk2(s[2 * s2 + 1][0], s[2 * s2 + 1][1]); pw.w = pk2(s[2 * s2 + 1][2], s[2 * s2 + 1][3]); pf[s2] = __builtin_bit_cast(bf16x8, pw); }
        float al[4];
#pragma unroll
        for (int r = 0; r < 4; ++r) al[r] = DECAY ? 1.f : __shfl(alpha, g * 4 + r);
        {
            v4u vb[2][KT / 32];
#pragma unroll
            for (int s2 = 0; s2 < KT / 32; ++s2) vb[0][s2] = *(const LAS v4u*)(Vl + li * VP + (s2 * 32 + g * 8) * 2);
#pragma unroll
            for (int c = 0; c < DV / 16; ++c) {
                if (c + 1 < DV / 16) {
#pragma unroll
                    for (int s2 = 0; s2 < KT / 32; ++s2) vb[(c + 1) & 1][s2] = *(const LAS v4u*)(Vl + ((c + 1) * 16 + li) * VP + (s2 * 32 + g * 8) * 2); }
                __builtin_amdgcn_sched_barrier(0);
                if (!DECAY) {
#pragma unroll
                    for (int r = 0; r < 4; ++r) o[c][r] *= al[r]; }
#pragma unroll
                for (int s2 = 0; s2 < KT / 32; ++s2) o[c] = __builtin_amdgcn_mfma_f32_16x16x32_bf16(pf[s2], __builtin_bit_cast(bf16x8, vb[c & 1][s2]), o[c], 0, 0, 0);
                __builtin_amdgcn_sched_barrier(0);
            }
        }
    }
    float il[4];
#pragma unroll
    for (int r = 0; r < 4; ++r) il[r] = DECAY ? 1.f : 1.0f / __shfl(l_run, g * 4 + r);
#pragma unroll
    for (int c = 0; c < DV / 16; ++c)
#pragma unroll
        for (int r = 0; r < 4; ++r) { const unsigned off = (unsigned)((w * 16 + g * 4 + r) * opitch + c * 16 + li); const float v = o[c][r] * il[r];
            if (OUT_BF16) OUTB[off] = (bf16)f2bf(v); else OUTF[off] = v; }
}

constexpr int GDN_CH_BYTES = 16384 + 16384 + 8192 + 16384 + 32768;
DI int perm32pos(int k) { return (k & ~31) | (((k >> 2) & 3) << 3) | (((k >> 4) & 1) << 2) | (k & 3); }
DI void gdn_prep_item(const Frame& F, int l, int bh, int n, const bf16* BQKV, const float* BBA, const float* cw, const float* a_log, const float* dt_bias, unsigned char* CH, float* GLp) {
    LAS unsigned char* Kl = F.lds; LAS unsigned char* Ql = F.lds + 17408; LAS unsigned char* KBT = F.lds + 34816; LAS unsigned char* VBT = F.lds + 53248; LAS unsigned char* KTl = F.lds + 71680;
    LAS float* Am = (LAS float*)(F.lds + 90112); LAS unsigned char* Tl = F.lds + 106752; LAS unsigned char* AQl = F.lds + 115968; LAS float* Gs = (LAS float*)(F.lds + 125184); LAS float* gs = Gs + 64; LAS float* bs = gs + 64;
    LAS float* CWl = Am;
    int tid_ = F.tid; asm volatile("" : "+v"(tid_));
    const int tid = tid_, lane = tid & 63, w = F.wave, li = lane & 15, g = lane >> 4;
    const int b = bh >> 3, h = bh & 7, i = tid >> 3, cg = tid & 7, c0 = cg * 16, s = n * 64 + i, t = b * SEQ + s;
    bf16* Wn = (bf16*)CH; bf16* QD = (bf16*)(CH + 16384); bf16* AQK = (bf16*)(CH + 32768); bf16* KT = (bf16*)(CH + 40960); float* UT = (float*)(CH + 57344);
    __syncthreads();
    for (int e = tid; e < 1536; e += 512) { const int part = e >> 9, j = (e >> 7) & 3, c = e & 127; CWl[e] = cw[j * 3072 + part * 1024 + h * 128 + c]; }
    if (cg == 0) { const float bbv = BBA[(size_t)t * 16 + h], bav = BBA[(size_t)t * 16 + 8 + h] + dt_bias[l * 8 + h]; const float sp = bav > 20.f ? bav : log1pf(__expf(bav)); bs[i] = pg8::fsigm(bbv); gs[i] = -__expf(a_log[l * 8 + h]) * sp; }
    __syncthreads();
    float qv[16], kv[16], vv[16];
#pragma unroll
    for (int part = 0; part < 3; ++part) {
        float a[16];
#pragma unroll
        for (int c = 0; c < 16; ++c) a[c] = 0.f;
#pragma unroll
        for (int j = 0; j < 4; ++j) { if (s - 3 + j >= 0) { const v4u x0 = *(const v4u*)(BQKV + (size_t)(t - 3 + j) * 3072 + part * 1024 + h * 128 + c0), x1 = *(const v4u*)(BQKV + (size_t)(t - 3 + j) * 3072 + part * 1024 + h * 128 + c0 + 8);
                const LAS float* wj = CWl + part * 512 + j * 128 + c0;
#pragma unroll
                for (int c = 0; c < 4; ++c) { a[2 * c] += bf2f(x0[c] & 0xffffu) * wj[2 * c]; a[2 * c + 1] += __uint_as_float(x0[c] & 0xffff0000u) * wj[2 * c + 1]; a[8 + 2 * c] += bf2f(x1[c] & 0xffffu) * wj[8 + 2 * c]; a[9 + 2 * c] += __uint_as_float(x1[c] & 0xffff0000u) * wj[9 + 2 * c]; } } }
#pragma unroll
        for (int c = 0; c < 16; ++c) { const float y = pg8::fsilu(a[c]); if (part == 0) qv[c] = y; else if (part == 1) kv[c] = y; else vv[c] = y; }
    }
    { float sq = 0.f, sk = 0.f;
#pragma unroll
      for (int c = 0; c < 16; ++c) { sq += qv[c] * qv[c]; sk += kv[c] * kv[c]; }
      sq += __shfl_xor(sq, 1); sq += __shfl_xor(sq, 2); sq += __shfl_xor(sq, 4); sk += __shfl_xor(sk, 1); sk += __shfl_xor(sk, 2); sk += __shfl_xor(sk, 4);
      const float qn = rsqrtf(sq + 1e-6f) * 0.08838834764831845f, kn = rsqrtf(sk + 1e-6f);
#pragma unroll
      for (int c = 0; c < 16; ++c) { qv[c] *= qn; kv[c] *= kn; } }
    if (w == 0) { float v = gs[lane];
#pragma unroll
        for (int o = 1; o < 64; o <<= 1) { const float u = __shfl_up(v, o); if (lane >= o) v += u; }
        Gs[lane] = v; }
    __syncthreads();
    {
        const float Gi = Gs[i], Gl = Gs[63], be = bs[i], eg = __expf(Gi), kbs = be * eg, kts = __expf(Gl - Gi);
        v4u pk, pq;
#pragma unroll
        for (int hh = 0; hh < 2; ++hh) {
            pk.x = pk2(kv[8 * hh + 0], kv[8 * hh + 1]); pk.y = pk2(kv[8 * hh + 2], kv[8 * hh + 3]); pk.z = pk2(kv[8 * hh + 4], kv[8 * hh + 5]); pk.w = pk2(kv[8 * hh + 6], kv[8 * hh + 7]);
            pq.x = pk2(qv[8 * hh + 0], qv[8 * hh + 1]); pq.y = pk2(qv[8 * hh + 2], qv[8 * hh + 3]); pq.z = pk2(qv[8 * hh + 4], qv[8 * hh + 5]); pq.w = pk2(qv[8 * hh + 6], qv[8 * hh + 7]);
            *(LAS v4u*)(Kl + i * 272 + (c0 + 8 * hh) * 2) = pk; *(LAS v4u*)(Ql + i * 272 + (c0 + 8 * hh) * 2) = pq; }
        const int ip = perm32pos(i);
#pragma unroll
        for (int c = 0; c < 16; ++c) { *(LAS bf16*)(KBT + (c0 + c) * 144 + i * 2) = (bf16)f2bf(kv[c] * kbs); *(LAS bf16*)(VBT + (c0 + c) * 144 + i * 2) = (bf16)f2bf(vv[c] * be); *(LAS bf16*)(KTl + (c0 + c) * 144 + ip * 2) = (bf16)f2bf(kv[c] * kts); }
#pragma unroll
        for (int gp = 0; gp < 4; ++gp) { v2u o; o.x = pk2(qv[4 * gp] * eg, qv[4 * gp + 1] * eg); o.y = pk2(qv[4 * gp + 2] * eg, qv[4 * gp + 3] * eg); *(v2u*)(QD + i * 128 + 32 * (cg >> 1) + 8 * gp + 4 * (cg & 1)) = o; }
        if (tid == 0) *GLp = __expf(Gl);
    }
    __syncthreads();
    {
        const int kind = w >> 2, rb = w & 3; LAS unsigned char* Al = kind ? Ql : Kl;
        bf16x8 af[4];
#pragma unroll
        for (int ks = 0; ks < 4; ++ks) af[ks] = *(const LAS bf16x8*)(Al + (rb * 16 + li) * 272 + (ks * 32 + g * 8) * 2);
#pragma unroll
        for (int cb = 0; cb < 4; ++cb) {
            f32x4 acc = (f32x4){0.f, 0.f, 0.f, 0.f};
            if (cb <= rb) {
#pragma unroll
                for (int ks = 0; ks < 4; ++ks) { const bf16x8 bfr = *(const LAS bf16x8*)(Kl + (cb * 16 + li) * 272 + (ks * 32 + g * 8) * 2); acc = __builtin_amdgcn_mfma_f32_16x16x32_bf16(af[ks], bfr, acc, 0, 0, 0); } }
            const int j = cb * 16 + li; const float Gj = Gs[j];
#pragma unroll
            for (int r = 0; r < 4; ++r) { const int ii = rb * 16 + 4 * g + r; const float Lij = __expf(Gs[ii] - Gj);
                if (kind == 0) Am[ii * 65 + j] = ii > j ? acc[r] * Lij * bs[ii] : 0.f;
                else *(LAS bf16*)(AQl + ii * 144 + perm32pos(j) * 2) = (bf16)f2bf(ii >= j ? acc[r] * Lij : 0.f); }
        }
    }
    __syncthreads();
    if (w == 0) {
        int zv = 0; asm volatile("" : "+v"(zv)); const LAS float* Amv = Am + zv;
        float Tr[64];
#pragma unroll
        for (int ii = 0; ii < 64; ++ii) {
            float a0 = (ii == lane) ? 1.f : 0.f, a1 = 0.f;
#pragma unroll
            for (int j = 0; j < ii; ++j) { if (j & 1) a1 -= Amv[ii * 65 + j] * Tr[j]; else a0 -= Amv[ii * 65 + j] * Tr[j]; }
            Tr[ii] = a0 + a1;
            *(LAS bf16*)(Tl + ii * 144 + lane * 2) = (bf16)f2bf(Tr[ii]);
            asm volatile("" ::: "memory");
        }
    }
    __syncthreads();
    {
        const int kind = w >> 2; LAS unsigned char* Xl = kind ? VBT : KBT;
#pragma unroll
        for (int q2 = 0; q2 < 2; ++q2) { const int rbk = 2 * (w & 3) + q2;
            bf16x8 af[2];
#pragma unroll
            for (int ks = 0; ks < 2; ++ks) af[ks] = *(const LAS bf16x8*)(Xl + (rbk * 16 + li) * 144 + (ks * 32 + g * 8) * 2);
#pragma unroll
            for (int cb = 0; cb < 4; ++cb) { f32x4 acc = (f32x4){0.f, 0.f, 0.f, 0.f};
#pragma unroll
                for (int ks = 0; ks < 2; ++ks) { const bf16x8 bfr = *(const LAS bf16x8*)(Tl + (cb * 16 + li) * 144 + (ks * 32 + g * 8) * 2); acc = __builtin_amdgcn_mfma_f32_16x16x32_bf16(af[ks], bfr, acc, 0, 0, 0); }
                const int ii = cb * 16 + li;
                if (kind == 0) { v2u o; o.x = pk2(-acc[0], -acc[1]); o.y = pk2(-acc[2], -acc[3]); *(v2u*)(Wn + ii * 128 + 32 * (rbk >> 1) + 8 * g + 4 * (rbk & 1)) = o; }
                else {
#pragma unroll
                    for (int r = 0; r < 4; ++r) UT[(rbk * 16 + 4 * g + r) * 64 + ii] = acc[r]; } }
        }
    }
#pragma unroll
    for (int q2 = 0; q2 < 2; ++q2) { const int c = tid + 512 * q2, row = c >> 3, cc = c & 7; *(v4u*)(KT + row * 64 + cc * 8) = *(const LAS v4u*)(KTl + row * 144 + cc * 16); }
    { const int row = tid >> 3, cc = tid & 7; *(v4u*)(AQK + row * 64 + cc * 8) = *(const LAS v4u*)(AQl + row * 144 + cc * 16); }
}

DI void gdn_scan(const Frame& F, int bh, const unsigned char* CHB, const float* GLB, bf16* OB) {
    constexpr int BUFB = 62464, O_QD = 17408, O_AQ = 34816, O_KT = 44032;
    int tid_ = F.tid; asm volatile("" : "+v"(tid_));
    const int tid = tid_, lane = tid & 63, w = F.wave, li = lane & 15, g = lane >> 4, b = bh >> 3, h = bh & 7;
    f32x4 S[8];
#pragma unroll
    for (int kb = 0; kb < 8; ++kb) S[kb] = (f32x4){0.f, 0.f, 0.f, 0.f};
    int ldso[7];
#pragma unroll
    for (int q = 0; q < 7; ++q) { const int c = tid + 512 * q;
        if (q < 2) ldso[q] = (c >> 4) * 272 + (c & 15) * 16; else if (q < 4) ldso[q] = O_QD + ((c - 1024) >> 4) * 272 + (c & 15) * 16;
        else if (q == 4) ldso[q] = O_AQ + ((c - 2048) >> 3) * 144 + (c & 7) * 16; else ldso[q] = O_KT + ((c - 2560) >> 3) * 144 + (c & 7) * 16; }
    const unsigned char* CH0 = CHB + (size_t)(bh * 32) * GDN_CH_BYTES;
    v4u st[7]; f32x4 utc[4], utn[4]; float glc, gln;
    __syncthreads();
#pragma unroll
    for (int q = 0; q < 7; ++q) st[q] = *(const v4u*)(CH0 + (size_t)(tid + 512 * q) * 16);
#pragma unroll
    for (int jb = 0; jb < 4; ++jb) utc[jb] = *(const f32x4*)((const float*)(CH0 + 57344) + (16 * w + li) * 64 + jb * 16 + 4 * g);
    glc = GLB[bh * 32];
#pragma unroll
    for (int q = 0; q < 7; ++q) *(LAS v4u*)(F.lds + ldso[q]) = st[q];
    __syncthreads();
    for (int n = 0; n < 32; ++n) {
        const LAS unsigned char* Lb = F.lds + (n & 1) * BUFB;
        if (n + 1 < 32) { const unsigned char* CH = CH0 + (size_t)(n + 1) * GDN_CH_BYTES;
#pragma unroll
            for (int q = 0; q < 7; ++q) st[q] = *(const v4u*)(CH + (size_t)(tid + 512 * q) * 16);
#pragma unroll
            for (int jb = 0; jb < 4; ++jb) utn[jb] = *(const f32x4*)((const float*)(CH + 57344) + (16 * w + li) * 64 + jb * 16 + 4 * g);
            gln = GLB[bh * 32 + n + 1]; }
        bf16x8 sf[4];
#pragma unroll
        for (int ks = 0; ks < 4; ++ks) { v4u p; p.x = pk2(S[2 * ks][0], S[2 * ks][1]); p.y = pk2(S[2 * ks][2], S[2 * ks][3]); p.z = pk2(S[2 * ks + 1][0], S[2 * ks + 1][1]); p.w = pk2(S[2 * ks + 1][2], S[2 * ks + 1][3]); sf[ks] = __builtin_bit_cast(bf16x8, p); }
        f32x4 vn[4];
#pragma unroll
        for (int jb = 0; jb < 4; ++jb) { vn[jb] = utc[jb];
#pragma unroll
            for (int ks = 0; ks < 4; ++ks) { const bf16x8 a = *(const LAS bf16x8*)(Lb + (jb * 16 + li) * 272 + (ks * 32 + g * 8) * 2); vn[jb] = __builtin_amdgcn_mfma_f32_16x16x32_bf16(a, sf[ks], vn[jb], 0, 0, 0); } }
        bf16x8 vf[2];
#pragma unroll
        for (int js = 0; js < 2; ++js) { v4u p; p.x = pk2(vn[2 * js][0], vn[2 * js][1]); p.y = pk2(vn[2 * js][2], vn[2 * js][3]); p.z = pk2(vn[2 * js + 1][0], vn[2 * js + 1][1]); p.w = pk2(vn[2 * js + 1][2], vn[2 * js + 1][3]); vf[js] = __builtin_bit_cast(bf16x8, p); }
#pragma unroll
        for (int ib = 0; ib < 4; ++ib) { f32x4 z = (f32x4){0.f, 0.f, 0.f, 0.f};
#pragma unroll
            for (int ks = 0; ks < 4; ++ks) { const bf16x8 bq = *(const LAS bf16x8*)(Lb + O_QD + (ib * 16 + li) * 272 + (ks * 32 + g * 8) * 2); z = __builtin_amdgcn_mfma_f32_16x16x32_bf16(sf[ks], bq, z, 0, 0, 0); }
#pragma unroll
            for (int js = 0; js < 2; ++js) { const bf16x8 ba = *(const LAS bf16x8*)(Lb + O_AQ + (ib * 16 + li) * 144 + (js * 32 + g * 8) * 2); z = __builtin_amdgcn_mfma_f32_16x16x32_bf16(vf[js], ba, z, 0, 0, 0); }
            v2u zo; zo.x = pk2(z[0], z[1]); zo.y = pk2(z[2], z[3]); *(v2u*)(OB + ((size_t)(b * SEQ + n * 64 + ib * 16 + li)) * 1024 + h * 128 + 16 * w + 4 * g) = zo; }
#pragma unroll
        for (int kb = 0; kb < 8; ++kb) { S[kb] = S[kb] * glc;
#pragma unroll
            for (int js = 0; js < 2; ++js) { const bf16x8 a = *(const LAS bf16x8*)(Lb + O_KT + (kb * 16 + li) * 144 + (js * 32 + g * 8) * 2); S[kb] = __builtin_amdgcn_mfma_f32_16x16x32_bf16(a, vf[js], S[kb], 0, 0, 0); } }
        if (n + 1 < 32) {
            LAS unsigned char* Ln = F.lds + ((n + 1) & 1) * BUFB;
#pragma unroll
            for (int q = 0; q < 7; ++q) *(LAS v4u*)(Ln + ldso[q]) = st[q];
#pragma unroll
            for (int jb = 0; jb < 4; ++jb) utc[jb] = utn[jb];
            glc = gln; }
        __syncthreads();
    }
}

#define x_in ((const float*)args.in[0])
#define mem ((const float*)args.in[1])
#define w_in ((const float*)args.in[2])
#define conv_w ((const float*)args.in[3])
#define a_log ((const float*)args.in[4])
#define dt_bias ((const float*)args.in[5])
#define gdn_norm_w ((const float*)args.in[6])
#define diff_lambda ((const float*)args.in[7])
#define diff_norm_w ((const float*)args.in[8])
#define w_branch ((const float*)args.in[9])
#define w_out ((const float*)args.in[10])
#define mix_norm_w ((const float*)args.in[11])
#define mem_norm_w ((const float*)args.in[12])
#define cross_norm_w ((const float*)args.in[13])
#define cross_w_q ((const float*)args.in[14])
#define cross_w_kv ((const float*)args.in[15])
#define cross_w_o ((const float*)args.in[16])
#define ffn_norm_w ((const float*)args.in[17])
#define dense_w_gu ((const float*)args.in[18])
#define dense_w_down ((const float*)args.in[19])
#define router_w ((const float*)args.in[20])
#define expert_w_gu ((const float*)args.in[21])
#define expert_w_down ((const float*)args.in[22])
#define final_norm_w ((const float*)args.in[23])
#define WIN ((bf16*)(ws + WS_WIN))
#define WBR ((bf16*)(ws + WS_WBR))
#define WOUT ((bf16*)(ws + WS_WOUT))
#define WQ ((bf16*)(ws + WS_WQ))
#define WKV ((bf16*)(ws + WS_WKV))
#define WO ((bf16*)(ws + WS_WO))
#define WGU ((bf16*)(ws + WS_WGU))
#define WDN ((bf16*)(ws + WS_WDN))
#define WEGU ((bf16*)(ws + WS_WEGU))
#define WEDN ((bf16*)(ws + WS_WEDN))
#define XRES ((float*)(ws + WS_XRES))
#define H ((bf16*)(ws + WS_H))
#define RQ ((bf16*)(ws + WS_RQ))
#define RK ((bf16*)(ws + WS_RK))
#define RVT ((bf16*)(ws + WS_RV))
#define RG ((bf16*)(ws + WS_RG))
#define BQKV ((bf16*)(ws + WS_BQKV))
#define BZ ((bf16*)(ws + WS_BZ))
#define BBA ((float*)(ws + WS_BBA))
#define CQ ((bf16*)(ws + WS_CQ))
#define CK ((bf16*)(ws + WS_CK))
#define CVT ((bf16*)(ws + WS_CVT))
#define GATES ((bf16*)(ws + WS_GATES))
#define GQ ((bf16*)(ws + WS_GQ))
#define GK ((bf16*)(ws + WS_GK))
#define GV ((bf16*)(ws + WS_GV))
#define GG ((float*)(ws + WS_GG))
#define GB ((float*)(ws + WS_GB))
#define OA ((bf16*)(ws + WS_OA))
#define OB ((bf16*)(ws + WS_OB))
#define O12 ((bf16*)(ws + WS_O12))
#define OCAT ((bf16*)(ws + WS_OCAT))
#define MERGE ((float*)(ws + WS_MERGE))
#define MERGEB ((bf16*)(ws + WS_MERGEB))
#define MEMN ((bf16*)(ws + WS_MEMN))
#define KX ((bf16*)(ws + WS_KX))
#define VXT ((bf16*)(ws + WS_VXT))
#define QX ((bf16*)(ws + WS_QX))
#define OX ((bf16*)(ws + WS_OX))
#define ACT ((bf16*)(ws + WS_ACT))
#define HG ((bf16*)(ws + WS_HG))
#define EACT ((bf16*)(ws + WS_EACT))
#define Y ((float*)(ws + WS_Y))
#define ROUTE ((int*)(ws + WS_ROUTE))
#define H8 ((unsigned char*)(ws + WS_H8))
#define WIN8 ((unsigned char*)(ws + WS_WIN8))
__global__ void __launch_bounds__(NWAVES * 64, 2) mk_fwd(Args args) {
    extern __shared__ __attribute__((aligned(16))) unsigned char lds_raw[];
    Frame F;
    F.lds = (LAS unsigned char*)lds_raw;
    F.tid = threadIdx.x; F.lane = F.tid & 63; F.wave = __builtin_amdgcn_readfirstlane(F.tid >> 6);
    F.G = gridDim.x; { const int bx = blockIdx.x; F.vcu = (F.G % 8 == 0) ? (bx % 8) * (F.G / 8) + bx / 8 : bx; }
    F.gw = F.vcu * NWAVES + F.wave; F.NGW = F.G * NWAVES;
    volatile LAS unsigned* MISC = (volatile LAS unsigned*)(F.lds + MISC_OFF);
    LAS int* MTAB = (LAS int*)(F.lds + MISC_OFF + 128);
    unsigned char* ws = args.ws;
    unsigned* ctl = (unsigned*)(ws + WS_CTL);
    for (int u = F.tid; u < (LDS_BYTES - RING_BYTES) / 4; u += NWAVES * 64) ((LAS unsigned*)(F.lds + RING_BYTES))[u] = 0u;
    __syncthreads();
#if MK_ONE_LAUNCH
    XcdBarrier bar = xcd_barrier_post(ctl + CW_BAR, MISC + 8);
#define GRID_BAR() xcd_barrier(bar)
#else
#define GRID_BAR() do {} while (0)
#endif
    const int lo = args.ph_lo, hi = args.ph_hi;
#ifndef PROBE_PH
#define PROBE_PH -1
#endif
#define IN(k) (lo <= (k) && ((k) < hi) && (hi <= 100 || (k) == lo))
#define REP(k) for (int rep_ = 0; rep_ < ((k) == PROBE_PH ? 2 : 1); ++rep_)
#define SEAM(k) do { if (IN(k) && IN((k) + 1)) GRID_BAR(); } while (0)

    if (IN(0)) REP(0) {
        for (int l = 0; l < 2; ++l) {
            conv_wg<false>(F, w_in + (size_t)l * D * 17424, D, 17424, WIN + (size_t)l * NINP * D, 45 * 256, 3, 0, 1.f);
            conv_wg<true>(F, w_in + (size_t)l * D * 17424, D, 17424, WIN8 + (size_t)l * 32 * 256 * D, 24 * 256, 4, 0, 256.f);
            conv_wg<false>(F, w_branch + (size_t)l * 3072 * D, 3072, D, WBR + (size_t)l * D * 3072, D, 0, 0, 1.f);
            conv_wg<false>(F, w_out + (size_t)l * D * D, D, D, WOUT + (size_t)l * D * D, D, 0, 0, 1.f);
            conv_wg<false>(F, cross_w_q + (size_t)l * D * 512, D, 512, WQ + (size_t)l * 512 * D, 512, 0, 0, 1.f);
            conv_wg<false>(F, cross_w_kv + (size_t)l * D * 1024, D, 1024, WKV + (size_t)l * 1024 * D, 1024, 0, 0, 1.f);
            conv_wg<false>(F, cross_w_o + (size_t)l * 512 * D, 512, D, WO + (size_t)l * D * 512, D, 0, 0, 1.f);
        }
        conv_wg<false>(F, dense_w_gu, D, 2 * DFF, WGU, 2 * DFF, 2, DFF, 1.f);
        conv_wg<false>(F, dense_w_down, DFF, D, WDN, D, 0, 0, 1.f);
        for (int e = 0; e < NEXP; ++e) {
            conv_wg<true>(F, expert_w_gu + (size_t)e * D * 2 * EFF, D, 2 * EFF, (unsigned char*)WEGU + (size_t)e * 2 * EFF * D, 2 * EFF, 2, EFF, 256.f);
            conv_wg<true>(F, expert_w_down + (size_t)e * EFF * D, EFF, D, (unsigned char*)WEDN + (size_t)e * D * EFF, D, 0, 0, 256.f);
        }
        for (int r = F.gw; r < T; r += F.NGW) rms_row(x_in + (size_t)r * D, mix_norm_w, H + (size_t)r * D, F.lane, H8 + (size_t)r * D);
        for (int r = F.gw; r < 2 * MEMR; r += F.NGW) { const int l = r / MEMR, rr = r % MEMR; rms_row(mem + (size_t)rr * D, mem_norm_w + l * D, MEMN + (size_t)r * D, F.lane); }
    }
    SEAM(0);

    { constexpr int l = 0;
        const int pb = 2 + l * NPL;
        const float lambda_init = l == 0 ? 0.2f : 0.35550906f;
        const float* xin = l == 0 ? x_in : XRES;
        if (IN(pb + 0)) REP(pb + 0) {
            { pg8::Gemm g{H, WIN + (size_t)l * NINP * D, T, 45 * 256, D}; pg8::StaticOrder S; S.init(T, 45 * 256, F.G, (int)blockIdx.x);
              pg8::EpiIn E{RQ, RK, RVT, RG, BQKV, BZ, CQ, CK, CVT, GATES, BBA, 0, 1.f};
              pg8::gemm_phase<pg8::EpiIn, pg8::StaticOrder, true, true>(F.lds, g, S, E); }
            { pg8::Gemm g{(const bf16*)H8, (const bf16*)(WIN8 + (size_t)l * 32 * 256 * D), T, 24 * 256, D / 2}; pg8::StaticOrder S; S.init(T, 24 * 256, F.G, (int)blockIdx.x);
              pg8::EpiIn E{RQ, RK, RVT, RG, BQKV, BZ, CQ, CK, CVT, GATES, BBA, 1, 1.0f / 256.f};
              pg8::gemm_phase<pg8::EpiIn, pg8::StaticOrder, true, true, true>(F.lds, g, S, E); }
        }
        SEAM(pb + 0);
        if (IN(pb + 1)) REP(pb + 1) {
            const float* cw = conv_w + (size_t)l * 4 * 3072;
            for (int it = F.vcu; it < 1024; it += F.G) gdn_prep_item(F, l, it >> 5, it & 31, BQKV, BBA, cw, a_log, dt_bias, ws + WS_GCH + (size_t)it * GDN_CH_BYTES, (float*)(ws + WS_GL) + it);
        }
        SEAM(pb + 1);
        if (IN(pb + 2)) REP(pb + 2) {
            const int bx = F.vcu;
            const int mixsel = (l == 0 && args.ph_hi > 100) ? (args.ph_hi - 100) : 3, qw = (l == 0 && args.ph_hi > 100) ? 104 : 100 + l;
            if (bx < 32 && (mixsel & 1)) gdn_scan(F, bx, ws + WS_GCH, (const float*)(ws + WS_GL), OB);
            if (mixsel & 2) {
                volatile LAS int* qslot = (volatile LAS int*)(F.lds + MISC_OFF + 256);
                int nxt = 0; if (F.tid == 0) nxt = (int)atomicAdd(ctl + qw, 1u);
                for (;;) {
                    __syncthreads(); if (F.tid == 0) qslot[0] = nxt; __syncthreads();
                    const int it = __builtin_amdgcn_readfirstlane(qslot[0]); if (it >= 1024) break;
                    if (F.tid == 0) nxt = (int)atomicAdd(ctl + qw, 1u);
                    const int qt = 15 - (it >> 6), kind = (it >> 5) & 1, hd = it & 31, b = hd >> 3, hm = hd & 7;
                    if (kind == 0) { const int hh = hm >> 1, m = hm & 1; const float slope = exp2f(-2.0f * (float)(hh + 1));
                        flash_item<256, 128, true, true, false>(F, CQ + ((size_t)hd * SEQ + qt * 128) * 128, CK + (size_t)hd * SEQ * 128, CVT + (size_t)(b * 4 + hh) * 256 * SEQ, SEQ, qt * 128, SEQ, slope,
                                                            nullptr, O12 + ((size_t)m * T + b * SEQ + qt * 128) * 1024 + hh * 256, 1024); }
                    else { const float lg = log2f(1.0f - exp2f(-5.0f - (float)hm));
                        flash_item<128, 128, true, true, true>(F, RQ + ((size_t)hd * SEQ + qt * 128) * 128, RK + (size_t)hd * SEQ * 128, RVT + (size_t)hd * 128 * SEQ, SEQ, qt * 128, SEQ, lg,
                                                           nullptr, OA + ((size_t)(b * SEQ + qt * 128)) * 1024 + hm * 128, 1024); }
                }
            }
        }
        SEAM(pb + 2);
        if (IN(pb + 3)) REP(pb + 3) {
            const int lane = F.lane;
            const float* lv = diff_lambda + (size_t)l * 512;
            const float d01 = wave_sum(lv[lane] * lv[128 + lane] + lv[64 + lane] * lv[192 + lane]), d23 = wave_sum(lv[256 + lane] * lv[384 + lane] + lv[320 + lane] * lv[448 + lane]);
            const float lam = __expf(d01) - __expf(d23) + lambda_init;
            for (int t = F.gw; t < T; t += F.NGW) {
#pragma unroll
                for (int h = 0; h < 8; ++h) { const size_t o = (size_t)t * 1024 + h * 128 + 2 * lane;
                    { const unsigned av = *(const unsigned*)(OA + o); const float a0 = bf2f(av & 0xffffu), a1 = __uint_as_float(av & 0xffff0000u); const float mean = wave_sum(a0 + a1) * (1.f / 128.f); const float c0 = a0 - mean, c1 = a1 - mean; const float rstd = rsqrtf(wave_sum(c0 * c0 + c1 * c1) * (1.f / 128.f) + EPS);
                      const unsigned gv = *(const unsigned*)(RG + o); *(unsigned*)(OCAT + (size_t)t * 3072 + h * 128 + 2 * lane) = pk2(c0 * rstd * bf2f(gv & 0xffffu), c1 * rstd * __uint_as_float(gv & 0xffff0000u)); }
                    { const unsigned av = *(const unsigned*)(OB + o); const float a0 = bf2f(av & 0xffffu), a1 = __uint_as_float(av & 0xffff0000u); const float rstd = rsqrtf(wave_sum(a0 * a0 + a1 * a1) * (1.f / 128.f) + EPS); const unsigned gv = *(const unsigned*)(BZ + o);
                      *(unsigned*)(OCAT + (size_t)t * 3072 + 1024 + h * 128 + 2 * lane) = pk2(a0 * rstd * gdn_norm_w[l * 128 + 2 * lane] * bf2f(gv & 0xffffu), a1 * rstd * gdn_norm_w[l * 128 + 2 * lane + 1] * __uint_as_float(gv & 0xffff0000u)); } }
#pragma unroll
                for (int h = 0; h < 4; ++h) { const size_t o = (size_t)t * 1024 + h * 256 + 4 * lane; const v2u pw = *(const v2u*)(O12 + o), qw = *(const v2u*)(O12 + (size_t)T * 1024 + o); const f32x4 p = {bf2f(pw.x & 0xffffu), __uint_as_float(pw.x & 0xffff0000u), bf2f(pw.y & 0xffffu), __uint_as_float(pw.y & 0xffff0000u)}, q = {bf2f(qw.x & 0xffffu), __uint_as_float(qw.x & 0xffff0000u), bf2f(qw.y & 0xffffu), __uint_as_float(qw.y & 0xffff0000u)}; const f32x4 d = p - q * lam;
                    const float rstd = rsqrtf(wave_sum((d[0] * d[0] + d[1] * d[1]) + (d[2] * d[2] + d[3] * d[3])) * (1.f / 256.f) + EPS) * (1.0f - lambda_init); const f32x4 ww = *(const f32x4*)(diff_norm_w + l * 256 + 4 * lane);
                    v2u ov; ov.x = pk2(d[0] * rstd * ww[0], d[1] * rstd * ww[1]); ov.y = pk2(d[2] * rstd * ww[2], d[3] * rstd * ww[3]); *(v2u*)(OCAT + (size_t)t * 3072 + 2048 + h * 256 + 4 * lane) = ov; }
            }
        }
        SEAM(pb + 3);
        if (IN(pb + 4)) REP(pb + 4) {
            pg8::Gemm g{OCAT, WBR + (size_t)l * D * 3072, T, D, 3072}; pg8::StaticOrder S; S.init(T, D, F.G, (int)blockIdx.x);
            pg8::EpiBranch E{MERGEB, GATES, 16, 32};
            pg8::gemm_phase<pg8::EpiBranch, pg8::StaticOrder, true, true>(F.lds, g, S, E);
        }
        SEAM(pb + 4);
        if (IN(pb + 5)) REP(pb + 5) {
            pg8::Gemm g{MERGEB, WOUT + (size_t)l * D * D, T, D, D}; pg8::StaticOrder S; S.init(T, D, F.G, (int)blockIdx.x);
            pg8::EpiResid E{xin, XRES, D, 1.f};
            pg8::gemm_phase<pg8::EpiResid, pg8::StaticOrder, true, true>(F.lds, g, S, E);
        }
        SEAM(pb + 5);
        if (IN(pb + 6)) REP(pb + 6) { for (int r = F.gw; r < T; r += F.NGW) rms_row(XRES + (size_t)r * D, cross_norm_w + l * D, H + (size_t)r * D, F.lane); }
        SEAM(pb + 6);
        if (IN(pb + 7)) REP(pb + 7) {
            pg8::Gemm g{H, WQ + (size_t)l * 512 * D, T, 512, D}; pg8::StaticOrder S; S.init(T, 512, F.G, (int)blockIdx.x);
            pg8::EpiHeads E{QX, nullptr, 4, 11, 1 << 20};
            pg8::gemm_phase<pg8::EpiHeads, pg8::StaticOrder, true, true>(F.lds, g, S, E);
            pg8::Gemm g2{MEMN + (size_t)l * MEMR * D, WKV + (size_t)l * 1024 * D, MEMR, 1024, D}; pg8::StaticOrder S2; S2.init(MEMR, 1024, F.G, (int)((blockIdx.x + F.G - 64) % F.G));
            pg8::EpiHeads E2{KX + (size_t)l * NB * 4 * MEML * 128, VXT + (size_t)l * NB * 4 * 128 * MEML, 4, 8, 2};
            pg8::gemm_phase<pg8::EpiHeads, pg8::StaticOrder, true, true>(F.lds, g2, S2, E2);
        }
        SEAM(pb + 7);
        if (IN(pb + 8)) REP(pb + 8) {
            for (int it = F.vcu; it < 256; it += F.G) { const int hd = it >> 4, qt = it & 15, b = hd >> 2, hh = hd & 3;
                flash_item<128, 128, false, true, false>(F, QX + ((size_t)hd * SEQ + qt * 128) * 128, KX + ((size_t)l * 16 + hd) * MEML * 128, VXT + ((size_t)l * 16 + hd) * 128 * MEML, MEML, qt * 128, MEML, 0.f,
                                             nullptr, OX + ((size_t)(b * SEQ + qt * 128)) * 512 + hh * 128, 512); }
        }
        SEAM(pb + 8);
        if (IN(pb + 9)) REP(pb + 9) {
            pg8::Gemm g{OX, WO + (size_t)l * D * 512, T, D, 512}; pg8::StaticOrder S; S.init(T, D, F.G, (int)blockIdx.x);
            pg8::EpiResid E{XRES, XRES, D, 1.f};
            pg8::gemm_phase<pg8::EpiResid, pg8::StaticOrder, true, true>(F.lds, g, S, E);
        }
        SEAM(pb + 9);
        if (IN(pb + 10)) REP(pb + 10) {
            const int lane = F.lane; const float* w = ffn_norm_w + l * D;
            for (int r = F.gw; r < T; r += F.NGW) {
                const float* xrow = XRES + (size_t)r * D; f32x4 v[8]; float ss = 0.f;
#pragma unroll
                for (int j = 0; j < 8; ++j) { v[j] = *(const f32x4*)(xrow + 4 * (lane + 64 * j)); ss += (v[j][0] * v[j][0] + v[j][1] * v[j][1]) + (v[j][2] * v[j][2] + v[j][3] * v[j][3]); }
                const float rstd = rsqrtf(wave_sum(ss) * (1.f / D) + EPS);
                float lg[8];
#pragma unroll
                for (int e = 0; e < 8; ++e) lg[e] = 0.f;
#pragma unroll
                for (int j = 0; j < 8; ++j) { const f32x4 ww = *(const f32x4*)(w + 4 * (lane + 64 * j)); f32x4 y; y[0] = v[j][0] * rstd * ww[0]; y[1] = v[j][1] * rstd * ww[1]; y[2] = v[j][2] * rstd * ww[2]; y[3] = v[j][3] * rstd * ww[3];
                    if (l == 0) { v2u o; o.x = pk2(y[0], y[1]); o.y = pk2(y[2], y[3]); *(v2u*)(H + (size_t)r * D + 4 * (lane + 64 * j)) = o; }
                    else *(unsigned*)(H8 + (size_t)r * D + 4 * (lane + 64 * j)) = pg8::pk4_fp8(y[0], y[1], y[2], y[3]);
                    if (l == 1) {
#pragma unroll
                        for (int c = 0; c < 4; ++c) { const float* rw = router_w + (size_t)(4 * (lane + 64 * j) + c) * 8; const f32x4 r0 = *(const f32x4*)rw, r1 = *(const f32x4*)(rw + 4);
                            lg[0] += y[c] * r0[0]; lg[1] += y[c] * r0[1]; lg[2] += y[c] * r0[2]; lg[3] += y[c] * r0[3]; lg[4] += y[c] * r1[0]; lg[5] += y[c] * r1[1]; lg[6] += y[c] * r1[2]; lg[7] += y[c] * r1[3]; } } }
                if (l == 1) {
#pragma unroll
                    for (int e = 0; e < 8; ++e) lg[e] = wave_sum(lg[e]);
                    int e0 = 0; float v0 = lg[0];
#pragma unroll
                    for (int e = 1; e < 8; ++e) if (lg[e] > v0) { v0 = lg[e]; e0 = e; }
                    int e1 = -1; float v1 = -__builtin_inff();
#pragma unroll
                    for (int e = 0; e < 8; ++e) if (e != e0 && lg[e] > v1) { v1 = lg[e]; e1 = e; }
                    if (lane == 0) { const float p0 = 1.0f / (1.0f + __expf(v1 - v0)); int* ro = ROUTE + (size_t)r * 8;
                        ro[0] = e0; ro[1] = e1; ro[2] = (int)atomicAdd(ctl + CW_CNT + e0, 1u); ro[3] = (int)atomicAdd(ctl + CW_CNT + e1, 1u); ((float*)ro)[4] = p0; ((float*)ro)[5] = 1.0f - p0; }
                }
            }
        }
        SEAM(pb + 10);
        if (l == 0) {
            if (IN(pb + 11)) REP(pb + 11) {
                pg8::Gemm g{H, WGU, T, 2 * DFF, D}; pg8::StaticOrder S; S.init(T, 2 * DFF, F.G, (int)blockIdx.x);
                pg8::EpiSwiglu E{ACT, DFF, 1 << 20};
                pg8::gemm_phase<pg8::EpiSwiglu, pg8::StaticOrder, true, true>(F.lds, g, S, E);
            }
            SEAM(pb + 11);
            if (IN(pb + 12)) REP(pb + 12) {
                pg8::Gemm g{ACT, WDN, T, D, DFF}; pg8::StaticOrder S; S.init(T, D, F.G, (int)blockIdx.x);
                pg8::EpiResid E{XRES, XRES, D, 1.f};
                pg8::gemm_phase<pg8::EpiResid, pg8::StaticOrder, true, true>(F.lds, g, S, E);
            }
            SEAM(pb + 12);
            if (IN(pb + 13)) REP(pb + 13) { for (int r = F.gw; r < T; r += F.NGW) rms_row(XRES + (size_t)r * D, mix_norm_w + D, H + (size_t)r * D, F.lane, H8 + (size_t)r * D); }
            SEAM(pb + 13);
        } else {
#define MOE_OFFSETS() int off[9]; off[0] = 0; _Pragma("unroll") for (int e = 0; e < 8; ++e) { const int c = __builtin_amdgcn_readfirstlane((int)__hip_atomic_load(ctl + CW_CNT + e, __ATOMIC_RELAXED, __HIP_MEMORY_SCOPE_AGENT)); off[e + 1] = off[e] + ((c + 255) & ~255); }
            if (IN(pb + 11)) REP(pb + 11) {
                MOE_OFFSETS();
                for (int it = F.gw; it < T * 2; it += F.NGW) { const int t = it >> 1, k = it & 1; int* ro = ROUTE + (size_t)t * 8; const int e = ro[k], pos = ro[2 + k];
                    int base = 0;
#pragma unroll
                    for (int q = 0; q < 8; ++q) if (e == q) base = off[q];
                    const int slot = base + pos; if (F.lane == 0) ro[6 + k] = slot;
                    const v4u* src = (const v4u*)(H8 + (size_t)t * D); v4u* dst = (v4u*)((unsigned char*)HG + (size_t)slot * D);
#pragma unroll
                    for (int j = 0; j < 2; ++j) dst[F.lane + 64 * j] = src[F.lane + 64 * j]; }
#pragma unroll
                for (int e = 0; e < 8; ++e) { const int c = __builtin_amdgcn_readfirstlane((int)__hip_atomic_load(ctl + CW_CNT + e, __ATOMIC_RELAXED, __HIP_MEMORY_SCOPE_AGENT));
                    for (int rr = off[e] + c + F.gw; rr < off[e + 1]; rr += F.NGW) { v4u* dst = (v4u*)((unsigned char*)HG + (size_t)rr * D);
#pragma unroll
                        for (int j = 0; j < 2; ++j) dst[F.lane + 64 * j] = (v4u){0u, 0u, 0u, 0u}; } }
            }
            SEAM(pb + 11);
            if (IN(pb + 12)) REP(pb + 12) {
                if (F.tid == 0) { MOE_OFFSETS(); int cu = 0;
#pragma unroll
                    for (int e = 0; e < 8; ++e) { const int ne = (off[e + 1] - off[e]) >> 8; MTAB[e] = ne; MTAB[8 + e] = off[e] >> 8; MTAB[16 + e] = cu; cu += ne * 56; } MTAB[24] = cu; MTAB[25] = cu; }
                __syncthreads();
                pg8::Gemm g{HG, WEGU, MAXSLOT, NEXP * 2 * EFF, D / 2}; pg8::MoeOrder S{(const LAS int*)MTAB, 56, F.G, (int)blockIdx.x};
                pg8::EpiSwiglu8 E{(unsigned char*)EACT, EFF, 56, 1.0f / 256.f, 8.f};
                pg8::gemm_phase<pg8::EpiSwiglu8, pg8::MoeOrder, true, true, true>(F.lds, g, S, E);
            }
            SEAM(pb + 12);
            if (IN(pb + 13)) REP(pb + 13) {
                __syncthreads();
                if (F.tid == 0) { MOE_OFFSETS(); int cu = 0;
#pragma unroll
                    for (int e = 0; e < 8; ++e) { const int ne = (off[e + 1] - off[e]) >> 8; MTAB[e] = ne; MTAB[8 + e] = off[e] >> 8; MTAB[16 + e] = cu; cu += ne * 8; } MTAB[24] = cu; MTAB[25] = cu; }
                __syncthreads();
                pg8::Gemm g{EACT, WEDN, MAXSLOT, NEXP * D, EFF / 2}; pg8::MoeOrder S{(const LAS int*)MTAB, 8, F.G, (int)blockIdx.x};
                pg8::EpiStoreF32 E{Y, D, 8, 1.0f / 2048.f};
                pg8::gemm_phase<pg8::EpiStoreF32, pg8::MoeOrder, true, true, true>(F.lds, g, S, E);
            }
            SEAM(pb + 13);
            if (IN(pb + 14)) REP(pb + 14) {
                const int lane = F.lane;
                for (int r = F.gw; r < T; r += F.NGW) { const int* ro = ROUTE + (size_t)r * 8; const float p0 = ((const float*)ro)[4], p1 = ((const float*)ro)[5]; const float* y0 = Y + (size_t)ro[6] * D; const float* y1 = Y + (size_t)ro[7] * D;
                    const float* xrow = XRES + (size_t)r * D; f32x4 v[8]; float ss = 0.f;
#pragma unroll
                    for (int j = 0; j < 8; ++j) { const int o = 4 * (lane + 64 * j); v[j] = *(const f32x4*)(xrow + o) + *(const f32x4*)(y0 + o) * p0 + *(const f32x4*)(y1 + o) * p1; ss += (v[j][0] * v[j][0] + v[j][1] * v[j][1]) + (v[j][2] * v[j][2] + v[j][3] * v[j][3]); }
                    const float rstd = rsqrtf(wave_sum(ss) * (1.f / D) + EPS);
#pragma unroll
                    for (int j = 0; j < 8; ++j) { const int o = 4 * (lane + 64 * j); const f32x4 ww = *(const f32x4*)(final_norm_w + o); *(f32x4*)(args.out + (size_t)r * D + o) = v[j] * rstd * ww; } }
            }
        }
    }
    { constexpr int l = 1;
        const int pb = 2 + l * NPL;
        const float lambda_init = l == 0 ? 0.2f : 0.35550906f;
        const float* xin = l == 0 ? x_in : XRES;
        if (IN(pb + 0)) REP(pb + 0) {
            { pg8::Gemm g{H, WIN + (size_t)l * NINP * D, T, 45 * 256, D}; pg8::StaticOrder S; S.init(T, 45 * 256, F.G, (int)blockIdx.x);
              pg8::EpiIn E{RQ, RK, RVT, RG, BQKV, BZ, CQ, CK, CVT, GATES, BBA, 0, 1.f};
              pg8::gemm_phase<pg8::EpiIn, pg8::StaticOrder, true, true>(F.lds, g, S, E); }
            { pg8::Gemm g{(const bf16*)H8, (const bf16*)(WIN8 + (size_t)l * 32 * 256 * D), T, 24 * 256, D / 2}; pg8::StaticOrder S; S.init(T, 24 * 256, F.G, (int)blockIdx.x);
              pg8::EpiIn E{RQ, RK, RVT, RG, BQKV, BZ, CQ, CK, CVT, GATES, BBA, 1, 1.0f / 256.f};
              pg8::gemm_phase<pg8::EpiIn, pg8::StaticOrder, true, true, true>(F.lds, g, S, E); }
        }
        SEAM(pb + 0);
        if (IN(pb + 1)) REP(pb + 1) {
            const float* cw = conv_w + (size_t)l * 4 * 3072;
            for (int it = F.vcu; it < 1024; it += F.G) gdn_prep_item(F, l, it >> 5, it & 31, BQKV, BBA, cw, a_log, dt_bias, ws + WS_GCH + (size_t)it * GDN_CH_BYTES, (float*)(ws + WS_GL) + it);
        }
        SEAM(pb + 1);
        if (IN(pb + 2)) REP(pb + 2) {
            const int bx = F.vcu;
            const int mixsel = (l == 0 && args.ph_hi > 100) ? (args.ph_hi - 100) : 3, qw = (l == 0 && args.ph_hi > 100) ? 104 : 100 + l;
            if (bx < 32 && (mixsel & 1)) gdn_scan(F, bx, ws + WS_GCH, (const float*)(ws + WS_GL), OB);
            if (mixsel & 2) {
                volatile LAS int* qslot = (volatile LAS int*)(F.lds + MISC_OFF + 256);
                int nxt = 0; if (F.tid == 0) nxt = (int)atomicAdd(ctl + qw, 1u);
                for (;;) {
                    __syncthreads(); if (F.tid == 0) qslot[0] = nxt; __syncthreads();
                    const int it = __builtin_amdgcn_readfirstlane(qslot[0]); if (it >= 1024) break;
                    if (F.tid == 0) nxt = (int)atomicAdd(ctl + qw, 1u);
                    const int qt = 15 - (it >> 6), kind = (it >> 5) & 1, hd = it & 31, b = hd >> 3, hm = hd & 7;
                    if (kind == 0) { const int hh = hm >> 1, m = hm & 1; const float slope = exp2f(-2.0f * (float)(hh + 1));
                        flash_item<256, 128, true, true, false>(F, CQ + ((size_t)hd * SEQ + qt * 128) * 128, CK + (size_t)hd * SEQ * 128, CVT + (size_t)(b * 4 + hh) * 256 * SEQ, SEQ, qt * 128, SEQ, slope,
                                                            nullptr, O12 + ((size_t)m * T + b * SEQ + qt * 128) * 1024 + hh * 256, 1024); }
                    else { const float lg = log2f(1.0f - exp2f(-5.0f - (float)hm));
                        flash_item<128, 128, true, true, true>(F, RQ + ((size_t)hd * SEQ + qt * 128) * 128, RK + (size_t)hd * SEQ * 128, RVT + (size_t)hd * 128 * SEQ, SEQ, qt * 128, SEQ, lg,
                                                           nullptr, OA + ((size_t)(b * SEQ + qt * 128)) * 1024 + hm * 128, 1024); }
                }
            }
        }
        SEAM(pb + 2);
        if (IN(pb + 3)) REP(pb + 3) {
            const int lane = F.lane;
            const float* lv = diff_lambda + (size_t)l * 512;
            const float d01 = wave_sum(lv[lane] * lv[128 + lane] + lv[64 + lane] * lv[192 + lane]), d23 = wave_sum(lv[256 + lane] * lv[384 + lane] + lv[320 + lane] * lv[448 + lane]);
            const float lam = __expf(d01) - __expf(d23) + lambda_init;
            for (int t = F.gw; t < T; t += F.NGW) {
#pragma unroll
                for (int h = 0; h < 8; ++h) { const size_t o = (size_t)t * 1024 + h * 128 + 2 * lane;
                    { const unsigned av = *(const unsigned*)(OA + o); const float a0 = bf2f(av & 0xffffu), a1 = __uint_as_float(av & 0xffff0000u); const float mean = wave_sum(a0 + a1) * (1.f / 128.f); const float c0 = a0 - mean, c1 = a1 - mean; const float rstd = rsqrtf(wave_sum(c0 * c0 + c1 * c1) * (1.f / 128.f) + EPS);
                      const unsigned gv = *(const unsigned*)(RG + o); *(unsigned*)(OCAT + (size_t)t * 3072 + h * 128 + 2 * lane) = pk2(c0 * rstd * bf2f(gv & 0xffffu), c1 * rstd * __uint_as_float(gv & 0xffff0000u)); }
                    { const unsigned av = *(const unsigned*)(OB + o); const float a0 = bf2f(av & 0xffffu), a1 = __uint_as_float(av & 0xffff0000u); const float rstd = rsqrtf(wave_sum(a0 * a0 + a1 * a1) * (1.f / 128.f) + EPS); const unsigned gv = *(const unsigned*)(BZ + o);
                      *(unsigned*)(OCAT + (size_t)t * 3072 + 1024 + h * 128 + 2 * lane) = pk2(a0 * rstd * gdn_norm_w[l * 128 + 2 * lane] * bf2f(gv & 0xffffu), a1 * rstd * gdn_norm_w[l * 128 + 2 * lane + 1] * __uint_as_float(gv & 0xffff0000u)); } }
#pragma unroll
                for (int h = 0; h < 4; ++h) { const size_t o = (size_t)t * 1024 + h * 256 + 4 * lane; const v2u pw = *(const v2u*)(O12 + o), qw = *(const v2u*)(O12 + (size_t)T * 1024 + o); const f32x4 p = {bf2f(pw.x & 0xffffu), __uint_as_float(pw.x & 0xffff0000u), bf2f(pw.y & 0xffffu), __uint_as_float(pw.y & 0xffff0000u)}, q = {bf2f(qw.x & 0xffffu), __uint_as_float(qw.x & 0xffff0000u), bf2f(qw.y & 0xffffu), __uint_as_float(qw.y & 0xffff0000u)}; const f32x4 d = p - q * lam;
                    const float rstd = rsqrtf(wave_sum((d[0] * d[0] + d[1] * d[1]) + (d[2] * d[2] + d[3] * d[3])) * (1.f / 256.f) + EPS) * (1.0f - lambda_init); const f32x4 ww = *(const f32x4*)(diff_norm_w + l * 256 + 4 * lane);
                    v2u ov; ov.x = pk2(d[0] * rstd * ww[0], d[1] * rstd * ww[1]); ov.y = pk2(d[2] * rstd * ww[2], d[3] * rstd * ww[3]); *(v2u*)(OCAT + (size_t)t * 3072 + 2048 + h * 256 + 4 * lane) = ov; }
            }
        }
        SEAM(pb + 3);
        if (IN(pb + 4)) REP(pb + 4) {
            pg8::Gemm g{OCAT, WBR + (size_t)l * D * 3072, T, D, 3072}; pg8::StaticOrder S; S.init(T, D, F.G, (int)blockIdx.x);
            pg8::EpiBranch E{MERGEB, GATES, 16, 32};
            pg8::gemm_phase<pg8::EpiBranch, pg8::StaticOrder, true, true>(F.lds, g, S, E);
        }
        SEAM(pb + 4);
        if (IN(pb + 5)) REP(pb + 5) {
            pg8::Gemm g{MERGEB, WOUT + (size_t)l * D * D, T, D, D}; pg8::StaticOrder S; S.init(T, D, F.G, (int)blockIdx.x);
            pg8::EpiResid E{xin, XRES, D, 1.f};
            pg8::gemm_phase<pg8::EpiResid, pg8::StaticOrder, true, true>(F.lds, g, S, E);
        }
        SEAM(pb + 5);
        if (IN(pb + 6)) REP(pb + 6) { for (int r = F.gw; r < T; r += F.NGW) rms_row(XRES + (size_t)r * D, cross_norm_w + l * D, H + (size_t)r * D, F.lane); }
        SEAM(pb + 6);
        if (IN(pb + 7)) REP(pb + 7) {
            pg8::Gemm g{H, WQ + (size_t)l * 512 * D, T, 512, D}; pg8::StaticOrder S; S.init(T, 512, F.G, (int)blockIdx.x);
            pg8::EpiHeads E{QX, nullptr, 4, 11, 1 << 20};
            pg8::gemm_phase<pg8::EpiHeads, pg8::StaticOrder, true, true>(F.lds, g, S, E);
            pg8::Gemm g2{MEMN + (size_t)l * MEMR * D, WKV + (size_t)l * 1024 * D, MEMR, 1024, D}; pg8::StaticOrder S2; S2.init(MEMR, 1024, F.G, (int)((blockIdx.x + F.G - 64) % F.G));
            pg8::EpiHeads E2{KX + (size_t)l * NB * 4 * MEML * 128, VXT + (size_t)l * NB * 4 * 128 * MEML, 4, 8, 2};
            pg8::gemm_phase<pg8::EpiHeads, pg8::StaticOrder, true, true>(F.lds, g2, S2, E2);
        }
        SEAM(pb + 7);
        if (IN(pb + 8)) REP(pb + 8) {
            for (int it = F.vcu; it < 256; it += F.G) { const int hd = it >> 4, qt = it & 15, b = hd >> 2, hh = hd & 3;
                flash_item<128, 128, false, true, false>(F, QX + ((size_t)hd * SEQ + qt * 128) * 128, KX + ((size_t)l * 16 + hd) * MEML * 128, VXT + ((size_t)l * 16 + hd) * 128 * MEML, MEML, qt * 128, MEML, 0.f,
                                             nullptr, OX + ((size_t)(b * SEQ + qt * 128)) * 512 + hh * 128, 512); }
        }
        SEAM(pb + 8);
        if (IN(pb + 9)) REP(pb + 9) {
            pg8::Gemm g{OX, WO + (size_t)l * D * 512, T, D, 512}; pg8::StaticOrder S; S.init(T, D, F.G, (int)blockIdx.x);
            pg8::EpiResid E{XRES, XRES, D, 1.f};
            pg8::gemm_phase<pg8::EpiResid, pg8::StaticOrder, true, true>(F.lds, g, S, E);
        }
        SEAM(pb + 9);
        if (IN(pb + 10)) REP(pb + 10) {
            const int lane = F.lane; const float* w = ffn_norm_w + l * D;
            for (int r = F.gw; r < T; r += F.NGW) {
                const float* xrow = XRES + (size_t)r * D; f32x4 v[8]; float ss = 0.f;
#pragma unroll
                for (int j = 0; j < 8; ++j) { v[j] = *(const f32x4*)(xrow + 4 * (lane + 64 * j)); ss += (v[j][0] * v[j][0] + v[j][1] * v[j][1]) + (v[j][2] * v[j][2] + v[j][3] * v[j][3]); }
                const float rstd = rsqrtf(wave_sum(ss) * (1.f / D) + EPS);
                float lg[8];
#pragma unroll
                for (int e = 0; e < 8; ++e) lg[e] = 0.f;
#pragma unroll
                for (int j = 0; j < 8; ++j) { const f32x4 ww = *(const f32x4*)(w + 4 * (lane + 64 * j)); f32x4 y; y[0] = v[j][0] * rstd * ww[0]; y[1] = v[j][1] * rstd * ww[1]; y[2] = v[j][2] * rstd * ww[2]; y[3] = v[j][3] * rstd * ww[3];
                    if (l == 0) { v2u o; o.x = pk2(y[0], y[1]); o.y = pk2(y[2], y[3]); *(v2u*)(H + (size_t)r * D + 4 * (lane + 64 * j)) = o; }
                    else *(unsigned*)(H8 + (size_t)r * D + 4 * (lane + 64 * j)) = pg8::pk4_fp8(y[0], y[1], y[2], y[3]);
                    if (l == 1) {
#pragma unroll
                        for (int c = 0; c < 4; ++c) { const float* rw = router_w + (size_t)(4 * (lane + 64 * j) + c) * 8; const f32x4 r0 = *(const f32x4*)rw, r1 = *(const f32x4*)(rw + 4);
                            lg[0] += y[c] * r0[0]; lg[1] += y[c] * r0[1]; lg[2] += y[c] * r0[2]; lg[3] += y[c] * r0[3]; lg[4] += y[c] * r1[0]; lg[5] += y[c] * r1[1]; lg[6] += y[c] * r1[2]; lg[7] += y[c] * r1[3]; } } }
                if (l == 1) {
#pragma unroll
                    for (int e = 0; e < 8; ++e) lg[e] = wave_sum(lg[e]);
                    int e0 = 0; float v0 = lg[0];
#pragma unroll
                    for (int e = 1; e < 8; ++e) if (lg[e] > v0) { v0 = lg[e]; e0 = e; }
                    int e1 = -1; float v1 = -__builtin_inff();
#pragma unroll
                    for (int e = 0; e < 8; ++e) if (e != e0 && lg[e] > v1) { v1 = lg[e]; e1 = e; }
                    if (lane == 0) { const float p0 = 1.0f / (1.0f + __expf(v1 - v0)); int* ro = ROUTE + (size_t)r * 8;
                        ro[0] = e0; ro[1] = e1; ro[2] = (int)atomicAdd(ctl + CW_CNT + e0, 1u); ro[3] = (int)atomicAdd(ctl + CW_CNT + e1, 1u); ((float*)ro)[4] = p0; ((float*)ro)[5] = 1.0f - p0; }
                }
            }
        }
        SEAM(pb + 10);
        if (l == 0) {
            if (IN(pb + 11)) REP(pb + 11) {
                pg8::Gemm g{H, WGU, T, 2 * DFF, D}; pg8::StaticOrder S; S.init(T, 2 * DFF, F.G, (int)blockIdx.x);
                pg8::EpiSwiglu E{ACT, DFF, 1 << 20};
                pg8::gemm_phase<pg8::EpiSwiglu, pg8::StaticOrder, true, true>(F.lds, g, S, E);
            }
            SEAM(pb + 11);
            if (IN(pb + 12)) REP(pb + 12) {
                pg8::Gemm g{ACT, WDN, T, D, DFF}; pg8::StaticOrder S; S.init(T, D, F.G, (int)blockIdx.x);
                pg8::EpiResid E{XRES, XRES, D, 1.f};
                pg8::gemm_phase<pg8::EpiResid, pg8::StaticOrder, true, true>(F.lds, g, S, E);
            }
            SEAM(pb + 12);
            if (IN(pb + 13)) REP(pb + 13) { for (int r = F.gw; r < T; r += F.NGW) rms_row(XRES + (size_t)r * D, mix_norm_w + D, H + (size_t)r * D, F.lane, H8 + (size_t)r * D); }
            SEAM(pb + 13);
        } else {
#define MOE_OFFSETS() int off[9]; off[0] = 0; _Pragma("unroll") for (int e = 0; e < 8; ++e) { const int c = __builtin_amdgcn_readfirstlane((int)__hip_atomic_load(ctl + CW_CNT + e, __ATOMIC_RELAXED, __HIP_MEMORY_SCOPE_AGENT)); off[e + 1] = off[e] + ((c + 255) & ~255); }
            if (IN(pb + 11)) REP(pb + 11) {
                MOE_OFFSETS();
                for (int it = F.gw; it < T * 2; it += F.NGW) { const int t = it >> 1, k = it & 1; int* ro = ROUTE + (size_t)t * 8; const int e = ro[k], pos = ro[2 + k];
                    int base = 0;
#pragma unroll
                    for (int q = 0; q < 8; ++q) if (e == q) base = off[q];
                    const int slot = base + pos; if (F.lane == 0) ro[6 + k] = slot;
                    const v4u* src = (const v4u*)(H8 + (size_t)t * D); v4u* dst = (v4u*)((unsigned char*)HG + (size_t)slot * D);
#pragma unroll
                    for (int j = 0; j < 2; ++j) dst[F.lane + 64 * j] = src[F.lane + 64 * j]; }
#pragma unroll
                for (int e = 0; e < 8; ++e) { const int c = __builtin_amdgcn_readfirstlane((int)__hip_atomic_load(ctl + CW_CNT + e, __ATOMIC_RELAXED, __HIP_MEMORY_SCOPE_AGENT));
                    for (int rr = off[e] + c + F.gw; rr < off[e + 1]; rr += F.NGW) { v4u* dst = (v4u*)((unsigned char*)HG + (size_t)rr * D);
#pragma unroll
                        for (int j = 0; j < 2; ++j) dst[F.lane + 64 * j] = (v4u){0u, 0u, 0u, 0u}; } }
            }
            SEAM(pb + 11);
            if (IN(pb + 12)) REP(pb + 12) {
                if (F.tid == 0) { MOE_OFFSETS(); int cu = 0;
#pragma unroll
                    for (int e = 0; e < 8; ++e) { const int ne = (off[e + 1] - off[e]) >> 8; MTAB[e] = ne; MTAB[8 + e] = off[e] >> 8; MTAB[16 + e] = cu; cu += ne * 56; } MTAB[24] = cu; MTAB[25] = cu; }
                __syncthreads();
                pg8::Gemm g{HG, WEGU, MAXSLOT, NEXP * 2 * EFF, D / 2}; pg8::MoeOrder S{(const LAS int*)MTAB, 56, F.G, (int)blockIdx.x};
                pg8::EpiSwiglu8 E{(unsigned char*)EACT, EFF, 56, 1.0f / 256.f, 8.f};
                pg8::gemm_phase<pg8::EpiSwiglu8, pg8::MoeOrder, true, true, true>(F.lds, g, S, E);
            }
            SEAM(pb + 12);
            if (IN(pb + 13)) REP(pb + 13) {
                __syncthreads();
                if (F.tid == 0) { MOE_OFFSETS(); int cu = 0;
#pragma unroll
                    for (int e = 0; e < 8; ++e) { const int ne = (off[e + 1] - off[e]) >> 8; MTAB[e] = ne; MTAB[8 + e] = off[e] >> 8; MTAB[16 + e] = cu; cu += ne * 8; } MTAB[24] = cu; MTAB[25] = cu; }
                __syncthreads();
                pg8::Gemm g{EACT, WEDN, MAXSLOT, NEXP * D, EFF / 2}; pg8::MoeOrder S{(const LAS int*)MTAB, 8, F.G, (int)blockIdx.x};
                pg8::EpiStoreF32 E{Y, D, 8, 1.0f / 2048.f};
                pg8::gemm_phase<pg8::EpiStoreF32, pg8::MoeOrder, true, true, true>(F.lds, g, S, E);
            }
            SEAM(pb + 13);
            if (IN(pb + 14)) REP(pb + 14) {
                const int lane = F.lane;
                for (int r = F.gw; r < T; r += F.NGW) { const int* ro = ROUTE + (size_t)r * 8; const float p0 = ((const float*)ro)[4], p1 = ((const float*)ro)[5]; const float* y0 = Y + (size_t)ro[6] * D; const float* y1 = Y + (size_t)ro[7] * D;
                    const float* xrow = XRES + (size_t)r * D; f32x4 v[8]; float ss = 0.f;
#pragma unroll
                    for (int j = 0; j < 8; ++j) { const int o = 4 * (lane + 64 * j); v[j] = *(const f32x4*)(xrow + o) + *(const f32x4*)(y0 + o) * p0 + *(const f32x4*)(y1 + o) * p1; ss += (v[j][0] * v[j][0] + v[j][1] * v[j][1]) + (v[j][2] * v[j][2] + v[j][3] * v[j][3]); }
                    const float rstd = rsqrtf(wave_sum(ss) * (1.f / D) + EPS);
#pragma unroll
                    for (int j = 0; j < 8; ++j) { const int o = 4 * (lane + 64 * j); const f32x4 ww = *(const f32x4*)(final_norm_w + o); *(f32x4*)(args.out + (size_t)r * D + o) = v[j] * rstd * ww; } }
            }
        }
    }
#undef IN
#undef SEAM
}

extern "C" void kernel_launch(void* const* d_in, const int* in_sizes, int n_in, void* d_out, int out_size, void* d_ws, size_t ws_size, hipStream_t stream) {
    static int grid = 0;
    if (grid == 0) {
        if (n_in != 24 || out_size != T * D || ws_size < WS_END) { fprintf(stderr, "kernel_launch: unexpected shapes (n_in %d, out %d, ws %zu < %zu)\n", n_in, out_size, ws_size, (size_t)WS_END); grid = -1; return; }
        int dev = 0, cus = 0, per_cu = 0;
        if (hipGetDevice(&dev) != hipSuccess || hipDeviceGetAttribute(&cus, hipDeviceAttributeMultiprocessorCount, dev) != hipSuccess) { grid = -1; return; }
        if (hipFuncSetAttribute((const void*)mk_fwd, hipFuncAttributeMaxDynamicSharedMemorySize, LDS_BYTES) != hipSuccess) { fprintf(stderr, "kernel_launch: hipFuncSetAttribute failed\n"); grid = -1; return; }
        if (hipOccupancyMaxActiveBlocksPerMultiprocessor(&per_cu, (const void*)mk_fwd, NWAVES * 64, LDS_BYTES) != hipSuccess || per_cu < 1) fprintf(stderr, "kernel_launch: occupancy query says %d\n", per_cu);
        (void)hipGetLastError();
        grid = cus;
    }
    if (grid < 0) return;
    (void)hipMemsetAsync((char*)d_ws + WS_CTL, 0, CTL_BYTES, stream);
    Args a{};
    for (int i = 0; i < 24; ++i) a.in[i] = d_in[i];
    a.out = (float*)d_out; a.ws = (unsigned char*)d_ws;
#if MK_ONE_LAUNCH
    a.ph_lo = 0; a.ph_hi = NPH;
    hipLaunchKernelGGL(mk_fwd, dim3(grid), dim3(NWAVES * 64), LDS_BYTES, stream, a);
#else
#ifndef DUP_MASK
#define DUP_MASK 0ull
#endif
    for (int p = 0; p < NPH; ++p) { a.ph_lo = p; a.ph_hi = p + 1; const int reps = ((DUP_MASK >> p) & 1ull) ? 2 : 1;
        for (int r = 0; r < reps; ++r) hipLaunchKernelGGL(mk_fwd, dim3(grid), dim3(NWAVES * 64), LDS_BYTES, stream, a);
#ifdef MIX_EXTRA
        if (p == 4) { a.ph_hi = 100 + MIX_EXTRA; hipLaunchKernelGGL(mk_fwd, dim3(grid), dim3(NWAVES * 64), LDS_BYTES, stream, a); }
#endif
    }
#endif
}
```

```cpp
#include <hip/hip_runtime.h>
#include <cstdio>
#include <cstdint>
#define MK_ONE_LAUNCH 1
namespace pg8 {
#define PG8_LAS __attribute__((address_space(3)))
typedef unsigned short bf16_t;
typedef short bf16x8 __attribute__((ext_vector_type(8)));
typedef float f32x4 __attribute__((ext_vector_type(4)));
typedef unsigned u32x4 __attribute__((ext_vector_type(4)));
typedef int i32x4 __attribute__((ext_vector_type(4)));
constexpr int BM = 256, BK = 64, HALF = 128, HTB = HALF * BK * 2  , STAGE_BYTES = 8 * HTB, NXCD = 8, WGM = 8;

__host__ __device__ __forceinline__ int lds_byte(int r, int c) { const int st = (r >> 4) * 2 + (c >> 5), rr = r & 15, cc = c & 31, ob = rr * 64 + cc * 2; return st * 1024 + (ob ^ (((ob >> 9) & 1) << 5)); }
__host__ __device__ __forceinline__ void stage_rc(int b, int& R, int& C) { const int st = b / 1024, sb = b % 1024, swz = sb ^ (((sb >> 9) & 1) << 5); R = (st >> 1) * 16 + swz / 64; C = (st & 1) * 32 + (swz % 64) / 2; }
__host__ __device__ __forceinline__ int perm32(int rho) { const int n = rho >> 4, i = rho & 15; return 8 * (i >> 2) + 4 * n + (i & 3); }

struct Unit { int pm, pn; };
struct Gemm { const bf16_t* A; const bf16_t* Bt; int M, N, K; };

struct StaticOrder {
    int nM, nN, nwg, G, c;
    __host__ __device__ void init(int M, int N, int G_, int c_) { nM = M / BM; nN = N / BM; nwg = nM * nN; G = G_; c = c_; }
    __host__ __device__ bool next(int i, Unit& u) const {
        const long L = (long)i * G + c; if (L >= nwg) return false;
        int wgid = (int)L; { const int q = nwg / NXCD, r = nwg % NXCD, xcd = wgid % NXCD, off = wgid / NXCD; wgid = (xcd < r ? xcd * (q + 1) : r * (q + 1) + (xcd - r) * q) + off; }
        const int nig = WGM * nN, gid = wgid / nig, fm = gid * WGM, gsz = (nM - fm) < WGM ? (nM - fm) : WGM;
        u.pm = fm + ((wgid % nig) % gsz); u.pn = (wgid % nig) / gsz; return true;
    }
    __device__ __forceinline__ void a_ready(const Unit&) const {}
    __device__ __forceinline__ void done(const Unit&) const {}
};

typedef float cvt_f32x2_t __attribute__((ext_vector_type(2))); typedef __bf16 cvt_bf16x2_t __attribute__((ext_vector_type(2)));
__device__ __forceinline__ unsigned cvt_pk_bf16(float lo, float hi) { const cvt_f32x2_t v = {lo, hi}; const cvt_bf16x2_t b = __builtin_convertvector(v, cvt_bf16x2_t); return __builtin_bit_cast(unsigned, b); }
typedef float f32x2 __attribute__((ext_vector_type(2)));
__device__ __forceinline__ float fsigm(float v) { return __builtin_amdgcn_rcpf(1.0f + __builtin_amdgcn_exp2f(-1.4426950408889634f * v)); }
__device__ __forceinline__ float fsilu(float v) { return v * fsigm(v); }
__device__ __forceinline__ void st8bf(bf16_t* p, f32x4 v0, f32x4 v1) { u32x4 w; w.x = cvt_pk_bf16(v0[0], v0[1]); w.y = cvt_pk_bf16(v0[2], v0[3]); w.z = cvt_pk_bf16(v1[0], v1[1]); w.w = cvt_pk_bf16(v1[2], v1[3]); *(u32x4*)p = w; }
__device__ __forceinline__ bf16_t f2bf1(float f) { unsigned u = __builtin_bit_cast(unsigned, f); return (bf16_t)((u + 0x7fffu + ((u >> 16) & 1u)) >> 16); }

struct EpiIn {
    static constexpr bool PERM = true, AFTER_DRAIN = false, HOOK = false;
    bf16_t *RQ, *RK, *RVT, *RG, *BQKV, *BZ, *CQ, *CK, *CVT, *GATES; float* BBA; int set; float sc8;
    __device__ __forceinline__ void operator()(const f32x4 (&acc_)[2][2][4][2], const Unit& u, int wr, int wc, int fr, int fq) const {
        f32x4 acc[2][2][4][2];
#pragma unroll
        for (int a_ = 0; a_ < 2; ++a_)
#pragma unroll
            for (int b_ = 0; b_ < 2; ++b_)
#pragma unroll
                for (int m_ = 0; m_ < 4; ++m_)
#pragma unroll
                    for (int n_ = 0; n_ < 2; ++n_) acc[a_][b_][m_][n_] = set ? acc_[a_][b_][m_][n_] * sc8 : acc_[a_][b_][m_][n_];
        const int lp = u.pn, pn = set == 0 ? (lp < 44 ? lp : 68) : lp + 44, b = u.pm >> 3;
        const int rowt = u.pm * BM + wr * 64 + fr;
        const int cin = wc * 32 + 8 * fq;
        if (pn < 8 || (pn >= 32 && pn < 40)) {
            auto heads = [&](bf16_t* base, int hb, float sc) __attribute__((always_inline)) {
#pragma unroll
                for (int ai = 0; ai < 2; ++ai)
#pragma unroll
                    for (int m = 0; m < 4; ++m) { const int s = (rowt + ai * HALF + m * 16) - b * 2048;
#pragma unroll
                        for (int bj = 0; bj < 2; ++bj) st8bf(base + ((size_t)((b * 8 + hb + bj) * 2048 + s)) * 128 + cin, acc[ai][bj][m][0] * sc, acc[ai][bj][m][1] * sc); } };
            if (pn < 4) heads(RQ, pn * 2, 1.f); else if (pn < 8) heads(RK, (pn - 4) * 2, 0.08838834764831845f);
            else if (pn < 36) heads(CQ, (pn - 32) * 2, 1.f); else heads(CK, (pn - 36) * 2, 1.f);
        } else if ((pn >= 40 && pn < 44) || (pn >= 8 && pn < 12)) {
            const bool isr = pn < 12; const int h = isr ? pn - 8 : pn - 40; bf16_t* CVT = isr ? RVT : this->CVT;
#pragma unroll
            for (int ai = 0; ai < 2; ++ai)
#pragma unroll
                for (int m = 0; m < 4; ++m) { const int s = (rowt + ai * HALF + m * 16) - b * 2048;
#pragma unroll
                    for (int bj = 0; bj < 2; ++bj)
#pragma unroll
                        for (int n = 0; n < 2; ++n)
#pragma unroll
                            for (int e = 0; e < 4; ++e) CVT[((size_t)((b * 4 + h) * 256 + bj * HALF + cin + 4 * n + e)) * 2048 + s] = f2bf1(acc[ai][bj][m][n][e]); }
        } else if (pn == 68) {
            if (wc == 0 && fq < 2) {
#pragma unroll
                for (int ai = 0; ai < 2; ++ai)
#pragma unroll
                    for (int m = 0; m < 4; ++m) { float* p = BBA + (size_t)(rowt + ai * HALF + m * 16) * 16 + 8 * fq; *(f32x4*)p = acc[ai][0][m][0]; *(f32x4*)(p + 4) = acc[ai][0][m][1]; }
            }
        } else {
            auto rows = [&](bf16_t* base, int ldc, int c0, int act) __attribute__((always_inline)) {
#pragma unroll
                for (int ai = 0; ai < 2; ++ai)
#pragma unroll
                    for (int m = 0; m < 4; ++m) { bf16_t* rowp = base + (size_t)(rowt + ai * HALF + m * 16) * ldc + c0 + cin;
#pragma unroll
                        for (int bj = 0; bj < 2; ++bj) { f32x4 v0 = acc[ai][bj][m][0], v1 = acc[ai][bj][m][1];
                            if (act == 1) {
#pragma unroll
                                for (int e = 0; e < 4; ++e) { v0[e] = fsilu(v0[e]); v1[e] = fsilu(v1[e]); } }
                            else if (act == 2) {
#pragma unroll
                                for (int e = 0; e < 4; ++e) { v0[e] = fsigm(v0[e]); v1[e] = fsigm(v1[e]); } }
                            st8bf(rowp + bj * HALF, v0, v1); } } };
            if (pn < 16) rows(RG, 1024, (pn - 12) * 256, 1); else if (pn < 28) rows(BQKV, 3072, (pn - 16) * 256, 0);
            else if (pn < 32) rows(BZ, 1024, (pn - 28) * 256, 1); else rows(GATES, 6144, (pn - 44) * 256, 2);
        }
    }
};

struct EpiHeads {
    static constexpr bool PERM = true, AFTER_DRAIN = false, HOOK = false;
    bf16_t* O; bf16_t* VT; int NH, rpb_shift  , vt_from_pn;
    __device__ __forceinline__ void operator()(const f32x4 (&acc)[2][2][4][2], const Unit& u, int wr, int wc, int fr, int fq) const {
        const int rowt = u.pm * BM + wr * 64 + fr, cin = wc * 32 + 8 * fq, rpb = 1 << rpb_shift;
        if (u.pn < vt_from_pn) {
#pragma unroll
            for (int ai = 0; ai < 2; ++ai)
#pragma unroll
                for (int m = 0; m < 4; ++m) { const int row = rowt + ai * HALF + m * 16, b = row >> rpb_shift, s = row & (rpb - 1);
#pragma unroll
                    for (int bj = 0; bj < 2; ++bj) st8bf(O + ((size_t)((b * NH + u.pn * 2 + bj) * rpb + s)) * 128 + cin, acc[ai][bj][m][0], acc[ai][bj][m][1]); }
        } else {
            const int hb = (u.pn - vt_from_pn) * 2;
#pragma unroll
            for (int ai = 0; ai < 2; ++ai)
#pragma unroll
                for (int m = 0; m < 4; ++m) { const int row = rowt + ai * HALF + m * 16, b = row >> rpb_shift, s = row & (rpb - 1);
#pragma unroll
                    for (int bj = 0; bj < 2; ++bj)
#pragma unroll
                        for (int n = 0; n < 2; ++n)
#pragma unroll
                            for (int e = 0; e < 4; ++e) VT[((size_t)((b * NH + hb + bj) * 128 + cin + 4 * n + e)) * rpb + s] = f2bf1(acc[ai][bj][m][n][e]); }
        }
    }
};

struct EpiResid {
    static constexpr bool PERM = false, AFTER_DRAIN = false, HOOK = false;
    const float* in; float* out; int ldc; float sc;
    __device__ __forceinline__ void operator()(const f32x4 (&acc)[2][2][4][2], const Unit& u, int wr, int wc, int fr, int fq) const {
        const int row0 = u.pm * BM + wr * 64 + fr, col0 = u.pn * BM + wc * 32 + 4 * fq;
        f32x4 x[2][2][2];
#pragma unroll
        for (int bj = 0; bj < 2; ++bj)
#pragma unroll
            for (int n = 0; n < 2; ++n) x[0][bj][n] = *(const f32x4*)(in + (size_t)row0 * ldc + col0 + bj * HALF + n * 16);
#pragma unroll
        for (int gidx = 0; gidx < 8; ++gidx) { const int ai = gidx >> 2, m = gidx & 3; const size_t off = (size_t)(row0 + ai * HALF + m * 16) * ldc + col0;
            if (gidx + 1 < 8) { const int ai2 = (gidx + 1) >> 2, m2 = (gidx + 1) & 3; const size_t off2 = (size_t)(row0 + ai2 * HALF + m2 * 16) * ldc + col0;
#pragma unroll
                for (int bj = 0; bj < 2; ++bj)
#pragma unroll
                    for (int n = 0; n < 2; ++n) x[(gidx + 1) & 1][bj][n] = *(const f32x4*)(in + off2 + bj * HALF + n * 16); }
#pragma unroll
            for (int bj = 0; bj < 2; ++bj)
#pragma unroll
                for (int n = 0; n < 2; ++n) *(f32x4*)(out + off + bj * HALF + n * 16) = x[gidx & 1][bj][n] + acc[ai][bj][m][n] * sc; }
    }
};

struct EpiBranch {
    static constexpr bool PERM = false, AFTER_DRAIN = false, HOOK = true;
    bf16_t* OUT; const bf16_t* GATES; int hk0, hk1;
    typedef unsigned u32x2 __attribute__((ext_vector_type(2)));
    static __device__ __forceinline__ f32x4 g4(const bf16_t* p) { const u32x2 gw = *(const u32x2*)p; f32x4 g; g[0] = __uint_as_float(gw.x << 16); g[1] = __uint_as_float(gw.x & 0xffff0000u); g[2] = __uint_as_float(gw.y << 16); g[3] = __uint_as_float(gw.y & 0xffff0000u); return g; }
    __device__ __forceinline__ void hook(f32x4 (&acc)[2][2][4][2], const Unit& u, int s, int wr, int wc, int fr, int fq) const {
        int z_ = 0; asm volatile("" : "+v"(z_));
        const int row0 = u.pm * BM + wr * 64 + fr + z_, col0 = u.pn * BM + wc * 32 + 4 * fq;
#pragma unroll
        for (int ai = 0; ai < 2; ++ai)
#pragma unroll
            for (int mp = 0; mp < 2; ++mp) {
                u32x2 ga[2][2][2], gb[2][2][2];
#pragma unroll
                for (int mm = 0; mm < 2; ++mm) { const bf16_t* gp = GATES + (size_t)(row0 + ai * HALF + (2 * mp + mm) * 16) * 6144 + s * 2048 + col0;
#pragma unroll
                    for (int bj = 0; bj < 2; ++bj)
#pragma unroll
                        for (int n = 0; n < 2; ++n) { ga[mm][bj][n] = *(const u32x2*)(gp + bj * HALF + n * 16); gb[mm][bj][n] = *(const u32x2*)(gp + 2048 + bj * HALF + n * 16); } }
#pragma unroll
                for (int mm = 0; mm < 2; ++mm)
#pragma unroll
                    for (int bj = 0; bj < 2; ++bj)
#pragma unroll
                        for (int n = 0; n < 2; ++n) { const u32x2 a = ga[mm][bj][n], b = gb[mm][bj][n]; f32x4& v = acc[ai][bj][2 * mp + mm][n];
                            v[0] *= __uint_as_float(a.x << 16) * __builtin_amdgcn_rcpf(__builtin_fmaxf(__uint_as_float(b.x << 16), 1e-30f));
                            v[1] *= __uint_as_float(a.x & 0xffff0000u) * __builtin_amdgcn_rcpf(__builtin_fmaxf(__uint_as_float(b.x & 0xffff0000u), 1e-30f));
                            v[2] *= __uint_as_float(a.y << 16) * __builtin_amdgcn_rcpf(__builtin_fmaxf(__uint_as_float(b.y << 16), 1e-30f));
                            v[3] *= __uint_as_float(a.y & 0xffff0000u) * __builtin_amdgcn_rcpf(__builtin_fmaxf(__uint_as_float(b.y & 0xffff0000u), 1e-30f)); }
            }
    }
    __device__ __forceinline__ void operator()(const f32x4 (&acc)[2][2][4][2], const Unit& u, int wr, int wc, int fr, int fq) const {
        const int row0 = u.pm * BM + wr * 64 + fr, col0 = u.pn * BM + wc * 32 + 4 * fq;
        f32x4 gt[2][2][2];
#pragma unroll
        for (int bj = 0; bj < 2; ++bj)
#pragma unroll
            for (int n = 0; n < 2; ++n) gt[0][bj][n] = g4(GATES + (size_t)row0 * 6144 + 4096 + col0 + bj * HALF + n * 16);
#pragma unroll
        for (int gidx = 0; gidx < 8; ++gidx) { const int ai = gidx >> 2, m = gidx & 3, row = row0 + ai * HALF + m * 16;
            if (gidx + 1 < 8) { const int row2 = row0 + ((gidx + 1) >> 2) * HALF + ((gidx + 1) & 3) * 16;
#pragma unroll
                for (int bj = 0; bj < 2; ++bj)
#pragma unroll
                    for (int n = 0; n < 2; ++n) gt[(gidx + 1) & 1][bj][n] = g4(GATES + (size_t)row2 * 6144 + 4096 + col0 + bj * HALF + n * 16); }
#pragma unroll
            for (int bj = 0; bj < 2; ++bj)
#pragma unroll
                for (int n = 0; n < 2; ++n) { const f32x4 v = gt[gidx & 1][bj][n] * acc[ai][bj][m][n];
                    u32x2 w; w.x = cvt_pk_bf16(v[0], v[1]); w.y = cvt_pk_bf16(v[2], v[3]); *(u32x2*)(OUT + (size_t)row * 2048 + col0 + bj * HALF + n * 16) = w; } }
    }
};

struct EpiSwiglu {
    static constexpr bool PERM = true, AFTER_DRAIN = false, HOOK = false;
    bf16_t* O; int ldc, npn;
    __device__ __forceinline__ void operator()(const f32x4 (&acc)[2][2][4][2], const Unit& u, int wr, int wc, int fr, int fq) const {
        const int row0 = u.pm * BM + wr * 64 + fr, col0 = (u.pn % npn) * HALF + wc * 32 + 8 * fq;
#pragma unroll
        for (int ai = 0; ai < 2; ++ai)
#pragma unroll
            for (int m = 0; m < 4; ++m) { f32x4 v0, v1;
#pragma unroll
                for (int e = 0; e < 4; ++e) { v0[e] = fsilu(acc[ai][0][m][0][e]) * acc[ai][1][m][0][e]; v1[e] = fsilu(acc[ai][0][m][1][e]) * acc[ai][1][m][1][e]; }
                st8bf(O + (size_t)(row0 + ai * HALF + m * 16) * ldc + col0, v0, v1); }
    }
};


__device__ __forceinline__ float clamp8(float v) { return __builtin_fminf(__builtin_fmaxf(v, -448.f), 448.f); }
__device__ __forceinline__ unsigned pk4_fp8(float a, float b, float c, float d) { int r = 0; r = __builtin_amdgcn_cvt_pk_fp8_f32(clamp8(a), clamp8(b), r, false); r = __builtin_amdgcn_cvt_pk_fp8_f32(clamp8(c), clamp8(d), r, true); return (unsigned)r; }
struct EpiSwiglu8 {
    static constexpr bool PERM = true, AFTER_DRAIN = false, HOOK = false;
    unsigned char* O; int ldc, npn; float ws, as;
    __device__ __forceinline__ void operator()(const f32x4 (&acc)[2][2][4][2], const Unit& u, int wr, int wc, int fr, int fq) const {
        typedef unsigned u32x2 __attribute__((ext_vector_type(2)));
        const int row0 = u.pm * BM + wr * 64 + fr, col0 = (u.pn % npn) * HALF + wc * 32 + 8 * fq;
#pragma unroll
        for (int ai = 0; ai < 2; ++ai)
#pragma unroll
            for (int m = 0; m < 4; ++m) { float v[8];
#pragma unroll
                for (int n = 0; n < 2; ++n)
#pragma unroll
                    for (int e = 0; e < 4; ++e) v[4 * n + e] = fsilu(acc[ai][0][m][n][e] * ws) * (acc[ai][1][m][n][e] * ws) * as;
                u32x2 o; o.x = pk4_fp8(v[0], v[1], v[2], v[3]); o.y = pk4_fp8(v[4], v[5], v[6], v[7]);
                *(u32x2*)(O + (size_t)(row0 + ai * HALF + m * 16) * ldc + col0) = o; }
    }
};

struct EpiStoreF32 {
    static constexpr bool PERM = false, AFTER_DRAIN = false, HOOK = false;
    float* Y; int ldc, npn; float sc;
    __device__ __forceinline__ void operator()(const f32x4 (&acc)[2][2][4][2], const Unit& u, int wr, int wc, int fr, int fq) const {
        const int row0 = u.pm * BM + wr * 64 + fr, col0 = (u.pn % npn) * BM + wc * 32 + 4 * fq;
#pragma unroll
        for (int ai = 0; ai < 2; ++ai)
#pragma unroll
            for (int m = 0; m < 4; ++m) { float* rowp = Y + (size_t)(row0 + ai * HALF + m * 16) * ldc + col0;
#pragma unroll
                for (int bj = 0; bj < 2; ++bj)
#pragma unroll
                    for (int n = 0; n < 2; ++n) *(f32x4*)(rowp + bj * HALF + n * 16) = acc[ai][bj][m][n] * sc; }
    }
};

struct MoeOrder {
    const PG8_LAS int* T; int npn, G, c;
    __device__ __forceinline__ int rd(int k) const { return __builtin_amdgcn_readfirstlane(T[k]); }
    __device__ __forceinline__ bool next(int i, Unit& u) const {
        const int total = rd(25); const long L = (long)i * G + c; if (L >= total) return false;
        int wgid = (int)L; { const int q = total / NXCD, r = total % NXCD, xcd = wgid % NXCD, off = wgid / NXCD; wgid = (xcd < r ? xcd * (q + 1) : r * (q + 1) + (xcd - r) * q) + off; }
        int e = 0, cue = 0;
#pragma unroll
        for (int k = 1; k < 8; ++k) { const int ck = rd(16 + k); if (wgid >= ck) { e = k; cue = ck; } }
        const int loc = wgid - cue, ne = rd(e), r0 = rd(8 + e);
        u.pm = r0 + loc % ne; u.pn = e * npn + loc / ne; return true;
    }
    __device__ __forceinline__ void a_ready(const Unit&) const {}
    __device__ __forceinline__ void done(const Unit&) const {}
};

struct SegOrder {
    int nM, nN, nseg, G, c;
    __device__ __forceinline__ bool next(int i, Unit& u) const {
        const int nwg = nM * nN; const long L = (long)i * G + c; if (L >= (long)nseg * nwg) return false;
        const int s = (int)(L / nwg); int wgid = (int)(L % nwg); { const int q = nwg / NXCD, r = nwg % NXCD, xcd = wgid % NXCD, off = wgid / NXCD; wgid = (xcd < r ? xcd * (q + 1) : r * (q + 1) + (xcd - r) * q) + off; }
        const int nig = WGM * nN, gid = wgid / nig, fm = gid * WGM, gsz = (nM - fm) < WGM ? (nM - fm) : WGM;
        u.pm = s * nM + fm + ((wgid % nig) % gsz); u.pn = s * nN + (wgid % nig) / gsz; return true;
    }
    __device__ __forceinline__ void a_ready(const Unit&) const {}
    __device__ __forceinline__ void done(const Unit&) const {}
};
template <class Epi, class Sched, bool ALIGN_EPI = false, bool SP2 = false, bool F8 = false>
__device__ __forceinline__ void gemm_phase(PG8_LAS unsigned char* lds, const Gemm g, const Sched& S, const Epi& E) {
    int tid_ = threadIdx.x; asm volatile("" : "+v"(tid_)); const int tid = tid_, wid = __builtin_amdgcn_readfirstlane(tid >> 6), lane = tid & 63, wr = wid >> 2, wc = wid & 3, fr = lane & 15, fq = lane >> 4;
    const int K = g.K, nt = K / BK; typedef int i32x8 __attribute__((ext_vector_type(8))); int f8scale_ = 0x7f7f7f7f; asm volatile("" : "+v"(f8scale_));
    unsigned voffA[2], voffB[2];
#pragma unroll
    for (int i = 0; i < 2; ++i) { int R, C; stage_rc(tid * 16 + i * 8192, R, C); const int Rb = Epi::PERM ? ((R & ~31) + perm32(R & 31)) : R;
        voffA[i] = (unsigned)(R * K + C) * 2u; voffB[i] = (unsigned)(Rb * K + C) * 2u; }
    const size_t kstep = (size_t)(BK * 2);
    const size_t hstep = (size_t)HALF * K * 2;
    const size_t tstep = 2 * hstep;
    const unsigned ldsw = (unsigned)wid * 1024u;
    const int aoff = lds_byte(wr * 64 + fr, fq * 8), boff = lds_byte(wc * 32 + fr, fq * 8);
#define PG8_SA(b, h) (((b) * 2 + (h)) * HTB)
#define PG8_SB(b, h) ((4 + (b) * 2 + (h)) * HTB)
#define PG8_STAGE(bufoff, gbase, voff) do { _Pragma("unroll") for (int _i = 0; _i < 2; ++_i) \
        __builtin_amdgcn_global_load_lds((const unsigned*)((const char*)(gbase) + (voff)[_i]), (PG8_LAS unsigned*)(lds + (bufoff) + ldsw + _i * 8192), 16, 0, 0); } while (0)
#define PG8_LDA(dst, b, h) do { _Pragma("unroll") for (int m = 0; m < 4; ++m) _Pragma("unroll") for (int k = 0; k < 2; ++k) dst[m][k] = *(const PG8_LAS bf16x8*)(lds + PG8_SA(b, h) + aoff + m * 2048 + k * 1024); } while (0)
#define PG8_LDB(dst, b, h) do { _Pragma("unroll") for (int n = 0; n < 2; ++n) _Pragma("unroll") for (int k = 0; k < 2; ++k) dst[n][k] = *(const PG8_LAS bf16x8*)(lds + PG8_SB(b, h) + boff + n * 2048 + k * 1024); } while (0)
#define PG8_MMA(ai, bj, At, Bt) do { __builtin_amdgcn_s_setprio(1); \
        if constexpr (F8) { _Pragma("unroll") for (int m = 0; m < 4; ++m) _Pragma("unroll") for (int n = 0; n < 2; ++n) { \
            const i32x4 b0_ = __builtin_bit_cast(i32x4, Bt[n][0]), b1_ = __builtin_bit_cast(i32x4, Bt[n][1]), a0_ = __builtin_bit_cast(i32x4, At[m][0]), a1_ = __builtin_bit_cast(i32x4, At[m][1]); \
            const i32x8 bb_ = __builtin_shufflevector(b0_, b1_, 0, 1, 2, 3, 4, 5, 6, 7), aa_ = __builtin_shufflevector(a0_, a1_, 0, 1, 2, 3, 4, 5, 6, 7); \
            asm volatile("v_mfma_scale_f32_16x16x128_f8f6f4 %0, %1, %2, %0, %3, %3 op_sel_hi:[0,0,0]" : "+v"(acc[ai][bj][m][n]) : "v"(bb_), "v"(aa_), "v"(f8scale_)); } } \
        else { _Pragma("unroll") for (int m = 0; m < 4; ++m) _Pragma("unroll") for (int n = 0; n < 2; ++n) _Pragma("unroll") for (int k = 0; k < 2; ++k) \
        acc[ai][bj][m][n] = __builtin_amdgcn_mfma_f32_16x16x32_bf16(Bt[n][k], At[m][k], acc[ai][bj][m][n], 0, 0, 0); } __builtin_amdgcn_s_setprio(0); } while (0)
#define PG8_WAIT_V(n) asm volatile("s_waitcnt vmcnt(" #n ")" ::: "memory")
#define PG8_WAIT_L(n) asm volatile("s_waitcnt lgkmcnt(" #n ")" ::: "memory")
#define PG8_BAR __builtin_amdgcn_s_barrier()
#define PG8_SCHED __builtin_amdgcn_sched_barrier(0)
    Unit cur, nxt; int ui = 0;
    if (!S.next(0, cur)) return;
    f32x4 acc[2][2][4][2];
#pragma unroll
    for (int a = 0; a < 2; ++a)
#pragma unroll
        for (int b = 0; b < 2; ++b)
#pragma unroll
            for (int m = 0; m < 4; ++m)
#pragma unroll
                for (int n = 0; n < 2; ++n) acc[a][b][m][n] = (f32x4){0.f, 0.f, 0.f, 0.f};
    bf16x8 At[4][2], B0[2][2], B1[2][2];
    const char* cA = (const char*)g.A + (size_t)cur.pm * tstep; const char* cB = (const char*)g.Bt + (size_t)cur.pn * tstep;
    S.a_ready(cur);
    if constexpr (SP2) {
        PG8_STAGE(PG8_SB(0, 0), cB, voffB); PG8_STAGE(PG8_SB(0, 1), cB + hstep, voffB); PG8_STAGE(PG8_SA(0, 0), cA, voffA); PG8_STAGE(PG8_SA(0, 1), cA + hstep, voffA);
        if (wr == 1) PG8_BAR;
        PG8_WAIT_V(2); PG8_BAR;
        PG8_STAGE(PG8_SB(1, 0), cB + kstep, voffB); PG8_STAGE(PG8_SA(1, 0), cA + kstep, voffA); PG8_STAGE(PG8_SB(1, 1), cB + hstep + kstep, voffB);
        PG8_WAIT_V(6); PG8_BAR;
    } else {
        PG8_STAGE(PG8_SB(0, 0), cB, voffB); PG8_STAGE(PG8_SA(0, 0), cA, voffA); PG8_STAGE(PG8_SB(0, 1), cB + hstep, voffB); PG8_STAGE(PG8_SA(0, 1), cA + hstep, voffA);
        if (wr == 1) PG8_BAR;
        PG8_WAIT_V(4); PG8_BAR;
        PG8_STAGE(PG8_SB(1, 0), cB + kstep, voffB); PG8_STAGE(PG8_SA(1, 0), cA + kstep, voffA); PG8_STAGE(PG8_SB(1, 1), cB + hstep + kstep, voffB);
        PG8_WAIT_V(6); PG8_BAR;
    }
    for (;;) {
        const bool has_next = S.next(ui + 1, nxt);
        const char* nA = has_next ? (const char*)g.A + (size_t)nxt.pm * tstep : cA; const char* nB = has_next ? (const char*)g.Bt + (size_t)nxt.pn * tstep : cB;
        for (int t = 0; t < nt; t += 2) {
            const bool last = (t == nt - 2);
            const char* a1 = cA + (size_t)(t + 1) * kstep;
            const char* a2 = last ? nA : cA + (size_t)(t + 2) * kstep; const char* b2 = last ? nB : cB + (size_t)(t + 2) * kstep;
            const char* a3 = a2 + kstep; const char* b3 = b2 + kstep;
            if (last && has_next) S.a_ready(nxt);
            if constexpr (Epi::HOOK) { if (t == E.hk0 || t == E.hk1) E.hook(acc, cur, t == E.hk0 ? 0 : 1, wr, wc, fr, fq); }
            if constexpr (SP2) {
            PG8_LDB(B0, 0, 0); PG8_LDB(B1, 0, 1); PG8_SCHED; PG8_LDA(At, 0, 0); PG8_STAGE(PG8_SA(1, 1), a1 + hstep, voffA);
            PG8_WAIT_V(8); PG8_WAIT_L(0); PG8_BAR; PG8_MMA(0, 0, At, B0); PG8_MMA(0, 1, At, B1); PG8_BAR; PG8_SCHED;
            PG8_LDA(At, 0, 1); PG8_STAGE(PG8_SB(0, 0), b2, voffB); PG8_STAGE(PG8_SB(0, 1), b2 + hstep, voffB); PG8_STAGE(PG8_SA(0, 0), a2, voffA);
            PG8_WAIT_V(8); PG8_WAIT_L(0); PG8_BAR; PG8_MMA(1, 0, At, B0); PG8_MMA(1, 1, At, B1); PG8_BAR; PG8_SCHED;
            PG8_LDB(B0, 1, 0); PG8_LDB(B1, 1, 1); PG8_SCHED; PG8_LDA(At, 1, 0); PG8_STAGE(PG8_SA(0, 1), a2 + hstep, voffA);
            PG8_WAIT_V(8); PG8_WAIT_L(0); PG8_BAR; PG8_MMA(0, 0, At, B0); PG8_MMA(0, 1, At, B1); PG8_BAR; PG8_SCHED;
            PG8_LDA(At, 1, 1); PG8_STAGE(PG8_SB(1, 0), b3, voffB); PG8_STAGE(PG8_SB(1, 1), b3 + hstep, voffB); PG8_STAGE(PG8_SA(1, 0), a3, voffA);
            PG8_WAIT_V(8); PG8_WAIT_L(0); PG8_BAR; PG8_MMA(1, 0, At, B0); PG8_MMA(1, 1, At, B1); PG8_BAR; PG8_SCHED;
            } else {
            PG8_LDB(B0, 0, 0); PG8_SCHED; PG8_LDA(At, 0, 0); PG8_STAGE(PG8_SA(1, 1), a1 + hstep, voffA);
            PG8_WAIT_L(8); PG8_BAR; PG8_WAIT_L(0); PG8_MMA(0, 0, At, B0); PG8_BAR; PG8_SCHED;
            PG8_LDB(B1, 0, 1); PG8_STAGE(PG8_SB(0, 0), b2, voffB);
            PG8_BAR; PG8_WAIT_L(0); PG8_MMA(0, 1, At, B1); PG8_BAR;
            PG8_LDA(At, 0, 1); PG8_STAGE(PG8_SA(0, 0), a2, voffA);
            PG8_BAR; PG8_WAIT_L(0); PG8_MMA(1, 0, At, B0); PG8_BAR; PG8_SCHED;
            PG8_STAGE(PG8_SB(0, 1), b2 + hstep, voffB);
            PG8_WAIT_V(6); PG8_BAR; PG8_MMA(1, 1, At, B1); PG8_BAR;
            PG8_LDB(B0, 1, 0); PG8_SCHED; PG8_LDA(At, 1, 0); PG8_STAGE(PG8_SA(0, 1), a2 + hstep, voffA);
            PG8_WAIT_L(8); PG8_BAR; PG8_WAIT_L(0); PG8_MMA(0, 0, At, B0); PG8_BAR; PG8_SCHED;
            PG8_LDB(B1, 1, 1); PG8_STAGE(PG8_SB(1, 0), b3, voffB);
            PG8_BAR; PG8_WAIT_L(0); PG8_MMA(0, 1, At, B1); PG8_BAR;
            PG8_LDA(At, 1, 1); PG8_STAGE(PG8_SA(1, 0), a3, voffA);
            PG8_BAR; PG8_WAIT_L(0); PG8_MMA(1, 0, At, B0); PG8_BAR; PG8_SCHED;
            PG8_STAGE(PG8_SB(1, 1), b3 + hstep, voffB);
            PG8_WAIT_V(6); PG8_BAR; PG8_MMA(1, 1, At, B1); PG8_BAR;
            }
        }
        if constexpr (ALIGN_EPI) { if (wr == 0) PG8_BAR; }
        if constexpr (F8) asm volatile("s_nop 15\n\ts_nop 15" ::: "memory");
        if constexpr (!Epi::AFTER_DRAIN) { E(acc, cur, wr, wc, fr, fq); S.done(cur); }
        if (!has_next) break;
#pragma unroll
        for (int a = 0; a < 2; ++a)
#pragma unroll
            for (int b = 0; b < 2; ++b)
#pragma unroll
                for (int m = 0; m < 4; ++m)
#pragma unroll
                    for (int n = 0; n < 2; ++n) acc[a][b][m][n] = (f32x4){0.f, 0.f, 0.f, 0.f};
        cur = nxt; cA = nA; cB = nB; ++ui;
        if constexpr (ALIGN_EPI) { if (wr == 1) PG8_BAR; }
    }
    PG8_WAIT_V(0);
    if constexpr (!ALIGN_EPI) { if (wr == 0) PG8_BAR; }
    PG8_BAR;
    if constexpr (Epi::AFTER_DRAIN) { E.fused(acc, cur, wr, wc, fr, fq, lds, wid, lane); S.done(cur); }
#undef PG8_SA
#undef PG8_SB
#undef PG8_STAGE
#undef PG8_LDA
#undef PG8_LDB
#undef PG8_MMA
#undef PG8_WAIT_V
#undef PG8_WAIT_L
#undef PG8_BAR
#undef PG8_SCHED
}
}
#ifndef MK_ONE_LAUNCH
#define MK_ONE_LAUNCH 0
#endif
constexpr int NWAVES = 8;
constexpr int NB = 4, SEQ = 2048, T = NB * SEQ, D = 2048, MEML = 256, MEMR = NB * MEML;
constexpr int NINP = 17664;
constexpr int DFF = 5632, EFF = 7168, NEXP = 8, MAXSLOT = 18432;
constexpr float EPS = 1e-6f;
constexpr int NPL = 15, NPH = 2 + 2 * NPL;

constexpr size_t MiB = 1u << 20;
constexpr size_t WS_CTL = 0, CTL_BYTES = 1 * MiB;
constexpr size_t WS_WIN = WS_CTL + CTL_BYTES;
constexpr size_t WS_WBR = WS_WIN + 2 * 69 * MiB;
constexpr size_t WS_WOUT = WS_WBR + 2 * 12 * MiB;
constexpr size_t WS_WQ = WS_WOUT + 2 * 8 * MiB;
constexpr size_t WS_WKV = WS_WQ + 2 * 2 * MiB;
constexpr size_t WS_WO = WS_WKV + 2 * 4 * MiB;
constexpr size_t WS_WGU = WS_WO + 2 * 2 * MiB;
constexpr size_t WS_WDN = WS_WGU + 44 * MiB;
constexpr size_t WS_WEGU = WS_WDN + 22 * MiB;
constexpr size_t WS_WEDN = WS_WEGU + 448 * MiB;
constexpr size_t WS_XRES = WS_WEDN + 224 * MiB;
constexpr size_t WS_H = WS_XRES + 64 * MiB;
constexpr size_t WS_RQ = WS_H + 32 * MiB, WS_RK = WS_RQ + 16 * MiB, WS_RV = WS_RK + 16 * MiB, WS_RG = WS_RV + 16 * MiB;
constexpr size_t WS_BQKV = WS_RG + 16 * MiB;
constexpr size_t WS_BZ = WS_BQKV + 48 * MiB;
constexpr size_t WS_BBA = WS_BZ + 16 * MiB;
constexpr size_t WS_CQ = WS_BBA + 1 * MiB, WS_CK = WS_CQ + 16 * MiB, WS_CVT = WS_CK + 16 * MiB;
constexpr size_t WS_GATES = WS_CVT + 16 * MiB;
constexpr size_t WS_GQ = WS_GATES + 96 * MiB, WS_GK = WS_GQ + 16 * MiB, WS_GV = WS_GK + 16 * MiB;
constexpr size_t WS_GG = WS_GV + 16 * MiB, WS_GB = WS_GG + 1 * MiB;
constexpr size_t WS_OA = WS_GB + 1 * MiB, WS_OB = WS_OA + 32 * MiB;
constexpr size_t WS_O12 = WS_OB + 32 * MiB;
constexpr size_t WS_OCAT = WS_O12 + 64 * MiB;
constexpr size_t WS_MERGE = WS_OCAT + 48 * MiB;
constexpr size_t WS_MERGEB = WS_MERGE + 64 * MiB;
constexpr size_t WS_MEMN = WS_MERGEB + 32 * MiB;
constexpr size_t WS_KX = WS_MEMN + 8 * MiB;
constexpr size_t WS_VXT = WS_KX + 2 * MiB;
constexpr size_t WS_QX = WS_VXT + 2 * MiB;
constexpr size_t WS_OX = WS_QX + 8 * MiB;
constexpr size_t WS_ACT = WS_OX + 8 * MiB;
constexpr size_t WS_HG = WS_ACT + 88 * MiB;
constexpr size_t WS_EACT = WS_HG + 72 * MiB;
constexpr size_t WS_Y = WS_EACT + 252 * MiB;
constexpr size_t WS_ROUTE = WS_Y + 144 * MiB;
constexpr size_t WS_GCH = WS_ROUTE + 1 * MiB;
constexpr size_t WS_GL = WS_GCH + 88 * MiB;
constexpr size_t WS_H8 = WS_GL + 1 * MiB;
constexpr size_t WS_WIN8 = WS_H8 + 16 * MiB;
constexpr size_t WS_END = WS_WIN8 + 32 * MiB;
constexpr int CW_CNT = 64;
constexpr int CW_BAR = 4096;

constexpr int RING_BYTES = 131072, MISC_OFF = RING_BYTES + 320, LDS_BYTES = 147456;

#define GAS __attribute__((address_space(1)))
#define LAS __attribute__((address_space(3)))
#define DI __device__ __forceinline__
typedef unsigned short bf16;
typedef unsigned v4u __attribute__((ext_vector_type(4)));
typedef unsigned v2u __attribute__((ext_vector_type(2)));
typedef float f32x4 __attribute__((ext_vector_type(4)));
typedef short bf16x8 __attribute__((ext_vector_type(8)));
typedef short s16x4 __attribute__((ext_vector_type(4)));
DI float bf2f(unsigned v) { return __uint_as_float(v << 16); }
DI unsigned f2bf(float f) { unsigned u = __builtin_bit_cast(unsigned, f); return (u + 0x7fffu + ((u >> 16) & 1u)) >> 16; }
typedef float f32x2_t __attribute__((ext_vector_type(2))); typedef __bf16 bf16x2_t __attribute__((ext_vector_type(2)));
DI unsigned pk2(float lo, float hi) { const f32x2_t v = {lo, hi}; const bf16x2_t b = __builtin_convertvector(v, bf16x2_t); return __builtin_bit_cast(unsigned, b); }
DI float wave_sum(float v) {
#pragma unroll
    for (int o = 1; o < 64; o <<= 1) v += __shfl_xor(v, o);
    return v;
}

#define XB_TMO      128
#define XB_XCNT(j)  (256  + 64 * (j))
#define XB_XSUB(j)  (1280 + 64 * (j))
#define XB_XGEN(j)  (2304 + 64 * (j))
#define XB_TOP      3328
#define XB_TOPGEN   3392
#define XCD_BAR_WORDS 3456
#define XB_SPIN_CAP (1u << 18)

__device__ __forceinline__ unsigned xb_ld(unsigned* p)              { return __hip_atomic_load(p, __ATOMIC_RELAXED, __HIP_MEMORY_SCOPE_AGENT); }
__device__ __forceinline__ unsigned xb_add(unsigned* p, unsigned v) { return __hip_atomic_fetch_add(p, v, __ATOMIC_RELAXED, __HIP_MEMORY_SCOPE_AGENT); }
__device__ __forceinline__ unsigned xb_xcc_id() { return (unsigned)__builtin_amdgcn_s_getreg((3 << 11) | 20) & 0xFu; }
#define XB_SPIN(cond, bar) do { unsigned _sp = 0; while (cond) { __builtin_amdgcn_s_sleep(1); \
    if ((++_sp & 255u) == 0u) { if (xb_ld(&(bar)[XB_TMO])) break; if (_sp > XB_SPIN_CAP) { atomicAdd(&(bar)[XB_TMO], 1u); break; } } } } while (0)

struct XcdBarrier {
    unsigned* bar; unsigned x;
    volatile LAS unsigned* st;
};

__device__ __forceinline__ XcdBarrier xcd_barrier_post(unsigned* bar, volatile LAS unsigned* st) {
    XcdBarrier b; b.bar = bar; b.x = xb_xcc_id(); b.st = st;
    if (threadIdx.x == 0) (void)xb_add(&bar[XB_XCNT(b.x)], 1u);
    return b;
}
__device__ __forceinline__ void xcd_barrier_complete(unsigned* bar, unsigned x, unsigned& nloc, unsigned& nx) {
    const unsigned G = gridDim.x * gridDim.y * gridDim.z;
    unsigned sum, cnt, mine, sp = 0u;
    for (;;) {
        sum = 0u; cnt = 0u; mine = 0u;
#pragma unroll
        for (unsigned j = 0; j < 16; ++j) { const unsigned c = xb_ld(&bar[XB_XCNT(j)]); sum += c; cnt += (c > 0u) ? 1u : 0u; mine = (j == x) ? c : mine; }
        if (sum == G) break;
        __builtin_amdgcn_s_sleep(1);
        if ((++sp & 255u) == 0u) { if (xb_ld(&bar[XB_TMO])) break; if (sp > XB_SPIN_CAP) { atomicAdd(&bar[XB_TMO], 1u); break; } }
    }
    nloc = mine > 0u ? mine : 1u; nx = cnt > 0u ? cnt : 1u;
}

__device__ __forceinline__ void xcd_barrier(const XcdBarrier& b) {
    asm volatile("s_waitcnt vmcnt(0)" ::: "memory");
    __syncthreads();
    if (threadIdx.x == 0) {
        unsigned* bar = b.bar;
        __builtin_amdgcn_s_waitcnt(0);
        unsigned nloc = b.st[0], nx = b.st[1];
        if (nloc == 0u) { xcd_barrier_complete(bar, b.x, nloc, nx); b.st[0] = nloc; b.st[1] = nx; }
        const unsigned old = xb_add(&bar[XB_XSUB(b.x)], 1u);
        const unsigned gen = old / nloc;
        if (old + 1u == (gen + 1u) * nloc) {
            __builtin_amdgcn_fence(__ATOMIC_RELEASE, "agent");
            asm volatile("s_waitcnt vmcnt(0)" ::: "memory");
            const unsigned og = xb_add(&bar[XB_TOP], 1u);
            const unsigned tg = og / nx;
            if (og + 1u == (tg + 1u) * nx) xb_add(&bar[XB_TOPGEN], 1u);
            else XB_SPIN(xb_ld(&bar[XB_TOPGEN]) == tg, bar);
            __builtin_amdgcn_fence(__ATOMIC_ACQUIRE, "agent");
            xb_add(&bar[XB_XGEN(b.x)], 1u);
            asm volatile("s_waitcnt vmcnt(0)" ::: "memory");
        } else {
            XB_SPIN(xb_ld(&bar[XB_XGEN(b.x)]) == gen, bar);
            __builtin_amdgcn_fence(__ATOMIC_ACQUIRE, "agent");
            asm volatile("s_waitcnt vmcnt(0)" ::: "memory");
        }
    }
    __syncthreads();
}

struct Args { const void* in[24]; float* out; unsigned char* ws; int ph_lo, ph_hi; };

struct Frame {
    LAS unsigned char* lds;
    int tid, lane, wave, G, vcu, gw, NGW;
};

DI void conv_job(const Frame& F, const float* W, int K, int Nsrc, bf16* WT, int Ndst, int mode, int Fgu) {
    LAS unsigned* scr = (LAS unsigned*)(F.lds + F.wave * 8704);
    const int nkb = K / 64, nnb = Ndst / 64, items = nkb * nnb, lane = F.lane;
    for (int it = F.gw; it < items; it += F.NGW) {
        const int nb = it / nkb, kb = it % nkb, k0 = kb * 64, n0 = nb * 64, n = n0 + lane;
        int ns;
        if (mode == 0) ns = n;
        else if (mode == 1) ns = n < 8192 ? n : (n < 17408 ? n + 16 : (n < 17424 ? n - 17408 + 8192 : -1));
        else { const int pn = n >> 8, half = (n >> 7) & 1, j = n & 127; ns = half * Fgu + 128 * pn + j; }
        const float* src = W + (size_t)k0 * Nsrc + (ns < 0 ? 0 : ns);
#pragma unroll 8
        for (int i = 0; i < 32; ++i) { float a = src[(size_t)(2 * i) * Nsrc], b = src[(size_t)(2 * i + 1) * Nsrc]; if (ns < 0) { a = 0.f; b = 0.f; } scr[lane * 33 + i] = pk2(a, b); }
        asm volatile("s_waitcnt lgkmcnt(0)" ::: "memory");
#pragma unroll
        for (int j = 0; j < 8; ++j) { const int nn = (lane >> 3) + 8 * j, kq = lane & 7; v4u o; const LAS unsigned* s = scr + nn * 33 + 4 * kq; o.x = s[0]; o.y = s[1]; o.z = s[2]; o.w = s[3];
            *(v4u*)(WT + (size_t)(n0 + nn) * K + k0 + 8 * kq) = o; }
        asm volatile("s_waitcnt lgkmcnt(0)" ::: "memory");
    }
}

DI void conv_job_f8(const Frame& F, const float* W, int K, int Nsrc, unsigned char* WT, int Ndst, int mode, int Fgu, float scale) {
    LAS unsigned* scr = (LAS unsigned*)(F.lds + F.wave * 8704);
    const int nkb = K / 128, nnb = Ndst / 64, items = nkb * nnb, lane = F.lane;
    for (int it = F.gw; it < items; it += F.NGW) {
        const int nb = it / nkb, kb = it % nkb, k0 = kb * 128, n0 = nb * 64, n = n0 + lane;
        int ns;
        if (mode == 0) ns = n; else { const int pn = n >> 8, half = (n >> 7) & 1, j = n & 127; ns = half * Fgu + 128 * pn + j; }
        const float* src = W + (size_t)k0 * Nsrc + ns;
#pragma unroll 4
        for (int i = 0; i < 32; ++i) { const float a = src[(size_t)(4 * i) * Nsrc], b = src[(size_t)(4 * i + 1) * Nsrc], c = src[(size_t)(4 * i + 2) * Nsrc], d = src[(size_t)(4 * i + 3) * Nsrc]; scr[lane * 33 + i] = pg8::pk4_fp8(a * scale, b * scale, c * scale, d * scale); }
        asm volatile("s_waitcnt lgkmcnt(0)" ::: "memory");
#pragma unroll
        for (int j = 0; j < 8; ++j) { const int nn = (lane >> 3) + 8 * j, kq = lane & 7; v4u o; const LAS unsigned* s = scr + nn * 33 + 4 * kq; o.x = s[0]; o.y = s[1]; o.z = s[2]; o.w = s[3];
            *(v4u*)(WT + (size_t)(n0 + nn) * K + k0 + 16 * kq) = o; }
        asm volatile("s_waitcnt lgkmcnt(0)" ::: "memory");
    }
}

template <bool F8>
DI void conv_wg(const Frame& F, const float* W, int K, int Nsrc, void* WTv, int Ndst, int mode, int Fgu, float scale) {
    constexpr int KI = F8 ? 256 : 128;
    LAS unsigned* scr = (LAS unsigned*)F.lds;
    const int nkb = K / KI, items = nkb * (Ndst / 256), lane = F.lane, w = F.wave, tid = F.tid;
    for (int it = F.vcu; it < items; it += F.G) {
        const int nb = it / nkb, kb = it % nkb, k0 = kb * KI, n0 = nb * 256, n = n0 + 4 * lane;
        int ns;
        if (mode == 0) ns = n;
        else if (mode == 1 || mode == 3 || mode == 4) {
            int ng = n;
            if (mode == 3) { const int lp = n >> 8; ng = ((lp < 44 ? lp : 68) << 8) + (n & 255); }
            if (mode == 4) ng = n + 44 * 256;
            ns = ng < 8192 ? ng : (ng < 17408 ? ng + 16 : (ng < 17424 ? ng - 17408 + 8192 : -1)); }
        else { const int pn = n >> 8, half = (n >> 7) & 1, j = n & 127; ns = half * Fgu + 128 * pn + j; }
        __syncthreads();
#pragma unroll
        for (int h = 0; h < (F8 ? 2 : 1); ++h) {
            const float* src = W + (size_t)(k0 + (F8 ? 32 : 16) * w + 16 * h) * Nsrc + (ns < 0 ? 0 : ns);
            f32x4 a[16];
#pragma unroll
            for (int i = 0; i < 16; ++i) a[i] = __builtin_nontemporal_load((const f32x4*)(src + (size_t)i * Nsrc));
            if (ns < 0) {
#pragma unroll
                for (int i = 0; i < 16; ++i) a[i] = (f32x4){0.f, 0.f, 0.f, 0.f}; }
#pragma unroll
            for (int c = 0; c < 4; ++c) {
                if (F8) {
#pragma unroll
                    for (int q = 0; q < 4; ++q) scr[(4 * lane + c) * 65 + 8 * w + 4 * h + q] = pg8::pk4_fp8(a[4 * q][c] * scale, a[4 * q + 1][c] * scale, a[4 * q + 2][c] * scale, a[4 * q + 3][c] * scale);
                } else {
#pragma unroll
                    for (int p = 0; p < 8; ++p) scr[(4 * lane + c) * 65 + 8 * w + p] = pk2(a[2 * p][c], a[2 * p + 1][c]); } }
        }
        __syncthreads();
#pragma unroll
        for (int ps = 0; ps < 8; ++ps) { const int row = ps * 32 + (tid >> 4), kq = tid & 15; const LAS unsigned* s = scr + row * 65 + 4 * kq; v4u o; o.x = s[0]; o.y = s[1]; o.z = s[2]; o.w = s[3];
            __builtin_nontemporal_store(o, (v4u*)((unsigned char*)WTv + ((size_t)(n0 + row) * K + k0) * (F8 ? 1 : 2) + 16 * kq)); }
    }
}

DI void rms_row(const float* xrow, const float* w, bf16* orow, int lane, unsigned char* o8 = nullptr) {
    f32x4 v[8], ww[8]; float ss = 0.f;
#pragma unroll
    for (int j = 0; j < 8; ++j) { v[j] = *(const f32x4*)(xrow + 4 * (lane + 64 * j)); ww[j] = *(const f32x4*)(w + 4 * (lane + 64 * j)); }
#pragma unroll
    for (int j = 0; j < 8; ++j) ss += (v[j][0] * v[j][0] + v[j][1] * v[j][1]) + (v[j][2] * v[j][2] + v[j][3] * v[j][3]);
    const float rstd = rsqrtf(wave_sum(ss) * (1.f / D) + EPS);
#pragma unroll
    for (int j = 0; j < 8; ++j) { const f32x4 y = v[j] * rstd * ww[j]; v2u o; o.x = pk2(y[0], y[1]); o.y = pk2(y[2], y[3]);
        *(v2u*)(orow + 4 * (lane + 64 * j)) = o;
        if (o8) *(unsigned*)(o8 + 4 * (lane + 64 * j)) = pg8::pk4_fp8(y[0], y[1], y[2], y[3]); }
}

template <bool GDN>
DI void seq_mixer(const Frame& F, int bh, const bf16* Q, const bf16* K, const bf16* V, const float* Gg, const float* Gb, float* OUT, float gamma) {
    LAS float* qs = (LAS float*)F.lds; LAS float* ks = qs + 32 * 128; LAS float* vs = ks + 32 * 128; LAS float* red = vs + 32 * 128; LAS float* gs = red + 2 * 4 * 128; LAS float* bs = gs + 32;
    const int tid = F.tid, v = tid & 127, kg = tid >> 7, b = bh >> 3, h = bh & 7;
    const size_t hb = (size_t)bh * SEQ * 128;
    float Sr[32];
#pragma unroll
    for (int i = 0; i < 32; ++i) Sr[i] = 0.f;
    for (int c0 = 0; c0 < SEQ; c0 += 32) {
        __syncthreads();
#pragma unroll
        for (int j = 0; j < 4; ++j) { const int idx = tid + 512 * j, tok = idx >> 6, d = (idx & 63) * 2; const size_t go = hb + (size_t)(c0 + tok) * 128 + d;
            const unsigned a = *(const unsigned*)(Q + go), bb = *(const unsigned*)(K + go), cc = *(const unsigned*)(V + go);
            qs[tok * 128 + d] = bf2f(a & 0xffffu); qs[tok * 128 + d + 1] = __uint_as_float(a & 0xffff0000u);
            ks[tok * 128 + d] = bf2f(bb & 0xffffu); ks[tok * 128 + d + 1] = __uint_as_float(bb & 0xffff0000u);
            vs[tok * 128 + d] = bf2f(cc & 0xffffu); vs[tok * 128 + d + 1] = __uint_as_float(cc & 0xffff0000u); }
        if (GDN && tid < 32) { gs[tid] = Gg[(size_t)bh * SEQ + c0 + tid]; bs[tid] = Gb[(size_t)bh * SEQ + c0 + tid]; }
        __syncthreads();
        for (int tt = 0; tt < 32; ++tt) {
            const LAS float* kt = ks + tt * 128 + kg * 32; const LAS float* qt = qs + tt * 128 + kg * 32;
            float po = 0.f;
            if (GDN) {
                const float a = __expf(gs[tt]); float p = 0.f;
#pragma unroll
                for (int i = 0; i < 32; ++i) { Sr[i] *= a; p += Sr[i] * kt[i]; }
                red[kg * 128 + v] = p; __syncthreads();
                const float kv = (red[v] + red[128 + v]) + (red[256 + v] + red[384 + v]);
                const float delta = bs[tt] * (vs[tt * 128 + v] - kv);
#pragma unroll
                for (int i = 0; i < 32; ++i) { Sr[i] += kt[i] * delta; po += Sr[i] * qt[i]; }
                red[512 + kg * 128 + v] = po; __syncthreads();
                if (kg == 0) OUT[((size_t)(b * SEQ + c0 + tt)) * 1024 + h * 128 + v] = (red[512 + v] + red[640 + v]) + (red[768 + v] + red[896 + v]);
            } else {
                const float vv = vs[tt * 128 + v]; LAS float* r = red + (tt & 1) * 512;
#pragma unroll
                for (int i = 0; i < 32; ++i) { Sr[i] = gamma * Sr[i] + kt[i] * vv; po += Sr[i] * qt[i]; }
                r[kg * 128 + v] = po; __syncthreads();
                if (kg == 0) OUT[((size_t)(b * SEQ + c0 + tt)) * 1024 + h * 128 + v] = (r[v] + r[128 + v]) + (r[256 + v] + r[384 + v]);
            }
        }
    }
    __syncthreads();
}

template <int DV, int KT, bool CAUSAL, bool OUT_BF16, bool DECAY>
DI void flash_item(const Frame& F, const bf16* Q, const bf16* Kh, const bf16* VT, int vpitch, int q0, int nkeys, float slope, float* OUTF, bf16* OUTB, int opitch) {
    constexpr int KP = 272, VP = KT * 2 + 16, NKC = KT / 32, NVC = DV * KT / 4096, VCH = KT / 8;
    LAS unsigned char* Kl = F.lds; LAS unsigned char* Vl = F.lds + KT * KP;
    int tid_ = F.tid; asm volatile("" : "+v"(tid_));
    const int tid = tid_, lane = tid & 63, w = F.wave, li = lane & 15, g = lane >> 4;
    const float SC = 0.08838834764831845f, L2E = 1.4426950408889634f;
    bf16x8 qf[4];
#pragma unroll
    for (int ks = 0; ks < 4; ++ks) qf[ks] = *(const bf16x8*)(Q + (size_t)(w * 16 + li) * 128 + ks * 32 + g * 8);
    f32x4 o[DV / 16];
#pragma unroll
    for (int c = 0; c < DV / 16; ++c) o[c] = (f32x4){0.f, 0.f, 0.f, 0.f};
    float m_run = -1e30f, l_run = 0.f;
    const int qpos = q0 + w * 16 + li;
    const int kend = CAUSAL ? (q0 + 128 < nkeys ? q0 + 128 : nkeys) : nkeys;
    v4u kr[NKC], vr[NVC];
#pragma unroll
    for (int i = 0; i < NKC; ++i) { const int c = tid + 512 * i; kr[i] = *(const v4u*)(Kh + (size_t)(c >> 4) * 128 + (c & 15) * 8); }
#pragma unroll
    for (int i = 0; i < NVC; ++i) { const int c = tid + 512 * i; vr[i] = *(const v4u*)(VT + (size_t)(c / VCH) * vpitch + (c % VCH) * 8); }
    for (int j0 = 0; j0 < kend; j0 += KT) {
        __syncthreads();
#pragma unroll
        for (int i = 0; i < NKC; ++i) { const int c = tid + 512 * i; *(LAS v4u*)(Kl + (c >> 4) * KP + (c & 15) * 16) = kr[i]; }
#pragma unroll
        for (int i = 0; i < NVC; ++i) { const int c = tid + 512 * i, cc = c % VCH, j = cc & 3; LAS unsigned char* rp = Vl + (c / VCH) * VP + (cc >> 2) * 64;
            *(LAS v2u*)(rp + (8 * ((2 * j) & 3) + 4 * (j >> 1)) * 2) = (v2u){vr[i].x, vr[i].y}; *(LAS v2u*)(rp + (8 * ((2 * j + 1) & 3) + 4 * (j >> 1)) * 2) = (v2u){vr[i].z, vr[i].w}; }
        __syncthreads();
        if (j0 + KT < kend) {
#pragma unroll
            for (int i = 0; i < NKC; ++i) { const int c = tid + 512 * i; kr[i] = *(const v4u*)(Kh + (size_t)(j0 + KT + (c >> 4)) * 128 + (c & 15) * 8); }
#pragma unroll
            for (int i = 0; i < NVC; ++i) { const int c = tid + 512 * i; vr[i] = *(const v4u*)(VT + (size_t)(c / VCH) * vpitch + j0 + KT + (c % VCH) * 8); }
        }
        f32x4 s[KT / 16];
        {
            bf16x8 ka[2][4];
#pragma unroll
            for (int ks = 0; ks < 4; ++ks) ka[0][ks] = *(const LAS bf16x8*)(Kl + li * KP + (ks * 32 + g * 8) * 2);
#pragma unroll
            for (int t = 0; t < KT / 16; ++t) {
                if (t + 1 < KT / 16) {
#pragma unroll
                    for (int ks = 0; ks < 4; ++ks) ka[(t + 1) & 1][ks] = *(const LAS bf16x8*)(Kl + ((t + 1) * 16 + li) * KP + (ks * 32 + g * 8) * 2); }
                __builtin_amdgcn_sched_barrier(0);
                s[t] = (f32x4){0.f, 0.f, 0.f, 0.f};
#pragma unroll
                for (int ks = 0; ks < 4; ++ks) s[t] = __builtin_amdgcn_mfma_f32_16x16x32_bf16(ka[t & 1][ks], qf[ks], s[t], 0, 0, 0);
                __builtin_amdgcn_sched_barrier(0);
            }
        }
        float alpha = 1.f;
        const bool diag = CAUSAL && (j0 + KT - 1 > q0 + w * 16);
        if (DECAY) {
            const float base = slope * (float)(qpos - j0 - 4 * g);
#pragma unroll
            for (int t = 0; t < KT / 16; ++t)
#pragma unroll
                for (int r = 0; r < 4; ++r) s[t][r] *= __builtin_amdgcn_exp2f(fmaf(slope, -(float)(16 * t + r), base));
            if (diag) {
#pragma unroll
                for (int t = 0; t < KT / 16; ++t)
#pragma unroll
                    for (int r = 0; r < 4; ++r) if (j0 + t * 16 + g * 4 + r > qpos) s[t][r] = 0.f; }
        } else {
        const float C2 = SC * L2E, sl2 = slope * L2E, base = -sl2 * (float)(qpos - j0 - 4 * g);
        float mx = -__builtin_inff();
#pragma unroll
        for (int t = 0; t < KT / 16; ++t)
#pragma unroll
            for (int r = 0; r < 4; ++r) s[t][r] = fmaf(s[t][r], C2, fmaf(sl2, (float)(16 * t + r), base));
        if (diag) {
#pragma unroll
            for (int t = 0; t < KT / 16; ++t)
#pragma unroll
                for (int r = 0; r < 4; ++r) if (j0 + t * 16 + g * 4 + r > qpos) s[t][r] = -__builtin_inff(); }
#pragma unroll
        for (int t = 0; t < KT / 16; ++t)
#pragma unroll
            for (int r = 0; r < 4; ++r) mx = fmaxf(mx, s[t][r]);
        mx = fmaxf(mx, __shfl_xor(mx, 16)); mx = fmaxf(mx, __shfl_xor(mx, 32));
        const float m_new = fmaxf(m_run, mx); alpha = __builtin_amdgcn_exp2f(m_run - m_new); m_run = m_new;
        float ps = 0.f;
#pragma unroll
        for (int t = 0; t < KT / 16; ++t)
#pragma unroll
            for (int r = 0; r < 4; ++r) { const float p = __builtin_amdgcn_exp2f(s[t][r] - m_new); s[t][r] = p; ps += p; }
        ps += __shfl_xor(ps, 16); ps += __shfl_xor(ps, 32);
        l_run = l_run * alpha + ps;
        }
        bf16x8 pf[KT / 32];
#pragma unroll
        for (int s2 = 0; s2 < KT / 32; ++s2) { v4u pw; pw.x = pk2(s[2 * s2][0], s[2 * s2][1]); pw.y = pk2(s[2 * s2][2], s[2 * s2][3]); pw.z = pk2(s[2 * s2 + 1][0], s[2 * s2 + 1][1]); pw.w = pk2(s[2 * s2 + 1][2], s[2 * s2 + 1][3]); pf[s2] = __builtin_bit_cast(bf16x8, pw); }
        float al[4];
#pragma unroll
        for (int r = 0; r < 4; ++r) al[r] = DECAY ? 1.f : __shfl(alpha, g * 4 + r);
        {
            v4u vb[2][KT / 32];
#pragma unroll
            for (int s2 = 0; s2 < KT / 32; ++s2) vb[0][s2] = *(const LAS v4u*)(Vl + li * VP + (s2 * 32 + g * 8) * 2);
#pragma unroll
            for (int c = 0; c < DV / 16; ++c) {
                if (c + 1 < DV / 16) {
#pragma unroll
                    for (int s2 = 0; s2 < KT / 32; ++s2) vb[(c + 1) & 1][s2] = *(const LAS v4u*)(Vl + ((c + 1) * 16 + li) * VP + (s2 * 32 + g * 8) * 2); }
                __builtin_amdgcn_sched_barrier(0);
                if (!DECAY) {
#pragma unroll
                    for (int r = 0; r < 4; ++r) o[c][r] *= al[r]; }
#pragma unroll
                for (int s2 = 0; s2 < KT / 32; ++s2) o[c] = __builtin_amdgcn_mfma_f32_16x16x32_bf16(pf[s2], __builtin_bit_cast(bf16x8, vb[c & 1][s2]), o[c], 0, 0, 0);
                __builtin_amdgcn_sched_barrier(0);
            }
        }
    }
    float il[4];
#pragma unroll
    for (int r = 0; r < 4; ++r) il[r] = DECAY ? 1.f : 1.0f / __shfl(l_run, g * 4 + r);
#pragma unroll
    for (int c = 0; c < DV / 16; ++c)
#pragma unroll
        for (int r = 0; r < 4; ++r) { const unsigned off = (unsigned)((w * 16 + g * 4 + r) * opitch + c * 16 + li); const float v = o[c][r] * il[r];
            if (OUT_BF16) OUTB[off] = (bf16)f2bf(v); else OUTF[off] = v; }
}

DI void flash_ret(const Frame& F, const bf16* Q, const bf16* Kh, const bf16* VT, int vpitch, int q0, float lg2, bf16* OUTB, int opitch) {
    constexpr int KP = 272, VP = 144;
    LAS unsigned char* Kl = F.lds; LAS unsigned char* Vl = F.lds + 64 * KP;
    int tid_ = F.tid; asm volatile("" : "+v"(tid_));
    const int tid = tid_, lane = tid & 63, w = F.wave, li = lane & 15, g = lane >> 4;
    bf16x8 qf[2][4];
#pragma unroll
    for (int qs = 0; qs < 2; ++qs)
#pragma unroll
        for (int ks = 0; ks < 4; ++ks) qf[qs][ks] = *(const bf16x8*)(Q + (size_t)(w * 32 + qs * 16 + li) * 128 + ks * 32 + g * 8);
    f32x4 o[2][8];
#pragma unroll
    for (int qs = 0; qs < 2; ++qs)
#pragma unroll
        for (int c = 0; c < 8; ++c) o[qs][c] = (f32x4){0.f, 0.f, 0.f, 0.f};
    const int kend = q0 + 256, qw0 = q0 + w * 32;
    v4u kr[2], vr[2];
#pragma unroll
    for (int i = 0; i < 2; ++i) { const int c = tid + 512 * i; kr[i] = *(const v4u*)(Kh + (size_t)(c >> 4) * 128 + (c & 15) * 8); vr[i] = *(const v4u*)(VT + (size_t)(c >> 3) * vpitch + (c & 7) * 8); }
    for (int j0 = 0; j0 < kend; j0 += 64) {
        __syncthreads();
#pragma unroll
        for (int i = 0; i < 2; ++i) { const int c = tid + 512 * i; *(LAS v4u*)(Kl + (c >> 4) * KP + (c & 15) * 16) = kr[i];
            const int cc = c & 7, j = cc & 3; LAS unsigned char* rp = Vl + (c >> 3) * VP + (cc >> 2) * 64;
            *(LAS v2u*)(rp + (8 * ((2 * j) & 3) + 4 * (j >> 1)) * 2) = (v2u){vr[i].x, vr[i].y}; *(LAS v2u*)(rp + (8 * ((2 * j + 1) & 3) + 4 * (j >> 1)) * 2) = (v2u){vr[i].z, vr[i].w}; }
        __syncthreads();
        if (j0 + 64 < kend) {
#pragma unroll
            for (int i = 0; i < 2; ++i) { const int c = tid + 512 * i; kr[i] = *(const v4u*)(Kh + (size_t)(j0 + 64 + (c >> 4)) * 128 + (c & 15) * 8); vr[i] = *(const v4u*)(VT + (size_t)(c >> 3) * vpitch + j0 + 64 + (c & 7) * 8); }
        }
        if (j0 > qw0 + 31) continue;
        f32x4 s[2][4];
        {
            bf16x8 ka[2][4];
#pragma unroll
            for (int ks = 0; ks < 4; ++ks) ka[0][ks] = *(const LAS bf16x8*)(Kl + li * KP + (ks * 32 + g * 8) * 2);
#pragma unroll
            for (int t = 0; t < 4; ++t) {
                if (t + 1 < 4) {
#pragma unroll
                    for (int ks = 0; ks < 4; ++ks) ka[(t + 1) & 1][ks] = *(const LAS bf16x8*)(Kl + ((t + 1) * 16 + li) * KP + (ks * 32 + g * 8) * 2); }
                __builtin_amdgcn_sched_barrier(0);
#pragma unroll
                for (int qs = 0; qs < 2; ++qs) { s[qs][t] = (f32x4){0.f, 0.f, 0.f, 0.f};
#pragma unroll
                    for (int ks = 0; ks < 4; ++ks) s[qs][t] = __builtin_amdgcn_mfma_f32_16x16x32_bf16(ka[t & 1][ks], qf[qs][ks], s[qs][t], 0, 0, 0); }
                __builtin_amdgcn_sched_barrier(0);
            }
        }
        const bool diag = j0 + 63 > qw0;
        bf16x8 pf[2][2];
#pragma unroll
        for (int qs = 0; qs < 2; ++qs) { const int qpos = qw0 + qs * 16 + li; const float base = lg2 * (float)(qpos - j0 - 4 * g);
#pragma unroll
            for (int t = 0; t < 4; ++t)
#pragma unroll
                for (int r = 0; r < 4; ++r) s[qs][t][r] *= __builtin_amdgcn_exp2f(fmaf(lg2, -(float)(16 * t + r), base));
            if (diag) {
#pragma unroll
                for (int t = 0; t < 4; ++t)
#pragma unroll
                    for (int r = 0; r < 4; ++r) if (j0 + t * 16 + g * 4 + r > qpos) s[qs][t][r] = 0.f; }
#pragma unroll
            for (int s2 = 0; s2 < 2; ++s2) { v4u pw; pw.x = pk2(s[qs][2 * s2][0], s[qs][2 * s2][1]); pw.y = pk2(s[qs][2 * s2][2], s[qs][2 * s2][3]); pw.z = pk2(s[qs][2 * s2 + 1][0], s[qs][2 * s2 + 1][1]); pw.w = pk2(s[qs][2 * s2 + 1][2], s[qs][2 * s2 + 1][3]); pf[qs][s2] = __builtin_bit_cast(bf16x8, pw); } }
        {
            v4u vb[2][2];
#pragma unroll
            for (int s2 = 0; s2 < 2; ++s2) vb[0][s2] = *(const LAS v4u*)(Vl + li * VP + (s2 * 32 + g * 8) * 2);
#pragma unroll
            for (int c = 0; c < 8; ++c) {
                if (c + 1 < 8) {
#pragma unroll
                    for (int s2 = 0; s2 < 2; ++s2) vb[(c + 1) & 1][s2] = *(const LAS v4u*)(Vl + ((c + 1) * 16 + li) * VP + (s2 * 32 + g * 8) * 2); }
                __builtin_amdgcn_sched_barrier(0);
#pragma unroll
                for (int qs = 0; qs < 2; ++qs)
#pragma unroll
                    for (int s2 = 0; s2 < 2; ++s2) o[qs][c] = __builtin_amdgcn_mfma_f32_16x16x32_bf16(pf[qs][s2], __builtin_bit_cast(bf16x8, vb[c & 1][s2]), o[qs][c], 0, 0, 0);
                __builtin_amdgcn_sched_barrier(0);
            }
        }
    }
#pragma unroll
    for (int qs = 0; qs < 2; ++qs)
#pragma unroll
        for (int c = 0; c < 8; ++c)
#pragma unroll
            for (int r = 0; r < 4; ++r) OUTB[(unsigned)((w * 32 + qs * 16 + g * 4 + r) * opitch + c * 16 + li)] = (bf16)f2bf(o[qs][c][r]);
}

constexpr int GDN_CH_BYTES = 16384 + 16384 + 8192 + 16384 + 32768;
DI int perm32pos(int k) { return (k & ~31) | (((k >> 2) & 3) << 3) | (((k >> 4) & 1) << 2) | (k & 3); }
DI void gdn_prep_item(const Frame& F, int l, int bh, int n, const bf16* BQKV, const float* BBA, const float* cw, const float* a_log, const float* dt_bias, unsigned char* CH, float* GLp) {
    LAS unsigned char* Kl = F.lds; LAS unsigned char* Ql = F.lds + 17408; LAS unsigned char* KBT = F.lds + 34816; LAS unsigned char* VBT = F.lds + 53248; LAS unsigned char* KTl = F.lds + 71680;
    LAS float* Am = (LAS float*)(F.lds + 90112); LAS unsigned char* Tl = F.lds + 106752; LAS unsigned char* AQl = F.lds + 115968; LAS float* Gs = (LAS float*)(F.lds + 125184); LAS float* gs = Gs + 64; LAS float* bs = gs + 64;
    LAS float* CWl = Am;
    int tid_ = F.tid; asm volatile("" : "+v"(tid_));
    const int tid = tid_, lane = tid & 63, w = F.wave, li = lane & 15, g = lane >> 4;
    const int b = bh >> 3, h = bh & 7, i = tid >> 3, cg = tid & 7, c0 = cg * 16, s = n * 64 + i, t = b * SEQ + s;
    bf16* Wn = (bf16*)CH; bf16* QD = (bf16*)(CH + 16384); bf16* AQK = (bf16*)(CH + 32768); bf16* KT = (bf16*)(CH + 40960); float* UT = (float*)(CH + 57344);
    __syncthreads();
    for (int e = tid; e < 1536; e += 512) { const int part = e >> 9, j = (e >> 7) & 3, c = e & 127; CWl[e] = cw[j * 3072 + part * 1024 + h * 128 + c]; }
    if (cg == 0) { const float bbv = BBA[(size_t)t * 16 + h], bav = BBA[(size_t)t * 16 + 8 + h] + dt_bias[l * 8 + h]; const float sp = bav > 20.f ? bav : log1pf(__expf(bav)); bs[i] = pg8::fsigm(bbv); gs[i] = -__expf(a_log[l * 8 + h]) * sp; }
    __syncthreads();
    float qv[16], kv[16], vv[16];
#pragma unroll
    for (int part = 0; part < 3; ++part) {
        float a[16];
#pragma unroll
        for (int c = 0; c < 16; ++c) a[c] = 0.f;
#pragma unroll
        for (int j = 0; j < 4; ++j) { const bool ok = s - 3 + j >= 0; const int tj = ok ? t - 3 + j : t;
            const v4u x0 = *(const v4u*)(BQKV + (size_t)tj * 3072 + part * 1024 + h * 128 + c0), x1 = *(const v4u*)(BQKV + (size_t)tj * 3072 + part * 1024 + h * 128 + c0 + 8);
            const LAS float* wj = CWl + part * 512 + j * 128 + c0; const float mk = ok ? 1.f : 0.f;
#pragma unroll
            for (int c = 0; c < 4; ++c) { a[2 * c] += bf2f(x0[c] & 0xffffu) * (wj[2 * c] * mk); a[2 * c + 1] += __uint_as_float(x0[c] & 0xffff0000u) * (wj[2 * c + 1] * mk); a[8 + 2 * c] += bf2f(x1[c] & 0xffffu) * (wj[8 + 2 * c] * mk); a[9 + 2 * c] += __uint_as_float(x1[c] & 0xffff0000u) * (wj[9 + 2 * c] * mk); } }
#pragma unroll
        for (int c = 0; c < 16; ++c) { const float y = pg8::fsilu(a[c]); if (part == 0) qv[c] = y; else if (part == 1) kv[c] = y; else vv[c] = y; }
    }
    { float sq = 0.f, sk = 0.f;
#pragma unroll
      for (int c = 0; c < 16; ++c) { sq += qv[c] * qv[c]; sk += kv[c] * kv[c]; }
      sq += __shfl_xor(sq, 1); sq += __shfl_xor(sq, 2); sq += __shfl_xor(sq, 4); sk += __shfl_xor(sk, 1); sk += __shfl_xor(sk, 2); sk += __shfl_xor(sk, 4);
      const float qn = rsqrtf(sq + 1e-6f) * 0.08838834764831845f, kn = rsqrtf(sk + 1e-6f);
#pragma unroll
      for (int c = 0; c < 16; ++c) { qv[c] *= qn; kv[c] *= kn; } }
    if (w == 0) { float v = gs[lane];
#pragma unroll
        for (int o = 1; o < 64; o <<= 1) { const float u = __shfl_up(v, o); if (lane >= o) v += u; }
        Gs[lane] = v; }
    __syncthreads();
    {
        const float Gi = Gs[i], Gl = Gs[63], be = bs[i], eg = __expf(Gi), kbs = be * eg, kts = __expf(Gl - Gi);
        v4u pk, pq;
#pragma unroll
        for (int hh = 0; hh < 2; ++hh) {
            pk.x = pk2(kv[8 * hh + 0], kv[8 * hh + 1]); pk.y = pk2(kv[8 * hh + 2], kv[8 * hh + 3]); pk.z = pk2(kv[8 * hh + 4], kv[8 * hh + 5]); pk.w = pk2(kv[8 * hh + 6], kv[8 * hh + 7]);
            pq.x = pk2(qv[8 * hh + 0], qv[8 * hh + 1]); pq.y = pk2(qv[8 * hh + 2], qv[8 * hh + 3]); pq.z = pk2(qv[8 * hh + 4], qv[8 * hh + 5]); pq.w = pk2(qv[8 * hh + 6], qv[8 * hh + 7]);
            *(LAS v4u*)(Kl + i * 272 + (c0 + 8 * hh) * 2) = pk; *(LAS v4u*)(Ql + i * 272 + (c0 + 8 * hh) * 2) = pq; }
        const int ip = perm32pos(i);
#pragma unroll
        for (int c = 0; c < 16; ++c) { *(LAS bf16*)(KBT + (c0 + c) * 144 + i * 2) = (bf16)f2bf(kv[c] * kbs); *(LAS bf16*)(VBT + (c0 + c) * 144 + i * 2) = (bf16)f2bf(vv[c] * be); *(LAS bf16*)(KTl + (c0 + c) * 144 + ip * 2) = (bf16)f2bf(kv[c] * kts); }
#pragma unroll
        for (int gp = 0; gp < 4; ++gp) { v2u o; o.x = pk2(qv[4 * gp] * eg, qv[4 * gp + 1] * eg); o.y = pk2(qv[4 * gp + 2] * eg, qv[4 * gp + 3] * eg); *(v2u*)(QD + i * 128 + 32 * (cg >> 1) + 8 * gp + 4 * (cg & 1)) = o; }
        if (tid == 0) *GLp = __expf(Gl);
    }
    __syncthreads();
    {
        const int kind = w >> 2, rb = w & 3; LAS unsigned char* Al = kind ? Ql : Kl;
        bf16x8 af[4];
#pragma unroll
        for (int ks = 0; ks < 4; ++ks) af[ks] = *(const LAS bf16x8*)(Al + (rb * 16 + li) * 272 + (ks * 32 + g * 8) * 2);
#pragma unroll
        for (int cb = 0; cb < 4; ++cb) {
            f32x4 acc = (f32x4){0.f, 0.f, 0.f, 0.f};
            if (cb <= rb) {
#pragma unroll
                for (int ks = 0; ks < 4; ++ks) { const bf16x8 bfr = *(const LAS bf16x8*)(Kl + (cb * 16 + li) * 272 + (ks * 32 + g * 8) * 2); acc = __builtin_amdgcn_mfma_f32_16x16x32_bf16(af[ks], bfr, acc, 0, 0, 0); } }
            const int j = cb * 16 + li; const float Gj = Gs[j];
#pragma unroll
            for (int r = 0; r < 4; ++r) { const int ii = rb * 16 + 4 * g + r; const float Lij = __expf(Gs[ii] - Gj);
                if (kind == 0) Am[ii * 65 + j] = ii > j ? acc[r] * Lij * bs[ii] : 0.f;
                else *(LAS bf16*)(AQl + ii * 144 + perm32pos(j) * 2) = (bf16)f2bf(ii >= j ? acc[r] * Lij : 0.f); }
        }
    }
    __syncthreads();
    if (w == 0) {
        int zv = 0; asm volatile("" : "+v"(zv)); const LAS float* Amv = Am + zv;
        float Tr[64];
#pragma unroll
        for (int ii = 0; ii < 64; ++ii) {
            float a0 = (ii == lane) ? 1.f : 0.f, a1 = 0.f;
#pragma unroll
            for (int j = 0; j < ii; ++j) { if (j & 1) a1 -= Amv[ii * 65 + j] * Tr[j]; else a0 -= Amv[ii * 65 + j] * Tr[j]; }
            Tr[ii] = a0 + a1;
            *(LAS bf16*)(Tl + ii * 144 + lane * 2) = (bf16)f2bf(Tr[ii]);
            asm volatile("" ::: "memory");
        }
    }
    __syncthreads();
    {
        const int kind = w >> 2; LAS unsigned char* Xl = kind ? VBT : KBT;
#pragma unroll
        for (int q2 = 0; q2 < 2; ++q2) { const int rbk = 2 * (w & 3) + q2;
            bf16x8 af[2];
#pragma unroll
            for (int ks = 0; ks < 2; ++ks) af[ks] = *(const LAS bf16x8*)(Xl + (rbk * 16 + li) * 144 + (ks * 32 + g * 8) * 2);
#pragma unroll
            for (int cb = 0; cb < 4; ++cb) { f32x4 acc = (f32x4){0.f, 0.f, 0.f, 0.f};
#pragma unroll
                for (int ks = 0; ks < 2; ++ks) { const bf16x8 bfr = *(const LAS bf16x8*)(Tl + (cb * 16 + li) * 144 + (ks * 32 + g * 8) * 2); acc = __builtin_amdgcn_mfma_f32_16x16x32_bf16(af[ks], bfr, acc, 0, 0, 0); }
                const int ii = cb * 16 + li;
                if (kind == 0) { v2u o; o.x = pk2(-acc[0], -acc[1]); o.y = pk2(-acc[2], -acc[3]); *(v2u*)(Wn + ii * 128 + 32 * (rbk >> 1) + 8 * g + 4 * (rbk & 1)) = o; }
                else {
#pragma unroll
                    for (int r = 0; r < 4; ++r) UT[(rbk * 16 + 4 * g + r) * 64 + ii] = acc[r]; } }
        }
    }
#pragma unroll
    for (int q2 = 0; q2 < 2; ++q2) { const int c = tid + 512 * q2, row = c >> 3, cc = c & 7; *(v4u*)(KT + row * 64 + cc * 8) = *(const LAS v4u*)(KTl + row * 144 + cc * 16); }
    { const int row = tid >> 3, cc = tid & 7; *(v4u*)(AQK + row * 64 + cc * 8) = *(const LAS v4u*)(AQl + row * 144 + cc * 16); }
}

DI void gdn_scan(const Frame& F, int bh, const unsigned char* CHB, const float* GLB, bf16* OB) {
    constexpr int BUFB = 62464, O_QD = 17408, O_AQ = 34816, O_KT = 44032;
    int tid_ = F.tid; asm volatile("" : "+v"(tid_));
    const int tid = tid_, lane = tid & 63, w = F.wave, li = lane & 15, g = lane >> 4, b = bh >> 3, h = bh & 7;
    f32x4 S[8];
#pragma unroll
    for (int kb = 0; kb < 8; ++kb) S[kb] = (f32x4){0.f, 0.f, 0.f, 0.f};
    int ldso[7];
#pragma unroll
    for (int q = 0; q < 7; ++q) { const int c = tid + 512 * q;
        if (q < 2) ldso[q] = (c >> 4) * 272 + (c & 15) * 16; else if (q < 4) ldso[q] = O_QD + ((c - 1024) >> 4) * 272 + (c & 15) * 16;
        else if (q == 4) ldso[q] = O_AQ + ((c - 2048) >> 3) * 144 + (c & 7) * 16; else ldso[q] = O_KT + ((c - 2560) >> 3) * 144 + (c & 7) * 16; }
    const unsigned char* CH0 = CHB + (size_t)(bh * 32) * GDN_CH_BYTES;
    v4u st[7]; f32x4 utc[4], utn[4]; float glc, gln;
    __syncthreads();
#pragma unroll
    for (int q = 0; q < 7; ++q) st[q] = *(const v4u*)(CH0 + (size_t)(tid + 512 * q) * 16);
#pragma unroll
    for (int jb = 0; jb < 4; ++jb) utc[jb] = *(const f32x4*)((const float*)(CH0 + 57344) + (16 * w + li) * 64 + jb * 16 + 4 * g);
    glc = GLB[bh * 32];
#pragma unroll
    for (int q = 0; q < 7; ++q) *(LAS v4u*)(F.lds + ldso[q]) = st[q];
    __syncthreads();
    for (int n = 0; n < 32; ++n) {
        const LAS unsigned char* Lb = F.lds + (n & 1) * BUFB;
        if (n + 1 < 32) { const unsigned char* CH = CH0 + (size_t)(n + 1) * GDN_CH_BYTES;
#pragma unroll
            for (int q = 0; q < 7; ++q) st[q] = *(const v4u*)(CH + (size_t)(tid + 512 * q) * 16);
#pragma unroll
            for (int jb = 0; jb < 4; ++jb) utn[jb] = *(const f32x4*)((const float*)(CH + 57344) + (16 * w + li) * 64 + jb * 16 + 4 * g);
            gln = GLB[bh * 32 + n + 1]; }
        bf16x8 sf[4];
#pragma unroll
        for (int ks = 0; ks < 4; ++ks) { v4u p; p.x = pk2(S[2 * ks][0], S[2 * ks][1]); p.y = pk2(S[2 * ks][2], S[2 * ks][3]); p.z = pk2(S[2 * ks + 1][0], S[2 * ks + 1][1]); p.w = pk2(S[2 * ks + 1][2], S[2 * ks + 1][3]); sf[ks] = __builtin_bit_cast(bf16x8, p); }
        f32x4 vn[4];
#pragma unroll
        for (int jb = 0; jb < 4; ++jb) { vn[jb] = utc[jb];
#pragma unroll
            for (int ks = 0; ks < 4; ++ks) { const bf16x8 a = *(const LAS bf16x8*)(Lb + (jb * 16 + li) * 272 + (ks * 32 + g * 8) * 2); vn[jb] = __builtin_amdgcn_mfma_f32_16x16x32_bf16(a, sf[ks], vn[jb], 0, 0, 0); } }
        bf16x8 vf[2];
#pragma unroll
        for (int js = 0; js < 2; ++js) { v4u p; p.x = pk2(vn[2 * js][0], vn[2 * js][1]); p.y = pk2(vn[2 * js][2], vn[2 * js][3]); p.z = pk2(vn[2 * js + 1][0], vn[2 * js + 1][1]); p.w = pk2(vn[2 * js + 1][2], vn[2 * js + 1][3]); vf[js] = __builtin_bit_cast(bf16x8, p); }
#pragma unroll
        for (int ib = 0; ib < 4; ++ib) { f32x4 z = (f32x4){0.f, 0.f, 0.f, 0.f};
#pragma unroll
            for (int ks = 0; ks < 4; ++ks) { const bf16x8 bq = *(const LAS bf16x8*)(Lb + O_QD + (ib * 16 + li) * 272 + (ks * 32 + g * 8) * 2); z = __builtin_amdgcn_mfma_f32_16x16x32_bf16(sf[ks], bq, z, 0, 0, 0); }
#pragma unroll
            for (int js = 0; js < 2; ++js) { const bf16x8 ba = *(const LAS bf16x8*)(Lb + O_AQ + (ib * 16 + li) * 144 + (js * 32 + g * 8) * 2); z = __builtin_amdgcn_mfma_f32_16x16x32_bf16(vf[js], ba, z, 0, 0, 0); }
            v2u zo; zo.x = pk2(z[0], z[1]); zo.y = pk2(z[2], z[3]); *(v2u*)(OB + ((size_t)(b * SEQ + n * 64 + ib * 16 + li)) * 1024 + h * 128 + 16 * w + 4 * g) = zo; }
#pragma unroll
        for (int kb = 0; kb < 8; ++kb) { S[kb] = S[kb] * glc;
#pragma unroll
            for (int js = 0; js < 2; ++js) { const bf16x8 a = *(const LAS bf16x8*)(Lb + O_KT + (kb * 16 + li) * 144 + (js * 32 + g * 8) * 2); S[kb] = __builtin_amdgcn_mfma_f32_16x16x32_bf16(a, vf[js], S[kb], 0, 0, 0); } }
        if (n + 1 < 32) {
            LAS unsigned char* Ln = F.lds + ((n + 1) & 1) * BUFB;
#pragma unroll
            for (int q = 0; q < 7; ++q) *(LAS v4u*)(Ln + ldso[q]) = st[q];
#pragma unroll
            for (int jb = 0; jb < 4; ++jb) utc[jb] = utn[jb];
            glc = gln; }
        __syncthreads();
    }
}

#define x_in ((const float*)args.in[0])
#define mem ((const float*)args.in[1])
#define w_in ((const float*)args.in[2])
#define conv_w ((const float*)args.in[3])
#define a_log ((const float*)args.in[4])
#define dt_bias ((const float*)args.in[5])
#define gdn_norm_w ((const float*)args.in[6])
#define diff_lambda ((const float*)args.in[7])
#define diff_norm_w ((const float*)args.in[8])
#define w_branch ((const float*)args.in[9])
#define w_out ((const float*)args.in[10])
#define mix_norm_w ((const float*)args.in[11])
#define mem_norm_w ((const float*)args.in[12])
#define cross_norm_w ((const float*)args.in[13])
#define cross_w_q ((const float*)args.in[14])
#define cross_w_kv ((const float*)args.in[15])
#define cross_w_o ((const float*)args.in[16])
#define ffn_norm_w ((const float*)args.in[17])
#define dense_w_gu ((const float*)args.in[18])
#define dense_w_down ((const float*)args.in[19])
#define router_w ((const float*)args.in[20])
#define expert_w_gu ((const float*)args.in[21])
#define expert_w_down ((const float*)args.in[22])
#define final_norm_w ((const float*)args.in[23])
#define WIN ((bf16*)(ws + WS_WIN))
#define WBR ((bf16*)(ws + WS_WBR))
#define WOUT ((bf16*)(ws + WS_WOUT))
#define WQ ((bf16*)(ws + WS_WQ))
#define WKV ((bf16*)(ws + WS_WKV))
#define WO ((bf16*)(ws + WS_WO))
#define WGU ((bf16*)(ws + WS_WGU))
#define WDN ((bf16*)(ws + WS_WDN))
#define WEGU ((bf16*)(ws + WS_WEGU))
#define WEDN ((bf16*)(ws + WS_WEDN))
#define XRES ((float*)(ws + WS_XRES))
#define H ((bf16*)(ws + WS_H))
#define RQ ((bf16*)(ws + WS_RQ))
#define RK ((bf16*)(ws + WS_RK))
#define RVT ((bf16*)(ws + WS_RV))
#define RG ((bf16*)(ws + WS_RG))
#define BQKV ((bf16*)(ws + WS_BQKV))
#define BZ ((bf16*)(ws + WS_BZ))
#define BBA ((float*)(ws + WS_BBA))
#define CQ ((bf16*)(ws + WS_CQ))
#define CK ((bf16*)(ws + WS_CK))
#define CVT ((bf16*)(ws + WS_CVT))
#define GATES ((bf16*)(ws + WS_GATES))
#define GQ ((bf16*)(ws + WS_GQ))
#define GK ((bf16*)(ws + WS_GK))
#define GV ((bf16*)(ws + WS_GV))
#define GG ((float*)(ws + WS_GG))
#define GB ((float*)(ws + WS_GB))
#define OA ((bf16*)(ws + WS_OA))
#define OB ((bf16*)(ws + WS_OB))
#define O12 ((bf16*)(ws + WS_O12))
#define OCAT ((bf16*)(ws + WS_OCAT))
#define MERGE ((float*)(ws + WS_MERGE))
#define MERGEB ((bf16*)(ws + WS_MERGEB))
#define MEMN ((bf16*)(ws + WS_MEMN))
#define KX ((bf16*)(ws + WS_KX))
#define VXT ((bf16*)(ws + WS_VXT))
#define QX ((bf16*)(ws + WS_QX))
#define OX ((bf16*)(ws + WS_OX))
#define ACT ((bf16*)(ws + WS_ACT))
#define HG ((bf16*)(ws + WS_HG))
#define EACT ((bf16*)(ws + WS_EACT))
#define Y ((float*)(ws + WS_Y))
#define ROUTE ((int*)(ws + WS_ROUTE))
#define H8 ((unsigned char*)(ws + WS_H8))
#define WIN8 ((unsigned char*)(ws + WS_WIN8))
__global__ void __launch_bounds__(NWAVES * 64, 2) mk_fwd(Args args) {
    extern __shared__ __attribute__((aligned(16))) unsigned char lds_raw[];
    Frame F;
    F.lds = (LAS unsigned char*)lds_raw;
    F.tid = threadIdx.x; F.lane = F.tid & 63; F.wave = __builtin_amdgcn_readfirstlane(F.tid >> 6);
    F.G = gridDim.x; { const int bx = blockIdx.x; F.vcu = (F.G % 8 == 0) ? (bx % 8) * (F.G / 8) + bx / 8 : bx; }
    F.gw = F.vcu * NWAVES + F.wave; F.NGW = F.G * NWAVES;
    volatile LAS unsigned* MISC = (volatile LAS unsigned*)(F.lds + MISC_OFF);
    LAS int* MTAB = (LAS int*)(F.lds + MISC_OFF + 128);
    unsigned char* ws = args.ws;
    unsigned* ctl = (unsigned*)(ws + WS_CTL);
    for (int u = F.tid; u < (LDS_BYTES - RING_BYTES) / 4; u += NWAVES * 64) ((LAS unsigned*)(F.lds + RING_BYTES))[u] = 0u;
    __syncthreads();
#if MK_ONE_LAUNCH
    XcdBarrier bar = xcd_barrier_post(ctl + CW_BAR, MISC + 8);
#define GRID_BAR() xcd_barrier(bar)
#else
#define GRID_BAR() do {} while (0)
#endif
    const int lo = args.ph_lo, hi = args.ph_hi;
#ifndef PROBE_PH
#define PROBE_PH -1
#endif
#define IN(k) (lo <= (k) && ((k) < hi) && (hi <= 100 || (k) == lo))
#define REP(k) for (int rep_ = 0; rep_ < ((k) == PROBE_PH ? 2 : 1); ++rep_)
#define SEAM(k) do { if (IN(k) && IN((k) + 1)) GRID_BAR(); } while (0)

    if (IN(0)) REP(0) {
        for (int l = 0; l < 2; ++l) {
            conv_wg<false>(F, w_in + (size_t)l * D * 17424, D, 17424, WIN + (size_t)l * NINP * D, 45 * 256, 3, 0, 1.f);
            conv_wg<true>(F, w_in + (size_t)l * D * 17424, D, 17424, WIN8 + (size_t)l * 32 * 256 * D, 24 * 256, 4, 0, 256.f);
            conv_wg<false>(F, w_branch + (size_t)l * 3072 * D, 3072, D, WBR + (size_t)l * D * 3072, D, 0, 0, 1.f);
            conv_wg<false>(F, w_out + (size_t)l * D * D, D, D, WOUT + (size_t)l * D * D, D, 0, 0, 1.f);
            conv_wg<false>(F, cross_w_q + (size_t)l * D * 512, D, 512, WQ + (size_t)l * 512 * D, 512, 0, 0, 1.f);
            conv_wg<false>(F, cross_w_kv + (size_t)l * D * 1024, D, 1024, WKV + (size_t)l * 1024 * D, 1024, 0, 0, 1.f);
            conv_wg<false>(F, cross_w_o + (size_t)l * 512 * D, 512, D, WO + (size_t)l * D * 512, D, 0, 0, 1.f);
        }
        conv_wg<false>(F, dense_w_gu, D, 2 * DFF, WGU, 2 * DFF, 2, DFF, 1.f);
        conv_wg<false>(F, dense_w_down, DFF, D, WDN, D, 0, 0, 1.f);
        for (int e = 0; e < NEXP; ++e) {
            conv_wg<true>(F, expert_w_gu + (size_t)e * D * 2 * EFF, D, 2 * EFF, (unsigned char*)WEGU + (size_t)e * 2 * EFF * D, 2 * EFF, 2, EFF, 256.f);
            conv_wg<true>(F, expert_w_down + (size_t)e * EFF * D, EFF, D, (unsigned char*)WEDN + (size_t)e * D * EFF, D, 0, 0, 256.f);
        }
        for (int r = F.gw; r < T; r += F.NGW) rms_row(x_in + (size_t)r * D, mix_norm_w, H + (size_t)r * D, F.lane, H8 + (size_t)r * D);
        for (int r = F.gw; r < 2 * MEMR; r += F.NGW) { const int l = r / MEMR, rr = r % MEMR; rms_row(mem + (size_t)rr * D, mem_norm_w + l * D, MEMN + (size_t)r * D, F.lane); }
    }
    SEAM(0);

    { constexpr int l = 0;
        const int pb = 2 + l * NPL;
        const float lambda_init = l == 0 ? 0.2f : 0.35550906f;
        const float* xin = l == 0 ? x_in : XRES;
        if (IN(pb + 0)) REP(pb + 0) {
            { pg8::Gemm g{H, WIN + (size_t)l * NINP * D, T, 45 * 256, D}; pg8::StaticOrder S; S.init(T, 45 * 256, F.G, (int)blockIdx.x);
              pg8::EpiIn E{RQ, RK, RVT, RG, BQKV, BZ, CQ, CK, CVT, GATES, BBA, 0, 1.f};
              pg8::gemm_phase<pg8::EpiIn, pg8::StaticOrder, true, true>(F.lds, g, S, E); }
            { pg8::Gemm g{(const bf16*)H8, (const bf16*)(WIN8 + (size_t)l * 32 * 256 * D), T, 24 * 256, D / 2}; pg8::StaticOrder S; S.init(T, 24 * 256, F.G, (int)blockIdx.x);
              pg8::EpiIn E{RQ, RK, RVT, RG, BQKV, BZ, CQ, CK, CVT, GATES, BBA, 1, 1.0f / 256.f};
              pg8::gemm_phase<pg8::EpiIn, pg8::StaticOrder, true, true, true>(F.lds, g, S, E); }
        }
        SEAM(pb + 0);
        if (IN(pb + 1)) REP(pb + 1) {
            const float* cw = conv_w + (size_t)l * 4 * 3072;
            for (int it = F.vcu; it < 1024; it += F.G) gdn_prep_item(F, l, it >> 5, it & 31, BQKV, BBA, cw, a_log, dt_bias, ws + WS_GCH + (size_t)it * GDN_CH_BYTES, (float*)(ws + WS_GL) + it);
        }
        SEAM(pb + 1);
        if (IN(pb + 2)) REP(pb + 2) {
            const int bx = F.vcu;
            const int mixsel = (l == 0 && args.ph_hi > 100) ? (args.ph_hi - 100) : 3, qw = (l == 0 && args.ph_hi > 100) ? 104 : 100 + l;
            if (bx < 32 && (mixsel & 1)) gdn_scan(F, bx, ws + WS_GCH, (const float*)(ws + WS_GL), OB);
            if (mixsel & 2) {
                volatile LAS int* qslot = (volatile LAS int*)(F.lds + MISC_OFF + 256);
                int nxt = 0; if (F.tid == 0) nxt = (int)atomicAdd(ctl + qw, 1u);
                for (;;) {
                    __syncthreads(); if (F.tid == 0) qslot[0] = nxt; __syncthreads();
                    const int it = __builtin_amdgcn_readfirstlane(qslot[0]); if (it >= 768) break;
                    if (F.tid == 0) nxt = (int)atomicAdd(ctl + qw, 1u);
                    const int v = it / 48, r = it % 48;
                    if (r < 32) { const int qt = 15 - v, hd = r, b = hd >> 3, hm = hd & 7, hh = hm >> 1, m = hm & 1; const float slope = exp2f(-2.0f * (float)(hh + 1));
                        flash_item<256, 128, true, true, false>(F, CQ + ((size_t)hd * SEQ + qt * 128) * 128, CK + (size_t)hd * SEQ * 128, CVT + (size_t)(b * 4 + hh) * 256 * SEQ, SEQ, qt * 128, SEQ, slope,
                                                            nullptr, O12 + ((size_t)m * T + b * SEQ + qt * 128) * 1024 + hh * 256, 1024); }
                    else { const int qt2 = 7 - (v >> 1), hd = (r - 32) + 16 * (v & 1), b = hd >> 3, hm = hd & 7; const float lg = log2f(1.0f - exp2f(-5.0f - (float)hm));
                        flash_ret(F, RQ + ((size_t)hd * SEQ + qt2 * 256) * 128, RK + (size_t)hd * SEQ * 128, RVT + (size_t)hd * 128 * SEQ, SEQ, qt2 * 256, lg, OA + ((size_t)(b * SEQ + qt2 * 256)) * 1024 + hm * 128, 1024); }
                }
            }
        }
        SEAM(pb + 2);
        if (IN(pb + 3)) REP(pb + 3) {
            const int lane = F.lane;
            const float* lv = diff_lambda + (size_t)l * 512;
            const float d01 = wave_sum(lv[lane] * lv[128 + lane] + lv[64 + lane] * lv[192 + lane]), d23 = wave_sum(lv[256 + lane] * lv[384 + lane] + lv[320 + lane] * lv[448 + lane]);
            const float lam = __expf(d01) - __expf(d23) + lambda_init;
            const float gw0 = gdn_norm_w[l * 128 + 2 * lane], gw1 = gdn_norm_w[l * 128 + 2 * lane + 1]; const f32x4 dw = *(const f32x4*)(diff_norm_w + l * 256 + 4 * lane);
            for (int t = F.gw; t < T; t += F.NGW) {
                float a0[8], a1[8], b0[8], b1[8], red[28]; f32x4 dd[4];
#pragma unroll
                for (int h = 0; h < 8; ++h) { const size_t o = (size_t)t * 1024 + h * 128 + 2 * lane; const unsigned av = *(const unsigned*)(OA + o), bv = *(const unsigned*)(OB + o);
                    a0[h] = bf2f(av & 0xffffu); a1[h] = __uint_as_float(av & 0xffff0000u); b0[h] = bf2f(bv & 0xffffu); b1[h] = __uint_as_float(bv & 0xffff0000u);
                    red[h] = a0[h] + a1[h]; red[8 + h] = a0[h] * a0[h] + a1[h] * a1[h]; red[16 + h] = b0[h] * b0[h] + b1[h] * b1[h]; }
#pragma unroll
                for (int h = 0; h < 4; ++h) { const size_t o = (size_t)t * 1024 + h * 256 + 4 * lane; const v2u pw = *(const v2u*)(O12 + o), qw = *(const v2u*)(O12 + (size_t)T * 1024 + o);
                    const f32x4 p = {bf2f(pw.x & 0xffffu), __uint_as_float(pw.x & 0xffff0000u), bf2f(pw.y & 0xffffu), __uint_as_float(pw.y & 0xffff0000u)}, q = {bf2f(qw.x & 0xffffu), __uint_as_float(qw.x & 0xffff0000u), bf2f(qw.y & 0xffffu), __uint_as_float(qw.y & 0xffff0000u)};
                    dd[h] = p - q * lam; red[24 + h] = (dd[h][0] * dd[h][0] + dd[h][1] * dd[h][1]) + (dd[h][2] * dd[h][2] + dd[h][3] * dd[h][3]); }
#pragma unroll
                for (int o = 1; o < 64; o <<= 1) {
#pragma unroll
                    for (int i = 0; i < 28; ++i) red[i] += __shfl_xor(red[i], o); }
#pragma unroll
                for (int h = 0; h < 8; ++h) { const size_t o = (size_t)t * 1024 + h * 128 + 2 * lane; const unsigned gv = *(const unsigned*)(RG + o), zv = *(const unsigned*)(BZ + o);
                    const float mean = red[h] * (1.f / 128.f), var = fmaxf(red[8 + h] * (1.f / 128.f) - mean * mean, 0.f), rsa = rsqrtf(var + EPS), rsb = rsqrtf(red[16 + h] * (1.f / 128.f) + EPS);
                    *(unsigned*)(OCAT + (size_t)t * 3072 + h * 128 + 2 * lane) = pk2((a0[h] - mean) * rsa * bf2f(gv & 0xffffu), (a1[h] - mean) * rsa * __uint_as_float(gv & 0xffff0000u));
                    *(unsigned*)(OCAT + (size_t)t * 3072 + 1024 + h * 128 + 2 * lane) = pk2(b0[h] * rsb * gw0 * bf2f(zv & 0xffffu), b1[h] * rsb * gw1 * __uint_as_float(zv & 0xffff0000u)); }
#pragma unroll
                for (int h = 0; h < 4; ++h) { const float rstd = rsqrtf(red[24 + h] * (1.f / 256.f) + EPS) * (1.0f - lambda_init);
                    v2u ov; ov.x = pk2(dd[h][0] * rstd * dw[0], dd[h][1] * rstd * dw[1]); ov.y = pk2(dd[h][2] * rstd * dw[2], dd[h][3] * rstd * dw[3]); *(v2u*)(OCAT + (size_t)t * 3072 + 2048 + h * 256 + 4 * lane) = ov; }
            }
        }
        SEAM(pb + 3);
        if (IN(pb + 4)) REP(pb + 4) {
            pg8::Gemm g{OCAT, WBR + (size_t)l * D * 3072, T, D, 3072}; pg8::StaticOrder S; S.init(T, D, F.G, (int)blockIdx.x);
            pg8::EpiBranch E{MERGEB, GATES, 16, 32};
            pg8::gemm_phase<pg8::EpiBranch, pg8::StaticOrder, true, true>(F.lds, g, S, E);
        }
        SEAM(pb + 4);
        if (IN(pb + 5)) REP(pb + 5) {
            pg8::Gemm g{MERGEB, WOUT + (size_t)l * D * D, T, D, D}; pg8::StaticOrder S; S.init(T, D, F.G, (int)blockIdx.x);
            pg8::EpiResid E{xin, XRES, D, 1.f};
            pg8::gemm_phase<pg8::EpiResid, pg8::StaticOrder, true, true>(F.lds, g, S, E);
        }
        SEAM(pb + 5);
        if (IN(pb + 6)) REP(pb + 6) { for (int r = F.gw; r < T; r += F.NGW) rms_row(XRES + (size_t)r * D, cross_norm_w + l * D, H + (size_t)r * D, F.lane); }
        SEAM(pb + 6);
        if (IN(pb + 7)) REP(pb + 7) {
            pg8::Gemm g{H, WQ + (size_t)l * 512 * D, T, 512, D}; pg8::StaticOrder S; S.init(T, 512, F.G, (int)blockIdx.x);
            pg8::EpiHeads E{QX, nullptr, 4, 11, 1 << 20};
            pg8::gemm_phase<pg8::EpiHeads, pg8::StaticOrder, true, true>(F.lds, g, S, E);
            pg8::Gemm g2{MEMN + (size_t)l * MEMR * D, WKV + (size_t)l * 1024 * D, MEMR, 1024, D}; pg8::StaticOrder S2; S2.init(MEMR, 1024, F.G, (int)((blockIdx.x + F.G - 64) % F.G));
            pg8::EpiHeads E2{KX + (size_t)l * NB * 4 * MEML * 128, VXT + (size_t)l * NB * 4 * 128 * MEML, 4, 8, 2};
            pg8::gemm_phase<pg8::EpiHeads, pg8::StaticOrder, true, true>(F.lds, g2, S2, E2);
        }
        SEAM(pb + 7);
        if (IN(pb + 8)) REP(pb + 8) {
            for (int it = F.vcu; it < 256; it += F.G) { const int hd = it >> 4, qt = it & 15, b = hd >> 2, hh = hd & 3;
                flash_item<128, 128, false, true, false>(F, QX + ((size_t)hd * SEQ + qt * 128) * 128, KX + ((size_t)l * 16 + hd) * MEML * 128, VXT + ((size_t)l * 16 + hd) * 128 * MEML, MEML, qt * 128, MEML, 0.f,
                                             nullptr, OX + ((size_t)(b * SEQ + qt * 128)) * 512 + hh * 128, 512); }
        }
        SEAM(pb + 8);
        if (IN(pb + 9)) REP(pb + 9) {
            pg8::Gemm g{OX, WO + (size_t)l * D * 512, T, D, 512}; pg8::StaticOrder S; S.init(T, D, F.G, (int)blockIdx.x);
            pg8::EpiResid E{XRES, XRES, D, 1.f};
            pg8::gemm_phase<pg8::EpiResid, pg8::StaticOrder, true, true>(F.lds, g, S, E);
        }
        SEAM(pb + 9);
        if (IN(pb + 10)) REP(pb + 10) {
            const int lane = F.lane; const float* w = ffn_norm_w + l * D;
            for (int r = F.gw; r < T; r += F.NGW) {
                const float* xrow = XRES + (size_t)r * D; f32x4 v[8]; float ss = 0.f;
#pragma unroll
                for (int j = 0; j < 8; ++j) { v[j] = *(const f32x4*)(xrow + 4 * (lane + 64 * j)); ss += (v[j][0] * v[j][0] + v[j][1] * v[j][1]) + (v[j][2] * v[j][2] + v[j][3] * v[j][3]); }
                const float rstd = rsqrtf(wave_sum(ss) * (1.f / D) + EPS);
                float lg[8];
#pragma unroll
                for (int e = 0; e < 8; ++e) lg[e] = 0.f;
#pragma unroll
                for (int j = 0; j < 8; ++j) { const f32x4 ww = *(const f32x4*)(w + 4 * (lane + 64 * j)); v[j] = v[j] * rstd * ww; }
                if (l == 1) {
#pragma unroll
                    for (int j = 0; j < 8; ++j)
#pragma unroll
                        for (int c = 0; c < 4; ++c) { const float* rw = router_w + (size_t)(4 * (lane + 64 * j) + c) * 8; const f32x4 r0 = *(const f32x4*)rw, r1 = *(const f32x4*)(rw + 4); const float yc = v[j][c];
                            lg[0] += yc * r0[0]; lg[1] += yc * r0[1]; lg[2] += yc * r0[2]; lg[3] += yc * r0[3]; lg[4] += yc * r1[0]; lg[5] += yc * r1[1]; lg[6] += yc * r1[2]; lg[7] += yc * r1[3]; } }
#pragma unroll
                for (int j = 0; j < 8; ++j) {
                    if (l == 0) { v2u o; o.x = pk2(v[j][0], v[j][1]); o.y = pk2(v[j][2], v[j][3]); *(v2u*)(H + (size_t)r * D + 4 * (lane + 64 * j)) = o; }
                    else *(unsigned*)(H8 + (size_t)r * D + 4 * (lane + 64 * j)) = pg8::pk4_fp8(v[j][0], v[j][1], v[j][2], v[j][3]); }
                if (l == 1) {
#pragma unroll
                    for (int e = 0; e < 8; ++e) lg[e] = wave_sum(lg[e]);
                    int e0 = 0; float v0 = lg[0];
#pragma unroll
                    for (int e = 1; e < 8; ++e) if (lg[e] > v0) { v0 = lg[e]; e0 = e; }
                    int e1 = -1; float v1 = -__builtin_inff();
#pragma unroll
                    for (int e = 0; e < 8; ++e) if (e != e0 && lg[e] > v1) { v1 = lg[e]; e1 = e; }
                    if (lane == 0) { const float p0 = 1.0f / (1.0f + __expf(v1 - v0)); int* ro = ROUTE + (size_t)r * 8;
                        ro[0] = e0; ro[1] = e1; ro[2] = (int)atomicAdd(ctl + CW_CNT + e0, 1u); ro[3] = (int)atomicAdd(ctl + CW_CNT + e1, 1u); ((float*)ro)[4] = p0; ((float*)ro)[5] = 1.0f - p0; }
                }
            }
        }
        SEAM(pb + 10);
        if (l == 0) {
            if (IN(pb + 11)) REP(pb + 11) {
                pg8::Gemm g{H, WGU, T, 2 * DFF, D}; pg8::StaticOrder S; S.init(T, 2 * DFF, F.G, (int)blockIdx.x);
                pg8::EpiSwiglu E{ACT, DFF, 1 << 20};
                pg8::gemm_phase<pg8::EpiSwiglu, pg8::StaticOrder, true, true>(F.lds, g, S, E);
            }
            SEAM(pb + 11);
            if (IN(pb + 12)) REP(pb + 12) {
                pg8::Gemm g{ACT, WDN, T, D, DFF}; pg8::StaticOrder S; S.init(T, D, F.G, (int)blockIdx.x);
                pg8::EpiResid E{XRES, XRES, D, 1.f};
                pg8::gemm_phase<pg8::EpiResid, pg8::StaticOrder, true, true>(F.lds, g, S, E);
            }
            SEAM(pb + 12);
            if (IN(pb + 13)) REP(pb + 13) { for (int r = F.gw; r < T; r += F.NGW) rms_row(XRES + (size_t)r * D, mix_norm_w + D, H + (size_t)r * D, F.lane, H8 + (size_t)r * D); }
            SEAM(pb + 13);
        } else {
#define MOE_OFFSETS() int off[9]; off[0] = 0; _Pragma("unroll") for (int e = 0; e < 8; ++e) { const int c = __builtin_amdgcn_readfirstlane((int)__hip_atomic_load(ctl + CW_CNT + e, __ATOMIC_RELAXED, __HIP_MEMORY_SCOPE_AGENT)); off[e + 1] = off[e] + ((c + 255) & ~255); }
            if (IN(pb + 11)) REP(pb + 11) {
                MOE_OFFSETS();
                for (int it = F.gw; it < T * 2; it += F.NGW) { const int t = it >> 1, k = it & 1; int* ro = ROUTE + (size_t)t * 8; const int e = ro[k], pos = ro[2 + k];
                    int base = 0;
#pragma unroll
                    for (int q = 0; q < 8; ++q) if (e == q) base = off[q];
                    const int slot = base + pos; if (F.lane == 0) ro[6 + k] = slot;
                    const v4u* src = (const v4u*)(H8 + (size_t)t * D); v4u* dst = (v4u*)((unsigned char*)HG + (size_t)slot * D);
#pragma unroll
                    for (int j = 0; j < 2; ++j) dst[F.lane + 64 * j] = src[F.lane + 64 * j]; }
#pragma unroll
                for (int e = 0; e < 8; ++e) { const int c = __builtin_amdgcn_readfirstlane((int)__hip_atomic_load(ctl + CW_CNT + e, __ATOMIC_RELAXED, __HIP_MEMORY_SCOPE_AGENT));
                    for (int rr = off[e] + c + F.gw; rr < off[e + 1]; rr += F.NGW) { v4u* dst = (v4u*)((unsigned char*)HG + (size_t)rr * D);
#pragma unroll
                        for (int j = 0; j < 2; ++j) dst[F.lane + 64 * j] = (v4u){0u, 0u, 0u, 0u}; } }
            }
            SEAM(pb + 11);
            if (IN(pb + 12)) REP(pb + 12) {
                if (F.tid == 0) { MOE_OFFSETS(); int cu = 0;
#pragma unroll
                    for (int e = 0; e < 8; ++e) { const int ne = (off[e + 1] - off[e]) >> 8; MTAB[e] = ne; MTAB[8 + e] = off[e] >> 8; MTAB[16 + e] = cu; cu += ne * 56; } MTAB[24] = cu; MTAB[25] = cu; }
                __syncthreads();
                pg8::Gemm g{HG, WEGU, MAXSLOT, NEXP * 2 * EFF, D / 2}; pg8::MoeOrder S{(const LAS int*)MTAB, 56, F.G, (int)blockIdx.x};
                pg8::EpiSwiglu8 E{(unsigned char*)EACT, EFF, 56, 1.0f / 256.f, 8.f};
                pg8::gemm_phase<pg8::EpiSwiglu8, pg8::MoeOrder, true, true, true>(F.lds, g, S, E);
            }
            SEAM(pb + 12);
            if (IN(pb + 13)) REP(pb + 13) {
                __syncthreads();
                if (F.tid == 0) { MOE_OFFSETS(); int cu = 0;
#pragma unroll
                    for (int e = 0; e < 8; ++e) { const int ne = (off[e + 1] - off[e]) >> 8; MTAB[e] = ne; MTAB[8 + e] = off[e] >> 8; MTAB[16 + e] = cu; cu += ne * 8; } MTAB[24] = cu; MTAB[25] = cu; }
                __syncthreads();
                pg8::Gemm g{EACT, WEDN, MAXSLOT, NEXP * D, EFF / 2}; pg8::MoeOrder S{(const LAS int*)MTAB, 8, F.G, (int)blockIdx.x};
                pg8::EpiStoreF32 E{Y, D, 8, 1.0f / 2048.f};
                pg8::gemm_phase<pg8::EpiStoreF32, pg8::MoeOrder, true, true, true>(F.lds, g, S, E);
            }
            SEAM(pb + 13);
            if (IN(pb + 14)) REP(pb + 14) {
                const int lane = F.lane;
                for (int r = F.gw; r < T; r += F.NGW) { const int* ro = ROUTE + (size_t)r * 8; const float p0 = ((const float*)ro)[4], p1 = ((const float*)ro)[5]; const float* y0 = Y + (size_t)ro[6] * D; const float* y1 = Y + (size_t)ro[7] * D;
                    const float* xrow = XRES + (size_t)r * D; f32x4 v[8]; float ss = 0.f;
#pragma unroll
                    for (int j = 0; j < 8; ++j) { const int o = 4 * (lane + 64 * j); v[j] = *(const f32x4*)(xrow + o) + *(const f32x4*)(y0 + o) * p0 + *(const f32x4*)(y1 + o) * p1; ss += (v[j][0] * v[j][0] + v[j][1] * v[j][1]) + (v[j][2] * v[j][2] + v[j][3] * v[j][3]); }
                    f32x4 fw[8];
#pragma unroll
                    for (int j = 0; j < 8; ++j) fw[j] = *(const f32x4*)(final_norm_w + 4 * (lane + 64 * j));
                    const float rstd = rsqrtf(wave_sum(ss) * (1.f / D) + EPS);
#pragma unroll
                    for (int j = 0; j < 8; ++j) { const int o = 4 * (lane + 64 * j); const f32x4 ww = fw[j]; *(f32x4*)(args.out + (size_t)r * D + o) = v[j] * rstd * ww; } }
            }
        }
    }
    { constexpr int l = 1;
        const int pb = 2 + l * NPL;
        const float lambda_init = l == 0 ? 0.2f : 0.35550906f;
        const float* xin = l == 0 ? x_in : XRES;
        if (IN(pb + 0)) REP(pb + 0) {
            { pg8::Gemm g{H, WIN + (size_t)l * NINP * D, T, 45 * 256, D}; pg8::StaticOrder S; S.init(T, 45 * 256, F.G, (int)blockIdx.x);
              pg8::EpiIn E{RQ, RK, RVT, RG, BQKV, BZ, CQ, CK, CVT, GATES, BBA, 0, 1.f};
              pg8::gemm_phase<pg8::EpiIn, pg8::StaticOrder, true, true>(F.lds, g, S, E); }
            { pg8::Gemm g{(const bf16*)H8, (const bf16*)(WIN8 + (size_t)l * 32 * 256 * D), T, 24 * 256, D / 2}; pg8::StaticOrder S; S.init(T, 24 * 256, F.G, (int)blockIdx.x);
              pg8::EpiIn E{RQ, RK, RVT, RG, BQKV, BZ, CQ, CK, CVT, GATES, BBA, 1, 1.0f / 256.f};
              pg8::gemm_phase<pg8::EpiIn, pg8::StaticOrder, true, true, true>(F.lds, g, S, E); }
        }
        SEAM(pb + 0);
        if (IN(pb + 1)) REP(pb + 1) {
            const float* cw = conv_w + (size_t)l * 4 * 3072;
            for (int it = F.vcu; it < 1024; it += F.G) gdn_prep_item(F, l, it >> 5, it & 31, BQKV, BBA, cw, a_log, dt_bias, ws + WS_GCH + (size_t)it * GDN_CH_BYTES, (float*)(ws + WS_GL) + it);
        }
        SEAM(pb + 1);
        if (IN(pb + 2)) REP(pb + 2) {
            const int bx = F.vcu;
            const int mixsel = (l == 0 && args.ph_hi > 100) ? (args.ph_hi - 100) : 3, qw = (l == 0 && args.ph_hi > 100) ? 104 : 100 + l;
            if (bx < 32 && (mixsel & 1)) gdn_scan(F, bx, ws + WS_GCH, (const float*)(ws + WS_GL), OB);
            if (mixsel & 2) {
                volatile LAS int* qslot = (volatile LAS int*)(F.lds + MISC_OFF + 256);
                int nxt = 0; if (F.tid == 0) nxt = (int)atomicAdd(ctl + qw, 1u);
                for (;;) {
                    __syncthreads(); if (F.tid == 0) qslot[0] = nxt; __syncthreads();
                    const int it = __builtin_amdgcn_readfirstlane(qslot[0]); if (it >= 768) break;
                    if (F.tid == 0) nxt = (int)atomicAdd(ctl + qw, 1u);
                    const int v = it / 48, r = it % 48;
                    if (r < 32) { const int qt = 15 - v, hd = r, b = hd >> 3, hm = hd & 7, hh = hm >> 1, m = hm & 1; const float slope = exp2f(-2.0f * (float)(hh + 1));
                        flash_item<256, 128, true, true, false>(F, CQ + ((size_t)hd * SEQ + qt * 128) * 128, CK + (size_t)hd * SEQ * 128, CVT + (size_t)(b * 4 + hh) * 256 * SEQ, SEQ, qt * 128, SEQ, slope,
                                                            nullptr, O12 + ((size_t)m * T + b * SEQ + qt * 128) * 1024 + hh * 256, 1024); }
                    else { const int qt2 = 7 - (v >> 1), hd = (r - 32) + 16 * (v & 1), b = hd >> 3, hm = hd & 7; const float lg = log2f(1.0f - exp2f(-5.0f - (float)hm));
                        flash_ret(F, RQ + ((size_t)hd * SEQ + qt2 * 256) * 128, RK + (size_t)hd * SEQ * 128, RVT + (size_t)hd * 128 * SEQ, SEQ, qt2 * 256, lg, OA + ((size_t)(b * SEQ + qt2 * 256)) * 1024 + hm * 128, 1024); }
                }
            }
        }
        SEAM(pb + 2);
        if (IN(pb + 3)) REP(pb + 3) {
            const int lane = F.lane;
            const float* lv = diff_lambda + (size_t)l * 512;
            const float d01 = wave_sum(lv[lane] * lv[128 + lane] + lv[64 + lane] * lv[192 + lane]), d23 = wave_sum(lv[256 + lane] * lv[384 + lane] + lv[320 + lane] * lv[448 + lane]);
            const float lam = __expf(d01) - __expf(d23) + lambda_init;
            const float gw0 = gdn_norm_w[l * 128 + 2 * lane], gw1 = gdn_norm_w[l * 128 + 2 * lane + 1]; const f32x4 dw = *(const f32x4*)(diff_norm_w + l * 256 + 4 * lane);
            for (int t = F.gw; t < T; t += F.NGW) {
                float a0[8], a1[8], b0[8], b1[8], red[28]; f32x4 dd[4];
#pragma unroll
                for (int h = 0; h < 8; ++h) { const size_t o = (size_t)t * 1024 + h * 128 + 2 * lane; const unsigned av = *(const unsigned*)(OA + o), bv = *(const unsigned*)(OB + o);
                    a0[h] = bf2f(av & 0xffffu); a1[h] = __uint_as_float(av & 0xffff0000u); b0[h] = bf2f(bv & 0xffffu); b1[h] = __uint_as_float(bv & 0xffff0000u);
                    red[h] = a0[h] + a1[h]; red[8 + h] = a0[h] * a0[h] + a1[h] * a1[h]; red[16 + h] = b0[h] * b0[h] + b1[h] * b1[h]; }
#pragma unroll
                for (int h = 0; h < 4; ++h) { const size_t o = (size_t)t * 1024 + h * 256 + 4 * lane; const v2u pw = *(const v2u*)(O12 + o), qw = *(const v2u*)(O12 + (size_t)T * 1024 + o);
                    const f32x4 p = {bf2f(pw.x & 0xffffu), __uint_as_float(pw.x & 0xffff0000u), bf2f(pw.y & 0xffffu), __uint_as_float(pw.y & 0xffff0000u)}, q = {bf2f(qw.x & 0xffffu), __uint_as_float(qw.x & 0xffff0000u), bf2f(qw.y & 0xffffu), __uint_as_float(qw.y & 0xffff0000u)};
                    dd[h] = p - q * lam; red[24 + h] = (dd[h][0] * dd[h][0] + dd[h][1] * dd[h][1]) + (dd[h][2] * dd[h][2] + dd[h][3] * dd[h][3]); }
#pragma unroll
                for (int o = 1; o < 64; o <<= 1) {
#pragma unroll
                    for (int i = 0; i < 28; ++i) red[i] += __shfl_xor(red[i], o); }
#pragma unroll
                for (int h = 0; h < 8; ++h) { const size_t o = (size_t)t * 1024 + h * 128 + 2 * lane; const unsigned gv = *(const unsigned*)(RG + o), zv = *(const unsigned*)(BZ + o);
                    const float mean = red[h] * (1.f / 128.f), var = fmaxf(red[8 + h] * (1.f / 128.f) - mean * mean, 0.f), rsa = rsqrtf(var + EPS), rsb = rsqrtf(red[16 + h] * (1.f / 128.f) + EPS);
                    *(unsigned*)(OCAT + (size_t)t * 3072 + h * 128 + 2 * lane) = pk2((a0[h] - mean) * rsa * bf2f(gv & 0xffffu), (a1[h] - mean) * rsa * __uint_as_float(gv & 0xffff0000u));
                    *(unsigned*)(OCAT + (size_t)t * 3072 + 1024 + h * 128 + 2 * lane) = pk2(b0[h] * rsb * gw0 * bf2f(zv & 0xffffu), b1[h] * rsb * gw1 * __uint_as_float(zv & 0xffff0000u)); }
#pragma unroll
                for (int h = 0; h < 4; ++h) { const float rstd = rsqrtf(red[24 + h] * (1.f / 256.f) + EPS) * (1.0f - lambda_init);
                    v2u ov; ov.x = pk2(dd[h][0] * rstd * dw[0], dd[h][1] * rstd * dw[1]); ov.y = pk2(dd[h][2] * rstd * dw[2], dd[h][3] * rstd * dw[3]); *(v2u*)(OCAT + (size_t)t * 3072 + 2048 + h * 256 + 4 * lane) = ov; }
            }
        }
        SEAM(pb + 3);
        if (IN(pb + 4)) REP(pb + 4) {
            pg8::Gemm g{OCAT, WBR + (size_t)l * D * 3072, T, D, 3072}; pg8::StaticOrder S; S.init(T, D, F.G, (int)blockIdx.x);
            pg8::EpiBranch E{MERGEB, GATES, 16, 32};
            pg8::gemm_phase<pg8::EpiBranch, pg8::StaticOrder, true, true>(F.lds, g, S, E);
        }
        SEAM(pb + 4);
        if (IN(pb + 5)) REP(pb + 5) {
            pg8::Gemm g{MERGEB, WOUT + (size_t)l * D * D, T, D, D}; pg8::StaticOrder S; S.init(T, D, F.G, (int)blockIdx.x);
            pg8::EpiResid E{xin, XRES, D, 1.f};
            pg8::gemm_phase<pg8::EpiResid, pg8::StaticOrder, true, true>(F.lds, g, S, E);
        }
        SEAM(pb + 5);
        if (IN(pb + 6)) REP(pb + 6) { for (int r = F.gw; r < T; r += F.NGW) rms_row(XRES + (size_t)r * D, cross_norm_w + l * D, H + (size_t)r * D, F.lane); }
        SEAM(pb + 6);
        if (IN(pb + 7)) REP(pb + 7) {
            pg8::Gemm g{H, WQ + (size_t)l * 512 * D, T, 512, D}; pg8::StaticOrder S; S.init(T, 512, F.G, (int)blockIdx.x);
            pg8::EpiHeads E{QX, nullptr, 4, 11, 1 << 20};
            pg8::gemm_phase<pg8::EpiHeads, pg8::StaticOrder, true, true>(F.lds, g, S, E);
            pg8::Gemm g2{MEMN + (size_t)l * MEMR * D, WKV + (size_t)l * 1024 * D, MEMR, 1024, D}; pg8::StaticOrder S2; S2.init(MEMR, 1024, F.G, (int)((blockIdx.x + F.G - 64) % F.G));
            pg8::EpiHeads E2{KX + (size_t)l * NB * 4 * MEML * 128, VXT + (size_t)l * NB * 4 * 128 * MEML, 4, 8, 2};
            pg8::gemm_phase<pg8::EpiHeads, pg8::StaticOrder, true, true>(F.lds, g2, S2, E2);
        }
        SEAM(pb + 7);
        if (IN(pb + 8)) REP(pb + 8) {
            for (int it = F.vcu; it < 256; it += F.G) { const int hd = it >> 4, qt = it & 15, b = hd >> 2, hh = hd & 3;
                flash_item<128, 128, false, true, false>(F, QX + ((size_t)hd * SEQ + qt * 128) * 128, KX + ((size_t)l * 16 + hd) * MEML * 128, VXT + ((size_t)l * 16 + hd) * 128 * MEML, MEML, qt * 128, MEML, 0.f,
                                             nullptr, OX + ((size_t)(b * SEQ + qt * 128)) * 512 + hh * 128, 512); }
        }
        SEAM(pb + 8);
        if (IN(pb + 9)) REP(pb + 9) {
            pg8::Gemm g{OX, WO + (size_t)l * D * 512, T, D, 512}; pg8::StaticOrder S; S.init(T, D, F.G, (int)blockIdx.x);
            pg8::EpiResid E{XRES, XRES, D, 1.f};
            pg8::gemm_phase<pg8::EpiResid, pg8::StaticOrder, true, true>(F.lds, g, S, E);
        }
        SEAM(pb + 9);
        if (IN(pb + 10)) REP(pb + 10) {
            const int lane = F.lane; const float* w = ffn_norm_w + l * D;
            for (int r = F.gw; r < T; r += F.NGW) {
                const float* xrow = XRES + (size_t)r * D; f32x4 v[8]; float ss = 0.f;
#pragma unroll
                for (int j = 0; j < 8; ++j) { v[j] = *(const f32x4*)(xrow + 4 * (lane + 64 * j)); ss += (v[j][0] * v[j][0] + v[j][1] * v[j][1]) + (v[j][2] * v[j][2] + v[j][3] * v[j][3]); }
                const float rstd = rsqrtf(wave_sum(ss) * (1.f / D) + EPS);
                float lg[8];
#pragma unroll
                for (int e = 0; e < 8; ++e) lg[e] = 0.f;
#pragma unroll
                for (int j = 0; j < 8; ++j) { const f32x4 ww = *(const f32x4*)(w + 4 * (lane + 64 * j)); v[j] = v[j] * rstd * ww; }
                if (l == 1) {
#pragma unroll
                    for (int j = 0; j < 8; ++j)
#pragma unroll
                        for (int c = 0; c < 4; ++c) { const float* rw = router_w + (size_t)(4 * (lane + 64 * j) + c) * 8; const f32x4 r0 = *(const f32x4*)rw, r1 = *(const f32x4*)(rw + 4); const float yc = v[j][c];
                            lg[0] += yc * r0[0]; lg[1] += yc * r0[1]; lg[2] += yc * r0[2]; lg[3] += yc * r0[3]; lg[4] += yc * r1[0]; lg[5] += yc * r1[1]; lg[6] += yc * r1[2]; lg[7] += yc * r1[3]; } }
#pragma unroll
                for (int j = 0; j < 8; ++j) {
                    if (l == 0) { v2u o; o.x = pk2(v[j][0], v[j][1]); o.y = pk2(v[j][2], v[j][3]); *(v2u*)(H + (size_t)r * D + 4 * (lane + 64 * j)) = o; }
                    else *(unsigned*)(H8 + (size_t)r * D + 4 * (lane + 64 * j)) = pg8::pk4_fp8(v[j][0], v[j][1], v[j][2], v[j][3]); }
                if (l == 1) {
#pragma unroll
                    for (int e = 0; e < 8; ++e) lg[e] = wave_sum(lg[e]);
                    int e0 = 0; float v0 = lg[0];
#pragma unroll
                    for (int e = 1; e < 8; ++e) if (lg[e] > v0) { v0 = lg[e]; e0 = e; }
                    int e1 = -1; float v1 = -__builtin_inff();
#pragma unroll
                    for (int e = 0; e < 8; ++e) if (e != e0 && lg[e] > v1) { v1 = lg[e]; e1 = e; }
                    if (lane == 0) { const float p0 = 1.0f / (1.0f + __expf(v1 - v0)); int* ro = ROUTE + (size_t)r * 8;
                        ro[0] = e0; ro[1] = e1; ro[2] = (int)atomicAdd(ctl + CW_CNT + e0, 1u); ro[3] = (int)atomicAdd(ctl + CW_CNT + e1, 1u); ((float*)ro)[4] = p0; ((float*)ro)[5] = 1.0f - p0; }
                }
            }
        }
        SEAM(pb + 10);
        if (l == 0) {
            if (IN(pb + 11)) REP(pb + 11) {
                pg8::Gemm g{H, WGU, T, 2 * DFF, D}; pg8::StaticOrder S; S.init(T, 2 * DFF, F.G, (int)blockIdx.x);
                pg8::EpiSwiglu E{ACT, DFF, 1 << 20};
                pg8::gemm_phase<pg8::EpiSwiglu, pg8::StaticOrder, true, true>(F.lds, g, S, E);
            }
            SEAM(pb + 11);
            if (IN(pb + 12)) REP(pb + 12) {
                pg8::Gemm g{ACT, WDN, T, D, DFF}; pg8::StaticOrder S; S.init(T, D, F.G, (int)blockIdx.x);
                pg8::EpiResid E{XRES, XRES, D, 1.f};
                pg8::gemm_phase<pg8::EpiResid, pg8::StaticOrder, true, true>(F.lds, g, S, E);
            }
            SEAM(pb + 12);
            if (IN(pb + 13)) REP(pb + 13) { for (int r = F.gw; r < T; r += F.NGW) rms_row(XRES + (size_t)r * D, mix_norm_w + D, H + (size_t)r * D, F.lane, H8 + (size_t)r * D); }
            SEAM(pb + 13);
        } else {
#define MOE_OFFSETS() int off[9]; off[0] = 0; _Pragma("unroll") for (int e = 0; e < 8; ++e) { const int c = __builtin_amdgcn_readfirstlane((int)__hip_atomic_load(ctl + CW_CNT + e, __ATOMIC_RELAXED, __HIP_MEMORY_SCOPE_AGENT)); off[e + 1] = off[e] + ((c + 255) & ~255); }
            if (IN(pb + 11)) REP(pb + 11) {
                MOE_OFFSETS();
                for (int it = F.gw; it < T * 2; it += F.NGW) { const int t = it >> 1, k = it & 1; int* ro = ROUTE + (size_t)t * 8; const int e = ro[k], pos = ro[2 + k];
                    int base = 0;
#pragma unroll
                    for (int q = 0; q < 8; ++q) if (e == q) base = off[q];
                    const int slot = base + pos; if (F.lane == 0) ro[6 + k] = slot;
                    const v4u* src = (const v4u*)(H8 + (size_t)t * D); v4u* dst = (v4u*)((unsigned char*)HG + (size_t)slot * D);
#pragma unroll
                    for (int j = 0; j < 2; ++j) dst[F.lane + 64 * j] = src[F.lane + 64 * j]; }
#pragma unroll
                for (int e = 0; e < 8; ++e) { const int c = __builtin_amdgcn_readfirstlane((int)__hip_atomic_load(ctl + CW_CNT + e, __ATOMIC_RELAXED, __HIP_MEMORY_SCOPE_AGENT));
                    for (int rr = off[e] + c + F.gw; rr < off[e + 1]; rr += F.NGW) { v4u* dst = (v4u*)((unsigned char*)HG + (size_t)rr * D);
#pragma unroll
                        for (int j = 0; j < 2; ++j) dst[F.lane + 64 * j] = (v4u){0u, 0u, 0u, 0u}; } }
            }
            SEAM(pb + 11);
            if (IN(pb + 12)) REP(pb + 12) {
                if (F.tid == 0) { MOE_OFFSETS(); int cu = 0;
#pragma unroll
                    for (int e = 0; e < 8; ++e) { const int ne = (off[e + 1] - off[e]) >> 8; MTAB[e] = ne; MTAB[8 + e] = off[e] >> 8; MTAB[16 + e] = cu; cu += ne * 56; } MTAB[24] = cu; MTAB[25] = cu; }
                __syncthreads();
                pg8::Gemm g{HG, WEGU, MAXSLOT, NEXP * 2 * EFF, D / 2}; pg8::MoeOrder S{(const LAS int*)MTAB, 56, F.G, (int)blockIdx.x};
                pg8::EpiSwiglu8 E{(unsigned char*)EACT, EFF, 56, 1.0f / 256.f, 8.f};
                pg8::gemm_phase<pg8::EpiSwiglu8, pg8::MoeOrder, true, true, true>(F.lds, g, S, E);
            }
            SEAM(pb + 12);
            if (IN(pb + 13)) REP(pb + 13) {
                __syncthreads();
                if (F.tid == 0) { MOE_OFFSETS(); int cu = 0;
#pragma unroll
                    for (int e = 0; e < 8; ++e) { const int ne = (off[e + 1] - off[e]) >> 8; MTAB[e] = ne; MTAB[8 + e] = off[e] >> 8; MTAB[16 + e] = cu; cu += ne * 8; } MTAB[24] = cu; MTAB[25] = cu; }
                __syncthreads();
                pg8::Gemm g{EACT, WEDN, MAXSLOT, NEXP * D, EFF / 2}; pg8::MoeOrder S{(const LAS int*)MTAB, 8, F.G, (int)blockIdx.x};
                pg8::EpiStoreF32 E{Y, D, 8, 1.0f / 2048.f};
                pg8::gemm_phase<pg8::EpiStoreF32, pg8::MoeOrder, true, true, true>(F.lds, g, S, E);
            }
            SEAM(pb + 13);
            if (IN(pb + 14)) REP(pb + 14) {
                const int lane = F.lane;
                for (int r = F.gw; r < T; r += F.NGW) { const int* ro = ROUTE + (size_t)r * 8; const float p0 = ((const float*)ro)[4], p1 = ((const float*)ro)[5]; const float* y0 = Y + (size_t)ro[6] * D; const float* y1 = Y + (size_t)ro[7] * D;
                    const float* xrow = XRES + (size_t)r * D; f32x4 v[8]; float ss = 0.f;
#pragma unroll
                    for (int j = 0; j < 8; ++j) { const int o = 4 * (lane + 64 * j); v[j] = *(const f32x4*)(xrow + o) + *(const f32x4*)(y0 + o) * p0 + *(const f32x4*)(y1 + o) * p1; ss += (v[j][0] * v[j][0] + v[j][1] * v[j][1]) + (v[j][2] * v[j][2] + v[j][3] * v[j][3]); }
                    f32x4 fw[8];
#pragma unroll
                    for (int j = 0; j < 8; ++j) fw[j] = *(const f32x4*)(final_norm_w + 4 * (lane + 64 * j));
                    const float rstd = rsqrtf(wave_sum(ss) * (1.f / D) + EPS);
#pragma unroll
                    for (int j = 0; j < 8; ++j) { const int o = 4 * (lane + 64 * j); const f32x4 ww = fw[j]; *(f32x4*)(args.out + (size_t)r * D + o) = v[j] * rstd * ww; } }
            }
        }
    }
#undef IN
#undef SEAM
}

extern "C" void kernel_launch(void* const* d_in, const int* in_sizes, int n_in, void* d_out, int out_size, void* d_ws, size_t ws_size, hipStream_t stream) {
    static int grid = 0;
    if (grid == 0) {
        if (n_in != 24 || out_size != T * D || ws_size < WS_END) { fprintf(stderr, "kernel_launch: unexpected shapes (n_in %d, out %d, ws %zu < %zu)\n", n_in, out_size, ws_size, (size_t)WS_END); grid = -1; return; }
        int dev = 0, cus = 0, per_cu = 0;
        if (hipGetDevice(&dev) != hipSuccess || hipDeviceGetAttribute(&cus, hipDeviceAttributeMultiprocessorCount, dev) != hipSuccess) { grid = -1; return; }
        if (hipFuncSetAttribute((const void*)mk_fwd, hipFuncAttributeMaxDynamicSharedMemorySize, LDS_BYTES) != hipSuccess) { fprintf(stderr, "kernel_launch: hipFuncSetAttribute failed\n"); grid = -1; return; }
        if (hipOccupancyMaxActiveBlocksPerMultiprocessor(&per_cu, (const void*)mk_fwd, NWAVES * 64, LDS_BYTES) != hipSuccess || per_cu < 1) fprintf(stderr, "kernel_launch: occupancy query says %d\n", per_cu);
        (void)hipGetLastError();
        grid = cus;
    }
    if (grid < 0) return;
    (void)hipMemsetAsync((char*)d_ws + WS_CTL, 0, CTL_BYTES, stream);
    Args a{};
    for (int i = 0; i < 24; ++i) a.in[i] = d_in[i];
    a.out = (float*)d_out; a.ws = (unsigned char*)d_ws;
#if MK_ONE_LAUNCH
    a.ph_lo = 0; a.ph_hi = NPH;
    hipLaunchKernelGGL(mk_fwd, dim3(grid), dim3(NWAVES * 64), LDS_BYTES, stream, a);
#else
#ifndef DUP_MASK
#define DUP_MASK 0ull
#endif
    for (int p = 0; p < NPH; ++p) { a.ph_lo = p; a.ph_hi = p + 1; const int reps = ((DUP_MASK >> p) & 1ull) ? 2 : 1;
        for (int r = 0; r < reps; ++r) hipLaunchKernelGGL(mk_fwd, dim3(grid), dim3(NWAVES * 64), LDS_BYTES, stream, a);
#ifdef MIX_EXTRA
        if (p == 4) { a.ph_hi = 100 + MIX_EXTRA; hipLaunchKernelGGL(mk_fwd, dim3(grid), dim3(NWAVES * 64), LDS_BYTES, stream, a); }
#endif
    }
#endif
}
```

```cpp
#include <hip/hip_runtime.h>
#include <cstdio>
#include <cstdint>
#define MK_ONE_LAUNCH 1
namespace pg8 {
#define PG8_LAS __attribute__((address_space(3)))
typedef unsigned short bf16_t;
typedef short bf16x8 __attribute__((ext_vector_type(8)));
typedef float f32x4 __attribute__((ext_vector_type(4)));
typedef unsigned u32x4 __attribute__((ext_vector_type(4)));
typedef int i32x4 __attribute__((ext_vector_type(4)));
constexpr int BM = 256, BK = 64, HALF = 128, HTB = HALF * BK * 2  , STAGE_BYTES = 8 * HTB, NXCD = 8, WGM = 8;

__host__ __device__ __forceinline__ int lds_byte(int r, int c) { const int st = (r >> 4) * 2 + (c >> 5), rr = r & 15, cc = c & 31, ob = rr * 64 + cc * 2; return st * 1024 + (ob ^ (((ob >> 9) & 1) << 5)); }
__host__ __device__ __forceinline__ void stage_rc(int b, int& R, int& C) { const int st = b / 1024, sb = b % 1024, swz = sb ^ (((sb >> 9) & 1) << 5); R = (st >> 1) * 16 + swz / 64; C = (st & 1) * 32 + (swz % 64) / 2; }
__host__ __device__ __forceinline__ int perm32(int rho) { const int n = rho >> 4, i = rho & 15; return 8 * (i >> 2) + 4 * n + (i & 3); }

struct Unit { int pm, pn; int ko = 0; };
struct Gemm { const bf16_t* A; const bf16_t* Bt; int M, N, K; int ldk = 0; };

struct StaticOrder {
    int nM, nN, nwg, G, c;
    __host__ __device__ void init(int M, int N, int G_, int c_) { nM = M / BM; nN = N / BM; nwg = nM * nN; G = G_; c = c_; }
    __host__ __device__ bool next(int i, Unit& u) const {
        const long L = (long)i * G + c; if (L >= nwg) return false;
        int wgid = (int)L; { const int q = nwg / NXCD, r = nwg % NXCD, xcd = wgid % NXCD, off = wgid / NXCD; wgid = (xcd < r ? xcd * (q + 1) : r * (q + 1) + (xcd - r) * q) + off; }
        const int nig = WGM * nN, gid = wgid / nig, fm = gid * WGM, gsz = (nM - fm) < WGM ? (nM - fm) : WGM;
        u.pm = fm + ((wgid % nig) % gsz); u.pn = (wgid % nig) / gsz; return true;
    }
    __device__ __forceinline__ void a_ready(const Unit&) const {}
    __device__ __forceinline__ void done(const Unit&) const {}
};

typedef float cvt_f32x2_t __attribute__((ext_vector_type(2))); typedef __bf16 cvt_bf16x2_t __attribute__((ext_vector_type(2)));
__device__ __forceinline__ unsigned cvt_pk_bf16(float lo, float hi) { const cvt_f32x2_t v = {lo, hi}; const cvt_bf16x2_t b = __builtin_convertvector(v, cvt_bf16x2_t); return __builtin_bit_cast(unsigned, b); }
typedef float f32x2 __attribute__((ext_vector_type(2)));
__device__ __forceinline__ float fsigm(float v) { return __builtin_amdgcn_rcpf(1.0f + __builtin_amdgcn_exp2f(-1.4426950408889634f * v)); }
__device__ __forceinline__ float fsilu(float v) { return v * fsigm(v); }
__device__ __forceinline__ void st8bf(bf16_t* p, f32x4 v0, f32x4 v1) { u32x4 w; w.x = cvt_pk_bf16(v0[0], v0[1]); w.y = cvt_pk_bf16(v0[2], v0[3]); w.z = cvt_pk_bf16(v1[0], v1[1]); w.w = cvt_pk_bf16(v1[2], v1[3]); __builtin_nontemporal_store(w, (u32x4*)p); }
__device__ __forceinline__ bf16_t f2bf1(float f) { unsigned u = __builtin_bit_cast(unsigned, f); return (bf16_t)((u + 0x7fffu + ((u >> 16) & 1u)) >> 16); }

struct EpiIn {
    static constexpr bool PERM = true, AFTER_DRAIN = false, HOOK = false;
    bf16_t *RQ, *RK, *RVT, *RG, *BQKV, *BZ, *CQ, *CK, *CVT, *GATES; float* BBA; int set; float sc8;
    __device__ __forceinline__ void operator()(const f32x4 (&acc_)[2][2][4][2], const Unit& u, int wr, int wc, int fr, int fq) const {
        f32x4 acc[2][2][4][2];
#pragma unroll
        for (int a_ = 0; a_ < 2; ++a_)
#pragma unroll
            for (int b_ = 0; b_ < 2; ++b_)
#pragma unroll
                for (int m_ = 0; m_ < 4; ++m_)
#pragma unroll
                    for (int n_ = 0; n_ < 2; ++n_) acc[a_][b_][m_][n_] = set ? acc_[a_][b_][m_][n_] * sc8 : acc_[a_][b_][m_][n_];
        const int lp = u.pn, pn = set == 0 ? (lp < 44 ? lp : 68) : lp + 44, b = u.pm >> 3;
        const int rowt = u.pm * BM + wr * 64 + fr;
        const int cin = wc * 32 + 8 * fq;
        if (pn < 8 || (pn >= 32 && pn < 40)) {
            auto heads = [&](bf16_t* base, int hb, float sc) __attribute__((always_inline)) {
#pragma unroll
                for (int ai = 0; ai < 2; ++ai)
#pragma unroll
                    for (int m = 0; m < 4; ++m) { const int s = (rowt + ai * HALF + m * 16) - b * 2048;
#pragma unroll
                        for (int bj = 0; bj < 2; ++bj) st8bf(base + ((size_t)((b * 8 + hb + bj) * 2048 + s)) * 128 + cin, acc[ai][bj][m][0] * sc, acc[ai][bj][m][1] * sc); } };
            if (pn < 4) heads(RQ, pn * 2, 1.f); else if (pn < 8) heads(RK, (pn - 4) * 2, 0.08838834764831845f);
            else if (pn < 36) heads(CQ, (pn - 32) * 2, 1.f); else heads(CK, (pn - 36) * 2, 1.f);
        } else if ((pn >= 40 && pn < 44) || (pn >= 8 && pn < 12)) {
            const bool isr = pn < 12; const int h = isr ? pn - 8 : pn - 40; bf16_t* CVT = isr ? RVT : this->CVT;
#pragma unroll
            for (int ai = 0; ai < 2; ++ai)
#pragma unroll
                for (int m = 0; m < 4; ++m) { const int s = (rowt + ai * HALF + m * 16) - b * 2048;
#pragma unroll
                    for (int bj = 0; bj < 2; ++bj)
#pragma unroll
                        for (int n = 0; n < 2; ++n)
#pragma unroll
                            for (int e = 0; e < 4; ++e) CVT[((size_t)((b * 4 + h) * 256 + bj * HALF + cin + 4 * n + e)) * 2048 + s] = f2bf1(acc[ai][bj][m][n][e]); }
        } else if (pn == 68) {
            if (wc == 0 && fq < 2) {
#pragma unroll
                for (int ai = 0; ai < 2; ++ai)
#pragma unroll
                    for (int m = 0; m < 4; ++m) { float* p = BBA + (size_t)(rowt + ai * HALF + m * 16) * 16 + 8 * fq; *(f32x4*)p = acc[ai][0][m][0]; *(f32x4*)(p + 4) = acc[ai][0][m][1]; }
            }
        } else {
            auto rows = [&](bf16_t* base, int ldc, int c0, int act) __attribute__((always_inline)) {
#pragma unroll
                for (int ai = 0; ai < 2; ++ai)
#pragma unroll
                    for (int m = 0; m < 4; ++m) { bf16_t* rowp = base + (size_t)(rowt + ai * HALF + m * 16) * ldc + c0 + cin;
#pragma unroll
                        for (int bj = 0; bj < 2; ++bj) { f32x4 v0 = acc[ai][bj][m][0], v1 = acc[ai][bj][m][1];
                            if (act == 1) {
#pragma unroll
                                for (int e = 0; e < 4; ++e) { v0[e] = fsilu(v0[e]); v1[e] = fsilu(v1[e]); } }
                            else if (act == 2) {
#pragma unroll
                                for (int e = 0; e < 4; ++e) { v0[e] = fsigm(v0[e]); v1[e] = fsigm(v1[e]); } }
                            st8bf(rowp + bj * HALF, v0, v1); } } };
            if (pn < 16) rows(RG, 1024, (pn - 12) * 256, 1); else if (pn < 28) rows(BQKV, 3072, (pn - 16) * 256, 0);
            else if (pn < 32) rows(BZ, 1024, (pn - 28) * 256, 1); else rows(GATES, 6144, (pn - 44) * 256, 2);
        }
    }
};

struct EpiHeads {
    static constexpr bool PERM = true, AFTER_DRAIN = false, HOOK = false;
    bf16_t* O; bf16_t* VT; int NH, rpb_shift  , vt_from_pn;
    __device__ __forceinline__ void operator()(const f32x4 (&acc)[2][2][4][2], const Unit& u, int wr, int wc, int fr, int fq) const {
        const int rowt = u.pm * BM + wr * 64 + fr, cin = wc * 32 + 8 * fq, rpb = 1 << rpb_shift;
        if (u.pn < vt_from_pn) {
#pragma unroll
            for (int ai = 0; ai < 2; ++ai)
#pragma unroll
                for (int m = 0; m < 4; ++m) { const int row = rowt + ai * HALF + m * 16, b = row >> rpb_shift, s = row & (rpb - 1);
#pragma unroll
                    for (int bj = 0; bj < 2; ++bj) st8bf(O + ((size_t)((b * NH + u.pn * 2 + bj) * rpb + s)) * 128 + cin, acc[ai][bj][m][0], acc[ai][bj][m][1]); }
        } else {
            const int hb = (u.pn - vt_from_pn) * 2;
#pragma unroll
            for (int ai = 0; ai < 2; ++ai)
#pragma unroll
                for (int m = 0; m < 4; ++m) { const int row = rowt + ai * HALF + m * 16, b = row >> rpb_shift, s = row & (rpb - 1);
#pragma unroll
                    for (int bj = 0; bj < 2; ++bj)
#pragma unroll
                        for (int n = 0; n < 2; ++n)
#pragma unroll
                            for (int e = 0; e < 4; ++e) VT[((size_t)((b * NH + hb + bj) * 128 + cin + 4 * n + e)) * rpb + s] = f2bf1(acc[ai][bj][m][n][e]); }
        }
    }
};

struct EpiResid {
    static constexpr bool PERM = false, AFTER_DRAIN = false, HOOK = false;
    const float* in; float* out; int ldc; float sc;
    __device__ __forceinline__ void operator()(const f32x4 (&acc)[2][2][4][2], const Unit& u, int wr, int wc, int fr, int fq) const {
        const int row0 = u.pm * BM + wr * 64 + fr, col0 = u.pn * BM + wc * 32 + 4 * fq;
        f32x4 x[2][2][2];
#pragma unroll
        for (int bj = 0; bj < 2; ++bj)
#pragma unroll
            for (int n = 0; n < 2; ++n) x[0][bj][n] = *(const f32x4*)(in + (size_t)row0 * ldc + col0 + bj * HALF + n * 16);
#pragma unroll
        for (int gidx = 0; gidx < 8; ++gidx) { const int ai = gidx >> 2, m = gidx & 3; const size_t off = (size_t)(row0 + ai * HALF + m * 16) * ldc + col0;
            if (gidx + 1 < 8) { const int ai2 = (gidx + 1) >> 2, m2 = (gidx + 1) & 3; const size_t off2 = (size_t)(row0 + ai2 * HALF + m2 * 16) * ldc + col0;
#pragma unroll
                for (int bj = 0; bj < 2; ++bj)
#pragma unroll
                    for (int n = 0; n < 2; ++n) x[(gidx + 1) & 1][bj][n] = *(const f32x4*)(in + off2 + bj * HALF + n * 16); }
#pragma unroll
            for (int bj = 0; bj < 2; ++bj)
#pragma unroll
                for (int n = 0; n < 2; ++n) *(f32x4*)(out + off + bj * HALF + n * 16) = x[gidx & 1][bj][n] + acc[ai][bj][m][n] * sc; }
    }
};

struct EpiBranch {
    static constexpr bool PERM = false, AFTER_DRAIN = false, HOOK = true;
    bf16_t* OUT; const bf16_t* GATES; int hk0, hk1;
    typedef unsigned u32x2 __attribute__((ext_vector_type(2)));
    static __device__ __forceinline__ f32x4 g4(const bf16_t* p) { const u32x2 gw = *(const u32x2*)p; f32x4 g; g[0] = __uint_as_float(gw.x << 16); g[1] = __uint_as_float(gw.x & 0xffff0000u); g[2] = __uint_as_float(gw.y << 16); g[3] = __uint_as_float(gw.y & 0xffff0000u); return g; }
    __device__ __forceinline__ void hook(f32x4 (&acc)[2][2][4][2], const Unit& u, int s, int wr, int wc, int fr, int fq) const {
        int z_ = 0; asm volatile("" : "+v"(z_));
        const int row0 = u.pm * BM + wr * 64 + fr + z_, col0 = u.pn * BM + wc * 32 + 4 * fq;
#pragma unroll
        for (int ai = 0; ai < 2; ++ai)
#pragma unroll
            for (int mp = 0; mp < 2; ++mp) {
                u32x2 ga[2][2][2], gb[2][2][2];
#pragma unroll
                for (int mm = 0; mm < 2; ++mm) { const bf16_t* gp = GATES + (size_t)(row0 + ai * HALF + (2 * mp + mm) * 16) * 6144 + s * 2048 + col0;
#pragma unroll
                    for (int bj = 0; bj < 2; ++bj)
#pragma unroll
                        for (int n = 0; n < 2; ++n) { ga[mm][bj][n] = *(const u32x2*)(gp + bj * HALF + n * 16); gb[mm][bj][n] = *(const u32x2*)(gp + 2048 + bj * HALF + n * 16); } }
#pragma unroll
                for (int mm = 0; mm < 2; ++mm)
#pragma unroll
                    for (int bj = 0; bj < 2; ++bj)
#pragma unroll
                        for (int n = 0; n < 2; ++n) { const u32x2 a = ga[mm][bj][n], b = gb[mm][bj][n]; f32x4& v = acc[ai][bj][2 * mp + mm][n];
                            v[0] *= __uint_as_float(a.x << 16) * __builtin_amdgcn_rcpf(__builtin_fmaxf(__uint_as_float(b.x << 16), 1e-30f));
                            v[1] *= __uint_as_float(a.x & 0xffff0000u) * __builtin_amdgcn_rcpf(__builtin_fmaxf(__uint_as_float(b.x & 0xffff0000u), 1e-30f));
                            v[2] *= __uint_as_float(a.y << 16) * __builtin_amdgcn_rcpf(__builtin_fmaxf(__uint_as_float(b.y << 16), 1e-30f));
                            v[3] *= __uint_as_float(a.y & 0xffff0000u) * __builtin_amdgcn_rcpf(__builtin_fmaxf(__uint_as_float(b.y & 0xffff0000u), 1e-30f)); }
            }
    }
    __device__ __forceinline__ void operator()(const f32x4 (&acc)[2][2][4][2], const Unit& u, int wr, int wc, int fr, int fq) const {
        const int row0 = u.pm * BM + wr * 64 + fr, col0 = u.pn * BM + wc * 32 + 4 * fq;
        f32x4 gt[2][2][2];
#pragma unroll
        for (int bj = 0; bj < 2; ++bj)
#pragma unroll
            for (int n = 0; n < 2; ++n) gt[0][bj][n] = g4(GATES + (size_t)row0 * 6144 + 4096 + col0 + bj * HALF + n * 16);
#pragma unroll
        for (int gidx = 0; gidx < 8; ++gidx) { const int ai = gidx >> 2, m = gidx & 3, row = row0 + ai * HALF + m * 16;
            if (gidx + 1 < 8) { const int row2 = row0 + ((gidx + 1) >> 2) * HALF + ((gidx + 1) & 3) * 16;
#pragma unroll
                for (int bj = 0; bj < 2; ++bj)
#pragma unroll
                    for (int n = 0; n < 2; ++n) gt[(gidx + 1) & 1][bj][n] = g4(GATES + (size_t)row2 * 6144 + 4096 + col0 + bj * HALF + n * 16); }
#pragma unroll
            for (int bj = 0; bj < 2; ++bj)
#pragma unroll
                for (int n = 0; n < 2; ++n) { const f32x4 v = gt[gidx & 1][bj][n] * acc[ai][bj][m][n];
                    u32x2 w; w.x = cvt_pk_bf16(v[0], v[1]); w.y = cvt_pk_bf16(v[2], v[3]); *(u32x2*)(OUT + (size_t)row * 2048 + col0 + bj * HALF + n * 16) = w; } }
    }
};

struct EpiSwiglu {
    static constexpr bool PERM = true, AFTER_DRAIN = false, HOOK = false;
    bf16_t* O; int ldc, npn; float sc;
    __device__ __forceinline__ void operator()(const f32x4 (&acc)[2][2][4][2], const Unit& u, int wr, int wc, int fr, int fq) const {
        const int row0 = u.pm * BM + wr * 64 + fr, col0 = (u.pn % npn) * HALF + wc * 32 + 8 * fq;
#pragma unroll
        for (int ai = 0; ai < 2; ++ai)
#pragma unroll
            for (int m = 0; m < 4; ++m) { f32x4 v0, v1;
#pragma unroll
                for (int e = 0; e < 4; ++e) { v0[e] = fsilu(acc[ai][0][m][0][e] * sc) * (acc[ai][1][m][0][e] * sc); v1[e] = fsilu(acc[ai][0][m][1][e] * sc) * (acc[ai][1][m][1][e] * sc); }
                st8bf(O + (size_t)(row0 + ai * HALF + m * 16) * ldc + col0, v0, v1); }
    }
};


__device__ __forceinline__ float clamp8(float v) { return __builtin_fminf(__builtin_fmaxf(v, -448.f), 448.f); }
__device__ __forceinline__ unsigned pk4_fp8(float a, float b, float c, float d) { int r = 0; r = __builtin_amdgcn_cvt_pk_fp8_f32(clamp8(a), clamp8(b), r, false); r = __builtin_amdgcn_cvt_pk_fp8_f32(clamp8(c), clamp8(d), r, true); return (unsigned)r; }
struct EpiSwiglu8 {
    static constexpr bool PERM = true, AFTER_DRAIN = false, HOOK = false;
    unsigned char* O; int ldc, npn; float ws, as;
    __device__ __forceinline__ void operator()(const f32x4 (&acc)[2][2][4][2], const Unit& u, int wr, int wc, int fr, int fq) const {
        typedef unsigned u32x2 __attribute__((ext_vector_type(2)));
        const int row0 = u.pm * BM + wr * 64 + fr, col0 = (u.pn % npn) * HALF + wc * 32 + 8 * fq;
#pragma unroll
        for (int ai = 0; ai < 2; ++ai)
#pragma unroll
            for (int m = 0; m < 4; ++m) { float v[8];
#pragma unroll
                for (int n = 0; n < 2; ++n)
#pragma unroll
                    for (int e = 0; e < 4; ++e) v[4 * n + e] = fsilu(acc[ai][0][m][n][e] * ws) * (acc[ai][1][m][n][e] * ws) * as;
                u32x2 o; o.x = pk4_fp8(v[0], v[1], v[2], v[3]); o.y = pk4_fp8(v[4], v[5], v[6], v[7]);
                __builtin_nontemporal_store(o, (u32x2*)(O + (size_t)(row0 + ai * HALF + m * 16) * ldc + col0)); }
    }
};

struct EpiStoreF32 {
    static constexpr bool PERM = false, AFTER_DRAIN = false, HOOK = false;
    float* Y; int ldc, npn; float sc;
    __device__ __forceinline__ void operator()(const f32x4 (&acc)[2][2][4][2], const Unit& u, int wr, int wc, int fr, int fq) const {
        const int row0 = u.pm * BM + wr * 64 + fr, col0 = (u.pn % npn) * BM + wc * 32 + 4 * fq;
#pragma unroll
        for (int ai = 0; ai < 2; ++ai)
#pragma unroll
            for (int m = 0; m < 4; ++m) { float* rowp = Y + (size_t)(row0 + ai * HALF + m * 16) * ldc + col0;
#pragma unroll
                for (int bj = 0; bj < 2; ++bj)
#pragma unroll
                    for (int n = 0; n < 2; ++n) *(f32x4*)(rowp + bj * HALF + n * 16) = acc[ai][bj][m][n] * sc; }
    }
};

__device__ __forceinline__ void moe_map(const PG8_LAS int* T, int npn, int L, int& pm, int& pn) {
    auto rd = [&](int k) __attribute__((always_inline)) { return __builtin_amdgcn_readfirstlane(T[k]); };
    const int total = rd(25);
    int wgid = L; { const int q = total / NXCD, r = total % NXCD, xcd = wgid % NXCD, off = wgid / NXCD; wgid = (xcd < r ? xcd * (q + 1) : r * (q + 1) + (xcd - r) * q) + off; }
    int e = 0, cue = 0;
#pragma unroll
    for (int k = 1; k < 8; ++k) { const int ck = rd(16 + k); if (wgid >= ck) { e = k; cue = ck; } }
    const int loc = wgid - cue, ne = rd(e), r0 = rd(8 + e);
    pm = r0 + loc % ne; pn = e * npn + loc / ne;
}
struct MoeOrder {
    const PG8_LAS int* T; int npn, G, c; int cap = 1 << 30;
    __device__ __forceinline__ bool next(int i, Unit& u) const {
        const int total = __builtin_amdgcn_readfirstlane(T[25]); const long L = (long)i * G + c; if (L >= total || L >= cap) return false;
        moe_map(T, npn, (int)L, u.pm, u.pn); return true;
    }
    __device__ __forceinline__ void a_ready(const Unit&) const {}
    __device__ __forceinline__ void done(const Unit&) const {}
};
struct MoeTailOrder {
    const PG8_LAS int* T; int npn, c, base, kq;
    __device__ __forceinline__ bool next(int i, Unit& u) const {
        const int total = __builtin_amdgcn_readfirstlane(T[25]), t = c >> 2; if (i > 0 || base + t >= total) return false;
        moe_map(T, npn, base + t, u.pm, u.pn); u.ko = (c & 3) * kq; return true;
    }
    __device__ __forceinline__ void a_ready(const Unit&) const {}
    __device__ __forceinline__ void done(const Unit&) const {}
};
struct EpiAtomicF32 {
    static constexpr bool PERM = false, AFTER_DRAIN = false, HOOK = false;
    float* Y; int ldc, npn; float sc;
    __device__ __forceinline__ void operator()(const f32x4 (&acc)[2][2][4][2], const Unit& u, int wr, int wc, int fr, int fq) const {
        const int row0 = u.pm * BM + wr * 64 + fr, col0 = (u.pn % npn) * BM + wc * 32 + 4 * fq;
#pragma unroll
        for (int ai = 0; ai < 2; ++ai)
#pragma unroll
            for (int m = 0; m < 4; ++m) { float* rowp = Y + (size_t)(row0 + ai * HALF + m * 16) * ldc + col0;
#pragma unroll
                for (int bj = 0; bj < 2; ++bj)
#pragma unroll
                    for (int n = 0; n < 2; ++n)
#pragma unroll
                        for (int e = 0; e < 4; ++e) unsafeAtomicAdd(rowp + bj * HALF + n * 16 + e, acc[ai][bj][m][n][e] * sc); }
    }
};

struct SegOrder {
    int nM, nN, nseg, G, c;
    __device__ __forceinline__ bool next(int i, Unit& u) const {
        const int nwg = nM * nN; const long L = (long)i * G + c; if (L >= (long)nseg * nwg) return false;
        const int s = (int)(L / nwg); int wgid = (int)(L % nwg); { const int q = nwg / NXCD, r = nwg % NXCD, xcd = wgid % NXCD, off = wgid / NXCD; wgid = (xcd < r ? xcd * (q + 1) : r * (q + 1) + (xcd - r) * q) + off; }
        const int nig = WGM * nN, gid = wgid / nig, fm = gid * WGM, gsz = (nM - fm) < WGM ? (nM - fm) : WGM;
        u.pm = s * nM + fm + ((wgid % nig) % gsz); u.pn = s * nN + (wgid % nig) / gsz; return true;
    }
    __device__ __forceinline__ void a_ready(const Unit&) const {}
    __device__ __forceinline__ void done(const Unit&) const {}
};

struct SplitK4Order {
    int G, c;
    __device__ __forceinline__ bool next(int i, Unit& u) const {
        const long L = (long)i * G + c; if (L >= 256) return false;
        const int x = (int)L & 7, y = (int)L >> 3;
        u.pm = 4 * x + (y & 3); u.pn = (y >> 2) & 1; u.ko = (y >> 3) * 1024; return true;
    }
    __device__ __forceinline__ void a_ready(const Unit&) const {}
    __device__ __forceinline__ void done(const Unit&) const {}
};
struct EpiPart {
    static constexpr bool PERM = false, AFTER_DRAIN = false, HOOK = false;
    float* P; int ldc; size_t pstride;
    __device__ __forceinline__ void operator()(const f32x4 (&acc)[2][2][4][2], const Unit& u, int wr, int wc, int fr, int fq) const {
        const int row0 = u.pm * BM + wr * 64 + fr, col0 = u.pn * BM + wc * 32 + 4 * fq; float* base = P + (size_t)(u.ko >> 10) * pstride;
#pragma unroll
        for (int ai = 0; ai < 2; ++ai)
#pragma unroll
            for (int m = 0; m < 4; ++m) { float* rowp = base + (size_t)(row0 + ai * HALF + m * 16) * ldc + col0;
#pragma unroll
                for (int bj = 0; bj < 2; ++bj)
#pragma unroll
                    for (int n = 0; n < 2; ++n) *(f32x4*)(rowp + bj * HALF + n * 16) = acc[ai][bj][m][n]; }
    }
};
template <class Epi, class Sched, bool ALIGN_EPI = false, bool SP2 = false, bool F8 = false>
__device__ __forceinline__ void gemm_phase(PG8_LAS unsigned char* lds, const Gemm g, const Sched& S, const Epi& E) {
    int tid_ = threadIdx.x; asm volatile("" : "+v"(tid_)); const int tid = tid_, wid = __builtin_amdgcn_readfirstlane(tid >> 6), lane = tid & 63, wr = wid >> 2, wc = wid & 3, fr = lane & 15, fq = lane >> 4;
    const int K = g.K, LDK = g.ldk ? g.ldk : g.K, nt = K / BK; typedef int i32x8 __attribute__((ext_vector_type(8))); int f8scale_ = 0x7f7f7f7f; asm volatile("" : "+v"(f8scale_));
    unsigned voffA[2], voffB[2];
#pragma unroll
    for (int i = 0; i < 2; ++i) { int R, C; stage_rc(tid * 16 + i * 8192, R, C); const int Rb = Epi::PERM ? ((R & ~31) + perm32(R & 31)) : R;
        voffA[i] = (unsigned)(R * LDK + C) * 2u; voffB[i] = (unsigned)(Rb * LDK + C) * 2u; }
    const size_t kstep = (size_t)(BK * 2);
    const size_t hstep = (size_t)HALF * LDK * 2;
    const size_t tstep = 2 * hstep;
    const unsigned ldsw = (unsigned)wid * 1024u;
    const int aoff = lds_byte(wr * 64 + fr, fq * 8), boff = lds_byte(wc * 32 + fr, fq * 8);
#define PG8_SA(b, h) (((b) * 2 + (h)) * HTB)
#define PG8_SB(b, h) ((4 + (b) * 2 + (h)) * HTB)
#define PG8_STAGE(bufoff, gbase, voff) do { _Pragma("unroll") for (int _i = 0; _i < 2; ++_i) \
        __builtin_amdgcn_global_load_lds((const unsigned*)((const char*)(gbase) + (voff)[_i]), (PG8_LAS unsigned*)(lds + (bufoff) + ldsw + _i * 8192), 16, 0, 0); } while (0)
#define PG8_LDA(dst, b, h) do { _Pragma("unroll") for (int m = 0; m < 4; ++m) _Pragma("unroll") for (int k = 0; k < 2; ++k) dst[m][k] = *(const PG8_LAS bf16x8*)(lds + PG8_SA(b, h) + aoff + m * 2048 + k * 1024); } while (0)
#define PG8_LDB(dst, b, h) do { _Pragma("unroll") for (int n = 0; n < 2; ++n) _Pragma("unroll") for (int k = 0; k < 2; ++k) dst[n][k] = *(const PG8_LAS bf16x8*)(lds + PG8_SB(b, h) + boff + n * 2048 + k * 1024); } while (0)
#define PG8_MMA(ai, bj, At, Bt) do { __builtin_amdgcn_s_setprio(1); \
        if constexpr (F8) { _Pragma("unroll") for (int m = 0; m < 4; ++m) _Pragma("unroll") for (int n = 0; n < 2; ++n) { \
            const i32x4 b0_ = __builtin_bit_cast(i32x4, Bt[n][0]), b1_ = __builtin_bit_cast(i32x4, Bt[n][1]), a0_ = __builtin_bit_cast(i32x4, At[m][0]), a1_ = __builtin_bit_cast(i32x4, At[m][1]); \
            const i32x8 bb_ = __builtin_shufflevector(b0_, b1_, 0, 1, 2, 3, 4, 5, 6, 7), aa_ = __builtin_shufflevector(a0_, a1_, 0, 1, 2, 3, 4, 5, 6, 7); \
            asm volatile("v_mfma_scale_f32_16x16x128_f8f6f4 %0, %1, %2, %0, %3, %3 op_sel_hi:[0,0,0]" : "+v"(acc[ai][bj][m][n]) : "v"(bb_), "v"(aa_), "v"(f8scale_)); } } \
        else { _Pragma("unroll") for (int m = 0; m < 4; ++m) _Pragma("unroll") for (int n = 0; n < 2; ++n) _Pragma("unroll") for (int k = 0; k < 2; ++k) \
        acc[ai][bj][m][n] = __builtin_amdgcn_mfma_f32_16x16x32_bf16(Bt[n][k], At[m][k], acc[ai][bj][m][n], 0, 0, 0); } __builtin_amdgcn_s_setprio(0); } while (0)
#define PG8_WAIT_V(n) asm volatile("s_waitcnt vmcnt(" #n ")" ::: "memory")
#define PG8_WAIT_L(n) asm volatile("s_waitcnt lgkmcnt(" #n ")" ::: "memory")
#define PG8_BAR __builtin_amdgcn_s_barrier()
#define PG8_SCHED __builtin_amdgcn_sched_barrier(0)
    Unit cur, nxt; int ui = 0;
    if (!S.next(0, cur)) return;
    f32x4 acc[2][2][4][2];
#pragma unroll
    for (int a = 0; a < 2; ++a)
#pragma unroll
        for (int b = 0; b < 2; ++b)
#pragma unroll
            for (int m = 0; m < 4; ++m)
#pragma unroll
                for (int n = 0; n < 2; ++n) acc[a][b][m][n] = (f32x4){0.f, 0.f, 0.f, 0.f};
    bf16x8 At[4][2], B0[2][2], B1[2][2];
    const char* cA = (const char*)g.A + (size_t)cur.pm * tstep + cur.ko; const char* cB = (const char*)g.Bt + (size_t)cur.pn * tstep + cur.ko;
    S.a_ready(cur);
    if constexpr (SP2) {
        PG8_STAGE(PG8_SB(0, 0), cB, voffB); PG8_STAGE(PG8_SB(0, 1), cB + hstep, voffB); PG8_STAGE(PG8_SA(0, 0), cA, voffA); PG8_STAGE(PG8_SA(0, 1), cA + hstep, voffA);
        if (wr == 1) PG8_BAR;
        PG8_WAIT_V(2); PG8_BAR;
        PG8_STAGE(PG8_SB(1, 0), cB + kstep, voffB); PG8_STAGE(PG8_SA(1, 0), cA + kstep, voffA); PG8_STAGE(PG8_SB(1, 1), cB + hstep + kstep, voffB);
        PG8_WAIT_V(6); PG8_BAR;
    } else {
        PG8_STAGE(PG8_SB(0, 0), cB, voffB); PG8_STAGE(PG8_SA(0, 0), cA, voffA); PG8_STAGE(PG8_SB(0, 1), cB + hstep, voffB); PG8_STAGE(PG8_SA(0, 1), cA + hstep, voffA);
        if (wr == 1) PG8_BAR;
        PG8_WAIT_V(4); PG8_BAR;
        PG8_STAGE(PG8_SB(1, 0), cB + kstep, voffB); PG8_STAGE(PG8_SA(1, 0), cA + kstep, voffA); PG8_STAGE(PG8_SB(1, 1), cB + hstep + kstep, voffB);
        PG8_WAIT_V(6); PG8_BAR;
    }
    for (;;) {
        const bool has_next = S.next(ui + 1, nxt);
        const char* nA = has_next ? (const char*)g.A + (size_t)nxt.pm * tstep + nxt.ko : cA; const char* nB = has_next ? (const char*)g.Bt + (size_t)nxt.pn * tstep + nxt.ko : cB;
        for (int t = 0; t < nt; t += 2) {
            const bool last = (t == nt - 2);
            const char* a1 = cA + (size_t)(t + 1) * kstep;
            const char* a2 = last ? nA : cA + (size_t)(t + 2) * kstep; const char* b2 = last ? nB : cB + (size_t)(t + 2) * kstep;
            const char* a3 = a2 + kstep; const char* b3 = b2 + kstep;
            if (last && has_next) S.a_ready(nxt);
            if constexpr (Epi::HOOK) { if (t == E.hk0 || t == E.hk1) E.hook(acc, cur, t == E.hk0 ? 0 : 1, wr, wc, fr, fq); }
            if constexpr (SP2) {
            PG8_LDB(B0, 0, 0); PG8_LDB(B1, 0, 1); PG8_SCHED; PG8_LDA(At, 0, 0); PG8_STAGE(PG8_SA(1, 1), a1 + hstep, voffA);
            PG8_WAIT_V(8); PG8_WAIT_L(0); PG8_BAR; PG8_MMA(0, 0, At, B0); PG8_MMA(0, 1, At, B1); PG8_BAR; PG8_SCHED;
            PG8_LDA(At, 0, 1); PG8_STAGE(PG8_SB(0, 0), b2, voffB); PG8_STAGE(PG8_SB(0, 1), b2 + hstep, voffB); PG8_STAGE(PG8_SA(0, 0), a2, voffA);
            PG8_WAIT_V(8); PG8_WAIT_L(0); PG8_BAR; PG8_MMA(1, 0, At, B0); PG8_MMA(1, 1, At, B1); PG8_BAR; PG8_SCHED;
            PG8_LDB(B0, 1, 0); PG8_LDB(B1, 1, 1); PG8_SCHED; PG8_LDA(At, 1, 0); PG8_STAGE(PG8_SA(0, 1), a2 + hstep, voffA);
            PG8_WAIT_V(8); PG8_WAIT_L(0); PG8_BAR; PG8_MMA(0, 0, At, B0); PG8_MMA(0, 1, At, B1); PG8_BAR; PG8_SCHED;
            PG8_LDA(At, 1, 1); PG8_STAGE(PG8_SB(1, 0), b3, voffB); PG8_STAGE(PG8_SB(1, 1), b3 + hstep, voffB); PG8_STAGE(PG8_SA(1, 0), a3, voffA);
            PG8_WAIT_V(8); PG8_WAIT_L(0); PG8_BAR; PG8_MMA(1, 0, At, B0); PG8_MMA(1, 1, At, B1); PG8_BAR; PG8_SCHED;
            } else {
            PG8_LDB(B0, 0, 0); PG8_SCHED; PG8_LDA(At, 0, 0); PG8_STAGE(PG8_SA(1, 1), a1 + hstep, voffA);
            PG8_WAIT_L(8); PG8_BAR; PG8_WAIT_L(0); PG8_MMA(0, 0, At, B0); PG8_BAR; PG8_SCHED;
            PG8_LDB(B1, 0, 1); PG8_STAGE(PG8_SB(0, 0), b2, voffB);
            PG8_BAR; PG8_WAIT_L(0); PG8_MMA(0, 1, At, B1); PG8_BAR;
            PG8_LDA(At, 0, 1); PG8_STAGE(PG8_SA(0, 0), a2, voffA);
            PG8_BAR; PG8_WAIT_L(0); PG8_MMA(1, 0, At, B0); PG8_BAR; PG8_SCHED;
            PG8_STAGE(PG8_SB(0, 1), b2 + hstep, voffB);
            PG8_WAIT_V(6); PG8_BAR; PG8_MMA(1, 1, At, B1); PG8_BAR;
            PG8_LDB(B0, 1, 0); PG8_SCHED; PG8_LDA(At, 1, 0); PG8_STAGE(PG8_SA(0, 1), a2 + hstep, voffA);
            PG8_WAIT_L(8); PG8_BAR; PG8_WAIT_L(0); PG8_MMA(0, 0, At, B0); PG8_BAR; PG8_SCHED;
            PG8_LDB(B1, 1, 1); PG8_STAGE(PG8_SB(1, 0), b3, voffB);
            PG8_BAR; PG8_WAIT_L(0); PG8_MMA(0, 1, At, B1); PG8_BAR;
            PG8_LDA(At, 1, 1); PG8_STAGE(PG8_SA(1, 0), a3, voffA);
            PG8_BAR; PG8_WAIT_L(0); PG8_MMA(1, 0, At, B0); PG8_BAR; PG8_SCHED;
            PG8_STAGE(PG8_SB(1, 1), b3 + hstep, voffB);
            PG8_WAIT_V(6); PG8_BAR; PG8_MMA(1, 1, At, B1); PG8_BAR;
            }
        }
        if constexpr (ALIGN_EPI) { if (wr == 0) PG8_BAR; }
        if constexpr (F8) { __builtin_amdgcn_sched_barrier(0); asm volatile("s_nop 15\n\ts_nop 15" ::: "memory"); __builtin_amdgcn_sched_barrier(0); }
        if constexpr (!Epi::AFTER_DRAIN) { E(acc, cur, wr, wc, fr, fq); S.done(cur); }
        if (!has_next) break;
#pragma unroll
        for (int a = 0; a < 2; ++a)
#pragma unroll
            for (int b = 0; b < 2; ++b)
#pragma unroll
                for (int m = 0; m < 4; ++m)
#pragma unroll
                    for (int n = 0; n < 2; ++n) acc[a][b][m][n] = (f32x4){0.f, 0.f, 0.f, 0.f};
        cur = nxt; cA = nA; cB = nB; ++ui;
        if constexpr (ALIGN_EPI) { if (wr == 1) PG8_BAR; }
    }
    PG8_WAIT_V(0);
    if constexpr (!ALIGN_EPI) { if (wr == 0) PG8_BAR; }
    PG8_BAR;
    if constexpr (Epi::AFTER_DRAIN) { E.fused(acc, cur, wr, wc, fr, fq, lds, wid, lane); S.done(cur); }
#undef PG8_SA
#undef PG8_SB
#undef PG8_STAGE
#undef PG8_LDA
#undef PG8_LDB
#undef PG8_MMA
#undef PG8_WAIT_V
#undef PG8_WAIT_L
#undef PG8_BAR
#undef PG8_SCHED
}
}
#ifndef MK_ONE_LAUNCH
#define MK_ONE_LAUNCH 0
#endif
constexpr int NWAVES = 8;
constexpr int NB = 4, SEQ = 2048, T = NB * SEQ, D = 2048, MEML = 256, MEMR = NB * MEML;
constexpr int NINP = 17664;
constexpr int DFF = 5632, EFF = 7168, NEXP = 8, MAXSLOT = 18432;
constexpr float EPS = 1e-6f;
constexpr int NPL = 15, NPH = 2 + 2 * NPL;

constexpr size_t MiB = 1u << 20;
constexpr size_t WS_CTL = 0, CTL_BYTES = 1 * MiB;
constexpr size_t WS_WIN = WS_CTL + CTL_BYTES;
constexpr size_t WS_WBR = WS_WIN + 2 * 69 * MiB;
constexpr size_t WS_WOUT = WS_WBR + 2 * 12 * MiB;
constexpr size_t WS_WQ = WS_WOUT + 2 * 8 * MiB;
constexpr size_t WS_WKV = WS_WQ + 2 * 2 * MiB;
constexpr size_t WS_WO = WS_WKV + 2 * 4 * MiB;
constexpr size_t WS_WGU = WS_WO + 2 * 2 * MiB;
constexpr size_t WS_WDN = WS_WGU + 44 * MiB;
constexpr size_t WS_WEGU = WS_WDN + 22 * MiB;
constexpr size_t WS_WEDN = WS_WEGU + 448 * MiB;
constexpr size_t WS_XRES = WS_WEDN + 224 * MiB;
constexpr size_t WS_H = WS_XRES + 64 * MiB;
constexpr size_t WS_RQ = WS_H + 32 * MiB, WS_RK = WS_RQ + 16 * MiB, WS_RV = WS_RK + 16 * MiB, WS_RG = WS_RV + 16 * MiB;
constexpr size_t WS_BQKV = WS_RG + 16 * MiB;
constexpr size_t WS_BZ = WS_BQKV + 48 * MiB;
constexpr size_t WS_BBA = WS_BZ + 16 * MiB;
constexpr size_t WS_CQ = WS_BBA + 1 * MiB, WS_CK = WS_CQ + 16 * MiB, WS_CVT = WS_CK + 16 * MiB;
constexpr size_t WS_GATES = WS_CVT + 16 * MiB;
constexpr size_t WS_GQ = WS_GATES + 96 * MiB, WS_GK = WS_GQ + 16 * MiB, WS_GV = WS_GK + 16 * MiB;
constexpr size_t WS_GG = WS_GV + 16 * MiB, WS_GB = WS_GG + 1 * MiB;
constexpr size_t WS_OA = WS_GB + 1 * MiB, WS_OB = WS_OA + 32 * MiB;
constexpr size_t WS_O12 = WS_OB + 32 * MiB;
constexpr size_t WS_OCAT = WS_O12 + 64 * MiB;
constexpr size_t WS_MERGE = WS_OCAT + 48 * MiB;
constexpr size_t WS_MERGEB = WS_MERGE + 64 * MiB;
constexpr size_t WS_MEMN = WS_MERGEB + 32 * MiB;
constexpr size_t WS_KX = WS_MEMN + 8 * MiB;
constexpr size_t WS_VXT = WS_KX + 2 * MiB;
constexpr size_t WS_QX = WS_VXT + 2 * MiB;
constexpr size_t WS_OX = WS_QX + 8 * MiB;
constexpr size_t WS_ACT = WS_OX + 8 * MiB;
constexpr size_t WS_HG = WS_ACT + 88 * MiB;
constexpr size_t WS_EACT = WS_HG + 72 * MiB;
constexpr size_t WS_Y = WS_EACT + 252 * MiB;
constexpr size_t WS_ROUTE = WS_Y + 144 * MiB;
constexpr size_t WS_GCH = WS_ROUTE + 1 * MiB;
constexpr size_t WS_GL = WS_GCH + 88 * MiB;
constexpr size_t WS_H8 = WS_GL + 1 * MiB;
constexpr size_t WS_WIN8 = WS_H8 + 16 * MiB;
constexpr size_t WS_END = WS_WIN8 + 32 * MiB;
constexpr int CW_CNT = 64;
constexpr int CW_BAR = 4096;

constexpr int RING_BYTES = 131072, MISC_OFF = RING_BYTES + 8192 + 320, LDS_BYTES = 147456;

#define GAS __attribute__((address_space(1)))
#define LAS __attribute__((address_space(3)))
#define DI __device__ __forceinline__
typedef unsigned short bf16;
typedef unsigned v4u __attribute__((ext_vector_type(4)));
typedef unsigned v2u __attribute__((ext_vector_type(2)));
typedef float f32x4 __attribute__((ext_vector_type(4)));
typedef short bf16x8 __attribute__((ext_vector_type(8)));
typedef short s16x4 __attribute__((ext_vector_type(4)));
DI float bf2f(unsigned v) { return __uint_as_float(v << 16); }
DI unsigned f2bf(float f) { unsigned u = __builtin_bit_cast(unsigned, f); return (u + 0x7fffu + ((u >> 16) & 1u)) >> 16; }
typedef float f32x2_t __attribute__((ext_vector_type(2))); typedef __bf16 bf16x2_t __attribute__((ext_vector_type(2)));
DI unsigned pk2(float lo, float hi) { const f32x2_t v = {lo, hi}; const bf16x2_t b = __builtin_convertvector(v, bf16x2_t); return __builtin_bit_cast(unsigned, b); }
DI float wave_sum(float v) {
#pragma unroll
    for (int o = 1; o < 64; o <<= 1) v += __shfl_xor(v, o);
    return v;
}

#define XB_TMO      128
#define XB_XCNT(j)  (256  + 64 * (j))
#define XB_XSUB(j)  (1280 + 64 * (j))
#define XB_XGEN(j)  (2304 + 64 * (j))
#define XB_TOP      3328
#define XB_TOPGEN   3392
#define XCD_BAR_WORDS 3456
#define XB_SPIN_CAP (1u << 18)

__device__ __forceinline__ unsigned xb_ld(unsigned* p)              { return __hip_atomic_load(p, __ATOMIC_RELAXED, __HIP_MEMORY_SCOPE_AGENT); }
__device__ __forceinline__ unsigned xb_add(unsigned* p, unsigned v) { return __hip_atomic_fetch_add(p, v, __ATOMIC_RELAXED, __HIP_MEMORY_SCOPE_AGENT); }
__device__ __forceinline__ unsigned xb_xcc_id() { return (unsigned)__builtin_amdgcn_s_getreg((3 << 11) | 20) & 0xFu; }
#define XB_SPIN(cond, bar) do { unsigned _sp = 0; while (cond) { __builtin_amdgcn_s_sleep(1); \
    if ((++_sp & 255u) == 0u) { if (xb_ld(&(bar)[XB_TMO])) break; if (_sp > XB_SPIN_CAP) { atomicAdd(&(bar)[XB_TMO], 1u); break; } } } } while (0)

struct XcdBarrier {
    unsigned* bar; unsigned x;
    volatile LAS unsigned* st;
};

__device__ __forceinline__ XcdBarrier xcd_barrier_post(unsigned* bar, volatile LAS unsigned* st) {
    XcdBarrier b; b.bar = bar; b.x = xb_xcc_id(); b.st = st;
    if (threadIdx.x == 0) (void)xb_add(&bar[XB_XCNT(b.x)], 1u);
    return b;
}
__device__ __forceinline__ void xcd_barrier_complete(unsigned* bar, unsigned x, unsigned& nloc, unsigned& nx) {
    const unsigned G = gridDim.x * gridDim.y * gridDim.z;
    unsigned sum, cnt, mine, sp = 0u;
    for (;;) {
        sum = 0u; cnt = 0u; mine = 0u;
#pragma unroll
        for (unsigned j = 0; j < 16; ++j) { const unsigned c = xb_ld(&bar[XB_XCNT(j)]); sum += c; cnt += (c > 0u) ? 1u : 0u; mine = (j == x) ? c : mine; }
        if (sum == G) break;
        __builtin_amdgcn_s_sleep(1);
        if ((++sp & 255u) == 0u) { if (xb_ld(&bar[XB_TMO])) break; if (sp > XB_SPIN_CAP) { atomicAdd(&bar[XB_TMO], 1u); break; } }
    }
    nloc = mine > 0u ? mine : 1u; nx = cnt > 0u ? cnt : 1u;
}

__device__ __forceinline__ void xcd_barrier(const XcdBarrier& b) {
    asm volatile("s_waitcnt vmcnt(0)" ::: "memory");
    __syncthreads();
    if (threadIdx.x == 0) {
        unsigned* bar = b.bar;
        __builtin_amdgcn_s_waitcnt(0);
        unsigned nloc = b.st[0], nx = b.st[1];
        if (nloc == 0u) { xcd_barrier_complete(bar, b.x, nloc, nx); b.st[0] = nloc; b.st[1] = nx; }
        const unsigned old = xb_add(&bar[XB_XSUB(b.x)], 1u);
        const unsigned gen = old / nloc;
        if (old + 1u == (gen + 1u) * nloc) {
            __builtin_amdgcn_fence(__ATOMIC_RELEASE, "agent");
            asm volatile("s_waitcnt vmcnt(0)" ::: "memory");
            const unsigned og = xb_add(&bar[XB_TOP], 1u);
            const unsigned tg = og / nx;
            if (og + 1u == (tg + 1u) * nx) xb_add(&bar[XB_TOPGEN], 1u);
            else XB_SPIN(xb_ld(&bar[XB_TOPGEN]) == tg, bar);
            __builtin_amdgcn_fence(__ATOMIC_ACQUIRE, "agent");
            xb_add(&bar[XB_XGEN(b.x)], 1u);
            asm volatile("s_waitcnt vmcnt(0)" ::: "memory");
        } else {
            XB_SPIN(xb_ld(&bar[XB_XGEN(b.x)]) == gen, bar);
            __builtin_amdgcn_fence(__ATOMIC_ACQUIRE, "agent");
            asm volatile("s_waitcnt vmcnt(0)" ::: "memory");
        }
    }
    __syncthreads();
}

struct Args { const void* in[24]; float* out; unsigned char* ws; int ph_lo, ph_hi; };

struct Frame {
    LAS unsigned char* lds;
    int tid, lane, wave, G, vcu, gw, NGW;
};

template <bool F8>
DI void conv_item(const Frame& F, const float* W, int K, int Nsrc, void* WTv, int mode, int Fgu, float scale, int it) {
    constexpr int KI = F8 ? 256 : 128;
    LAS unsigned* scr = (LAS unsigned*)F.lds;
    const int nkb = K / KI, lane = F.lane, w = F.wave, tid = F.tid;
    {
        const int nb = it / nkb, kb = it % nkb, k0 = kb * KI, n0 = nb * 256, n = n0 + 4 * lane;
        int ns;
        if (mode == 0) ns = n;
        else if (mode == 1 || mode == 3 || mode == 4) {
            int ng = n;
            if (mode == 3) { const int lp = n >> 8; ng = ((lp < 44 ? lp : 68) << 8) + (n & 255); }
            if (mode == 4) ng = n + 44 * 256;
            ns = ng < 8192 ? ng : (ng < 17408 ? ng + 16 : (ng < 17424 ? ng - 17408 + 8192 : -1)); }
        else { const int pn = n >> 8, half = (n >> 7) & 1, j = n & 127; ns = half * Fgu + 128 * pn + j; }
        __syncthreads();
#pragma unroll
        for (int h = 0; h < (F8 ? 2 : 1); ++h) {
            const float* src = W + (size_t)(k0 + (F8 ? 32 : 16) * w + 16 * h) * Nsrc + (ns < 0 ? 0 : ns);
            f32x4 a[16];
#pragma unroll
            for (int i = 0; i < 16; ++i) a[i] = __builtin_nontemporal_load((const f32x4*)(src + (size_t)i * Nsrc));
            if (ns < 0) {
#pragma unroll
                for (int i = 0; i < 16; ++i) a[i] = (f32x4){0.f, 0.f, 0.f, 0.f}; }
#pragma unroll
            for (int c = 0; c < 4; ++c) {
                if (F8) {
#pragma unroll
                    for (int q = 0; q < 4; ++q) scr[(4 * lane + c) * 65 + 8 * w + 4 * h + q] = pg8::pk4_fp8(a[4 * q][c] * scale, a[4 * q + 1][c] * scale, a[4 * q + 2][c] * scale, a[4 * q + 3][c] * scale);
                } else {
#pragma unroll
                    for (int p = 0; p < 8; ++p) scr[(4 * lane + c) * 65 + 8 * w + p] = pk2(a[2 * p][c], a[2 * p + 1][c]); } }
        }
        __syncthreads();
#pragma unroll
        for (int ps = 0; ps < 8; ++ps) { const int row = ps * 32 + (tid >> 4), kq = tid & 15; const LAS unsigned* s = scr + row * 65 + 4 * kq; v4u o; o.x = s[0]; o.y = s[1]; o.z = s[2]; o.w = s[3];
            __builtin_nontemporal_store(o, (v4u*)((unsigned char*)WTv + ((size_t)(n0 + row) * K + k0) * (F8 ? 1 : 2) + 16 * kq)); }
    }
}
template <bool F8>
DI void conv_wg(const Frame& F, int& rot, const float* W, int K, int Nsrc, void* WTv, int Ndst, int mode, int Fgu, float scale) {
    const int items = (K / (F8 ? 256 : 128)) * (Ndst / 256);
    const int it0 = (F.vcu - rot + F.G) % F.G; rot = (rot + items) % F.G;
    for (int it = it0; it < items; it += F.G) conv_item<F8>(F, W, K, Nsrc, WTv, mode, Fgu, scale, it);
}
constexpr int MOE_ITEMS = 8 * 672, NCONV = 16, MOE_HOST = 28 * NCONV, MOE_HOSTB = 14 * NCONV, MOE_X0 = MOE_ITEMS - 2 * MOE_HOST - MOE_HOSTB, MOE_X1 = MOE_X0 + MOE_HOST, MOE_X2 = MOE_X1 + MOE_HOSTB;
DI void conv_moe(const Frame& F, const float* egu, const float* edn, unsigned char* wegu, unsigned char* wedn, int lo, int hi, int c, int NC) {
    LAS unsigned* scr = (LAS unsigned*)F.lds;
    const int lane = F.lane, w = F.wave, tid = F.tid;
    f32x4 a[32];
    int it = lo + c;
    if (it >= hi) return;
#define MOE_DECODE(IT) const int e_ = (IT) / 672, r_ = (IT) % 672; const bool gu_ = r_ < 448; const int rr_ = gu_ ? r_ : r_ - 448, nkb_ = gu_ ? 8 : 28, nb_ = rr_ / nkb_, kb_ = rr_ % nkb_;
#define MOE_LOAD(IT) { MOE_DECODE(IT) const int Nsrc_ = gu_ ? 2 * EFF : D, n_ = nb_ * 256 + 4 * lane, ns_ = gu_ ? (((n_ >> 7) & 1) * EFF + 128 * (n_ >> 8) + (n_ & 127)) : n_; \
        const float* src_ = (gu_ ? egu + (size_t)e_ * D * 2 * EFF : edn + (size_t)e_ * EFF * D) + (size_t)(kb_ * 256 + 32 * w) * Nsrc_ + ns_; \
        _Pragma("unroll") for (int i = 0; i < 32; ++i) a[i] = __builtin_nontemporal_load((const f32x4*)(src_ + (size_t)i * Nsrc_)); }
    MOE_LOAD(it)
    __syncthreads();
    for (; it < hi; it += NC) {
#pragma unroll
        for (int h = 0; h < 2; ++h)
#pragma unroll
            for (int cc = 0; cc < 4; ++cc)
#pragma unroll
                for (int q = 0; q < 4; ++q) scr[(4 * lane + cc) * 65 + 8 * w + 4 * h + q] = pg8::pk4_fp8(a[16 * h + 4 * q][cc] * 256.f, a[16 * h + 4 * q + 1][cc] * 256.f, a[16 * h + 4 * q + 2][cc] * 256.f, a[16 * h + 4 * q + 3][cc] * 256.f);
        __syncthreads();
        if (it + NC < hi) MOE_LOAD(it + NC)
        { MOE_DECODE(it) const int K_ = gu_ ? D : EFF; unsigned char* dst_ = (gu_ ? wegu + (size_t)e_ * 2 * EFF * D : wedn + (size_t)e_ * D * EFF) + (size_t)(nb_ * 256) * K_ + kb_ * 256;
#pragma unroll
          for (int ps = 0; ps < 8; ++ps) { const int row = ps * 32 + (tid >> 4), kq = tid & 15; const LAS unsigned* s = scr + row * 65 + 4 * kq; v4u o; o.x = s[0]; o.y = s[1]; o.z = s[2]; o.w = s[3];
              __builtin_nontemporal_store(o, (v4u*)(dst_ + (size_t)row * K_ + 16 * kq)); } }
        __syncthreads();
    }
#undef MOE_LOAD
#undef MOE_DECODE
}

DI void rms_row(const float* xrow, const float* w, bf16* orow, int lane, unsigned char* o8 = nullptr) {
    f32x4 v[8], ww[8]; float ss = 0.f;
#pragma unroll
    for (int j = 0; j < 8; ++j) { v[j] = *(const f32x4*)(xrow + 4 * (lane + 64 * j)); ww[j] = *(const f32x4*)(w + 4 * (lane + 64 * j)); }
#pragma unroll
    for (int j = 0; j < 8; ++j) ss += (v[j][0] * v[j][0] + v[j][1] * v[j][1]) + (v[j][2] * v[j][2] + v[j][3] * v[j][3]);
    const float rstd = rsqrtf(wave_sum(ss) * (1.f / D) + EPS);
#pragma unroll
    for (int j = 0; j < 8; ++j) { const f32x4 y = v[j] * rstd * ww[j]; v2u o; o.x = pk2(y[0], y[1]); o.y = pk2(y[2], y[3]);
        *(v2u*)(orow + 4 * (lane + 64 * j)) = o;
        if (o8) *(unsigned*)(o8 + 4 * (lane + 64 * j)) = pg8::pk4_fp8(y[0], y[1], y[2], y[3]); }
}

template <int DV, int KT, bool CAUSAL, bool OUT_BF16, bool DECAY, bool QP4 = false>
DI void flash_item(const Frame& F, const bf16* Q, const bf16* Kh, const bf16* VT, int vpitch, int q0, int nkeys, float slope, float* OUTF, bf16* OUTB, int opitch) {
    constexpr int KP = 272, VP = KT * 2 + 16, NKC = KT / 32, NVC = DV * KT / 4096, VCH = KT / 8;
    LAS unsigned char* Kl = F.lds; LAS unsigned char* Vl = F.lds + KT * KP;
    int tid_ = F.tid; asm volatile("" : "+v"(tid_));
    const int tid = tid_, lane = tid & 63, w = F.wave, li = lane & 15, g = lane >> 4;
    const float SC = 0.08838834764831845f, L2E = 1.4426950408889634f;
    bf16x8 qf[4];
#pragma unroll
    for (int ks = 0; ks < 4; ++ks) {
        if (QP4) {
            const float* qp = (const float*)Q + (size_t)(w * 16 + li) * 512 + ks * 32 + g * 8; f32x4 a0 = *(const f32x4*)qp, a1 = *(const f32x4*)(qp + 4);
#pragma unroll
            for (int p = 1; p < 4; ++p) { a0 = a0 + *(const f32x4*)(qp + (size_t)p * T * 512); a1 = a1 + *(const f32x4*)(qp + (size_t)p * T * 512 + 4); }
            v4u pw; pw.x = pk2(a0[0], a0[1]); pw.y = pk2(a0[2], a0[3]); pw.z = pk2(a1[0], a1[1]); pw.w = pk2(a1[2], a1[3]); qf[ks] = __builtin_bit_cast(bf16x8, pw);
        } else qf[ks] = *(const bf16x8*)(Q + (size_t)(w * 16 + li) * 128 + ks * 32 + g * 8); }
    f32x4 o[DV / 16];
#pragma unroll
    for (int c = 0; c < DV / 16; ++c) o[c] = (f32x4){0.f, 0.f, 0.f, 0.f};
    float m_run = -1e30f, l_run = 0.f;
    const int qpos = q0 + w * 16 + li;
    const int kend = CAUSAL ? (q0 + 128 < nkeys ? q0 + 128 : nkeys) : nkeys;
    v4u kr[NKC], vr[NVC];
#pragma unroll
    for (int i = 0; i < NKC; ++i) { const int c = tid + 512 * i; kr[i] = *(const v4u*)(Kh + (size_t)(c >> 4) * 128 + (c & 15) * 8); }
#pragma unroll
    for (int i = 0; i < NVC; ++i) { const int c = tid + 512 * i; vr[i] = *(const v4u*)(VT + (size_t)(c / VCH) * vpitch + (c % VCH) * 8); }
    for (int j0 = 0; j0 < kend; j0 += KT) {
        __syncthreads();
#pragma unroll
        for (int i = 0; i < NKC; ++i) { const int c = tid + 512 * i; *(LAS v4u*)(Kl + (c >> 4) * KP + (c & 15) * 16) = kr[i]; }
#pragma unroll
        for (int i = 0; i < NVC; ++i) { const int c = tid + 512 * i, cc = c % VCH, j = cc & 3; LAS unsigned char* rp = Vl + (c / VCH) * VP + (cc >> 2) * 64;
            *(LAS v2u*)(rp + (8 * ((2 * j) & 3) + 4 * (j >> 1)) * 2) = (v2u){vr[i].x, vr[i].y}; *(LAS v2u*)(rp + (8 * ((2 * j + 1) & 3) + 4 * (j >> 1)) * 2) = (v2u){vr[i].z, vr[i].w}; }
        __syncthreads();
        if (j0 + KT < kend) {
#pragma unroll
            for (int i = 0; i < NKC; ++i) { const int c = tid + 512 * i; kr[i] = *(const v4u*)(Kh + (size_t)(j0 + KT + (c >> 4)) * 128 + (c & 15) * 8); }
#pragma unroll
            for (int i = 0; i < NVC; ++i) { const int c = tid + 512 * i; vr[i] = *(const v4u*)(VT + (size_t)(c / VCH) * vpitch + j0 + KT + (c % VCH) * 8); }
        }
        f32x4 s[KT / 16];
        {
            bf16x8 ka[2][4];
#pragma unroll
            for (int ks = 0; ks < 4; ++ks) ka[0][ks] = *(const LAS bf16x8*)(Kl + li * KP + (ks * 32 + g * 8) * 2);
#pragma unroll
            for (int t = 0; t < KT / 16; ++t) {
                if (t + 1 < KT / 16) {
#pragma unroll
                    for (int ks = 0; ks < 4; ++ks) ka[(t + 1) & 1][ks] = *(const LAS bf16x8*)(Kl + ((t + 1) * 16 + li) * KP + (ks * 32 + g * 8) * 2); }
                __builtin_amdgcn_sched_barrier(0);
                s[t] = (f32x4){0.f, 0.f, 0.f, 0.f};
#pragma unroll
                for (int ks = 0; ks < 4; ++ks) s[t] = __builtin_amdgcn_mfma_f32_16x16x32_bf16(ka[t & 1][ks], qf[ks], s[t], 0, 0, 0);
                __builtin_amdgcn_sched_barrier(0);
            }
        }
        float alpha = 1.f;
        const bool diag = CAUSAL && (j0 + KT - 1 > q0 + w * 16);
        if (DECAY) {
            const float base = slope * (float)(qpos - j0 - 4 * g);
#pragma unroll
            for (int t = 0; t < KT / 16; ++t)
#pragma unroll
                for (int r = 0; r < 4; ++r) s[t][r] *= __builtin_amdgcn_exp2f(fmaf(slope, -(float)(16 * t + r), base));
            if (diag) {
#pragma unroll
                for (int t = 0; t < KT / 16; ++t)
#pragma unroll
                    for (int r = 0; r < 4; ++r) if (j0 + t * 16 + g * 4 + r > qpos) s[t][r] = 0.f; }
        } else {
        const float C2 = SC * L2E, sl2 = slope * L2E, base = -sl2 * (float)(qpos - j0 - 4 * g);
        float mx = -__builtin_inff();
#pragma unroll
        for (int t = 0; t < KT / 16; ++t)
#pragma unroll
            for (int r = 0; r < 4; ++r) s[t][r] = fmaf(s[t][r], C2, fmaf(sl2, (float)(16 * t + r), base));
        if (diag) {
#pragma unroll
            for (int t = 0; t < KT / 16; ++t)
#pragma unroll
                for (int r = 0; r < 4; ++r) if (j0 + t * 16 + g * 4 + r > qpos) s[t][r] = -__builtin_inff(); }
#pragma unroll
        for (int t = 0; t < KT / 16; ++t)
#pragma unroll
            for (int r = 0; r < 4; ++r) mx = fmaxf(mx, s[t][r]);
        mx = fmaxf(mx, __shfl_xor(mx, 16)); mx = fmaxf(mx, __shfl_xor(mx, 32));
        const float m_new = fmaxf(m_run, mx); alpha = __builtin_amdgcn_exp2f(m_run - m_new); m_run = m_new;
        float ps = 0.f;
#pragma unroll
        for (int t = 0; t < KT / 16; ++t)
#pragma unroll
            for (int r = 0; r < 4; ++r) { const float p = __builtin_amdgcn_exp2f(s[t][r] - m_new); s[t][r] = p; ps += p; }
        ps += __shfl_xor(ps, 16); ps += __shfl_xor(ps, 32);
        l_run = l_run * alpha + ps;
        }
        bf16x8 pf[KT / 32];
#pragma unroll
        for (int s2 = 0; s2 < KT / 32; ++s2) { v4u pw; pw.x = pk2(s[2 * s2][0], s[2 * s2][1]); pw.y = pk2(s[2 * s2][2], s[2 * s2][3]); pw.z = pk2(s[2 * s2 + 1][0], s[2 * s2 + 1][1]); pw.w = pk2(s[2 * s2 + 1][2], s[2 * s2 + 1][3]); pf[s2] = __builtin_bit_cast(bf16x8, pw); }
        float al[4];
#pragma unroll
        for (int r = 0; r < 4; ++r) al[r] = DECAY ? 1.f : __shfl(alpha, g * 4 + r);
        {
            v4u vb[2][KT / 32];
#pragma unroll
            for (int s2 = 0; s2 < KT / 32; ++s2) vb[0][s2] = *(const LAS v4u*)(Vl + li * VP + (s2 * 32 + g * 8) * 2);
#pragma unroll
            for (int c = 0; c < DV / 16; ++c) {
                if (c + 1 < DV / 16) {
#pragma unroll
                    for (int s2 = 0; s2 < KT / 32; ++s2) vb[(c + 1) & 1][s2] = *(const LAS v4u*)(Vl + ((c + 1) * 16 + li) * VP + (s2 * 32 + g * 8) * 2); }
                __builtin_amdgcn_sched_barrier(0);
                if (!DECAY) {
#pragma unroll
                    for (int r = 0; r < 4; ++r) o[c][r] *= al[r]; }
#pragma unroll
                for (int s2 = 0; s2 < KT / 32; ++s2) o[c] = __builtin_amdgcn_mfma_f32_16x16x32_bf16(pf[s2], __builtin_bit_cast(bf16x8, vb[c & 1][s2]), o[c], 0, 0, 0);
                __builtin_amdgcn_sched_barrier(0);
            }
        }
    }
    float il[4];
#pragma unroll
    for (int r = 0; r < 4; ++r) il[r] = DECAY ? 1.f : 1.0f / __shfl(l_run, g * 4 + r);
#pragma unroll
    for (int c = 0; c < DV / 16; ++c)
#pragma unroll
        for (int r = 0; r < 4; ++r) { const unsigned off = (unsigned)((w * 16 + g * 4 + r) * opitch + c * 16 + li); const float v = o[c][r] * il[r];
            if (OUT_BF16) OUTB[off] = (bf16)f2bf(v); else OUTF[off] = v; }
}

DI void flash_ret(const Frame& F, const bf16* Q, const bf16* Kh, const bf16* VT, int vpitch, int q0, float lg2, bf16* OUTB, int opitch) {
    constexpr int KP = 272, VP = 144;
    LAS unsigned char* Kl = F.lds; LAS unsigned char* Vl = F.lds + 64 * KP;
    int tid_ = F.tid; asm volatile("" : "+v"(tid_));
    const int tid = tid_, lane = tid & 63, w = F.wave, li = lane & 15, g = lane >> 4;
    bf16x8 qf[2][4];
#pragma unroll
    for (int qs = 0; qs < 2; ++qs)
#pragma unroll
        for (int ks = 0; ks < 4; ++ks) qf[qs][ks] = *(const bf16x8*)(Q + (size_t)(w * 32 + qs * 16 + li) * 128 + ks * 32 + g * 8);
    f32x4 o[2][8];
#pragma unroll
    for (int qs = 0; qs < 2; ++qs)
#pragma unroll
        for (int c = 0; c < 8; ++c) o[qs][c] = (f32x4){0.f, 0.f, 0.f, 0.f};
    const int kend = q0 + 256, qw0 = q0 + w * 32;
    v4u kr[2], vr[2];
#pragma unroll
    for (int i = 0; i < 2; ++i) { const int c = tid + 512 * i; kr[i] = *(const v4u*)(Kh + (size_t)(c >> 4) * 128 + (c & 15) * 8); vr[i] = *(const v4u*)(VT + (size_t)(c >> 3) * vpitch + (c & 7) * 8); }
    for (int j0 = 0; j0 < kend; j0 += 64) {
        __syncthreads();
#pragma unroll
        for (int i = 0; i < 2; ++i) { const int c = tid + 512 * i; *(LAS v4u*)(Kl + (c >> 4) * KP + (c & 15) * 16) = kr[i];
            const int cc = c & 7, j = cc & 3; LAS unsigned char* rp = Vl + (c >> 3) * VP + (cc >> 2) * 64;
            *(LAS v2u*)(rp + (8 * ((2 * j) & 3) + 4 * (j >> 1)) * 2) = (v2u){vr[i].x, vr[i].y}; *(LAS v2u*)(rp + (8 * ((2 * j + 1) & 3) + 4 * (j >> 1)) * 2) = (v2u){vr[i].z, vr[i].w}; }
        __syncthreads();
        if (j0 + 64 < kend) {
#pragma unroll
            for (int i = 0; i < 2; ++i) { const int c = tid + 512 * i; kr[i] = *(const v4u*)(Kh + (size_t)(j0 + 64 + (c >> 4)) * 128 + (c & 15) * 8); vr[i] = *(const v4u*)(VT + (size_t)(c >> 3) * vpitch + j0 + 64 + (c & 7) * 8); }
        }
        if (j0 > qw0 + 31) continue;
        f32x4 s[2][4];
        {
            bf16x8 ka[2][4];
#pragma unroll
            for (int ks = 0; ks < 4; ++ks) ka[0][ks] = *(const LAS bf16x8*)(Kl + li * KP + (ks * 32 + g * 8) * 2);
#pragma unroll
            for (int t = 0; t < 4; ++t) {
                if (t + 1 < 4) {
#pragma unroll
                    for (int ks = 0; ks < 4; ++ks) ka[(t + 1) & 1][ks] = *(const LAS bf16x8*)(Kl + ((t + 1) * 16 + li) * KP + (ks * 32 + g * 8) * 2); }
                __builtin_amdgcn_sched_barrier(0);
#pragma unroll
                for (int qs = 0; qs < 2; ++qs) { s[qs][t] = (f32x4){0.f, 0.f, 0.f, 0.f};
#pragma unroll
                    for (int ks = 0; ks < 4; ++ks) s[qs][t] = __builtin_amdgcn_mfma_f32_16x16x32_bf16(ka[t & 1][ks], qf[qs][ks], s[qs][t], 0, 0, 0); }
                __builtin_amdgcn_sched_barrier(0);
            }
        }
        const bool diag = j0 + 63 > qw0;
        bf16x8 pf[2][2];
#pragma unroll
        for (int qs = 0; qs < 2; ++qs) { const int qpos = qw0 + qs * 16 + li; const float base = lg2 * (float)(qpos - j0 - 4 * g);
#pragma unroll
            for (int t = 0; t < 4; ++t)
#pragma unroll
                for (int r = 0; r < 4; ++r) s[qs][t][r] *= __builtin_amdgcn_exp2f(fmaf(lg2, -(float)(16 * t + r), base));
            if (diag) {
#pragma unroll
                for (int t = 0; t < 4; ++t)
#pragma unroll
                    for (int r = 0; r < 4; ++r) if (j0 + t * 16 + g * 4 + r > qpos) s[qs][t][r] = 0.f; }
#pragma unroll
            for (int s2 = 0; s2 < 2; ++s2) { v4u pw; pw.x = pk2(s[qs][2 * s2][0], s[qs][2 * s2][1]); pw.y = pk2(s[qs][2 * s2][2], s[qs][2 * s2][3]); pw.z = pk2(s[qs][2 * s2 + 1][0], s[qs][2 * s2 + 1][1]); pw.w = pk2(s[qs][2 * s2 + 1][2], s[qs][2 * s2 + 1][3]); pf[qs][s2] = __builtin_bit_cast(bf16x8, pw); } }
        {
            v4u vb[2][2];
#pragma unroll
            for (int s2 = 0; s2 < 2; ++s2) vb[0][s2] = *(const LAS v4u*)(Vl + li * VP + (s2 * 32 + g * 8) * 2);
#pragma unroll
            for (int c = 0; c < 8; ++c) {
                if (c + 1 < 8) {
#pragma unroll
                    for (int s2 = 0; s2 < 2; ++s2) vb[(c + 1) & 1][s2] = *(const LAS v4u*)(Vl + ((c + 1) * 16 + li) * VP + (s2 * 32 + g * 8) * 2); }
                __builtin_amdgcn_sched_barrier(0);
#pragma unroll
                for (int qs = 0; qs < 2; ++qs)
#pragma unroll
                    for (int s2 = 0; s2 < 2; ++s2) o[qs][c] = __builtin_amdgcn_mfma_f32_16x16x32_bf16(pf[qs][s2], __builtin_bit_cast(bf16x8, vb[c & 1][s2]), o[qs][c], 0, 0, 0);
                __builtin_amdgcn_sched_barrier(0);
            }
        }
    }
#pragma unroll
    for (int qs = 0; qs < 2; ++qs)
#pragma unroll
        for (int c = 0; c < 8; ++c)
#pragma unroll
            for (int r = 0; r < 4; ++r) OUTB[(unsigned)((w * 32 + qs * 16 + g * 4 + r) * opitch + c * 16 + li)] = (bf16)f2bf(o[qs][c][r]);
}

constexpr int GDN_CH_BYTES = 16384 + 16384 + 8192 + 16384 + 32768;
DI int perm32pos(int k) { return (k & ~31) | (((k >> 2) & 3) << 3) | (((k >> 4) & 1) << 2) | (k & 3); }
DI void gdn_prep_item(const Frame& F, int l, int bh, int n, bool stage_cw, const bf16* BQKV, const float* BBA, const float* cw, const float* a_log, const float* dt_bias, unsigned char* CH, float* GLp) {
    LAS unsigned char* Kl = F.lds; LAS unsigned char* Ql = F.lds + 17408; LAS unsigned char* KBT = F.lds + 34816; LAS unsigned char* VBT = F.lds + 53248; LAS unsigned char* KTl = F.lds + 71680;
    LAS float* Am = (LAS float*)(F.lds + 90112); LAS unsigned char* Tl = F.lds + 106752; LAS unsigned char* AQl = F.lds + 115968; LAS float* Gs = (LAS float*)(F.lds + 125184); LAS float* gs = Gs + 64; LAS float* bs = gs + 64;
    LAS float* CWl = (LAS float*)(F.lds + RING_BYTES);
    int tid_ = F.tid; asm volatile("" : "+v"(tid_));
    const int tid = tid_, lane = tid & 63, w = F.wave, li = lane & 15, g = lane >> 4;
    const int b = bh >> 3, h = bh & 7, i = tid >> 3, cg = tid & 7, c0 = cg * 16, s = n * 64 + i, t = b * SEQ + s;
    bf16* Wn = (bf16*)CH; bf16* QD = (bf16*)(CH + 16384); bf16* AQK = (bf16*)(CH + 32768); bf16* KT = (bf16*)(CH + 40960); float* UT = (float*)(CH + 57344);
    v4u xr[3][4][2];
#pragma unroll
    for (int part = 0; part < 3; ++part)
#pragma unroll
        for (int j = 0; j < 4; ++j) { const int tj = (s - 3 + j >= 0) ? t - 3 + j : t; const bf16* xp = BQKV + (size_t)tj * 3072 + part * 1024 + h * 128 + c0; xr[part][j][0] = *(const v4u*)xp; xr[part][j][1] = *(const v4u*)(xp + 8); }
    float bbv = 0.f, bav = 0.f;
    if (w == 0) { const size_t tt = (size_t)(b * SEQ + n * 64 + lane) * 16; bbv = BBA[tt + h]; bav = BBA[tt + 8 + h] + dt_bias[l * 8 + h]; }
    __syncthreads();
    if (stage_cw) { for (int e = tid; e < 1536; e += 512) { const int part = e >> 9, j = (e >> 7) & 3, c = e & 127; CWl[e] = cw[j * 3072 + part * 1024 + h * 128 + c]; } __syncthreads(); }
    if (w == 0) { const float sp = bav > 20.f ? bav : log1pf(__expf(bav)); float v = -__expf(a_log[l * 8 + h]) * sp; bs[lane] = pg8::fsigm(bbv);
#pragma unroll
        for (int o = 1; o < 64; o <<= 1) { const float u = __shfl_up(v, o); if (lane >= o) v += u; }
        Gs[lane] = v; }
    float qv[16], kv[16], vv[16];
#pragma unroll
    for (int part = 0; part < 3; ++part) {
        float a[16];
#pragma unroll
        for (int c = 0; c < 16; ++c) a[c] = 0.f;
#pragma unroll
        for (int j = 0; j < 4; ++j) { const v4u x0 = xr[part][j][0], x1 = xr[part][j][1];
            const LAS float* wj = CWl + part * 512 + j * 128 + c0; const float mk = (s - 3 + j >= 0) ? 1.f : 0.f;
#pragma unroll
            for (int c = 0; c < 4; ++c) { a[2 * c] += bf2f(x0[c] & 0xffffu) * (wj[2 * c] * mk); a[2 * c + 1] += __uint_as_float(x0[c] & 0xffff0000u) * (wj[2 * c + 1] * mk); a[8 + 2 * c] += bf2f(x1[c] & 0xffffu) * (wj[8 + 2 * c] * mk); a[9 + 2 * c] += __uint_as_float(x1[c] & 0xffff0000u) * (wj[9 + 2 * c] * mk); } }
#pragma unroll
        for (int c = 0; c < 16; ++c) { const float y = pg8::fsilu(a[c]); if (part == 0) qv[c] = y; else if (part == 1) kv[c] = y; else vv[c] = y; }
    }
    { float sq = 0.f, sk = 0.f;
#pragma unroll
      for (int c = 0; c < 16; ++c) { sq += qv[c] * qv[c]; sk += kv[c] * kv[c]; }
      sq += __shfl_xor(sq, 1); sq += __shfl_xor(sq, 2); sq += __shfl_xor(sq, 4); sk += __shfl_xor(sk, 1); sk += __shfl_xor(sk, 2); sk += __shfl_xor(sk, 4);
      const float qn = rsqrtf(sq + 1e-6f) * 0.08838834764831845f, kn = rsqrtf(sk + 1e-6f);
#pragma unroll
      for (int c = 0; c < 16; ++c) { qv[c] *= qn; kv[c] *= kn; } }
    __syncthreads();
    {
        const float Gi = Gs[i], Gl = Gs[63], be = bs[i], eg = __expf(Gi), kbs = be * eg, kts = __expf(Gl - Gi);
        v4u pk, pq;
#pragma unroll
        for (int hh = 0; hh < 2; ++hh) {
            pk.x = pk2(kv[8 * hh + 0], kv[8 * hh + 1]); pk.y = pk2(kv[8 * hh + 2], kv[8 * hh + 3]); pk.z = pk2(kv[8 * hh + 4], kv[8 * hh + 5]); pk.w = pk2(kv[8 * hh + 6], kv[8 * hh + 7]);
            pq.x = pk2(qv[8 * hh + 0], qv[8 * hh + 1]); pq.y = pk2(qv[8 * hh + 2], qv[8 * hh + 3]); pq.z = pk2(qv[8 * hh + 4], qv[8 * hh + 5]); pq.w = pk2(qv[8 * hh + 6], qv[8 * hh + 7]);
            *(LAS v4u*)(Kl + i * 272 + (c0 + 8 * hh) * 2) = pk; *(LAS v4u*)(Ql + i * 272 + (c0 + 8 * hh) * 2) = pq; }
        const int ip = perm32pos(i);
        const int isw = ((((i >> 3) ^ cg) << 3) + (i & 7)) * 2, ipsw = ((((ip >> 3) ^ cg) << 3) + (ip & 7)) * 2;
#pragma unroll
        for (int c = 0; c < 16; ++c) { *(LAS bf16*)(KBT + (c0 + c) * 144 + isw) = (bf16)f2bf(kv[c] * kbs); *(LAS bf16*)(VBT + (c0 + c) * 144 + isw) = (bf16)f2bf(vv[c] * be); *(LAS bf16*)(KTl + (c0 + c) * 144 + ipsw) = (bf16)f2bf(kv[c] * kts); }
#pragma unroll
        for (int gp = 0; gp < 4; ++gp) { v2u o; o.x = pk2(qv[4 * gp] * eg, qv[4 * gp + 1] * eg); o.y = pk2(qv[4 * gp + 2] * eg, qv[4 * gp + 3] * eg); *(v2u*)(QD + i * 128 + 32 * (cg >> 1) + 8 * gp + 4 * (cg & 1)) = o; }
        if (tid == 0) *GLp = __expf(Gl);
    }
    __syncthreads();
    {
        const int kind = w >> 2, rb = w & 3; LAS unsigned char* Al = kind ? Ql : Kl;
        bf16x8 af[4];
#pragma unroll
        for (int ks = 0; ks < 4; ++ks) af[ks] = *(const LAS bf16x8*)(Al + (rb * 16 + li) * 272 + (ks * 32 + g * 8) * 2);
#pragma unroll
        for (int cb = 0; cb < 4; ++cb) {
            f32x4 acc = (f32x4){0.f, 0.f, 0.f, 0.f};
            if (cb <= rb) {
#pragma unroll
                for (int ks = 0; ks < 4; ++ks) { const bf16x8 bfr = *(const LAS bf16x8*)(Kl + (cb * 16 + li) * 272 + (ks * 32 + g * 8) * 2); acc = __builtin_amdgcn_mfma_f32_16x16x32_bf16(af[ks], bfr, acc, 0, 0, 0); } }
            const int j = cb * 16 + li; const float Gj = Gs[j];
#pragma unroll
            for (int r = 0; r < 4; ++r) { const int ii = rb * 16 + 4 * g + r; const float Lij = __expf(Gs[ii] - Gj);
                if (kind == 0) Am[ii * 65 + j] = ii > j ? acc[r] * Lij * bs[ii] : 0.f;
                else *(LAS bf16*)(AQl + ii * 144 + perm32pos(j) * 2) = (bf16)f2bf(ii >= j ? acc[r] * Lij : 0.f); }
        }
    }
    __syncthreads();
    if (w == 0) {
        int zv = 0; asm volatile("" : "+v"(zv)); const LAS float* Amv = Am + zv;
        float Tr[64], ar[2][64];
        ar[1][0] = Amv[65];
#pragma unroll
        for (int ii = 0; ii < 64; ++ii) {
            if (ii + 1 < 64 && ii >= 1) {
#pragma unroll
                for (int j = 0; j < ii + 1; ++j) ar[(ii + 1) & 1][j] = Amv[(ii + 1) * 65 + j]; }
            __builtin_amdgcn_sched_barrier(0);
            float ac[4] = {(ii == lane) ? 1.f : 0.f, 0.f, 0.f, 0.f};
#pragma unroll
            for (int j = 0; j < ii; ++j) ac[j & 3] -= ar[ii & 1][j] * Tr[j];
            Tr[ii] = (ac[0] + ac[1]) + (ac[2] + ac[3]);
            *(LAS bf16*)(Tl + ii * 144 + lane * 2) = (bf16)f2bf(Tr[ii]);
            __builtin_amdgcn_sched_barrier(0);
        }
    }
    __syncthreads();
    {
        const int kind = w >> 2; LAS unsigned char* Xl = kind ? VBT : KBT;
#pragma unroll
        for (int q2 = 0; q2 < 2; ++q2) { const int rbk = 2 * (w & 3) + q2;
            bf16x8 af[2];
#pragma unroll
            for (int ks = 0; ks < 2; ++ks) af[ks] = *(const LAS bf16x8*)(Xl + (rbk * 16 + li) * 144 + (((ks * 4 + g) ^ rbk) * 8) * 2);
#pragma unroll
            for (int cb = 0; cb < 4; ++cb) { f32x4 acc = (f32x4){0.f, 0.f, 0.f, 0.f};
#pragma unroll
                for (int ks = 0; ks < 2; ++ks) { const bf16x8 bfr = *(const LAS bf16x8*)(Tl + (cb * 16 + li) * 144 + (ks * 32 + g * 8) * 2); acc = __builtin_amdgcn_mfma_f32_16x16x32_bf16(af[ks], bfr, acc, 0, 0, 0); }
                const int ii = cb * 16 + li;
                if (kind == 0) { v2u o; o.x = pk2(-acc[0], -acc[1]); o.y = pk2(-acc[2], -acc[3]); *(v2u*)(Wn + ii * 128 + 32 * (rbk >> 1) + 8 * g + 4 * (rbk & 1)) = o; }
                else {
#pragma unroll
                    for (int r = 0; r < 4; ++r) UT[(rbk * 16 + 4 * g + r) * 64 + ii] = acc[r]; } }
        }
    }
#pragma unroll
    for (int q2 = 0; q2 < 2; ++q2) { const int c = tid + 512 * q2, row = c >> 3, cc = c & 7; *(v4u*)(KT + row * 64 + cc * 8) = *(const LAS v4u*)(KTl + row * 144 + (cc ^ (row >> 4)) * 16); }
    { const int row = tid >> 3, cc = tid & 7; *(v4u*)(AQK + row * 64 + cc * 8) = *(const LAS v4u*)(AQl + row * 144 + cc * 16); }
}

DI void gdn_scan(const Frame& F, int bh, const unsigned char* CHB, const float* GLB, bf16* OB) {
    constexpr int BUFB = 62464, O_QD = 17408, O_AQ = 34816, O_KT = 44032;
    int tid_ = F.tid; asm volatile("" : "+v"(tid_));
    const int tid = tid_, lane = tid & 63, w = F.wave, li = lane & 15, g = lane >> 4, b = bh >> 3, h = bh & 7;
    f32x4 S[8];
#pragma unroll
    for (int kb = 0; kb < 8; ++kb) S[kb] = (f32x4){0.f, 0.f, 0.f, 0.f};
    int ldso[7];
#pragma unroll
    for (int q = 0; q < 7; ++q) { const int c = tid + 512 * q;
        if (q < 2) ldso[q] = (c >> 4) * 272 + (c & 15) * 16; else if (q < 4) ldso[q] = O_QD + ((c - 1024) >> 4) * 272 + (c & 15) * 16;
        else if (q == 4) ldso[q] = O_AQ + ((c - 2048) >> 3) * 144 + (c & 7) * 16; else ldso[q] = O_KT + ((c - 2560) >> 3) * 144 + (c & 7) * 16; }
    const unsigned char* CH0 = CHB + (size_t)(bh * 32) * GDN_CH_BYTES;
    v4u st[7]; f32x4 utc[4], utn[4]; float glc, gln;
    __syncthreads();
#pragma unroll
    for (int q = 0; q < 7; ++q) st[q] = *(const v4u*)(CH0 + (size_t)(tid + 512 * q) * 16);
#pragma unroll
    for (int jb = 0; jb < 4; ++jb) utc[jb] = *(const f32x4*)((const float*)(CH0 + 57344) + (16 * w + li) * 64 + jb * 16 + 4 * g);
    glc = GLB[bh * 32];
#pragma unroll
    for (int q = 0; q < 7; ++q) *(LAS v4u*)(F.lds + ldso[q]) = st[q];
    __syncthreads();
    for (int n = 0; n < 32; ++n) {
        const LAS unsigned char* Lb = F.lds + (n & 1) * BUFB;
        if (n + 1 < 32) { const unsigned char* CH = CH0 + (size_t)(n + 1) * GDN_CH_BYTES;
#pragma unroll
            for (int q = 0; q < 7; ++q) st[q] = *(const v4u*)(CH + (size_t)(tid + 512 * q) * 16);
#pragma unroll
            for (int jb = 0; jb < 4; ++jb) utn[jb] = *(const f32x4*)((const float*)(CH + 57344) + (16 * w + li) * 64 + jb * 16 + 4 * g);
            gln = GLB[bh * 32 + n + 1]; }
        bf16x8 sf[4];
#pragma unroll
        for (int ks = 0; ks < 4; ++ks) { v4u p; p.x = pk2(S[2 * ks][0], S[2 * ks][1]); p.y = pk2(S[2 * ks][2], S[2 * ks][3]); p.z = pk2(S[2 * ks + 1][0], S[2 * ks + 1][1]); p.w = pk2(S[2 * ks + 1][2], S[2 * ks + 1][3]); sf[ks] = __builtin_bit_cast(bf16x8, p); }
        f32x4 vn[4];
#pragma unroll
        for (int jb = 0; jb < 4; ++jb) { vn[jb] = utc[jb];
#pragma unroll
            for (int ks = 0; ks < 4; ++ks) { const bf16x8 a = *(const LAS bf16x8*)(Lb + (jb * 16 + li) * 272 + (ks * 32 + g * 8) * 2); vn[jb] = __builtin_amdgcn_mfma_f32_16x16x32_bf16(a, sf[ks], vn[jb], 0, 0, 0); } }
        bf16x8 vf[2];
#pragma unroll
        for (int js = 0; js < 2; ++js) { v4u p; p.x = pk2(vn[2 * js][0], vn[2 * js][1]); p.y = pk2(vn[2 * js][2], vn[2 * js][3]); p.z = pk2(vn[2 * js + 1][0], vn[2 * js + 1][1]); p.w = pk2(vn[2 * js + 1][2], vn[2 * js + 1][3]); vf[js] = __builtin_bit_cast(bf16x8, p); }
#pragma unroll
        for (int ib = 0; ib < 4; ++ib) { f32x4 z = (f32x4){0.f, 0.f, 0.f, 0.f};
#pragma unroll
            for (int ks = 0; ks < 4; ++ks) { const bf16x8 bq = *(const LAS bf16x8*)(Lb + O_QD + (ib * 16 + li) * 272 + (ks * 32 + g * 8) * 2); z = __builtin_amdgcn_mfma_f32_16x16x32_bf16(sf[ks], bq, z, 0, 0, 0); }
#pragma unroll
            for (int js = 0; js < 2; ++js) { const bf16x8 ba = *(const LAS bf16x8*)(Lb + O_AQ + (ib * 16 + li) * 144 + (js * 32 + g * 8) * 2); z = __builtin_amdgcn_mfma_f32_16x16x32_bf16(vf[js], ba, z, 0, 0, 0); }
            v2u zo; zo.x = pk2(z[0], z[1]); zo.y = pk2(z[2], z[3]); *(v2u*)(OB + ((size_t)(b * SEQ + n * 64 + ib * 16 + li)) * 1024 + h * 128 + 16 * w + 4 * g) = zo; }
#pragma unroll
        for (int kb = 0; kb < 8; ++kb) { S[kb] = S[kb] * glc;
#pragma unroll
            for (int js = 0; js < 2; ++js) { const bf16x8 a = *(const LAS bf16x8*)(Lb + O_KT + (kb * 16 + li) * 144 + (js * 32 + g * 8) * 2); S[kb] = __builtin_amdgcn_mfma_f32_16x16x32_bf16(a, vf[js], S[kb], 0, 0, 0); } }
        if (n + 1 < 32) {
            LAS unsigned char* Ln = F.lds + ((n + 1) & 1) * BUFB;
#pragma unroll
            for (int q = 0; q < 7; ++q) *(LAS v4u*)(Ln + ldso[q]) = st[q];
#pragma unroll
            for (int jb = 0; jb < 4; ++jb) utc[jb] = utn[jb];
            glc = gln; }
        __syncthreads();
    }
}

#define x_in ((const float*)args.in[0])
#define mem ((const float*)args.in[1])
#define w_in ((const float*)args.in[2])
#define conv_w ((const float*)args.in[3])
#define a_log ((const float*)args.in[4])
#define dt_bias ((const float*)args.in[5])
#define gdn_norm_w ((const float*)args.in[6])
#define diff_lambda ((const float*)args.in[7])
#define diff_norm_w ((const float*)args.in[8])
#define w_branch ((const float*)args.in[9])
#define w_out ((const float*)args.in[10])
#define mix_norm_w ((const float*)args.in[11])
#define mem_norm_w ((const float*)args.in[12])
#define cross_norm_w ((const float*)args.in[13])
#define cross_w_q ((const float*)args.in[14])
#define cross_w_kv ((const float*)args.in[15])
#define cross_w_o ((const float*)args.in[16])
#define ffn_norm_w ((const float*)args.in[17])
#define dense_w_gu ((const float*)args.in[18])
#define dense_w_down ((const float*)args.in[19])
#define router_w ((const float*)args.in[20])
#define expert_w_gu ((const float*)args.in[21])
#define expert_w_down ((const float*)args.in[22])
#define final_norm_w ((const float*)args.in[23])
#define WIN ((bf16*)(ws + WS_WIN))
#define WBR ((bf16*)(ws + WS_WBR))
#define WOUT ((bf16*)(ws + WS_WOUT))
#define WQ ((bf16*)(ws + WS_WQ))
#define WKV ((bf16*)(ws + WS_WKV))
#define WO ((bf16*)(ws + WS_WO))
#define WGU ((bf16*)(ws + WS_WGU))
#define WDN ((bf16*)(ws + WS_WDN))
#define WEGU ((bf16*)(ws + WS_WEGU))
#define WEDN ((bf16*)(ws + WS_WEDN))
#define XRES ((float*)(ws + WS_XRES))
#define H ((bf16*)(ws + WS_H))
#define RQ ((bf16*)(ws + WS_RQ))
#define RK ((bf16*)(ws + WS_RK))
#define RVT ((bf16*)(ws + WS_RV))
#define RG ((bf16*)(ws + WS_RG))
#define BQKV ((bf16*)(ws + WS_BQKV))
#define BZ ((bf16*)(ws + WS_BZ))
#define BBA ((float*)(ws + WS_BBA))
#define CQ ((bf16*)(ws + WS_CQ))
#define CK ((bf16*)(ws + WS_CK))
#define CVT ((bf16*)(ws + WS_CVT))
#define GATES ((bf16*)(ws + WS_GATES))
#define OA ((bf16*)(ws + WS_OA))
#define OB ((bf16*)(ws + WS_OB))
#define O12 ((bf16*)(ws + WS_O12))
#define OCAT ((bf16*)(ws + WS_OCAT))
#define MERGEB ((bf16*)(ws + WS_MERGEB))
#define MEMN ((bf16*)(ws + WS_MEMN))
#define KX ((bf16*)(ws + WS_KX))
#define VXT ((bf16*)(ws + WS_VXT))
#define QX ((bf16*)(ws + WS_QX))
#define OX ((bf16*)(ws + WS_OX))
#define ACT ((bf16*)(ws + WS_ACT))
#define HG ((bf16*)(ws + WS_HG))
#define EACT ((bf16*)(ws + WS_EACT))
#define Y ((float*)(ws + WS_Y))
#define ROUTE ((int*)(ws + WS_ROUTE))
#define QP ((float*)(ws + WS_MERGE))
#define H8 ((unsigned char*)(ws + WS_H8))
#define WIN8 ((unsigned char*)(ws + WS_WIN8))
__global__ void __launch_bounds__(NWAVES * 64, 2) mk_fwd(Args args) {
    extern __shared__ __attribute__((aligned(16))) unsigned char lds_raw[];
    Frame F;
    F.lds = (LAS unsigned char*)lds_raw;
    F.tid = threadIdx.x; F.lane = F.tid & 63; F.wave = __builtin_amdgcn_readfirstlane(F.tid >> 6);
    F.G = gridDim.x; { const int bx = blockIdx.x; F.vcu = (F.G % 8 == 0) ? (bx % 8) * (F.G / 8) + bx / 8 : bx; }
    F.gw = F.vcu * NWAVES + F.wave; F.NGW = F.G * NWAVES;
    volatile LAS unsigned* MISC = (volatile LAS unsigned*)(F.lds + MISC_OFF);
    LAS int* MTAB = (LAS int*)(F.lds + MISC_OFF + 128);
    unsigned char* ws = args.ws;
    unsigned* ctl = (unsigned*)(ws + WS_CTL);
    for (int u = F.tid; u < (LDS_BYTES - RING_BYTES) / 4; u += NWAVES * 64) ((LAS unsigned*)(F.lds + RING_BYTES))[u] = 0u;
    __syncthreads();
#if MK_ONE_LAUNCH
    XcdBarrier bar = xcd_barrier_post(ctl + CW_BAR, MISC + 8);
#define GRID_BAR() xcd_barrier(bar)
#else
#define GRID_BAR() do {} while (0)
#endif
    const int lo = args.ph_lo, hi = args.ph_hi;
#define IN(k) (lo <= (k) && (k) < hi)
#define SEAM(k) do { if (IN(k) && IN((k) + 1)) GRID_BAR(); } while (0)

    if (IN(0)) {
        int rot = 0;
        for (int l = 0; l < 2; ++l) {
            conv_wg<false>(F, rot, w_in + (size_t)l * D * 17424, D, 17424, WIN + (size_t)l * NINP * D, 45 * 256, 3, 0, 1.f);
            conv_wg<true>(F, rot, w_in + (size_t)l * D * 17424, D, 17424, WIN8 + (size_t)l * 32 * 256 * D, 24 * 256, 4, 0, 256.f);
            conv_wg<false>(F, rot, w_branch + (size_t)l * 3072 * D, 3072, D, WBR + (size_t)l * D * 3072, D, 0, 0, 1.f);
            conv_wg<false>(F, rot, w_out + (size_t)l * D * D, D, D, WOUT + (size_t)l * D * D, D, 0, 0, 1.f);
            conv_wg<false>(F, rot, cross_w_q + (size_t)l * D * 512, D, 512, WQ + (size_t)l * 512 * D, 512, 0, 0, 1.f);
            conv_wg<false>(F, rot, cross_w_kv + (size_t)l * D * 1024, D, 1024, WKV + (size_t)l * 1024 * D, 1024, 0, 0, 1.f);
            conv_wg<false>(F, rot, cross_w_o + (size_t)l * 512 * D, 512, D, WO + (size_t)l * D * 512, D, 0, 0, 1.f);
        }
        conv_wg<true>(F, rot, dense_w_gu, D, 2 * DFF, WGU, 2 * DFF, 2, DFF, 256.f);
        conv_wg<false>(F, rot, dense_w_down, DFF, D, WDN, D, 0, 0, 1.f);
        conv_moe(F, expert_w_gu, expert_w_down, (unsigned char*)WEGU, (unsigned char*)WEDN, 0, MOE_X0, (F.vcu - rot + F.G) % F.G, F.G);
        for (int r = F.gw; r < T; r += F.NGW) rms_row(x_in + (size_t)r * D, mix_norm_w, H + (size_t)r * D, F.lane, H8 + (size_t)r * D);
        for (int r = F.gw; r < 2 * MEMR; r += F.NGW) { const int l = r / MEMR, rr = r % MEMR; rms_row(mem + (size_t)rr * D, mem_norm_w + l * D, MEMN + (size_t)r * D, F.lane); }
    }
    SEAM(0);

    { constexpr int l = 0;
        const int pb = 2 + l * NPL;
        const float lambda_init = l == 0 ? 0.2f : 0.35550906f;
        const float* xin = l == 0 ? x_in : XRES;
        if (IN(pb + 0)) {
            if ((int)blockIdx.x >= F.G - NCONV) conv_moe(F, expert_w_gu, expert_w_down, (unsigned char*)WEGU, (unsigned char*)WEDN, l == 0 ? MOE_X0 : MOE_X2, l == 0 ? MOE_X1 : MOE_ITEMS, (int)blockIdx.x - (F.G - NCONV), NCONV);
            else
            { pg8::Gemm g{H, WIN + (size_t)l * NINP * D, T, 45 * 256, D}; pg8::StaticOrder S; S.init(T, 45 * 256, F.G - NCONV, (int)blockIdx.x);
              pg8::EpiIn E{RQ, RK, RVT, RG, BQKV, BZ, CQ, CK, CVT, GATES, BBA, 0, 1.f};
              pg8::gemm_phase<pg8::EpiIn, pg8::StaticOrder, true, true>(F.lds, g, S, E); }
            { pg8::Gemm g{(const bf16*)H8, (const bf16*)(WIN8 + (size_t)l * 32 * 256 * D), T, 24 * 256, D / 2}; pg8::StaticOrder S; S.init(T, 24 * 256, F.G, (int)blockIdx.x);
              pg8::EpiIn E{RQ, RK, RVT, RG, BQKV, BZ, CQ, CK, CVT, GATES, BBA, 1, 1.0f / 256.f};
              pg8::gemm_phase<pg8::EpiIn, pg8::StaticOrder, true, true, true>(F.lds, g, S, E); }
        }
        SEAM(pb + 0);
        if (IN(pb + 1)) {
            const float* cw = conv_w + (size_t)l * 4 * 3072;
            { const int per = (1024 + F.G - 1) / F.G, lo_ = F.vcu * per, hi_ = lo_ + per < 1024 ? lo_ + per : 1024;
              for (int it = lo_; it < hi_; ++it) gdn_prep_item(F, l, it >> 5, it & 31, it == lo_ || (it & 31) == 0, BQKV, BBA, cw, a_log, dt_bias, ws + WS_GCH + (size_t)it * GDN_CH_BYTES, (float*)(ws + WS_GL) + it); }
        }
        SEAM(pb + 1);
        if (IN(pb + 2)) {
            const int bx = F.vcu;
            const int qw = 100 + l;
            if (bx >= 32 && bx < 48) {
                pg8::Gemm g2{MEMN + (size_t)l * MEMR * D, WKV + (size_t)l * 1024 * D, MEMR, 1024, D}; pg8::StaticOrder S2; S2.init(MEMR, 1024, F.G, bx - 32);
                pg8::EpiHeads E2{KX + (size_t)l * NB * 4 * MEML * 128, VXT + (size_t)l * NB * 4 * 128 * MEML, 4, 8, 2};
                pg8::gemm_phase<pg8::EpiHeads, pg8::StaticOrder, true, true>(F.lds, g2, S2, E2);
            }
            if (bx < 32) gdn_scan(F, bx, ws + WS_GCH, (const float*)(ws + WS_GL), OB);
            {
                volatile LAS int* qslot = (volatile LAS int*)(F.lds + MISC_OFF + 256);
                int nxt = 0; if (F.tid == 0) nxt = (int)atomicAdd(ctl + qw, 1u);
                for (;;) {
                    __syncthreads(); if (F.tid == 0) qslot[0] = nxt; __syncthreads();
                    const int it = __builtin_amdgcn_readfirstlane(qslot[0]); if (it >= 768) break;
                    if (F.tid == 0) nxt = (int)atomicAdd(ctl + qw, 1u);
                    const int v = it / 48, r = it % 48;
                    if (r < 32) { const int qt = 15 - v, hd = r, b = hd >> 3, hm = hd & 7, hh = hm >> 1, m = hm & 1; const float slope = exp2f(-2.0f * (float)(hh + 1));
                        flash_item<256, 128, true, true, false>(F, CQ + ((size_t)hd * SEQ + qt * 128) * 128, CK + (size_t)hd * SEQ * 128, CVT + (size_t)(b * 4 + hh) * 256 * SEQ, SEQ, qt * 128, SEQ, slope,
                                                            nullptr, O12 + ((size_t)m * T + b * SEQ + qt * 128) * 1024 + hh * 256, 1024); }
                    else { const int qt2 = 7 - (v >> 1), hd = (r - 32) + 16 * (v & 1), b = hd >> 3, hm = hd & 7; const float lg = log2f(1.0f - exp2f(-5.0f - (float)hm));
                        flash_ret(F, RQ + ((size_t)hd * SEQ + qt2 * 256) * 128, RK + (size_t)hd * SEQ * 128, RVT + (size_t)hd * 128 * SEQ, SEQ, qt2 * 256, lg, OA + ((size_t)(b * SEQ + qt2 * 256)) * 1024 + hm * 128, 1024); }
                }
            }
        }
        SEAM(pb + 2);
        if (IN(pb + 3)) {
            const int lane = F.lane;
            const float* lv = diff_lambda + (size_t)l * 512;
            const float d01 = wave_sum(lv[lane] * lv[128 + lane] + lv[64 + lane] * lv[192 + lane]), d23 = wave_sum(lv[256 + lane] * lv[384 + lane] + lv[320 + lane] * lv[448 + lane]);
            const float lam = __expf(d01) - __expf(d23) + lambda_init;
            const float gw0 = gdn_norm_w[l * 128 + 2 * lane], gw1 = gdn_norm_w[l * 128 + 2 * lane + 1]; const f32x4 dw = *(const f32x4*)(diff_norm_w + l * 256 + 4 * lane);
            for (int t = F.gw; t < T; t += F.NGW) {
                float a0[8], a1[8], b0[8], b1[8], red[28]; f32x4 dd[4];
#pragma unroll
                for (int h = 0; h < 8; ++h) { const size_t o = (size_t)t * 1024 + h * 128 + 2 * lane; const unsigned av = *(const unsigned*)(OA + o), bv = *(const unsigned*)(OB + o);
                    a0[h] = bf2f(av & 0xffffu); a1[h] = __uint_as_float(av & 0xffff0000u); b0[h] = bf2f(bv & 0xffffu); b1[h] = __uint_as_float(bv & 0xffff0000u);
                    red[h] = a0[h] + a1[h]; red[8 + h] = a0[h] * a0[h] + a1[h] * a1[h]; red[16 + h] = b0[h] * b0[h] + b1[h] * b1[h]; }
#pragma unroll
                for (int h = 0; h < 4; ++h) { const size_t o = (size_t)t * 1024 + h * 256 + 4 * lane; const v2u pw = *(const v2u*)(O12 + o), qw = *(const v2u*)(O12 + (size_t)T * 1024 + o);
                    const f32x4 p = {bf2f(pw.x & 0xffffu), __uint_as_float(pw.x & 0xffff0000u), bf2f(pw.y & 0xffffu), __uint_as_float(pw.y & 0xffff0000u)}, q = {bf2f(qw.x & 0xffffu), __uint_as_float(qw.x & 0xffff0000u), bf2f(qw.y & 0xffffu), __uint_as_float(qw.y & 0xffff0000u)};
                    dd[h] = p - q * lam; red[24 + h] = (dd[h][0] * dd[h][0] + dd[h][1] * dd[h][1]) + (dd[h][2] * dd[h][2] + dd[h][3] * dd[h][3]); }
#pragma unroll
                for (int o = 1; o < 64; o <<= 1) {
#pragma unroll
                    for (int i = 0; i < 28; ++i) red[i] += __shfl_xor(red[i], o); }
#pragma unroll
                for (int h = 0; h < 8; ++h) { const size_t o = (size_t)t * 1024 + h * 128 + 2 * lane; const unsigned gv = *(const unsigned*)(RG + o), zv = *(const unsigned*)(BZ + o);
                    const float mean = red[h] * (1.f / 128.f), var = fmaxf(red[8 + h] * (1.f / 128.f) - mean * mean, 0.f), rsa = rsqrtf(var + EPS), rsb = rsqrtf(red[16 + h] * (1.f / 128.f) + EPS);
                    *(unsigned*)(OCAT + (size_t)t * 3072 + h * 128 + 2 * lane) = pk2((a0[h] - mean) * rsa * bf2f(gv & 0xffffu), (a1[h] - mean) * rsa * __uint_as_float(gv & 0xffff0000u));
                    *(unsigned*)(OCAT + (size_t)t * 3072 + 1024 + h * 128 + 2 * lane) = pk2(b0[h] * rsb * gw0 * bf2f(zv & 0xffffu), b1[h] * rsb * gw1 * __uint_as_float(zv & 0xffff0000u)); }
#pragma unroll
                for (int h = 0; h < 4; ++h) { const float rstd = rsqrtf(red[24 + h] * (1.f / 256.f) + EPS) * (1.0f - lambda_init);
                    v2u ov; ov.x = pk2(dd[h][0] * rstd * dw[0], dd[h][1] * rstd * dw[1]); ov.y = pk2(dd[h][2] * rstd * dw[2], dd[h][3] * rstd * dw[3]); *(v2u*)(OCAT + (size_t)t * 3072 + 2048 + h * 256 + 4 * lane) = ov; }
            }
        }
        SEAM(pb + 3);
        if (IN(pb + 4)) {
            pg8::Gemm g{OCAT, WBR + (size_t)l * D * 3072, T, D, 3072}; pg8::StaticOrder S; S.init(T, D, F.G, (int)blockIdx.x);
            pg8::EpiBranch E{MERGEB, GATES, 16, 32};
            pg8::gemm_phase<pg8::EpiBranch, pg8::StaticOrder, true, true>(F.lds, g, S, E);
        }
        SEAM(pb + 4);
        if (IN(pb + 5)) {
            pg8::Gemm g{MERGEB, WOUT + (size_t)l * D * D, T, D, D}; pg8::StaticOrder S; S.init(T, D, F.G, (int)blockIdx.x);
            pg8::EpiResid E{xin, XRES, D, 1.f};
            pg8::gemm_phase<pg8::EpiResid, pg8::StaticOrder, true, true>(F.lds, g, S, E);
        }
        SEAM(pb + 5);
        if (IN(pb + 6)) { for (int r = F.gw; r < T; r += F.NGW) rms_row(XRES + (size_t)r * D, cross_norm_w + l * D, H + (size_t)r * D, F.lane); }
        SEAM(pb + 6);
        if (IN(pb + 7)) {
            pg8::Gemm g{H, WQ + (size_t)l * 512 * D, T, 512, 512, D}; pg8::SplitK4Order S{F.G, (int)blockIdx.x};
            pg8::EpiPart E{QP, 512, (size_t)T * 512};
            pg8::gemm_phase<pg8::EpiPart, pg8::SplitK4Order, true, true>(F.lds, g, S, E);
        }
        SEAM(pb + 7);
        if (IN(pb + 8)) {
            for (int it = F.vcu; it < 256; it += F.G) { const int hd = it >> 4, qt = it & 15, b = hd >> 2, hh = hd & 3;
                flash_item<128, 128, false, true, false, true>(F, (const bf16*)(QP + ((size_t)(b * SEQ + qt * 128)) * 512 + hh * 128), KX + ((size_t)l * 16 + hd) * MEML * 128, VXT + ((size_t)l * 16 + hd) * 128 * MEML, MEML, qt * 128, MEML, 0.f,
                                             nullptr, OX + ((size_t)(b * SEQ + qt * 128)) * 512 + hh * 128, 512); }
        }
        SEAM(pb + 8);
        if (IN(pb + 9)) {
            pg8::Gemm g{OX, WO + (size_t)l * D * 512, T, D, 512}; pg8::StaticOrder S; S.init(T, D, F.G, (int)blockIdx.x);
            pg8::EpiResid E{XRES, XRES, D, 1.f};
            pg8::gemm_phase<pg8::EpiResid, pg8::StaticOrder, true, true>(F.lds, g, S, E);
        }
        SEAM(pb + 9);
        if (IN(pb + 10)) {
            const int lane = F.lane; const float* w = ffn_norm_w + l * D;
            for (int r = F.gw; r < T; r += F.NGW) {
                const float* xrow = XRES + (size_t)r * D; f32x4 v[8]; float ss = 0.f;
#pragma unroll
                for (int j = 0; j < 8; ++j) { v[j] = *(const f32x4*)(xrow + 4 * (lane + 64 * j)); ss += (v[j][0] * v[j][0] + v[j][1] * v[j][1]) + (v[j][2] * v[j][2] + v[j][3] * v[j][3]); }
                const float rstd = rsqrtf(wave_sum(ss) * (1.f / D) + EPS);
                float lg[8];
#pragma unroll
                for (int e = 0; e < 8; ++e) lg[e] = 0.f;
#pragma unroll
                for (int j = 0; j < 8; ++j) { const f32x4 ww = *(const f32x4*)(w + 4 * (lane + 64 * j)); v[j] = v[j] * rstd * ww; }
                if (l == 1) {
#pragma unroll
                    for (int j = 0; j < 8; ++j)
#pragma unroll
                        for (int c = 0; c < 4; ++c) { const float* rw = router_w + (size_t)(4 * (lane + 64 * j) + c) * 8; const f32x4 r0 = *(const f32x4*)rw, r1 = *(const f32x4*)(rw + 4); const float yc = v[j][c];
                            lg[0] += yc * r0[0]; lg[1] += yc * r0[1]; lg[2] += yc * r0[2]; lg[3] += yc * r0[3]; lg[4] += yc * r1[0]; lg[5] += yc * r1[1]; lg[6] += yc * r1[2]; lg[7] += yc * r1[3]; } }
#pragma unroll
                for (int j = 0; j < 8; ++j) {
                    *(unsigned*)(H8 + (size_t)r * D + 4 * (lane + 64 * j)) = pg8::pk4_fp8(v[j][0], v[j][1], v[j][2], v[j][3]); }
                if (l == 1) {
#pragma unroll
                    for (int e = 0; e < 8; ++e) lg[e] = wave_sum(lg[e]);
                    int e0 = 0; float v0 = lg[0];
#pragma unroll
                    for (int e = 1; e < 8; ++e) if (lg[e] > v0) { v0 = lg[e]; e0 = e; }
                    int e1 = -1; float v1 = -__builtin_inff();
#pragma unroll
                    for (int e = 0; e < 8; ++e) if (e != e0 && lg[e] > v1) { v1 = lg[e]; e1 = e; }
                    if (lane == 0) { const float p0 = 1.0f / (1.0f + __expf(v1 - v0)); int* ro = ROUTE + (size_t)r * 8;
                        ro[0] = e0; ro[1] = e1; ro[2] = (int)atomicAdd(ctl + CW_CNT + e0, 1u); ro[3] = (int)atomicAdd(ctl + CW_CNT + e1, 1u); ((float*)ro)[4] = p0; ((float*)ro)[5] = 1.0f - p0; }
                }
            }
        }
        SEAM(pb + 10);
        if (l == 0) {
            if (IN(pb + 11)) {
                if ((int)blockIdx.x >= F.G - NCONV) conv_moe(F, expert_w_gu, expert_w_down, (unsigned char*)WEGU, (unsigned char*)WEDN, MOE_X1, MOE_X2, (int)blockIdx.x - (F.G - NCONV), NCONV);
                else {
                pg8::Gemm g{(const bf16*)H8, (const bf16*)WGU, T, 2 * DFF, D / 2}; pg8::StaticOrder S; S.init(T, 2 * DFF, F.G - NCONV, (int)blockIdx.x);
                pg8::EpiSwiglu E{ACT, DFF, 1 << 20, 1.0f / 256.f};
                pg8::gemm_phase<pg8::EpiSwiglu, pg8::StaticOrder, true, true, true>(F.lds, g, S, E); }
            }
            SEAM(pb + 11);
            if (IN(pb + 12)) {
                pg8::Gemm g{ACT, WDN, T, D, DFF}; pg8::StaticOrder S; S.init(T, D, F.G, (int)blockIdx.x);
                pg8::EpiResid E{XRES, XRES, D, 1.f};
                pg8::gemm_phase<pg8::EpiResid, pg8::StaticOrder, true, true>(F.lds, g, S, E);
            }
            SEAM(pb + 12);
            if (IN(pb + 13)) { for (int r = F.gw; r < T; r += F.NGW) rms_row(XRES + (size_t)r * D, mix_norm_w + D, H + (size_t)r * D, F.lane, H8 + (size_t)r * D); }
            SEAM(pb + 13);
        } else {
#define MOE_OFFSETS() int off[9]; off[0] = 0; _Pragma("unroll") for (int e = 0; e < 8; ++e) { const int c = __builtin_amdgcn_readfirstlane((int)__hip_atomic_load(ctl + CW_CNT + e, __ATOMIC_RELAXED, __HIP_MEMORY_SCOPE_AGENT)); off[e + 1] = off[e] + ((c + 255) & ~255); }
            if (IN(pb + 11)) {
                MOE_OFFSETS();
                for (int it = F.gw; it < T * 2; it += F.NGW) { const int t = it >> 1, k = it & 1; int* ro = ROUTE + (size_t)t * 8; const int e = ro[k], pos = ro[2 + k];
                    int base = 0;
#pragma unroll
                    for (int q = 0; q < 8; ++q) if (e == q) base = off[q];
                    const int slot = base + pos; if (F.lane == 0) ro[6 + k] = slot;
                    const v4u* src = (const v4u*)(H8 + (size_t)t * D); v4u* dst = (v4u*)((unsigned char*)HG + (size_t)slot * D);
#pragma unroll
                    for (int j = 0; j < 2; ++j) dst[F.lane + 64 * j] = src[F.lane + 64 * j]; }
#pragma unroll
                for (int e = 0; e < 8; ++e) { const int c = __builtin_amdgcn_readfirstlane((int)__hip_atomic_load(ctl + CW_CNT + e, __ATOMIC_RELAXED, __HIP_MEMORY_SCOPE_AGENT));
                    for (int rr = off[e] + c + F.gw; rr < off[e + 1]; rr += F.NGW) { v4u* dst = (v4u*)((unsigned char*)HG + (size_t)rr * D);
#pragma unroll
                        for (int j = 0; j < 2; ++j) dst[F.lane + 64 * j] = (v4u){0u, 0u, 0u, 0u}; } }
            }
            SEAM(pb + 11);
            if (IN(pb + 12)) {
                if (F.tid == 0) { MOE_OFFSETS(); int cu = 0;
#pragma unroll
                    for (int e = 0; e < 8; ++e) { const int ne = (off[e + 1] - off[e]) >> 8; MTAB[e] = ne; MTAB[8 + e] = off[e] >> 8; MTAB[16 + e] = cu; cu += ne * 56; } MTAB[24] = cu; MTAB[25] = cu; int cu8 = 0;
#pragma unroll
                    for (int e = 0; e < 8; ++e) { const int ne = (off[e + 1] - off[e]) >> 8; MTAB[32 + e] = ne; MTAB[40 + e] = off[e] >> 8; MTAB[48 + e] = cu8; cu8 += ne * 8; } MTAB[56] = cu8; MTAB[57] = cu8; }
                __syncthreads();
                { const int t8 = __builtin_amdgcn_readfirstlane(MTAB[57]), tu = 2 * F.G + ((int)blockIdx.x >> 2);
                  if (tu < t8) { int pm, pn; pg8::moe_map((const LAS int*)MTAB + 32, 8, tu, pm, pn); float* yt = Y + (size_t)(pm * 256 + ((int)blockIdx.x & 3) * 64) * D + (pn % 8) * 256;
                      for (int q = F.tid; q < 64 * 64; q += NWAVES * 64) *(f32x4*)(yt + (size_t)(q >> 6) * D + 4 * (q & 63)) = (f32x4){0.f, 0.f, 0.f, 0.f}; } }
                pg8::Gemm g{HG, WEGU, MAXSLOT, NEXP * 2 * EFF, D / 2}; pg8::MoeOrder S{(const LAS int*)MTAB, 56, F.G, (int)blockIdx.x};
                pg8::EpiSwiglu8 E{(unsigned char*)EACT, EFF, 56, 1.0f / 256.f, 8.f};
                pg8::gemm_phase<pg8::EpiSwiglu8, pg8::MoeOrder, true, true, true>(F.lds, g, S, E);
            }
            SEAM(pb + 12);
            if (IN(pb + 13)) {
                __syncthreads();
                if (F.tid == 0) { MOE_OFFSETS(); int cu = 0;
#pragma unroll
                    for (int e = 0; e < 8; ++e) { const int ne = (off[e + 1] - off[e]) >> 8; MTAB[e] = ne; MTAB[8 + e] = off[e] >> 8; MTAB[16 + e] = cu; cu += ne * 8; } MTAB[24] = cu; MTAB[25] = cu; }
                __syncthreads();
                { pg8::Gemm g{EACT, WEDN, MAXSLOT, NEXP * D, EFF / 2}; pg8::MoeOrder S{(const LAS int*)MTAB, 8, F.G, (int)blockIdx.x, 2 * F.G};
                  pg8::EpiStoreF32 E{Y, D, 8, 1.0f / 2048.f};
                  pg8::gemm_phase<pg8::EpiStoreF32, pg8::MoeOrder, true, true, true>(F.lds, g, S, E); }
                { pg8::Gemm g{EACT, WEDN, MAXSLOT, NEXP * D, EFF / 8, EFF / 2}; pg8::MoeTailOrder S{(const LAS int*)MTAB, 8, (int)blockIdx.x, 2 * F.G, EFF / 4};
                  pg8::EpiAtomicF32 E{Y, D, 8, 1.0f / 2048.f};
                  pg8::gemm_phase<pg8::EpiAtomicF32, pg8::MoeTailOrder, true, true, true>(F.lds, g, S, E); }
            }
            SEAM(pb + 13);
            if (IN(pb + 14)) {
                const int lane = F.lane;
                for (int r = F.gw; r < T; r += F.NGW) { const int* ro = ROUTE + (size_t)r * 8; const float p0 = ((const float*)ro)[4], p1 = ((const float*)ro)[5]; const float* y0 = Y + (size_t)ro[6] * D; const float* y1 = Y + (size_t)ro[7] * D;
                    const float* xrow = XRES + (size_t)r * D; f32x4 v[8]; float ss = 0.f;
#pragma unroll
                    for (int j = 0; j < 8; ++j) { const int o = 4 * (lane + 64 * j); v[j] = *(const f32x4*)(xrow + o) + *(const f32x4*)(y0 + o) * p0 + *(const f32x4*)(y1 + o) * p1; ss += (v[j][0] * v[j][0] + v[j][1] * v[j][1]) + (v[j][2] * v[j][2] + v[j][3] * v[j][3]); }
                    f32x4 fw[8];
#pragma unroll
                    for (int j = 0; j < 8; ++j) fw[j] = *(const f32x4*)(final_norm_w + 4 * (lane + 64 * j));
                    const float rstd = rsqrtf(wave_sum(ss) * (1.f / D) + EPS);
#pragma unroll
                    for (int j = 0; j < 8; ++j) { const int o = 4 * (lane + 64 * j); const f32x4 ww = fw[j]; *(f32x4*)(args.out + (size_t)r * D + o) = v[j] * rstd * ww; } }
            }
        }
    }
    { constexpr int l = 1;
        const int pb = 2 + l * NPL;
        const float lambda_init = l == 0 ? 0.2f : 0.35550906f;
        const float* xin = l == 0 ? x_in : XRES;
        if (IN(pb + 0)) {
            if ((int)blockIdx.x >= F.G - NCONV) conv_moe(F, expert_w_gu, expert_w_down, (unsigned char*)WEGU, (unsigned char*)WEDN, l == 0 ? MOE_X0 : MOE_X2, l == 0 ? MOE_X1 : MOE_ITEMS, (int)blockIdx.x - (F.G - NCONV), NCONV);
            else
            { pg8::Gemm g{H, WIN + (size_t)l * NINP * D, T, 45 * 256, D}; pg8::StaticOrder S; S.init(T, 45 * 256, F.G - NCONV, (int)blockIdx.x);
              pg8::EpiIn E{RQ, RK, RVT, RG, BQKV, BZ, CQ, CK, CVT, GATES, BBA, 0, 1.f};
              pg8::gemm_phase<pg8::EpiIn, pg8::StaticOrder, true, true>(F.lds, g, S, E); }
            { pg8::Gemm g{(const bf16*)H8, (const bf16*)(WIN8 + (size_t)l * 32 * 256 * D), T, 24 * 256, D / 2}; pg8::StaticOrder S; S.init(T, 24 * 256, F.G, (int)blockIdx.x);
              pg8::EpiIn E{RQ, RK, RVT, RG, BQKV, BZ, CQ, CK, CVT, GATES, BBA, 1, 1.0f / 256.f};
              pg8::gemm_phase<pg8::EpiIn, pg8::StaticOrder, true, true, true>(F.lds, g, S, E); }
        }
        SEAM(pb + 0);
        if (IN(pb + 1)) {
            const float* cw = conv_w + (size_t)l * 4 * 3072;
            { const int per = (1024 + F.G - 1) / F.G, lo_ = F.vcu * per, hi_ = lo_ + per < 1024 ? lo_ + per : 1024;
              for (int it = lo_; it < hi_; ++it) gdn_prep_item(F, l, it >> 5, it & 31, it == lo_ || (it & 31) == 0, BQKV, BBA, cw, a_log, dt_bias, ws + WS_GCH + (size_t)it * GDN_CH_BYTES, (float*)(ws + WS_GL) + it); }
        }
        SEAM(pb + 1);
        if (IN(pb + 2)) {
            const int bx = F.vcu;
            const int qw = 100 + l;
            if (bx >= 32 && bx < 48) {
                pg8::Gemm g2{MEMN + (size_t)l * MEMR * D, WKV + (size_t)l * 1024 * D, MEMR, 1024, D}; pg8::StaticOrder S2; S2.init(MEMR, 1024, F.G, bx - 32);
                pg8::EpiHeads E2{KX + (size_t)l * NB * 4 * MEML * 128, VXT + (size_t)l * NB * 4 * 128 * MEML, 4, 8, 2};
                pg8::gemm_phase<pg8::EpiHeads, pg8::StaticOrder, true, true>(F.lds, g2, S2, E2);
            }
            if (bx < 32) gdn_scan(F, bx, ws + WS_GCH, (const float*)(ws + WS_GL), OB);
            {
                volatile LAS int* qslot = (volatile LAS int*)(F.lds + MISC_OFF + 256);
                int nxt = 0; if (F.tid == 0) nxt = (int)atomicAdd(ctl + qw, 1u);
                for (;;) {
                    __syncthreads(); if (F.tid == 0) qslot[0] = nxt; __syncthreads();
                    const int it = __builtin_amdgcn_readfirstlane(qslot[0]); if (it >= 768) break;
                    if (F.tid == 0) nxt = (int)atomicAdd(ctl + qw, 1u);
                    const int v = it / 48, r = it % 48;
                    if (r < 32) { const int qt = 15 - v, hd = r, b = hd >> 3, hm = hd & 7, hh = hm >> 1, m = hm & 1; const float slope = exp2f(-2.0f * (float)(hh + 1));
                        flash_item<256, 128, true, true, false>(F, CQ + ((size_t)hd * SEQ + qt * 128) * 128, CK + (size_t)hd * SEQ * 128, CVT + (size_t)(b * 4 + hh) * 256 * SEQ, SEQ, qt * 128, SEQ, slope,
                                                            nullptr, O12 + ((size_t)m * T + b * SEQ + qt * 128) * 1024 + hh * 256, 1024); }
                    else { const int qt2 = 7 - (v >> 1), hd = (r - 32) + 16 * (v & 1), b = hd >> 3, hm = hd & 7; const float lg = log2f(1.0f - exp2f(-5.0f - (float)hm));
                        flash_ret(F, RQ + ((size_t)hd * SEQ + qt2 * 256) * 128, RK + (size_t)hd * SEQ * 128, RVT + (size_t)hd * 128 * SEQ, SEQ, qt2 * 256, lg, OA + ((size_t)(b * SEQ + qt2 * 256)) * 1024 + hm * 128, 1024); }
                }
            }
        }
        SEAM(pb + 2);
        if (IN(pb + 3)) {
            const int lane = F.lane;
            const float* lv = diff_lambda + (size_t)l * 512;
            const float d01 = wave_sum(lv[lane] * lv[128 + lane] + lv[64 + lane] * lv[192 + lane]), d23 = wave_sum(lv[256 + lane] * lv[384 + lane] + lv[320 + lane] * lv[448 + lane]);
            const float lam = __expf(d01) - __expf(d23) + lambda_init;
            const float gw0 = gdn_norm_w[l * 128 + 2 * lane], gw1 = gdn_norm_w[l * 128 + 2 * lane + 1]; const f32x4 dw = *(const f32x4*)(diff_norm_w + l * 256 + 4 * lane);
            for (int t = F.gw; t < T; t += F.NGW) {
                float a0[8], a1[8], b0[8], b1[8], red[28]; f32x4 dd[4];
#pragma unroll
                for (int h = 0; h < 8; ++h) { const size_t o = (size_t)t * 1024 + h * 128 + 2 * lane; const unsigned av = *(const unsigned*)(OA + o), bv = *(const unsigned*)(OB + o);
                    a0[h] = bf2f(av & 0xffffu); a1[h] = __uint_as_float(av & 0xffff0000u); b0[h] = bf2f(bv & 0xffffu); b1[h] = __uint_as_float(bv & 0xffff0000u);
                    red[h] = a0[h] + a1[h]; red[8 + h] = a0[h] * a0[h] + a1[h] * a1[h]; red[16 + h] = b0[h] * b0[h] + b1[h] * b1[h]; }
#pragma unroll
                for (int h = 0; h < 4; ++h) { const size_t o = (size_t)t * 1024 + h * 256 + 4 * lane; const v2u pw = *(const v2u*)(O12 + o), qw = *(const v2u*)(O12 + (size_t)T * 1024 + o);
                    const f32x4 p = {bf2f(pw.x & 0xffffu), __uint_as_float(pw.x & 0xffff0000u), bf2f(pw.y & 0xffffu), __uint_as_float(pw.y & 0xffff0000u)}, q = {bf2f(qw.x & 0xffffu), __uint_as_float(qw.x & 0xffff0000u), bf2f(qw.y & 0xffffu), __uint_as_float(qw.y & 0xffff0000u)};
                    dd[h] = p - q * lam; red[24 + h] = (dd[h][0] * dd[h][0] + dd[h][1] * dd[h][1]) + (dd[h][2] * dd[h][2] + dd[h][3] * dd[h][3]); }
#pragma unroll
                for (int o = 1; o < 64; o <<= 1) {
#pragma unroll
                    for (int i = 0; i < 28; ++i) red[i] += __shfl_xor(red[i], o); }
#pragma unroll
                for (int h = 0; h < 8; ++h) { const size_t o = (size_t)t * 1024 + h * 128 + 2 * lane; const unsigned gv = *(const unsigned*)(RG + o), zv = *(const unsigned*)(BZ + o);
                    const float mean = red[h] * (1.f / 128.f), var = fmaxf(red[8 + h] * (1.f / 128.f) - mean * mean, 0.f), rsa = rsqrtf(var + EPS), rsb = rsqrtf(red[16 + h] * (1.f / 128.f) + EPS);
                    *(unsigned*)(OCAT + (size_t)t * 3072 + h * 128 + 2 * lane) = pk2((a0[h] - mean) * rsa * bf2f(gv & 0xffffu), (a1[h] - mean) * rsa * __uint_as_float(gv & 0xffff0000u));
                    *(unsigned*)(OCAT + (size_t)t * 3072 + 1024 + h * 128 + 2 * lane) = pk2(b0[h] * rsb * gw0 * bf2f(zv & 0xffffu), b1[h] * rsb * gw1 * __uint_as_float(zv & 0xffff0000u)); }
#pragma unroll
                for (int h = 0; h < 4; ++h) { const float rstd = rsqrtf(red[24 + h] * (1.f / 256.f) + EPS) * (1.0f - lambda_init);
                    v2u ov; ov.x = pk2(dd[h][0] * rstd * dw[0], dd[h][1] * rstd * dw[1]); ov.y = pk2(dd[h][2] * rstd * dw[2], dd[h][3] * rstd * dw[3]); *(v2u*)(OCAT + (size_t)t * 3072 + 2048 + h * 256 + 4 * lane) = ov; }
            }
        }
        SEAM(pb + 3);
        if (IN(pb + 4)) {
            pg8::Gemm g{OCAT, WBR + (size_t)l * D * 3072, T, D, 3072}; pg8::StaticOrder S; S.init(T, D, F.G, (int)blockIdx.x);
            pg8::EpiBranch E{MERGEB, GATES, 16, 32};
            pg8::gemm_phase<pg8::EpiBranch, pg8::StaticOrder, true, true>(F.lds, g, S, E);
        }
        SEAM(pb + 4);
        if (IN(pb + 5)) {
            pg8::Gemm g{MERGEB, WOUT + (size_t)l * D * D, T, D, D}; pg8::StaticOrder S; S.init(T, D, F.G, (int)blockIdx.x);
            pg8::EpiResid E{xin, XRES, D, 1.f};
            pg8::gemm_phase<pg8::EpiResid, pg8::StaticOrder, true, true>(F.lds, g, S, E);
        }
        SEAM(pb + 5);
        if (IN(pb + 6)) { for (int r = F.gw; r < T; r += F.NGW) rms_row(XRES + (size_t)r * D, cross_norm_w + l * D, H + (size_t)r * D, F.lane); }
        SEAM(pb + 6);
        if (IN(pb + 7)) {
            pg8::Gemm g{H, WQ + (size_t)l * 512 * D, T, 512, 512, D}; pg8::SplitK4Order S{F.G, (int)blockIdx.x};
            pg8::EpiPart E{QP, 512, (size_t)T * 512};
            pg8::gemm_phase<pg8::EpiPart, pg8::SplitK4Order, true, true>(F.lds, g, S, E);
        }
        SEAM(pb + 7);
        if (IN(pb + 8)) {
            for (int it = F.vcu; it < 256; it += F.G) { const int hd = it >> 4, qt = it & 15, b = hd >> 2, hh = hd & 3;
                flash_item<128, 128, false, true, false, true>(F, (const bf16*)(QP + ((size_t)(b * SEQ + qt * 128)) * 512 + hh * 128), KX + ((size_t)l * 16 + hd) * MEML * 128, VXT + ((size_t)l * 16 + hd) * 128 * MEML, MEML, qt * 128, MEML, 0.f,
                                             nullptr, OX + ((size_t)(b * SEQ + qt * 128)) * 512 + hh * 128, 512); }
        }
        SEAM(pb + 8);
        if (IN(pb + 9)) {
            pg8::Gemm g{OX, WO + (size_t)l * D * 512, T, D, 512}; pg8::StaticOrder S; S.init(T, D, F.G, (int)blockIdx.x);
            pg8::EpiResid E{XRES, XRES, D, 1.f};
            pg8::gemm_phase<pg8::EpiResid, pg8::StaticOrder, true, true>(F.lds, g, S, E);
        }
        SEAM(pb + 9);
        if (IN(pb + 10)) {
            const int lane = F.lane; const float* w = ffn_norm_w + l * D;
            for (int r = F.gw; r < T; r += F.NGW) {
                const float* xrow = XRES + (size_t)r * D; f32x4 v[8]; float ss = 0.f;
#pragma unroll
                for (int j = 0; j < 8; ++j) { v[j] = *(const f32x4*)(xrow + 4 * (lane + 64 * j)); ss += (v[j][0] * v[j][0] + v[j][1] * v[j][1]) + (v[j][2] * v[j][2] + v[j][3] * v[j][3]); }
                const float rstd = rsqrtf(wave_sum(ss) * (1.f / D) + EPS);
                float lg[8];
#pragma unroll
                for (int e = 0; e < 8; ++e) lg[e] = 0.f;
#pragma unroll
                for (int j = 0; j < 8; ++j) { const f32x4 ww = *(const f32x4*)(w + 4 * (lane + 64 * j)); v[j] = v[j] * rstd * ww; }
                if (l == 1) {
#pragma unroll
                    for (int j = 0; j < 8; ++j)
#pragma unroll
                        for (int c = 0; c < 4; ++c) { const float* rw = router_w + (size_t)(4 * (lane + 64 * j) + c) * 8; const f32x4 r0 = *(const f32x4*)rw, r1 = *(const f32x4*)(rw + 4); const float yc = v[j][c];
                            lg[0] += yc * r0[0]; lg[1] += yc * r0[1]; lg[2] += yc * r0[2]; lg[3] += yc * r0[3]; lg[4] += yc * r1[0]; lg[5] += yc * r1[1]; lg[6] += yc * r1[2]; lg[7] += yc * r1[3]; } }
#pragma unroll
                for (int j = 0; j < 8; ++j) {
                    *(unsigned*)(H8 + (size_t)r * D + 4 * (lane + 64 * j)) = pg8::pk4_fp8(v[j][0], v[j][1], v[j][2], v[j][3]); }
                if (l == 1) {
#pragma unroll
                    for (int e = 0; e < 8; ++e) lg[e] = wave_sum(lg[e]);
                    int e0 = 0; float v0 = lg[0];
#pragma unroll
                    for (int e = 1; e < 8; ++e) if (lg[e] > v0) { v0 = lg[e]; e0 = e; }
                    int e1 = -1; float v1 = -__builtin_inff();
#pragma unroll
                    for (int e = 0; e < 8; ++e) if (e != e0 && lg[e] > v1) { v1 = lg[e]; e1 = e; }
                    if (lane == 0) { const float p0 = 1.0f / (1.0f + __expf(v1 - v0)); int* ro = ROUTE + (size_t)r * 8;
                        ro[0] = e0; ro[1] = e1; ro[2] = (int)atomicAdd(ctl + CW_CNT + e0, 1u); ro[3] = (int)atomicAdd(ctl + CW_CNT + e1, 1u); ((float*)ro)[4] = p0; ((float*)ro)[5] = 1.0f - p0; }
                }
            }
        }
        SEAM(pb + 10);
        if (l == 0) {
            if (IN(pb + 11)) {
                if ((int)blockIdx.x >= F.G - NCONV) conv_moe(F, expert_w_gu, expert_w_down, (unsigned char*)WEGU, (unsigned char*)WEDN, MOE_X1, MOE_X2, (int)blockIdx.x - (F.G - NCONV), NCONV);
                else {
                pg8::Gemm g{(const bf16*)H8, (const bf16*)WGU, T, 2 * DFF, D / 2}; pg8::StaticOrder S; S.init(T, 2 * DFF, F.G - NCONV, (int)blockIdx.x);
                pg8::EpiSwiglu E{ACT, DFF, 1 << 20, 1.0f / 256.f};
                pg8::gemm_phase<pg8::EpiSwiglu, pg8::StaticOrder, true, true, true>(F.lds, g, S, E); }
            }
            SEAM(pb + 11);
            if (IN(pb + 12)) {
                pg8::Gemm g{ACT, WDN, T, D, DFF}; pg8::StaticOrder S; S.init(T, D, F.G, (int)blockIdx.x);
                pg8::EpiResid E{XRES, XRES, D, 1.f};
                pg8::gemm_phase<pg8::EpiResid, pg8::StaticOrder, true, true>(F.lds, g, S, E);
            }
            SEAM(pb + 12);
            if (IN(pb + 13)) { for (int r = F.gw; r < T; r += F.NGW) rms_row(XRES + (size_t)r * D, mix_norm_w + D, H + (size_t)r * D, F.lane, H8 + (size_t)r * D); }
            SEAM(pb + 13);
        } else {
#define MOE_OFFSETS() int off[9]; off[0] = 0; _Pragma("unroll") for (int e = 0; e < 8; ++e) { const int c = __builtin_amdgcn_readfirstlane((int)__hip_atomic_load(ctl + CW_CNT + e, __ATOMIC_RELAXED, __HIP_MEMORY_SCOPE_AGENT)); off[e + 1] = off[e] + ((c + 255) & ~255); }
            if (IN(pb + 11)) {
                MOE_OFFSETS();
                for (int it = F.gw; it < T * 2; it += F.NGW) { const int t = it >> 1, k = it & 1; int* ro = ROUTE + (size_t)t * 8; const int e = ro[k], pos = ro[2 + k];
                    int base = 0;
#pragma unroll
                    for (int q = 0; q < 8; ++q) if (e == q) base = off[q];
                    const int slot = base + pos; if (F.lane == 0) ro[6 + k] = slot;
                    const v4u* src = (const v4u*)(H8 + (size_t)t * D); v4u* dst = (v4u*)((unsigned char*)HG + (size_t)slot * D);
#pragma unroll
                    for (int j = 0; j < 2; ++j) dst[F.lane + 64 * j] = src[F.lane + 64 * j]; }
#pragma unroll
                for (int e = 0; e < 8; ++e) { const int c = __builtin_amdgcn_readfirstlane((int)__hip_atomic_load(ctl + CW_CNT + e, __ATOMIC_RELAXED, __HIP_MEMORY_SCOPE_AGENT));
                    for (int rr = off[e] + c + F.gw; rr < off[e + 1]; rr += F.NGW) { v4u* dst = (v4u*)((unsigned char*)HG + (size_t)rr * D);
#pragma unroll
                        for (int j = 0; j < 2; ++j) dst[F.lane + 64 * j] = (v4u){0u, 0u, 0u, 0u}; } }
            }
            SEAM(pb + 11);
            if (IN(pb + 12)) {
                if (F.tid == 0) { MOE_OFFSETS(); int cu = 0;
#pragma unroll
                    for (int e = 0; e < 8; ++e) { const int ne = (off[e + 1] - off[e]) >> 8; MTAB[e] = ne; MTAB[8 + e] = off[e] >> 8; MTAB[16 + e] = cu; cu += ne * 56; } MTAB[24] = cu; MTAB[25] = cu; int cu8 = 0;
#pragma unroll
                    for (int e = 0; e < 8; ++e) { const int ne = (off[e + 1] - off[e]) >> 8; MTAB[32 + e] = ne; MTAB[40 + e] = off[e] >> 8; MTAB[48 + e] = cu8; cu8 += ne * 8; } MTAB[56] = cu8; MTAB[57] = cu8; }
                __syncthreads();
                { const int t8 = __builtin_amdgcn_readfirstlane(MTAB[57]), tu = 2 * F.G + ((int)blockIdx.x >> 2);
                  if (tu < t8) { int pm, pn; pg8::moe_map((const LAS int*)MTAB + 32, 8, tu, pm, pn); float* yt = Y + (size_t)(pm * 256 + ((int)blockIdx.x & 3) * 64) * D + (pn % 8) * 256;
                      for (int q = F.tid; q < 64 * 64; q += NWAVES * 64) *(f32x4*)(yt + (size_t)(q >> 6) * D + 4 * (q & 63)) = (f32x4){0.f, 0.f, 0.f, 0.f}; } }
                pg8::Gemm g{HG, WEGU, MAXSLOT, NEXP * 2 * EFF, D / 2}; pg8::MoeOrder S{(const LAS int*)MTAB, 56, F.G, (int)blockIdx.x};
                pg8::EpiSwiglu8 E{(unsigned char*)EACT, EFF, 56, 1.0f / 256.f, 8.f};
                pg8::gemm_phase<pg8::EpiSwiglu8, pg8::MoeOrder, true, true, true>(F.lds, g, S, E);
            }
            SEAM(pb + 12);
            if (IN(pb + 13)) {
                __syncthreads();
                if (F.tid == 0) { MOE_OFFSETS(); int cu = 0;
#pragma unroll
                    for (int e = 0; e < 8; ++e) { const int ne = (off[e + 1] - off[e]) >> 8; MTAB[e] = ne; MTAB[8 + e] = off[e] >> 8; MTAB[16 + e] = cu; cu += ne * 8; } MTAB[24] = cu; MTAB[25] = cu; }
                __syncthreads();
                { pg8::Gemm g{EACT, WEDN, MAXSLOT, NEXP * D, EFF / 2}; pg8::MoeOrder S{(const LAS int*)MTAB, 8, F.G, (int)blockIdx.x, 2 * F.G};
                  pg8::EpiStoreF32 E{Y, D, 8, 1.0f / 2048.f};
                  pg8::gemm_phase<pg8::EpiStoreF32, pg8::MoeOrder, true, true, true>(F.lds, g, S, E); }
                { pg8::Gemm g{EACT, WEDN, MAXSLOT, NEXP * D, EFF / 8, EFF / 2}; pg8::MoeTailOrder S{(const LAS int*)MTAB, 8, (int)blockIdx.x, 2 * F.G, EFF / 4};
                  pg8::EpiAtomicF32 E{Y, D, 8, 1.0f / 2048.f};
                  pg8::gemm_phase<pg8::EpiAtomicF32, pg8::MoeTailOrder, true, true, true>(F.lds, g, S, E); }
            }
            SEAM(pb + 13);
            if (IN(pb + 14)) {
                const int lane = F.lane;
                for (int r = F.gw; r < T; r += F.NGW) { const int* ro = ROUTE + (size_t)r * 8; const float p0 = ((const float*)ro)[4], p1 = ((const float*)ro)[5]; const float* y0 = Y + (size_t)ro[6] * D; const float* y1 = Y + (size_t)ro[7] * D;
                    const float* xrow = XRES + (size_t)r * D; f32x4 v[8]; float ss = 0.f;
#pragma unroll
                    for (int j = 0; j < 8; ++j) { const int o = 4 * (lane + 64 * j); v[j] = *(const f32x4*)(xrow + o) + *(const f32x4*)(y0 + o) * p0 + *(const f32x4*)(y1 + o) * p1; ss += (v[j][0] * v[j][0] + v[j][1] * v[j][1]) + (v[j][2] * v[j][2] + v[j][3] * v[j][3]); }
                    f32x4 fw[8];
#pragma unroll
                    for (int j = 0; j < 8; ++j) fw[j] = *(const f32x4*)(final_norm_w + 4 * (lane + 64 * j));
                    const float rstd = rsqrtf(wave_sum(ss) * (1.f / D) + EPS);
#pragma unroll
                    for (int j = 0; j < 8; ++j) { const int o = 4 * (lane + 64 * j); const f32x4 ww = fw[j]; *(f32x4*)(args.out + (size_t)r * D + o) = v[j] * rstd * ww; } }
            }
        }
    }
#undef IN
#undef SEAM
}

extern "C" void kernel_launch(void* const* d_in, const int* in_sizes, int n_in, void* d_out, int out_size, void* d_ws, size_t ws_size, hipStream_t stream) {
    static int grid = 0;
    if (grid == 0) {
        if (n_in != 24 || out_size != T * D || ws_size < WS_END) { fprintf(stderr, "kernel_launch: unexpected shapes (n_in %d, out %d, ws %zu < %zu)\n", n_in, out_size, ws_size, (size_t)WS_END); grid = -1; return; }
        int dev = 0, cus = 0, per_cu = 0;
        if (hipGetDevice(&dev) != hipSuccess || hipDeviceGetAttribute(&cus, hipDeviceAttributeMultiprocessorCount, dev) != hipSuccess) { grid = -1; return; }
        if (hipFuncSetAttribute((const void*)mk_fwd, hipFuncAttributeMaxDynamicSharedMemorySize, LDS_BYTES) != hipSuccess) { fprintf(stderr, "kernel_launch: hipFuncSetAttribute failed\n"); grid = -1; return; }
        if (hipOccupancyMaxActiveBlocksPerMultiprocessor(&per_cu, (const void*)mk_fwd, NWAVES * 64, LDS_BYTES) != hipSuccess || per_cu < 1) fprintf(stderr, "kernel_launch: occupancy query says %d\n", per_cu);
        (void)hipGetLastError();
        grid = cus;
    }
    if (grid < 0) return;
    (void)hipMemsetAsync((char*)d_ws + WS_CTL, 0, CTL_BYTES, stream);
    Args a{};
    for (int i = 0; i < 24; ++i) a.in[i] = d_in[i];
    a.out = (float*)d_out; a.ws = (unsigned char*)d_ws;
#if MK_ONE_LAUNCH
    a.ph_lo = 0; a.ph_hi = NPH;
    hipLaunchKernelGGL(mk_fwd, dim3(grid), dim3(NWAVES * 64), LDS_BYTES, stream, a);
#else
    for (int p = 0; p < NPH; ++p) { a.ph_lo = p; a.ph_hi = p + 1; hipLaunchKernelGGL(mk_fwd, dim3(grid), dim3(NWAVES * 64), LDS_BYTES, stream, a); }
#endif
}
```

```cpp
#include <hip/hip_runtime.h>
#include <cstdio>
#include <cstdint>
#define MK_ONE_LAUNCH 1
namespace pg8 {
#define PG8_LAS __attribute__((address_space(3)))
typedef unsigned short bf16_t;
typedef short bf16x8 __attribute__((ext_vector_type(8)));
typedef float f32x4 __attribute__((ext_vector_type(4)));
typedef unsigned u32x4 __attribute__((ext_vector_type(4)));
typedef int i32x4 __attribute__((ext_vector_type(4)));
constexpr int BM = 256, BK = 64, HALF = 128, HTB = HALF * BK * 2  , STAGE_BYTES = 8 * HTB, NXCD = 8, WGM = 8;

__host__ __device__ __forceinline__ int lds_byte(int r, int c) { const int st = (r >> 4) * 2 + (c >> 5), rr = r & 15, cc = c & 31, ob = rr * 64 + cc * 2; return st * 1024 + (ob ^ (((ob >> 9) & 1) << 5)); }
__host__ __device__ __forceinline__ void stage_rc(int b, int& R, int& C) { const int st = b / 1024, sb = b % 1024, swz = sb ^ (((sb >> 9) & 1) << 5); R = (st >> 1) * 16 + swz / 64; C = (st & 1) * 32 + (swz % 64) / 2; }
__host__ __device__ __forceinline__ int perm32(int rho) { const int n = rho >> 4, i = rho & 15; return 8 * (i >> 2) + 4 * n + (i & 3); }

struct Unit { int pm, pn; int ko = 0; };
struct Gemm { const bf16_t* A; const bf16_t* Bt; int M, N, K; int ldk = 0; };

struct StaticOrder {
    int nM, nN, nwg, G, c;
    __host__ __device__ void init(int M, int N, int G_, int c_) { nM = M / BM; nN = N / BM; nwg = nM * nN; G = G_; c = c_; }
    __host__ __device__ bool next(int i, Unit& u) const {
        const long L = (long)i * G + c; if (L >= nwg) return false;
        int wgid = (int)L; { const int q = nwg / NXCD, r = nwg % NXCD, xcd = wgid % NXCD, off = wgid / NXCD; wgid = (xcd < r ? xcd * (q + 1) : r * (q + 1) + (xcd - r) * q) + off; }
        const int nig = WGM * nN, gid = wgid / nig, fm = gid * WGM, gsz = (nM - fm) < WGM ? (nM - fm) : WGM;
        u.pm = fm + ((wgid % nig) % gsz); u.pn = (wgid % nig) / gsz; return true;
    }
    __device__ __forceinline__ void a_ready(const Unit&) const {}
    __device__ __forceinline__ void done(const Unit&) const {}
};

typedef float cvt_f32x2_t __attribute__((ext_vector_type(2))); typedef __bf16 cvt_bf16x2_t __attribute__((ext_vector_type(2)));
__device__ __forceinline__ unsigned cvt_pk_bf16(float lo, float hi) { const cvt_f32x2_t v = {lo, hi}; const cvt_bf16x2_t b = __builtin_convertvector(v, cvt_bf16x2_t); return __builtin_bit_cast(unsigned, b); }
typedef float f32x2 __attribute__((ext_vector_type(2)));
__device__ __forceinline__ float fsigm(float v) { return __builtin_amdgcn_rcpf(1.0f + __builtin_amdgcn_exp2f(-1.4426950408889634f * v)); }
__device__ __forceinline__ float fsilu(float v) { return v * fsigm(v); }
__device__ __forceinline__ void st8bf(bf16_t* p, f32x4 v0, f32x4 v1) { u32x4 w; w.x = cvt_pk_bf16(v0[0], v0[1]); w.y = cvt_pk_bf16(v0[2], v0[3]); w.z = cvt_pk_bf16(v1[0], v1[1]); w.w = cvt_pk_bf16(v1[2], v1[3]); __builtin_nontemporal_store(w, (u32x4*)p); }
__device__ __forceinline__ bf16_t f2bf1(float f) { unsigned u = __builtin_bit_cast(unsigned, f); return (bf16_t)((u + 0x7fffu + ((u >> 16) & 1u)) >> 16); }

struct EpiIn {
    static constexpr bool PERM = true, AFTER_DRAIN = false, HOOK = false;
    bf16_t *RQ, *RK, *RVT, *RG, *BQKV, *BZ, *CQ, *CK, *CVT, *GATES; float* BBA; int set; float sc8;
    __device__ __forceinline__ void operator()(const f32x4 (&acc_)[2][2][4][2], const Unit& u, int wr, int wc, int fr, int fq) const {
        f32x4 acc[2][2][4][2];
#pragma unroll
        for (int a_ = 0; a_ < 2; ++a_)
#pragma unroll
            for (int b_ = 0; b_ < 2; ++b_)
#pragma unroll
                for (int m_ = 0; m_ < 4; ++m_)
#pragma unroll
                    for (int n_ = 0; n_ < 2; ++n_) acc[a_][b_][m_][n_] = set ? acc_[a_][b_][m_][n_] * sc8 : acc_[a_][b_][m_][n_];
        const int lp = u.pn, pn = set == 0 ? (lp < 44 ? lp : 68) : lp + 44, b = u.pm >> 3;
        const int rowt = u.pm * BM + wr * 64 + fr;
        const int cin = wc * 32 + 8 * fq;
        if (pn < 8 || (pn >= 32 && pn < 40)) {
            auto heads = [&](bf16_t* base, int hb, float sc) __attribute__((always_inline)) {
#pragma unroll
                for (int ai = 0; ai < 2; ++ai)
#pragma unroll
                    for (int m = 0; m < 4; ++m) { const int s = (rowt + ai * HALF + m * 16) - b * 2048;
#pragma unroll
                        for (int bj = 0; bj < 2; ++bj) st8bf(base + ((size_t)((b * 8 + hb + bj) * 2048 + s)) * 128 + cin, acc[ai][bj][m][0] * sc, acc[ai][bj][m][1] * sc); } };
            if (pn < 4) heads(RQ, pn * 2, 1.f); else if (pn < 8) heads(RK, (pn - 4) * 2, 0.08838834764831845f);
            else if (pn < 36) heads(CQ, (pn - 32) * 2, 1.f); else heads(CK, (pn - 36) * 2, 1.f);
        } else if ((pn >= 40 && pn < 44) || (pn >= 8 && pn < 12)) {
            const bool isr = pn < 12; const int h = isr ? pn - 8 : pn - 40; bf16_t* CVT = isr ? RVT : this->CVT;
#pragma unroll
            for (int ai = 0; ai < 2; ++ai)
#pragma unroll
                for (int m = 0; m < 4; ++m) { const int s = (rowt + ai * HALF + m * 16) - b * 2048;
#pragma unroll
                    for (int bj = 0; bj < 2; ++bj)
#pragma unroll
                        for (int n = 0; n < 2; ++n)
#pragma unroll
                            for (int e = 0; e < 4; ++e) CVT[((size_t)((b * 4 + h) * 256 + bj * HALF + cin + 4 * n + e)) * 2048 + s] = f2bf1(acc[ai][bj][m][n][e]); }
        } else if (pn == 68) {
            if (wc == 0 && fq < 2) {
#pragma unroll
                for (int ai = 0; ai < 2; ++ai)
#pragma unroll
                    for (int m = 0; m < 4; ++m) { float* p = BBA + (size_t)(rowt + ai * HALF + m * 16) * 16 + 8 * fq; *(f32x4*)p = acc[ai][0][m][0]; *(f32x4*)(p + 4) = acc[ai][0][m][1]; }
            }
        } else {
            auto rows = [&](bf16_t* base, int ldc, int c0, int act) __attribute__((always_inline)) {
#pragma unroll
                for (int ai = 0; ai < 2; ++ai)
#pragma unroll
                    for (int m = 0; m < 4; ++m) { bf16_t* rowp = base + (size_t)(rowt + ai * HALF + m * 16) * ldc + c0 + cin;
#pragma unroll
                        for (int bj = 0; bj < 2; ++bj) { f32x4 v0 = acc[ai][bj][m][0], v1 = acc[ai][bj][m][1];
                            if (act == 1) {
#pragma unroll
                                for (int e = 0; e < 4; ++e) { v0[e] = fsilu(v0[e]); v1[e] = fsilu(v1[e]); } }
                            else if (act == 2) {
#pragma unroll
                                for (int e = 0; e < 4; ++e) { v0[e] = fsigm(v0[e]); v1[e] = fsigm(v1[e]); } }
                            st8bf(rowp + bj * HALF, v0, v1); } } };
            if (pn < 16) rows(RG, 1024, (pn - 12) * 256, 1); else if (pn < 28) rows(BQKV, 3072, (pn - 16) * 256, 0);
            else if (pn < 32) rows(BZ, 1024, (pn - 28) * 256, 1); else rows(GATES, 6144, (pn - 44) * 256, 2);
        }
    }
};

struct EpiHeads {
    static constexpr bool PERM = true, AFTER_DRAIN = false, HOOK = false;
    bf16_t* O; bf16_t* VT; int NH, rpb_shift  , vt_from_pn;
    __device__ __forceinline__ void operator()(const f32x4 (&acc)[2][2][4][2], const Unit& u, int wr, int wc, int fr, int fq) const {
        const int rowt = u.pm * BM + wr * 64 + fr, cin = wc * 32 + 8 * fq, rpb = 1 << rpb_shift;
        if (u.pn < vt_from_pn) {
#pragma unroll
            for (int ai = 0; ai < 2; ++ai)
#pragma unroll
                for (int m = 0; m < 4; ++m) { const int row = rowt + ai * HALF + m * 16, b = row >> rpb_shift, s = row & (rpb - 1);
#pragma unroll
                    for (int bj = 0; bj < 2; ++bj) st8bf(O + ((size_t)((b * NH + u.pn * 2 + bj) * rpb + s)) * 128 + cin, acc[ai][bj][m][0], acc[ai][bj][m][1]); }
        } else {
            const int hb = (u.pn - vt_from_pn) * 2;
#pragma unroll
            for (int ai = 0; ai < 2; ++ai)
#pragma unroll
                for (int m = 0; m < 4; ++m) { const int row = rowt + ai * HALF + m * 16, b = row >> rpb_shift, s = row & (rpb - 1);
#pragma unroll
                    for (int bj = 0; bj < 2; ++bj)
#pragma unroll
                        for (int n = 0; n < 2; ++n)
#pragma unroll
                            for (int e = 0; e < 4; ++e) VT[((size_t)((b * NH + hb + bj) * 128 + cin + 4 * n + e)) * rpb + s] = f2bf1(acc[ai][bj][m][n][e]); }
        }
    }
};

struct EpiResid {
    static constexpr bool PERM = false, AFTER_DRAIN = false, HOOK = false;
    const float* in; float* out; int ldc; float sc;
    __device__ __forceinline__ void operator()(const f32x4 (&acc)[2][2][4][2], const Unit& u, int wr, int wc, int fr, int fq) const {
        const int row0 = u.pm * BM + wr * 64 + fr, col0 = u.pn * BM + wc * 32 + 4 * fq;
        f32x4 x[2][2][2];
#pragma unroll
        for (int bj = 0; bj < 2; ++bj)
#pragma unroll
            for (int n = 0; n < 2; ++n) x[0][bj][n] = *(const f32x4*)(in + (size_t)row0 * ldc + col0 + bj * HALF + n * 16);
#pragma unroll
        for (int gidx = 0; gidx < 8; ++gidx) { const int ai = gidx >> 2, m = gidx & 3; const size_t off = (size_t)(row0 + ai * HALF + m * 16) * ldc + col0;
            if (gidx + 1 < 8) { const int ai2 = (gidx + 1) >> 2, m2 = (gidx + 1) & 3; const size_t off2 = (size_t)(row0 + ai2 * HALF + m2 * 16) * ldc + col0;
#pragma unroll
                for (int bj = 0; bj < 2; ++bj)
#pragma unroll
                    for (int n = 0; n < 2; ++n) x[(gidx + 1) & 1][bj][n] = *(const f32x4*)(in + off2 + bj * HALF + n * 16); }
#pragma unroll
            for (int bj = 0; bj < 2; ++bj)
#pragma unroll
                for (int n = 0; n < 2; ++n) *(f32x4*)(out + off + bj * HALF + n * 16) = x[gidx & 1][bj][n] + acc[ai][bj][m][n] * sc; }
    }
};

template <bool INF32>
struct EpiResidB {
    static constexpr bool PERM = true, AFTER_DRAIN = false, HOOK = false;
    const void* in; bf16_t* out; int ldc; float sc;
    __device__ __forceinline__ void ld8(f32x4 (&x)[2], size_t off) const {
        if (INF32) { const float* p = (const float*)in + off; x[0] = *(const f32x4*)p; x[1] = *(const f32x4*)(p + 4); }
        else { const u32x4 w = *(const u32x4*)((const bf16_t*)in + off);
            x[0][0] = __uint_as_float(w.x << 16); x[0][1] = __uint_as_float(w.x & 0xffff0000u); x[0][2] = __uint_as_float(w.y << 16); x[0][3] = __uint_as_float(w.y & 0xffff0000u);
            x[1][0] = __uint_as_float(w.z << 16); x[1][1] = __uint_as_float(w.z & 0xffff0000u); x[1][2] = __uint_as_float(w.w << 16); x[1][3] = __uint_as_float(w.w & 0xffff0000u); }
    }
    __device__ __forceinline__ void operator()(const f32x4 (&acc)[2][2][4][2], const Unit& u, int wr, int wc, int fr, int fq) const {
        const int row0 = u.pm * BM + wr * 64 + fr, col0 = u.pn * BM + wc * 32 + 8 * fq;
        f32x4 x[2][2][2];
#pragma unroll
        for (int bj = 0; bj < 2; ++bj) ld8(x[0][bj], (size_t)row0 * ldc + col0 + bj * HALF);
#pragma unroll
        for (int gidx = 0; gidx < 8; ++gidx) { const int ai = gidx >> 2, m = gidx & 3; const size_t off = (size_t)(row0 + ai * HALF + m * 16) * ldc + col0;
            if (gidx + 1 < 8) { const int ai2 = (gidx + 1) >> 2, m2 = (gidx + 1) & 3; const size_t off2 = (size_t)(row0 + ai2 * HALF + m2 * 16) * ldc + col0;
#pragma unroll
                for (int bj = 0; bj < 2; ++bj) ld8(x[(gidx + 1) & 1][bj], off2 + bj * HALF); }
#pragma unroll
            for (int bj = 0; bj < 2; ++bj) st8bf(out + off + bj * HALF, x[gidx & 1][bj][0] + acc[ai][bj][m][0] * sc, x[gidx & 1][bj][1] + acc[ai][bj][m][1] * sc); }
    }
};

struct EpiBranch {
    static constexpr bool PERM = false, AFTER_DRAIN = false, HOOK = true;
    bf16_t* OUT; const bf16_t* GATES; int hk0, hk1;
    typedef unsigned u32x2 __attribute__((ext_vector_type(2)));
    static __device__ __forceinline__ f32x4 g4(const bf16_t* p) { const u32x2 gw = *(const u32x2*)p; f32x4 g; g[0] = __uint_as_float(gw.x << 16); g[1] = __uint_as_float(gw.x & 0xffff0000u); g[2] = __uint_as_float(gw.y << 16); g[3] = __uint_as_float(gw.y & 0xffff0000u); return g; }
    __device__ __forceinline__ void hook(f32x4 (&acc)[2][2][4][2], const Unit& u, int s, int wr, int wc, int fr, int fq) const {
        int z_ = 0; asm volatile("" : "+v"(z_));
        const int row0 = u.pm * BM + wr * 64 + fr + z_, col0 = u.pn * BM + wc * 32 + 4 * fq;
#pragma unroll
        for (int ai = 0; ai < 2; ++ai)
#pragma unroll
            for (int mp = 0; mp < 2; ++mp) {
                u32x2 ga[2][2][2], gb[2][2][2];
#pragma unroll
                for (int mm = 0; mm < 2; ++mm) { const bf16_t* gp = GATES + (size_t)(row0 + ai * HALF + (2 * mp + mm) * 16) * 6144 + s * 2048 + col0;
#pragma unroll
                    for (int bj = 0; bj < 2; ++bj)
#pragma unroll
                        for (int n = 0; n < 2; ++n) { ga[mm][bj][n] = *(const u32x2*)(gp + bj * HALF + n * 16); gb[mm][bj][n] = *(const u32x2*)(gp + 2048 + bj * HALF + n * 16); } }
#pragma unroll
                for (int mm = 0; mm < 2; ++mm)
#pragma unroll
                    for (int bj = 0; bj < 2; ++bj)
#pragma unroll
                        for (int n = 0; n < 2; ++n) { const u32x2 a = ga[mm][bj][n], b = gb[mm][bj][n]; f32x4& v = acc[ai][bj][2 * mp + mm][n];
                            v[0] *= __uint_as_float(a.x << 16) * __builtin_amdgcn_rcpf(__builtin_fmaxf(__uint_as_float(b.x << 16), 1e-30f));
                            v[1] *= __uint_as_float(a.x & 0xffff0000u) * __builtin_amdgcn_rcpf(__builtin_fmaxf(__uint_as_float(b.x & 0xffff0000u), 1e-30f));
                            v[2] *= __uint_as_float(a.y << 16) * __builtin_amdgcn_rcpf(__builtin_fmaxf(__uint_as_float(b.y << 16), 1e-30f));
                            v[3] *= __uint_as_float(a.y & 0xffff0000u) * __builtin_amdgcn_rcpf(__builtin_fmaxf(__uint_as_float(b.y & 0xffff0000u), 1e-30f)); }
            }
    }
    __device__ __forceinline__ void operator()(const f32x4 (&acc)[2][2][4][2], const Unit& u, int wr, int wc, int fr, int fq) const {
        const int row0 = u.pm * BM + wr * 64 + fr, col0 = u.pn * BM + wc * 32 + 4 * fq;
        f32x4 gt[2][2][2];
#pragma unroll
        for (int bj = 0; bj < 2; ++bj)
#pragma unroll
            for (int n = 0; n < 2; ++n) gt[0][bj][n] = g4(GATES + (size_t)row0 * 6144 + 4096 + col0 + bj * HALF + n * 16);
#pragma unroll
        for (int gidx = 0; gidx < 8; ++gidx) { const int ai = gidx >> 2, m = gidx & 3, row = row0 + ai * HALF + m * 16;
            if (gidx + 1 < 8) { const int row2 = row0 + ((gidx + 1) >> 2) * HALF + ((gidx + 1) & 3) * 16;
#pragma unroll
                for (int bj = 0; bj < 2; ++bj)
#pragma unroll
                    for (int n = 0; n < 2; ++n) gt[(gidx + 1) & 1][bj][n] = g4(GATES + (size_t)row2 * 6144 + 4096 + col0 + bj * HALF + n * 16); }
#pragma unroll
            for (int bj = 0; bj < 2; ++bj)
#pragma unroll
                for (int n = 0; n < 2; ++n) { const f32x4 v = gt[gidx & 1][bj][n] * acc[ai][bj][m][n];
                    u32x2 w; w.x = cvt_pk_bf16(v[0], v[1]); w.y = cvt_pk_bf16(v[2], v[3]); *(u32x2*)(OUT + (size_t)row * 2048 + col0 + bj * HALF + n * 16) = w; } }
    }
};

struct EpiSwiglu {
    static constexpr bool PERM = true, AFTER_DRAIN = false, HOOK = false;
    bf16_t* O; int ldc, npn; float sc;
    __device__ __forceinline__ void operator()(const f32x4 (&acc)[2][2][4][2], const Unit& u, int wr, int wc, int fr, int fq) const {
        const int row0 = u.pm * BM + wr * 64 + fr, col0 = (u.pn % npn) * HALF + wc * 32 + 8 * fq;
#pragma unroll
        for (int ai = 0; ai < 2; ++ai)
#pragma unroll
            for (int m = 0; m < 4; ++m) { f32x4 v0, v1;
#pragma unroll
                for (int e = 0; e < 4; ++e) { v0[e] = fsilu(acc[ai][0][m][0][e] * sc) * (acc[ai][1][m][0][e] * sc); v1[e] = fsilu(acc[ai][0][m][1][e] * sc) * (acc[ai][1][m][1][e] * sc); }
                st8bf(O + (size_t)(row0 + ai * HALF + m * 16) * ldc + col0, v0, v1); }
    }
};


__device__ __forceinline__ float clamp8(float v) { return __builtin_fminf(__builtin_fmaxf(v, -448.f), 448.f); }
__device__ __forceinline__ unsigned pk4_fp8(float a, float b, float c, float d) { int r = 0; r = __builtin_amdgcn_cvt_pk_fp8_f32(clamp8(a), clamp8(b), r, false); r = __builtin_amdgcn_cvt_pk_fp8_f32(clamp8(c), clamp8(d), r, true); return (unsigned)r; }
struct EpiSwiglu8 {
    static constexpr bool PERM = true, AFTER_DRAIN = false, HOOK = false;
    unsigned char* O; int ldc, npn; float ws, as;
    __device__ __forceinline__ void operator()(const f32x4 (&acc)[2][2][4][2], const Unit& u, int wr, int wc, int fr, int fq) const {
        typedef unsigned u32x2 __attribute__((ext_vector_type(2)));
        const int row0 = u.pm * BM + wr * 64 + fr, col0 = (u.pn % npn) * HALF + wc * 32 + 8 * fq;
#pragma unroll
        for (int ai = 0; ai < 2; ++ai)
#pragma unroll
            for (int m = 0; m < 4; ++m) { float v[8];
#pragma unroll
                for (int n = 0; n < 2; ++n)
#pragma unroll
                    for (int e = 0; e < 4; ++e) v[4 * n + e] = fsilu(acc[ai][0][m][n][e] * ws) * (acc[ai][1][m][n][e] * ws) * as;
                u32x2 o; o.x = pk4_fp8(v[0], v[1], v[2], v[3]); o.y = pk4_fp8(v[4], v[5], v[6], v[7]);
                __builtin_nontemporal_store(o, (u32x2*)(O + (size_t)(row0 + ai * HALF + m * 16) * ldc + col0)); }
    }
};

struct EpiStoreF32 {
    static constexpr bool PERM = false, AFTER_DRAIN = false, HOOK = false;
    float* Y; int ldc, npn; float sc;
    __device__ __forceinline__ void operator()(const f32x4 (&acc)[2][2][4][2], const Unit& u, int wr, int wc, int fr, int fq) const {
        const int row0 = u.pm * BM + wr * 64 + fr, col0 = (u.pn % npn) * BM + wc * 32 + 4 * fq;
#pragma unroll
        for (int ai = 0; ai < 2; ++ai)
#pragma unroll
            for (int m = 0; m < 4; ++m) { float* rowp = Y + (size_t)(row0 + ai * HALF + m * 16) * ldc + col0;
#pragma unroll
                for (int bj = 0; bj < 2; ++bj)
#pragma unroll
                    for (int n = 0; n < 2; ++n) *(f32x4*)(rowp + bj * HALF + n * 16) = acc[ai][bj][m][n] * sc; }
    }
};

__device__ __forceinline__ void moe_map(const PG8_LAS int* T, int npn, int L, int& pm, int& pn) {
    auto rd = [&](int k) __attribute__((always_inline)) { return __builtin_amdgcn_readfirstlane(T[k]); };
    const int total = rd(25);
    int wgid = L; { const int q = total / NXCD, r = total % NXCD, xcd = wgid % NXCD, off = wgid / NXCD; wgid = (xcd < r ? xcd * (q + 1) : r * (q + 1) + (xcd - r) * q) + off; }
    int e = 0, cue = 0;
#pragma unroll
    for (int k = 1; k < 8; ++k) { const int ck = rd(16 + k); if (wgid >= ck) { e = k; cue = ck; } }
    const int loc = wgid - cue, ne = rd(e), r0 = rd(8 + e);
    pm = r0 + loc % ne; pn = e * npn + loc / ne;
}
struct MoeOrder {
    const PG8_LAS int* T; int npn, G, c; int cap = 1 << 30;
    __device__ __forceinline__ bool next(int i, Unit& u) const {
        const int total = __builtin_amdgcn_readfirstlane(T[25]); const long L = (long)i * G + c; if (L >= total || L >= cap) return false;
        moe_map(T, npn, (int)L, u.pm, u.pn); return true;
    }
    __device__ __forceinline__ void a_ready(const Unit&) const {}
    __device__ __forceinline__ void done(const Unit&) const {}
};
struct MoeTailOrder {
    const PG8_LAS int* T; int npn, c, base, kq;
    __device__ __forceinline__ bool next(int i, Unit& u) const {
        const int total = __builtin_amdgcn_readfirstlane(T[25]), t = c >> 2; if (i > 0 || base + t >= total) return false;
        moe_map(T, npn, base + t, u.pm, u.pn); u.ko = (c & 3) * kq; return true;
    }
    __device__ __forceinline__ void a_ready(const Unit&) const {}
    __device__ __forceinline__ void done(const Unit&) const {}
};
struct EpiTailPart {
    static constexpr bool PERM = false, AFTER_DRAIN = false, HOOK = false;
    float* P; int ldc, npn; float sc; int kq; size_t pstride;
    __device__ __forceinline__ void operator()(const f32x4 (&acc)[2][2][4][2], const Unit& u, int wr, int wc, int fr, int fq) const {
        const int row0 = u.pm * BM + wr * 64 + fr, col0 = (u.pn % npn) * BM + wc * 32 + 4 * fq; float* base = P + (size_t)(u.ko / kq) * pstride;
#pragma unroll
        for (int ai = 0; ai < 2; ++ai)
#pragma unroll
            for (int m = 0; m < 4; ++m) { float* rowp = base + (size_t)(row0 + ai * HALF + m * 16) * ldc + col0;
#pragma unroll
                for (int bj = 0; bj < 2; ++bj)
#pragma unroll
                    for (int n = 0; n < 2; ++n) *(f32x4*)(rowp + bj * HALF + n * 16) = acc[ai][bj][m][n] * sc; }
    }
};

struct SegOrder {
    int nM, nN, nseg, G, c;
    __device__ __forceinline__ bool next(int i, Unit& u) const {
        const int nwg = nM * nN; const long L = (long)i * G + c; if (L >= (long)nseg * nwg) return false;
        const int s = (int)(L / nwg); int wgid = (int)(L % nwg); { const int q = nwg / NXCD, r = nwg % NXCD, xcd = wgid % NXCD, off = wgid / NXCD; wgid = (xcd < r ? xcd * (q + 1) : r * (q + 1) + (xcd - r) * q) + off; }
        const int nig = WGM * nN, gid = wgid / nig, fm = gid * WGM, gsz = (nM - fm) < WGM ? (nM - fm) : WGM;
        u.pm = s * nM + fm + ((wgid % nig) % gsz); u.pn = s * nN + (wgid % nig) / gsz; return true;
    }
    __device__ __forceinline__ void a_ready(const Unit&) const {}
    __device__ __forceinline__ void done(const Unit&) const {}
};

struct SplitK4Order {
    int G, c;
    __device__ __forceinline__ bool next(int i, Unit& u) const {
        const long L = (long)i * G + c; if (L >= 256) return false;
        const int x = (int)L & 7, y = (int)L >> 3;
        u.pm = 4 * x + (y & 3); u.pn = (y >> 2) & 1; u.ko = (y >> 3) * 1024; return true;
    }
    __device__ __forceinline__ void a_ready(const Unit&) const {}
    __device__ __forceinline__ void done(const Unit&) const {}
};
struct EpiPart {
    static constexpr bool PERM = false, AFTER_DRAIN = false, HOOK = false;
    float* P; int ldc; size_t pstride;
    __device__ __forceinline__ void operator()(const f32x4 (&acc)[2][2][4][2], const Unit& u, int wr, int wc, int fr, int fq) const {
        const int row0 = u.pm * BM + wr * 64 + fr, col0 = u.pn * BM + wc * 32 + 4 * fq; float* base = P + (size_t)(u.ko >> 10) * pstride;
#pragma unroll
        for (int ai = 0; ai < 2; ++ai)
#pragma unroll
            for (int m = 0; m < 4; ++m) { float* rowp = base + (size_t)(row0 + ai * HALF + m * 16) * ldc + col0;
#pragma unroll
                for (int bj = 0; bj < 2; ++bj)
#pragma unroll
                    for (int n = 0; n < 2; ++n) *(f32x4*)(rowp + bj * HALF + n * 16) = acc[ai][bj][m][n]; }
    }
};
template <class Epi, class Sched, bool ALIGN_EPI = false, bool SP2 = false, bool F8 = false>
__device__ __forceinline__ void gemm_phase(PG8_LAS unsigned char* lds, const Gemm g, const Sched& S, const Epi& E) {
    int tid_ = threadIdx.x; asm volatile("" : "+v"(tid_)); const int tid = tid_, wid = __builtin_amdgcn_readfirstlane(tid >> 6), lane = tid & 63, wr = wid >> 2, wc = wid & 3, fr = lane & 15, fq = lane >> 4;
    const int K = g.K, LDK = g.ldk ? g.ldk : g.K, nt = K / BK; typedef int i32x8 __attribute__((ext_vector_type(8))); int f8scale_ = 0x7f7f7f7f; asm volatile("" : "+v"(f8scale_));
    unsigned voffA[2], voffB[2];
#pragma unroll
    for (int i = 0; i < 2; ++i) { int R, C; stage_rc(tid * 16 + i * 8192, R, C); const int Rb = Epi::PERM ? ((R & ~31) + perm32(R & 31)) : R;
        voffA[i] = (unsigned)(R * LDK + C) * 2u; voffB[i] = (unsigned)(Rb * LDK + C) * 2u; }
    const size_t kstep = (size_t)(BK * 2);
    const size_t hstep = (size_t)HALF * LDK * 2;
    const size_t tstep = 2 * hstep;
    const unsigned ldsw = (unsigned)wid * 1024u;
    const int aoff = lds_byte(wr * 64 + fr, fq * 8), boff = lds_byte(wc * 32 + fr, fq * 8);
#define PG8_SA(b, h) (((b) * 2 + (h)) * HTB)
#define PG8_SB(b, h) ((4 + (b) * 2 + (h)) * HTB)
#define PG8_STAGE(bufoff, gbase, voff) do { _Pragma("unroll") for (int _i = 0; _i < 2; ++_i) \
        __builtin_amdgcn_global_load_lds((const unsigned*)((const char*)(gbase) + (voff)[_i]), (PG8_LAS unsigned*)(lds + (bufoff) + ldsw + _i * 8192), 16, 0, 0); } while (0)
#define PG8_LDA(dst, b, h) do { _Pragma("unroll") for (int m = 0; m < 4; ++m) _Pragma("unroll") for (int k = 0; k < 2; ++k) dst[m][k] = *(const PG8_LAS bf16x8*)(lds + PG8_SA(b, h) + aoff + m * 2048 + k * 1024); } while (0)
#define PG8_LDB(dst, b, h) do { _Pragma("unroll") for (int n = 0; n < 2; ++n) _Pragma("unroll") for (int k = 0; k < 2; ++k) dst[n][k] = *(const PG8_LAS bf16x8*)(lds + PG8_SB(b, h) + boff + n * 2048 + k * 1024); } while (0)
#define PG8_MMA(ai, bj, At, Bt) do { __builtin_amdgcn_s_setprio(1); \
        if constexpr (F8) { _Pragma("unroll") for (int m = 0; m < 4; ++m) _Pragma("unroll") for (int n = 0; n < 2; ++n) { \
            const i32x4 b0_ = __builtin_bit_cast(i32x4, Bt[n][0]), b1_ = __builtin_bit_cast(i32x4, Bt[n][1]), a0_ = __builtin_bit_cast(i32x4, At[m][0]), a1_ = __builtin_bit_cast(i32x4, At[m][1]); \
            const i32x8 bb_ = __builtin_shufflevector(b0_, b1_, 0, 1, 2, 3, 4, 5, 6, 7), aa_ = __builtin_shufflevector(a0_, a1_, 0, 1, 2, 3, 4, 5, 6, 7); \
            asm volatile("v_mfma_scale_f32_16x16x128_f8f6f4 %0, %1, %2, %0, %3, %3 op_sel_hi:[0,0,0]" : "+v"(acc[ai][bj][m][n]) : "v"(bb_), "v"(aa_), "v"(f8scale_)); } } \
        else { _Pragma("unroll") for (int m = 0; m < 4; ++m) _Pragma("unroll") for (int n = 0; n < 2; ++n) _Pragma("unroll") for (int k = 0; k < 2; ++k) \
        acc[ai][bj][m][n] = __builtin_amdgcn_mfma_f32_16x16x32_bf16(Bt[n][k], At[m][k], acc[ai][bj][m][n], 0, 0, 0); } __builtin_amdgcn_s_setprio(0); } while (0)
#define PG8_WAIT_V(n) asm volatile("s_waitcnt vmcnt(" #n ")" ::: "memory")
#define PG8_WAIT_L(n) asm volatile("s_waitcnt lgkmcnt(" #n ")" ::: "memory")
#define PG8_BAR __builtin_amdgcn_s_barrier()
#define PG8_SCHED __builtin_amdgcn_sched_barrier(0)
    Unit cur, nxt; int ui = 0;
    if (!S.next(0, cur)) return;
    f32x4 acc[2][2][4][2];
#pragma unroll
    for (int a = 0; a < 2; ++a)
#pragma unroll
        for (int b = 0; b < 2; ++b)
#pragma unroll
            for (int m = 0; m < 4; ++m)
#pragma unroll
                for (int n = 0; n < 2; ++n) acc[a][b][m][n] = (f32x4){0.f, 0.f, 0.f, 0.f};
    bf16x8 At[4][2], B0[2][2], B1[2][2];
    const char* cA = (const char*)g.A + (size_t)cur.pm * tstep + cur.ko; const char* cB = (const char*)g.Bt + (size_t)cur.pn * tstep + cur.ko;
    S.a_ready(cur);
    if constexpr (SP2) {
        PG8_STAGE(PG8_SB(0, 0), cB, voffB); PG8_STAGE(PG8_SB(0, 1), cB + hstep, voffB); PG8_STAGE(PG8_SA(0, 0), cA, voffA); PG8_STAGE(PG8_SA(0, 1), cA + hstep, voffA);
        if (wr == 1) PG8_BAR;
        PG8_WAIT_V(2); PG8_BAR;
        PG8_STAGE(PG8_SB(1, 0), cB + kstep, voffB); PG8_STAGE(PG8_SA(1, 0), cA + kstep, voffA); PG8_STAGE(PG8_SB(1, 1), cB + hstep + kstep, voffB);
        PG8_WAIT_V(6); PG8_BAR;
    } else {
        PG8_STAGE(PG8_SB(0, 0), cB, voffB); PG8_STAGE(PG8_SA(0, 0), cA, voffA); PG8_STAGE(PG8_SB(0, 1), cB + hstep, voffB); PG8_STAGE(PG8_SA(0, 1), cA + hstep, voffA);
        if (wr == 1) PG8_BAR;
        PG8_WAIT_V(4); PG8_BAR;
        PG8_STAGE(PG8_SB(1, 0), cB + kstep, voffB); PG8_STAGE(PG8_SA(1, 0), cA + kstep, voffA); PG8_STAGE(PG8_SB(1, 1), cB + hstep + kstep, voffB);
        PG8_WAIT_V(6); PG8_BAR;
    }
    for (;;) {
        const bool has_next = S.next(ui + 1, nxt);
        const char* nA = has_next ? (const char*)g.A + (size_t)nxt.pm * tstep + nxt.ko : cA; const char* nB = has_next ? (const char*)g.Bt + (size_t)nxt.pn * tstep + nxt.ko : cB;
        for (int t = 0; t < nt; t += 2) {
            const bool last = (t == nt - 2);
            const char* a1 = cA + (size_t)(t + 1) * kstep;
            const char* a2 = last ? nA : cA + (size_t)(t + 2) * kstep; const char* b2 = last ? nB : cB + (size_t)(t + 2) * kstep;
            const char* a3 = a2 + kstep; const char* b3 = b2 + kstep;
            if (last && has_next) S.a_ready(nxt);
            if constexpr (Epi::HOOK) { if (t == E.hk0 || t == E.hk1) E.hook(acc, cur, t == E.hk0 ? 0 : 1, wr, wc, fr, fq); }
            if constexpr (SP2) {
            PG8_LDB(B0, 0, 0); PG8_LDB(B1, 0, 1); PG8_SCHED; PG8_LDA(At, 0, 0); PG8_STAGE(PG8_SA(1, 1), a1 + hstep, voffA);
            PG8_WAIT_V(8); PG8_WAIT_L(0); PG8_BAR; PG8_MMA(0, 0, At, B0); PG8_MMA(0, 1, At, B1); PG8_BAR; PG8_SCHED;
            PG8_LDA(At, 0, 1); PG8_STAGE(PG8_SB(0, 0), b2, voffB); PG8_STAGE(PG8_SB(0, 1), b2 + hstep, voffB); PG8_STAGE(PG8_SA(0, 0), a2, voffA);
            PG8_WAIT_V(8); PG8_WAIT_L(0); PG8_BAR; PG8_MMA(1, 0, At, B0); PG8_MMA(1, 1, At, B1); PG8_BAR; PG8_SCHED;
            PG8_LDB(B0, 1, 0); PG8_LDB(B1, 1, 1); PG8_SCHED; PG8_LDA(At, 1, 0); PG8_STAGE(PG8_SA(0, 1), a2 + hstep, voffA);
            PG8_WAIT_V(8); PG8_WAIT_L(0); PG8_BAR; PG8_MMA(0, 0, At, B0); PG8_MMA(0, 1, At, B1); PG8_BAR; PG8_SCHED;
            PG8_LDA(At, 1, 1); PG8_STAGE(PG8_SB(1, 0), b3, voffB); PG8_STAGE(PG8_SB(1, 1), b3 + hstep, voffB); PG8_STAGE(PG8_SA(1, 0), a3, voffA);
            PG8_WAIT_V(8); PG8_WAIT_L(0); PG8_BAR; PG8_MMA(1, 0, At, B0); PG8_MMA(1, 1, At, B1); PG8_BAR; PG8_SCHED;
            } else {
            PG8_LDB(B0, 0, 0); PG8_SCHED; PG8_LDA(At, 0, 0); PG8_STAGE(PG8_SA(1, 1), a1 + hstep, voffA);
            PG8_WAIT_L(8); PG8_BAR; PG8_WAIT_L(0); PG8_MMA(0, 0, At, B0); PG8_BAR; PG8_SCHED;
            PG8_LDB(B1, 0, 1); PG8_STAGE(PG8_SB(0, 0), b2, voffB);
            PG8_BAR; PG8_WAIT_L(0); PG8_MMA(0, 1, At, B1); PG8_BAR;
            PG8_LDA(At, 0, 1); PG8_STAGE(PG8_SA(0, 0), a2, voffA);
            PG8_BAR; PG8_WAIT_L(0); PG8_MMA(1, 0, At, B0); PG8_BAR; PG8_SCHED;
            PG8_STAGE(PG8_SB(0, 1), b2 + hstep, voffB);
            PG8_WAIT_V(6); PG8_BAR; PG8_MMA(1, 1, At, B1); PG8_BAR;
            PG8_LDB(B0, 1, 0); PG8_SCHED; PG8_LDA(At, 1, 0); PG8_STAGE(PG8_SA(0, 1), a2 + hstep, voffA);
            PG8_WAIT_L(8); PG8_BAR; PG8_WAIT_L(0); PG8_MMA(0, 0, At, B0); PG8_BAR; PG8_SCHED;
            PG8_LDB(B1, 1, 1); PG8_STAGE(PG8_SB(1, 0), b3, voffB);
            PG8_BAR; PG8_WAIT_L(0); PG8_MMA(0, 1, At, B1); PG8_BAR;
            PG8_LDA(At, 1, 1); PG8_STAGE(PG8_SA(1, 0), a3, voffA);
            PG8_BAR; PG8_WAIT_L(0); PG8_MMA(1, 0, At, B0); PG8_BAR; PG8_SCHED;
            PG8_STAGE(PG8_SB(1, 1), b3 + hstep, voffB);
            PG8_WAIT_V(6); PG8_BAR; PG8_MMA(1, 1, At, B1); PG8_BAR;
            }
        }
        if constexpr (ALIGN_EPI) { if (wr == 0) PG8_BAR; }
        if constexpr (F8) { __builtin_amdgcn_sched_barrier(0); asm volatile("s_nop 15\n\ts_nop 15" ::: "memory"); __builtin_amdgcn_sched_barrier(0); }
        if constexpr (!Epi::AFTER_DRAIN) { E(acc, cur, wr, wc, fr, fq); S.done(cur); }
        if (!has_next) break;
#pragma unroll
        for (int a = 0; a < 2; ++a)
#pragma unroll
            for (int b = 0; b < 2; ++b)
#pragma unroll
                for (int m = 0; m < 4; ++m)
#pragma unroll
                    for (int n = 0; n < 2; ++n) acc[a][b][m][n] = (f32x4){0.f, 0.f, 0.f, 0.f};
        cur = nxt; cA = nA; cB = nB; ++ui;
        if constexpr (ALIGN_EPI) { if (wr == 1) PG8_BAR; }
    }
    PG8_WAIT_V(0);
    if constexpr (!ALIGN_EPI) { if (wr == 0) PG8_BAR; }
    PG8_BAR;
    if constexpr (Epi::AFTER_DRAIN) { E.fused(acc, cur, wr, wc, fr, fq, lds, wid, lane); S.done(cur); }
#undef PG8_SA
#undef PG8_SB
#undef PG8_STAGE
#undef PG8_LDA
#undef PG8_LDB
#undef PG8_MMA
#undef PG8_WAIT_V
#undef PG8_WAIT_L
#undef PG8_BAR
#undef PG8_SCHED
}
}
#ifndef MK_ONE_LAUNCH
#define MK_ONE_LAUNCH 0
#endif
constexpr int NWAVES = 8;
constexpr int NB = 4, SEQ = 2048, T = NB * SEQ, D = 2048, MEML = 256, MEMR = NB * MEML;
constexpr int NINP = 17664;
constexpr int DFF = 5632, EFF = 7168, NEXP = 8, MAXSLOT = 18432;
constexpr float EPS = 1e-6f;
constexpr int NPL = 15, NPH = 2 + 2 * NPL;

constexpr size_t MiB = 1u << 20;
constexpr size_t WS_CTL = 0, CTL_BYTES = 1 * MiB;
constexpr size_t WS_WIN = WS_CTL + CTL_BYTES;
constexpr size_t WS_WBR = WS_WIN + 2 * 69 * MiB;
constexpr size_t WS_WOUT = WS_WBR + 2 * 12 * MiB;
constexpr size_t WS_WQ = WS_WOUT + 2 * 8 * MiB;
constexpr size_t WS_WKV = WS_WQ + 2 * 2 * MiB;
constexpr size_t WS_WO = WS_WKV + 2 * 4 * MiB;
constexpr size_t WS_WGU = WS_WO + 2 * 2 * MiB;
constexpr size_t WS_WDN = WS_WGU + 44 * MiB;
constexpr size_t WS_WEGU = WS_WDN + 22 * MiB;
constexpr size_t WS_WEDN = WS_WEGU + 448 * MiB;
constexpr size_t WS_XRES = WS_WEDN + 224 * MiB;
constexpr size_t WS_H = WS_XRES + 64 * MiB;
constexpr size_t WS_RQ = WS_H + 32 * MiB, WS_RK = WS_RQ + 16 * MiB, WS_RV = WS_RK + 16 * MiB, WS_RG = WS_RV + 16 * MiB;
constexpr size_t WS_BQKV = WS_RG + 16 * MiB;
constexpr size_t WS_BZ = WS_BQKV + 48 * MiB;
constexpr size_t WS_BBA = WS_BZ + 16 * MiB;
constexpr size_t WS_CQ = WS_BBA + 1 * MiB, WS_CK = WS_CQ + 16 * MiB, WS_CVT = WS_CK + 16 * MiB;
constexpr size_t WS_GATES = WS_CVT + 16 * MiB;
constexpr size_t WS_GQ = WS_GATES + 96 * MiB, WS_GK = WS_GQ + 16 * MiB, WS_GV = WS_GK + 16 * MiB;
constexpr size_t WS_GG = WS_GV + 16 * MiB, WS_GB = WS_GG + 1 * MiB;
constexpr size_t WS_OA = WS_GB + 1 * MiB, WS_OB = WS_OA + 32 * MiB;
constexpr size_t WS_O12 = WS_OB + 32 * MiB;
constexpr size_t WS_OCAT = WS_O12 + 64 * MiB;
constexpr size_t WS_MERGE = WS_OCAT + 48 * MiB;
constexpr size_t WS_MERGEB = WS_MERGE + 64 * MiB;
constexpr size_t WS_MEMN = WS_MERGEB + 32 * MiB;
constexpr size_t WS_KX = WS_MEMN + 8 * MiB;
constexpr size_t WS_VXT = WS_KX + 2 * MiB;
constexpr size_t WS_QX = WS_VXT + 2 * MiB;
constexpr size_t WS_OX = WS_QX + 8 * MiB;
constexpr size_t WS_ACT = WS_OX + 8 * MiB;
constexpr size_t WS_HG = WS_ACT + 88 * MiB;
constexpr size_t WS_EACT = WS_HG + 72 * MiB;
constexpr size_t WS_Y = WS_EACT + 252 * MiB;
constexpr size_t WS_ROUTE = WS_Y + 144 * MiB;
constexpr size_t WS_GCH = WS_ROUTE + 1 * MiB;
constexpr size_t WS_GL = WS_GCH + 88 * MiB;
constexpr size_t WS_H8 = WS_GL + 1 * MiB;
constexpr size_t WS_WIN8 = WS_H8 + 16 * MiB;
constexpr size_t WS_YP = WS_WIN8 + 32 * MiB;
constexpr size_t WS_END = WS_YP + 4 * 144 * MiB;
constexpr int CW_CNT = 64;
constexpr int CW_BAR = 4096;

constexpr int RING_BYTES = 131072, MISC_OFF = RING_BYTES + 8192 + 320, LDS_BYTES = 147456;

#define GAS __attribute__((address_space(1)))
#define LAS __attribute__((address_space(3)))
#define DI __device__ __forceinline__
typedef unsigned short bf16;
typedef unsigned v4u __attribute__((ext_vector_type(4)));
typedef unsigned v2u __attribute__((ext_vector_type(2)));
typedef float f32x4 __attribute__((ext_vector_type(4)));
typedef short bf16x8 __attribute__((ext_vector_type(8)));
typedef short s16x4 __attribute__((ext_vector_type(4)));
DI float bf2f(unsigned v) { return __uint_as_float(v << 16); }
DI unsigned f2bf(float f) { unsigned u = __builtin_bit_cast(unsigned, f); return (u + 0x7fffu + ((u >> 16) & 1u)) >> 16; }
typedef float f32x2_t __attribute__((ext_vector_type(2))); typedef __bf16 bf16x2_t __attribute__((ext_vector_type(2)));
DI unsigned pk2(float lo, float hi) { const f32x2_t v = {lo, hi}; const bf16x2_t b = __builtin_convertvector(v, bf16x2_t); return __builtin_bit_cast(unsigned, b); }
DI float wave_sum(float v) {
#pragma unroll
    for (int o = 1; o < 64; o <<= 1) v += __shfl_xor(v, o);
    return v;
}

#define XB_TMO      128
#define XB_XCNT(j)  (256  + 64 * (j))
#define XB_XSUB(j)  (1280 + 64 * (j))
#define XB_XGEN(j)  (2304 + 64 * (j))
#define XB_TOP      3328
#define XB_TOPGEN   3392
#define XCD_BAR_WORDS 3456
#define XB_SPIN_CAP (1u << 18)

__device__ __forceinline__ unsigned xb_ld(unsigned* p)              { return __hip_atomic_load(p, __ATOMIC_RELAXED, __HIP_MEMORY_SCOPE_AGENT); }
__device__ __forceinline__ unsigned xb_add(unsigned* p, unsigned v) { return __hip_atomic_fetch_add(p, v, __ATOMIC_RELAXED, __HIP_MEMORY_SCOPE_AGENT); }
__device__ __forceinline__ unsigned xb_xcc_id() { return (unsigned)__builtin_amdgcn_s_getreg((3 << 11) | 20) & 0xFu; }
#define XB_SPIN(cond, bar) do { unsigned _sp = 0; while (cond) { __builtin_amdgcn_s_sleep(1); \
    if ((++_sp & 255u) == 0u) { if (xb_ld(&(bar)[XB_TMO])) break; if (_sp > XB_SPIN_CAP) { atomicAdd(&(bar)[XB_TMO], 1u); break; } } } } while (0)

struct XcdBarrier {
    unsigned* bar; unsigned x;
    volatile LAS unsigned* st;
};

__device__ __forceinline__ XcdBarrier xcd_barrier_post(unsigned* bar, volatile LAS unsigned* st) {
    XcdBarrier b; b.bar = bar; b.x = xb_xcc_id(); b.st = st;
    if (threadIdx.x == 0) (void)xb_add(&bar[XB_XCNT(b.x)], 1u);
    return b;
}
__device__ __forceinline__ void xcd_barrier_complete(unsigned* bar, unsigned x, unsigned& nloc, unsigned& nx) {
    const unsigned G = gridDim.x * gridDim.y * gridDim.z;
    unsigned sum, cnt, mine, sp = 0u;
    for (;;) {
        sum = 0u; cnt = 0u; mine = 0u;
#pragma unroll
        for (unsigned j = 0; j < 16; ++j) { const unsigned c = xb_ld(&bar[XB_XCNT(j)]); sum += c; cnt += (c > 0u) ? 1u : 0u; mine = (j == x) ? c : mine; }
        if (sum == G) break;
        __builtin_amdgcn_s_sleep(1);
        if ((++sp & 255u) == 0u) { if (xb_ld(&bar[XB_TMO])) break; if (sp > XB_SPIN_CAP) { atomicAdd(&bar[XB_TMO], 1u); break; } }
    }
    nloc = mine > 0u ? mine : 1u; nx = cnt > 0u ? cnt : 1u;
}

__device__ __forceinline__ void xcd_barrier(const XcdBarrier& b) {
    asm volatile("s_waitcnt vmcnt(0)" ::: "memory");
    __syncthreads();
    if (threadIdx.x == 0) {
        unsigned* bar = b.bar;
        __builtin_amdgcn_s_waitcnt(0);
        unsigned nloc = b.st[0], nx = b.st[1];
        if (nloc == 0u) { xcd_barrier_complete(bar, b.x, nloc, nx); b.st[0] = nloc; b.st[1] = nx; }
        const unsigned old = xb_add(&bar[XB_XSUB(b.x)], 1u);
        const unsigned gen = old / nloc;
        if (old + 1u == (gen + 1u) * nloc) {
            __builtin_amdgcn_fence(__ATOMIC_RELEASE, "agent");
            asm volatile("s_waitcnt vmcnt(0)" ::: "memory");
            const unsigned og = xb_add(&bar[XB_TOP], 1u);
            const unsigned tg = og / nx;
            if (og + 1u == (tg + 1u) * nx) xb_add(&bar[XB_TOPGEN], 1u);
            else XB_SPIN(xb_ld(&bar[XB_TOPGEN]) == tg, bar);
            __builtin_amdgcn_fence(__ATOMIC_ACQUIRE, "agent");
            xb_add(&bar[XB_XGEN(b.x)], 1u);
            asm volatile("s_waitcnt vmcnt(0)" ::: "memory");
        } else {
            XB_SPIN(xb_ld(&bar[XB_XGEN(b.x)]) == gen, bar);
            __builtin_amdgcn_fence(__ATOMIC_ACQUIRE, "agent");
            asm volatile("s_waitcnt vmcnt(0)" ::: "memory");
        }
    }
    __syncthreads();
}

struct Args { const void* in[24]; float* out; unsigned char* ws; int ph_lo, ph_hi; };

struct Frame {
    LAS unsigned char* lds;
    int tid, lane, wave, G, vcu, gw, NGW;
};

template <bool F8>
DI void conv_item(const Frame& F, const float* W, int K, int Nsrc, void* WTv, int mode, int Fgu, float scale, int it) {
    constexpr int KI = F8 ? 256 : 128;
    LAS unsigned* scr = (LAS unsigned*)F.lds;
    const int nkb = K / KI, lane = F.lane, w = F.wave, tid = F.tid;
    {
        const int nb = it / nkb, kb = it % nkb, k0 = kb * KI, n0 = nb * 256, n = n0 + 4 * lane;
        int ns;
        if (mode == 0) ns = n;
        else if (mode == 1 || mode == 3 || mode == 4) {
            int ng = n;
            if (mode == 3) { const int lp = n >> 8; ng = ((lp < 44 ? lp : 68) << 8) + (n & 255); }
            if (mode == 4) ng = n + 44 * 256;
            ns = ng < 8192 ? ng : (ng < 17408 ? ng + 16 : (ng < 17424 ? ng - 17408 + 8192 : -1)); }
        else { const int pn = n >> 8, half = (n >> 7) & 1, j = n & 127; ns = half * Fgu + 128 * pn + j; }
        __syncthreads();
#pragma unroll
        for (int h = 0; h < (F8 ? 2 : 1); ++h) {
            const float* src = W + (size_t)(k0 + (F8 ? 32 : 16) * w + 16 * h) * Nsrc + (ns < 0 ? 0 : ns);
            f32x4 a[16];
#pragma unroll
            for (int i = 0; i < 16; ++i) a[i] = __builtin_nontemporal_load((const f32x4*)(src + (size_t)i * Nsrc));
            if (ns < 0) {
#pragma unroll
                for (int i = 0; i < 16; ++i) a[i] = (f32x4){0.f, 0.f, 0.f, 0.f}; }
#pragma unroll
            for (int c = 0; c < 4; ++c) {
                if (F8) {
#pragma unroll
                    for (int q = 0; q < 4; ++q) scr[(4 * lane + c) * 65 + 8 * w + 4 * h + q] = pg8::pk4_fp8(a[4 * q][c] * scale, a[4 * q + 1][c] * scale, a[4 * q + 2][c] * scale, a[4 * q + 3][c] * scale);
                } else {
#pragma unroll
                    for (int p = 0; p < 8; ++p) scr[(4 * lane + c) * 65 + 8 * w + p] = pk2(a[2 * p][c], a[2 * p + 1][c]); } }
        }
        __syncthreads();
#pragma unroll
        for (int ps = 0; ps < 8; ++ps) { const int row = ps * 32 + (tid >> 4), kq = tid & 15; const LAS unsigned* s = scr + row * 65 + 4 * kq; v4u o; o.x = s[0]; o.y = s[1]; o.z = s[2]; o.w = s[3];
            __builtin_nontemporal_store(o, (v4u*)((unsigned char*)WTv + ((size_t)(n0 + row) * K + k0) * (F8 ? 1 : 2) + 16 * kq)); }
    }
}
template <bool F8>
DI void conv_wg(const Frame& F, int& rot, const float* W, int K, int Nsrc, void* WTv, int Ndst, int mode, int Fgu, float scale) {
    const int items = (K / (F8 ? 256 : 128)) * (Ndst / 256);
    const int it0 = (F.vcu - rot + F.G) % F.G; rot = (rot + items) % F.G;
    for (int it = it0; it < items; it += F.G) conv_item<F8>(F, W, K, Nsrc, WTv, mode, Fgu, scale, it);
}
constexpr int MOE_ITEMS = 8 * 672, NCONV = 16, MOE_HOST = 28 * NCONV, MOE_HOSTB = 14 * NCONV, MOE_X0 = MOE_ITEMS - 2 * MOE_HOST - MOE_HOSTB, MOE_X1 = MOE_X0 + MOE_HOST, MOE_X2 = MOE_X1 + MOE_HOSTB;
DI void conv_moe(const Frame& F, const float* egu, const float* edn, unsigned char* wegu, unsigned char* wedn, int lo, int hi, int c, int NC) {
    LAS unsigned* scr = (LAS unsigned*)F.lds;
    const int lane = F.lane, w = F.wave, tid = F.tid;
    f32x4 a[32];
    int it = lo + c;
    if (it >= hi) return;
#define MOE_DECODE(IT) const int e_ = (IT) / 672, r_ = (IT) % 672; const bool gu_ = r_ < 448; const int rr_ = gu_ ? r_ : r_ - 448, nkb_ = gu_ ? 8 : 28, nb_ = rr_ / nkb_, kb_ = rr_ % nkb_;
#define MOE_LOAD(IT) { MOE_DECODE(IT) const int Nsrc_ = gu_ ? 2 * EFF : D, n_ = nb_ * 256 + 4 * lane, ns_ = gu_ ? (((n_ >> 7) & 1) * EFF + 128 * (n_ >> 8) + (n_ & 127)) : n_; \
        const float* src_ = (gu_ ? egu + (size_t)e_ * D * 2 * EFF : edn + (size_t)e_ * EFF * D) + (size_t)(kb_ * 256 + 32 * w) * Nsrc_ + ns_; \
        _Pragma("unroll") for (int i = 0; i < 32; ++i) a[i] = __builtin_nontemporal_load((const f32x4*)(src_ + (size_t)i * Nsrc_)); }
    MOE_LOAD(it)
    __syncthreads();
    for (; it < hi; it += NC) {
#pragma unroll
        for (int h = 0; h < 2; ++h)
#pragma unroll
            for (int cc = 0; cc < 4; ++cc)
#pragma unroll
                for (int q = 0; q < 4; ++q) scr[(4 * lane + cc) * 65 + 8 * w + 4 * h + q] = pg8::pk4_fp8(a[16 * h + 4 * q][cc] * 256.f, a[16 * h + 4 * q + 1][cc] * 256.f, a[16 * h + 4 * q + 2][cc] * 256.f, a[16 * h + 4 * q + 3][cc] * 256.f);
        __syncthreads();
        if (it + NC < hi) MOE_LOAD(it + NC)
        { MOE_DECODE(it) const int K_ = gu_ ? D : EFF; unsigned char* dst_ = (gu_ ? wegu + (size_t)e_ * 2 * EFF * D : wedn + (size_t)e_ * D * EFF) + (size_t)(nb_ * 256) * K_ + kb_ * 256;
#pragma unroll
          for (int ps = 0; ps < 8; ++ps) { const int row = ps * 32 + (tid >> 4), kq = tid & 15; const LAS unsigned* s = scr + row * 65 + 4 * kq; v4u o; o.x = s[0]; o.y = s[1]; o.z = s[2]; o.w = s[3];
              __builtin_nontemporal_store(o, (v4u*)(dst_ + (size_t)row * K_ + 16 * kq)); } }
        __syncthreads();
    }
#undef MOE_LOAD
#undef MOE_DECODE
}

DI f32x4 ldx4(const float* p) { return *(const f32x4*)p; }
DI f32x4 ldx4(const bf16* p) { const v2u w = *(const v2u*)p; f32x4 r; r[0] = __uint_as_float(w.x << 16); r[1] = __uint_as_float(w.x & 0xffff0000u); r[2] = __uint_as_float(w.y << 16); r[3] = __uint_as_float(w.y & 0xffff0000u); return r; }
template <class XT>
DI void rms_row(const XT* xrow, const float* w, bf16* orow, int lane, unsigned char* o8 = nullptr) {
    f32x4 v[8], ww[8]; float ss = 0.f;
#pragma unroll
    for (int j = 0; j < 8; ++j) { v[j] = ldx4(xrow + 4 * (lane + 64 * j)); ww[j] = *(const f32x4*)(w + 4 * (lane + 64 * j)); }
#pragma unroll
    for (int j = 0; j < 8; ++j) ss += (v[j][0] * v[j][0] + v[j][1] * v[j][1]) + (v[j][2] * v[j][2] + v[j][3] * v[j][3]);
    const float rstd = rsqrtf(wave_sum(ss) * (1.f / D) + EPS);
#pragma unroll
    for (int j = 0; j < 8; ++j) { const f32x4 y = v[j] * rstd * ww[j]; v2u o; o.x = pk2(y[0], y[1]); o.y = pk2(y[2], y[3]);
        *(v2u*)(orow + 4 * (lane + 64 * j)) = o;
        if (o8) *(unsigned*)(o8 + 4 * (lane + 64 * j)) = pg8::pk4_fp8(y[0], y[1], y[2], y[3]); }
}

template <int DV, int KT, bool CAUSAL, bool OUT_BF16, bool DECAY, bool QP4 = false>
DI void flash_item(const Frame& F, const bf16* Q, const bf16* Kh, const bf16* VT, int vpitch, int q0, int nkeys, float slope, float* OUTF, bf16* OUTB, int opitch) {
    constexpr int KP = 272, VP = KT * 2 + 16, NKC = KT / 32, NVC = DV * KT / 4096, VCH = KT / 8;
    LAS unsigned char* Kl = F.lds; LAS unsigned char* Vl = F.lds + KT * KP;
    int tid_ = F.tid; asm volatile("" : "+v"(tid_));
    const int tid = tid_, lane = tid & 63, w = F.wave, li = lane & 15, g = lane >> 4;
    const float SC = 0.08838834764831845f, L2E = 1.4426950408889634f;
    bf16x8 qf[4];
#pragma unroll
    for (int ks = 0; ks < 4; ++ks) {
        if (QP4) {
            const float* qp = (const float*)Q + (size_t)(w * 16 + li) * 512 + ks * 32 + g * 8; f32x4 a0 = *(const f32x4*)qp, a1 = *(const f32x4*)(qp + 4);
#pragma unroll
            for (int p = 1; p < 4; ++p) { a0 = a0 + *(const f32x4*)(qp + (size_t)p * T * 512); a1 = a1 + *(const f32x4*)(qp + (size_t)p * T * 512 + 4); }
            v4u pw; pw.x = pk2(a0[0], a0[1]); pw.y = pk2(a0[2], a0[3]); pw.z = pk2(a1[0], a1[1]); pw.w = pk2(a1[2], a1[3]); qf[ks] = __builtin_bit_cast(bf16x8, pw);
        } else qf[ks] = *(const bf16x8*)(Q + (size_t)(w * 16 + li) * 128 + ks * 32 + g * 8); }
    f32x4 o[DV / 16];
#pragma unroll
    for (int c = 0; c < DV / 16; ++c) o[c] = (f32x4){0.f, 0.f, 0.f, 0.f};
    float m_run = -1e30f, l_run = 0.f;
    const int qpos = q0 + w * 16 + li;
    const int kend = CAUSAL ? (q0 + 128 < nkeys ? q0 + 128 : nkeys) : nkeys;
    v4u kr[NKC], vr[NVC];
#pragma unroll
    for (int i = 0; i < NKC; ++i) { const int c = tid + 512 * i; kr[i] = *(const v4u*)(Kh + (size_t)(c >> 4) * 128 + (c & 15) * 8); }
#pragma unroll
    for (int i = 0; i < NVC; ++i) { const int c = tid + 512 * i; vr[i] = *(const v4u*)(VT + (size_t)(c / VCH) * vpitch + (c % VCH) * 8); }
    for (int j0 = 0; j0 < kend; j0 += KT) {
        __syncthreads();
#pragma unroll
        for (int i = 0; i < NKC; ++i) { const int c = tid + 512 * i; *(LAS v4u*)(Kl + (c >> 4) * KP + (c & 15) * 16) = kr[i]; }
#pragma unroll
        for (int i = 0; i < NVC; ++i) { const int c = tid + 512 * i, cc = c % VCH, j = cc & 3; LAS unsigned char* rp = Vl + (c / VCH) * VP + (cc >> 2) * 64;
            *(LAS v2u*)(rp + (8 * ((2 * j) & 3) + 4 * (j >> 1)) * 2) = (v2u){vr[i].x, vr[i].y}; *(LAS v2u*)(rp + (8 * ((2 * j + 1) & 3) + 4 * (j >> 1)) * 2) = (v2u){vr[i].z, vr[i].w}; }
        __syncthreads();
        if (j0 + KT < kend) {
#pragma unroll
            for (int i = 0; i < NKC; ++i) { const int c = tid + 512 * i; kr[i] = *(const v4u*)(Kh + (size_t)(j0 + KT + (c >> 4)) * 128 + (c & 15) * 8); }
#pragma unroll
            for (int i = 0; i < NVC; ++i) { const int c = tid + 512 * i; vr[i] = *(const v4u*)(VT + (size_t)(c / VCH) * vpitch + j0 + KT + (c % VCH) * 8); }
        }
        f32x4 s[KT / 16];
        {
            bf16x8 ka[2][4];
#pragma unroll
            for (int ks = 0; ks < 4; ++ks) ka[0][ks] = *(const LAS bf16x8*)(Kl + li * KP + (ks * 32 + g * 8) * 2);
#pragma unroll
            for (int t = 0; t < KT / 16; ++t) {
                if (t + 1 < KT / 16) {
#pragma unroll
                    for (int ks = 0; ks < 4; ++ks) ka[(t + 1) & 1][ks] = *(const LAS bf16x8*)(Kl + ((t + 1) * 16 + li) * KP + (ks * 32 + g * 8) * 2); }
                __builtin_amdgcn_sched_barrier(0);
                s[t] = (f32x4){0.f, 0.f, 0.f, 0.f};
#pragma unroll
                for (int ks = 0; ks < 4; ++ks) s[t] = __builtin_amdgcn_mfma_f32_16x16x32_bf16(ka[t & 1][ks], qf[ks], s[t], 0, 0, 0);
                __builtin_amdgcn_sched_barrier(0);
            }
        }
        float alpha = 1.f;
        const bool diag = CAUSAL && (j0 + KT - 1 > q0 + w * 16);
        if (DECAY) {
            const float base = slope * (float)(qpos - j0 - 4 * g);
#pragma unroll
            for (int t = 0; t < KT / 16; ++t)
#pragma unroll
                for (int r = 0; r < 4; ++r) s[t][r] *= __builtin_amdgcn_exp2f(fmaf(slope, -(float)(16 * t + r), base));
            if (diag) {
#pragma unroll
                for (int t = 0; t < KT / 16; ++t)
#pragma unroll
                    for (int r = 0; r < 4; ++r) if (j0 + t * 16 + g * 4 + r > qpos) s[t][r] = 0.f; }
        } else {
        const float C2 = SC * L2E, sl2 = slope * L2E, base = -sl2 * (float)(qpos - j0 - 4 * g);
        float mx = -__builtin_inff();
#pragma unroll
        for (int t = 0; t < KT / 16; ++t)
#pragma unroll
            for (int r = 0; r < 4; ++r) s[t][r] = fmaf(s[t][r], C2, fmaf(sl2, (float)(16 * t + r), base));
        if (diag) {
#pragma unroll
            for (int t = 0; t < KT / 16; ++t)
#pragma unroll
                for (int r = 0; r < 4; ++r) if (j0 + t * 16 + g * 4 + r > qpos) s[t][r] = -__builtin_inff(); }
#pragma unroll
        for (int t = 0; t < KT / 16; ++t)
#pragma unroll
            for (int r = 0; r < 4; ++r) mx = fmaxf(mx, s[t][r]);
        mx = fmaxf(mx, __shfl_xor(mx, 16)); mx = fmaxf(mx, __shfl_xor(mx, 32));
        const float m_new = fmaxf(m_run, mx); alpha = __builtin_amdgcn_exp2f(m_run - m_new); m_run = m_new;
        float ps = 0.f;
#pragma unroll
        for (int t = 0; t < KT / 16; ++t)
#pragma unroll
            for (int r = 0; r < 4; ++r) { const float p = __builtin_amdgcn_exp2f(s[t][r] - m_new); s[t][r] = p; ps += p; }
        ps += __shfl_xor(ps, 16); ps += __shfl_xor(ps, 32);
        l_run = l_run * alpha + ps;
        }
        bf16x8 pf[KT / 32];
#pragma unroll
        for (int s2 = 0; s2 < KT / 32; ++s2) { v4u pw; pw.x = pk2(s[2 * s2][0], s[2 * s2][1]); pw.y = pk2(s[2 * s2][2], s[2 * s2][3]); pw.z = pk2(s[2 * s2 + 1][0], s[2 * s2 + 1][1]); pw.w = pk2(s[2 * s2 + 1][2], s[2 * s2 + 1][3]); pf[s2] = __builtin_bit_cast(bf16x8, pw); }
        float al[4];
#pragma unroll
        for (int r = 0; r < 4; ++r) al[r] = DECAY ? 1.f : __shfl(alpha, g * 4 + r);
        {
            v4u vb[2][KT / 32];
#pragma unroll
            for (int s2 = 0; s2 < KT / 32; ++s2) vb[0][s2] = *(const LAS v4u*)(Vl + li * VP + (s2 * 32 + g * 8) * 2);
#pragma unroll
            for (int c = 0; c < DV / 16; ++c) {
                if (c + 1 < DV / 16) {
#pragma unroll
                    for (int s2 = 0; s2 < KT / 32; ++s2) vb[(c + 1) & 1][s2] = *(const LAS v4u*)(Vl + ((c + 1) * 16 + li) * VP + (s2 * 32 + g * 8) * 2); }
                __builtin_amdgcn_sched_barrier(0);
                if (!DECAY) {
#pragma unroll
                    for (int r = 0; r < 4; ++r) o[c][r] *= al[r]; }
#pragma unroll
                for (int s2 = 0; s2 < KT / 32; ++s2) o[c] = __builtin_amdgcn_mfma_f32_16x16x32_bf16(pf[s2], __builtin_bit_cast(bf16x8, vb[c & 1][s2]), o[c], 0, 0, 0);
                __builtin_amdgcn_sched_barrier(0);
            }
        }
    }
    float il[4];
#pragma unroll
    for (int r = 0; r < 4; ++r) il[r] = DECAY ? 1.f : 1.0f / __shfl(l_run, g * 4 + r);
#pragma unroll
    for (int c = 0; c < DV / 16; ++c)
#pragma unroll
        for (int r = 0; r < 4; ++r) { const unsigned off = (unsigned)((w * 16 + g * 4 + r) * opitch + c * 16 + li); const float v = o[c][r] * il[r];
            if (OUT_BF16) OUTB[off] = (bf16)f2bf(v); else OUTF[off] = v; }
}

DI void flash_ret(const Frame& F, const bf16* Q, const bf16* Kh, const bf16* VT, int vpitch, int q0, float lg2, bf16* OUTB, int opitch) {
    constexpr int KP = 272, VP = 144;
    LAS unsigned char* Kl = F.lds; LAS unsigned char* Vl = F.lds + 64 * KP;
    int tid_ = F.tid; asm volatile("" : "+v"(tid_));
    const int tid = tid_, lane = tid & 63, w = F.wave, li = lane & 15, g = lane >> 4;
    bf16x8 qf[2][4];
#pragma unroll
    for (int qs = 0; qs < 2; ++qs)
#pragma unroll
        for (int ks = 0; ks < 4; ++ks) qf[qs][ks] = *(const bf16x8*)(Q + (size_t)(w * 32 + qs * 16 + li) * 128 + ks * 32 + g * 8);
    f32x4 o[2][8];
#pragma unroll
    for (int qs = 0; qs < 2; ++qs)
#pragma unroll
        for (int c = 0; c < 8; ++c) o[qs][c] = (f32x4){0.f, 0.f, 0.f, 0.f};
    const int kend = q0 + 256, qw0 = q0 + w * 32;
    v4u kr[2], vr[2];
#pragma unroll
    for (int i = 0; i < 2; ++i) { const int c = tid + 512 * i; kr[i] = *(const v4u*)(Kh + (size_t)(c >> 4) * 128 + (c & 15) * 8); vr[i] = *(const v4u*)(VT + (size_t)(c >> 3) * vpitch + (c & 7) * 8); }
    for (int j0 = 0; j0 < kend; j0 += 64) {
        __syncthreads();
#pragma unroll
        for (int i = 0; i < 2; ++i) { const int c = tid + 512 * i; *(LAS v4u*)(Kl + (c >> 4) * KP + (c & 15) * 16) = kr[i];
            const int cc = c & 7, j = cc & 3; LAS unsigned char* rp = Vl + (c >> 3) * VP + (cc >> 2) * 64;
            *(LAS v2u*)(rp + (8 * ((2 * j) & 3) + 4 * (j >> 1)) * 2) = (v2u){vr[i].x, vr[i].y}; *(LAS v2u*)(rp + (8 * ((2 * j + 1) & 3) + 4 * (j >> 1)) * 2) = (v2u){vr[i].z, vr[i].w}; }
        __syncthreads();
        if (j0 + 64 < kend) {
#pragma unroll
            for (int i = 0; i < 2; ++i) { const int c = tid + 512 * i; kr[i] = *(const v4u*)(Kh + (size_t)(j0 + 64 + (c >> 4)) * 128 + (c & 15) * 8); vr[i] = *(const v4u*)(VT + (size_t)(c >> 3) * vpitch + j0 + 64 + (c & 7) * 8); }
        }
        if (j0 > qw0 + 31) continue;
        f32x4 s[2][4];
        {
            bf16x8 ka[2][4];
#pragma unroll
            for (int ks = 0; ks < 4; ++ks) ka[0][ks] = *(const LAS bf16x8*)(Kl + li * KP + (ks * 32 + g * 8) * 2);
#pragma unroll
            for (int t = 0; t < 4; ++t) {
                if (t + 1 < 4) {
#pragma unroll
                    for (int ks = 0; ks < 4; ++ks) ka[(t + 1) & 1][ks] = *(const LAS bf16x8*)(Kl + ((t + 1) * 16 + li) * KP + (ks * 32 + g * 8) * 2); }
                __builtin_amdgcn_sched_barrier(0);
#pragma unroll
                for (int qs = 0; qs < 2; ++qs) { s[qs][t] = (f32x4){0.f, 0.f, 0.f, 0.f};
#pragma unroll
                    for (int ks = 0; ks < 4; ++ks) s[qs][t] = __builtin_amdgcn_mfma_f32_16x16x32_bf16(ka[t & 1][ks], qf[qs][ks], s[qs][t], 0, 0, 0); }
                __builtin_amdgcn_sched_barrier(0);
            }
        }
        const bool diag = j0 + 63 > qw0;
        bf16x8 pf[2][2];
#pragma unroll
        for (int qs = 0; qs < 2; ++qs) { const int qpos = qw0 + qs * 16 + li; const float base = lg2 * (float)(qpos - j0 - 4 * g);
#pragma unroll
            for (int t = 0; t < 4; ++t)
#pragma unroll
                for (int r = 0; r < 4; ++r) s[qs][t][r] *= __builtin_amdgcn_exp2f(fmaf(lg2, -(float)(16 * t + r), base));
            if (diag) {
#pragma unroll
                for (int t = 0; t < 4; ++t)
#pragma unroll
                    for (int r = 0; r < 4; ++r) if (j0 + t * 16 + g * 4 + r > qpos) s[qs][t][r] = 0.f; }
#pragma unroll
            for (int s2 = 0; s2 < 2; ++s2) { v4u pw; pw.x = pk2(s[qs][2 * s2][0], s[qs][2 * s2][1]); pw.y = pk2(s[qs][2 * s2][2], s[qs][2 * s2][3]); pw.z = pk2(s[qs][2 * s2 + 1][0], s[qs][2 * s2 + 1][1]); pw.w = pk2(s[qs][2 * s2 + 1][2], s[qs][2 * s2 + 1][3]); pf[qs][s2] = __builtin_bit_cast(bf16x8, pw); } }
        {
            v4u vb[2][2];
#pragma unroll
            for (int s2 = 0; s2 < 2; ++s2) vb[0][s2] = *(const LAS v4u*)(Vl + li * VP + (s2 * 32 + g * 8) * 2);
#pragma unroll
            for (int c = 0; c < 8; ++c) {
                if (c + 1 < 8) {
#pragma unroll
                    for (int s2 = 0; s2 < 2; ++s2) vb[(c + 1) & 1][s2] = *(const LAS v4u*)(Vl + ((c + 1) * 16 + li) * VP + (s2 * 32 + g * 8) * 2); }
                __builtin_amdgcn_sched_barrier(0);
#pragma unroll
                for (int qs = 0; qs < 2; ++qs)
#pragma unroll
                    for (int s2 = 0; s2 < 2; ++s2) o[qs][c] = __builtin_amdgcn_mfma_f32_16x16x32_bf16(pf[qs][s2], __builtin_bit_cast(bf16x8, vb[c & 1][s2]), o[qs][c], 0, 0, 0);
                __builtin_amdgcn_sched_barrier(0);
            }
        }
    }
#pragma unroll
    for (int qs = 0; qs < 2; ++qs)
#pragma unroll
        for (int c = 0; c < 8; ++c)
#pragma unroll
            for (int r = 0; r < 4; ++r) OUTB[(unsigned)((w * 32 + qs * 16 + g * 4 + r) * opitch + c * 16 + li)] = (bf16)f2bf(o[qs][c][r]);
}

constexpr int GDN_CH_BYTES = 16384 + 16384 + 8192 + 16384 + 32768;
DI int perm32pos(int k) { return (k & ~31) | (((k >> 2) & 3) << 3) | (((k >> 4) & 1) << 2) | (k & 3); }
DI void gdn_prep_item(const Frame& F, int l, int bh, int n, bool stage_cw, const bf16* BQKV, const float* BBA, const float* cw, const float* a_log, const float* dt_bias, unsigned char* CH, float* GLp) {
    LAS unsigned char* Kl = F.lds; LAS unsigned char* Ql = F.lds + 17408; LAS unsigned char* KBT = F.lds + 34816; LAS unsigned char* VBT = F.lds + 53248; LAS unsigned char* KTl = F.lds + 71680;
    LAS float* Am = (LAS float*)(F.lds + 90112); LAS unsigned char* Tl = F.lds + 106752; LAS unsigned char* AQl = F.lds + 115968; LAS float* Gs = (LAS float*)(F.lds + 125184); LAS float* gs = Gs + 64; LAS float* bs = gs + 64;
    LAS float* CWl = (LAS float*)(F.lds + RING_BYTES);
    int tid_ = F.tid; asm volatile("" : "+v"(tid_));
    const int tid = tid_, lane = tid & 63, w = F.wave, li = lane & 15, g = lane >> 4;
    const int b = bh >> 3, h = bh & 7, i = tid >> 3, cg = tid & 7, c0 = cg * 16, s = n * 64 + i, t = b * SEQ + s;
    bf16* Wn = (bf16*)CH; bf16* QD = (bf16*)(CH + 16384); bf16* AQK = (bf16*)(CH + 32768); bf16* KT = (bf16*)(CH + 40960); float* UT = (float*)(CH + 57344);
    v4u xr[3][4][2];
#pragma unroll
    for (int part = 0; part < 3; ++part)
#pragma unroll
        for (int j = 0; j < 4; ++j) { const int tj = (s - 3 + j >= 0) ? t - 3 + j : t; const bf16* xp = BQKV + (size_t)tj * 3072 + part * 1024 + h * 128 + c0; xr[part][j][0] = *(const v4u*)xp; xr[part][j][1] = *(const v4u*)(xp + 8); }
    float bbv = 0.f, bav = 0.f;
    if (w == 0) { const size_t tt = (size_t)(b * SEQ + n * 64 + lane) * 16; bbv = BBA[tt + h]; bav = BBA[tt + 8 + h] + dt_bias[l * 8 + h]; }
    __syncthreads();
    if (stage_cw) { for (int e = tid; e < 1536; e += 512) { const int part = e >> 9, j = (e >> 7) & 3, c = e & 127; CWl[e] = cw[j * 3072 + part * 1024 + h * 128 + c]; } __syncthreads(); }
    if (w == 0) { const float sp = bav > 20.f ? bav : log1pf(__expf(bav)); float v = -__expf(a_log[l * 8 + h]) * sp; bs[lane] = pg8::fsigm(bbv);
#pragma unroll
        for (int o = 1; o < 64; o <<= 1) { const float u = __shfl_up(v, o); if (lane >= o) v += u; }
        Gs[lane] = v; }
    float qv[16], kv[16], vv[16];
#pragma unroll
    for (int part = 0; part < 3; ++part) {
        float a[16];
#pragma unroll
        for (int c = 0; c < 16; ++c) a[c] = 0.f;
#pragma unroll
        for (int j = 0; j < 4; ++j) { const v4u x0 = xr[part][j][0], x1 = xr[part][j][1];
            const LAS float* wj = CWl + part * 512 + j * 128 + c0; const float mk = (s - 3 + j >= 0) ? 1.f : 0.f;
#pragma unroll
            for (int c = 0; c < 4; ++c) { a[2 * c] += bf2f(x0[c] & 0xffffu) * (wj[2 * c] * mk); a[2 * c + 1] += __uint_as_float(x0[c] & 0xffff0000u) * (wj[2 * c + 1] * mk); a[8 + 2 * c] += bf2f(x1[c] & 0xffffu) * (wj[8 + 2 * c] * mk); a[9 + 2 * c] += __uint_as_float(x1[c] & 0xffff0000u) * (wj[9 + 2 * c] * mk); } }
#pragma unroll
        for (int c = 0; c < 16; ++c) { const float y = pg8::fsilu(a[c]); if (part == 0) qv[c] = y; else if (part == 1) kv[c] = y; else vv[c] = y; }
    }
    { float sq = 0.f, sk = 0.f;
#pragma unroll
      for (int c = 0; c < 16; ++c) { sq += qv[c] * qv[c]; sk += kv[c] * kv[c]; }
      sq += __shfl_xor(sq, 1); sq += __shfl_xor(sq, 2); sq += __shfl_xor(sq, 4); sk += __shfl_xor(sk, 1); sk += __shfl_xor(sk, 2); sk += __shfl_xor(sk, 4);
      const float qn = rsqrtf(sq + 1e-6f) * 0.08838834764831845f, kn = rsqrtf(sk + 1e-6f);
#pragma unroll
      for (int c = 0; c < 16; ++c) { qv[c] *= qn; kv[c] *= kn; } }
    __syncthreads();
    {
        const float Gi = Gs[i], Gl = Gs[63], be = bs[i], eg = __expf(Gi), kbs = be * eg, kts = __expf(Gl - Gi);
        v4u pk, pq;
#pragma unroll
        for (int hh = 0; hh < 2; ++hh) {
            pk.x = pk2(kv[8 * hh + 0], kv[8 * hh + 1]); pk.y = pk2(kv[8 * hh + 2], kv[8 * hh + 3]); pk.z = pk2(kv[8 * hh + 4], kv[8 * hh + 5]); pk.w = pk2(kv[8 * hh + 6], kv[8 * hh + 7]);
            pq.x = pk2(qv[8 * hh + 0], qv[8 * hh + 1]); pq.y = pk2(qv[8 * hh + 2], qv[8 * hh + 3]); pq.z = pk2(qv[8 * hh + 4], qv[8 * hh + 5]); pq.w = pk2(qv[8 * hh + 6], qv[8 * hh + 7]);
            *(LAS v4u*)(Kl + i * 272 + (c0 + 8 * hh) * 2) = pk; *(LAS v4u*)(Ql + i * 272 + (c0 + 8 * hh) * 2) = pq; }
        const int ip = perm32pos(i);
#pragma unroll
        for (int c = 0; c < 16; ++c) { *(LAS bf16*)(KBT + (c0 + c) * 144 + i * 2) = (bf16)f2bf(kv[c] * kbs); *(LAS bf16*)(VBT + (c0 + c) * 144 + i * 2) = (bf16)f2bf(vv[c] * be); *(LAS bf16*)(KTl + (c0 + c) * 144 + ip * 2) = (bf16)f2bf(kv[c] * kts); }
#pragma unroll
        for (int gp = 0; gp < 4; ++gp) { v2u o; o.x = pk2(qv[4 * gp] * eg, qv[4 * gp + 1] * eg); o.y = pk2(qv[4 * gp + 2] * eg, qv[4 * gp + 3] * eg); *(v2u*)(QD + i * 128 + 32 * (cg >> 1) + 8 * gp + 4 * (cg & 1)) = o; }
        if (tid == 0) *GLp = __expf(Gl);
    }
    __syncthreads();
    {
        const int kind = w >> 2, rb = w & 3; LAS unsigned char* Al = kind ? Ql : Kl;
        bf16x8 af[4];
#pragma unroll
        for (int ks = 0; ks < 4; ++ks) af[ks] = *(const LAS bf16x8*)(Al + (rb * 16 + li) * 272 + (ks * 32 + g * 8) * 2);
#pragma unroll
        for (int cb = 0; cb < 4; ++cb) {
            f32x4 acc = (f32x4){0.f, 0.f, 0.f, 0.f};
            if (cb <= rb) {
#pragma unroll
                for (int ks = 0; ks < 4; ++ks) { const bf16x8 bfr = *(const LAS bf16x8*)(Kl + (cb * 16 + li) * 272 + (ks * 32 + g * 8) * 2); acc = __builtin_amdgcn_mfma_f32_16x16x32_bf16(af[ks], bfr, acc, 0, 0, 0); } }
            const int j = cb * 16 + li; const float Gj = Gs[j];
#pragma unroll
            for (int r = 0; r < 4; ++r) { const int ii = rb * 16 + 4 * g + r; const float Lij = __expf(Gs[ii] - Gj);
                if (kind == 0) Am[ii * 65 + j] = ii > j ? acc[r] * Lij * bs[ii] : 0.f;
                else *(LAS bf16*)(AQl + ii * 144 + perm32pos(j) * 2) = (bf16)f2bf(ii >= j ? acc[r] * Lij : 0.f); }
        }
    }
    __syncthreads();
    if (w == 0) {
        int zv = 0; asm volatile("" : "+v"(zv)); const LAS float* Amv = Am + zv;
        float Tr[64], ar[2][64];
        ar[1][0] = Amv[65];
#pragma unroll
        for (int ii = 0; ii < 64; ++ii) {
            if (ii + 1 < 64 && ii >= 1) {
#pragma unroll
                for (int j = 0; j < ii + 1; ++j) ar[(ii + 1) & 1][j] = Amv[(ii + 1) * 65 + j]; }
            __builtin_amdgcn_sched_barrier(0);
            float ac[4] = {(ii == lane) ? 1.f : 0.f, 0.f, 0.f, 0.f};
#pragma unroll
            for (int j = 0; j < ii; ++j) ac[j & 3] -= ar[ii & 1][j] * Tr[j];
            Tr[ii] = (ac[0] + ac[1]) + (ac[2] + ac[3]);
            *(LAS bf16*)(Tl + ii * 144 + lane * 2) = (bf16)f2bf(Tr[ii]);
            __builtin_amdgcn_sched_barrier(0);
        }
    }
    __syncthreads();
    {
        const int kind = w >> 2; LAS unsigned char* Xl = kind ? VBT : KBT;
#pragma unroll
        for (int q2 = 0; q2 < 2; ++q2) { const int rbk = 2 * (w & 3) + q2;
            bf16x8 af[2];
#pragma unroll
            for (int ks = 0; ks < 2; ++ks) af[ks] = *(const LAS bf16x8*)(Xl + (rbk * 16 + li) * 144 + (ks * 32 + g * 8) * 2);
#pragma unroll
            for (int cb = 0; cb < 4; ++cb) { f32x4 acc = (f32x4){0.f, 0.f, 0.f, 0.f};
#pragma unroll
                for (int ks = 0; ks < 2; ++ks) { const bf16x8 bfr = *(const LAS bf16x8*)(Tl + (cb * 16 + li) * 144 + (ks * 32 + g * 8) * 2); acc = __builtin_amdgcn_mfma_f32_16x16x32_bf16(af[ks], bfr, acc, 0, 0, 0); }
                const int ii = cb * 16 + li;
                if (kind == 0) { v2u o; o.x = pk2(-acc[0], -acc[1]); o.y = pk2(-acc[2], -acc[3]); *(v2u*)(Wn + ii * 128 + 32 * (rbk >> 1) + 8 * g + 4 * (rbk & 1)) = o; }
                else {
#pragma unroll
                    for (int r = 0; r < 4; ++r) UT[(rbk * 16 + 4 * g + r) * 64 + ii] = acc[r]; } }
        }
    }
#pragma unroll
    for (int q2 = 0; q2 < 2; ++q2) { const int c = tid + 512 * q2, row = c >> 3, cc = c & 7; *(v4u*)(KT + row * 64 + cc * 8) = *(const LAS v4u*)(KTl + row * 144 + cc * 16); }
    { const int row = tid >> 3, cc = tid & 7; *(v4u*)(AQK + row * 64 + cc * 8) = *(const LAS v4u*)(AQl + row * 144 + cc * 16); }
}

DI void gdn_scan(const Frame& F, int bh, const unsigned char* CHB, const float* GLB, bf16* OB) {
    constexpr int BUFB = 62464, O_QD = 17408, O_AQ = 34816, O_KT = 44032;
    int tid_ = F.tid; asm volatile("" : "+v"(tid_));
    const int tid = tid_, lane = tid & 63, w = F.wave, li = lane & 15, g = lane >> 4, b = bh >> 3, h = bh & 7;
    f32x4 S[8];
#pragma unroll
    for (int kb = 0; kb < 8; ++kb) S[kb] = (f32x4){0.f, 0.f, 0.f, 0.f};
    int ldso[7];
#pragma unroll
    for (int q = 0; q < 7; ++q) { const int c = tid + 512 * q;
        if (q < 2) ldso[q] = (c >> 4) * 272 + (c & 15) * 16; else if (q < 4) ldso[q] = O_QD + ((c - 1024) >> 4) * 272 + (c & 15) * 16;
        else if (q == 4) ldso[q] = O_AQ + ((c - 2048) >> 3) * 144 + (c & 7) * 16; else ldso[q] = O_KT + ((c - 2560) >> 3) * 144 + (c & 7) * 16; }
    const unsigned char* CH0 = CHB + (size_t)(bh * 32) * GDN_CH_BYTES;
    v4u st[7]; f32x4 utc[4], utn[4]; float glc, gln;
    __syncthreads();
#pragma unroll
    for (int q = 0; q < 7; ++q) st[q] = *(const v4u*)(CH0 + (size_t)(tid + 512 * q) * 16);
#pragma unroll
    for (int jb = 0; jb < 4; ++jb) utc[jb] = *(const f32x4*)((const float*)(CH0 + 57344) + (16 * w + li) * 64 + jb * 16 + 4 * g);
    glc = GLB[bh * 32];
#pragma unroll
    for (int q = 0; q < 7; ++q) *(LAS v4u*)(F.lds + ldso[q]) = st[q];
    __syncthreads();
    for (int n = 0; n < 32; ++n) {
        const LAS unsigned char* Lb = F.lds + (n & 1) * BUFB;
        if (n + 1 < 32) { const unsigned char* CH = CH0 + (size_t)(n + 1) * GDN_CH_BYTES;
#pragma unroll
            for (int q = 0; q < 7; ++q) st[q] = *(const v4u*)(CH + (size_t)(tid + 512 * q) * 16);
#pragma unroll
            for (int jb = 0; jb < 4; ++jb) utn[jb] = *(const f32x4*)((const float*)(CH + 57344) + (16 * w + li) * 64 + jb * 16 + 4 * g);
            gln = GLB[bh * 32 + n + 1]; }
        bf16x8 sf[4];
#pragma unroll
        for (int ks = 0; ks < 4; ++ks) { v4u p; p.x = pk2(S[2 * ks][0], S[2 * ks][1]); p.y = pk2(S[2 * ks][2], S[2 * ks][3]); p.z = pk2(S[2 * ks + 1][0], S[2 * ks + 1][1]); p.w = pk2(S[2 * ks + 1][2], S[2 * ks + 1][3]); sf[ks] = __builtin_bit_cast(bf16x8, p); }
        f32x4 vn[4];
#pragma unroll
        for (int jb = 0; jb < 4; ++jb) { vn[jb] = utc[jb];
#pragma unroll
            for (int ks = 0; ks < 4; ++ks) { const bf16x8 a = *(const LAS bf16x8*)(Lb + (jb * 16 + li) * 272 + (ks * 32 + g * 8) * 2); vn[jb] = __builtin_amdgcn_mfma_f32_16x16x32_bf16(a, sf[ks], vn[jb], 0, 0, 0); } }
        bf16x8 vf[2];
#pragma unroll
        for (int js = 0; js < 2; ++js) { v4u p; p.x = pk2(vn[2 * js][0], vn[2 * js][1]); p.y = pk2(vn[2 * js][2], vn[2 * js][3]); p.z = pk2(vn[2 * js + 1][0], vn[2 * js + 1][1]); p.w = pk2(vn[2 * js + 1][2], vn[2 * js + 1][3]); vf[js] = __builtin_bit_cast(bf16x8, p); }
#pragma unroll
        for (int ib = 0; ib < 4; ++ib) { f32x4 z = (f32x4){0.f, 0.f, 0.f, 0.f};
#pragma unroll
            for (int ks = 0; ks < 4; ++ks) { const bf16x8 bq = *(const LAS bf16x8*)(Lb + O_QD + (ib * 16 + li) * 272 + (ks * 32 + g * 8) * 2); z = __builtin_amdgcn_mfma_f32_16x16x32_bf16(sf[ks], bq, z, 0, 0, 0); }
#pragma unroll
            for (int js = 0; js < 2; ++js) { const bf16x8 ba = *(const LAS bf16x8*)(Lb + O_AQ + (ib * 16 + li) * 144 + (js * 32 + g * 8) * 2); z = __builtin_amdgcn_mfma_f32_16x16x32_bf16(vf[js], ba, z, 0, 0, 0); }
            v2u zo; zo.x = pk2(z[0], z[1]); zo.y = pk2(z[2], z[3]); *(v2u*)(OB + ((size_t)(b * SEQ + n * 64 + ib * 16 + li)) * 1024 + h * 128 + 16 * w + 4 * g) = zo; }
#pragma unroll
        for (int kb = 0; kb < 8; ++kb) { S[kb] = S[kb] * glc;
#pragma unroll
            for (int js = 0; js < 2; ++js) { const bf16x8 a = *(const LAS bf16x8*)(Lb + O_KT + (kb * 16 + li) * 144 + (js * 32 + g * 8) * 2); S[kb] = __builtin_amdgcn_mfma_f32_16x16x32_bf16(a, vf[js], S[kb], 0, 0, 0); } }
        if (n + 1 < 32) {
            LAS unsigned char* Ln = F.lds + ((n + 1) & 1) * BUFB;
#pragma unroll
            for (int q = 0; q < 7; ++q) *(LAS v4u*)(Ln + ldso[q]) = st[q];
#pragma unroll
            for (int jb = 0; jb < 4; ++jb) utc[jb] = utn[jb];
            glc = gln; }
        __syncthreads();
    }
}

#define x_in ((const float*)args.in[0])
#define mem ((const float*)args.in[1])
#define w_in ((const float*)args.in[2])
#define conv_w ((const float*)args.in[3])
#define a_log ((const float*)args.in[4])
#define dt_bias ((const float*)args.in[5])
#define gdn_norm_w ((const float*)args.in[6])
#define diff_lambda ((const float*)args.in[7])
#define diff_norm_w ((const float*)args.in[8])
#define w_branch ((const float*)args.in[9])
#define w_out ((const float*)args.in[10])
#define mix_norm_w ((const float*)args.in[11])
#define mem_norm_w ((const float*)args.in[12])
#define cross_norm_w ((const float*)args.in[13])
#define cross_w_q ((const float*)args.in[14])
#define cross_w_kv ((const float*)args.in[15])
#define cross_w_o ((const float*)args.in[16])
#define ffn_norm_w ((const float*)args.in[17])
#define dense_w_gu ((const float*)args.in[18])
#define dense_w_down ((const float*)args.in[19])
#define router_w ((const float*)args.in[20])
#define expert_w_gu ((const float*)args.in[21])
#define expert_w_down ((const float*)args.in[22])
#define final_norm_w ((const float*)args.in[23])
#define WIN ((bf16*)(ws + WS_WIN))
#define WBR ((bf16*)(ws + WS_WBR))
#define WOUT ((bf16*)(ws + WS_WOUT))
#define WQ ((bf16*)(ws + WS_WQ))
#define WKV ((bf16*)(ws + WS_WKV))
#define WO ((bf16*)(ws + WS_WO))
#define WGU ((bf16*)(ws + WS_WGU))
#define WDN ((bf16*)(ws + WS_WDN))
#define WEGU ((bf16*)(ws + WS_WEGU))
#define WEDN ((bf16*)(ws + WS_WEDN))
#define XRES ((bf16*)(ws + WS_XRES))
#define H ((bf16*)(ws + WS_H))
#define RQ ((bf16*)(ws + WS_RQ))
#define RK ((bf16*)(ws + WS_RK))
#define RVT ((bf16*)(ws + WS_RV))
#define RG ((bf16*)(ws + WS_RG))
#define BQKV ((bf16*)(ws + WS_BQKV))
#define BZ ((bf16*)(ws + WS_BZ))
#define BBA ((float*)(ws + WS_BBA))
#define CQ ((bf16*)(ws + WS_CQ))
#define CK ((bf16*)(ws + WS_CK))
#define CVT ((bf16*)(ws + WS_CVT))
#define GATES ((bf16*)(ws + WS_GATES))
#define OA ((bf16*)(ws + WS_OA))
#define OB ((bf16*)(ws + WS_OB))
#define O12 ((bf16*)(ws + WS_O12))
#define OCAT ((bf16*)(ws + WS_OCAT))
#define MERGEB ((bf16*)(ws + WS_MERGEB))
#define MEMN ((bf16*)(ws + WS_MEMN))
#define KX ((bf16*)(ws + WS_KX))
#define VXT ((bf16*)(ws + WS_VXT))
#define QX ((bf16*)(ws + WS_QX))
#define OX ((bf16*)(ws + WS_OX))
#define ACT ((bf16*)(ws + WS_ACT))
#define HG ((bf16*)(ws + WS_HG))
#define EACT ((bf16*)(ws + WS_EACT))
#define Y ((float*)(ws + WS_Y))
#define ROUTE ((int*)(ws + WS_ROUTE))
#define QP ((float*)(ws + WS_MERGE))
#define H8 ((unsigned char*)(ws + WS_H8))
#define WIN8 ((unsigned char*)(ws + WS_WIN8))
__global__ void __launch_bounds__(NWAVES * 64, 2) mk_fwd(Args args) {
    extern __shared__ __attribute__((aligned(16))) unsigned char lds_raw[];
    Frame F;
    F.lds = (LAS unsigned char*)lds_raw;
    F.tid = threadIdx.x; F.lane = F.tid & 63; F.wave = __builtin_amdgcn_readfirstlane(F.tid >> 6);
    F.G = gridDim.x; { const int bx = blockIdx.x; F.vcu = (F.G % 8 == 0) ? (bx % 8) * (F.G / 8) + bx / 8 : bx; }
    F.gw = F.vcu * NWAVES + F.wave; F.NGW = F.G * NWAVES;
    volatile LAS unsigned* MISC = (volatile LAS unsigned*)(F.lds + MISC_OFF);
    LAS int* MTAB = (LAS int*)(F.lds + MISC_OFF + 128);
    unsigned char* ws = args.ws;
    unsigned* ctl = (unsigned*)(ws + WS_CTL);
    for (int u = F.tid; u < (LDS_BYTES - RING_BYTES) / 4; u += NWAVES * 64) ((LAS unsigned*)(F.lds + RING_BYTES))[u] = 0u;
    __syncthreads();
#if MK_ONE_LAUNCH
    XcdBarrier bar = xcd_barrier_post(ctl + CW_BAR, MISC + 8);
#define GRID_BAR() xcd_barrier(bar)
#else
#define GRID_BAR() do {} while (0)
#endif
    const int lo = args.ph_lo, hi = args.ph_hi;
#define IN(k) (lo <= (k) && (k) < hi)
#define SEAM(k) do { if (IN(k) && IN((k) + 1)) GRID_BAR(); } while (0)

    if (IN(0)) {
        int rot = 0;
        for (int l = 0; l < 2; ++l) {
            conv_wg<false>(F, rot, w_in + (size_t)l * D * 17424, D, 17424, WIN + (size_t)l * NINP * D, 45 * 256, 3, 0, 1.f);
            conv_wg<true>(F, rot, w_in + (size_t)l * D * 17424, D, 17424, WIN8 + (size_t)l * 32 * 256 * D, 24 * 256, 4, 0, 256.f);
            conv_wg<false>(F, rot, w_branch + (size_t)l * 3072 * D, 3072, D, WBR + (size_t)l * D * 3072, D, 0, 0, 1.f);
            conv_wg<false>(F, rot, w_out + (size_t)l * D * D, D, D, WOUT + (size_t)l * D * D, D, 0, 0, 1.f);
            conv_wg<false>(F, rot, cross_w_q + (size_t)l * D * 512, D, 512, WQ + (size_t)l * 512 * D, 512, 0, 0, 1.f);
            conv_wg<false>(F, rot, cross_w_kv + (size_t)l * D * 1024, D, 1024, WKV + (size_t)l * 1024 * D, 1024, 0, 0, 1.f);
            conv_wg<false>(F, rot, cross_w_o + (size_t)l * 512 * D, 512, D, WO + (size_t)l * D * 512, D, 0, 0, 1.f);
        }
        conv_wg<true>(F, rot, dense_w_gu, D, 2 * DFF, WGU, 2 * DFF, 2, DFF, 256.f);
        conv_wg<true>(F, rot, dense_w_down, DFF, D, WDN, D, 0, 0, 256.f);
        conv_moe(F, expert_w_gu, expert_w_down, (unsigned char*)WEGU, (unsigned char*)WEDN, 0, MOE_X0, (F.vcu - rot + F.G) % F.G, F.G);
        for (int r = F.gw; r < T; r += F.NGW) rms_row(x_in + (size_t)r * D, mix_norm_w, H + (size_t)r * D, F.lane, H8 + (size_t)r * D);
        for (int r = F.gw; r < 2 * MEMR; r += F.NGW) { const int l = r / MEMR, rr = r % MEMR; rms_row(mem + (size_t)rr * D, mem_norm_w + l * D, MEMN + (size_t)r * D, F.lane); }
    }
    SEAM(0);

    { constexpr int l = 0;
        const int pb = 2 + l * NPL;
        const float lambda_init = l == 0 ? 0.2f : 0.35550906f;
        if (IN(pb + 0)) {
            if ((int)blockIdx.x >= F.G - NCONV) conv_moe(F, expert_w_gu, expert_w_down, (unsigned char*)WEGU, (unsigned char*)WEDN, l == 0 ? MOE_X0 : MOE_X2, l == 0 ? MOE_X1 : MOE_ITEMS, (int)blockIdx.x - (F.G - NCONV), NCONV);
            else
            { pg8::Gemm g{H, WIN + (size_t)l * NINP * D, T, 45 * 256, D}; pg8::StaticOrder S; S.init(T, 45 * 256, F.G - NCONV, (int)blockIdx.x);
              pg8::EpiIn E{RQ, RK, RVT, RG, BQKV, BZ, CQ, CK, CVT, GATES, BBA, 0, 1.f};
              pg8::gemm_phase<pg8::EpiIn, pg8::StaticOrder, true, true>(F.lds, g, S, E); }
            { pg8::Gemm g{(const bf16*)H8, (const bf16*)(WIN8 + (size_t)l * 32 * 256 * D), T, 24 * 256, D / 2}; pg8::StaticOrder S; S.init(T, 24 * 256, F.G, (int)blockIdx.x);
              pg8::EpiIn E{RQ, RK, RVT, RG, BQKV, BZ, CQ, CK, CVT, GATES, BBA, 1, 1.0f / 256.f};
              pg8::gemm_phase<pg8::EpiIn, pg8::StaticOrder, true, true, true>(F.lds, g, S, E); }
        }
        SEAM(pb + 0);
        if (IN(pb + 1)) {
            const float* cw = conv_w + (size_t)l * 4 * 3072;
            { const int per = (1024 + F.G - 1) / F.G, lo_ = F.vcu * per, hi_ = lo_ + per < 1024 ? lo_ + per : 1024;
              for (int it = lo_; it < hi_; ++it) gdn_prep_item(F, l, it >> 5, it & 31, it == lo_ || (it & 31) == 0, BQKV, BBA, cw, a_log, dt_bias, ws + WS_GCH + (size_t)it * GDN_CH_BYTES, (float*)(ws + WS_GL) + it); }
        }
        SEAM(pb + 1);
        if (IN(pb + 2)) {
            const int bx = F.vcu;
            const int qw = 100 + l;
            if (bx >= 32 && bx < 48) {
                pg8::Gemm g2{MEMN + (size_t)l * MEMR * D, WKV + (size_t)l * 1024 * D, MEMR, 1024, D}; pg8::StaticOrder S2; S2.init(MEMR, 1024, F.G, bx - 32);
                pg8::EpiHeads E2{KX + (size_t)l * NB * 4 * MEML * 128, VXT + (size_t)l * NB * 4 * 128 * MEML, 4, 8, 2};
                pg8::gemm_phase<pg8::EpiHeads, pg8::StaticOrder, true, true>(F.lds, g2, S2, E2);
            }
            if (bx < 32) gdn_scan(F, bx, ws + WS_GCH, (const float*)(ws + WS_GL), OB);
            {
                volatile LAS int* qslot = (volatile LAS int*)(F.lds + MISC_OFF + 256);
                int nxt = 0; if (F.tid == 0) nxt = (int)atomicAdd(ctl + qw, 1u);
                for (;;) {
                    __syncthreads(); if (F.tid == 0) qslot[0] = nxt; __syncthreads();
                    const int it = __builtin_amdgcn_readfirstlane(qslot[0]); if (it >= 768) break;
                    if (F.tid == 0) nxt = (int)atomicAdd(ctl + qw, 1u);
                    const int v = it / 48, r = it % 48;
                    if (r < 32) { const int qt = 15 - v, hd = r, b = hd >> 3, hm = hd & 7, hh = hm >> 1, m = hm & 1; const float slope = exp2f(-2.0f * (float)(hh + 1));
                        flash_item<256, 128, true, true, false>(F, CQ + ((size_t)hd * SEQ + qt * 128) * 128, CK + (size_t)hd * SEQ * 128, CVT + (size_t)(b * 4 + hh) * 256 * SEQ, SEQ, qt * 128, SEQ, slope,
                                                            nullptr, O12 + ((size_t)m * T + b * SEQ + qt * 128) * 1024 + hh * 256, 1024); }
                    else { const int qt2 = 7 - (v >> 1), hd = (r - 32) + 16 * (v & 1), b = hd >> 3, hm = hd & 7; const float lg = log2f(1.0f - exp2f(-5.0f - (float)hm));
                        flash_ret(F, RQ + ((size_t)hd * SEQ + qt2 * 256) * 128, RK + (size_t)hd * SEQ * 128, RVT + (size_t)hd * 128 * SEQ, SEQ, qt2 * 256, lg, OA + ((size_t)(b * SEQ + qt2 * 256)) * 1024 + hm * 128, 1024); }
                }
            }
        }
        SEAM(pb + 2);
        if (IN(pb + 3)) {
            const int lane = F.lane;
            const float* lv = diff_lambda + (size_t)l * 512;
            const float d01 = wave_sum(lv[lane] * lv[128 + lane] + lv[64 + lane] * lv[192 + lane]), d23 = wave_sum(lv[256 + lane] * lv[384 + lane] + lv[320 + lane] * lv[448 + lane]);
            const float lam = __expf(d01) - __expf(d23) + lambda_init;
            const float gw0 = gdn_norm_w[l * 128 + 2 * lane], gw1 = gdn_norm_w[l * 128 + 2 * lane + 1]; const f32x4 dw = *(const f32x4*)(diff_norm_w + l * 256 + 4 * lane);
            for (int t = F.gw; t < T; t += F.NGW) {
                float a0[8], a1[8], b0[8], b1[8], red[28]; f32x4 dd[4];
#pragma unroll
                for (int h = 0; h < 8; ++h) { const size_t o = (size_t)t * 1024 + h * 128 + 2 * lane; const unsigned av = *(const unsigned*)(OA + o), bv = *(const unsigned*)(OB + o);
                    a0[h] = bf2f(av & 0xffffu); a1[h] = __uint_as_float(av & 0xffff0000u); b0[h] = bf2f(bv & 0xffffu); b1[h] = __uint_as_float(bv & 0xffff0000u);
                    red[h] = a0[h] + a1[h]; red[8 + h] = a0[h] * a0[h] + a1[h] * a1[h]; red[16 + h] = b0[h] * b0[h] + b1[h] * b1[h]; }
#pragma unroll
                for (int h = 0; h < 4; ++h) { const size_t o = (size_t)t * 1024 + h * 256 + 4 * lane; const v2u pw = *(const v2u*)(O12 + o), qw = *(const v2u*)(O12 + (size_t)T * 1024 + o);
                    const f32x4 p = {bf2f(pw.x & 0xffffu), __uint_as_float(pw.x & 0xffff0000u), bf2f(pw.y & 0xffffu), __uint_as_float(pw.y & 0xffff0000u)}, q = {bf2f(qw.x & 0xffffu), __uint_as_float(qw.x & 0xffff0000u), bf2f(qw.y & 0xffffu), __uint_as_float(qw.y & 0xffff0000u)};
                    dd[h] = p - q * lam; red[24 + h] = (dd[h][0] * dd[h][0] + dd[h][1] * dd[h][1]) + (dd[h][2] * dd[h][2] + dd[h][3] * dd[h][3]); }
#pragma unroll
                for (int o = 1; o < 64; o <<= 1) {
#pragma unroll
                    for (int i = 0; i < 28; ++i) red[i] += __shfl_xor(red[i], o); }
#pragma unroll
                for (int h = 0; h < 8; ++h) { const size_t o = (size_t)t * 1024 + h * 128 + 2 * lane; const unsigned gv = *(const unsigned*)(RG + o), zv = *(const unsigned*)(BZ + o);
                    const float mean = red[h] * (1.f / 128.f), var = fmaxf(red[8 + h] * (1.f / 128.f) - mean * mean, 0.f), rsa = rsqrtf(var + EPS), rsb = rsqrtf(red[16 + h] * (1.f / 128.f) + EPS);
                    *(unsigned*)(OCAT + (size_t)t * 3072 + h * 128 + 2 * lane) = pk2((a0[h] - mean) * rsa * bf2f(gv & 0xffffu), (a1[h] - mean) * rsa * __uint_as_float(gv & 0xffff0000u));
                    *(unsigned*)(OCAT + (size_t)t * 3072 + 1024 + h * 128 + 2 * lane) = pk2(b0[h] * rsb * gw0 * bf2f(zv & 0xffffu), b1[h] * rsb * gw1 * __uint_as_float(zv & 0xffff0000u)); }
#pragma unroll
                for (int h = 0; h < 4; ++h) { const float rstd = rsqrtf(red[24 + h] * (1.f / 256.f) + EPS) * (1.0f - lambda_init);
                    v2u ov; ov.x = pk2(dd[h][0] * rstd * dw[0], dd[h][1] * rstd * dw[1]); ov.y = pk2(dd[h][2] * rstd * dw[2], dd[h][3] * rstd * dw[3]); *(v2u*)(OCAT + (size_t)t * 3072 + 2048 + h * 256 + 4 * lane) = ov; }
            }
        }
        SEAM(pb + 3);
        if (IN(pb + 4)) {
            pg8::Gemm g{OCAT, WBR + (size_t)l * D * 3072, T, D, 3072}; pg8::StaticOrder S; S.init(T, D, F.G, (int)blockIdx.x);
            pg8::EpiBranch E{MERGEB, GATES, 16, 32};
            pg8::gemm_phase<pg8::EpiBranch, pg8::StaticOrder, true, true>(F.lds, g, S, E);
        }
        SEAM(pb + 4);
        if (IN(pb + 5)) {
            pg8::Gemm g{MERGEB, WOUT + (size_t)l * D * D, T, D, D}; pg8::StaticOrder S; S.init(T, D, F.G, (int)blockIdx.x);
            if (l == 0) { pg8::EpiResidB<true> E{x_in, XRES, D, 1.f}; pg8::gemm_phase<pg8::EpiResidB<true>, pg8::StaticOrder, true, true>(F.lds, g, S, E); }
            else { pg8::EpiResidB<false> E{XRES, XRES, D, 1.f}; pg8::gemm_phase<pg8::EpiResidB<false>, pg8::StaticOrder, true, true>(F.lds, g, S, E); }
        }
        SEAM(pb + 5);
        if (IN(pb + 6)) { for (int r = F.gw; r < T; r += F.NGW) rms_row(XRES + (size_t)r * D, cross_norm_w + l * D, H + (size_t)r * D, F.lane); }
        SEAM(pb + 6);
        if (IN(pb + 7)) {
            pg8::Gemm g{H, WQ + (size_t)l * 512 * D, T, 512, 512, D}; pg8::SplitK4Order S{F.G, (int)blockIdx.x};
            pg8::EpiPart E{QP, 512, (size_t)T * 512};
            pg8::gemm_phase<pg8::EpiPart, pg8::SplitK4Order, true, true>(F.lds, g, S, E);
        }
        SEAM(pb + 7);
        if (IN(pb + 8)) {
            for (int it = F.vcu; it < 256; it += F.G) { const int hd = it >> 4, qt = it & 15, b = hd >> 2, hh = hd & 3;
                flash_item<128, 128, false, true, false, true>(F, (const bf16*)(QP + ((size_t)(b * SEQ + qt * 128)) * 512 + hh * 128), KX + ((size_t)l * 16 + hd) * MEML * 128, VXT + ((size_t)l * 16 + hd) * 128 * MEML, MEML, qt * 128, MEML, 0.f,
                                             nullptr, OX + ((size_t)(b * SEQ + qt * 128)) * 512 + hh * 128, 512); }
        }
        SEAM(pb + 8);
        if (IN(pb + 9)) {
            pg8::Gemm g{OX, WO + (size_t)l * D * 512, T, D, 512}; pg8::StaticOrder S; S.init(T, D, F.G, (int)blockIdx.x);
            pg8::EpiResidB<false> E{XRES, XRES, D, 1.f};
            pg8::gemm_phase<pg8::EpiResidB<false>, pg8::StaticOrder, true, true>(F.lds, g, S, E);
        }
        SEAM(pb + 9);
        if (IN(pb + 10)) {
            const int lane = F.lane; const float* w = ffn_norm_w + l * D;
            for (int r = F.gw; r < T; r += F.NGW) {
                const bf16* xrow = XRES + (size_t)r * D; f32x4 v[8]; float ss = 0.f;
#pragma unroll
                for (int j = 0; j < 8; ++j) { v[j] = ldx4(xrow + 4 * (lane + 64 * j)); ss += (v[j][0] * v[j][0] + v[j][1] * v[j][1]) + (v[j][2] * v[j][2] + v[j][3] * v[j][3]); }
                const float rstd = rsqrtf(wave_sum(ss) * (1.f / D) + EPS);
                float lg[8];
#pragma unroll
                for (int e = 0; e < 8; ++e) lg[e] = 0.f;
#pragma unroll
                for (int j = 0; j < 8; ++j) { const f32x4 ww = *(const f32x4*)(w + 4 * (lane + 64 * j)); v[j] = v[j] * rstd * ww; }
                if (l == 1) {
#pragma unroll
                    for (int j = 0; j < 8; ++j)
#pragma unroll
                        for (int c = 0; c < 4; ++c) { const float* rw = router_w + (size_t)(4 * (lane + 64 * j) + c) * 8; const f32x4 r0 = *(const f32x4*)rw, r1 = *(const f32x4*)(rw + 4); const float yc = v[j][c];
                            lg[0] += yc * r0[0]; lg[1] += yc * r0[1]; lg[2] += yc * r0[2]; lg[3] += yc * r0[3]; lg[4] += yc * r1[0]; lg[5] += yc * r1[1]; lg[6] += yc * r1[2]; lg[7] += yc * r1[3]; } }
#pragma unroll
                for (int j = 0; j < 8; ++j) {
                    *(unsigned*)(H8 + (size_t)r * D + 4 * (lane + 64 * j)) = pg8::pk4_fp8(v[j][0], v[j][1], v[j][2], v[j][3]); }
                if (l == 1) {
#pragma unroll
                    for (int e = 0; e < 8; ++e) lg[e] = wave_sum(lg[e]);
                    int e0 = 0; float v0 = lg[0];
#pragma unroll
                    for (int e = 1; e < 8; ++e) if (lg[e] > v0) { v0 = lg[e]; e0 = e; }
                    int e1 = -1; float v1 = -__builtin_inff();
#pragma unroll
                    for (int e = 0; e < 8; ++e) if (e != e0 && lg[e] > v1) { v1 = lg[e]; e1 = e; }
                    if (lane == 0) { const float p0 = 1.0f / (1.0f + __expf(v1 - v0)); int* ro = ROUTE + (size_t)r * 8;
                        ro[0] = e0; ro[1] = e1; ro[2] = (int)atomicAdd(ctl + CW_CNT + e0, 1u); ro[3] = (int)atomicAdd(ctl + CW_CNT + e1, 1u); ((float*)ro)[4] = p0; ((float*)ro)[5] = 1.0f - p0; }
                }
            }
        }
        SEAM(pb + 10);
        if (l == 0) {
            if (IN(pb + 11)) {
                if ((int)blockIdx.x >= F.G - NCONV) conv_moe(F, expert_w_gu, expert_w_down, (unsigned char*)WEGU, (unsigned char*)WEDN, MOE_X1, MOE_X2, (int)blockIdx.x - (F.G - NCONV), NCONV);
                else {
                pg8::Gemm g{(const bf16*)H8, (const bf16*)WGU, T, 2 * DFF, D / 2}; pg8::StaticOrder S; S.init(T, 2 * DFF, F.G - NCONV, (int)blockIdx.x);
                pg8::EpiSwiglu8 E{(unsigned char*)ACT, DFF, 1 << 20, 1.0f / 256.f, 8.f};
                pg8::gemm_phase<pg8::EpiSwiglu8, pg8::StaticOrder, true, true, true>(F.lds, g, S, E); }
            }
            SEAM(pb + 11);
            if (IN(pb + 12)) {
                pg8::Gemm g{ACT, WDN, T, D, DFF / 2}; pg8::StaticOrder S; S.init(T, D, F.G, (int)blockIdx.x);
                pg8::EpiResidB<false> E{XRES, XRES, D, 1.0f / 2048.f};
                pg8::gemm_phase<pg8::EpiResidB<false>, pg8::StaticOrder, true, true, true>(F.lds, g, S, E);
            }
            SEAM(pb + 12);
            if (IN(pb + 13)) { for (int r = F.gw; r < T; r += F.NGW) rms_row(XRES + (size_t)r * D, mix_norm_w + D, H + (size_t)r * D, F.lane, H8 + (size_t)r * D); }
            SEAM(pb + 13);
        } else {
#define MOE_OFFSETS() int off[9]; off[0] = 0; _Pragma("unroll") for (int e = 0; e < 8; ++e) { const int c = __builtin_amdgcn_readfirstlane((int)__hip_atomic_load(ctl + CW_CNT + e, __ATOMIC_RELAXED, __HIP_MEMORY_SCOPE_AGENT)); off[e + 1] = off[e] + ((c + 255) & ~255); }
            if (IN(pb + 11)) {
                MOE_OFFSETS();
                for (int it = F.gw; it < T * 2; it += F.NGW) { const int t = it >> 1, k = it & 1; int* ro = ROUTE + (size_t)t * 8; const int e = ro[k], pos = ro[2 + k];
                    int base = 0;
#pragma unroll
                    for (int q = 0; q < 8; ++q) if (e == q) base = off[q];
                    const int slot = base + pos; if (F.lane == 0) ro[6 + k] = slot;
                    const v4u* src = (const v4u*)(H8 + (size_t)t * D); v4u* dst = (v4u*)((unsigned char*)HG + (size_t)slot * D);
#pragma unroll
                    for (int j = 0; j < 2; ++j) dst[F.lane + 64 * j] = src[F.lane + 64 * j]; }
#pragma unroll
                for (int e = 0; e < 8; ++e) { const int c = __builtin_amdgcn_readfirstlane((int)__hip_atomic_load(ctl + CW_CNT + e, __ATOMIC_RELAXED, __HIP_MEMORY_SCOPE_AGENT));
                    for (int rr = off[e] + c + F.gw; rr < off[e + 1]; rr += F.NGW) { v4u* dst = (v4u*)((unsigned char*)HG + (size_t)rr * D);
#pragma unroll
                        for (int j = 0; j < 2; ++j) dst[F.lane + 64 * j] = (v4u){0u, 0u, 0u, 0u}; } }
            }
            SEAM(pb + 11);
            if (IN(pb + 12)) {
                if (F.tid == 0) { MOE_OFFSETS(); int cu = 0;
#pragma unroll
                    for (int e = 0; e < 8; ++e) { const int ne = (off[e + 1] - off[e]) >> 8; MTAB[e] = ne; MTAB[8 + e] = off[e] >> 8; MTAB[16 + e] = cu; cu += ne * 56; } MTAB[24] = cu; MTAB[25] = cu; }
                __syncthreads();
                pg8::Gemm g{HG, WEGU, MAXSLOT, NEXP * 2 * EFF, D / 2}; pg8::MoeOrder S{(const LAS int*)MTAB, 56, F.G, (int)blockIdx.x};
                pg8::EpiSwiglu8 E{(unsigned char*)EACT, EFF, 56, 1.0f / 256.f, 8.f};
                pg8::gemm_phase<pg8::EpiSwiglu8, pg8::MoeOrder, true, true, true>(F.lds, g, S, E);
            }
            SEAM(pb + 12);
            if (IN(pb + 13)) {
                __syncthreads();
                if (F.tid == 0) { MOE_OFFSETS(); int cu = 0;
#pragma unroll
                    for (int e = 0; e < 8; ++e) { const int ne = (off[e + 1] - off[e]) >> 8; MTAB[e] = ne; MTAB[8 + e] = off[e] >> 8; MTAB[16 + e] = cu; cu += ne * 8; } MTAB[24] = cu; MTAB[25] = cu; }
                __syncthreads();
                { pg8::Gemm g{EACT, WEDN, MAXSLOT, NEXP * D, EFF / 2}; pg8::MoeOrder S{(const LAS int*)MTAB, 8, F.G, (int)blockIdx.x, F.G == 256 ? 2 * F.G : (1 << 30)};
                  pg8::EpiStoreF32 E{Y, D, 8, 1.0f / 2048.f};
                  pg8::gemm_phase<pg8::EpiStoreF32, pg8::MoeOrder, true, true, true>(F.lds, g, S, E); }
                { pg8::Gemm g{EACT, WEDN, MAXSLOT, NEXP * D, EFF / 8, EFF / 2}; pg8::MoeTailOrder S{(const LAS int*)MTAB, 8, (int)blockIdx.x, F.G == 256 ? 2 * F.G : (1 << 30), EFF / 4};
                  pg8::EpiTailPart E{(float*)(ws + WS_YP), D, 8, 1.0f / 2048.f, EFF / 4, (size_t)MAXSLOT * D};
                  pg8::gemm_phase<pg8::EpiTailPart, pg8::MoeTailOrder, true, true, true>(F.lds, g, S, E); }
            }
            SEAM(pb + 13);
            if (IN(pb + 14)) {
                const int lane = F.lane;
                LAS int* TMAP = (LAS int*)F.lds;
                __syncthreads();
                if (F.tid == 0) { MOE_OFFSETS(); int cu = 0;
#pragma unroll
                    for (int e = 0; e < 8; ++e) { const int ne = (off[e + 1] - off[e]) >> 8; MTAB[e] = ne; MTAB[8 + e] = off[e] >> 8; MTAB[16 + e] = cu; cu += ne * 8; } MTAB[24] = cu; MTAB[25] = cu; }
                for (int q = F.tid; q < 72 * 8; q += NWAVES * 64) TMAP[q] = 0;
                __syncthreads();
                if (F.G == 256) { const int tot = __builtin_amdgcn_readfirstlane(MTAB[25]); for (int tu = 2 * F.G; tu < tot; ++tu) { int pm, pn; pg8::moe_map((const LAS int*)MTAB, 8, tu, pm, pn); if (F.tid == 0) TMAP[pm * 8 + (pn & 7)] = 1; } }
                __syncthreads();
                const float* YP = (const float*)(ws + WS_YP); const size_t PS = (size_t)MAXSLOT * D;
                for (int r = F.gw; r < T; r += F.NGW) { const int* ro = ROUTE + (size_t)r * 8; const float p0 = ((const float*)ro)[4], p1 = ((const float*)ro)[5]; const int s0 = __builtin_amdgcn_readfirstlane(ro[6]), s1 = __builtin_amdgcn_readfirstlane(ro[7]);
                    const bf16* xrow = XRES + (size_t)r * D; f32x4 v[8]; float ss = 0.f;
#pragma unroll
                    for (int j = 0; j < 8; ++j) { const int o = 4 * (lane + 64 * j);
                        const size_t a0 = (size_t)s0 * D + o, a1 = (size_t)s1 * D + o;
                        const f32x4 y0 = TMAP[(s0 >> 8) * 8 + j] ? (*(const f32x4*)(YP + a0) + *(const f32x4*)(YP + PS + a0)) + (*(const f32x4*)(YP + 2 * PS + a0) + *(const f32x4*)(YP + 3 * PS + a0)) : *(const f32x4*)(Y + a0);
                        const f32x4 y1 = TMAP[(s1 >> 8) * 8 + j] ? (*(const f32x4*)(YP + a1) + *(const f32x4*)(YP + PS + a1)) + (*(const f32x4*)(YP + 2 * PS + a1) + *(const f32x4*)(YP + 3 * PS + a1)) : *(const f32x4*)(Y + a1);
                        v[j] = ldx4(xrow + o) + y0 * p0 + y1 * p1; ss += (v[j][0] * v[j][0] + v[j][1] * v[j][1]) + (v[j][2] * v[j][2] + v[j][3] * v[j][3]); }
                    f32x4 fw[8];
#pragma unroll
                    for (int j = 0; j < 8; ++j) fw[j] = *(const f32x4*)(final_norm_w + 4 * (lane + 64 * j));
                    const float rstd = rsqrtf(wave_sum(ss) * (1.f / D) + EPS);
#pragma unroll
                    for (int j = 0; j < 8; ++j) { const int o = 4 * (lane + 64 * j); const f32x4 ww = fw[j]; *(f32x4*)(args.out + (size_t)r * D + o) = v[j] * rstd * ww; } }
            }
        }
    }
    { constexpr int l = 1;
        const int pb = 2 + l * NPL;
        const float lambda_init = l == 0 ? 0.2f : 0.35550906f;
        if (IN(pb + 0)) {
            if ((int)blockIdx.x >= F.G - NCONV) conv_moe(F, expert_w_gu, expert_w_down, (unsigned char*)WEGU, (unsigned char*)WEDN, l == 0 ? MOE_X0 : MOE_X2, l == 0 ? MOE_X1 : MOE_ITEMS, (int)blockIdx.x - (F.G - NCONV), NCONV);
            else
            { pg8::Gemm g{H, WIN + (size_t)l * NINP * D, T, 45 * 256, D}; pg8::StaticOrder S; S.init(T, 45 * 256, F.G - NCONV, (int)blockIdx.x);
              pg8::EpiIn E{RQ, RK, RVT, RG, BQKV, BZ, CQ, CK, CVT, GATES, BBA, 0, 1.f};
              pg8::gemm_phase<pg8::EpiIn, pg8::StaticOrder, true, true>(F.lds, g, S, E); }
            { pg8::Gemm g{(const bf16*)H8, (const bf16*)(WIN8 + (size_t)l * 32 * 256 * D), T, 24 * 256, D / 2}; pg8::StaticOrder S; S.init(T, 24 * 256, F.G, (int)blockIdx.x);
              pg8::EpiIn E{RQ, RK, RVT, RG, BQKV, BZ, CQ, CK, CVT, GATES, BBA, 1, 1.0f / 256.f};
              pg8::gemm_phase<pg8::EpiIn, pg8::StaticOrder, true, true, true>(F.lds, g, S, E); }
        }
        SEAM(pb + 0);
        if (IN(pb + 1)) {
            const float* cw = conv_w + (size_t)l * 4 * 3072;
            { const int per = (1024 + F.G - 1) / F.G, lo_ = F.vcu * per, hi_ = lo_ + per < 1024 ? lo_ + per : 1024;
              for (int it = lo_; it < hi_; ++it) gdn_prep_item(F, l, it >> 5, it & 31, it == lo_ || (it & 31) == 0, BQKV, BBA, cw, a_log, dt_bias, ws + WS_GCH + (size_t)it * GDN_CH_BYTES, (float*)(ws + WS_GL) + it); }
        }
        SEAM(pb + 1);
        if (IN(pb + 2)) {
            const int bx = F.vcu;
            const int qw = 100 + l;
            if (bx >= 32 && bx < 48) {
                pg8::Gemm g2{MEMN + (size_t)l * MEMR * D, WKV + (size_t)l * 1024 * D, MEMR, 1024, D}; pg8::StaticOrder S2; S2.init(MEMR, 1024, F.G, bx - 32);
                pg8::EpiHeads E2{KX + (size_t)l * NB * 4 * MEML * 128, VXT + (size_t)l * NB * 4 * 128 * MEML, 4, 8, 2};
                pg8::gemm_phase<pg8::EpiHeads, pg8::StaticOrder, true, true>(F.lds, g2, S2, E2);
            }
            if (bx < 32) gdn_scan(F, bx, ws + WS_GCH, (const float*)(ws + WS_GL), OB);
            {
                volatile LAS int* qslot = (volatile LAS int*)(F.lds + MISC_OFF + 256);
                int nxt = 0; if (F.tid == 0) nxt = (int)atomicAdd(ctl + qw, 1u);
                for (;;) {
                    __syncthreads(); if (F.tid == 0) qslot[0] = nxt; __syncthreads();
                    const int it = __builtin_amdgcn_readfirstlane(qslot[0]); if (it >= 768) break;
                    if (F.tid == 0) nxt = (int)atomicAdd(ctl + qw, 1u);
                    const int v = it / 48, r = it % 48;
                    if (r < 32) { const int qt = 15 - v, hd = r, b = hd >> 3, hm = hd & 7, hh = hm >> 1, m = hm & 1; const float slope = exp2f(-2.0f * (float)(hh + 1));
                        flash_item<256, 128, true, true, false>(F, CQ + ((size_t)hd * SEQ + qt * 128) * 128, CK + (size_t)hd * SEQ * 128, CVT + (size_t)(b * 4 + hh) * 256 * SEQ, SEQ, qt * 128, SEQ, slope,
                                                            nullptr, O12 + ((size_t)m * T + b * SEQ + qt * 128) * 1024 + hh * 256, 1024); }
                    else { const int qt2 = 7 - (v >> 1), hd = (r - 32) + 16 * (v & 1), b = hd >> 3, hm = hd & 7; const float lg = log2f(1.0f - exp2f(-5.0f - (float)hm));
                        flash_ret(F, RQ + ((size_t)hd * SEQ + qt2 * 256) * 128, RK + (size_t)hd * SEQ * 128, RVT + (size_t)hd * 128 * SEQ, SEQ, qt2 * 256, lg, OA + ((size_t)(b * SEQ + qt2 * 256)) * 1024 + hm * 128, 1024); }
                }
            }
        }
        SEAM(pb + 2);
        if (IN(pb + 3)) {
            const int lane = F.lane;
            const float* lv = diff_lambda + (size_t)l * 512;
            const float d01 = wave_sum(lv[lane] * lv[128 + lane] + lv[64 + lane] * lv[192 + lane]), d23 = wave_sum(lv[256 + lane] * lv[384 + lane] + lv[320 + lane] * lv[448 + lane]);
            const float lam = __expf(d01) - __expf(d23) + lambda_init;
            const float gw0 = gdn_norm_w[l * 128 + 2 * lane], gw1 = gdn_norm_w[l * 128 + 2 * lane + 1]; const f32x4 dw = *(const f32x4*)(diff_norm_w + l * 256 + 4 * lane);
            for (int t = F.gw; t < T; t += F.NGW) {
                float a0[8], a1[8], b0[8], b1[8], red[28]; f32x4 dd[4];
#pragma unroll
                for (int h = 0; h < 8; ++h) { const size_t o = (size_t)t * 1024 + h * 128 + 2 * lane; const unsigned av = *(const unsigned*)(OA + o), bv = *(const unsigned*)(OB + o);
                    a0[h] = bf2f(av & 0xffffu); a1[h] = __uint_as_float(av & 0xffff0000u); b0[h] = bf2f(bv & 0xffffu); b1[h] = __uint_as_float(bv & 0xffff0000u);
                    red[h] = a0[h] + a1[h]; red[8 + h] = a0[h] * a0[h] + a1[h] * a1[h]; red[16 + h] = b0[h] * b0[h] + b1[h] * b1[h]; }
#pragma unroll
                for (int h = 0; h < 4; ++h) { const size_t o = (size_t)t * 1024 + h * 256 + 4 * lane; const v2u pw = *(const v2u*)(O12 + o), qw = *(const v2u*)(O12 + (size_t)T * 1024 + o);
                    const f32x4 p = {bf2f(pw.x & 0xffffu), __uint_as_float(pw.x & 0xffff0000u), bf2f(pw.y & 0xffffu), __uint_as_float(pw.y & 0xffff0000u)}, q = {bf2f(qw.x & 0xffffu), __uint_as_float(qw.x & 0xffff0000u), bf2f(qw.y & 0xffffu), __uint_as_float(qw.y & 0xffff0000u)};
                    dd[h] = p - q * lam; red[24 + h] = (dd[h][0] * dd[h][0] + dd[h][1] * dd[h][1]) + (dd[h][2] * dd[h][2] + dd[h][3] * dd[h][3]); }
#pragma unroll
                for (int o = 1; o < 64; o <<= 1) {
#pragma unroll
                    for (int i = 0; i < 28; ++i) red[i] += __shfl_xor(red[i], o); }
#pragma unroll
                for (int h = 0; h < 8; ++h) { const size_t o = (size_t)t * 1024 + h * 128 + 2 * lane; const unsigned gv = *(const unsigned*)(RG + o), zv = *(const unsigned*)(BZ + o);
                    const float mean = red[h] * (1.f / 128.f), var = fmaxf(red[8 + h] * (1.f / 128.f) - mean * mean, 0.f), rsa = rsqrtf(var + EPS), rsb = rsqrtf(red[16 + h] * (1.f / 128.f) + EPS);
                    *(unsigned*)(OCAT + (size_t)t * 3072 + h * 128 + 2 * lane) = pk2((a0[h] - mean) * rsa * bf2f(gv & 0xffffu), (a1[h] - mean) * rsa * __uint_as_float(gv & 0xffff0000u));
                    *(unsigned*)(OCAT + (size_t)t * 3072 + 1024 + h * 128 + 2 * lane) = pk2(b0[h] * rsb * gw0 * bf2f(zv & 0xffffu), b1[h] * rsb * gw1 * __uint_as_float(zv & 0xffff0000u)); }
#pragma unroll
                for (int h = 0; h < 4; ++h) { const float rstd = rsqrtf(red[24 + h] * (1.f / 256.f) + EPS) * (1.0f - lambda_init);
                    v2u ov; ov.x = pk2(dd[h][0] * rstd * dw[0], dd[h][1] * rstd * dw[1]); ov.y = pk2(dd[h][2] * rstd * dw[2], dd[h][3] * rstd * dw[3]); *(v2u*)(OCAT + (size_t)t * 3072 + 2048 + h * 256 + 4 * lane) = ov; }
            }
        }
        SEAM(pb + 3);
        if (IN(pb + 4)) {
            pg8::Gemm g{OCAT, WBR + (size_t)l * D * 3072, T, D, 3072}; pg8::StaticOrder S; S.init(T, D, F.G, (int)blockIdx.x);
            pg8::EpiBranch E{MERGEB, GATES, 16, 32};
            pg8::gemm_phase<pg8::EpiBranch, pg8::StaticOrder, true, true>(F.lds, g, S, E);
        }
        SEAM(pb + 4);
        if (IN(pb + 5)) {
            pg8::Gemm g{MERGEB, WOUT + (size_t)l * D * D, T, D, D}; pg8::StaticOrder S; S.init(T, D, F.G, (int)blockIdx.x);
            if (l == 0) { pg8::EpiResidB<true> E{x_in, XRES, D, 1.f}; pg8::gemm_phase<pg8::EpiResidB<true>, pg8::StaticOrder, true, true>(F.lds, g, S, E); }
            else { pg8::EpiResidB<false> E{XRES, XRES, D, 1.f}; pg8::gemm_phase<pg8::EpiResidB<false>, pg8::StaticOrder, true, true>(F.lds, g, S, E); }
        }
        SEAM(pb + 5);
        if (IN(pb + 6)) { for (int r = F.gw; r < T; r += F.NGW) rms_row(XRES + (size_t)r * D, cross_norm_w + l * D, H + (size_t)r * D, F.lane); }
        SEAM(pb + 6);
        if (IN(pb + 7)) {
            pg8::Gemm g{H, WQ + (size_t)l * 512 * D, T, 512, 512, D}; pg8::SplitK4Order S{F.G, (int)blockIdx.x};
            pg8::EpiPart E{QP, 512, (size_t)T * 512};
            pg8::gemm_phase<pg8::EpiPart, pg8::SplitK4Order, true, true>(F.lds, g, S, E);
        }
        SEAM(pb + 7);
        if (IN(pb + 8)) {
            for (int it = F.vcu; it < 256; it += F.G) { const int hd = it >> 4, qt = it & 15, b = hd >> 2, hh = hd & 3;
                flash_item<128, 128, false, true, false, true>(F, (const bf16*)(QP + ((size_t)(b * SEQ + qt * 128)) * 512 + hh * 128), KX + ((size_t)l * 16 + hd) * MEML * 128, VXT + ((size_t)l * 16 + hd) * 128 * MEML, MEML, qt * 128, MEML, 0.f,
                                             nullptr, OX + ((size_t)(b * SEQ + qt * 128)) * 512 + hh * 128, 512); }
        }
        SEAM(pb + 8);
        if (IN(pb + 9)) {
            pg8::Gemm g{OX, WO + (size_t)l * D * 512, T, D, 512}; pg8::StaticOrder S; S.init(T, D, F.G, (int)blockIdx.x);
            pg8::EpiResidB<false> E{XRES, XRES, D, 1.f};
            pg8::gemm_phase<pg8::EpiResidB<false>, pg8::StaticOrder, true, true>(F.lds, g, S, E);
        }
        SEAM(pb + 9);
        if (IN(pb + 10)) {
            const int lane = F.lane; const float* w = ffn_norm_w + l * D;
            for (int r = F.gw; r < T; r += F.NGW) {
                const bf16* xrow = XRES + (size_t)r * D; f32x4 v[8]; float ss = 0.f;
#pragma unroll
                for (int j = 0; j < 8; ++j) { v[j] = ldx4(xrow + 4 * (lane + 64 * j)); ss += (v[j][0] * v[j][0] + v[j][1] * v[j][1]) + (v[j][2] * v[j][2] + v[j][3] * v[j][3]); }
                const float rstd = rsqrtf(wave_sum(ss) * (1.f / D) + EPS);
                float lg[8];
#pragma unroll
                for (int e = 0; e < 8; ++e) lg[e] = 0.f;
#pragma unroll
                for (int j = 0; j < 8; ++j) { const f32x4 ww = *(const f32x4*)(w + 4 * (lane + 64 * j)); v[j] = v[j] * rstd * ww; }
                if (l == 1) {
#pragma unroll
                    for (int j = 0; j < 8; ++j)
#pragma unroll
                        for (int c = 0; c < 4; ++c) { const float* rw = router_w + (size_t)(4 * (lane + 64 * j) + c) * 8; const f32x4 r0 = *(const f32x4*)rw, r1 = *(const f32x4*)(rw + 4); const float yc = v[j][c];
                            lg[0] += yc * r0[0]; lg[1] += yc * r0[1]; lg[2] += yc * r0[2]; lg[3] += yc * r0[3]; lg[4] += yc * r1[0]; lg[5] += yc * r1[1]; lg[6] += yc * r1[2]; lg[7] += yc * r1[3]; } }
#pragma unroll
                for (int j = 0; j < 8; ++j) {
                    *(unsigned*)(H8 + (size_t)r * D + 4 * (lane + 64 * j)) = pg8::pk4_fp8(v[j][0], v[j][1], v[j][2], v[j][3]); }
                if (l == 1) {
#pragma unroll
                    for (int e = 0; e < 8; ++e) lg[e] = wave_sum(lg[e]);
                    int e0 = 0; float v0 = lg[0];
#pragma unroll
                    for (int e = 1; e < 8; ++e) if (lg[e] > v0) { v0 = lg[e]; e0 = e; }
                    int e1 = -1; float v1 = -__builtin_inff();
#pragma unroll
                    for (int e = 0; e < 8; ++e) if (e != e0 && lg[e] > v1) { v1 = lg[e]; e1 = e; }
                    if (lane == 0) { const float p0 = 1.0f / (1.0f + __expf(v1 - v0)); int* ro = ROUTE + (size_t)r * 8;
                        ro[0] = e0; ro[1] = e1; ro[2] = (int)atomicAdd(ctl + CW_CNT + e0, 1u); ro[3] = (int)atomicAdd(ctl + CW_CNT + e1, 1u); ((float*)ro)[4] = p0; ((float*)ro)[5] = 1.0f - p0; }
                }
            }
        }
        SEAM(pb + 10);
        if (l == 0) {
            if (IN(pb + 11)) {
                if ((int)blockIdx.x >= F.G - NCONV) conv_moe(F, expert_w_gu, expert_w_down, (unsigned char*)WEGU, (unsigned char*)WEDN, MOE_X1, MOE_X2, (int)blockIdx.x - (F.G - NCONV), NCONV);
                else {
                pg8::Gemm g{(const bf16*)H8, (const bf16*)WGU, T, 2 * DFF, D / 2}; pg8::StaticOrder S; S.init(T, 2 * DFF, F.G - NCONV, (int)blockIdx.x);
                pg8::EpiSwiglu8 E{(unsigned char*)ACT, DFF, 1 << 20, 1.0f / 256.f, 8.f};
                pg8::gemm_phase<pg8::EpiSwiglu8, pg8::StaticOrder, true, true, true>(F.lds, g, S, E); }
            }
            SEAM(pb + 11);
            if (IN(pb + 12)) {
                pg8::Gemm g{ACT, WDN, T, D, DFF / 2}; pg8::StaticOrder S; S.init(T, D, F.G, (int)blockIdx.x);
                pg8::EpiResidB<false> E{XRES, XRES, D, 1.0f / 2048.f};
                pg8::gemm_phase<pg8::EpiResidB<false>, pg8::StaticOrder, true, true, true>(F.lds, g, S, E);
            }
            SEAM(pb + 12);
            if (IN(pb + 13)) { for (int r = F.gw; r < T; r += F.NGW) rms_row(XRES + (size_t)r * D, mix_norm_w + D, H + (size_t)r * D, F.lane, H8 + (size_t)r * D); }
            SEAM(pb + 13);
        } else {
#define MOE_OFFSETS() int off[9]; off[0] = 0; _Pragma("unroll") for (int e = 0; e < 8; ++e) { const int c = __builtin_amdgcn_readfirstlane((int)__hip_atomic_load(ctl + CW_CNT + e, __ATOMIC_RELAXED, __HIP_MEMORY_SCOPE_AGENT)); off[e + 1] = off[e] + ((c + 255) & ~255); }
            if (IN(pb + 11)) {
                MOE_OFFSETS();
                for (int it = F.gw; it < T * 2; it += F.NGW) { const int t = it >> 1, k = it & 1; int* ro = ROUTE + (size_t)t * 8; const int e = ro[k], pos = ro[2 + k];
                    int base = 0;
#pragma unroll
                    for (int q = 0; q < 8; ++q) if (e == q) base = off[q];
                    const int slot = base + pos; if (F.lane == 0) ro[6 + k] = slot;
                    const v4u* src = (const v4u*)(H8 + (size_t)t * D); v4u* dst = (v4u*)((unsigned char*)HG + (size_t)slot * D);
#pragma unroll
                    for (int j = 0; j < 2; ++j) dst[F.lane + 64 * j] = src[F.lane + 64 * j]; }
#pragma unroll
                for (int e = 0; e < 8; ++e) { const int c = __builtin_amdgcn_readfirstlane((int)__hip_atomic_load(ctl + CW_CNT + e, __ATOMIC_RELAXED, __HIP_MEMORY_SCOPE_AGENT));
                    for (int rr = off[e] + c + F.gw; rr < off[e + 1]; rr += F.NGW) { v4u* dst = (v4u*)((unsigned char*)HG + (size_t)rr * D);
#pragma unroll
                        for (int j = 0; j < 2; ++j) dst[F.lane + 64 * j] = (v4u){0u, 0u, 0u, 0u}; } }
            }
            SEAM(pb + 11);
            if (IN(pb + 12)) {
                if (F.tid == 0) { MOE_OFFSETS(); int cu = 0;
#pragma unroll
                    for (int e = 0; e < 8; ++e) { const int ne = (off[e + 1] - off[e]) >> 8; MTAB[e] = ne; MTAB[8 + e] = off[e] >> 8; MTAB[16 + e] = cu; cu += ne * 56; } MTAB[24] = cu; MTAB[25] = cu; }
                __syncthreads();
                pg8::Gemm g{HG, WEGU, MAXSLOT, NEXP * 2 * EFF, D / 2}; pg8::MoeOrder S{(const LAS int*)MTAB, 56, F.G, (int)blockIdx.x};
                pg8::EpiSwiglu8 E{(unsigned char*)EACT, EFF, 56, 1.0f / 256.f, 8.f};
                pg8::gemm_phase<pg8::EpiSwiglu8, pg8::MoeOrder, true, true, true>(F.lds, g, S, E);
            }
            SEAM(pb + 12);
            if (IN(pb + 13)) {
                __syncthreads();
                if (F.tid == 0) { MOE_OFFSETS(); int cu = 0;
#pragma unroll
                    for (int e = 0; e < 8; ++e) { const int ne = (off[e + 1] - off[e]) >> 8; MTAB[e] = ne; MTAB[8 + e] = off[e] >> 8; MTAB[16 + e] = cu; cu += ne * 8; } MTAB[24] = cu; MTAB[25] = cu; }
                __syncthreads();
                { pg8::Gemm g{EACT, WEDN, MAXSLOT, NEXP * D, EFF / 2}; pg8::MoeOrder S{(const LAS int*)MTAB, 8, F.G, (int)blockIdx.x, F.G == 256 ? 2 * F.G : (1 << 30)};
                  pg8::EpiStoreF32 E{Y, D, 8, 1.0f / 2048.f};
                  pg8::gemm_phase<pg8::EpiStoreF32, pg8::MoeOrder, true, true, true>(F.lds, g, S, E); }
                { pg8::Gemm g{EACT, WEDN, MAXSLOT, NEXP * D, EFF / 8, EFF / 2}; pg8::MoeTailOrder S{(const LAS int*)MTAB, 8, (int)blockIdx.x, F.G == 256 ? 2 * F.G : (1 << 30), EFF / 4};
                  pg8::EpiTailPart E{(float*)(ws + WS_YP), D, 8, 1.0f / 2048.f, EFF / 4, (size_t)MAXSLOT * D};
                  pg8::gemm_phase<pg8::EpiTailPart, pg8::MoeTailOrder, true, true, true>(F.lds, g, S, E); }
            }
            SEAM(pb + 13);
            if (IN(pb + 14)) {
                const int lane = F.lane;
                LAS int* TMAP = (LAS int*)F.lds;
                __syncthreads();
                if (F.tid == 0) { MOE_OFFSETS(); int cu = 0;
#pragma unroll
                    for (int e = 0; e < 8; ++e) { const int ne = (off[e + 1] - off[e]) >> 8; MTAB[e] = ne; MTAB[8 + e] = off[e] >> 8; MTAB[16 + e] = cu; cu += ne * 8; } MTAB[24] = cu; MTAB[25] = cu; }
                for (int q = F.tid; q < 72 * 8; q += NWAVES * 64) TMAP[q] = 0;
                __syncthreads();
                if (F.G == 256) { const int tot = __builtin_amdgcn_readfirstlane(MTAB[25]); for (int tu = 2 * F.G; tu < tot; ++tu) { int pm, pn; pg8::moe_map((const LAS int*)MTAB, 8, tu, pm, pn); if (F.tid == 0) TMAP[pm * 8 + (pn & 7)] = 1; } }
                __syncthreads();
                const float* YP = (const float*)(ws + WS_YP); const size_t PS = (size_t)MAXSLOT * D;
                for (int r = F.gw; r < T; r += F.NGW) { const int* ro = ROUTE + (size_t)r * 8; const float p0 = ((const float*)ro)[4], p1 = ((const float*)ro)[5]; const int s0 = __builtin_amdgcn_readfirstlane(ro[6]), s1 = __builtin_amdgcn_readfirstlane(ro[7]);
                    const bf16* xrow = XRES + (size_t)r * D; f32x4 v[8]; float ss = 0.f;
#pragma unroll
                    for (int j = 0; j < 8; ++j) { const int o = 4 * (lane + 64 * j);
                        const size_t a0 = (size_t)s0 * D + o, a1 = (size_t)s1 * D + o;
                        const f32x4 y0 = TMAP[(s0 >> 8) * 8 + j] ? (*(const f32x4*)(YP + a0) + *(const f32x4*)(YP + PS + a0)) + (*(const f32x4*)(YP + 2 * PS + a0) + *(const f32x4*)(YP + 3 * PS + a0)) : *(const f32x4*)(Y + a0);
                        const f32x4 y1 = TMAP[(s1 >> 8) * 8 + j] ? (*(const f32x4*)(YP + a1) + *(const f32x4*)(YP + PS + a1)) + (*(const f32x4*)(YP + 2 * PS + a1) + *(const f32x4*)(YP + 3 * PS + a1)) : *(const f32x4*)(Y + a1);
                        v[j] = ldx4(xrow + o) + y0 * p0 + y1 * p1; ss += (v[j][0] * v[j][0] + v[j][1] * v[j][1]) + (v[j][2] * v[j][2] + v[j][3] * v[j][3]); }
                    f32x4 fw[8];
#pragma unroll
                    for (int j = 0; j < 8; ++j) fw[j] = *(const f32x4*)(final_norm_w + 4 * (lane + 64 * j));
                    const float rstd = rsqrtf(wave_sum(ss) * (1.f / D) + EPS);
#pragma unroll
                    for (int j = 0; j < 8; ++j) { const int o = 4 * (lane + 64 * j); const f32x4 ww = fw[j]; *(f32x4*)(args.out + (size_t)r * D + o) = v[j] * rstd * ww; } }
            }
        }
    }
#undef IN
#undef SEAM
}

extern "C" void kernel_launch(void* const* d_in, const int* in_sizes, int n_in, void* d_out, int out_size, void* d_ws, size_t ws_size, hipStream_t stream) {
    static int grid = 0;
    if (grid == 0) {
        if (n_in != 24 || out_size != T * D || ws_size < WS_END) { fprintf(stderr, "kernel_launch: unexpected shapes (n_in %d, out %d, ws %zu < %zu)\n", n_in, out_size, ws_size, (size_t)WS_END); grid = -1; return; }
        int dev = 0, cus = 0, per_cu = 0;
        if (hipGetDevice(&dev) != hipSuccess || hipDeviceGetAttribute(&cus, hipDeviceAttributeMultiprocessorCount, dev) != hipSuccess) { grid = -1; return; }
        if (hipFuncSetAttribute((const void*)mk_fwd, hipFuncAttributeMaxDynamicSharedMemorySize, LDS_BYTES) != hipSuccess) { fprintf(stderr, "kernel_launch: hipFuncSetAttribute failed\n"); grid = -1; return; }
        if (hipOccupancyMaxActiveBlocksPerMultiprocessor(&per_cu, (const void*)mk_fwd, NWAVES * 64, LDS_BYTES) != hipSuccess || per_cu < 1) fprintf(stderr, "kernel_launch: occupancy query says %d\n", per_cu);
        (void)hipGetLastError();
        grid = cus;
    }
    if (grid < 0) return;
    (void)hipMemsetAsync((char*)d_ws + WS_CTL, 0, CTL_BYTES, stream);
    Args a{};
    for (int i = 0; i < 24; ++i) a.in[i] = d_in[i];
    a.out = (float*)d_out; a.ws = (unsigned char*)d_ws;
#if MK_ONE_LAUNCH
    a.ph_lo = 0; a.ph_hi = NPH;
    hipLaunchKernelGGL(mk_fwd, dim3(grid), dim3(NWAVES * 64), LDS_BYTES, stream, a);
#else
    for (int p = 0; p < NPH; ++p) { a.ph_lo = p; a.ph_hi = p + 1; hipLaunchKernelGGL(mk_fwd, dim3(grid), dim3(NWAVES * 64), LDS_BYTES, stream, a); }
#endif
}
```
